# Optimizing an MI355X kernel written in HIP

```python
import math
import jax, jax.numpy as jnp
from jax import lax
import numpy as np

D_MODEL = 1024
BATCH = 4
SEQ = 4096
DEPTH = 2

N_MEM = 256
HEAD_DIM = 64
SSD_HEADS = 6
SSD_WIDTH = SSD_HEADS * HEAD_DIM
SSD_GROUPS = 2
SSD_STATE = 64
SSD_CONV = 4
SSD_CHUNK = 128
SSD_CONV_CH = SSD_WIDTH + 2 * SSD_GROUPS * SSD_STATE
SB_HEADS = 6
SB_WIDTH = SB_HEADS * HEAD_DIM
SB_BLOCK = 128
MEM_HEADS = 4
MEM_WIDTH = MEM_HEADS * HEAD_DIM
D_MIX = SSD_WIDTH + SB_WIDTH + MEM_WIDTH
IN_SPLITS = [SSD_WIDTH, SSD_CONV_CH, SSD_HEADS, SB_WIDTH, SB_WIDTH, SB_WIDTH, MEM_WIDTH]
D_IN = sum(IN_SPLITS)
PEER_HEADS = 8
PEER_NKEYS = 128
PEER_EXPERTS = PEER_NKEYS * PEER_NKEYS
PEER_DKEY = 128
PEER_TOPK = 16
PEER_BLOCK = 128
EPS = 1e-6

kernel_name = "hymba_ssd_stickbreak_peer_trunk"


def rmsnorm(x, g):
    xf = x.astype(jnp.float32)
    y = xf * lax.rsqrt(jnp.mean(xf * xf, axis=-1, keepdims=True) + EPS)
    return (y * g.astype(jnp.float32)).astype(x.dtype)


def causal_depthwise_conv(x, w, b):
    k_w, ch = w.shape
    y = lax.conv_general_dilated(
        x, w.astype(x.dtype)[:, None, :], window_strides=(1,), padding=[(k_w - 1, 0)],
        dimension_numbers=("NWC", "WIO", "NWC"), feature_group_count=ch)
    return y + b.astype(x.dtype)


def ssd_scan(xh, dt, a, bm, cm):
    bsz, seqlen, nh, hp = xh.shape
    ns = bm.shape[-1]
    q = SSD_CHUNK
    nc = seqlen // q
    xdt = (xh * dt[..., None]).reshape(bsz, nc, q, nh, hp)
    adt = (dt * a).reshape(bsz, nc, q, nh)
    bm = bm.reshape(bsz, nc, q, nh, ns)
    cm = cm.reshape(bsz, nc, q, nh, ns)
    a_cs = jnp.cumsum(adt, axis=2)
    seg = a_cs[:, :, :, None, :] - a_cs[:, :, None, :, :]
    causal = jnp.tril(jnp.ones((q, q), dtype=bool))[None, None, :, :, None]
    lmat = jnp.exp(jnp.where(causal, seg, -jnp.inf))
    y_diag = jnp.einsum("bclhn,bcshn,bclsh,bcshp->bclhp", cm, bm, lmat, xdt)
    decay_s = jnp.exp(a_cs[:, :, -1:, :] - a_cs)
    states = jnp.einsum("bclhn,bclh,bclhp->bchpn", bm, decay_s, xdt)
    chunk_decay = jnp.exp(a_cs[:, :, -1, :])

    def step(h, inp):
        s_c, d_c = inp
        return h * d_c[:, :, None, None] + s_c, h

    h0 = jnp.zeros((bsz, nh, hp, ns), dtype=jnp.float32)
    _, h_in = lax.scan(step, h0, (jnp.swapaxes(states, 0, 1), jnp.swapaxes(chunk_decay, 0, 1)))
    h_in = jnp.swapaxes(h_in, 0, 1)
    y_off = jnp.einsum("bclhn,bchpn,bclh->bclhp", cm, h_in, jnp.exp(a_cs))
    return (y_diag + y_off).reshape(bsz, seqlen, nh, hp)


def ssd_mixer(u_z, u_xbc, u_dt, conv_w, conv_b, dt_bias, a_log, d_skip, norm_g):
    bsz, seqlen, _ = u_z.shape
    xbc = jax.nn.silu(causal_depthwise_conv(u_xbc, conv_w, conv_b))
    xs, bs, cs = jnp.split(xbc, [SSD_WIDTH, SSD_WIDTH + SSD_GROUPS * SSD_STATE], axis=-1)
    rep = SSD_HEADS // SSD_GROUPS
    xh = xs.reshape(bsz, seqlen, SSD_HEADS, HEAD_DIM).astype(jnp.float32)
    bm = jnp.repeat(bs.reshape(bsz, seqlen, SSD_GROUPS, SSD_STATE), rep, axis=2).astype(jnp.float32)
    cm = jnp.repeat(cs.reshape(bsz, seqlen, SSD_GROUPS, SSD_STATE), rep, axis=2).astype(jnp.float32)
    dt = jax.nn.softplus(u_dt.astype(jnp.float32) + dt_bias.astype(jnp.float32))
    a = -jnp.exp(a_log.astype(jnp.float32))
    y = ssd_scan(xh, dt, a, bm, cm) + xh * d_skip.astype(jnp.float32)[:, None]
    y = y.reshape(bsz, seqlen, SSD_WIDTH)
    return rmsnorm(y * jax.nn.silu(u_z.astype(jnp.float32)), norm_g)


def stick_breaking_attention(q, k, v):
    bsz, seqlen, nh, dh = q.shape
    q = jnp.transpose(q, (0, 2, 1, 3))
    k = jnp.transpose(k, (0, 2, 1, 3))
    v = jnp.transpose(v, (0, 2, 1, 3))
    scale = dh ** -0.5
    outs = []
    for i in range(seqlen // SB_BLOCK):
        start = i * SB_BLOCK
        end = start + SB_BLOCK
        qb = q[:, :, start:end]
        kp = k[:, :, :end]
        vp = v[:, :, :end]
        z = jnp.einsum("bhqd,bhkd->bhqk", qb, kp).astype(jnp.float32) * scale
        strict = jnp.arange(end)[None, :] < jnp.arange(start, end)[:, None]
        log_beta = jax.nn.log_sigmoid(z)
        log_keep = jnp.where(strict, jax.nn.log_sigmoid(-z), 0.0)
        suffix = lax.cumsum(log_keep, axis=3, reverse=True) - log_keep
        w = jnp.where(strict, jnp.exp(log_beta + suffix), 0.0)
        outs.append(jnp.einsum("bhqk,bhkd->bhqd", w.astype(vp.dtype), vp))
    out = jnp.concatenate(outs, axis=2)
    return jnp.transpose(out, (0, 2, 1, 3)).reshape(bsz, seqlen, nh * dh)


def memory_cross_attention(q, mk, mv, qg, kg):
    bsz, seqlen, nh, dh = q.shape
    q = rmsnorm(q, qg)
    mk = rmsnorm(mk, kg)
    s = jnp.einsum("bshd,bmhd->bhsm", q, mk).astype(jnp.float32) * (dh ** -0.5)
    p = jax.nn.softmax(s, axis=-1)
    o = jnp.einsum("bhsm,bmhd->bshd", p.astype(mv.dtype), mv)
    return o.reshape(bsz, seqlen, nh * dh)


def peer_ffn(h, wq, keys, u_tab, v_tab):
    bsz, seqlen, d = h.shape
    t = bsz * seqlen
    hf = h.reshape(t, d)
    q = (hf @ wq).reshape(t, PEER_HEADS, 2, PEER_DKEY // 2)
    scores = jnp.einsum("thcd,hcnd->thcn", q, keys).astype(jnp.float32)
    s_top, i_top = lax.top_k(scores, PEER_TOPK)
    cand = s_top[:, :, 0, :, None] + s_top[:, :, 1, None, :]
    cand_idx = i_top[:, :, 0, :, None] * PEER_NKEYS + i_top[:, :, 1, None, :]
    best, pos = lax.top_k(cand.reshape(t, PEER_HEADS, PEER_TOPK * PEER_TOPK), PEER_TOPK)
    eidx = jnp.take_along_axis(cand_idx.reshape(t, PEER_HEADS, PEER_TOPK * PEER_TOPK), pos, axis=-1)
    gates = jax.nn.softmax(best, axis=-1)

    def block(args):
        xb, ib, gb = args
        act = jax.nn.gelu(jnp.einsum("thkd,td->thk", u_tab[ib], xb).astype(jnp.float32), approximate=False)
        w = (gb * act).astype(xb.dtype)
        return jnp.einsum("thk,thkd->td", w, v_tab[ib])

    nb = t // PEER_BLOCK
    out = lax.map(block, (hf.reshape(nb, PEER_BLOCK, d),
                          eidx.reshape(nb, PEER_BLOCK, PEER_HEADS, PEER_TOPK),
                          gates.reshape(nb, PEER_BLOCK, PEER_HEADS, PEER_TOPK)))
    return out.reshape(bsz, seqlen, d)


def setup_inputs(seed: int = 0) -> dict:
    key = jax.random.key(seed)
    ks = jax.random.split(key, 24)
    f32 = jnp.float32
    L = DEPTH

    def nrm(k, shape, scale):
        return jax.random.normal(k, shape, dtype=f32) * scale

    def gain(k, shape):
        return 1.0 + 0.05 * jax.random.normal(k, shape, dtype=f32)

    dt0 = jnp.exp(jax.random.uniform(ks[5], (L, SSD_HEADS), dtype=f32,
                                     minval=math.log(1e-3), maxval=math.log(1e-1)))
    dt_bias = dt0 + jnp.log(-jnp.expm1(-dt0))
    a_log = jnp.log(jax.random.uniform(ks[6], (L, SSD_HEADS), dtype=f32, minval=1.0, maxval=16.0))
    return {
        "x": nrm(ks[0], (BATCH, SEQ, D_MODEL), 1.0),
        "mem": nrm(ks[1], (BATCH, N_MEM, D_MODEL), 1.0),
        "norm1_g": gain(ks[2], (L, D_MODEL)),
        "w_in": nrm(ks[3], (L, D_MODEL, D_IN), D_MODEL ** -0.5),
        "conv_w": nrm(ks[4], (L, SSD_CONV, SSD_CONV_CH), SSD_CONV ** -0.5),
        "conv_b": nrm(ks[7], (L, SSD_CONV_CH), 0.02),
        "dt_bias": dt_bias,
        "a_log": a_log,
        "d_skip": gain(ks[8], (L, SSD_HEADS)),
        "ssd_norm_g": gain(ks[9], (L, SSD_WIDTH)),
        "sb_out_g": gain(ks[10], (L, SB_WIDTH)),
        "mem_norm_g": gain(ks[11], (L, D_MODEL)),
        "w_mem_kv": nrm(ks[12], (L, D_MODEL, 2 * MEM_WIDTH), D_MODEL ** -0.5),
        "mq_norm_g": gain(ks[13], (L, HEAD_DIM)),
        "mk_norm_g": gain(ks[14], (L, HEAD_DIM)),
        "mem_out_g": gain(ks[15], (L, MEM_WIDTH)),
        "w_out": nrm(ks[16], (L, D_MIX, D_MODEL), D_MIX ** -0.5),
        "norm2_g": gain(ks[17], (L, D_MODEL)),
        "peer_wq": nrm(ks[18], (L, D_MODEL, PEER_HEADS * PEER_DKEY), D_MODEL ** -0.5),
        "peer_keys": nrm(ks[19], (L, PEER_HEADS, 2, PEER_NKEYS, PEER_DKEY // 2), (PEER_DKEY // 2) ** -0.5),
        "peer_u": nrm(ks[20], (L, PEER_EXPERTS, D_MODEL), D_MODEL ** -0.5),
        "peer_v": nrm(ks[21], (L, PEER_EXPERTS, D_MODEL), PEER_HEADS ** -0.5),
    }


def reference(x, mem, norm1_g, w_in, conv_w, conv_b, dt_bias, a_log, d_skip, ssd_norm_g,
              sb_out_g, mem_norm_g, w_mem_kv, mq_norm_g, mk_norm_g, mem_out_g, w_out,
              norm2_g, peer_wq, peer_keys, peer_u, peer_v):
    bsz, seqlen, _ = x.shape
    split_pts = list(np.cumsum(IN_SPLITS)[:-1])
    for l in range(DEPTH):
        h = rmsnorm(x, norm1_g[l])
        proj = h @ w_in[l]
        u_z, u_xbc, u_dt, q_sb, k_sb, v_sb, q_mem = jnp.split(proj, split_pts, axis=-1)

        y_ssd = ssd_mixer(u_z, u_xbc, u_dt, conv_w[l], conv_b[l], dt_bias[l], a_log[l],
                          d_skip[l], ssd_norm_g[l])

        hs = (bsz, seqlen, SB_HEADS, HEAD_DIM)
        y_sb = stick_breaking_attention(q_sb.reshape(hs), k_sb.reshape(hs), v_sb.reshape(hs))
        y_sb = rmsnorm(y_sb, sb_out_g[l])

        mem_kv = rmsnorm(mem, mem_norm_g[l]) @ w_mem_kv[l]
        mk, mv = jnp.split(mem_kv, 2, axis=-1)
        mhs = (bsz, N_MEM, MEM_HEADS, HEAD_DIM)
        y_mem = memory_cross_attention(q_mem.reshape(bsz, seqlen, MEM_HEADS, HEAD_DIM),
                                       mk.reshape(mhs), mv.reshape(mhs), mq_norm_g[l], mk_norm_g[l])
        y_mem = rmsnorm(y_mem, mem_out_g[l])

        y = jnp.concatenate([y_ssd.astype(x.dtype), y_sb.astype(x.dtype), y_mem.astype(x.dtype)], axis=-1) @ w_out[l]
        x = x + y.astype(x.dtype)

        h2 = rmsnorm(x, norm2_g[l])
        x = x + peer_ffn(h2, peer_wq[l], peer_keys[l], peer_u[l], peer_v[l]).astype(x.dtype)
    return x
```

```cpp
#include <hip/hip_runtime.h>
#include <cstdio>
#include <cstdint>
#include <cmath>

namespace {
constexpr int D = 1024, NB = 4, S = 4096, T = NB * S, NL = 2, NMEM = 256;
constexpr int DIN = 2438;
constexpr int O_Z = 0, O_XBC = 384, O_DT = 1024, O_QSB = 1030, O_KSB = 1414, O_VSB = 1798, O_QMEM = 2182;
constexpr int CONV_CH = 640;
constexpr float EPS = 1e-6f;

__device__ __forceinline__ float wave_sum(float v) {
#pragma unroll
    for (int o = 1; o < 64; o <<= 1) v += __shfl_xor(v, o);
    return v;
}
__device__ __forceinline__ float softplus_f(float x) { return fmaxf(x, 0.f) + log1pf(expf(-fabsf(x))); }
__device__ __forceinline__ float silu_f(float x) { return x / (1.f + expf(-x)); }

__global__ __launch_bounds__(256) void rmsnorm_kernel(const float* x, int xs, const float* g, float* out, int os, int rows, int dim) {
    const int row = blockIdx.x * 4 + (threadIdx.x >> 6), lane = threadIdx.x & 63;
    if (row >= rows) return;
    const float* xr = x + (size_t)row * xs;
    float s = 0.f;
    for (int i = lane; i < dim; i += 64) { float v = xr[i]; s += v * v; }
    s = wave_sum(s);
    const float r = rsqrtf(s / (float)dim + EPS);
    float* o = out + (size_t)row * os;
    for (int i = lane; i < dim; i += 64) o[i] = xr[i] * r * g[i];
}

__global__ __launch_bounds__(256) void sgemm_kernel(const float* A, const float* Bm, float* C, const float* R, int M, int N, int K) {
    __shared__ float As[16][65];
    __shared__ float Bs[16][65];
    const int tx = threadIdx.x & 15, ty = threadIdx.x >> 4;
    const int m0 = blockIdx.y * 64, n0 = blockIdx.x * 64;
    float acc[4][4];
#pragma unroll
    for (int i = 0; i < 4; ++i)
#pragma unroll
        for (int j = 0; j < 4; ++j) acc[i][j] = 0.f;
    for (int k0 = 0; k0 < K; k0 += 16) {
        for (int i = threadIdx.x; i < 1024; i += 256) { const int m = i >> 4, k = i & 15; As[k][m] = A[(size_t)(m0 + m) * K + k0 + k]; }
        for (int i = threadIdx.x; i < 1024; i += 256) { const int k = i >> 6, n = i & 63; Bs[k][n] = (n0 + n < N) ? Bm[(size_t)(k0 + k) * N + n0 + n] : 0.f; }
        __syncthreads();
#pragma unroll
        for (int k = 0; k < 16; ++k) {
            float a[4], b[4];
#pragma unroll
            for (int i = 0; i < 4; ++i) { a[i] = As[k][ty * 4 + i]; b[i] = Bs[k][tx * 4 + i]; }
#pragma unroll
            for (int i = 0; i < 4; ++i)
#pragma unroll
                for (int j = 0; j < 4; ++j) acc[i][j] += a[i] * b[j];
        }
        __syncthreads();
    }
#pragma unroll
    for (int i = 0; i < 4; ++i)
#pragma unroll
        for (int j = 0; j < 4; ++j) {
            const int m = m0 + ty * 4 + i, n = n0 + tx * 4 + j;
            if (n < N) { const size_t o = (size_t)m * N + n; C[o] = (R ? R[o] : 0.f) + acc[i][j]; }
        }
}

__global__ __launch_bounds__(256) void conv_kernel(const float* proj, const float* cw, const float* cb, const float* dtb, float* xbc, float* dt) {
    const int t = blockIdx.x, s = t % S;
    for (int c = threadIdx.x; c < CONV_CH; c += 256) {
        float a = cb[c];
#pragma unroll
        for (int k = 0; k < 4; ++k) { const int ss = s - 3 + k; if (ss >= 0) a += cw[k * CONV_CH + c] * proj[(size_t)(t - 3 + k) * DIN + O_XBC + c]; }
        xbc[(size_t)t * CONV_CH + c] = silu_f(a);
    }
    if (threadIdx.x < 6) dt[t * 8 + threadIdx.x] = softplus_f(proj[(size_t)t * DIN + O_DT + threadIdx.x] + dtb[threadIdx.x]);
}

__global__ __launch_bounds__(64) void ssd_scan_kernel(const float* xbc, const float* dt, const float* a_log, const float* d_skip, float* yraw) {
    const int b = blockIdx.x / 6, h = blockIdx.x % 6, g = h / 3, p = threadIdx.x;
    const float a = -expf(a_log[h]), dsk = d_skip[h];
    float hs[64];
#pragma unroll
    for (int n = 0; n < 64; ++n) hs[n] = 0.f;
    for (int s = 0; s < S; ++s) {
        const size_t t = (size_t)b * S + s;
        const float dtv = dt[t * 8 + h], decay = expf(dtv * a);
        const float xv = xbc[t * CONV_CH + h * 64 + p], xd = xv * dtv;
        const float* Bp = xbc + t * CONV_CH + 384 + g * 64;
        const float* Cp = xbc + t * CONV_CH + 512 + g * 64;
        float y = 0.f;
#pragma unroll
        for (int n = 0; n < 64; ++n) { hs[n] = decay * hs[n] + Bp[n] * xd; y += Cp[n] * hs[n]; }
        yraw[t * 384 + h * 64 + p] = y + dsk * xv;
    }
}

__global__ __launch_bounds__(256) void ssd_gate_kernel(const float* yraw, const float* proj, const float* g, float* ycat) {
    const int t = blockIdx.x * 4 + (threadIdx.x >> 6), lane = threadIdx.x & 63;
    float v[6]; float s = 0.f;
#pragma unroll
    for (int j = 0; j < 6; ++j) { const int c = lane + 64 * j; const float z = proj[(size_t)t * DIN + O_Z + c]; v[j] = yraw[(size_t)t * 384 + c] * silu_f(z); s += v[j] * v[j]; }
    s = wave_sum(s);
    const float r = rsqrtf(s / 384.f + EPS);
#pragma unroll
    for (int j = 0; j < 6; ++j) { const int c = lane + 64 * j; ycat[(size_t)t * D + c] = v[j] * r * g[c]; }
}

__global__ __launch_bounds__(64) void sb_kernel(const float* proj, float* sbraw) {
    const int bh = blockIdx.y, b = bh / 6, h = bh % 6;
    const int s_q = blockIdx.x * 64 + threadIdx.x;
    const size_t tq = (size_t)b * S + s_q;
    float q[64], o[64];
#pragma unroll
    for (int d = 0; d < 64; ++d) { q[d] = proj[tq * DIN + O_QSB + h * 64 + d] * 0.125f; o[d] = 0.f; }
    float R = 0.f;
    const int smax = blockIdx.x * 64 + 63;
    for (int s = smax - 1; s >= 0; --s) {
        const float* kp = proj + ((size_t)b * S + s) * DIN + O_KSB + h * 64;
        const float* vp = proj + ((size_t)b * S + s) * DIN + O_VSB + h * 64;
        float z = 0.f;
#pragma unroll
        for (int d = 0; d < 64; ++d) z += q[d] * kp[d];
        if (s < s_q) {
            const float l1p = log1pf(expf(-fabsf(z)));
            const float lb = fminf(z, 0.f) - l1p, lk = fminf(-z, 0.f) - l1p;
            const float w = expf(lb + R);
            R += lk;
#pragma unroll
            for (int d = 0; d < 64; ++d) o[d] += w * vp[d];
        }
    }
#pragma unroll
    for (int d = 0; d < 64; ++d) sbraw[tq * 384 + h * 64 + d] = o[d];
}

__global__ __launch_bounds__(64) void mk_norm_kernel(const float* memkv, const float* kg, float* mkn) {
    const int m = blockIdx.x / 4, h = blockIdx.x % 4, d = threadIdx.x;
    const float v = memkv[(size_t)m * 512 + h * 64 + d];
    const float s = wave_sum(v * v);
    mkn[(size_t)m * 256 + h * 64 + d] = v * rsqrtf(s / 64.f + EPS) * kg[d];
}

__global__ __launch_bounds__(64) void mem_attn_kernel(const float* proj, const float* qg, const float* mkn, const float* memkv, float* memraw) {
    const int h = blockIdx.y, t = blockIdx.x * 64 + threadIdx.x, b = t / S;
    float q[64], o[64]; float ss = 0.f;
#pragma unroll
    for (int d = 0; d < 64; ++d) { q[d] = proj[(size_t)t * DIN + O_QMEM + h * 64 + d]; ss += q[d] * q[d]; o[d] = 0.f; }
    const float r = rsqrtf(ss / 64.f + EPS) * 0.125f;
#pragma unroll
    for (int d = 0; d < 64; ++d) q[d] = q[d] * r * qg[d];
    float mx = -INFINITY, l = 0.f;
    for (int m = 0; m < NMEM; ++m) {
        const float* kp = mkn + ((size_t)b * NMEM + m) * 256 + h * 64;
        const float* vp = memkv + ((size_t)b * NMEM + m) * 512 + 256 + h * 64;
        float sc = 0.f;
#pragma unroll
        for (int d = 0; d < 64; ++d) sc += q[d] * kp[d];
        const float mn = fmaxf(mx, sc), corr = expf(mx - mn), p = expf(sc - mn);
        l = l * corr + p;
#pragma unroll
        for (int d = 0; d < 64; ++d) o[d] = o[d] * corr + p * vp[d];
        mx = mn;
    }
    const float il = 1.f / l;
#pragma unroll
    for (int d = 0; d < 64; ++d) memraw[(size_t)t * 256 + h * 64 + d] = o[d] * il;
}

__global__ __launch_bounds__(256) void peer_scores_kernel(const float* q, const float* keys, float* scores) {
    const size_t i = (size_t)blockIdx.x * 256 + threadIdx.x;
    const int n = i & 127, hc = (i >> 7) & 15; const size_t t = i >> 11;
    const float* qp = q + t * D + hc * 64;
    const float* kp = keys + ((size_t)hc * 128 + n) * 64;
    float s = 0.f;
#pragma unroll
    for (int d = 0; d < 64; ++d) s += qp[d] * kp[d];
    scores[i] = s;
}

__global__ __launch_bounds__(256) void peer_topk1_kernel(const float* scores, float* s_top, int* i_top) {
    const size_t r = (size_t)blockIdx.x * 256 + threadIdx.x;
    const float* sp = scores + r * 128;
    float pv = INFINITY; int pi = -1;
    for (int k = 0; k < 16; ++k) {
        float bv = -INFINITY; int bi = 1 << 30;
        for (int n = 0; n < 128; ++n) {
            const float v = sp[n];
            const bool elig = (v < pv) || (v == pv && n > pi);
            if (elig && (v > bv || (v == bv && n < bi))) { bv = v; bi = n; }
        }
        s_top[r * 16 + k] = bv; i_top[r * 16 + k] = bi; pv = bv; pi = bi;
    }
}

__global__ __launch_bounds__(256) void peer_topk2_kernel(const float* s_top, const int* i_top, int* eidx, float* gate) {
    const size_t r = (size_t)blockIdx.x * 256 + threadIdx.x;
    const float* s0 = s_top + r * 32; const float* s1 = s0 + 16;
    const int* i0 = i_top + r * 32; const int* i1 = i0 + 16;
    float pv = INFINITY; int pi = -1; float best0 = 0.f, den = 0.f;
    for (int k = 0; k < 16; ++k) {
        float bv = -INFINITY; int bi = 1 << 30;
        for (int c = 0; c < 256; ++c) {
            const float v = s0[c >> 4] + s1[c & 15];
            const bool elig = (v < pv) || (v == pv && c > pi);
            if (elig && (v > bv || (v == bv && c < bi))) { bv = v; bi = c; }
        }
        if (k == 0) best0 = bv;
        const float e = expf(bv - best0);
        den += e;
        gate[r * 16 + k] = e;
        eidx[r * 16 + k] = i0[bi >> 4] * 128 + i1[bi & 15];
        pv = bv; pi = bi;
    }
    const float inv = 1.f / den;
    for (int k = 0; k < 16; ++k) gate[r * 16 + k] *= inv;
}

__global__ __launch_bounds__(256) void peer_gather_kernel(const float* h2, const int* eidx, const float* gate, const float* ut, const float* vt, float* x) {
    const int t = blockIdx.x * 4 + (threadIdx.x >> 6), lane = threadIdx.x & 63;
    float4 hv[4], acc[4];
#pragma unroll
    for (int j = 0; j < 4; ++j) { hv[j] = *(const float4*)(h2 + (size_t)t * D + j * 256 + lane * 4); acc[j] = make_float4(0.f, 0.f, 0.f, 0.f); }
    for (int k = 0; k < 128; ++k) {
        const int e = eidx[(size_t)t * 128 + k]; const float gt = gate[(size_t)t * 128 + k];
        const float* ur = ut + (size_t)e * D; const float* vr = vt + (size_t)e * D;
        float s = 0.f;
#pragma unroll
        for (int j = 0; j < 4; ++j) { const float4 u = *(const float4*)(ur + j * 256 + lane * 4); s += u.x * hv[j].x + u.y * hv[j].y + u.z * hv[j].z + u.w * hv[j].w; }
        s = wave_sum(s);
        const float w = gt * 0.5f * s * (1.f + erff(s * 0.70710678118654752f));
#pragma unroll
        for (int j = 0; j < 4; ++j) { const float4 v = *(const float4*)(vr + j * 256 + lane * 4); acc[j].x += w * v.x; acc[j].y += w * v.y; acc[j].z += w * v.z; acc[j].w += w * v.w; }
    }
#pragma unroll
    for (int j = 0; j < 4; ++j) { float4* xp = (float4*)(x + (size_t)t * D + j * 256 + lane * 4); float4 xv = *xp; xv.x += acc[j].x; xv.y += acc[j].y; xv.z += acc[j].z; xv.w += acc[j].w; *xp = xv; }
}
}

extern "C" void kernel_launch(void* const* d_in, const int* in_sizes, int n_in, void* d_out, int out_size, void* d_ws, size_t ws_size, hipStream_t stream) {
    const float* x_in = (const float*)d_in[0];      const float* mem = (const float*)d_in[1];
    const float* norm1_g = (const float*)d_in[2];   const float* w_in = (const float*)d_in[3];
    const float* conv_w = (const float*)d_in[4];    const float* conv_b = (const float*)d_in[5];
    const float* dt_bias = (const float*)d_in[6];   const float* a_log = (const float*)d_in[7];
    const float* d_skip = (const float*)d_in[8];    const float* ssd_norm_g = (const float*)d_in[9];
    const float* sb_out_g = (const float*)d_in[10]; const float* mem_norm_g = (const float*)d_in[11];
    const float* w_mem_kv = (const float*)d_in[12]; const float* mq_norm_g = (const float*)d_in[13];
    const float* mk_norm_g = (const float*)d_in[14]; const float* mem_out_g = (const float*)d_in[15];
    const float* w_out = (const float*)d_in[16];    const float* norm2_g = (const float*)d_in[17];
    const float* peer_wq = (const float*)d_in[18];  const float* peer_keys = (const float*)d_in[19];
    const float* peer_u = (const float*)d_in[20];   const float* peer_v = (const float*)d_in[21];
    float* xo = (float*)d_out;

    size_t off = 0;
    auto take = [&](size_t n) { float* p = (float*)d_ws + off; off += (n + 63) & ~(size_t)63; return p; };
    float* hbuf = take((size_t)T * D);
    float* proj = take((size_t)T * DIN);
    float* scores = take((size_t)T * 2048);
    float* ycat = take((size_t)T * D);
    float* dt = take((size_t)T * 8);
    float* memn = take((size_t)NB * NMEM * D);
    float* memkv = take((size_t)NB * NMEM * 512);
    float* mkn = take((size_t)NB * NMEM * 256);
    float* s_top = take((size_t)T * 256);
    int* i_top = (int*)take((size_t)T * 256);
    int* eidx = (int*)take((size_t)T * 128);
    float* gate = take((size_t)T * 128);
    if (off * 4 > ws_size) { fprintf(stderr, "kernel_launch: workspace too small: need %zu have %zu\n", off * 4, ws_size); return; }
    float* xbc = scores;
    float* yraw = xbc + (size_t)T * CONV_CH;
    float* sbraw = yraw + (size_t)T * 384;
    float* memraw = sbraw + (size_t)T * 384;
    float* qbuf = proj;

    for (int l = 0; l < NL; ++l) {
        const float* xcur = (l == 0) ? x_in : xo;
        rmsnorm_kernel<<<T / 4, 256, 0, stream>>>(xcur, D, norm1_g + l * D, hbuf, D, T, D);
        sgemm_kernel<<<dim3((DIN + 63) / 64, T / 64), 256, 0, stream>>>(hbuf, w_in + (size_t)l * D * DIN, proj, nullptr, T, DIN, D);
        conv_kernel<<<T, 256, 0, stream>>>(proj, conv_w + l * 4 * CONV_CH, conv_b + l * CONV_CH, dt_bias + l * 6, xbc, dt);
        ssd_scan_kernel<<<NB * 6, 64, 0, stream>>>(xbc, dt, a_log + l * 6, d_skip + l * 6, yraw);
        ssd_gate_kernel<<<T / 4, 256, 0, stream>>>(yraw, proj, ssd_norm_g + l * 384, ycat);
        sb_kernel<<<dim3(S / 64, NB * 6), 64, 0, stream>>>(proj, sbraw);
        rmsnorm_kernel<<<T / 4, 256, 0, stream>>>(sbraw, 384, sb_out_g + l * 384, ycat + 384, D, T, 384);
        rmsnorm_kernel<<<NB * NMEM / 4, 256, 0, stream>>>(mem, D, mem_norm_g + l * D, memn, D, NB * NMEM, D);
        sgemm_kernel<<<dim3(512 / 64, NB * NMEM / 64), 256, 0, stream>>>(memn, w_mem_kv + (size_t)l * D * 512, memkv, nullptr, NB * NMEM, 512, D);
        mk_norm_kernel<<<NB * NMEM * 4, 64, 0, stream>>>(memkv, mk_norm_g + l * 64, mkn);
        mem_attn_kernel<<<dim3(T / 64, 4), 64, 0, stream>>>(proj, mq_norm_g + l * 64, mkn, memkv, memraw);
        rmsnorm_kernel<<<T / 4, 256, 0, stream>>>(memraw, 256, mem_out_g + l * 256, ycat + 768, D, T, 256);
        sgemm_kernel<<<dim3(D / 64, T / 64), 256, 0, stream>>>(ycat, w_out + (size_t)l * D * D, xo, xcur, T, D, D);
        rmsnorm_kernel<<<T / 4, 256, 0, stream>>>(xo, D, norm2_g + l * D, hbuf, D, T, D);
        sgemm_kernel<<<dim3(D / 64, T / 64), 256, 0, stream>>>(hbuf, peer_wq + (size_t)l * D * D, qbuf, nullptr, T, D, D);
        peer_scores_kernel<<<T * 2048 / 256, 256, 0, stream>>>(qbuf, peer_keys + (size_t)l * 16 * 128 * 64, scores);
        peer_topk1_kernel<<<T * 16 / 256, 256, 0, stream>>>(scores, s_top, i_top);
        peer_topk2_kernel<<<T * 8 / 256, 256, 0, stream>>>(s_top, i_top, eidx, gate);
        peer_gather_kernel<<<T / 4, 256, 0, stream>>>(hbuf, eidx, gate, peer_u + (size_t)l * 16384 * D, peer_v + (size_t)l * 16384 * D, xo);
    }
}
```

```cpp
#include <hip/hip_runtime.h>
#include <cstdio>
#include <cstdint>
#include <cmath>
namespace pg8 {
#define PG8_LAS __attribute__((address_space(3)))
typedef unsigned short bf16_t;
typedef short bf16x8 __attribute__((ext_vector_type(8)));
typedef float f32x4 __attribute__((ext_vector_type(4)));
typedef unsigned u32x4 __attribute__((ext_vector_type(4)));
constexpr int BM = 256, BK = 64, HALF = 128, HTB = HALF * BK * 2  , STAGE_BYTES = 8 * HTB, NXCD = 8, WGM = 8;

__host__ __device__ __forceinline__ int lds_byte(int r, int c) { const int st = (r >> 4) * 2 + (c >> 5), rr = r & 15, cc = c & 31, ob = rr * 64 + cc * 2; return st * 1024 + (ob ^ (((ob >> 9) & 1) << 5)); }
__host__ __device__ __forceinline__ void stage_rc(int b, int& R, int& C) { const int st = b / 1024, sb = b % 1024, swz = sb ^ (((sb >> 9) & 1) << 5); R = (st >> 1) * 16 + swz / 64; C = (st & 1) * 32 + (swz % 64) / 2; }
__host__ __device__ __forceinline__ int perm32(int rho) { const int n = rho >> 4, i = rho & 15; return 8 * (i >> 2) + 4 * n + (i & 3); }

struct Unit { int pm, pn; };
struct Gemm { const bf16_t* A; const bf16_t* Bt; int M, N, K; };

struct StaticOrder {
    int nM, nN, nwg, G, c;
    __host__ __device__ void init(int M, int N, int G_, int c_) { nM = M / BM; nN = N / BM; nwg = nM * nN; G = G_; c = c_; }
    __host__ __device__ bool next(int i, Unit& u) const {
        const long L = (long)i * G + c; if (L >= nwg) return false;
        int wgid = (int)L; { const int q = nwg / NXCD, r = nwg % NXCD, xcd = wgid % NXCD, off = wgid / NXCD; wgid = (xcd < r ? xcd * (q + 1) : r * (q + 1) + (xcd - r) * q) + off; }
        const int nig = WGM * nN, gid = wgid / nig, fm = gid * WGM, gsz = (nM - fm) < WGM ? (nM - fm) : WGM;
        u.pm = fm + ((wgid % nig) % gsz); u.pn = (wgid % nig) / gsz; return true;
    }
    __device__ __forceinline__ void a_ready(const Unit&) const {}
    __device__ __forceinline__ void done(const Unit&) const {}
};

__device__ __forceinline__ unsigned cvt_pk_bf16(float lo, float hi) { unsigned r; asm volatile("v_cvt_pk_bf16_f32 %0, %1, %2" : "=v"(r) : "v"(lo), "v"(hi)); return r; }
template <class Epi, class Sched, bool ALIGN_EPI = false, bool SP2 = false>
__device__ __forceinline__ void gemm_phase(PG8_LAS unsigned char* lds, const Gemm g, const Sched& S, const Epi& E) {
    int tid_ = threadIdx.x; asm volatile("" : "+v"(tid_));
    const int tid = tid_, wid = __builtin_amdgcn_readfirstlane(tid >> 6), lane = tid & 63, wr = wid >> 2, wc = wid & 3, fr = lane & 15, fq = lane >> 4;
    const int K = g.K, nt = K / BK;
    unsigned voffA[2], voffB[2];
#pragma unroll
    for (int i = 0; i < 2; ++i) { int R, C; stage_rc(tid * 16 + i * 8192, R, C); const int Rb = Epi::PERM ? ((R & ~31) + perm32(R & 31)) : R;
        voffA[i] = (unsigned)(R * K + C) * 2u; voffB[i] = (unsigned)(Rb * K + C) * 2u; }
    const size_t kstep = (size_t)(BK * 2);
    const size_t hstep = (size_t)HALF * K * 2;
    const size_t tstep = 2 * hstep;
    const unsigned ldsw = (unsigned)wid * 1024u;
    const int aoff = lds_byte(wr * 64 + fr, fq * 8), boff = lds_byte(wc * 32 + fr, fq * 8);
#define PG8_SA(b, h) (((b) * 2 + (h)) * HTB)
#define PG8_SB(b, h) ((4 + (b) * 2 + (h)) * HTB)
#define PG8_STAGE(bufoff, gbase, voff) do { _Pragma("unroll") for (int _i = 0; _i < 2; ++_i) \
        __builtin_amdgcn_global_load_lds((const unsigned*)((const char*)(gbase) + (voff)[_i]), (PG8_LAS unsigned*)(lds + (bufoff) + ldsw + _i * 8192), 16, 0, 0); } while (0)
#define PG8_LDA(dst, b, h) do { _Pragma("unroll") for (int m = 0; m < 4; ++m) _Pragma("unroll") for (int k = 0; k < 2; ++k) dst[m][k] = *(const PG8_LAS bf16x8*)(lds + PG8_SA(b, h) + aoff + m * 2048 + k * 1024); } while (0)
#define PG8_LDB(dst, b, h) do { _Pragma("unroll") for (int n = 0; n < 2; ++n) _Pragma("unroll") for (int k = 0; k < 2; ++k) dst[n][k] = *(const PG8_LAS bf16x8*)(lds + PG8_SB(b, h) + boff + n * 2048 + k * 1024); } while (0)
#define PG8_MMA(ai, bj, At, Bt) do { __builtin_amdgcn_s_setprio(1); _Pragma("unroll") for (int m = 0; m < 4; ++m) _Pragma("unroll") for (int n = 0; n < 2; ++n) _Pragma("unroll") for (int k = 0; k < 2; ++k) \
        acc[ai][bj][m][n] = __builtin_amdgcn_mfma_f32_16x16x32_bf16(Bt[n][k], At[m][k], acc[ai][bj][m][n], 0, 0, 0); __builtin_amdgcn_s_setprio(0); } while (0)
#define PG8_WAIT_V(n) asm volatile("s_waitcnt vmcnt(" #n ")" ::: "memory")
#define PG8_WAIT_L(n) asm volatile("s_waitcnt lgkmcnt(" #n ")" ::: "memory")
#define PG8_BAR __builtin_amdgcn_s_barrier()
#define PG8_SCHED __builtin_amdgcn_sched_barrier(0)
    Unit cur, nxt; int ui = 0;
    if (!S.next(0, cur)) return;
    f32x4 acc[2][2][4][2];
#pragma unroll
    for (int a = 0; a < 2; ++a)
#pragma unroll
        for (int b = 0; b < 2; ++b)
#pragma unroll
            for (int m = 0; m < 4; ++m)
#pragma unroll
                for (int n = 0; n < 2; ++n) acc[a][b][m][n] = (f32x4){0.f, 0.f, 0.f, 0.f};
    bf16x8 At[4][2], B0[2][2], B1[2][2];
    const char* cA = (const char*)g.A + (size_t)cur.pm * tstep; const char* cB = (const char*)g.Bt + (size_t)cur.pn * tstep;
    S.a_ready(cur);
    if constexpr (SP2) {
        PG8_STAGE(PG8_SB(0, 0), cB, voffB); PG8_STAGE(PG8_SB(0, 1), cB + hstep, voffB); PG8_STAGE(PG8_SA(0, 0), cA, voffA); PG8_STAGE(PG8_SA(0, 1), cA + hstep, voffA);
        if (wr == 1) PG8_BAR;
        PG8_WAIT_V(2); PG8_BAR;
        PG8_STAGE(PG8_SB(1, 0), cB + kstep, voffB); PG8_STAGE(PG8_SA(1, 0), cA + kstep, voffA); PG8_STAGE(PG8_SB(1, 1), cB + hstep + kstep, voffB);
        PG8_WAIT_V(6); PG8_BAR;
    } else {
        PG8_STAGE(PG8_SB(0, 0), cB, voffB); PG8_STAGE(PG8_SA(0, 0), cA, voffA); PG8_STAGE(PG8_SB(0, 1), cB + hstep, voffB); PG8_STAGE(PG8_SA(0, 1), cA + hstep, voffA);
        if (wr == 1) PG8_BAR;
        PG8_WAIT_V(4); PG8_BAR;
        PG8_STAGE(PG8_SB(1, 0), cB + kstep, voffB); PG8_STAGE(PG8_SA(1, 0), cA + kstep, voffA); PG8_STAGE(PG8_SB(1, 1), cB + hstep + kstep, voffB);
        PG8_WAIT_V(6); PG8_BAR;
    }
    for (;;) {
        const bool has_next = S.next(ui + 1, nxt);
        const char* nA = has_next ? (const char*)g.A + (size_t)nxt.pm * tstep : cA; const char* nB = has_next ? (const char*)g.Bt + (size_t)nxt.pn * tstep : cB;
        for (int t = 0; t < nt; t += 2) {
            const bool last = (t == nt - 2);
            const char* a1 = cA + (size_t)(t + 1) * kstep;
            const char* a2 = last ? nA : cA + (size_t)(t + 2) * kstep; const char* b2 = last ? nB : cB + (size_t)(t + 2) * kstep;
            const char* a3 = a2 + kstep; const char* b3 = b2 + kstep;
            if (last && has_next) S.a_ready(nxt);
            if constexpr (Epi::KHOOK) E.khook(acc, cur, t, wr, fr);
            if constexpr (SP2) {
            PG8_LDB(B0, 0, 0); PG8_LDB(B1, 0, 1); PG8_SCHED; PG8_LDA(At, 0, 0); PG8_STAGE(PG8_SA(1, 1), a1 + hstep, voffA);
            PG8_WAIT_V(8); PG8_WAIT_L(0); PG8_BAR; PG8_MMA(0, 0, At, B0); PG8_MMA(0, 1, At, B1); PG8_BAR; PG8_SCHED;
            PG8_LDA(At, 0, 1); PG8_STAGE(PG8_SB(0, 0), b2, voffB); PG8_STAGE(PG8_SB(0, 1), b2 + hstep, voffB); PG8_STAGE(PG8_SA(0, 0), a2, voffA);
            PG8_WAIT_V(8); PG8_WAIT_L(0); PG8_BAR; PG8_MMA(1, 0, At, B0); PG8_MMA(1, 1, At, B1); PG8_BAR; PG8_SCHED;
            PG8_LDB(B0, 1, 0); PG8_LDB(B1, 1, 1); PG8_SCHED; PG8_LDA(At, 1, 0); PG8_STAGE(PG8_SA(0, 1), a2 + hstep, voffA);
            PG8_WAIT_V(8); PG8_WAIT_L(0); PG8_BAR; PG8_MMA(0, 0, At, B0); PG8_MMA(0, 1, At, B1); PG8_BAR; PG8_SCHED;
            PG8_LDA(At, 1, 1); PG8_STAGE(PG8_SB(1, 0), b3, voffB); PG8_STAGE(PG8_SB(1, 1), b3 + hstep, voffB); PG8_STAGE(PG8_SA(1, 0), a3, voffA);
            PG8_WAIT_V(8); PG8_WAIT_L(0); PG8_BAR; PG8_MMA(1, 0, At, B0); PG8_MMA(1, 1, At, B1); PG8_BAR; PG8_SCHED;
            } else {
            PG8_LDB(B0, 0, 0); PG8_SCHED; PG8_LDA(At, 0, 0); PG8_STAGE(PG8_SA(1, 1), a1 + hstep, voffA);
            PG8_WAIT_L(8); PG8_BAR; PG8_WAIT_L(0); PG8_MMA(0, 0, At, B0); PG8_BAR; PG8_SCHED;
            PG8_LDB(B1, 0, 1); PG8_STAGE(PG8_SB(0, 0), b2, voffB);
            PG8_BAR; PG8_WAIT_L(0); PG8_MMA(0, 1, At, B1); PG8_BAR;
            PG8_LDA(At, 0, 1); PG8_STAGE(PG8_SA(0, 0), a2, voffA);
            PG8_BAR; PG8_WAIT_L(0); PG8_MMA(1, 0, At, B0); PG8_BAR; PG8_SCHED;
            PG8_STAGE(PG8_SB(0, 1), b2 + hstep, voffB);
            PG8_WAIT_V(6); PG8_BAR; PG8_MMA(1, 1, At, B1); PG8_BAR;
            PG8_LDB(B0, 1, 0); PG8_SCHED; PG8_LDA(At, 1, 0); PG8_STAGE(PG8_SA(0, 1), a2 + hstep, voffA);
            PG8_WAIT_L(8); PG8_BAR; PG8_WAIT_L(0); PG8_MMA(0, 0, At, B0); PG8_BAR; PG8_SCHED;
            PG8_LDB(B1, 1, 1); PG8_STAGE(PG8_SB(1, 0), b3, voffB);
            PG8_BAR; PG8_WAIT_L(0); PG8_MMA(0, 1, At, B1); PG8_BAR;
            PG8_LDA(At, 1, 1); PG8_STAGE(PG8_SA(1, 0), a3, voffA);
            PG8_BAR; PG8_WAIT_L(0); PG8_MMA(1, 0, At, B0); PG8_BAR; PG8_SCHED;
            PG8_STAGE(PG8_SB(1, 1), b3 + hstep, voffB);
            PG8_WAIT_V(6); PG8_BAR; PG8_MMA(1, 1, At, B1); PG8_BAR;
            }
        }
        if constexpr (ALIGN_EPI) { if (wr == 0) PG8_BAR; }
        if constexpr (!Epi::AFTER_DRAIN) { E(acc, cur, wr, wc, fr, fq); S.done(cur); }
        if (!has_next) break;
#pragma unroll
        for (int a = 0; a < 2; ++a)
#pragma unroll
            for (int b = 0; b < 2; ++b)
#pragma unroll
                for (int m = 0; m < 4; ++m)
#pragma unroll
                    for (int n = 0; n < 2; ++n) acc[a][b][m][n] = (f32x4){0.f, 0.f, 0.f, 0.f};
        cur = nxt; cA = nA; cB = nB; ++ui;
        if constexpr (ALIGN_EPI) { if (wr == 1) PG8_BAR; }
    }
    PG8_WAIT_V(0);
    if constexpr (!ALIGN_EPI) { if (wr == 0) PG8_BAR; }
    PG8_BAR;
    if constexpr (Epi::AFTER_DRAIN) { E.fused(acc, cur, wr, wc, fr, fq, lds, wid, lane); S.done(cur); }
#undef PG8_SA
#undef PG8_SB
#undef PG8_STAGE
#undef PG8_LDA
#undef PG8_LDB
#undef PG8_MMA
#undef PG8_WAIT_V
#undef PG8_WAIT_L
#undef PG8_BAR
#undef PG8_SCHED
}
}
#define GAS __attribute__((address_space(1)))
#define LAS __attribute__((address_space(3)))
typedef unsigned short bf16;
typedef unsigned v4u __attribute__((ext_vector_type(4)));
typedef float f32x4 __attribute__((ext_vector_type(4)));
typedef short bf16x8 __attribute__((ext_vector_type(8)));
typedef GAS unsigned gu32;
typedef GAS unsigned long long gu64;
#define RLX_AGENT __ATOMIC_RELAXED, __HIP_MEMORY_SCOPE_AGENT
#define LDS_WAIT() asm volatile("s_waitcnt lgkmcnt(0)" ::: "memory")
#define VM_WAIT() asm volatile("s_waitcnt vmcnt(0)" ::: "memory")
__device__ __forceinline__ unsigned long long rt() { return __builtin_amdgcn_s_memrealtime(); }
__device__ __forceinline__ unsigned f2bf(float f) { unsigned u = __builtin_bit_cast(unsigned, f); return (u + 0x7fffu + ((u >> 16) & 1u)) >> 16; }
__device__ __forceinline__ unsigned pk2(float lo, float hi) { return f2bf(lo) | (f2bf(hi) << 16); }

#define XB_TMO      128
#define XB_XCNT(j)  (256  + 64 * (j))
#define XB_XSUB(j)  (1280 + 64 * (j))
#define XB_XGEN(j)  (2304 + 64 * (j))
#define XB_TOP      3328
#define XB_TOPGEN   3392
#define XCD_BAR_WORDS 3456
#define XB_SPIN_CAP (1u << 18)

__device__ __forceinline__ unsigned xb_ld(unsigned* p)              { return __hip_atomic_load(p, __ATOMIC_RELAXED, __HIP_MEMORY_SCOPE_AGENT); }
__device__ __forceinline__ unsigned xb_add(unsigned* p, unsigned v) { return __hip_atomic_fetch_add(p, v, __ATOMIC_RELAXED, __HIP_MEMORY_SCOPE_AGENT); }
__device__ __forceinline__ unsigned xb_xcc_id() { return (unsigned)__builtin_amdgcn_s_getreg((3 << 11) | 20) & 0xFu; }
#define XB_SPIN(cond, bar) do { unsigned _sp = 0; while (cond) { __builtin_amdgcn_s_sleep(1); \
    if ((++_sp & 255u) == 0u) { if (xb_ld(&(bar)[XB_TMO])) break; if (_sp > XB_SPIN_CAP) { atomicAdd(&(bar)[XB_TMO], 1u); break; } } } } while (0)

struct XcdBarrier {
    unsigned* bar; unsigned x;
    volatile LAS unsigned* st;
};

__device__ __forceinline__ XcdBarrier xcd_barrier_post(unsigned* bar, volatile LAS unsigned* st) {
    XcdBarrier b; b.bar = bar; b.x = xb_xcc_id(); b.st = st;
    if (threadIdx.x == 0) (void)xb_add(&bar[XB_XCNT(b.x)], 1u);
    return b;
}
__device__ __forceinline__ void xcd_barrier_complete(unsigned* bar, unsigned x, unsigned& nloc, unsigned& nx) {
    const unsigned G = gridDim.x * gridDim.y * gridDim.z;
    unsigned sum, cnt, mine, sp = 0u;
    for (;;) {
        sum = 0u; cnt = 0u; mine = 0u;
#pragma unroll
        for (unsigned j = 0; j < 16; ++j) { const unsigned c = xb_ld(&bar[XB_XCNT(j)]); sum += c; cnt += (c > 0u) ? 1u : 0u; mine = (j == x) ? c : mine; }
        if (sum == G) break;
        __builtin_amdgcn_s_sleep(1);
        if ((++sp & 255u) == 0u) { if (xb_ld(&bar[XB_TMO])) break; if (sp > XB_SPIN_CAP) { atomicAdd(&bar[XB_TMO], 1u); break; } }
    }
    nloc = mine > 0u ? mine : 1u; nx = cnt > 0u ? cnt : 1u;
}

__device__ __forceinline__ void xcd_barrier(const XcdBarrier& b) {
    asm volatile("s_waitcnt vmcnt(0)" ::: "memory");
    __syncthreads();
    if (threadIdx.x == 0) {
        unsigned* bar = b.bar;
        __builtin_amdgcn_s_waitcnt(0);
        unsigned nloc = b.st[0], nx = b.st[1];
        if (nloc == 0u) { xcd_barrier_complete(bar, b.x, nloc, nx); b.st[0] = nloc; b.st[1] = nx; }
        const unsigned old = xb_add(&bar[XB_XSUB(b.x)], 1u);
        const unsigned gen = old / nloc;
        if (old + 1u == (gen + 1u) * nloc) {
            __builtin_amdgcn_fence(__ATOMIC_RELEASE, "agent");
            asm volatile("s_waitcnt vmcnt(0)" ::: "memory");
            const unsigned og = xb_add(&bar[XB_TOP], 1u);
            const unsigned tg = og / nx;
            if (og + 1u == (tg + 1u) * nx) xb_add(&bar[XB_TOPGEN], 1u);
            else XB_SPIN(xb_ld(&bar[XB_TOPGEN]) == tg, bar);
            __builtin_amdgcn_fence(__ATOMIC_ACQUIRE, "agent");
            xb_add(&bar[XB_XGEN(b.x)], 1u);
            asm volatile("s_waitcnt vmcnt(0)" ::: "memory");
        } else {
            XB_SPIN(xb_ld(&bar[XB_XGEN(b.x)]) == gen, bar);
            __builtin_amdgcn_fence(__ATOMIC_ACQUIRE, "agent");
            asm volatile("s_waitcnt vmcnt(0)" ::: "memory");
        }
    }
    __syncthreads();
}

constexpr int NWAVES = 8;
constexpr int D = 1024, NB = 4, S = 4096, T = NB * S, NL = 2, NMEM = 256, MROWS = NB * NMEM;
constexpr int DIN = 2438, NPROJ = 2560;
constexpr int PC_Z = 0, PC_XBC = 384, PC_QSB = 1024, PC_KSB = 1408, PC_VSB = 1792, PC_QMEM = 2176, PC_DT = 2432;
constexpr int CONV_CH = 640;
constexpr float EPS = 1e-6f;

constexpr int RING_BYTES = 131072;
constexpr int LDSCTL_OFF = RING_BYTES, MISC_OFF = LDSCTL_OFF + 320;
constexpr int LDS_BYTES = 147456;
constexpr int GTAB_OFF = RING_BYTES + 1024;

constexpr size_t MiB = 1u << 20;
constexpr size_t WS_CTL = 0, CTL_ZERO_BYTES = 1 * MiB;
constexpr size_t WS_WIN = 2 * MiB;
constexpr size_t WS_WMEM = 12 * MiB;
constexpr size_t WS_WOUT = 14 * MiB;
constexpr size_t WS_WSC = 18 * MiB;
constexpr size_t WS_MEMB = 26 * MiB;
constexpr size_t WS_RSM = 28 * MiB;
constexpr size_t WS_RS1 = WS_RSM + 64 * 1024;
constexpr size_t WS_DTF = WS_RS1 + 64 * 1024;
constexpr size_t WS_XSSQ = 29 * MiB;
constexpr size_t WS_YSSQ = 30 * MiB;
constexpr size_t WS_MEMKV = 31 * MiB;
constexpr size_t WS_XB = 34 * MiB;
constexpr size_t WS_YCAT = 66 * MiB;
constexpr size_t WS_PROJ = 98 * MiB;
constexpr size_t WS_SCORES = 178 * MiB;
constexpr size_t WS_XBC = WS_SCORES;
constexpr size_t WS_YRAW = WS_SCORES + 40 * MiB;
constexpr size_t WS_EIDX = 306 * MiB;
constexpr size_t WS_GATE = 314 * MiB;
constexpr size_t WS_STOP = 322 * MiB;
constexpr size_t WS_ITOP = 338 * MiB;
constexpr size_t WS_END = 354 * MiB;
constexpr int CW_BAR = 4096;

__device__ __forceinline__ float bf2f(bf16 v) { return __uint_as_float((unsigned)v << 16); }
__device__ __forceinline__ unsigned pkbf(float lo, float hi) { return pg8::cvt_pk_bf16(lo, hi); }
__device__ __forceinline__ float wave_sum(float v) {
#pragma unroll
    for (int o = 1; o < 64; o <<= 1) v += __shfl_xor(v, o);
    return v;
}
__device__ __forceinline__ float softplus_f(float x) { return fmaxf(x, 0.f) + log1pf(expf(-fabsf(x))); }
__device__ __forceinline__ float silu_f(float x) { return x / (1.f + expf(-x)); }

namespace pg8 {
struct EpiInProj {
    static constexpr bool PERM = true, AFTER_DRAIN = false, KHOOK = false;
    bf16_t* O; int ldc; const float* rs; float* dtf; const float* dtb;
    __device__ __forceinline__ void operator()(const f32x4 (&acc)[2][2][4][2], const Unit& u, int wr, int wc, int fr, int fq) const {
        const int row0 = u.pm * BM + wr * 64 + fr, col0 = u.pn * BM + wc * 32 + 8 * fq;
        const bool dtl = dtf && (u.pn * BM == PC_DT - 128) && wc == 0 && fq == 0;
#pragma unroll
        for (int ai = 0; ai < 2; ++ai)
#pragma unroll
            for (int m = 0; m < 4; ++m) {
                const int row = row0 + ai * HALF + m * 16; const float s = rs[row];
#pragma unroll
                for (int bj = 0; bj < 2; ++bj) {
                    const f32x4 v0 = acc[ai][bj][m][0] * s, v1 = acc[ai][bj][m][1] * s;
                    u32x4 w; w.x = cvt_pk_bf16(v0[0], v0[1]); w.y = cvt_pk_bf16(v0[2], v0[3]); w.z = cvt_pk_bf16(v1[0], v1[1]); w.w = cvt_pk_bf16(v1[2], v1[3]);
                    *(u32x4*)(O + (size_t)row * ldc + col0 + bj * HALF) = w;
                    if (bj == 1 && dtl) {
                        f32x4 d0; d0[0] = softplus_f(v0[0] + dtb[0]); d0[1] = softplus_f(v0[1] + dtb[1]); d0[2] = softplus_f(v0[2] + dtb[2]); d0[3] = softplus_f(v0[3] + dtb[3]);
                        f32x4 d1; d1[0] = softplus_f(v1[0] + dtb[4]); d1[1] = softplus_f(v1[1] + dtb[5]); d1[2] = 0.f; d1[3] = 0.f;
                        *(f32x4*)(dtf + (size_t)row * 8) = d0; *(f32x4*)(dtf + (size_t)row * 8 + 4) = d1;
                    }
                }
            }
    }
};
__device__ __forceinline__ void group_rstd(const float* yssq, int row, float& r_ssd, float& r_sb, float& r_mem) {
    const f32x4 a = *(const f32x4*)(yssq + (size_t)row * 16), b = *(const f32x4*)(yssq + (size_t)row * 16 + 4), c = *(const f32x4*)(yssq + (size_t)row * 16 + 8), d = *(const f32x4*)(yssq + (size_t)row * 16 + 12);
    const float s0 = (a[0] + a[1]) + (a[2] + a[3]) + (b[0] + b[1]), s1 = (b[2] + b[3]) + (c[0] + c[1]) + (c[2] + c[3]), s2 = (d[0] + d[1]) + (d[2] + d[3]);
    r_ssd = rsqrtf(s0 * (1.f / 384.f) + EPS); r_sb = rsqrtf(s1 * (1.f / 384.f) + EPS); r_mem = rsqrtf(s2 * (1.f / 256.f) + EPS);
}
struct EpiOut {
    static constexpr bool PERM = false, AFTER_DRAIN = false, KHOOK = true;
    const float* base; float* out; bf16_t* xb; float* xssq; const PG8_LAS float* gtab;
    __device__ __forceinline__ void khook(f32x4 (&acc)[2][2][4][2], const Unit& u, int t, int wr, int fr) const {
        if (t != 6 && t != 12) return;
#pragma unroll
        for (int ai = 0; ai < 2; ++ai)
#pragma unroll
            for (int m = 0; m < 4; ++m) {
                const float f = gtab[(t == 6 ? 0 : 256) + ai * HALF + wr * 64 + m * 16 + fr];
#pragma unroll
                for (int bj = 0; bj < 2; ++bj)
#pragma unroll
                    for (int n = 0; n < 2; ++n) acc[ai][bj][m][n] = acc[ai][bj][m][n] * f;
            }
    }
    __device__ __forceinline__ void operator()(const f32x4 (&acc)[2][2][4][2], const Unit& u, int wr, int wc, int fr, int fq) const {
        const int col0 = u.pn * BM + wc * 32 + 4 * fq;
#pragma unroll
        for (int ai = 0; ai < 2; ++ai)
#pragma unroll
            for (int m = 0; m < 4; ++m) {
                const int row = u.pm * BM + ai * HALF + wr * 64 + m * 16 + fr; const float r2 = gtab[512 + ai * HALF + wr * 64 + m * 16 + fr];
                float q = 0.f;
#pragma unroll
                for (int bj = 0; bj < 2; ++bj)
#pragma unroll
                    for (int n = 0; n < 2; ++n) {
                        const size_t off = (size_t)row * D + col0 + bj * HALF + n * 16;
                        const f32x4 x1 = *(const f32x4*)(base + off) + acc[ai][bj][m][n] * r2;
                        *(f32x4*)(out + off) = x1;
                        typedef unsigned u32x2v __attribute__((ext_vector_type(2)));
                        u32x2v w; w.x = cvt_pk_bf16(x1[0], x1[1]); w.y = cvt_pk_bf16(x1[2], x1[3]); *(u32x2v*)(xb + off) = w;
                        q += (x1[0] * x1[0] + x1[1] * x1[1]) + (x1[2] * x1[2] + x1[3] * x1[3]);
                    }
                q += __shfl_xor(q, 16); q += __shfl_xor(q, 32);
                if (fq == 0) xssq[(size_t)row * 16 + u.pn * 4 + wc] = q;
            }
    }
};
struct EpiScores {
    static constexpr bool PERM = false, AFTER_DRAIN = false, KHOOK = false;
    float* O; const float* xssq;
    __device__ __forceinline__ void operator()(const f32x4 (&acc)[2][2][4][2], const Unit& u, int wr, int wc, int fr, int fq) const {
        const int col0 = u.pn * BM + wc * 32 + 4 * fq;
#pragma unroll
        for (int ai = 0; ai < 2; ++ai)
#pragma unroll
            for (int m = 0; m < 4; ++m) {
                const int row = u.pm * BM + ai * HALF + wr * 64 + m * 16 + fr;
                const f32x4 a = *(const f32x4*)(xssq + (size_t)row * 16), b = *(const f32x4*)(xssq + (size_t)row * 16 + 4), c = *(const f32x4*)(xssq + (size_t)row * 16 + 8), d = *(const f32x4*)(xssq + (size_t)row * 16 + 12);
                const float ss = ((a[0] + a[1]) + (a[2] + a[3])) + ((b[0] + b[1]) + (b[2] + b[3])) + ((c[0] + c[1]) + (c[2] + c[3])) + ((d[0] + d[1]) + (d[2] + d[3]));
                const float r = rsqrtf(ss * (1.f / 1024.f) + EPS);
#pragma unroll
                for (int bj = 0; bj < 2; ++bj)
#pragma unroll
                    for (int n = 0; n < 2; ++n) *(f32x4*)(O + (size_t)row * 2048 + col0 + bj * HALF + n * 16) = acc[ai][bj][m][n] * r;
            }
    }
};
}

struct Args { const float* in[22]; float* out; unsigned char* ws; int ph_lo, ph_hi, li, pad; };
enum { I_X = 0, I_MEM, I_NORM1G, I_WIN, I_CONVW, I_CONVB, I_DTBIAS, I_ALOG, I_DSKIP, I_SSDG, I_SBG, I_MEMNG, I_WMEMKV, I_MQG, I_MKG, I_MEMOG, I_WOUT, I_NORM2G, I_WQ, I_KEYS, I_PU, I_PV };

__device__ __forceinline__ int opq(int i) { asm volatile("" : "+s"(i)); return i; }
#define AIN(i) (a.in[opq(i)])
__device__ __forceinline__ void transpose_item(const float* W, int ldw, int src_c0, int nvalid, const float* g, bf16* WT, int K, int dst_r0, int k0, LAS float* scr, int lane) {
    const int c = lane & 31;
#pragma unroll 8
    for (int i = 0; i < 32; ++i) {
        const int kk = 2 * i + (lane >> 5);
        float v = (c < nvalid) ? W[(size_t)(k0 + kk) * ldw + src_c0 + c] : 0.f;
        if (g) v *= g[k0 + kk];
        scr[kk * 33 + c] = v;
    }
    LDS_WAIT(); asm volatile("" ::: "memory");
    const int c8 = lane & 7;
#pragma unroll
    for (int j = 0; j < 4; ++j) {
        const int n = (lane >> 3) + 8 * j; const LAS float* s = scr + (8 * c8) * 33 + n;
        v4u o; o.x = pkbf(s[0 * 33], s[1 * 33]); o.y = pkbf(s[2 * 33], s[3 * 33]); o.z = pkbf(s[4 * 33], s[5 * 33]); o.w = pkbf(s[6 * 33], s[7 * 33]);
        *(GAS v4u*)(WT + (size_t)(dst_r0 + n) * K + k0 + 8 * c8) = o;
    }
    LDS_WAIT(); asm volatile("" ::: "memory");
}
__device__ __forceinline__ void wsc_item(const float* wq, const float* keys, const float* g2, bf16* WscT, int hc, int kb, int nq, LAS float* scr, int lane) {
    const int k0 = kb * 64;
#pragma unroll 8
    for (int kk = 0; kk < 64; ++kk) scr[kk * 64 + ((lane + kk) & 63)] = wq[(size_t)(k0 + kk) * D + hc * 64 + lane] * g2[k0 + kk];
    LDS_WAIT(); asm volatile("" ::: "memory");
    for (int n = nq * 32; n < nq * 32 + 32; ++n) {
        const float* kp = keys + ((size_t)hc * 128 + n) * 64;
        float a = 0.f;
#pragma unroll
        for (int d = 0; d < 64; ++d) a += scr[lane * 64 + ((d + lane) & 63)] * kp[d];
        WscT[(size_t)(hc * 128 + n) * D + k0 + lane] = (bf16)(pkbf(a, 0.f) & 0xffffu);
    }
    LDS_WAIT(); asm volatile("" ::: "memory");
}
__device__ __forceinline__ void row_to_bf16(const float* xrow, bf16* orow, float* rs, int lane) {
    const GAS f32x4* xr = (const GAS f32x4*)xrow + lane;
    f32x4 v[4]; float s = 0.f;
#pragma unroll
    for (int j = 0; j < 4; ++j) { v[j] = xr[64 * j]; s += (v[j].x * v[j].x + v[j].y * v[j].y) + (v[j].z * v[j].z + v[j].w * v[j].w); }
    s = wave_sum(s);
    GAS unsigned long long* o8 = (GAS unsigned long long*)orow + lane;
#pragma unroll
    for (int j = 0; j < 4; ++j) o8[64 * j] = (unsigned long long)pkbf(v[j].x, v[j].y) | ((unsigned long long)pkbf(v[j].z, v[j].w) << 32);
    if (lane == 0) *rs = rsqrtf(s * (1.f / 1024.f) + EPS);
}
__device__ __forceinline__ void ph_prologue(const Args& a, unsigned char* ws, LAS unsigned char* lds, int gw, int NGW, int wave, int lane) {
    LAS float* scr = (LAS float*)(lds + wave * 16384);
    constexpr int I_IN = 80 * 16, I_MEMW = 16 * 16, I_OUT = 32 * 16, I_SC = 16 * 16 * 4, PER_L = I_IN + I_MEMW + I_OUT + I_SC;
    constexpr int NW_ITEMS = NL * PER_L, NITEMS = NW_ITEMS + T + MROWS;
    for (int it = gw; it < NITEMS; it += NGW) {
        if (it < NW_ITEMS) {
            const int l = it / PER_L; int r = it % PER_L;
            if (r < I_IN) {
                const int j = r / 16, kb = r % 16;
                const int src = (j < 32) ? 32 * j : (j < 76 ? 32 * j + 6 : 1024), nv = (j < 76) ? 32 : (j == 76 ? 6 : 0);
                transpose_item(AIN(I_WIN) + (size_t)l * D * DIN, DIN, src, nv, AIN(I_NORM1G) + l * D, (bf16*)(ws + WS_WIN) + (size_t)l * NPROJ * D, D, 32 * j, 64 * kb, scr, lane);
                continue;
            }
            r -= I_IN;
            if (r < I_MEMW) {
                const int j = r / 16, kb = r % 16;
                transpose_item(AIN(I_WMEMKV) + (size_t)l * D * 512, 512, 32 * j, 32, AIN(I_MEMNG) + l * D, (bf16*)(ws + WS_WMEM) + (size_t)l * 512 * D, D, 32 * j, 64 * kb, scr, lane);
                continue;
            }
            r -= I_MEMW;
            if (r < I_OUT) {
                const int j = r / 16, kb = r % 16;
                const float* g = (kb < 6) ? AIN(I_SSDG) + l * 384 : (kb < 12 ? AIN(I_SBG) + l * 384 - 384 : AIN(I_MEMOG) + l * 256 - 768);
                transpose_item(AIN(I_WOUT) + (size_t)l * D * D, D, 32 * j, 32, g, (bf16*)(ws + WS_WOUT) + (size_t)l * D * D, D, 32 * j, 64 * kb, scr, lane);
                continue;
            }
            r -= I_OUT;
            { const int nq = r & 3, kb = (r >> 2) & 15, hc = r >> 6;
              wsc_item(AIN(I_WQ) + (size_t)l * D * D, AIN(I_KEYS) + (size_t)l * 16 * 128 * 64, AIN(I_NORM2G) + l * D, (bf16*)(ws + WS_WSC) + (size_t)l * 2048 * D, hc, kb, nq, scr, lane); }
            continue;
        }
        int r = it - NW_ITEMS;
        if (r < T) { row_to_bf16(AIN(I_X) + (size_t)r * D, (bf16*)(ws + WS_XB) + (size_t)r * D, (float*)(ws + WS_RS1) + r, lane); continue; }
        r -= T;
        row_to_bf16(AIN(I_MEM) + (size_t)r * D, (bf16*)(ws + WS_MEMB) + (size_t)r * D, (float*)(ws + WS_RSM) + r, lane);
    }
}

__device__ __forceinline__ void ph_conv_naive(const bf16* proj, const float* cw, const float* cb, float* xbc, int bx, int G, int tid) {
    for (size_t idx = (size_t)bx * 512 + tid; idx < (size_t)T * CONV_CH; idx += (size_t)G * 512) {
        const int t = (int)(idx / CONV_CH), c = (int)(idx % CONV_CH), s = t % S;
        float acc = cb[c];
#pragma unroll
        for (int k = 0; k < 4; ++k) { const int ss = s - 3 + k; if (ss >= 0) acc += cw[k * CONV_CH + c] * bf2f(proj[(size_t)(t - 3 + k) * NPROJ + PC_XBC + c]); }
        xbc[idx] = silu_f(acc);
    }
}
__device__ __forceinline__ void scan_item_naive(int b, int h, const float* xbc, const float* dtf, const float* a_log, const float* d_skip, float* yraw, int lane) {
    const int g = h / 3, p = lane;
    const float a = -expf(a_log[h]), dsk = d_skip[h];
    float hs[64];
#pragma unroll
    for (int n = 0; n < 64; ++n) hs[n] = 0.f;
    for (int s = 0; s < S; ++s) {
        const size_t t = (size_t)b * S + s;
        const float dtv = dtf[t * 8 + h], decay = expf(dtv * a);
        const float xv = xbc[t * CONV_CH + h * 64 + p], xd = xv * dtv;
        const float* Bp = xbc + t * CONV_CH + 384 + g * 64;
        const float* Cp = xbc + t * CONV_CH + 512 + g * 64;
        float y = 0.f;
#pragma unroll
        for (int n = 0; n < 64; ++n) { hs[n] = decay * hs[n] + Bp[n] * xd; y += Cp[n] * hs[n]; }
        yraw[t * 384 + h * 64 + p] = y + dsk * xv;
    }
}
__device__ __forceinline__ void sb_item_naive(int b, int h, int qb, const bf16* proj, bf16* ycat, float* yssq, int lane) {
    const int s_q = qb * 64 + lane; const size_t tq = (size_t)b * S + s_q;
    float q[64], o[64];
#pragma unroll
    for (int d = 0; d < 64; ++d) { q[d] = bf2f(proj[tq * NPROJ + PC_QSB + h * 64 + d]) * 0.125f; o[d] = 0.f; }
    float R = 0.f;
    for (int s = qb * 64 + 62; s >= 0; --s) {
        const bf16* kp = proj + ((size_t)b * S + s) * NPROJ + PC_KSB + h * 64;
        const bf16* vp = proj + ((size_t)b * S + s) * NPROJ + PC_VSB + h * 64;
        float z = 0.f;
#pragma unroll
        for (int d = 0; d < 64; ++d) z += q[d] * bf2f(kp[d]);
        if (s < s_q) {
            const float l1p = log1pf(expf(-fabsf(z)));
            const float lb = fminf(z, 0.f) - l1p, lk = fminf(-z, 0.f) - l1p;
            const float w = expf(lb + R);
            R += lk;
#pragma unroll
            for (int d = 0; d < 64; ++d) o[d] += w * bf2f(vp[d]);
        }
    }
    float ss = 0.f;
#pragma unroll
    for (int d = 0; d < 64; d += 2) { ss += o[d] * o[d] + o[d + 1] * o[d + 1]; *(unsigned*)(ycat + tq * D + 384 + h * 64 + d) = pkbf(o[d], o[d + 1]); }
    yssq[tq * 16 + 6 + h] = ss;
}
__device__ __forceinline__ void mem_item_naive(int tb, int h, const bf16* proj, const bf16* memkv, const float* qg, const float* kg, bf16* ycat, float* yssq, int lane) {
    const int t = tb * 64 + lane, b = t / S;
    float q[64], o[64]; float ss = 0.f;
#pragma unroll
    for (int d = 0; d < 64; ++d) { q[d] = bf2f(proj[(size_t)t * NPROJ + PC_QMEM + h * 64 + d]); ss += q[d] * q[d]; o[d] = 0.f; }
    const float r = rsqrtf(ss * (1.f / 64.f) + EPS) * 0.125f;
#pragma unroll
    for (int d = 0; d < 64; ++d) q[d] = q[d] * r * qg[d] * kg[d];
    float mx = -INFINITY, l = 0.f;
    for (int m = 0; m < NMEM; ++m) {
        const bf16* kp = memkv + ((size_t)b * NMEM + m) * 512 + h * 64;
        const bf16* vp = kp + 256;
        float sc = 0.f, kk = 0.f;
#pragma unroll
        for (int d = 0; d < 64; ++d) { const float kv = bf2f(kp[d]); sc += q[d] * kv; kk += kv * kv; }
        sc *= rsqrtf(kk * (1.f / 64.f) + EPS);
        const float mn = fmaxf(mx, sc), corr = expf(mx - mn), p = expf(sc - mn);
        l = l * corr + p;
#pragma unroll
        for (int d = 0; d < 64; ++d) o[d] = o[d] * corr + p * bf2f(vp[d]);
        mx = mn;
    }
    const float il = 1.f / l; float s2 = 0.f;
#pragma unroll
    for (int d = 0; d < 64; d += 2) { const float a0 = o[d] * il, a1 = o[d + 1] * il; s2 += a0 * a0 + a1 * a1; *(unsigned*)(ycat + (size_t)t * D + 768 + h * 64 + d) = pkbf(a0, a1); }
    yssq[(size_t)t * 16 + 12 + h] = s2;
}
__device__ __forceinline__ void ph_mix_naive(const Args& a, unsigned char* ws, int l, int gw, int NGW, int lane) {
    const bf16* proj = (const bf16*)(ws + WS_PROJ); bf16* ycat = (bf16*)(ws + WS_YCAT); float* yssq = (float*)(ws + WS_YSSQ);
    constexpr int N_SCAN = 24, N_SB = 24 * 64, N_MEM = 256 * 4;
    for (int it = gw; it < N_SCAN + N_SB + N_MEM; it += NGW) {
        if (it < N_SCAN) { scan_item_naive(it / 6, it % 6, (const float*)(ws + WS_XBC), (const float*)(ws + WS_DTF), AIN(I_ALOG) + l * 6, AIN(I_DSKIP) + l * 6, (float*)(ws + WS_YRAW), lane); continue; }
        int r = it - N_SCAN;
        if (r < N_SB) { const int qb = 63 - r / 24, bh = r % 24; sb_item_naive(bh / 6, bh % 6, qb, proj, ycat, yssq, lane); continue; }
        r -= N_SB;
        mem_item_naive(r >> 2, r & 3, proj, (const bf16*)(ws + WS_MEMKV), AIN(I_MQG) + l * 64, AIN(I_MKG) + l * 64, ycat, yssq, lane);
    }
}
__device__ __forceinline__ void ph_gate_naive(unsigned char* ws, int gw, int NGW, int lane) {
    const bf16* proj = (const bf16*)(ws + WS_PROJ); bf16* ycat = (bf16*)(ws + WS_YCAT); float* yssq = (float*)(ws + WS_YSSQ); const float* yraw = (const float*)(ws + WS_YRAW);
    for (int t = gw; t < T; t += NGW) {
#pragma unroll
        for (int j = 0; j < 6; ++j) {
            const int c = lane + 64 * j; const float z = bf2f(proj[(size_t)t * NPROJ + PC_Z + c]);
            const float v = yraw[(size_t)t * 384 + c] * silu_f(z);
            ycat[(size_t)t * D + c] = (bf16)(pkbf(v, 0.f) & 0xffffu);
            const float s = wave_sum(v * v);
            if (lane == 0) yssq[(size_t)t * 16 + j] = s;
        }
    }
}
__device__ __forceinline__ void ph_topk_naive(unsigned char* ws, int bx, int G, int tid) {
    const float* scores = (const float*)(ws + WS_SCORES); float* s_top = (float*)(ws + WS_STOP); int* i_top = (int*)(ws + WS_ITOP);
    int* eidx = (int*)(ws + WS_EIDX); float* gate = (float*)(ws + WS_GATE);
    for (size_t r = (size_t)bx * 512 + tid; r < (size_t)T * 8; r += (size_t)G * 512) {
        for (int c = 0; c < 2; ++c) {
            const float* sp = scores + (r * 2 + c) * 128;
            float pv = INFINITY; int pi = -1;
            for (int k = 0; k < 16; ++k) {
                float bv = -INFINITY; int bi = 1 << 30;
                for (int n = 0; n < 128; ++n) {
                    const float v = sp[n];
                    const bool elig = (v < pv) || (v == pv && n > pi);
                    if (elig && (v > bv || (v == bv && n < bi))) { bv = v; bi = n; }
                }
                s_top[(r * 2 + c) * 16 + k] = bv; i_top[(r * 2 + c) * 16 + k] = bi; pv = bv; pi = bi;
            }
        }
        const float* s0 = s_top + r * 32; const float* s1 = s0 + 16;
        const int* i0 = i_top + r * 32; const int* i1 = i0 + 16;
        float pv = INFINITY; int pi = -1; float best0 = 0.f, den = 0.f;
        for (int k = 0; k < 16; ++k) {
            float bv = -INFINITY; int bi = 1 << 30;
            for (int c = 0; c < 256; ++c) {
                const float v = s0[c >> 4] + s1[c & 15];
                const bool elig = (v < pv) || (v == pv && c > pi);
                if (elig && (v > bv || (v == bv && c < bi))) { bv = v; bi = c; }
            }
            if (k == 0) best0 = bv;
            const float e = expf(bv - best0);
            den += e;
            gate[r * 16 + k] = e;
            eidx[r * 16 + k] = i0[bi >> 4] * 128 + i1[bi & 15];
            pv = bv; pi = bi;
        }
        const float inv = 1.f / den;
        for (int k = 0; k < 16; ++k) gate[r * 16 + k] *= inv;
    }
}
__device__ __forceinline__ void ph_gather_naive(const Args& a, unsigned char* ws, int l, int gw, int NGW, int lane) {
    const int* eidx = (const int*)(ws + WS_EIDX); const float* gate = (const float*)(ws + WS_GATE);
    const float* ut = AIN(I_PU) + (size_t)l * 16384 * D; const float* vt = AIN(I_PV) + (size_t)l * 16384 * D; const float* g2 = AIN(I_NORM2G) + l * D;
    float* x = a.out;
    for (int t = gw; t < T; t += NGW) {
        f32x4 xv[4], hv[4], acc[4]; float ss = 0.f;
#pragma unroll
        for (int j = 0; j < 4; ++j) { xv[j] = *(const f32x4*)(x + (size_t)t * D + j * 256 + lane * 4); ss += (xv[j].x * xv[j].x + xv[j].y * xv[j].y) + (xv[j].z * xv[j].z + xv[j].w * xv[j].w); acc[j] = (f32x4){0.f, 0.f, 0.f, 0.f}; }
        const float r2 = rsqrtf(wave_sum(ss) * (1.f / 1024.f) + EPS);
#pragma unroll
        for (int j = 0; j < 4; ++j) hv[j] = xv[j] * r2 * *(const f32x4*)(g2 + j * 256 + lane * 4);
        for (int k = 0; k < 128; ++k) {
            const int e = eidx[(size_t)t * 128 + k]; const float gt = gate[(size_t)t * 128 + k];
            const float* ur = ut + (size_t)e * D; const float* vr = vt + (size_t)e * D;
            float s = 0.f;
#pragma unroll
            for (int j = 0; j < 4; ++j) { const f32x4 u = *(const f32x4*)(ur + j * 256 + lane * 4); s += (u.x * hv[j].x + u.y * hv[j].y) + (u.z * hv[j].z + u.w * hv[j].w); }
            s = wave_sum(s);
            const float w = gt * 0.5f * s * (1.f + erff(s * 0.70710678118654752f));
#pragma unroll
            for (int j = 0; j < 4; ++j) acc[j] += *(const f32x4*)(vr + j * 256 + lane * 4) * w;
        }
        float s2 = 0.f;
#pragma unroll
        for (int j = 0; j < 4; ++j) {
            const f32x4 o = xv[j] + acc[j];
            *(f32x4*)(x + (size_t)t * D + j * 256 + lane * 4) = o;
            s2 += (o.x * o.x + o.y * o.y) + (o.z * o.z + o.w * o.w);
            *(unsigned long long*)((bf16*)(ws + WS_XB) + (size_t)t * D + j * 256 + lane * 4) = (unsigned long long)pkbf(o.x, o.y) | ((unsigned long long)pkbf(o.z, o.w) << 32);
        }
        s2 = wave_sum(s2);
        if (lane == 0) ((float*)(ws + WS_RS1))[t] = rsqrtf(s2 * (1.f / 1024.f) + EPS);
    }
}

constexpr int NPH_L = 8, NPHASES = 1 + NL * NPH_L;
#ifndef MK_PHMASK
#define MK_PHMASK 0x1ff
#endif
#define PH_ON(j) ((MK_PHMASK >> (j)) & 1)
__global__ void __launch_bounds__(NWAVES * 64, 2) mega(Args a) {
    extern __shared__ __attribute__((aligned(16))) unsigned char lds_raw[];
    {
        LAS unsigned char* lds0 = (LAS unsigned char*)lds_raw;
        for (int u = threadIdx.x; u < (LDS_BYTES - LDSCTL_OFF) / 4; u += NWAVES * 64) ((LAS unsigned*)(lds0 + LDSCTL_OFF))[u] = 0u;
        __syncthreads();
    }
    const bool multi = (a.ph_hi - a.ph_lo) > 1;
    XcdBarrier bar; bar.bar = (unsigned*)(a.ws + WS_CTL) + CW_BAR + a.li * XCD_BAR_WORDS; bar.x = 0; bar.st = nullptr;
    if (multi) bar = xcd_barrier_post((unsigned*)(a.ws + WS_CTL) + CW_BAR + a.li * XCD_BAR_WORDS, (volatile LAS unsigned*)((LAS unsigned char*)lds_raw + MISC_OFF) + 8);

    for (int ph = a.ph_lo; ph < a.ph_hi; ++ph) {
        unsigned char* ws = a.ws; asm volatile("" : "+s"(ws));
        int G = (int)gridDim.x; asm volatile("" : "+s"(G));
        int bx = (int)blockIdx.x; asm volatile("" : "+s"(bx));
        int tid = (int)threadIdx.x; asm volatile("" : "+v"(tid));
        LAS unsigned char* lds = (LAS unsigned char*)lds_raw;
        const int lane = tid & 63, wave = __builtin_amdgcn_readfirstlane(tid >> 6);
        const int vcu = (G % 8 == 0) ? (bx % 8) * (G / 8) + bx / 8 : bx;
        const int gw = vcu * NWAVES + wave, NGW = G * NWAVES;
        if (ph == 0) {
            if (PH_ON(8)) ph_prologue(a, ws, lds, gw, NGW, wave, lane);
        } else {
            const int l = (ph - 1) / NPH_L, j = (ph - 1) % NPH_L;
            if (j == 0 && PH_ON(0)) {
                { pg8::Gemm g{(const pg8::bf16_t*)(ws + WS_XB), (const pg8::bf16_t*)(ws + WS_WIN) + (size_t)l * NPROJ * D, T, NPROJ, D};
                  pg8::StaticOrder So; So.init(T, NPROJ, G, bx);
                  pg8::EpiInProj E{(pg8::bf16_t*)(ws + WS_PROJ), NPROJ, (const float*)(ws + WS_RS1), (float*)(ws + WS_DTF), AIN(I_DTBIAS) + l * 6};
                  pg8::gemm_phase<pg8::EpiInProj, pg8::StaticOrder, true, true>(lds, g, So, E); }
                { pg8::Gemm g{(const pg8::bf16_t*)(ws + WS_MEMB), (const pg8::bf16_t*)(ws + WS_WMEM) + (size_t)l * 512 * D, MROWS, 512, D};
                  pg8::StaticOrder So; So.init(MROWS, 512, G, bx);
                  pg8::EpiInProj E{(pg8::bf16_t*)(ws + WS_MEMKV), 512, (const float*)(ws + WS_RSM), nullptr, nullptr};
                  pg8::gemm_phase<pg8::EpiInProj, pg8::StaticOrder, true, true>(lds, g, So, E); }
            } else if (j == 1 && PH_ON(1)) {
                ph_conv_naive((const bf16*)(ws + WS_PROJ), AIN(I_CONVW) + l * 4 * CONV_CH, AIN(I_CONVB) + l * CONV_CH, (float*)(ws + WS_XBC), bx, G, tid);
            } else if (j == 2 && PH_ON(2)) {
                ph_mix_naive(a, ws, l, gw, NGW, lane);
            } else if (j == 3 && PH_ON(3)) {
                ph_gate_naive(ws, gw, NGW, lane);
            } else if (j == 4 && PH_ON(4)) {
                pg8::Gemm g{(const pg8::bf16_t*)(ws + WS_YCAT), (const pg8::bf16_t*)(ws + WS_WOUT) + (size_t)l * D * D, T, D, D};
                pg8::StaticOrder So; So.init(T, D, G, bx);
                LAS float* gtab = (LAS float*)(lds + GTAB_OFF);
                { pg8::Unit u0; if (So.next(0, u0) && tid < 256) { float r0, r1, r2; pg8::group_rstd((const float*)(ws + WS_YSSQ), u0.pm * 256 + tid, r0, r1, r2); gtab[tid] = r0 / r1; gtab[256 + tid] = r1 / r2; gtab[512 + tid] = r2; } }
                __syncthreads();
                pg8::EpiOut E{l == 0 ? AIN(I_X) : a.out, a.out, (pg8::bf16_t*)(ws + WS_XB), (float*)(ws + WS_XSSQ), gtab};
                pg8::gemm_phase<pg8::EpiOut, pg8::StaticOrder, true, true>(lds, g, So, E);
            } else if (j == 5 && PH_ON(5)) {
                pg8::Gemm g{(const pg8::bf16_t*)(ws + WS_XB), (const pg8::bf16_t*)(ws + WS_WSC) + (size_t)l * 2048 * D, T, 2048, D};
                pg8::StaticOrder So; So.init(T, 2048, G, bx);
                pg8::EpiScores E{(float*)(ws + WS_SCORES), (const float*)(ws + WS_XSSQ)};
                pg8::gemm_phase<pg8::EpiScores, pg8::StaticOrder, true, true>(lds, g, So, E);
            } else if (j == 6 && PH_ON(6)) {
                ph_topk_naive(ws, bx, G, tid);
            } else if (j == 7 && PH_ON(7)) {
                ph_gather_naive(a, ws, l, gw, NGW, lane);
            }
        }
        if (ph + 1 < a.ph_hi) { XcdBarrier b2 = bar; { unsigned* p = b2.bar; unsigned x = b2.x; asm volatile("" : "+s"(p), "+s"(x)); b2.bar = p; b2.x = x; } xcd_barrier(b2); }
    }
}

#ifndef MK_ONE_LAUNCH
#define MK_ONE_LAUNCH 1
#endif
extern "C" void kernel_launch(void* const* d_in, const int* in_sizes, int n_in, void* d_out, int out_size, void* d_ws, size_t ws_size, hipStream_t stream) {
    static int grid = 0;
    if (grid == 0) {
        if (n_in != 22 || out_size != T * D || ws_size < WS_END) { fprintf(stderr, "kernel_launch: unexpected problem (n_in %d out %d ws %zu)\n", n_in, out_size, ws_size); grid = -1; return; }
        int dev = 0, cus = 0, per_cu = 0;
        if (hipGetDevice(&dev) != hipSuccess || hipDeviceGetAttribute(&cus, hipDeviceAttributeMultiprocessorCount, dev) != hipSuccess) { grid = -1; return; }
        if (hipFuncSetAttribute((const void*)mega, hipFuncAttributeMaxDynamicSharedMemorySize, LDS_BYTES) != hipSuccess) { fprintf(stderr, "kernel_launch: hipFuncSetAttribute failed\n"); grid = -1; return; }
        if (hipOccupancyMaxActiveBlocksPerMultiprocessor(&per_cu, (const void*)mega, NWAVES * 64, LDS_BYTES) != hipSuccess || per_cu < 1) { fprintf(stderr, "kernel_launch: occupancy query says %d\n", per_cu); (void)hipGetLastError(); per_cu = 1; }
        grid = cus;
    }
    if (grid < 0) return;
    (void)hipMemsetAsync((char*)d_ws + WS_CTL, 0, CTL_ZERO_BYTES, stream);
    Args a{};
    for (int i = 0; i < 22; ++i) a.in[i] = (const float*)d_in[i];
    a.out = (float*)d_out; a.ws = (unsigned char*)d_ws;
#if MK_ONE_LAUNCH
    a.ph_lo = 0; a.ph_hi = NPHASES; a.li = 0;
    hipLaunchKernelGGL(mega, dim3(grid), dim3(NWAVES * 64), LDS_BYTES, stream, a);
#else
    for (int ph = 0; ph < NPHASES; ++ph) { a.ph_lo = ph; a.ph_hi = ph + 1; a.li = 0; hipLaunchKernelGGL(mega, dim3(grid), dim3(NWAVES * 64), LDS_BYTES, stream, a); }
#endif
}
```

```cpp
#include <hip/hip_runtime.h>
#include <cstdio>
#include <cstdint>
#include <cmath>
namespace pg8 {
#define PG8_LAS __attribute__((address_space(3)))
typedef unsigned short bf16_t;
typedef short bf16x8 __attribute__((ext_vector_type(8)));
typedef float f32x4 __attribute__((ext_vector_type(4)));
typedef unsigned u32x4 __attribute__((ext_vector_type(4)));
constexpr int BM = 256, BK = 64, HALF = 128, HTB = HALF * BK * 2  , STAGE_BYTES = 8 * HTB, NXCD = 8, WGM = 8;

__host__ __device__ __forceinline__ int lds_byte(int r, int c) { const int st = (r >> 4) * 2 + (c >> 5), rr = r & 15, cc = c & 31, ob = rr * 64 + cc * 2; return st * 1024 + (ob ^ (((ob >> 9) & 1) << 5)); }
__host__ __device__ __forceinline__ void stage_rc(int b, int& R, int& C) { const int st = b / 1024, sb = b % 1024, swz = sb ^ (((sb >> 9) & 1) << 5); R = (st >> 1) * 16 + swz / 64; C = (st & 1) * 32 + (swz % 64) / 2; }
__host__ __device__ __forceinline__ int perm32(int rho) { const int n = rho >> 4, i = rho & 15; return 8 * (i >> 2) + 4 * n + (i & 3); }

struct Unit { int pm, pn; };
struct Gemm { const bf16_t* A; const bf16_t* Bt; int M, N, K; };

struct StaticOrder {
    int nM, nN, nwg, G, c;
    __host__ __device__ void init(int M, int N, int G_, int c_) { nM = M / BM; nN = N / BM; nwg = nM * nN; G = G_; c = c_; }
    __host__ __device__ bool next(int i, Unit& u) const {
        const long L = (long)i * G + c; if (L >= nwg) return false;
        int wgid = (int)L; { const int q = nwg / NXCD, r = nwg % NXCD, xcd = wgid % NXCD, off = wgid / NXCD; wgid = (xcd < r ? xcd * (q + 1) : r * (q + 1) + (xcd - r) * q) + off; }
        const int nig = WGM * nN, gid = wgid / nig, fm = gid * WGM, gsz = (nM - fm) < WGM ? (nM - fm) : WGM;
        u.pm = fm + ((wgid % nig) % gsz); u.pn = (wgid % nig) / gsz; return true;
    }
    __device__ __forceinline__ void a_ready(const Unit&) const {}
    __device__ __forceinline__ void done(const Unit&) const {}
};

__device__ __forceinline__ unsigned cvt_pk_bf16(float lo, float hi) { unsigned r; asm volatile("v_cvt_pk_bf16_f32 %0, %1, %2" : "=v"(r) : "v"(lo), "v"(hi)); return r; }
template <class Epi, class Sched, bool ALIGN_EPI = false, bool SP2 = false>
__device__ __forceinline__ void gemm_phase(PG8_LAS unsigned char* lds, const Gemm g, const Sched& S, const Epi& E) {
    int tid_ = threadIdx.x; asm volatile("" : "+v"(tid_));
    const int tid = tid_, wid = __builtin_amdgcn_readfirstlane(tid >> 6), lane = tid & 63, wr = wid >> 2, wc = wid & 3, fr = lane & 15, fq = lane >> 4;
    const int K = g.K, nt = K / BK;
    unsigned voffA[2], voffB[2];
#pragma unroll
    for (int i = 0; i < 2; ++i) { int R, C; stage_rc(tid * 16 + i * 8192, R, C); const int Rb = Epi::PERM ? ((R & ~31) + perm32(R & 31)) : R;
        voffA[i] = (unsigned)(R * K + C) * 2u; voffB[i] = (unsigned)(Rb * K + C) * 2u; }
    const size_t kstep = (size_t)(BK * 2);
    const size_t hstep = (size_t)HALF * K * 2;
    const size_t tstep = 2 * hstep;
    const unsigned ldsw = (unsigned)wid * 1024u;
    const int aoff = lds_byte(wr * 64 + fr, fq * 8), boff = lds_byte(wc * 32 + fr, fq * 8);
#define PG8_SA(b, h) (((b) * 2 + (h)) * HTB)
#define PG8_SB(b, h) ((4 + (b) * 2 + (h)) * HTB)
#define PG8_STAGE(bufoff, gbase, voff) do { _Pragma("unroll") for (int _i = 0; _i < 2; ++_i) \
        __builtin_amdgcn_global_load_lds((const unsigned*)((const char*)(gbase) + (voff)[_i]), (PG8_LAS unsigned*)(lds + (bufoff) + ldsw + _i * 8192), 16, 0, 0); } while (0)
#define PG8_LDA(dst, b, h) do { _Pragma("unroll") for (int m = 0; m < 4; ++m) _Pragma("unroll") for (int k = 0; k < 2; ++k) dst[m][k] = *(const PG8_LAS bf16x8*)(lds + PG8_SA(b, h) + aoff + m * 2048 + k * 1024); } while (0)
#define PG8_LDB(dst, b, h) do { _Pragma("unroll") for (int n = 0; n < 2; ++n) _Pragma("unroll") for (int k = 0; k < 2; ++k) dst[n][k] = *(const PG8_LAS bf16x8*)(lds + PG8_SB(b, h) + boff + n * 2048 + k * 1024); } while (0)
#define PG8_MMA(ai, bj, At, Bt) do { __builtin_amdgcn_s_setprio(1); _Pragma("unroll") for (int m = 0; m < 4; ++m) _Pragma("unroll") for (int n = 0; n < 2; ++n) _Pragma("unroll") for (int k = 0; k < 2; ++k) \
        acc[ai][bj][m][n] = __builtin_amdgcn_mfma_f32_16x16x32_bf16(Bt[n][k], At[m][k], acc[ai][bj][m][n], 0, 0, 0); __builtin_amdgcn_s_setprio(0); } while (0)
#define PG8_WAIT_V(n) asm volatile("s_waitcnt vmcnt(" #n ")" ::: "memory")
#define PG8_WAIT_L(n) asm volatile("s_waitcnt lgkmcnt(" #n ")" ::: "memory")
#define PG8_BAR __builtin_amdgcn_s_barrier()
#define PG8_SCHED __builtin_amdgcn_sched_barrier(0)
    Unit cur, nxt; int ui = 0;
    if (!S.next(0, cur)) return;
    f32x4 acc[2][2][4][2];
#pragma unroll
    for (int a = 0; a < 2; ++a)
#pragma unroll
        for (int b = 0; b < 2; ++b)
#pragma unroll
            for (int m = 0; m < 4; ++m)
#pragma unroll
                for (int n = 0; n < 2; ++n) acc[a][b][m][n] = (f32x4){0.f, 0.f, 0.f, 0.f};
    bf16x8 At[4][2], B0[2][2], B1[2][2];
    const char* cA = (const char*)g.A + (size_t)cur.pm * tstep; const char* cB = (const char*)g.Bt + (size_t)cur.pn * tstep;
    S.a_ready(cur);
    if constexpr (SP2) {
        PG8_STAGE(PG8_SB(0, 0), cB, voffB); PG8_STAGE(PG8_SB(0, 1), cB + hstep, voffB); PG8_STAGE(PG8_SA(0, 0), cA, voffA); PG8_STAGE(PG8_SA(0, 1), cA + hstep, voffA);
        if (wr == 1) PG8_BAR;
        PG8_WAIT_V(2); PG8_BAR;
        PG8_STAGE(PG8_SB(1, 0), cB + kstep, voffB); PG8_STAGE(PG8_SA(1, 0), cA + kstep, voffA); PG8_STAGE(PG8_SB(1, 1), cB + hstep + kstep, voffB);
        PG8_WAIT_V(6); PG8_BAR;
    } else {
        PG8_STAGE(PG8_SB(0, 0), cB, voffB); PG8_STAGE(PG8_SA(0, 0), cA, voffA); PG8_STAGE(PG8_SB(0, 1), cB + hstep, voffB); PG8_STAGE(PG8_SA(0, 1), cA + hstep, voffA);
        if (wr == 1) PG8_BAR;
        PG8_WAIT_V(4); PG8_BAR;
        PG8_STAGE(PG8_SB(1, 0), cB + kstep, voffB); PG8_STAGE(PG8_SA(1, 0), cA + kstep, voffA); PG8_STAGE(PG8_SB(1, 1), cB + hstep + kstep, voffB);
        PG8_WAIT_V(6); PG8_BAR;
    }
    for (;;) {
        const bool has_next = S.next(ui + 1, nxt);
        const char* nA = has_next ? (const char*)g.A + (size_t)nxt.pm * tstep : cA; const char* nB = has_next ? (const char*)g.Bt + (size_t)nxt.pn * tstep : cB;
        for (int t = 0; t < nt; t += 2) {
            const bool last = (t == nt - 2);
            const char* a1 = cA + (size_t)(t + 1) * kstep;
            const char* a2 = last ? nA : cA + (size_t)(t + 2) * kstep; const char* b2 = last ? nB : cB + (size_t)(t + 2) * kstep;
            const char* a3 = a2 + kstep; const char* b3 = b2 + kstep;
            if (last && has_next) S.a_ready(nxt);
            if constexpr (Epi::KHOOK) E.khook(acc, cur, t, wr, fr);
            if constexpr (SP2) {
            PG8_LDB(B0, 0, 0); PG8_LDB(B1, 0, 1); PG8_SCHED; PG8_LDA(At, 0, 0); PG8_STAGE(PG8_SA(1, 1), a1 + hstep, voffA);
            PG8_WAIT_V(8); PG8_WAIT_L(0); PG8_BAR; PG8_MMA(0, 0, At, B0); PG8_MMA(0, 1, At, B1); PG8_BAR; PG8_SCHED;
            PG8_LDA(At, 0, 1); PG8_STAGE(PG8_SB(0, 0), b2, voffB); PG8_STAGE(PG8_SB(0, 1), b2 + hstep, voffB); PG8_STAGE(PG8_SA(0, 0), a2, voffA);
            PG8_WAIT_V(8); PG8_WAIT_L(0); PG8_BAR; PG8_MMA(1, 0, At, B0); PG8_MMA(1, 1, At, B1); PG8_BAR; PG8_SCHED;
            PG8_LDB(B0, 1, 0); PG8_LDB(B1, 1, 1); PG8_SCHED; PG8_LDA(At, 1, 0); PG8_STAGE(PG8_SA(0, 1), a2 + hstep, voffA);
            PG8_WAIT_V(8); PG8_WAIT_L(0); PG8_BAR; PG8_MMA(0, 0, At, B0); PG8_MMA(0, 1, At, B1); PG8_BAR; PG8_SCHED;
            PG8_LDA(At, 1, 1); PG8_STAGE(PG8_SB(1, 0), b3, voffB); PG8_STAGE(PG8_SB(1, 1), b3 + hstep, voffB); PG8_STAGE(PG8_SA(1, 0), a3, voffA);
            PG8_WAIT_V(8); PG8_WAIT_L(0); PG8_BAR; PG8_MMA(1, 0, At, B0); PG8_MMA(1, 1, At, B1); PG8_BAR; PG8_SCHED;
            } else {
            PG8_LDB(B0, 0, 0); PG8_SCHED; PG8_LDA(At, 0, 0); PG8_STAGE(PG8_SA(1, 1), a1 + hstep, voffA);
            PG8_WAIT_L(8); PG8_BAR; PG8_WAIT_L(0); PG8_MMA(0, 0, At, B0); PG8_BAR; PG8_SCHED;
            PG8_LDB(B1, 0, 1); PG8_STAGE(PG8_SB(0, 0), b2, voffB);
            PG8_BAR; PG8_WAIT_L(0); PG8_MMA(0, 1, At, B1); PG8_BAR;
            PG8_LDA(At, 0, 1); PG8_STAGE(PG8_SA(0, 0), a2, voffA);
            PG8_BAR; PG8_WAIT_L(0); PG8_MMA(1, 0, At, B0); PG8_BAR; PG8_SCHED;
            PG8_STAGE(PG8_SB(0, 1), b2 + hstep, voffB);
            PG8_WAIT_V(6); PG8_BAR; PG8_MMA(1, 1, At, B1); PG8_BAR;
            PG8_LDB(B0, 1, 0); PG8_SCHED; PG8_LDA(At, 1, 0); PG8_STAGE(PG8_SA(0, 1), a2 + hstep, voffA);
            PG8_WAIT_L(8); PG8_BAR; PG8_WAIT_L(0); PG8_MMA(0, 0, At, B0); PG8_BAR; PG8_SCHED;
            PG8_LDB(B1, 1, 1); PG8_STAGE(PG8_SB(1, 0), b3, voffB);
            PG8_BAR; PG8_WAIT_L(0); PG8_MMA(0, 1, At, B1); PG8_BAR;
            PG8_LDA(At, 1, 1); PG8_STAGE(PG8_SA(1, 0), a3, voffA);
            PG8_BAR; PG8_WAIT_L(0); PG8_MMA(1, 0, At, B0); PG8_BAR; PG8_SCHED;
            PG8_STAGE(PG8_SB(1, 1), b3 + hstep, voffB);
            PG8_WAIT_V(6); PG8_BAR; PG8_MMA(1, 1, At, B1); PG8_BAR;
            }
        }
        if constexpr (ALIGN_EPI) { if (wr == 0) PG8_BAR; }
        if constexpr (!Epi::AFTER_DRAIN) { E(acc, cur, wr, wc, fr, fq); S.done(cur); }
        if (!has_next) break;
#pragma unroll
        for (int a = 0; a < 2; ++a)
#pragma unroll
            for (int b = 0; b < 2; ++b)
#pragma unroll
                for (int m = 0; m < 4; ++m)
#pragma unroll
                    for (int n = 0; n < 2; ++n) acc[a][b][m][n] = (f32x4){0.f, 0.f, 0.f, 0.f};
        cur = nxt; cA = nA; cB = nB; ++ui;
        if constexpr (ALIGN_EPI) { if (wr == 1) PG8_BAR; }
    }
    PG8_WAIT_V(0);
    if constexpr (!ALIGN_EPI) { if (wr == 0) PG8_BAR; }
    PG8_BAR;
    if constexpr (Epi::AFTER_DRAIN) { E.fused(acc, cur, wr, wc, fr, fq, lds, wid, lane); S.done(cur); }
#undef PG8_SA
#undef PG8_SB
#undef PG8_STAGE
#undef PG8_LDA
#undef PG8_LDB
#undef PG8_MMA
#undef PG8_WAIT_V
#undef PG8_WAIT_L
#undef PG8_BAR
#undef PG8_SCHED
}
}
#define GAS __attribute__((address_space(1)))
#define LAS __attribute__((address_space(3)))
typedef unsigned short bf16;
typedef unsigned v4u __attribute__((ext_vector_type(4)));
typedef float f32x4 __attribute__((ext_vector_type(4)));
typedef short bf16x8 __attribute__((ext_vector_type(8)));
typedef GAS unsigned gu32;
typedef GAS unsigned long long gu64;
#define RLX_AGENT __ATOMIC_RELAXED, __HIP_MEMORY_SCOPE_AGENT
#define LDS_WAIT() asm volatile("s_waitcnt lgkmcnt(0)" ::: "memory")
#define VM_WAIT() asm volatile("s_waitcnt vmcnt(0)" ::: "memory")
__device__ __forceinline__ unsigned long long rt() { return __builtin_amdgcn_s_memrealtime(); }
__device__ __forceinline__ unsigned f2bf(float f) { unsigned u = __builtin_bit_cast(unsigned, f); return (u + 0x7fffu + ((u >> 16) & 1u)) >> 16; }
__device__ __forceinline__ unsigned pk2(float lo, float hi) { return f2bf(lo) | (f2bf(hi) << 16); }

#define XB_TMO      128
#define XB_XCNT(j)  (256  + 64 * (j))
#define XB_XSUB(j)  (1280 + 64 * (j))
#define XB_XGEN(j)  (2304 + 64 * (j))
#define XB_TOP      3328
#define XB_TOPGEN   3392
#define XCD_BAR_WORDS 3456
#define XB_SPIN_CAP (1u << 18)

__device__ __forceinline__ unsigned xb_ld(unsigned* p)              { return __hip_atomic_load(p, __ATOMIC_RELAXED, __HIP_MEMORY_SCOPE_AGENT); }
__device__ __forceinline__ unsigned xb_add(unsigned* p, unsigned v) { return __hip_atomic_fetch_add(p, v, __ATOMIC_RELAXED, __HIP_MEMORY_SCOPE_AGENT); }
__device__ __forceinline__ unsigned xb_xcc_id() { return (unsigned)__builtin_amdgcn_s_getreg((3 << 11) | 20) & 0xFu; }
#define XB_SPIN(cond, bar) do { unsigned _sp = 0; while (cond) { __builtin_amdgcn_s_sleep(1); \
    if ((++_sp & 255u) == 0u) { if (xb_ld(&(bar)[XB_TMO])) break; if (_sp > XB_SPIN_CAP) { atomicAdd(&(bar)[XB_TMO], 1u); break; } } } } while (0)

struct XcdBarrier {
    unsigned* bar; unsigned x;
    volatile LAS unsigned* st;
};

__device__ __forceinline__ XcdBarrier xcd_barrier_post(unsigned* bar, volatile LAS unsigned* st) {
    XcdBarrier b; b.bar = bar; b.x = xb_xcc_id(); b.st = st;
    if (threadIdx.x == 0) (void)xb_add(&bar[XB_XCNT(b.x)], 1u);
    return b;
}
__device__ __forceinline__ void xcd_barrier_complete(unsigned* bar, unsigned x, unsigned& nloc, unsigned& nx) {
    const unsigned G = gridDim.x * gridDim.y * gridDim.z;
    unsigned sum, cnt, mine, sp = 0u;
    for (;;) {
        sum = 0u; cnt = 0u; mine = 0u;
#pragma unroll
        for (unsigned j = 0; j < 16; ++j) { const unsigned c = xb_ld(&bar[XB_XCNT(j)]); sum += c; cnt += (c > 0u) ? 1u : 0u; mine = (j == x) ? c : mine; }
        if (sum == G) break;
        __builtin_amdgcn_s_sleep(1);
        if ((++sp & 255u) == 0u) { if (xb_ld(&bar[XB_TMO])) break; if (sp > XB_SPIN_CAP) { atomicAdd(&bar[XB_TMO], 1u); break; } }
    }
    nloc = mine > 0u ? mine : 1u; nx = cnt > 0u ? cnt : 1u;
}

__device__ __forceinline__ void xcd_barrier(const XcdBarrier& b) {
    asm volatile("s_waitcnt vmcnt(0)" ::: "memory");
    __syncthreads();
    if (threadIdx.x == 0) {
        unsigned* bar = b.bar;
        __builtin_amdgcn_s_waitcnt(0);
        unsigned nloc = b.st[0], nx = b.st[1];
        if (nloc == 0u) { xcd_barrier_complete(bar, b.x, nloc, nx); b.st[0] = nloc; b.st[1] = nx; }
        const unsigned old = xb_add(&bar[XB_XSUB(b.x)], 1u);
        const unsigned gen = old / nloc;
        if (old + 1u == (gen + 1u) * nloc) {
            __builtin_amdgcn_fence(__ATOMIC_RELEASE, "agent");
            asm volatile("s_waitcnt vmcnt(0)" ::: "memory");
            const unsigned og = xb_add(&bar[XB_TOP], 1u);
            const unsigned tg = og / nx;
            if (og + 1u == (tg + 1u) * nx) xb_add(&bar[XB_TOPGEN], 1u);
            else XB_SPIN(xb_ld(&bar[XB_TOPGEN]) == tg, bar);
            __builtin_amdgcn_fence(__ATOMIC_ACQUIRE, "agent");
            xb_add(&bar[XB_XGEN(b.x)], 1u);
            asm volatile("s_waitcnt vmcnt(0)" ::: "memory");
        } else {
            XB_SPIN(xb_ld(&bar[XB_XGEN(b.x)]) == gen, bar);
            __builtin_amdgcn_fence(__ATOMIC_ACQUIRE, "agent");
            asm volatile("s_waitcnt vmcnt(0)" ::: "memory");
        }
    }
    __syncthreads();
}

constexpr int NWAVES = 8;
constexpr int D = 1024, NB = 4, S = 4096, T = NB * S, NL = 2, NMEM = 256, MROWS = NB * NMEM;
constexpr int DIN = 2438, NPROJ = 2560;
constexpr int PC_Z = 0, PC_XBC = 384, PC_QSB = 1024, PC_KSB = 1408, PC_VSB = 1792, PC_QMEM = 2176, PC_DT = 2432;
constexpr int CONV_CH = 640;
constexpr float EPS = 1e-6f;

constexpr int RING_BYTES = 131072;
constexpr int WSCR = 17408;
constexpr int LDSCTL_OFF = 8 * WSCR, MISC_OFF = LDSCTL_OFF + 320;
constexpr int LDS_BYTES = 147456;
constexpr int GTAB_OFF = LDSCTL_OFF + 1024;

constexpr size_t MiB = 1u << 20;
constexpr size_t WS_CTL = 0, CTL_ZERO_BYTES = 1 * MiB;
constexpr size_t WS_WIN = 2 * MiB;
constexpr size_t WS_WMEM = 12 * MiB;
constexpr size_t WS_WOUT = 14 * MiB;
constexpr size_t WS_WSC = 18 * MiB;
constexpr size_t WS_MEMB = 26 * MiB;
constexpr size_t WS_RSM = 28 * MiB;
constexpr size_t WS_RS1 = WS_RSM + 64 * 1024;
constexpr size_t WS_DTF = WS_RS1 + 64 * 1024;
constexpr size_t WS_XSSQ = 29 * MiB;
constexpr size_t WS_YSSQ = 30 * MiB;
constexpr size_t WS_MEMKV = 31 * MiB;
constexpr size_t WS_XB = 34 * MiB;
constexpr size_t WS_YCAT = 66 * MiB;
constexpr size_t WS_PROJ = 98 * MiB;
constexpr size_t WS_SCORES = 178 * MiB;
constexpr size_t WS_YPART = WS_SCORES;
constexpr size_t WS_XCONV = WS_SCORES + 24 * MiB;
constexpr size_t WS_CMG = WS_SCORES + 36 * MiB;
constexpr size_t WS_ACSG = WS_SCORES + 40 * MiB;
constexpr size_t WS_HS = WS_SCORES + 41 * MiB;
constexpr size_t WS_CD = WS_SCORES + 53 * MiB;
constexpr size_t WS_EIDX = 306 * MiB;
constexpr size_t WS_GATE = 314 * MiB;
constexpr size_t WS_STOP = 322 * MiB;
constexpr size_t WS_ITOP = 338 * MiB;
constexpr size_t WS_UT = 354 * MiB;
constexpr size_t WS_VT = 418 * MiB;
constexpr size_t WS_END = 482 * MiB;
constexpr int CW_BAR = 4096;

__device__ __forceinline__ float bf2f(bf16 v) { return __uint_as_float((unsigned)v << 16); }
__device__ __forceinline__ unsigned pkbf(float lo, float hi) { return pg8::cvt_pk_bf16(lo, hi); }
__device__ __forceinline__ float wave_sum(float v) {
#pragma unroll
    for (int o = 1; o < 64; o <<= 1) v += __shfl_xor(v, o);
    return v;
}
__device__ __forceinline__ float softplus_f(float x) { return fmaxf(x, 0.f) + log1pf(expf(-fabsf(x))); }
__device__ __forceinline__ float silu_f(float x) { return x / (1.f + expf(-x)); }

namespace pg8 {
struct EpiInProj {
    static constexpr bool PERM = true, AFTER_DRAIN = false, KHOOK = false;
    bf16_t* O; int ldc; const float* rs; float* dtf; const float* dtb;
    __device__ __forceinline__ void operator()(const f32x4 (&acc)[2][2][4][2], const Unit& u, int wr, int wc, int fr, int fq) const {
        const int row0 = u.pm * BM + wr * 64 + fr, col0 = u.pn * BM + wc * 32 + 8 * fq;
        const bool dtl = dtf && (u.pn * BM == PC_DT - 128) && wc == 0 && fq == 0;
#pragma unroll
        for (int ai = 0; ai < 2; ++ai)
#pragma unroll
            for (int m = 0; m < 4; ++m) {
                const int row = row0 + ai * HALF + m * 16; const float s = rs[row];
#pragma unroll
                for (int bj = 0; bj < 2; ++bj) {
                    const f32x4 v0 = acc[ai][bj][m][0] * s, v1 = acc[ai][bj][m][1] * s;
                    u32x4 w; w.x = cvt_pk_bf16(v0[0], v0[1]); w.y = cvt_pk_bf16(v0[2], v0[3]); w.z = cvt_pk_bf16(v1[0], v1[1]); w.w = cvt_pk_bf16(v1[2], v1[3]);
                    *(u32x4*)(O + (size_t)row * ldc + col0 + bj * HALF) = w;
                    if (bj == 1 && dtl) {
                        f32x4 d0; d0[0] = softplus_f(v0[0] + dtb[0]); d0[1] = softplus_f(v0[1] + dtb[1]); d0[2] = softplus_f(v0[2] + dtb[2]); d0[3] = softplus_f(v0[3] + dtb[3]);
                        f32x4 d1; d1[0] = softplus_f(v1[0] + dtb[4]); d1[1] = softplus_f(v1[1] + dtb[5]); d1[2] = 0.f; d1[3] = 0.f;
                        *(f32x4*)(dtf + (size_t)row * 8) = d0; *(f32x4*)(dtf + (size_t)row * 8 + 4) = d1;
                    }
                }
            }
    }
};
__device__ __forceinline__ void group_rstd(const float* yssq, int row, float& r_ssd, float& r_sb, float& r_mem) {
    const f32x4 a = *(const f32x4*)(yssq + (size_t)row * 16), b = *(const f32x4*)(yssq + (size_t)row * 16 + 4), c = *(const f32x4*)(yssq + (size_t)row * 16 + 8), d = *(const f32x4*)(yssq + (size_t)row * 16 + 12);
    const float s0 = (a[0] + a[1]) + (a[2] + a[3]) + (b[0] + b[1]), s1 = (b[2] + b[3]) + (c[0] + c[1]) + (c[2] + c[3]), s2 = (d[0] + d[1]) + (d[2] + d[3]);
    r_ssd = rsqrtf(s0 * (1.f / 384.f) + EPS); r_sb = rsqrtf(s1 * (1.f / 384.f) + EPS); r_mem = rsqrtf(s2 * (1.f / 256.f) + EPS);
}
struct EpiOut {
    static constexpr bool PERM = false, AFTER_DRAIN = false, KHOOK = true;
    const float* base; float* out; bf16_t* xb; float* xssq; const PG8_LAS float* gtab;
    __device__ __forceinline__ void khook(f32x4 (&acc)[2][2][4][2], const Unit& u, int t, int wr, int fr) const {
        if (t != 6 && t != 12) return;
#pragma unroll
        for (int ai = 0; ai < 2; ++ai)
#pragma unroll
            for (int m = 0; m < 4; ++m) {
                const float f = gtab[(t == 6 ? 0 : 256) + ai * HALF + wr * 64 + m * 16 + fr];
#pragma unroll
                for (int bj = 0; bj < 2; ++bj)
#pragma unroll
                    for (int n = 0; n < 2; ++n) acc[ai][bj][m][n] = acc[ai][bj][m][n] * f;
            }
    }
    __device__ __forceinline__ void operator()(const f32x4 (&acc)[2][2][4][2], const Unit& u, int wr, int wc, int fr, int fq) const {
        const int col0 = u.pn * BM + wc * 32 + 4 * fq;
#pragma unroll
        for (int ai = 0; ai < 2; ++ai)
#pragma unroll
            for (int m = 0; m < 4; ++m) {
                const int row = u.pm * BM + ai * HALF + wr * 64 + m * 16 + fr; const float r2 = gtab[512 + ai * HALF + wr * 64 + m * 16 + fr];
                float q = 0.f;
#pragma unroll
                for (int bj = 0; bj < 2; ++bj)
#pragma unroll
                    for (int n = 0; n < 2; ++n) {
                        const size_t off = (size_t)row * D + col0 + bj * HALF + n * 16;
                        const f32x4 x1 = *(const f32x4*)(base + off) + acc[ai][bj][m][n] * r2;
                        *(f32x4*)(out + off) = x1;
                        typedef unsigned u32x2v __attribute__((ext_vector_type(2)));
                        u32x2v w; w.x = cvt_pk_bf16(x1[0], x1[1]); w.y = cvt_pk_bf16(x1[2], x1[3]); *(u32x2v*)(xb + off) = w;
                        q += (x1[0] * x1[0] + x1[1] * x1[1]) + (x1[2] * x1[2] + x1[3] * x1[3]);
                    }
                q += __shfl_xor(q, 16); q += __shfl_xor(q, 32);
                if (fq == 0) xssq[(size_t)row * 16 + u.pn * 4 + wc] = q;
            }
    }
};
struct EpiScores {
    static constexpr bool PERM = false, AFTER_DRAIN = false, KHOOK = false;
    float* O; const float* xssq;
    __device__ __forceinline__ void operator()(const f32x4 (&acc)[2][2][4][2], const Unit& u, int wr, int wc, int fr, int fq) const {
        const int col0 = u.pn * BM + wc * 32 + 4 * fq;
#pragma unroll
        for (int ai = 0; ai < 2; ++ai)
#pragma unroll
            for (int m = 0; m < 4; ++m) {
                const int row = u.pm * BM + ai * HALF + wr * 64 + m * 16 + fr;
                const f32x4 a = *(const f32x4*)(xssq + (size_t)row * 16), b = *(const f32x4*)(xssq + (size_t)row * 16 + 4), c = *(const f32x4*)(xssq + (size_t)row * 16 + 8), d = *(const f32x4*)(xssq + (size_t)row * 16 + 12);
                const float ss = ((a[0] + a[1]) + (a[2] + a[3])) + ((b[0] + b[1]) + (b[2] + b[3])) + ((c[0] + c[1]) + (c[2] + c[3])) + ((d[0] + d[1]) + (d[2] + d[3]));
                const float r = rsqrtf(ss * (1.f / 1024.f) + EPS);
#pragma unroll
                for (int bj = 0; bj < 2; ++bj)
#pragma unroll
                    for (int n = 0; n < 2; ++n) *(f32x4*)(O + (size_t)row * 2048 + col0 + bj * HALF + n * 16) = acc[ai][bj][m][n] * r;
            }
    }
};
}

struct Args { const float* in[22]; float* out; unsigned char* ws; int ph_lo, ph_hi, li, pad; };
enum { I_X = 0, I_MEM, I_NORM1G, I_WIN, I_CONVW, I_CONVB, I_DTBIAS, I_ALOG, I_DSKIP, I_SSDG, I_SBG, I_MEMNG, I_WMEMKV, I_MQG, I_MKG, I_MEMOG, I_WOUT, I_NORM2G, I_WQ, I_KEYS, I_PU, I_PV };

__device__ __forceinline__ int opq(int i) { asm volatile("" : "+s"(i)); return i; }
#define AIN(i) (a.in[opq(i)])
__device__ __forceinline__ void transpose_item(const float* W, int ldw, int src_c0, int nvalid, const float* g, bf16* WT, int K, int dst_r0, int k0, LAS float* scr, int lane) {
    const int c = lane & 31;
#pragma unroll 8
    for (int i = 0; i < 32; ++i) {
        const int kk = 2 * i + (lane >> 5);
        float v = (c < nvalid) ? W[(size_t)(k0 + kk) * ldw + src_c0 + c] : 0.f;
        if (g) v *= g[k0 + kk];
        scr[kk * 33 + c] = v;
    }
    LDS_WAIT(); asm volatile("" ::: "memory");
    const int c8 = lane & 7;
#pragma unroll
    for (int j = 0; j < 4; ++j) {
        const int n = (lane >> 3) + 8 * j; const LAS float* s = scr + (8 * c8) * 33 + n;
        v4u o; o.x = pkbf(s[0 * 33], s[1 * 33]); o.y = pkbf(s[2 * 33], s[3 * 33]); o.z = pkbf(s[4 * 33], s[5 * 33]); o.w = pkbf(s[6 * 33], s[7 * 33]);
        *(GAS v4u*)(WT + (size_t)(dst_r0 + n) * K + k0 + 8 * c8) = o;
    }
    LDS_WAIT(); asm volatile("" ::: "memory");
}
__device__ __forceinline__ void wsc_item(const float* wq, const float* keys, const float* g2, bf16* WscT, int hc, int kb, int nq, LAS float* scr, int lane) {
    const int k0 = kb * 64;
#pragma unroll 8
    for (int kk = 0; kk < 64; ++kk) scr[kk * 64 + ((lane + kk) & 63)] = wq[(size_t)(k0 + kk) * D + hc * 64 + lane] * g2[k0 + kk];
    LDS_WAIT(); asm volatile("" ::: "memory");
    for (int n = nq * 32; n < nq * 32 + 32; ++n) {
        const float* kp = keys + ((size_t)hc * 128 + n) * 64;
        float a = 0.f;
#pragma unroll
        for (int d = 0; d < 64; ++d) a += scr[lane * 64 + ((d + lane) & 63)] * kp[d];
        WscT[(size_t)(hc * 128 + n) * D + k0 + lane] = (bf16)(pkbf(a, 0.f) & 0xffffu);
    }
    LDS_WAIT(); asm volatile("" ::: "memory");
}
__device__ __forceinline__ void row_to_bf16(const float* xrow, bf16* orow, float* rs, int lane) {
    const GAS f32x4* xr = (const GAS f32x4*)xrow + lane;
    f32x4 v[4]; float s = 0.f;
#pragma unroll
    for (int j = 0; j < 4; ++j) { v[j] = xr[64 * j]; s += (v[j].x * v[j].x + v[j].y * v[j].y) + (v[j].z * v[j].z + v[j].w * v[j].w); }
    s = wave_sum(s);
    GAS unsigned long long* o8 = (GAS unsigned long long*)orow + lane;
#pragma unroll
    for (int j = 0; j < 4; ++j) o8[64 * j] = (unsigned long long)pkbf(v[j].x, v[j].y) | ((unsigned long long)pkbf(v[j].z, v[j].w) << 32);
    if (lane == 0) *rs = rsqrtf(s * (1.f / 1024.f) + EPS);
}
__device__ __forceinline__ void ph_prologue(const Args& a, unsigned char* ws, LAS unsigned char* lds, int gw, int NGW, int wave, int lane) {
    LAS float* scr = (LAS float*)(lds + wave * 16384);
    constexpr int I_IN = 80 * 16, I_MEMW = 16 * 16, I_OUT = 32 * 16, I_SC = 16 * 16 * 4, PER_L = I_IN + I_MEMW + I_OUT + I_SC;
    constexpr int NW_ITEMS = NL * PER_L, NITEMS = NW_ITEMS + T + MROWS + 2 * NL * 16384;
    for (int it = gw; it < NITEMS; it += NGW) {
        if (it < NW_ITEMS) {
            const int l = it / PER_L; int r = it % PER_L;
            if (r < I_IN) {
                const int j = r / 16, kb = r % 16;
                const int src = (j < 32) ? 32 * j : (j < 76 ? 32 * j + 6 : 1024), nv = (j < 76) ? 32 : (j == 76 ? 6 : 0);
                transpose_item(AIN(I_WIN) + (size_t)l * D * DIN, DIN, src, nv, AIN(I_NORM1G) + l * D, (bf16*)(ws + WS_WIN) + (size_t)l * NPROJ * D, D, 32 * j, 64 * kb, scr, lane);
                continue;
            }
            r -= I_IN;
            if (r < I_MEMW) {
                const int j = r / 16, kb = r % 16;
                transpose_item(AIN(I_WMEMKV) + (size_t)l * D * 512, 512, 32 * j, 32, AIN(I_MEMNG) + l * D, (bf16*)(ws + WS_WMEM) + (size_t)l * 512 * D, D, 32 * j, 64 * kb, scr, lane);
                continue;
            }
            r -= I_MEMW;
            if (r < I_OUT) {
                const int j = r / 16, kb = r % 16;
                const float* g = (kb < 6) ? AIN(I_SSDG) + l * 384 : (kb < 12 ? AIN(I_SBG) + l * 384 - 384 : AIN(I_MEMOG) + l * 256 - 768);
                transpose_item(AIN(I_WOUT) + (size_t)l * D * D, D, 32 * j, 32, g, (bf16*)(ws + WS_WOUT) + (size_t)l * D * D, D, 32 * j, 64 * kb, scr, lane);
                continue;
            }
            r -= I_OUT;
            { const int nq = r & 3, kb = (r >> 2) & 15, hc = r >> 6;
              wsc_item(AIN(I_WQ) + (size_t)l * D * D, AIN(I_KEYS) + (size_t)l * 16 * 128 * 64, AIN(I_NORM2G) + l * D, (bf16*)(ws + WS_WSC) + (size_t)l * 2048 * D, hc, kb, nq, scr, lane); }
            continue;
        }
        int r = it - NW_ITEMS;
        if (r < T) { row_to_bf16(AIN(I_X) + (size_t)r * D, (bf16*)(ws + WS_XB) + (size_t)r * D, (float*)(ws + WS_RS1) + r, lane); continue; }
        r -= T;
        if (r < MROWS) { row_to_bf16(AIN(I_MEM) + (size_t)r * D, (bf16*)(ws + WS_MEMB) + (size_t)r * D, (float*)(ws + WS_RSM) + r, lane); continue; }
        r -= MROWS;
        { const int tb = r >> 15, e = r & 32767;
          const float* src = (tb == 0 ? AIN(I_PU) : AIN(I_PV)) + (size_t)e * D; bf16* dst = (bf16*)(ws + (tb == 0 ? WS_UT : WS_VT)) + (size_t)e * D;
          const float* g = AIN(I_NORM2G) + (e >> 14) * D;
#pragma unroll
          for (int j = 0; j < 4; ++j) { f32x4 v = *((const GAS f32x4*)src + 64 * j + lane); if (tb == 0) v = v * *((const GAS f32x4*)g + 64 * j + lane);
              *((GAS unsigned long long*)dst + 64 * j + lane) = (unsigned long long)pkbf(v.x, v.y) | ((unsigned long long)pkbf(v.z, v.w) << 32); } }
    }
}

__device__ __forceinline__ void sb_item_naive(int b, int h, int qb, const bf16* proj, bf16* ycat, float* yssq, int lane) {
    const int s_q = qb * 64 + lane; const size_t tq = (size_t)b * S + s_q;
    float q[64], o[64];
#pragma unroll
    for (int d = 0; d < 64; ++d) { q[d] = bf2f(proj[tq * NPROJ + PC_QSB + h * 64 + d]) * 0.125f; o[d] = 0.f; }
    float R = 0.f;
    for (int s = qb * 64 + 62; s >= 0; --s) {
        const bf16* kp = proj + ((size_t)b * S + s) * NPROJ + PC_KSB + h * 64;
        const bf16* vp = proj + ((size_t)b * S + s) * NPROJ + PC_VSB + h * 64;
        float z = 0.f;
#pragma unroll
        for (int d = 0; d < 64; ++d) z += q[d] * bf2f(kp[d]);
        if (s < s_q) {
            const float l1p = log1pf(expf(-fabsf(z)));
            const float lb = fminf(z, 0.f) - l1p, lk = fminf(-z, 0.f) - l1p;
            const float w = expf(lb + R);
            R += lk;
#pragma unroll
            for (int d = 0; d < 64; ++d) o[d] += w * bf2f(vp[d]);
        }
    }
    float ss = 0.f;
#pragma unroll
    for (int d = 0; d < 64; d += 2) { ss += o[d] * o[d] + o[d + 1] * o[d + 1]; *(unsigned*)(ycat + tq * D + 384 + h * 64 + d) = pkbf(o[d], o[d + 1]); }
    yssq[tq * 16 + 6 + h] = ss;
}
__device__ __forceinline__ void mem_item_naive(int tb, int h, const bf16* proj, const bf16* memkv, const float* qg, const float* kg, bf16* ycat, float* yssq, int lane) {
    const int t = tb * 64 + lane, b = t / S;
    float q[64], o[64]; float ss = 0.f;
#pragma unroll
    for (int d = 0; d < 64; ++d) { q[d] = bf2f(proj[(size_t)t * NPROJ + PC_QMEM + h * 64 + d]); ss += q[d] * q[d]; o[d] = 0.f; }
    const float r = rsqrtf(ss * (1.f / 64.f) + EPS) * 0.125f;
#pragma unroll
    for (int d = 0; d < 64; ++d) q[d] = q[d] * r * qg[d] * kg[d];
    float mx = -INFINITY, l = 0.f;
    for (int m = 0; m < NMEM; ++m) {
        const bf16* kp = memkv + ((size_t)b * NMEM + m) * 512 + h * 64;
        const bf16* vp = kp + 256;
        float sc = 0.f, kk = 0.f;
#pragma unroll
        for (int d = 0; d < 64; ++d) { const float kv = bf2f(kp[d]); sc += q[d] * kv; kk += kv * kv; }
        sc *= rsqrtf(kk * (1.f / 64.f) + EPS);
        const float mn = fmaxf(mx, sc), corr = expf(mx - mn), p = expf(sc - mn);
        l = l * corr + p;
#pragma unroll
        for (int d = 0; d < 64; ++d) o[d] = o[d] * corr + p * bf2f(vp[d]);
        mx = mn;
    }
    const float il = 1.f / l; float s2 = 0.f;
#pragma unroll
    for (int d = 0; d < 64; d += 2) { const float a0 = o[d] * il, a1 = o[d + 1] * il; s2 += a0 * a0 + a1 * a1; *(unsigned*)(ycat + (size_t)t * D + 768 + h * 64 + d) = pkbf(a0, a1); }
    yssq[(size_t)t * 16 + 12 + h] = s2;
}
__device__ __forceinline__ void ph_mix_naive(const Args& a, unsigned char* ws, int l, int gw, int NGW, int lane) {
    const bf16* proj = (const bf16*)(ws + WS_PROJ); bf16* ycat = (bf16*)(ws + WS_YCAT); float* yssq = (float*)(ws + WS_YSSQ);
    constexpr int N_SB = 24 * 64, N_MEM = 256 * 4;
    for (int it = gw; it < N_SB + N_MEM; it += NGW) {
        int r = it;
        if (r < N_SB) { const int qb = 63 - r / 24, bh = r % 24; sb_item_naive(bh / 6, bh % 6, qb, proj, ycat, yssq, lane); continue; }
        r -= N_SB;
        mem_item_naive(r >> 2, r & 3, proj, (const bf16*)(ws + WS_MEMKV), AIN(I_MQG) + l * 64, AIN(I_MKG) + l * 64, ycat, yssq, lane);
    }
}

typedef __attribute__((ext_vector_type(8))) __bf16 bf8_t;
typedef __attribute__((ext_vector_type(8))) float f32x8;
typedef __attribute__((ext_vector_type(8))) short s16x8;
typedef __attribute__((ext_vector_type(4))) short s16x4;
typedef __attribute__((ext_vector_type(16))) float f32x16;
typedef unsigned u32x2 __attribute__((ext_vector_type(2)));
#define MFMA32(a, b, c) __builtin_amdgcn_mfma_f32_32x32x16_bf16((a), (b), (c), 0, 0, 0)
__device__ __forceinline__ int crow(int i, int h) { return (i & 3) + 8 * (i >> 2) + 4 * h; }
__device__ __forceinline__ s16x8 cvt8(const f32x8 x) { return __builtin_bit_cast(s16x8, __builtin_convertvector(x, bf8_t)); }
__device__ __forceinline__ s16x8 pack_acc(const f32x16& x, int s) { f32x8 v;
#pragma unroll
    for (int j = 0; j < 8; ++j) v[j] = x[8 * s + j];
    return cvt8(v); }
__device__ __forceinline__ s16x8 cat4(const s16x4 lo, const s16x4 hi) { return __builtin_shufflevector(lo, hi, 0, 1, 2, 3, 4, 5, 6, 7); }
__device__ __forceinline__ f32x16 zero16() { f32x16 z;
#pragma unroll
    for (int i = 0; i < 16; ++i) z[i] = 0.f;
    return z; }
constexpr int L_BM = 0, L_CM = 18432, L_BMT = 36864, L_XDT = 54272, L_ACS = 106496, L_DT = 108032, L_TOT = 109568;

__device__ __forceinline__ void ssd_chunk_unit(const Args& a, unsigned char* ws, LAS unsigned char* lds, int l_, int unit, int tid, int wave, int lane) {
    const int g = unit & 1, c = (unit >> 1) & 31, b = unit >> 6, t0 = b * S + c * 128;
    const bf16* proj = (const bf16*)(ws + WS_PROJ); const float* dtf = (const float*)(ws + WS_DTF);
    LAS float* acs = (LAS float*)(lds + L_ACS); LAS float* dts = (LAS float*)(lds + L_DT); LAS float* tot = (LAS float*)(lds + L_TOT);
    float cs = 0.f, dtv = 0.f;
    if (wave < 6) {
        const int hh = wave >> 1, l = (wave & 1) * 64 + lane;
        dtv = dtf[(size_t)(t0 + l) * 8 + 3 * g + hh];
        cs = dtv * -expf(AIN(I_ALOG)[l_ * 6 + 3 * g + hh]);
#pragma unroll
        for (int o = 1; o < 64; o <<= 1) { const float t = __shfl_up(cs, o); if (lane >= o) cs += t; }
        if (lane == 63) tot[wave] = cs;
    }
    __syncthreads();
    if (wave < 6) {
        const int hh = wave >> 1, l = (wave & 1) * 64 + lane;
        if (wave & 1) cs += tot[wave - 1];
        acs[hh * 128 + l] = cs; dts[hh * 128 + l] = dtv;
        ((float*)(ws + WS_ACSG))[(size_t)(t0 + l) * 8 + 3 * g + hh] = cs;
    }
    __syncthreads();
    const float* cw = AIN(I_CONVW) + l_ * 4 * CONV_CH; const float* cb = AIN(I_CONVB) + l_ * CONV_CH;
#pragma unroll 2
    for (int it = 0; it < 10; ++it) {
        const int idx = tid + 512 * it, l = idx / 40, ck = idx % 40;
        int cc, kind, hh = 0, e0;
        if (ck < 24) { hh = ck >> 3; e0 = (ck & 7) * 8; cc = (3 * g + hh) * 64 + e0; kind = 0; }
        else if (ck < 32) { e0 = (ck - 24) * 8; cc = 384 + g * 64 + e0; kind = 1; }
        else { e0 = (ck - 32) * 8; cc = 512 + g * 64 + e0; kind = 2; }
        float acc[8];
        { const f32x4 b0 = *(const f32x4*)(cb + cc), b1 = *(const f32x4*)(cb + cc + 4); acc[0] = b0.x; acc[1] = b0.y; acc[2] = b0.z; acc[3] = b0.w; acc[4] = b1.x; acc[5] = b1.y; acc[6] = b1.z; acc[7] = b1.w; }
#pragma unroll
        for (int k = 0; k < 4; ++k) {
            const int sl = c * 128 + l - 3 + k;
            if (sl >= 0) {
                const v4u xv = *(const GAS v4u*)(proj + (size_t)(t0 + l - 3 + k) * NPROJ + PC_XBC + cc);
                const f32x4 w0 = *(const f32x4*)(cw + k * CONV_CH + cc), w1 = *(const f32x4*)(cw + k * CONV_CH + cc + 4);
                acc[0] += w0.x * __uint_as_float(xv.x << 16); acc[1] += w0.y * __uint_as_float(xv.x & 0xffff0000u);
                acc[2] += w0.z * __uint_as_float(xv.y << 16); acc[3] += w0.w * __uint_as_float(xv.y & 0xffff0000u);
                acc[4] += w1.x * __uint_as_float(xv.z << 16); acc[5] += w1.y * __uint_as_float(xv.z & 0xffff0000u);
                acc[6] += w1.z * __uint_as_float(xv.w << 16); acc[7] += w1.w * __uint_as_float(xv.w & 0xffff0000u);
            }
        }
#pragma unroll
        for (int e = 0; e < 8; ++e) acc[e] = silu_f(acc[e]);
        v4u pk; pk.x = pkbf(acc[0], acc[1]); pk.y = pkbf(acc[2], acc[3]); pk.z = pkbf(acc[4], acc[5]); pk.w = pkbf(acc[6], acc[7]);
        if (kind == 0) {
            *(GAS v4u*)((bf16*)(ws + WS_XCONV) + (size_t)(t0 + l) * 384 + (3 * g + hh) * 64 + e0) = pk;
            const float d = dts[hh * 128 + l];
            LAS bf16* xd = (LAS bf16*)(lds + L_XDT) + (hh * 64 + e0) * 136 + l;
#pragma unroll
            for (int e = 0; e < 8; e += 2) { const unsigned w = pkbf(acc[e] * d, acc[e + 1] * d); xd[e * 136] = (bf16)(w & 0xffffu); xd[(e + 1) * 136] = (bf16)(w >> 16); }
        } else if (kind == 1) {
            *(LAS v4u*)(lds + L_BM + (l * 72 + e0) * 2) = pk;
            LAS bf16* bt = (LAS bf16*)(lds + L_BMT) + e0 * 136 + l;
            bt[0 * 136] = (bf16)(pk.x & 0xffffu); bt[1 * 136] = (bf16)(pk.x >> 16); bt[2 * 136] = (bf16)(pk.y & 0xffffu); bt[3 * 136] = (bf16)(pk.y >> 16);
            bt[4 * 136] = (bf16)(pk.z & 0xffffu); bt[5 * 136] = (bf16)(pk.z >> 16); bt[6 * 136] = (bf16)(pk.w & 0xffffu); bt[7 * 136] = (bf16)(pk.w >> 16);
        } else {
            *(LAS v4u*)(lds + L_CM + (l * 72 + e0) * 2) = pk;
            *(GAS v4u*)((bf16*)(ws + WS_CMG) + (size_t)(t0 + l) * 128 + g * 64 + e0) = pk;
        }
    }
    __syncthreads();
    const int r = lane & 31, h = lane >> 5, lb = wave & 3, pt = wave >> 2;
    {
        s16x8 cf[4];
#pragma unroll
        for (int ks = 0; ks < 4; ++ks) cf[ks] = *(const LAS s16x8*)(lds + L_CM + ((lb * 32 + r) * 72 + ks * 16 + 8 * h) * 2);
        f32x16 gt[4];
#pragma unroll
        for (int sb = 0; sb < 4; ++sb) {
            gt[sb] = zero16();
            if (sb <= lb) {
#pragma unroll
                for (int ks = 0; ks < 4; ++ks) gt[sb] = MFMA32(*(const LAS s16x8*)(lds + L_BM + ((sb * 32 + r) * 72 + ks * 16 + 8 * h) * 2), cf[ks], gt[sb]);
            }
        }
#pragma unroll
        for (int hh = 0; hh < 3; ++hh) {
            const float al = acs[hh * 128 + lb * 32 + r];
            f32x16 yacc = zero16();
#pragma unroll
            for (int sb = 0; sb < 4; ++sb) {
                if (sb <= lb) {
                    f32x16 m;
#pragma unroll
                    for (int i = 0; i < 16; ++i) {
                        const int sl = crow(i, h);
                        const float v = gt[sb][i] * __expf(al - acs[hh * 128 + sb * 32 + sl]);
                        m[i] = (sb < lb || sl <= r) ? v : 0.f;
                    }
#pragma unroll
                    for (int ks = 0; ks < 2; ++ks) {
                        const LAS unsigned char* xp = lds + L_XDT + ((hh * 64 + pt * 32 + r) * 136 + sb * 32 + 16 * ks + 4 * h) * 2;
                        yacc = MFMA32(cat4(*(const LAS s16x4*)xp, *(const LAS s16x4*)(xp + 16)), pack_acc(m, ks), yacc);
                    }
                }
            }
            float* yp = (float*)(ws + WS_YPART) + (size_t)(t0 + lb * 32 + r) * 384 + (3 * g + hh) * 64 + pt * 32 + 4 * h;
#pragma unroll
            for (int i4 = 0; i4 < 4; ++i4) *(f32x4*)(yp + 8 * i4) = (f32x4){yacc[4 * i4], yacc[4 * i4 + 1], yacc[4 * i4 + 2], yacc[4 * i4 + 3]};
        }
    }
    for (int tl = wave; tl < 12; tl += 8) {
        const int hh = tl >> 2, nt = (tl >> 1) & 1, pt2 = tl & 1;
        const float alast = acs[hh * 128 + 127];
        f32x16 acc = zero16();
#pragma unroll
        for (int ks = 0; ks < 8; ++ks) {
            const s16x8 af = *(const LAS s16x8*)(lds + L_BMT + ((nt * 32 + r) * 136 + ks * 16 + 8 * h) * 2);
            const v4u xr = *(const LAS v4u*)(lds + L_XDT + ((hh * 64 + pt2 * 32 + r) * 136 + ks * 16 + 8 * h) * 2);
            const LAS float* ap = acs + hh * 128 + ks * 16 + 8 * h;
            f32x8 xf;
            xf[0] = __uint_as_float(xr.x << 16) * __expf(alast - ap[0]); xf[1] = __uint_as_float(xr.x & 0xffff0000u) * __expf(alast - ap[1]);
            xf[2] = __uint_as_float(xr.y << 16) * __expf(alast - ap[2]); xf[3] = __uint_as_float(xr.y & 0xffff0000u) * __expf(alast - ap[3]);
            xf[4] = __uint_as_float(xr.z << 16) * __expf(alast - ap[4]); xf[5] = __uint_as_float(xr.z & 0xffff0000u) * __expf(alast - ap[5]);
            xf[6] = __uint_as_float(xr.w << 16) * __expf(alast - ap[6]); xf[7] = __uint_as_float(xr.w & 0xffff0000u) * __expf(alast - ap[7]);
            acc = MFMA32(af, cvt8(xf), acc);
        }
        float* hp = (float*)(ws + WS_HS) + ((size_t)((b * 32 + c) * 6 + 3 * g + hh) * 64 + pt2 * 32 + r) * 64 + nt * 32 + 4 * h;
#pragma unroll
        for (int i4 = 0; i4 < 4; ++i4) *(f32x4*)(hp + 8 * i4) = (f32x4){acc[4 * i4], acc[4 * i4 + 1], acc[4 * i4 + 2], acc[4 * i4 + 3]};
    }
    if (tid < 3) ((float*)(ws + WS_CD))[(b * 32 + c) * 6 + 3 * g + tid] = __expf(acs[tid * 128 + 127]);
    __syncthreads();
}
__device__ __forceinline__ void ph_ssd_scan(unsigned char* ws, int bx, int G, int tid) {
    float* hs = (float*)(ws + WS_HS); const float* cd = (const float*)(ws + WS_CD);
    for (int e = bx * 512 + tid; e < 24 * 4096; e += G * 512) {
        const int bh = e >> 12, el = e & 4095, b = bh / 6, hh = bh % 6;
        float run = 0.f;
#pragma unroll 4
        for (int c = 0; c < 32; ++c) {
            const int idx = (b * 32 + c) * 6 + hh;
            const float v = hs[(size_t)idx * 4096 + el], d = cd[idx];
            hs[(size_t)idx * 4096 + el] = run; run = run * d + v;
        }
    }
}
__device__ __forceinline__ void ssd_finish_unit(const Args& a, unsigned char* ws, int l_, int unit, int wave, int lane) {
    const int g = unit & 1, c = (unit >> 1) & 31, b = unit >> 6, t0 = b * S + c * 128;
    const int r = lane & 31, h = lane >> 5, lb = wave & 3, hsel = wave >> 2;
    const int t = t0 + lb * 32 + r;
    const bf16* proj = (const bf16*)(ws + WS_PROJ); const bf16* cmg = (const bf16*)(ws + WS_CMG) + (size_t)t * 128 + g * 64;
    s16x8 cf[4];
#pragma unroll
    for (int ks = 0; ks < 4; ++ks) cf[ks] = *(const GAS s16x8*)(cmg + ks * 16 + 8 * h);
    for (int hh = hsel ? 2 : 0; hh < (hsel ? 3 : 2); ++hh) {
        const int hd = 3 * g + hh;
        const float* hin = (const float*)(ws + WS_HS) + (size_t)((b * 32 + c) * 6 + hd) * 4096;
        const float ea = __expf(((const float*)(ws + WS_ACSG))[(size_t)t * 8 + hd]), dsk = AIN(I_DSKIP)[l_ * 6 + hd];
        float ssq = 0.f;
#pragma unroll
        for (int pt = 0; pt < 2; ++pt) {
            f32x16 acc = zero16();
#pragma unroll
            for (int ks = 0; ks < 4; ++ks) {
                const float* hp = hin + (pt * 32 + r) * 64 + ks * 16 + 8 * h;
                const f32x4 h0 = *(const GAS f32x4*)hp, h1 = *(const GAS f32x4*)(hp + 4);
                acc = MFMA32(cvt8((f32x8){h0.x, h0.y, h0.z, h0.w, h1.x, h1.y, h1.z, h1.w}), cf[ks], acc);
            }
#pragma unroll
            for (int i4 = 0; i4 < 4; ++i4) {
                const int col = hd * 64 + pt * 32 + 8 * i4 + 4 * h;
                const f32x4 yp = *(const GAS f32x4*)((const float*)(ws + WS_YPART) + (size_t)t * 384 + col);
                const u32x2 xc = *(const GAS u32x2*)((const bf16*)(ws + WS_XCONV) + (size_t)t * 384 + col);
                const u32x2 zz = *(const GAS u32x2*)(proj + (size_t)t * NPROJ + PC_Z + col);
                const float y0 = (yp.x + acc[4 * i4 + 0] * ea + dsk * __uint_as_float(xc.x << 16)) * silu_f(__uint_as_float(zz.x << 16));
                const float y1 = (yp.y + acc[4 * i4 + 1] * ea + dsk * __uint_as_float(xc.x & 0xffff0000u)) * silu_f(__uint_as_float(zz.x & 0xffff0000u));
                const float y2 = (yp.z + acc[4 * i4 + 2] * ea + dsk * __uint_as_float(xc.y << 16)) * silu_f(__uint_as_float(zz.y << 16));
                const float y3 = (yp.w + acc[4 * i4 + 3] * ea + dsk * __uint_as_float(xc.y & 0xffff0000u)) * silu_f(__uint_as_float(zz.y & 0xffff0000u));
                ssq += (y0 * y0 + y1 * y1) + (y2 * y2 + y3 * y3);
                u32x2 w; w.x = pkbf(y0, y1); w.y = pkbf(y2, y3);
                *(GAS u32x2*)((bf16*)(ws + WS_YCAT) + (size_t)t * D + col) = w;
            }
        }
        ssq += __shfl_xor(ssq, 32);
        if (h == 0) ((float*)(ws + WS_YSSQ))[(size_t)t * 16 + hd] = ssq;
    }
}

#define LOG2E 1.4426950408889634f
__device__ __forceinline__ s16x8 trv_frag(const LAS unsigned char* vimg, int key0, int ks, int dt, int lane) {
    const int h = lane >> 5, i16 = lane & 15, blk = (lane >> 4) & 1;
    const LAS unsigned char* p = vimg + (key0 + 16 * ks + 4 * h + (i16 >> 2)) * 144 + (dt * 32 + 16 * blk) * 2 + 8 * (i16 & 3);
    const s16x4 lo = __builtin_amdgcn_ds_read_tr16_b64_v4i16((LAS s16x4*)p), hi = __builtin_amdgcn_ds_read_tr16_b64_v4i16((LAS s16x4*)(p + 8 * 144));
    return cat4(lo, hi);
}
__device__ __forceinline__ void mem_unit(const Args& a, unsigned char* ws, LAS unsigned char* lds, int l_, int b, int hd, int qb, int tid, int wave, int lane) {
    const bf16* proj = (const bf16*)(ws + WS_PROJ); const bf16* memkv = (const bf16*)(ws + WS_MEMKV);
    const float* qg = AIN(I_MQG) + l_ * 64; const float* kg = AIN(I_MKG) + l_ * 64;
    LAS unsigned char* kimg = lds; LAS unsigned char* vimg = lds + 36864;
#pragma unroll
    for (int it = 0; it < 4; ++it) {
        const int idx = tid + 512 * it, m = idx >> 3, ch = idx & 7;
        const v4u kv = *(const GAS v4u*)(memkv + (size_t)(b * NMEM + m) * 512 + hd * 64 + ch * 8);
        const v4u vv = *(const GAS v4u*)(memkv + (size_t)(b * NMEM + m) * 512 + 256 + hd * 64 + ch * 8);
        float kf[8] = {__uint_as_float(kv.x << 16), __uint_as_float(kv.x & 0xffff0000u), __uint_as_float(kv.y << 16), __uint_as_float(kv.y & 0xffff0000u),
                       __uint_as_float(kv.z << 16), __uint_as_float(kv.z & 0xffff0000u), __uint_as_float(kv.w << 16), __uint_as_float(kv.w & 0xffff0000u)};
        float ss = 0.f;
#pragma unroll
        for (int e = 0; e < 8; ++e) ss += kf[e] * kf[e];
        ss += __shfl_xor(ss, 1); ss += __shfl_xor(ss, 2); ss += __shfl_xor(ss, 4);
        const float rk = rsqrtf(ss * (1.f / 64.f) + EPS);
        const f32x4 g0 = *(const f32x4*)(kg + ch * 8), g1 = *(const f32x4*)(kg + ch * 8 + 4);
        v4u pk; pk.x = pkbf(kf[0] * rk * g0.x, kf[1] * rk * g0.y); pk.y = pkbf(kf[2] * rk * g0.z, kf[3] * rk * g0.w); pk.z = pkbf(kf[4] * rk * g1.x, kf[5] * rk * g1.y); pk.w = pkbf(kf[6] * rk * g1.z, kf[7] * rk * g1.w);
        *(LAS v4u*)(kimg + (m * 72 + ch * 8) * 2) = pk;
        *(LAS v4u*)(vimg + (m * 72 + ch * 8) * 2) = vv;
    }
    __syncthreads();
    const int r = lane & 31, h = lane >> 5;
    const int t = b * S + qb * 256 + wave * 32 + r;
    s16x8 qf[4];
    {
        f32x8 qv[4]; float ss = 0.f;
#pragma unroll
        for (int ks = 0; ks < 4; ++ks) {
            const v4u q = *(const GAS v4u*)(proj + (size_t)t * NPROJ + PC_QMEM + hd * 64 + ks * 16 + 8 * h);
            qv[ks] = (f32x8){__uint_as_float(q.x << 16), __uint_as_float(q.x & 0xffff0000u), __uint_as_float(q.y << 16), __uint_as_float(q.y & 0xffff0000u),
                             __uint_as_float(q.z << 16), __uint_as_float(q.z & 0xffff0000u), __uint_as_float(q.w << 16), __uint_as_float(q.w & 0xffff0000u)};
#pragma unroll
            for (int e = 0; e < 8; ++e) ss += qv[ks][e] * qv[ks][e];
        }
        ss += __shfl_xor(ss, 32);
        const float rq = rsqrtf(ss * (1.f / 64.f) + EPS) * (0.125f * LOG2E);
#pragma unroll
        for (int ks = 0; ks < 4; ++ks) {
            const f32x4 g0 = *(const f32x4*)(qg + ks * 16 + 8 * h), g1 = *(const f32x4*)(qg + ks * 16 + 8 * h + 4);
            qf[ks] = cvt8(qv[ks] * rq * (f32x8){g0.x, g0.y, g0.z, g0.w, g1.x, g1.y, g1.z, g1.w});
        }
    }
    f32x16 st[8];
    float mx = -INFINITY;
#pragma unroll
    for (int kt = 0; kt < 8; ++kt) {
        st[kt] = zero16();
#pragma unroll
        for (int ks = 0; ks < 4; ++ks) st[kt] = MFMA32(*(const LAS s16x8*)(kimg + ((kt * 32 + r) * 72 + ks * 16 + 8 * h) * 2), qf[ks], st[kt]);
#pragma unroll
        for (int i = 0; i < 16; ++i) mx = fmaxf(mx, st[kt][i]);
    }
    mx = fmaxf(mx, __shfl_xor(mx, 32));
    float lsum = 0.f;
    f32x16 o0 = zero16(), o1 = zero16();
#pragma unroll
    for (int kt = 0; kt < 8; ++kt) {
#pragma unroll
        for (int i = 0; i < 16; ++i) { st[kt][i] = __builtin_amdgcn_exp2f(st[kt][i] - mx); lsum += st[kt][i]; }
#pragma unroll
        for (int ks = 0; ks < 2; ++ks) {
            const s16x8 pf = pack_acc(st[kt], ks);
            o0 = MFMA32(trv_frag(vimg, kt * 32, ks, 0, lane), pf, o0);
            o1 = MFMA32(trv_frag(vimg, kt * 32, ks, 1, lane), pf, o1);
        }
    }
    lsum += __shfl_xor(lsum, 32);
    const float il = 1.f / lsum; float ssq = 0.f;
    bf16* yc = (bf16*)(ws + WS_YCAT) + (size_t)t * D + 768 + hd * 64 + 4 * h;
#pragma unroll
    for (int i4 = 0; i4 < 4; ++i4) {
        const float a0 = o0[4 * i4] * il, a1 = o0[4 * i4 + 1] * il, a2 = o0[4 * i4 + 2] * il, a3 = o0[4 * i4 + 3] * il;
        const float b0 = o1[4 * i4] * il, b1 = o1[4 * i4 + 1] * il, b2 = o1[4 * i4 + 2] * il, b3 = o1[4 * i4 + 3] * il;
        ssq += (a0 * a0 + a1 * a1) + (a2 * a2 + a3 * a3) + (b0 * b0 + b1 * b1) + (b2 * b2 + b3 * b3);
        u32x2 w; w.x = pkbf(a0, a1); w.y = pkbf(a2, a3); *(GAS u32x2*)(yc + 8 * i4) = w;
        w.x = pkbf(b0, b1); w.y = pkbf(b2, b3); *(GAS u32x2*)(yc + 32 + 8 * i4) = w;
    }
    ssq += __shfl_xor(ssq, 32);
    if (h == 0) ((float*)(ws + WS_YSSQ))[(size_t)t * 16 + 12 + hd] = ssq;
    __syncthreads();
}
__device__ __forceinline__ void sb_unit(unsigned char* ws, LAS unsigned char* lds, int b, int hd, int qb, int tid, int wave, int lane) {
    const bf16* proj = (const bf16*)(ws + WS_PROJ);
    const int r = lane & 31, h = lane >> 5;
    const int q0w = qb * 256 + wave * 32, t = b * S + q0w + r;
    s16x8 qf[4];
#pragma unroll
    for (int ks = 0; ks < 4; ++ks) {
        const v4u q = *(const GAS v4u*)(proj + (size_t)t * NPROJ + PC_QSB + hd * 64 + ks * 16 + 8 * h);
        const f32x8 qv = (f32x8){__uint_as_float(q.x << 16), __uint_as_float(q.x & 0xffff0000u), __uint_as_float(q.y << 16), __uint_as_float(q.y & 0xffff0000u),
                                 __uint_as_float(q.z << 16), __uint_as_float(q.z & 0xffff0000u), __uint_as_float(q.w << 16), __uint_as_float(q.w & 0xffff0000u)};
        qf[ks] = cvt8(qv * (0.125f * LOG2E));
    }
    const int srow = tid >> 3, sch = tid & 7;
    const bf16* kbase = proj + (size_t)(b * S) * NPROJ + PC_KSB + hd * 64 + sch * 8;
    const int ktop = qb * 4 + 3;
    v4u kr = *(const GAS v4u*)(kbase + (size_t)(ktop * 64 + srow) * NPROJ), vr = *(const GAS v4u*)(kbase + (size_t)(ktop * 64 + srow) * NPROJ + (PC_VSB - PC_KSB));
    *(LAS v4u*)(lds + (srow * 72 + sch * 8) * 2) = kr; *(LAS v4u*)(lds + 9216 + (srow * 72 + sch * 8) * 2) = vr;
    __syncthreads();
    f32x16 o0 = zero16(), o1 = zero16();
    float R = 0.f;
    for (int kt = ktop; kt >= 0; --kt) {
        LAS unsigned char* kimg = lds + ((ktop - kt) & 1) * 18432; LAS unsigned char* vimg = kimg + 9216;
        if (kt > 0) { kr = *(const GAS v4u*)(kbase + (size_t)((kt - 1) * 64 + srow) * NPROJ); vr = *(const GAS v4u*)(kbase + (size_t)((kt - 1) * 64 + srow) * NPROJ + (PC_VSB - PC_KSB)); }
#pragma unroll
        for (int sub = 1; sub >= 0; --sub) {
            const int kb = kt * 64 + sub * 32;
            if (kb <= q0w) {
                const bool diag = (kb == q0w);
                f32x16 z = zero16();
#pragma unroll
                for (int ks = 0; ks < 4; ++ks) z = MFMA32(*(const LAS s16x8*)(kimg + ((sub * 32 + r) * 72 + ks * 16 + 8 * h) * 2), qf[ks], z);
                float lk[16];
#pragma unroll
                for (int i = 0; i < 16; ++i) {
                    const float sp = fmaxf(z[i], 0.f) + __builtin_amdgcn_logf(1.f + __builtin_amdgcn_exp2f(-fabsf(z[i])));
                    const bool ok = !diag || (crow(i, h) < r);
                    lk[i] = ok ? -sp : 0.f;
                    z[i] = ok ? z[i] : -INFINITY;
                }
                float g[4], pg[4];
#pragma unroll
                for (int j = 0; j < 4; ++j) { g[j] = (lk[4 * j] + lk[4 * j + 1]) + (lk[4 * j + 2] + lk[4 * j + 3]); pg[j] = __shfl_xor(g[j], 32); }
                float ab[4];
                ab[3] = R + (h == 0 ? pg[3] : 0.f);
#pragma unroll
                for (int j = 2; j >= 0; --j) ab[j] = ab[j + 1] + g[j + 1] + (h == 0 ? pg[j] : pg[j + 1]);
#pragma unroll
                for (int j = 0; j < 4; ++j) {
                    const float s3 = ab[j], s2 = s3 + lk[4 * j + 3], s1 = s2 + lk[4 * j + 2], s0 = s1 + lk[4 * j + 1];
                    z[4 * j + 3] = __builtin_amdgcn_exp2f(z[4 * j + 3] + lk[4 * j + 3] + s3);
                    z[4 * j + 2] = __builtin_amdgcn_exp2f(z[4 * j + 2] + lk[4 * j + 2] + s2);
                    z[4 * j + 1] = __builtin_amdgcn_exp2f(z[4 * j + 1] + lk[4 * j + 1] + s1);
                    z[4 * j + 0] = __builtin_amdgcn_exp2f(z[4 * j + 0] + lk[4 * j + 0] + s0);
                }
                R = ab[0] + g[0] + (h == 0 ? 0.f : pg[0]);
#pragma unroll
                for (int ks = 0; ks < 2; ++ks) {
                    const s16x8 pf = pack_acc(z, ks);
                    o0 = MFMA32(trv_frag(vimg, sub * 32, ks, 0, lane), pf, o0);
                    o1 = MFMA32(trv_frag(vimg, sub * 32, ks, 1, lane), pf, o1);
                }
            }
        }
        if (kt > 0) { LAS unsigned char* nimg = lds + ((ktop - kt + 1) & 1) * 18432; *(LAS v4u*)(nimg + (srow * 72 + sch * 8) * 2) = kr; *(LAS v4u*)(nimg + 9216 + (srow * 72 + sch * 8) * 2) = vr; }
        __syncthreads();
    }
    float ssq = 0.f;
    bf16* yc = (bf16*)(ws + WS_YCAT) + (size_t)t * D + 384 + hd * 64 + 4 * h;
#pragma unroll
    for (int i4 = 0; i4 < 4; ++i4) {
        const float a0 = o0[4 * i4], a1 = o0[4 * i4 + 1], a2 = o0[4 * i4 + 2], a3 = o0[4 * i4 + 3];
        const float b0 = o1[4 * i4], b1 = o1[4 * i4 + 1], b2 = o1[4 * i4 + 2], b3 = o1[4 * i4 + 3];
        ssq += (a0 * a0 + a1 * a1) + (a2 * a2 + a3 * a3) + (b0 * b0 + b1 * b1) + (b2 * b2 + b3 * b3);
        u32x2 w; w.x = pkbf(a0, a1); w.y = pkbf(a2, a3); *(GAS u32x2*)(yc + 8 * i4) = w;
        w.x = pkbf(b0, b1); w.y = pkbf(b2, b3); *(GAS u32x2*)(yc + 32 + 8 * i4) = w;
    }
    ssq += __shfl_xor(ssq, 32);
    if (h == 0) ((float*)(ws + WS_YSSQ))[(size_t)t * 16 + 6 + hd] = ssq;
}
constexpr int CW_Q = 8192;
__device__ __forceinline__ void ph_mix(const Args& a, unsigned char* ws, LAS unsigned char* lds, int l, int tid, int wave, int lane) {
    unsigned* head = (unsigned*)(ws + WS_CTL) + CW_Q + 64 * l;
    volatile LAS unsigned* slot = (volatile LAS unsigned*)(lds + MISC_OFF);
    for (int it = 0;; ++it) {
        if (tid == 0) slot[it & 1] = __hip_atomic_fetch_add(head, 1u, __ATOMIC_RELAXED, __HIP_MEMORY_SCOPE_AGENT);
        __syncthreads();
        const int n = (int)slot[it & 1];
        if (n >= 896) break;
        asm volatile("" : "+s"(ws), "+v"(tid));
        lane = tid & 63; wave = __builtin_amdgcn_readfirstlane(tid >> 6);
        if (n < 384) { const int qb = 15 - n / 24, bh = n % 24; sb_unit(ws, lds, bh / 6, bh % 6, qb, tid, wave, lane); }
        else if (n < 640) { const int m = n - 384; mem_unit(a, ws, lds, l, m >> 6, (m >> 4) & 3, m & 15, tid, wave, lane); }
        else ssd_chunk_unit(a, ws, lds, l, n - 640, tid, wave, lane);
    }
}
__device__ __forceinline__ void ph_topk_naive(unsigned char* ws, int bx, int G, int tid) {
    const float* scores = (const float*)(ws + WS_SCORES); float* s_top = (float*)(ws + WS_STOP); int* i_top = (int*)(ws + WS_ITOP);
    int* eidx = (int*)(ws + WS_EIDX); float* gate = (float*)(ws + WS_GATE);
    for (size_t r = (size_t)bx * 512 + tid; r < (size_t)T * 8; r += (size_t)G * 512) {
        for (int c = 0; c < 2; ++c) {
            const float* sp = scores + (r * 2 + c) * 128;
            float pv = INFINITY; int pi = -1;
            for (int k = 0; k < 16; ++k) {
                float bv = -INFINITY; int bi = 1 << 30;
                for (int n = 0; n < 128; ++n) {
                    const float v = sp[n];
                    const bool elig = (v < pv) || (v == pv && n > pi);
                    if (elig && (v > bv || (v == bv && n < bi))) { bv = v; bi = n; }
                }
                s_top[(r * 2 + c) * 16 + k] = bv; i_top[(r * 2 + c) * 16 + k] = bi; pv = bv; pi = bi;
            }
        }
        const float* s0 = s_top + r * 32; const float* s1 = s0 + 16;
        const int* i0 = i_top + r * 32; const int* i1 = i0 + 16;
        float pv = INFINITY; int pi = -1; float best0 = 0.f, den = 0.f;
        for (int k = 0; k < 16; ++k) {
            float bv = -INFINITY; int bi = 1 << 30;
            for (int c = 0; c < 256; ++c) {
                const float v = s0[c >> 4] + s1[c & 15];
                const bool elig = (v < pv) || (v == pv && c > pi);
                if (elig && (v > bv || (v == bv && c < bi))) { bv = v; bi = c; }
            }
            if (k == 0) best0 = bv;
            const float e = expf(bv - best0);
            den += e;
            gate[r * 16 + k] = e;
            eidx[r * 16 + k] = i0[bi >> 4] * 128 + i1[bi & 15];
            pv = bv; pi = bi;
        }
        const float inv = 1.f / den;
        for (int k = 0; k < 16; ++k) gate[r * 16 + k] *= inv;
    }
}
__device__ __forceinline__ void ph_gather_naive(const Args& a, unsigned char* ws, int l, int gw, int NGW, int lane) {
    const int* eidx = (const int*)(ws + WS_EIDX); const float* gate = (const float*)(ws + WS_GATE);
    const float* ut = AIN(I_PU) + (size_t)l * 16384 * D; const float* vt = AIN(I_PV) + (size_t)l * 16384 * D; const float* g2 = AIN(I_NORM2G) + l * D;
    float* x = a.out;
    for (int t = gw; t < T; t += NGW) {
        f32x4 xv[4], hv[4], acc[4]; float ss = 0.f;
#pragma unroll
        for (int j = 0; j < 4; ++j) { xv[j] = *(const f32x4*)(x + (size_t)t * D + j * 256 + lane * 4); ss += (xv[j].x * xv[j].x + xv[j].y * xv[j].y) + (xv[j].z * xv[j].z + xv[j].w * xv[j].w); acc[j] = (f32x4){0.f, 0.f, 0.f, 0.f}; }
        const float r2 = rsqrtf(wave_sum(ss) * (1.f / 1024.f) + EPS);
#pragma unroll
        for (int j = 0; j < 4; ++j) hv[j] = xv[j] * r2 * *(const f32x4*)(g2 + j * 256 + lane * 4);
        for (int k = 0; k < 128; ++k) {
            const int e = eidx[(size_t)t * 128 + k]; const float gt = gate[(size_t)t * 128 + k];
            const float* ur = ut + (size_t)e * D; const float* vr = vt + (size_t)e * D;
            float s = 0.f;
#pragma unroll
            for (int j = 0; j < 4; ++j) { const f32x4 u = *(const f32x4*)(ur + j * 256 + lane * 4); s += (u.x * hv[j].x + u.y * hv[j].y) + (u.z * hv[j].z + u.w * hv[j].w); }
            s = wave_sum(s);
            const float w = gt * 0.5f * s * (1.f + erff(s * 0.70710678118654752f));
#pragma unroll
            for (int j = 0; j < 4; ++j) acc[j] += *(const f32x4*)(vr + j * 256 + lane * 4) * w;
        }
        float s2 = 0.f;
#pragma unroll
        for (int j = 0; j < 4; ++j) {
            const f32x4 o = xv[j] + acc[j];
            *(f32x4*)(x + (size_t)t * D + j * 256 + lane * 4) = o;
            s2 += (o.x * o.x + o.y * o.y) + (o.z * o.z + o.w * o.w);
            *(unsigned long long*)((bf16*)(ws + WS_XB) + (size_t)t * D + j * 256 + lane * 4) = (unsigned long long)pkbf(o.x, o.y) | ((unsigned long long)pkbf(o.z, o.w) << 32);
        }
        s2 = wave_sum(s2);
        if (lane == 0) ((float*)(ws + WS_RS1))[t] = rsqrtf(s2 * (1.f / 1024.f) + EPS);
    }
}


__device__ __forceinline__ unsigned f2o(float f) { const unsigned b = __float_as_uint(f); return b ^ ((unsigned)((int)b >> 31) | 0x80000000u); }
__device__ __forceinline__ float o2f(unsigned k) { return __uint_as_float(k ^ ((k & 0x80000000u) ? 0x80000000u : 0xffffffffu)); }
#define TK_CE(a, b) do { const unsigned _mx = (a) > (b) ? (a) : (b), _mn = (a) > (b) ? (b) : (a); (a) = _mx; (b) = _mn; } while (0)
template <int N, int BASE> __device__ __forceinline__ void tk_sort16(unsigned (&k)[N]) {
#pragma unroll
    for (int sz = 2; sz <= 16; sz <<= 1)
#pragma unroll
        for (int j = sz >> 1; j > 0; j >>= 1)
#pragma unroll
            for (int i = 0; i < 16; ++i) { const int l = i ^ j; if (l > i) { if ((i & sz) == 0) TK_CE(k[BASE + i], k[BASE + l]); else TK_CE(k[BASE + l], k[BASE + i]); } }
}
template <int NA, int A, int NB_, int B> __device__ __forceinline__ void tk_merge16(unsigned (&ka)[NA], const unsigned (&kb)[NB_]) {
#pragma unroll
    for (int i = 0; i < 16; ++i) ka[A + i] = ka[A + i] > kb[B + 15 - i] ? ka[A + i] : kb[B + 15 - i];
#pragma unroll
    for (int j = 8; j > 0; j >>= 1)
#pragma unroll
        for (int i = 0; i < 16; ++i) { const int l = i ^ j; if (l > i) TK_CE(ka[A + i], ka[A + l]); }
}
__device__ __forceinline__ void ph_topk(unsigned char* ws, LAS unsigned char* lds, int gw, int NGW, int wave, int lane) {
    const float* scores = (const float*)(ws + WS_SCORES); int* eidx = (int*)(ws + WS_EIDX); float* gate = (float*)(ws + WS_GATE);
    LAS float* tr = (LAS float*)(lds + wave * WSCR);
    for (int b = gw; b < T * 8 / 64; b += NGW) {
        const float* sb = scores + (size_t)b * 64 * 256;
        unsigned top[2][16];
#pragma unroll
        for (int c = 0; c < 2; ++c) {
#pragma unroll
            for (int half = 0; half < 2; ++half) {
#pragma unroll 4
                for (int i = 0; i < 16; ++i) {
                    const int pp = 4 * i + (lane >> 4), vq = (lane & 15) * 4;
                    const f32x4 x = *(const GAS f32x4*)(sb + pp * 256 + c * 128 + half * 64 + vq);
                    LAS float* r = tr + pp * 65 + vq;
                    r[0] = x.x; r[1] = x.y; r[2] = x.z; r[3] = x.w;
                }
                asm volatile("s_waitcnt lgkmcnt(0)" ::: "memory");
                unsigned k[64];
#pragma unroll
                for (int v = 0; v < 64; ++v) k[v] = (f2o(tr[lane * 65 + v]) & ~127u) | (unsigned)(127 - (half * 64 + v));
                asm volatile("s_waitcnt lgkmcnt(0)" ::: "memory");
                tk_sort16<64, 0>(k); tk_sort16<64, 16>(k); tk_sort16<64, 32>(k); tk_sort16<64, 48>(k);
                tk_merge16<64, 0, 64, 16>(k, k); tk_merge16<64, 32, 64, 48>(k, k); tk_merge16<64, 0, 64, 32>(k, k);
                if (half == 0) {
#pragma unroll
                    for (int i = 0; i < 16; ++i) top[c][i] = k[i];
                } else tk_merge16<16, 0, 64, 0>(top[c], k);
            }
        }
        float av[16], bv[16];
#pragma unroll
        for (int i = 0; i < 16; ++i) { av[i] = o2f(top[0][i] & ~127u); bv[i] = o2f(top[1][i] & ~127u); }
        LAS int* li = (LAS int*)tr + lane * 32;
#pragma unroll
        for (int i = 0; i < 16; ++i) { li[i] = 127 - (int)(top[0][i] & 127u); li[16 + i] = 127 - (int)(top[1][i] & 127u); }
        unsigned key[64];
        key[0] = (f2o(av[0] + bv[0]) & ~255u) | 255u;
        key[1] = (f2o(av[0] + bv[1]) & ~255u) | 254u;
        key[2] = (f2o(av[0] + bv[2]) & ~255u) | 253u;
        key[3] = (f2o(av[0] + bv[3]) & ~255u) | 252u;
        key[4] = (f2o(av[0] + bv[4]) & ~255u) | 251u;
        key[5] = (f2o(av[0] + bv[5]) & ~255u) | 250u;
        key[6] = (f2o(av[0] + bv[6]) & ~255u) | 249u;
        key[7] = (f2o(av[0] + bv[7]) & ~255u) | 248u;
        key[8] = (f2o(av[0] + bv[8]) & ~255u) | 247u;
        key[9] = (f2o(av[0] + bv[9]) & ~255u) | 246u;
        key[10] = (f2o(av[0] + bv[10]) & ~255u) | 245u;
        key[11] = (f2o(av[0] + bv[11]) & ~255u) | 244u;
        key[12] = (f2o(av[0] + bv[12]) & ~255u) | 243u;
        key[13] = (f2o(av[0] + bv[13]) & ~255u) | 242u;
        key[14] = (f2o(av[0] + bv[14]) & ~255u) | 241u;
        key[15] = (f2o(av[0] + bv[15]) & ~255u) | 240u;
        key[16] = (f2o(av[1] + bv[0]) & ~255u) | 239u;
        key[17] = (f2o(av[1] + bv[1]) & ~255u) | 238u;
        key[18] = (f2o(av[1] + bv[2]) & ~255u) | 237u;
        key[19] = (f2o(av[1] + bv[3]) & ~255u) | 236u;
        key[20] = (f2o(av[1] + bv[4]) & ~255u) | 235u;
        key[21] = (f2o(av[1] + bv[5]) & ~255u) | 234u;
        key[22] = (f2o(av[1] + bv[6]) & ~255u) | 233u;
        key[23] = (f2o(av[1] + bv[7]) & ~255u) | 232u;
        key[24] = (f2o(av[2] + bv[0]) & ~255u) | 223u;
        key[25] = (f2o(av[2] + bv[1]) & ~255u) | 222u;
        key[26] = (f2o(av[2] + bv[2]) & ~255u) | 221u;
        key[27] = (f2o(av[2] + bv[3]) & ~255u) | 220u;
        key[28] = (f2o(av[2] + bv[4]) & ~255u) | 219u;
        key[29] = (f2o(av[3] + bv[0]) & ~255u) | 207u;
        key[30] = (f2o(av[3] + bv[1]) & ~255u) | 206u;
        key[31] = (f2o(av[3] + bv[2]) & ~255u) | 205u;
        key[32] = (f2o(av[3] + bv[3]) & ~255u) | 204u;
        key[33] = (f2o(av[4] + bv[0]) & ~255u) | 191u;
        key[34] = (f2o(av[4] + bv[1]) & ~255u) | 190u;
        key[35] = (f2o(av[4] + bv[2]) & ~255u) | 189u;
        key[36] = (f2o(av[5] + bv[0]) & ~255u) | 175u;
        key[37] = (f2o(av[5] + bv[1]) & ~255u) | 174u;
        key[38] = (f2o(av[6] + bv[0]) & ~255u) | 159u;
        key[39] = (f2o(av[6] + bv[1]) & ~255u) | 158u;
        key[40] = (f2o(av[7] + bv[0]) & ~255u) | 143u;
        key[41] = (f2o(av[7] + bv[1]) & ~255u) | 142u;
        key[42] = (f2o(av[8] + bv[0]) & ~255u) | 127u;
        key[43] = (f2o(av[9] + bv[0]) & ~255u) | 111u;
        key[44] = (f2o(av[10] + bv[0]) & ~255u) | 95u;
        key[45] = (f2o(av[11] + bv[0]) & ~255u) | 79u;
        key[46] = (f2o(av[12] + bv[0]) & ~255u) | 63u;
        key[47] = (f2o(av[13] + bv[0]) & ~255u) | 47u;
        key[48] = (f2o(av[14] + bv[0]) & ~255u) | 31u;
        key[49] = (f2o(av[15] + bv[0]) & ~255u) | 15u;
#pragma unroll
        for (int i = 50; i < 64; ++i) key[i] = 0u;
        tk_sort16<64, 0>(key); tk_sort16<64, 16>(key); tk_sort16<64, 32>(key); tk_sort16<64, 48>(key);
        tk_merge16<64, 0, 64, 16>(key, key); tk_merge16<64, 32, 64, 48>(key, key); tk_merge16<64, 0, 64, 32>(key, key);
        asm volatile("s_waitcnt lgkmcnt(0)" ::: "memory");
        const float s0 = o2f(key[0] & ~255u);
        float ev[16]; int ei[16]; float den = 0.f;
#pragma unroll
        for (int w = 0; w < 16; ++w) {
            const unsigned ij = 255u - (key[w] & 255u);
            ev[w] = __expf(o2f(key[w] & ~255u) - s0); den += ev[w];
            ei[w] = li[ij >> 4] * 128 + li[16 + (ij & 15)];
        }
        const float inv = 1.f / den;
        const size_t ob = ((size_t)b * 64 + lane) * 16;
#pragma unroll
        for (int q = 0; q < 4; ++q) {
            typedef int i32x4 __attribute__((ext_vector_type(4)));
            *(GAS i32x4*)(eidx + ob + 4 * q) = (i32x4){ei[4 * q], ei[4 * q + 1], ei[4 * q + 2], ei[4 * q + 3]};
            *(GAS f32x4*)(gate + ob + 4 * q) = (f32x4){ev[4 * q] * inv, ev[4 * q + 1] * inv, ev[4 * q + 2] * inv, ev[4 * q + 3] * inv};
        }
        asm volatile("s_waitcnt lgkmcnt(0)" ::: "memory");
    }
}
typedef __attribute__((ext_vector_type(2))) __bf16 bf16x2_t;
__device__ __forceinline__ float dot2bf(unsigned a, unsigned b, float c) { return __builtin_amdgcn_fdot2_f32_bf16(__builtin_bit_cast(bf16x2_t, a), __builtin_bit_cast(bf16x2_t, b), c, false); }
__device__ __forceinline__ float gelu_erf(float v) { return 0.5f * v * (1.f + erff(v * 0.70710678118654752f)); }
__device__ __forceinline__ void ph_gather(unsigned char* ws, float* x, int l, int gw, int NGW, int lane) {
    const int* eidx = (const int*)(ws + WS_EIDX); const float* gate = (const float*)(ws + WS_GATE);
    const bf16* ut = (const bf16*)(ws + WS_UT) + (size_t)l * 16384 * D; const bf16* vt = (const bf16*)(ws + WS_VT) + (size_t)l * 16384 * D;
    bf16* xb = (bf16*)(ws + WS_XB); const float* xssq = (const float*)(ws + WS_XSSQ);
    const bool hi5 = (lane & 32) != 0, hi4 = (lane & 16) != 0, hi3 = (lane & 8) != 0;
    const int myj = (hi5 ? 4 : 0) + (hi4 ? 2 : 0) + (hi3 ? 1 : 0);
    for (int t = gw; t < T; t += NGW) {
        const v4u xa = *(const GAS v4u*)(xb + (size_t)t * D + 8 * lane), xc = *(const GAS v4u*)(xb + (size_t)t * D + 512 + 8 * lane);
        float ss = xssq[(size_t)t * 16 + (lane & 15)];
        ss += __shfl_xor(ss, 1); ss += __shfl_xor(ss, 2); ss += __shfl_xor(ss, 4); ss += __shfl_xor(ss, 8);
        const float r2 = rsqrtf(ss * (1.f / 1024.f) + EPS);
        const int e_lo = eidx[(size_t)t * 128 + lane], e_hi = eidx[(size_t)t * 128 + 64 + lane];
        const float g_lo = gate[(size_t)t * 128 + lane], g_hi = gate[(size_t)t * 128 + 64 + lane];
        float acc[16];
#pragma unroll
        for (int i = 0; i < 16; ++i) acc[i] = 0.f;
#pragma unroll 1
        for (int c = 0; c < 16; ++c) {
            v4u ua[8], uc[8], va[8], vc[8];
#pragma unroll
            for (int j = 0; j < 8; ++j) {
                const int k = 8 * c + j;
                const int e = __builtin_amdgcn_readlane(c < 8 ? e_lo : e_hi, k & 63);
                ua[j] = *(const GAS v4u*)(ut + (size_t)e * D + 8 * lane); uc[j] = *(const GAS v4u*)(ut + (size_t)e * D + 512 + 8 * lane);
                va[j] = *(const GAS v4u*)(vt + (size_t)e * D + 8 * lane); vc[j] = *(const GAS v4u*)(vt + (size_t)e * D + 512 + 8 * lane);
            }
            float p[8];
#pragma unroll
            for (int j = 0; j < 8; ++j) {
                float a = dot2bf(xa.x, ua[j].x, 0.f); a = dot2bf(xa.y, ua[j].y, a); a = dot2bf(xa.z, ua[j].z, a); a = dot2bf(xa.w, ua[j].w, a);
                a = dot2bf(xc.x, uc[j].x, a); a = dot2bf(xc.y, uc[j].y, a); a = dot2bf(xc.z, uc[j].z, a); a = dot2bf(xc.w, uc[j].w, a);
                p[j] = a;
            }
            float q4[4], q2[2], q1;
#pragma unroll
            for (int j = 0; j < 4; ++j) { const float keep = hi5 ? p[j + 4] : p[j], send = hi5 ? p[j] : p[j + 4]; q4[j] = keep + __shfl_xor(send, 32); }
#pragma unroll
            for (int j = 0; j < 2; ++j) { const float keep = hi4 ? q4[j + 2] : q4[j], send = hi4 ? q4[j] : q4[j + 2]; q2[j] = keep + __shfl_xor(send, 16); }
            { const float keep = hi3 ? q2[1] : q2[0], send = hi3 ? q2[0] : q2[1]; q1 = keep + __shfl_xor(send, 8); }
            q1 += __shfl_xor(q1, 4); q1 += __shfl_xor(q1, 2); q1 += __shfl_xor(q1, 1);
            const float gsel = __shfl(c < 8 ? g_lo : g_hi, (8 * c + myj) & 63);
            const float wv = gsel * gelu_erf(q1 * r2);
#pragma unroll
            for (int j = 0; j < 8; ++j) {
                const float w = __uint_as_float((unsigned)__builtin_amdgcn_readlane((int)__float_as_uint(wv), ((j >> 2) << 5) | (((j >> 1) & 1) << 4) | ((j & 1) << 3)));
                const unsigned vv[8] = {va[j].x, va[j].y, va[j].z, va[j].w, vc[j].x, vc[j].y, vc[j].z, vc[j].w};
#pragma unroll
                for (int i = 0; i < 8; ++i) { acc[2 * i] += w * __uint_as_float(vv[i] << 16); acc[2 * i + 1] += w * __uint_as_float(vv[i] & 0xffff0000u); }
            }
        }
        float* xr = x + (size_t)t * D; float s2 = 0.f; float o[16];
#pragma unroll
        for (int hh = 0; hh < 2; ++hh)
#pragma unroll
            for (int q = 0; q < 2; ++q) {
                const f32x4 xv = *(const GAS f32x4*)(xr + hh * 512 + 8 * lane + 4 * q);
                f32x4 ov; ov.x = xv.x + acc[hh * 8 + q * 4 + 0]; ov.y = xv.y + acc[hh * 8 + q * 4 + 1]; ov.z = xv.z + acc[hh * 8 + q * 4 + 2]; ov.w = xv.w + acc[hh * 8 + q * 4 + 3];
                *(GAS f32x4*)(xr + hh * 512 + 8 * lane + 4 * q) = ov;
                o[hh * 8 + q * 4 + 0] = ov.x; o[hh * 8 + q * 4 + 1] = ov.y; o[hh * 8 + q * 4 + 2] = ov.z; o[hh * 8 + q * 4 + 3] = ov.w;
                s2 += (ov.x * ov.x + ov.y * ov.y) + (ov.z * ov.z + ov.w * ov.w);
            }
#pragma unroll
        for (int hh = 0; hh < 2; ++hh) { v4u w; w.x = pkbf(o[hh * 8 + 0], o[hh * 8 + 1]); w.y = pkbf(o[hh * 8 + 2], o[hh * 8 + 3]); w.z = pkbf(o[hh * 8 + 4], o[hh * 8 + 5]); w.w = pkbf(o[hh * 8 + 6], o[hh * 8 + 7]);
            *(GAS v4u*)(xb + (size_t)t * D + hh * 512 + 8 * lane) = w; }
        s2 = wave_sum(s2);
        if (lane == 0) ((float*)(ws + WS_RS1))[t] = rsqrtf(s2 * (1.f / 1024.f) + EPS);
    }
}
constexpr int NPH_L = 8, NPHASES = 1 + NL * NPH_L;
#ifndef MK_PHMASK
#define MK_PHMASK 0x1ff
#endif
#define PH_ON(j) ((MK_PHMASK >> (j)) & 1)
__global__ void __launch_bounds__(NWAVES * 64, 2) mega(Args a) {
    extern __shared__ __attribute__((aligned(16))) unsigned char lds_raw[];
    {
        LAS unsigned char* lds0 = (LAS unsigned char*)lds_raw;
        for (int u = threadIdx.x; u < (LDS_BYTES - LDSCTL_OFF) / 4; u += NWAVES * 64) ((LAS unsigned*)(lds0 + LDSCTL_OFF))[u] = 0u;
        __syncthreads();
    }
    const bool multi = (a.ph_hi - a.ph_lo) > 1;
    XcdBarrier bar; bar.bar = (unsigned*)(a.ws + WS_CTL) + CW_BAR + a.li * XCD_BAR_WORDS; bar.x = 0; bar.st = nullptr;
    if (multi) bar = xcd_barrier_post((unsigned*)(a.ws + WS_CTL) + CW_BAR + a.li * XCD_BAR_WORDS, (volatile LAS unsigned*)((LAS unsigned char*)lds_raw + MISC_OFF) + 8);

    for (int ph = a.ph_lo; ph < a.ph_hi; ++ph) {
        unsigned char* ws = a.ws; asm volatile("" : "+s"(ws));
        int G = (int)gridDim.x; asm volatile("" : "+s"(G));
        int bx = (int)blockIdx.x; asm volatile("" : "+s"(bx));
        int tid = (int)threadIdx.x; asm volatile("" : "+v"(tid));
        LAS unsigned char* lds = (LAS unsigned char*)lds_raw;
        const int lane = tid & 63, wave = __builtin_amdgcn_readfirstlane(tid >> 6);
        const int vcu = (G % 8 == 0) ? (bx % 8) * (G / 8) + bx / 8 : bx;
        const int gw = vcu * NWAVES + wave, NGW = G * NWAVES;
        if (ph == 0) {
            if (PH_ON(8)) ph_prologue(a, ws, lds, gw, NGW, wave, lane);
        } else {
            const int l = (ph - 1) / NPH_L, j = (ph - 1) % NPH_L;
            if (j == 0 && PH_ON(0)) {
                { pg8::Gemm g{(const pg8::bf16_t*)(ws + WS_XB), (const pg8::bf16_t*)(ws + WS_WIN) + (size_t)l * NPROJ * D, T, NPROJ, D};
                  pg8::StaticOrder So; So.init(T, NPROJ, G, bx);
                  pg8::EpiInProj E{(pg8::bf16_t*)(ws + WS_PROJ), NPROJ, (const float*)(ws + WS_RS1), (float*)(ws + WS_DTF), AIN(I_DTBIAS) + l * 6};
                  pg8::gemm_phase<pg8::EpiInProj, pg8::StaticOrder, true, true>(lds, g, So, E); }
                { pg8::Gemm g{(const pg8::bf16_t*)(ws + WS_MEMB), (const pg8::bf16_t*)(ws + WS_WMEM) + (size_t)l * 512 * D, MROWS, 512, D};
                  pg8::StaticOrder So; So.init(MROWS, 512, G, bx);
                  pg8::EpiInProj E{(pg8::bf16_t*)(ws + WS_MEMKV), 512, (const float*)(ws + WS_RSM), nullptr, nullptr};
                  pg8::gemm_phase<pg8::EpiInProj, pg8::StaticOrder, true, true>(lds, g, So, E); }
            } else if (j == 1 && PH_ON(1)) {
                ph_mix(a, ws, lds, l, tid, wave, lane);
            } else if (j == 2 && PH_ON(2)) {
                ph_ssd_scan(ws, bx, G, tid);
            } else if (j == 3 && PH_ON(3)) {
                for (int u = vcu; u < 256; u += G) ssd_finish_unit(a, ws, l, u, wave, lane);
            } else if (j == 4 && PH_ON(4)) {
                pg8::Gemm g{(const pg8::bf16_t*)(ws + WS_YCAT), (const pg8::bf16_t*)(ws + WS_WOUT) + (size_t)l * D * D, T, D, D};
                pg8::StaticOrder So; So.init(T, D, G, bx);
                LAS float* gtab = (LAS float*)(lds + GTAB_OFF);
                { pg8::Unit u0; if (So.next(0, u0) && tid < 256) { float r0, r1, r2; pg8::group_rstd((const float*)(ws + WS_YSSQ), u0.pm * 256 + tid, r0, r1, r2); gtab[tid] = r0 / r1; gtab[256 + tid] = r1 / r2; gtab[512 + tid] = r2; } }
                __syncthreads();
                pg8::EpiOut E{l == 0 ? AIN(I_X) : a.out, a.out, (pg8::bf16_t*)(ws + WS_XB), (float*)(ws + WS_XSSQ), gtab};
                pg8::gemm_phase<pg8::EpiOut, pg8::StaticOrder, true, true>(lds, g, So, E);
            } else if (j == 5 && PH_ON(5)) {
                pg8::Gemm g{(const pg8::bf16_t*)(ws + WS_XB), (const pg8::bf16_t*)(ws + WS_WSC) + (size_t)l * 2048 * D, T, 2048, D};
                pg8::StaticOrder So; So.init(T, 2048, G, bx);
                pg8::EpiScores E{(float*)(ws + WS_SCORES), (const float*)(ws + WS_XSSQ)};
                pg8::gemm_phase<pg8::EpiScores, pg8::StaticOrder, true, true>(lds, g, So, E);
            } else if (j == 6 && PH_ON(6)) {
                ph_topk(ws, lds, gw, NGW, wave, lane);
            } else if (j == 7 && PH_ON(7)) {
                ph_gather(ws, a.out, l, gw, NGW, lane);
            }
        }
        if (ph + 1 < a.ph_hi) { XcdBarrier b2 = bar; { unsigned* p = b2.bar; unsigned x = b2.x; asm volatile("" : "+s"(p), "+s"(x)); b2.bar = p; b2.x = x; } xcd_barrier(b2); }
    }
}

#ifndef MK_ONE_LAUNCH
#define MK_ONE_LAUNCH 1
#endif
extern "C" void kernel_launch(void* const* d_in, const int* in_sizes, int n_in, void* d_out, int out_size, void* d_ws, size_t ws_size, hipStream_t stream) {
    static int grid = 0;
    if (grid == 0) {
        if (n_in != 22 || out_size != T * D || ws_size < WS_END) { fprintf(stderr, "kernel_launch: unexpected problem (n_in %d out %d ws %zu)\n", n_in, out_size, ws_size); grid = -1; return; }
        int dev = 0, cus = 0, per_cu = 0;
        if (hipGetDevice(&dev) != hipSuccess || hipDeviceGetAttribute(&cus, hipDeviceAttributeMultiprocessorCount, dev) != hipSuccess) { grid = -1; return; }
        if (hipFuncSetAttribute((const void*)mega, hipFuncAttributeMaxDynamicSharedMemorySize, LDS_BYTES) != hipSuccess) { fprintf(stderr, "kernel_launch: hipFuncSetAttribute failed\n"); grid = -1; return; }
        if (hipOccupancyMaxActiveBlocksPerMultiprocessor(&per_cu, (const void*)mega, NWAVES * 64, LDS_BYTES) != hipSuccess || per_cu < 1) { fprintf(stderr, "kernel_launch: occupancy query says %d\n", per_cu); (void)hipGetLastError(); per_cu = 1; }
        grid = cus;
    }
    if (grid < 0) return;
    (void)hipMemsetAsync((char*)d_ws + WS_CTL, 0, CTL_ZERO_BYTES, stream);
    Args a{};
    for (int i = 0; i < 22; ++i) a.in[i] = (const float*)d_in[i];
    a.out = (float*)d_out; a.ws = (unsigned char*)d_ws;
#if MK_ONE_LAUNCH
    a.ph_lo = 0; a.ph_hi = NPHASES; a.li = 0;
    hipLaunchKernelGGL(mega, dim3(grid), dim3(NWAVES * 64), LDS_BYTES, stream, a);
#else
    for (int ph = 0; ph < NPHASES; ++ph) { a.ph_lo = ph; a.ph_hi = ph + 1; a.li = 0; hipLaunchKernelGGL(mega, dim3(grid), dim3(NWAVES * 64), LDS_BYTES, stream, a); }
#endif
}
```

```cpp
#include <hip/hip_runtime.h>
#include <cstdio>
#include <cstdint>
#include <cmath>
namespace pg8 {
#define PG8_LAS __attribute__((address_space(3)))
typedef unsigned short bf16_t;
typedef short bf16x8 __attribute__((ext_vector_type(8)));
typedef float f32x4 __attribute__((ext_vector_type(4)));
typedef unsigned u32x4 __attribute__((ext_vector_type(4)));
constexpr int BM = 256, BK = 64, HALF = 128, HTB = HALF * BK * 2  , STAGE_BYTES = 8 * HTB, NXCD = 8, WGM = 8;

__host__ __device__ __forceinline__ int lds_byte(int r, int c) { const int st = (r >> 4) * 2 + (c >> 5), rr = r & 15, cc = c & 31, ob = rr * 64 + cc * 2; return st * 1024 + (ob ^ (((ob >> 9) & 1) << 5)); }
__host__ __device__ __forceinline__ void stage_rc(int b, int& R, int& C) { const int st = b / 1024, sb = b % 1024, swz = sb ^ (((sb >> 9) & 1) << 5); R = (st >> 1) * 16 + swz / 64; C = (st & 1) * 32 + (swz % 64) / 2; }
__host__ __device__ __forceinline__ int perm32(int rho) { const int n = rho >> 4, i = rho & 15; return 8 * (i >> 2) + 4 * n + (i & 3); }

struct Unit { int pm, pn; };
struct Gemm { const bf16_t* A; const bf16_t* Bt; int M, N, K; };

struct StaticOrder {
    int nM, nN, nwg, G, c;
    __host__ __device__ void init(int M, int N, int G_, int c_) { nM = M / BM; nN = N / BM; nwg = nM * nN; G = G_; c = c_; }
    __host__ __device__ bool next(int i, Unit& u) const {
        const long L = (long)i * G + c; if (L >= nwg) return false;
        int wgid = (int)L; { const int q = nwg / NXCD, r = nwg % NXCD, xcd = wgid % NXCD, off = wgid / NXCD; wgid = (xcd < r ? xcd * (q + 1) : r * (q + 1) + (xcd - r) * q) + off; }
        const int nig = WGM * nN, gid = wgid / nig, fm = gid * WGM, gsz = (nM - fm) < WGM ? (nM - fm) : WGM;
        u.pm = fm + ((wgid % nig) % gsz); u.pn = (wgid % nig) / gsz; return true;
    }
    __device__ __forceinline__ void a_ready(const Unit&) const {}
    __device__ __forceinline__ void done(const Unit&) const {}
};

__device__ __forceinline__ unsigned cvt_pk_bf16(float lo, float hi) { unsigned r; asm volatile("v_cvt_pk_bf16_f32 %0, %1, %2" : "=v"(r) : "v"(lo), "v"(hi)); return r; }
template <class Epi, class Sched, bool ALIGN_EPI = false, bool SP2 = false>
__device__ __forceinline__ void gemm_phase(PG8_LAS unsigned char* lds, const Gemm g, const Sched& S, const Epi& E) {
    int tid_ = threadIdx.x; asm volatile("" : "+v"(tid_));
    const int tid = tid_, wid = __builtin_amdgcn_readfirstlane(tid >> 6), lane = tid & 63, wr = wid >> 2, wc = wid & 3, fr = lane & 15, fq = lane >> 4;
    const int K = g.K, nt = K / BK;
    unsigned voffA[2], voffB[2];
#pragma unroll
    for (int i = 0; i < 2; ++i) { int R, C; stage_rc(tid * 16 + i * 8192, R, C); const int Rb = Epi::PERM ? ((R & ~31) + perm32(R & 31)) : R;
        voffA[i] = (unsigned)(R * K + C) * 2u; voffB[i] = (unsigned)(Rb * K + C) * 2u; }
    const size_t kstep = (size_t)(BK * 2);
    const size_t hstep = (size_t)HALF * K * 2;
    const size_t tstep = 2 * hstep;
    const unsigned ldsw = (unsigned)wid * 1024u;
    const int aoff = lds_byte(wr * 64 + fr, fq * 8), boff = lds_byte(wc * 32 + fr, fq * 8);
#define PG8_SA(b, h) (((b) * 2 + (h)) * HTB)
#define PG8_SB(b, h) ((4 + (b) * 2 + (h)) * HTB)
#define PG8_STAGE(bufoff, gbase, voff) do { _Pragma("unroll") for (int _i = 0; _i < 2; ++_i) \
        __builtin_amdgcn_global_load_lds((const unsigned*)((const char*)(gbase) + (voff)[_i]), (PG8_LAS unsigned*)(lds + (bufoff) + ldsw + _i * 8192), 16, 0, 0); } while (0)
#define PG8_LDA(dst, b, h) do { _Pragma("unroll") for (int m = 0; m < 4; ++m) _Pragma("unroll") for (int k = 0; k < 2; ++k) dst[m][k] = *(const PG8_LAS bf16x8*)(lds + PG8_SA(b, h) + aoff + m * 2048 + k * 1024); } while (0)
#define PG8_LDB(dst, b, h) do { _Pragma("unroll") for (int n = 0; n < 2; ++n) _Pragma("unroll") for (int k = 0; k < 2; ++k) dst[n][k] = *(const PG8_LAS bf16x8*)(lds + PG8_SB(b, h) + boff + n * 2048 + k * 1024); } while (0)
#define PG8_MMA(ai, bj, At, Bt) do { __builtin_amdgcn_s_setprio(1); _Pragma("unroll") for (int m = 0; m < 4; ++m) _Pragma("unroll") for (int n = 0; n < 2; ++n) _Pragma("unroll") for (int k = 0; k < 2; ++k) \
        acc[ai][bj][m][n] = __builtin_amdgcn_mfma_f32_16x16x32_bf16(Bt[n][k], At[m][k], acc[ai][bj][m][n], 0, 0, 0); __builtin_amdgcn_s_setprio(0); } while (0)
#define PG8_WAIT_V(n) asm volatile("s_waitcnt vmcnt(" #n ")" ::: "memory")
#define PG8_WAIT_L(n) asm volatile("s_waitcnt lgkmcnt(" #n ")" ::: "memory")
#define PG8_BAR __builtin_amdgcn_s_barrier()
#define PG8_SCHED __builtin_amdgcn_sched_barrier(0)
    Unit cur, nxt; int ui = 0;
    if (!S.next(0, cur)) return;
    f32x4 acc[2][2][4][2];
#pragma unroll
    for (int a = 0; a < 2; ++a)
#pragma unroll
        for (int b = 0; b < 2; ++b)
#pragma unroll
            for (int m = 0; m < 4; ++m)
#pragma unroll
                for (int n = 0; n < 2; ++n) acc[a][b][m][n] = (f32x4){0.f, 0.f, 0.f, 0.f};
    bf16x8 At[4][2], B0[2][2], B1[2][2];
    const char* cA = (const char*)g.A + (size_t)cur.pm * tstep; const char* cB = (const char*)g.Bt + (size_t)cur.pn * tstep;
    S.a_ready(cur);
    if constexpr (SP2) {
        PG8_STAGE(PG8_SB(0, 0), cB, voffB); PG8_STAGE(PG8_SB(0, 1), cB + hstep, voffB); PG8_STAGE(PG8_SA(0, 0), cA, voffA); PG8_STAGE(PG8_SA(0, 1), cA + hstep, voffA);
        if (wr == 1) PG8_BAR;
        PG8_WAIT_V(2); PG8_BAR;
        PG8_STAGE(PG8_SB(1, 0), cB + kstep, voffB); PG8_STAGE(PG8_SA(1, 0), cA + kstep, voffA); PG8_STAGE(PG8_SB(1, 1), cB + hstep + kstep, voffB);
        PG8_WAIT_V(6); PG8_BAR;
    } else {
        PG8_STAGE(PG8_SB(0, 0), cB, voffB); PG8_STAGE(PG8_SA(0, 0), cA, voffA); PG8_STAGE(PG8_SB(0, 1), cB + hstep, voffB); PG8_STAGE(PG8_SA(0, 1), cA + hstep, voffA);
        if (wr == 1) PG8_BAR;
        PG8_WAIT_V(4); PG8_BAR;
        PG8_STAGE(PG8_SB(1, 0), cB + kstep, voffB); PG8_STAGE(PG8_SA(1, 0), cA + kstep, voffA); PG8_STAGE(PG8_SB(1, 1), cB + hstep + kstep, voffB);
        PG8_WAIT_V(6); PG8_BAR;
    }
    for (;;) {
        const bool has_next = S.next(ui + 1, nxt);
        const char* nA = has_next ? (const char*)g.A + (size_t)nxt.pm * tstep : cA; const char* nB = has_next ? (const char*)g.Bt + (size_t)nxt.pn * tstep : cB;
        for (int t = 0; t < nt; t += 2) {
            const bool last = (t == nt - 2);
            const char* a1 = cA + (size_t)(t + 1) * kstep;
            const char* a2 = last ? nA : cA + (size_t)(t + 2) * kstep; const char* b2 = last ? nB : cB + (size_t)(t + 2) * kstep;
            const char* a3 = a2 + kstep; const char* b3 = b2 + kstep;
            if (last && has_next) S.a_ready(nxt);
            if constexpr (Epi::KHOOK) E.khook(acc, cur, t, wr, fr);
            if constexpr (SP2) {
            PG8_LDB(B0, 0, 0); PG8_LDB(B1, 0, 1); PG8_SCHED; PG8_LDA(At, 0, 0); PG8_STAGE(PG8_SA(1, 1), a1 + hstep, voffA);
            PG8_WAIT_V(8); PG8_WAIT_L(0); PG8_BAR; PG8_MMA(0, 0, At, B0); PG8_MMA(0, 1, At, B1); PG8_BAR; PG8_SCHED;
            PG8_LDA(At, 0, 1); PG8_STAGE(PG8_SB(0, 0), b2, voffB); PG8_STAGE(PG8_SB(0, 1), b2 + hstep, voffB); PG8_STAGE(PG8_SA(0, 0), a2, voffA);
            PG8_WAIT_V(8); PG8_WAIT_L(0); PG8_BAR; PG8_MMA(1, 0, At, B0); PG8_MMA(1, 1, At, B1); PG8_BAR; PG8_SCHED;
            PG8_LDB(B0, 1, 0); PG8_LDB(B1, 1, 1); PG8_SCHED; PG8_LDA(At, 1, 0); PG8_STAGE(PG8_SA(0, 1), a2 + hstep, voffA);
            PG8_WAIT_V(8); PG8_WAIT_L(0); PG8_BAR; PG8_MMA(0, 0, At, B0); PG8_MMA(0, 1, At, B1); PG8_BAR; PG8_SCHED;
            PG8_LDA(At, 1, 1); PG8_STAGE(PG8_SB(1, 0), b3, voffB); PG8_STAGE(PG8_SB(1, 1), b3 + hstep, voffB); PG8_STAGE(PG8_SA(1, 0), a3, voffA);
            PG8_WAIT_V(8); PG8_WAIT_L(0); PG8_BAR; PG8_MMA(1, 0, At, B0); PG8_MMA(1, 1, At, B1); PG8_BAR; PG8_SCHED;
            } else {
            PG8_LDB(B0, 0, 0); PG8_SCHED; PG8_LDA(At, 0, 0); PG8_STAGE(PG8_SA(1, 1), a1 + hstep, voffA);
            PG8_WAIT_L(8); PG8_BAR; PG8_WAIT_L(0); PG8_MMA(0, 0, At, B0); PG8_BAR; PG8_SCHED;
            PG8_LDB(B1, 0, 1); PG8_STAGE(PG8_SB(0, 0), b2, voffB);
            PG8_BAR; PG8_WAIT_L(0); PG8_MMA(0, 1, At, B1); PG8_BAR;
            PG8_LDA(At, 0, 1); PG8_STAGE(PG8_SA(0, 0), a2, voffA);
            PG8_BAR; PG8_WAIT_L(0); PG8_MMA(1, 0, At, B0); PG8_BAR; PG8_SCHED;
            PG8_STAGE(PG8_SB(0, 1), b2 + hstep, voffB);
            PG8_WAIT_V(6); PG8_BAR; PG8_MMA(1, 1, At, B1); PG8_BAR;
            PG8_LDB(B0, 1, 0); PG8_SCHED; PG8_LDA(At, 1, 0); PG8_STAGE(PG8_SA(0, 1), a2 + hstep, voffA);
            PG8_WAIT_L(8); PG8_BAR; PG8_WAIT_L(0); PG8_MMA(0, 0, At, B0); PG8_BAR; PG8_SCHED;
            PG8_LDB(B1, 1, 1); PG8_STAGE(PG8_SB(1, 0), b3, voffB);
            PG8_BAR; PG8_WAIT_L(0); PG8_MMA(0, 1, At, B1); PG8_BAR;
            PG8_LDA(At, 1, 1); PG8_STAGE(PG8_SA(1, 0), a3, voffA);
            PG8_BAR; PG8_WAIT_L(0); PG8_MMA(1, 0, At, B0); PG8_BAR; PG8_SCHED;
            PG8_STAGE(PG8_SB(1, 1), b3 + hstep, voffB);
            PG8_WAIT_V(6); PG8_BAR; PG8_MMA(1, 1, At, B1); PG8_BAR;
            }
        }
        if constexpr (ALIGN_EPI) { if (wr == 0) PG8_BAR; }
        if constexpr (!Epi::AFTER_DRAIN) { E(acc, cur, wr, wc, fr, fq); S.done(cur); }
        if (!has_next) break;
#pragma unroll
        for (int a = 0; a < 2; ++a)
#pragma unroll
            for (int b = 0; b < 2; ++b)
#pragma unroll
                for (int m = 0; m < 4; ++m)
#pragma unroll
                    for (int n = 0; n < 2; ++n) acc[a][b][m][n] = (f32x4){0.f, 0.f, 0.f, 0.f};
        cur = nxt; cA = nA; cB = nB; ++ui;
        if constexpr (ALIGN_EPI) { if (wr == 1) PG8_BAR; }
    }
    PG8_WAIT_V(0);
    if constexpr (!ALIGN_EPI) { if (wr == 0) PG8_BAR; }
    PG8_BAR;
    if constexpr (Epi::AFTER_DRAIN) { E.fused(acc, cur, wr, wc, fr, fq, lds, wid, lane); S.done(cur); }
#undef PG8_SA
#undef PG8_SB
#undef PG8_STAGE
#undef PG8_LDA
#undef PG8_LDB
#undef PG8_MMA
#undef PG8_WAIT_V
#undef PG8_WAIT_L
#undef PG8_BAR
#undef PG8_SCHED
}
}
#define GAS __attribute__((address_space(1)))
#define LAS __attribute__((address_space(3)))
typedef unsigned short bf16;
typedef unsigned v4u __attribute__((ext_vector_type(4)));
typedef float f32x4 __attribute__((ext_vector_type(4)));
typedef short bf16x8 __attribute__((ext_vector_type(8)));
typedef GAS unsigned gu32;
typedef GAS unsigned long long gu64;
#define RLX_AGENT __ATOMIC_RELAXED, __HIP_MEMORY_SCOPE_AGENT
#define LDS_WAIT() asm volatile("s_waitcnt lgkmcnt(0)" ::: "memory")
#define VM_WAIT() asm volatile("s_waitcnt vmcnt(0)" ::: "memory")
__device__ __forceinline__ unsigned long long rt() { return __builtin_amdgcn_s_memrealtime(); }
__device__ __forceinline__ unsigned f2bf(float f) { unsigned u = __builtin_bit_cast(unsigned, f); return (u + 0x7fffu + ((u >> 16) & 1u)) >> 16; }
__device__ __forceinline__ unsigned pk2(float lo, float hi) { return f2bf(lo) | (f2bf(hi) << 16); }

#define XB_TMO      128
#define XB_XCNT(j)  (256  + 64 * (j))
#define XB_XSUB(j)  (1280 + 64 * (j))
#define XB_XGEN(j)  (2304 + 64 * (j))
#define XB_TOP      3328
#define XB_TOPGEN   3392
#define XCD_BAR_WORDS 3456
#define XB_SPIN_CAP (1u << 18)

__device__ __forceinline__ unsigned xb_ld(unsigned* p)              { return __hip_atomic_load(p, __ATOMIC_RELAXED, __HIP_MEMORY_SCOPE_AGENT); }
__device__ __forceinline__ unsigned xb_add(unsigned* p, unsigned v) { return __hip_atomic_fetch_add(p, v, __ATOMIC_RELAXED, __HIP_MEMORY_SCOPE_AGENT); }
__device__ __forceinline__ unsigned xb_xcc_id() { return (unsigned)__builtin_amdgcn_s_getreg((3 << 11) | 20) & 0xFu; }
#define XB_SPIN(cond, bar) do { unsigned _sp = 0; while (cond) { __builtin_amdgcn_s_sleep(1); \
    if ((++_sp & 255u) == 0u) { if (xb_ld(&(bar)[XB_TMO])) break; if (_sp > XB_SPIN_CAP) { atomicAdd(&(bar)[XB_TMO], 1u); break; } } } } while (0)

struct XcdBarrier {
    unsigned* bar; unsigned x;
    volatile LAS unsigned* st;
};

__device__ __forceinline__ XcdBarrier xcd_barrier_post(unsigned* bar, volatile LAS unsigned* st) {
    XcdBarrier b; b.bar = bar; b.x = xb_xcc_id(); b.st = st;
    if (threadIdx.x == 0) (void)xb_add(&bar[XB_XCNT(b.x)], 1u);
    return b;
}
__device__ __forceinline__ void xcd_barrier_complete(unsigned* bar, unsigned x, unsigned& nloc, unsigned& nx) {
    const unsigned G = gridDim.x * gridDim.y * gridDim.z;
    unsigned sum, cnt, mine, sp = 0u;
    for (;;) {
        sum = 0u; cnt = 0u; mine = 0u;
#pragma unroll
        for (unsigned j = 0; j < 16; ++j) { const unsigned c = xb_ld(&bar[XB_XCNT(j)]); sum += c; cnt += (c > 0u) ? 1u : 0u; mine = (j == x) ? c : mine; }
        if (sum == G) break;
        __builtin_amdgcn_s_sleep(1);
        if ((++sp & 255u) == 0u) { if (xb_ld(&bar[XB_TMO])) break; if (sp > XB_SPIN_CAP) { atomicAdd(&bar[XB_TMO], 1u); break; } }
    }
    nloc = mine > 0u ? mine : 1u; nx = cnt > 0u ? cnt : 1u;
}

__device__ __forceinline__ void xcd_barrier(const XcdBarrier& b) {
    asm volatile("s_waitcnt vmcnt(0)" ::: "memory");
    __syncthreads();
    if (threadIdx.x == 0) {
        unsigned* bar = b.bar;
        __builtin_amdgcn_s_waitcnt(0);
        unsigned nloc = b.st[0], nx = b.st[1];
        if (nloc == 0u) { xcd_barrier_complete(bar, b.x, nloc, nx); b.st[0] = nloc; b.st[1] = nx; }
        const unsigned old = xb_add(&bar[XB_XSUB(b.x)], 1u);
        const unsigned gen = old / nloc;
        if (old + 1u == (gen + 1u) * nloc) {
            __builtin_amdgcn_fence(__ATOMIC_RELEASE, "agent");
            asm volatile("s_waitcnt vmcnt(0)" ::: "memory");
            const unsigned og = xb_add(&bar[XB_TOP], 1u);
            const unsigned tg = og / nx;
            if (og + 1u == (tg + 1u) * nx) xb_add(&bar[XB_TOPGEN], 1u);
            else XB_SPIN(xb_ld(&bar[XB_TOPGEN]) == tg, bar);
            __builtin_amdgcn_fence(__ATOMIC_ACQUIRE, "agent");
            xb_add(&bar[XB_XGEN(b.x)], 1u);
            asm volatile("s_waitcnt vmcnt(0)" ::: "memory");
        } else {
            XB_SPIN(xb_ld(&bar[XB_XGEN(b.x)]) == gen, bar);
            __builtin_amdgcn_fence(__ATOMIC_ACQUIRE, "agent");
            asm volatile("s_waitcnt vmcnt(0)" ::: "memory");
        }
    }
    __syncthreads();
}

constexpr int NWAVES = 8;
constexpr int D = 1024, NB = 4, S = 4096, T = NB * S, NL = 2, NMEM = 256, MROWS = NB * NMEM;
constexpr int DIN = 2438, NPROJ = 2560;
constexpr int PC_Z = 0, PC_XBC = 384, PC_QSB = 1024, PC_KSB = 1408, PC_VSB = 1792, PC_QMEM = 2176, PC_DT = 2432;
constexpr int CONV_CH = 640;
constexpr float EPS = 1e-6f;

constexpr int RING_BYTES = 131072;
constexpr int WSCR = 17408;
constexpr int LDSCTL_OFF = 8 * WSCR, MISC_OFF = LDSCTL_OFF + 320;
constexpr int LDS_BYTES = 147456;
constexpr int GTAB_OFF = LDSCTL_OFF + 1024;

constexpr size_t MiB = 1u << 20;
constexpr size_t WS_CTL = 0, CTL_ZERO_BYTES = 1 * MiB;
constexpr size_t WS_WIN = 2 * MiB;
constexpr size_t WS_WMEM = 12 * MiB;
constexpr size_t WS_WOUT = 14 * MiB;
constexpr size_t WS_WSC = 18 * MiB;
constexpr size_t WS_MEMB = 26 * MiB;
constexpr size_t WS_RSM = 28 * MiB;
constexpr size_t WS_RS1 = WS_RSM + 64 * 1024;
constexpr size_t WS_DTF = WS_RS1 + 64 * 1024;
constexpr size_t WS_XSSQ = 29 * MiB;
constexpr size_t WS_YSSQ = 30 * MiB;
constexpr size_t WS_MEMKV = 31 * MiB;
constexpr size_t WS_XB = 34 * MiB;
constexpr size_t WS_YCAT = 66 * MiB;
constexpr size_t WS_PROJ = 98 * MiB;
constexpr size_t WS_SCORES = 178 * MiB;
constexpr size_t WS_YPART = WS_SCORES;
constexpr size_t WS_XCONV = WS_SCORES + 24 * MiB;
constexpr size_t WS_CMG = WS_SCORES + 36 * MiB;
constexpr size_t WS_ACSG = WS_SCORES + 40 * MiB;
constexpr size_t WS_HS = WS_SCORES + 41 * MiB;
constexpr size_t WS_CD = WS_SCORES + 53 * MiB;
constexpr size_t WS_EIDX = 306 * MiB;
constexpr size_t WS_GATE = 314 * MiB;
constexpr size_t WS_STOP = 322 * MiB;
constexpr size_t WS_ITOP = 338 * MiB;
constexpr size_t WS_UT = 354 * MiB;
constexpr size_t WS_USC = 386 * MiB;
constexpr size_t WS_VT = 418 * MiB;
constexpr size_t WS_VSC = 450 * MiB;
constexpr size_t WS_END = 482 * MiB;
constexpr int CW_BAR = 4096;

__device__ __forceinline__ float bf2f(bf16 v) { return __uint_as_float((unsigned)v << 16); }
__device__ __forceinline__ unsigned pkbf(float lo, float hi) { return pg8::cvt_pk_bf16(lo, hi); }
__device__ __forceinline__ float wave_sum(float v) {
#pragma unroll
    for (int o = 1; o < 64; o <<= 1) v += __shfl_xor(v, o);
    return v;
}
__device__ __forceinline__ float softplus_f(float x) { return fmaxf(x, 0.f) + log1pf(expf(-fabsf(x))); }
__device__ __forceinline__ float silu_f(float x) { return x / (1.f + expf(-x)); }

namespace pg8 {
struct EpiInProj {
    static constexpr bool PERM = true, AFTER_DRAIN = false, KHOOK = false;
    bf16_t* O; int ldc; const float* rs; float* dtf; const float* dtb;
    __device__ __forceinline__ void operator()(const f32x4 (&acc)[2][2][4][2], const Unit& u, int wr, int wc, int fr, int fq) const {
        const int row0 = u.pm * BM + wr * 64 + fr, col0 = u.pn * BM + wc * 32 + 8 * fq;
        const bool dtl = dtf && (u.pn * BM == PC_DT - 128) && wc == 0 && fq == 0;
#pragma unroll
        for (int ai = 0; ai < 2; ++ai)
#pragma unroll
            for (int m = 0; m < 4; ++m) {
                const int row = row0 + ai * HALF + m * 16; const float s = rs[row];
#pragma unroll
                for (int bj = 0; bj < 2; ++bj) {
                    const f32x4 v0 = acc[ai][bj][m][0] * s, v1 = acc[ai][bj][m][1] * s;
                    u32x4 w; w.x = cvt_pk_bf16(v0[0], v0[1]); w.y = cvt_pk_bf16(v0[2], v0[3]); w.z = cvt_pk_bf16(v1[0], v1[1]); w.w = cvt_pk_bf16(v1[2], v1[3]);
                    *(u32x4*)(O + (size_t)row * ldc + col0 + bj * HALF) = w;
                    if (bj == 1 && dtl) {
                        f32x4 d0; d0[0] = softplus_f(v0[0] + dtb[0]); d0[1] = softplus_f(v0[1] + dtb[1]); d0[2] = softplus_f(v0[2] + dtb[2]); d0[3] = softplus_f(v0[3] + dtb[3]);
                        f32x4 d1; d1[0] = softplus_f(v1[0] + dtb[4]); d1[1] = softplus_f(v1[1] + dtb[5]); d1[2] = 0.f; d1[3] = 0.f;
                        *(f32x4*)(dtf + (size_t)row * 8) = d0; *(f32x4*)(dtf + (size_t)row * 8 + 4) = d1;
                    }
                }
            }
    }
};
__device__ __forceinline__ void group_rstd(const float* yssq, int row, float& r_ssd, float& r_sb, float& r_mem) {
    const f32x4 a = *(const f32x4*)(yssq + (size_t)row * 16), b = *(const f32x4*)(yssq + (size_t)row * 16 + 4), c = *(const f32x4*)(yssq + (size_t)row * 16 + 8), d = *(const f32x4*)(yssq + (size_t)row * 16 + 12);
    const float s0 = (a[0] + a[1]) + (a[2] + a[3]) + (b[0] + b[1]), s1 = (b[2] + b[3]) + (c[0] + c[1]) + (c[2] + c[3]), s2 = (d[0] + d[1]) + (d[2] + d[3]);
    r_ssd = rsqrtf(s0 * (1.f / 384.f) + EPS); r_sb = rsqrtf(s1 * (1.f / 384.f) + EPS); r_mem = rsqrtf(s2 * (1.f / 256.f) + EPS);
}
struct EpiOut {
    static constexpr bool PERM = false, AFTER_DRAIN = false, KHOOK = true;
    const float* base; float* out; bf16_t* xb; float* xssq; const PG8_LAS float* gtab;
    __device__ __forceinline__ void khook(f32x4 (&acc)[2][2][4][2], const Unit& u, int t, int wr, int fr) const {
        if (t != 6 && t != 12) return;
#pragma unroll
        for (int ai = 0; ai < 2; ++ai)
#pragma unroll
            for (int m = 0; m < 4; ++m) {
                const float f = gtab[(t == 6 ? 0 : 256) + ai * HALF + wr * 64 + m * 16 + fr];
#pragma unroll
                for (int bj = 0; bj < 2; ++bj)
#pragma unroll
                    for (int n = 0; n < 2; ++n) acc[ai][bj][m][n] = acc[ai][bj][m][n] * f;
            }
    }
    __device__ __forceinline__ void operator()(const f32x4 (&acc)[2][2][4][2], const Unit& u, int wr, int wc, int fr, int fq) const {
        const int col0 = u.pn * BM + wc * 32 + 4 * fq;
#pragma unroll
        for (int ai = 0; ai < 2; ++ai)
#pragma unroll
            for (int m = 0; m < 4; ++m) {
                const int row = u.pm * BM + ai * HALF + wr * 64 + m * 16 + fr; const float r2 = gtab[512 + ai * HALF + wr * 64 + m * 16 + fr];
                float q = 0.f;
#pragma unroll
                for (int bj = 0; bj < 2; ++bj)
#pragma unroll
                    for (int n = 0; n < 2; ++n) {
                        const size_t off = (size_t)row * D + col0 + bj * HALF + n * 16;
                        const f32x4 x1 = *(const f32x4*)(base + off) + acc[ai][bj][m][n] * r2;
                        *(f32x4*)(out + off) = x1;
                        typedef unsigned u32x2v __attribute__((ext_vector_type(2)));
                        u32x2v w; w.x = cvt_pk_bf16(x1[0], x1[1]); w.y = cvt_pk_bf16(x1[2], x1[3]); *(u32x2v*)(xb + off) = w;
                        q += (x1[0] * x1[0] + x1[1] * x1[1]) + (x1[2] * x1[2] + x1[3] * x1[3]);
                    }
                q += __shfl_xor(q, 16); q += __shfl_xor(q, 32);
                if (fq == 0) xssq[(size_t)row * 16 + u.pn * 4 + wc] = q;
            }
    }
};
struct EpiScores {
    static constexpr bool PERM = false, AFTER_DRAIN = false, KHOOK = false;
    float* O; const float* xssq;
    __device__ __forceinline__ void operator()(const f32x4 (&acc)[2][2][4][2], const Unit& u, int wr, int wc, int fr, int fq) const {
        const int col0 = u.pn * BM + wc * 32 + 4 * fq;
#pragma unroll
        for (int ai = 0; ai < 2; ++ai)
#pragma unroll
            for (int m = 0; m < 4; ++m) {
                const int row = u.pm * BM + ai * HALF + wr * 64 + m * 16 + fr;
                const f32x4 a = *(const f32x4*)(xssq + (size_t)row * 16), b = *(const f32x4*)(xssq + (size_t)row * 16 + 4), c = *(const f32x4*)(xssq + (size_t)row * 16 + 8), d = *(const f32x4*)(xssq + (size_t)row * 16 + 12);
                const float ss = ((a[0] + a[1]) + (a[2] + a[3])) + ((b[0] + b[1]) + (b[2] + b[3])) + ((c[0] + c[1]) + (c[2] + c[3])) + ((d[0] + d[1]) + (d[2] + d[3]));
                const float r = rsqrtf(ss * (1.f / 1024.f) + EPS);
#pragma unroll
                for (int bj = 0; bj < 2; ++bj)
#pragma unroll
                    for (int n = 0; n < 2; ++n) *(f32x4*)(O + (size_t)row * 2048 + col0 + bj * HALF + n * 16) = acc[ai][bj][m][n] * r;
            }
    }
};
}

struct Args { const float* in[22]; float* out; unsigned char* ws; int ph_lo, ph_hi, li, pad; };
enum { I_X = 0, I_MEM, I_NORM1G, I_WIN, I_CONVW, I_CONVB, I_DTBIAS, I_ALOG, I_DSKIP, I_SSDG, I_SBG, I_MEMNG, I_WMEMKV, I_MQG, I_MKG, I_MEMOG, I_WOUT, I_NORM2G, I_WQ, I_KEYS, I_PU, I_PV };

__device__ __forceinline__ int opq(int i) { asm volatile("" : "+s"(i)); return i; }
#define AIN(i) (a.in[opq(i)])
__device__ __forceinline__ void transpose_item(const float* W, int ldw, int src_c0, int nvalid, const float* g, bf16* WT, int K, int dst_r0, int k0, LAS float* scr, int lane) {
    const int c = lane & 31;
#pragma unroll 8
    for (int i = 0; i < 32; ++i) {
        const int kk = 2 * i + (lane >> 5);
        float v = (c < nvalid) ? W[(size_t)(k0 + kk) * ldw + src_c0 + c] : 0.f;
        if (g) v *= g[k0 + kk];
        scr[kk * 33 + c] = v;
    }
    LDS_WAIT(); asm volatile("" ::: "memory");
    const int c8 = lane & 7;
#pragma unroll
    for (int j = 0; j < 4; ++j) {
        const int n = (lane >> 3) + 8 * j; const LAS float* s = scr + (8 * c8) * 33 + n;
        v4u o; o.x = pkbf(s[0 * 33], s[1 * 33]); o.y = pkbf(s[2 * 33], s[3 * 33]); o.z = pkbf(s[4 * 33], s[5 * 33]); o.w = pkbf(s[6 * 33], s[7 * 33]);
        *(GAS v4u*)(WT + (size_t)(dst_r0 + n) * K + k0 + 8 * c8) = o;
    }
    LDS_WAIT(); asm volatile("" ::: "memory");
}
__device__ __forceinline__ void wsc_item(const float* wq, const float* keys, const float* g2, bf16* WscT, int hc, int kb, int nq, LAS float* scr, int lane) {
    const int k0 = kb * 64;
#pragma unroll 8
    for (int kk = 0; kk < 64; ++kk) scr[kk * 64 + ((lane + kk) & 63)] = wq[(size_t)(k0 + kk) * D + hc * 64 + lane] * g2[k0 + kk];
    LDS_WAIT(); asm volatile("" ::: "memory");
    for (int n = nq * 32; n < nq * 32 + 32; ++n) {
        const float* kp = keys + ((size_t)hc * 128 + n) * 64;
        float a = 0.f;
#pragma unroll
        for (int d = 0; d < 64; ++d) a += scr[lane * 64 + ((d + lane) & 63)] * kp[d];
        WscT[(size_t)(hc * 128 + n) * D + k0 + lane] = (bf16)(pkbf(a, 0.f) & 0xffffu);
    }
    LDS_WAIT(); asm volatile("" ::: "memory");
}
__device__ __forceinline__ void row_to_bf16(const float* xrow, bf16* orow, float* rs, int lane) {
    const GAS f32x4* xr = (const GAS f32x4*)xrow + lane;
    f32x4 v[4]; float s = 0.f;
#pragma unroll
    for (int j = 0; j < 4; ++j) { v[j] = xr[64 * j]; s += (v[j].x * v[j].x + v[j].y * v[j].y) + (v[j].z * v[j].z + v[j].w * v[j].w); }
    s = wave_sum(s);
    GAS unsigned long long* o8 = (GAS unsigned long long*)orow + lane;
#pragma unroll
    for (int j = 0; j < 4; ++j) o8[64 * j] = (unsigned long long)pkbf(v[j].x, v[j].y) | ((unsigned long long)pkbf(v[j].z, v[j].w) << 32);
    if (lane == 0) *rs = rsqrtf(s * (1.f / 1024.f) + EPS);
}
__device__ __forceinline__ void ph_prologue(const Args& a, unsigned char* ws, LAS unsigned char* lds, int gw, int NGW, int wave, int lane) {
    LAS float* scr = (LAS float*)(lds + wave * 16384);
    constexpr int I_IN = 80 * 16, I_MEMW = 16 * 16, I_OUT = 32 * 16, I_SC = 16 * 16 * 4, PER_L = I_IN + I_MEMW + I_OUT + I_SC;
    constexpr int NW_ITEMS = NL * PER_L, NITEMS = NW_ITEMS + T + MROWS + 2 * NL * 16384;
    for (int it = gw; it < NITEMS; it += NGW) {
        if (it < NW_ITEMS) {
            const int l = it / PER_L; int r = it % PER_L;
            if (r < I_IN) {
                const int j = r / 16, kb = r % 16;
                const int src = (j < 32) ? 32 * j : (j < 76 ? 32 * j + 6 : 1024), nv = (j < 76) ? 32 : (j == 76 ? 6 : 0);
                transpose_item(AIN(I_WIN) + (size_t)l * D * DIN, DIN, src, nv, AIN(I_NORM1G) + l * D, (bf16*)(ws + WS_WIN) + (size_t)l * NPROJ * D, D, 32 * j, 64 * kb, scr, lane);
                continue;
            }
            r -= I_IN;
            if (r < I_MEMW) {
                const int j = r / 16, kb = r % 16;
                transpose_item(AIN(I_WMEMKV) + (size_t)l * D * 512, 512, 32 * j, 32, AIN(I_MEMNG) + l * D, (bf16*)(ws + WS_WMEM) + (size_t)l * 512 * D, D, 32 * j, 64 * kb, scr, lane);
                continue;
            }
            r -= I_MEMW;
            if (r < I_OUT) {
                const int j = r / 16, kb = r % 16;
                const float* g = (kb < 6) ? AIN(I_SSDG) + l * 384 : (kb < 12 ? AIN(I_SBG) + l * 384 - 384 : AIN(I_MEMOG) + l * 256 - 768);
                transpose_item(AIN(I_WOUT) + (size_t)l * D * D, D, 32 * j, 32, g, (bf16*)(ws + WS_WOUT) + (size_t)l * D * D, D, 32 * j, 64 * kb, scr, lane);
                continue;
            }
            r -= I_OUT;
            { const int nq = r & 3, kb = (r >> 2) & 15, hc = r >> 6;
              wsc_item(AIN(I_WQ) + (size_t)l * D * D, AIN(I_KEYS) + (size_t)l * 16 * 128 * 64, AIN(I_NORM2G) + l * D, (bf16*)(ws + WS_WSC) + (size_t)l * 2048 * D, hc, kb, nq, scr, lane); }
            continue;
        }
        int r = it - NW_ITEMS;
        if (r < T) { row_to_bf16(AIN(I_X) + (size_t)r * D, (bf16*)(ws + WS_XB) + (size_t)r * D, (float*)(ws + WS_RS1) + r, lane); continue; }
        r -= T;
        if (r < MROWS) { row_to_bf16(AIN(I_MEM) + (size_t)r * D, (bf16*)(ws + WS_MEMB) + (size_t)r * D, (float*)(ws + WS_RSM) + r, lane); continue; }
        r -= MROWS;
        { const int tb = r >> 15, e = r & 32767;
          const float* src = (tb == 0 ? AIN(I_PU) : AIN(I_PV)) + (size_t)e * D; unsigned* dst = (unsigned*)(ws + (tb == 0 ? WS_UT : WS_VT) + (size_t)e * D);
          const float* g = AIN(I_NORM2G) + (e >> 14) * D;
          f32x4 v[4]; float am = 0.f;
#pragma unroll
          for (int j = 0; j < 4; ++j) { v[j] = *((const GAS f32x4*)src + 64 * j + lane); if (tb == 0) v[j] = v[j] * *((const GAS f32x4*)g + 64 * j + lane);
              am = fmaxf(fmaxf(am, fmaxf(fabsf(v[j].x), fabsf(v[j].y))), fmaxf(fabsf(v[j].z), fabsf(v[j].w))); }
#pragma unroll
          for (int o = 1; o < 64; o <<= 1) am = fmaxf(am, __shfl_xor(am, o));
          const float sc = am > 0.f ? 256.f / am : 1.f;
#pragma unroll
          for (int j = 0; j < 4; ++j) { int pk = 0; pk = __builtin_amdgcn_cvt_pk_fp8_f32(v[j].x * sc, v[j].y * sc, pk, false); pk = __builtin_amdgcn_cvt_pk_fp8_f32(v[j].z * sc, v[j].w * sc, pk, true); dst[64 * j + lane] = (unsigned)pk; }
          if (lane == 0) ((float*)(ws + (tb == 0 ? WS_USC : WS_VSC)))[e] = am > 0.f ? am * (1.f / 256.f) : 1.f; }
    }
}


typedef __attribute__((ext_vector_type(8))) __bf16 bf8_t;
typedef __attribute__((ext_vector_type(8))) float f32x8;
typedef __attribute__((ext_vector_type(8))) short s16x8;
typedef __attribute__((ext_vector_type(4))) short s16x4;
typedef __attribute__((ext_vector_type(16))) float f32x16;
typedef unsigned u32x2 __attribute__((ext_vector_type(2)));
#define MFMA32(a, b, c) __builtin_amdgcn_mfma_f32_32x32x16_bf16((a), (b), (c), 0, 0, 0)
__device__ __forceinline__ int crow(int i, int h) { return (i & 3) + 8 * (i >> 2) + 4 * h; }
__device__ __forceinline__ s16x8 cvt8(const f32x8 x) { return __builtin_bit_cast(s16x8, __builtin_convertvector(x, bf8_t)); }
__device__ __forceinline__ s16x8 pack_acc(const f32x16& x, int s) { f32x8 v;
#pragma unroll
    for (int j = 0; j < 8; ++j) v[j] = x[8 * s + j];
    return cvt8(v); }
__device__ __forceinline__ s16x8 cat4(const s16x4 lo, const s16x4 hi) { return __builtin_shufflevector(lo, hi, 0, 1, 2, 3, 4, 5, 6, 7); }
__device__ __forceinline__ f32x16 zero16() { f32x16 z;
#pragma unroll
    for (int i = 0; i < 16; ++i) z[i] = 0.f;
    return z; }
constexpr int L_BM = 0, L_CM = 18432, L_BMT = 36864, L_XDT = 54272, L_ACS = 106496, L_DT = 108032, L_TOT = 109568;

__device__ __forceinline__ void ssd_chunk_unit(const Args& a, unsigned char* ws, LAS unsigned char* lds, int l_, int unit, int tid, int wave, int lane) {
    const int g = unit & 1, c = (unit >> 1) & 31, b = unit >> 6, t0 = b * S + c * 128;
    const bf16* proj = (const bf16*)(ws + WS_PROJ); const float* dtf = (const float*)(ws + WS_DTF);
    LAS float* acs = (LAS float*)(lds + L_ACS); LAS float* dts = (LAS float*)(lds + L_DT); LAS float* tot = (LAS float*)(lds + L_TOT);
    float cs = 0.f, dtv = 0.f;
    if (wave < 6) {
        const int hh = wave >> 1, l = (wave & 1) * 64 + lane;
        dtv = dtf[(size_t)(t0 + l) * 8 + 3 * g + hh];
        cs = dtv * -expf(AIN(I_ALOG)[l_ * 6 + 3 * g + hh]);
#pragma unroll
        for (int o = 1; o < 64; o <<= 1) { const float t = __shfl_up(cs, o); if (lane >= o) cs += t; }
        if (lane == 63) tot[wave] = cs;
    }
    __syncthreads();
    if (wave < 6) {
        const int hh = wave >> 1, l = (wave & 1) * 64 + lane;
        if (wave & 1) cs += tot[wave - 1];
        acs[hh * 128 + l] = cs; dts[hh * 128 + l] = dtv;
        ((float*)(ws + WS_ACSG))[(size_t)(t0 + l) * 8 + 3 * g + hh] = cs;
    }
    __syncthreads();
    const float* cw = AIN(I_CONVW) + l_ * 4 * CONV_CH; const float* cb = AIN(I_CONVB) + l_ * CONV_CH;
#pragma unroll 2
    for (int it = 0; it < 10; ++it) {
        const int idx = tid + 512 * it, l = idx / 40, ck = idx % 40;
        int cc, kind, hh = 0, e0;
        if (ck < 24) { hh = ck >> 3; e0 = (ck & 7) * 8; cc = (3 * g + hh) * 64 + e0; kind = 0; }
        else if (ck < 32) { e0 = (ck - 24) * 8; cc = 384 + g * 64 + e0; kind = 1; }
        else { e0 = (ck - 32) * 8; cc = 512 + g * 64 + e0; kind = 2; }
        float acc[8];
        { const f32x4 b0 = *(const f32x4*)(cb + cc), b1 = *(const f32x4*)(cb + cc + 4); acc[0] = b0.x; acc[1] = b0.y; acc[2] = b0.z; acc[3] = b0.w; acc[4] = b1.x; acc[5] = b1.y; acc[6] = b1.z; acc[7] = b1.w; }
#pragma unroll
        for (int k = 0; k < 4; ++k) {
            const int sl = c * 128 + l - 3 + k;
            if (sl >= 0) {
                const v4u xv = *(const GAS v4u*)(proj + (size_t)(t0 + l - 3 + k) * NPROJ + PC_XBC + cc);
                const f32x4 w0 = *(const f32x4*)(cw + k * CONV_CH + cc), w1 = *(const f32x4*)(cw + k * CONV_CH + cc + 4);
                acc[0] += w0.x * __uint_as_float(xv.x << 16); acc[1] += w0.y * __uint_as_float(xv.x & 0xffff0000u);
                acc[2] += w0.z * __uint_as_float(xv.y << 16); acc[3] += w0.w * __uint_as_float(xv.y & 0xffff0000u);
                acc[4] += w1.x * __uint_as_float(xv.z << 16); acc[5] += w1.y * __uint_as_float(xv.z & 0xffff0000u);
                acc[6] += w1.z * __uint_as_float(xv.w << 16); acc[7] += w1.w * __uint_as_float(xv.w & 0xffff0000u);
            }
        }
#pragma unroll
        for (int e = 0; e < 8; ++e) acc[e] = silu_f(acc[e]);
        v4u pk; pk.x = pkbf(acc[0], acc[1]); pk.y = pkbf(acc[2], acc[3]); pk.z = pkbf(acc[4], acc[5]); pk.w = pkbf(acc[6], acc[7]);
        if (kind == 0) {
            *(GAS v4u*)((bf16*)(ws + WS_XCONV) + (size_t)(t0 + l) * 384 + (3 * g + hh) * 64 + e0) = pk;
            const float d = dts[hh * 128 + l];
            LAS bf16* xd = (LAS bf16*)(lds + L_XDT) + (hh * 64 + e0) * 136 + l;
#pragma unroll
            for (int e = 0; e < 8; e += 2) { const unsigned w = pkbf(acc[e] * d, acc[e + 1] * d); xd[e * 136] = (bf16)(w & 0xffffu); xd[(e + 1) * 136] = (bf16)(w >> 16); }
        } else if (kind == 1) {
            *(LAS v4u*)(lds + L_BM + (l * 72 + e0) * 2) = pk;
            LAS bf16* bt = (LAS bf16*)(lds + L_BMT) + e0 * 136 + l;
            bt[0 * 136] = (bf16)(pk.x & 0xffffu); bt[1 * 136] = (bf16)(pk.x >> 16); bt[2 * 136] = (bf16)(pk.y & 0xffffu); bt[3 * 136] = (bf16)(pk.y >> 16);
            bt[4 * 136] = (bf16)(pk.z & 0xffffu); bt[5 * 136] = (bf16)(pk.z >> 16); bt[6 * 136] = (bf16)(pk.w & 0xffffu); bt[7 * 136] = (bf16)(pk.w >> 16);
        } else {
            *(LAS v4u*)(lds + L_CM + (l * 72 + e0) * 2) = pk;
            *(GAS v4u*)((bf16*)(ws + WS_CMG) + (size_t)(t0 + l) * 128 + g * 64 + e0) = pk;
        }
    }
    __syncthreads();
    const int r = lane & 31, h = lane >> 5, lb = wave & 3, pt = wave >> 2;
    {
        s16x8 cf[4];
#pragma unroll
        for (int ks = 0; ks < 4; ++ks) cf[ks] = *(const LAS s16x8*)(lds + L_CM + ((lb * 32 + r) * 72 + ks * 16 + 8 * h) * 2);
        f32x16 gt[4];
#pragma unroll
        for (int sb = 0; sb < 4; ++sb) {
            gt[sb] = zero16();
            if (sb <= lb) {
#pragma unroll
                for (int ks = 0; ks < 4; ++ks) gt[sb] = MFMA32(*(const LAS s16x8*)(lds + L_BM + ((sb * 32 + r) * 72 + ks * 16 + 8 * h) * 2), cf[ks], gt[sb]);
            }
        }
#pragma unroll
        for (int hh = 0; hh < 3; ++hh) {
            const float al = acs[hh * 128 + lb * 32 + r];
            f32x16 yacc = zero16();
#pragma unroll
            for (int sb = 0; sb < 4; ++sb) {
                if (sb <= lb) {
                    f32x16 m;
#pragma unroll
                    for (int i = 0; i < 16; ++i) {
                        const int sl = crow(i, h);
                        const float v = gt[sb][i] * __expf(al - acs[hh * 128 + sb * 32 + sl]);
                        m[i] = (sb < lb || sl <= r) ? v : 0.f;
                    }
#pragma unroll
                    for (int ks = 0; ks < 2; ++ks) {
                        const LAS unsigned char* xp = lds + L_XDT + ((hh * 64 + pt * 32 + r) * 136 + sb * 32 + 16 * ks + 4 * h) * 2;
                        yacc = MFMA32(cat4(*(const LAS s16x4*)xp, *(const LAS s16x4*)(xp + 16)), pack_acc(m, ks), yacc);
                    }
                }
            }
            float* yp = (float*)(ws + WS_YPART) + (size_t)(t0 + lb * 32 + r) * 384 + (3 * g + hh) * 64 + pt * 32 + 4 * h;
#pragma unroll
            for (int i4 = 0; i4 < 4; ++i4) *(f32x4*)(yp + 8 * i4) = (f32x4){yacc[4 * i4], yacc[4 * i4 + 1], yacc[4 * i4 + 2], yacc[4 * i4 + 3]};
        }
    }
    for (int tl = wave; tl < 12; tl += 8) {
        const int hh = tl >> 2, nt = (tl >> 1) & 1, pt2 = tl & 1;
        const float alast = acs[hh * 128 + 127];
        f32x16 acc = zero16();
#pragma unroll
        for (int ks = 0; ks < 8; ++ks) {
            const s16x8 af = *(const LAS s16x8*)(lds + L_BMT + ((nt * 32 + r) * 136 + ks * 16 + 8 * h) * 2);
            const v4u xr = *(const LAS v4u*)(lds + L_XDT + ((hh * 64 + pt2 * 32 + r) * 136 + ks * 16 + 8 * h) * 2);
            const LAS float* ap = acs + hh * 128 + ks * 16 + 8 * h;
            f32x8 xf;
            xf[0] = __uint_as_float(xr.x << 16) * __expf(alast - ap[0]); xf[1] = __uint_as_float(xr.x & 0xffff0000u) * __expf(alast - ap[1]);
            xf[2] = __uint_as_float(xr.y << 16) * __expf(alast - ap[2]); xf[3] = __uint_as_float(xr.y & 0xffff0000u) * __expf(alast - ap[3]);
            xf[4] = __uint_as_float(xr.z << 16) * __expf(alast - ap[4]); xf[5] = __uint_as_float(xr.z & 0xffff0000u) * __expf(alast - ap[5]);
            xf[6] = __uint_as_float(xr.w << 16) * __expf(alast - ap[6]); xf[7] = __uint_as_float(xr.w & 0xffff0000u) * __expf(alast - ap[7]);
            acc = MFMA32(af, cvt8(xf), acc);
        }
        float* hp = (float*)(ws + WS_HS) + ((size_t)((b * 32 + c) * 6 + 3 * g + hh) * 64 + pt2 * 32 + r) * 64 + nt * 32 + 4 * h;
#pragma unroll
        for (int i4 = 0; i4 < 4; ++i4) *(f32x4*)(hp + 8 * i4) = (f32x4){acc[4 * i4], acc[4 * i4 + 1], acc[4 * i4 + 2], acc[4 * i4 + 3]};
    }
    if (tid < 3) ((float*)(ws + WS_CD))[(b * 32 + c) * 6 + 3 * g + tid] = __expf(acs[tid * 128 + 127]);
    __syncthreads();
}
__device__ __forceinline__ void ph_ssd_scan(unsigned char* ws, int bx, int G, int tid) {
    float* hs = (float*)(ws + WS_HS); const float* cd = (const float*)(ws + WS_CD);
    for (int e = bx * 512 + tid; e < 24 * 4096; e += G * 512) {
        const int bh = e >> 12, el = e & 4095, b = bh / 6, hh = bh % 6;
        float run = 0.f;
#pragma unroll 4
        for (int c = 0; c < 32; ++c) {
            const int idx = (b * 32 + c) * 6 + hh;
            const float v = hs[(size_t)idx * 4096 + el], d = cd[idx];
            hs[(size_t)idx * 4096 + el] = run; run = run * d + v;
        }
    }
}
__device__ __forceinline__ void ssd_finish_unit(const Args& a, unsigned char* ws, int l_, int unit, int wave, int lane) {
    const int g = unit & 1, c = (unit >> 1) & 31, b = unit >> 6, t0 = b * S + c * 128;
    const int r = lane & 31, h = lane >> 5, lb = wave & 3, hsel = wave >> 2;
    const int t = t0 + lb * 32 + r;
    const bf16* proj = (const bf16*)(ws + WS_PROJ); const bf16* cmg = (const bf16*)(ws + WS_CMG) + (size_t)t * 128 + g * 64;
    s16x8 cf[4];
#pragma unroll
    for (int ks = 0; ks < 4; ++ks) cf[ks] = *(const GAS s16x8*)(cmg + ks * 16 + 8 * h);
    for (int hh = hsel ? 2 : 0; hh < (hsel ? 3 : 2); ++hh) {
        const int hd = 3 * g + hh;
        const float* hin = (const float*)(ws + WS_HS) + (size_t)((b * 32 + c) * 6 + hd) * 4096;
        const float ea = __expf(((const float*)(ws + WS_ACSG))[(size_t)t * 8 + hd]), dsk = AIN(I_DSKIP)[l_ * 6 + hd];
        float ssq = 0.f;
#pragma unroll
        for (int pt = 0; pt < 2; ++pt) {
            f32x16 acc = zero16();
#pragma unroll
            for (int ks = 0; ks < 4; ++ks) {
                const float* hp = hin + (pt * 32 + r) * 64 + ks * 16 + 8 * h;
                const f32x4 h0 = *(const GAS f32x4*)hp, h1 = *(const GAS f32x4*)(hp + 4);
                acc = MFMA32(cvt8((f32x8){h0.x, h0.y, h0.z, h0.w, h1.x, h1.y, h1.z, h1.w}), cf[ks], acc);
            }
#pragma unroll
            for (int i4 = 0; i4 < 4; ++i4) {
                const int col = hd * 64 + pt * 32 + 8 * i4 + 4 * h;
                const f32x4 yp = *(const GAS f32x4*)((const float*)(ws + WS_YPART) + (size_t)t * 384 + col);
                const u32x2 xc = *(const GAS u32x2*)((const bf16*)(ws + WS_XCONV) + (size_t)t * 384 + col);
                const u32x2 zz = *(const GAS u32x2*)(proj + (size_t)t * NPROJ + PC_Z + col);
                const float y0 = (yp.x + acc[4 * i4 + 0] * ea + dsk * __uint_as_float(xc.x << 16)) * silu_f(__uint_as_float(zz.x << 16));
                const float y1 = (yp.y + acc[4 * i4 + 1] * ea + dsk * __uint_as_float(xc.x & 0xffff0000u)) * silu_f(__uint_as_float(zz.x & 0xffff0000u));
                const float y2 = (yp.z + acc[4 * i4 + 2] * ea + dsk * __uint_as_float(xc.y << 16)) * silu_f(__uint_as_float(zz.y << 16));
                const float y3 = (yp.w + acc[4 * i4 + 3] * ea + dsk * __uint_as_float(xc.y & 0xffff0000u)) * silu_f(__uint_as_float(zz.y & 0xffff0000u));
                ssq += (y0 * y0 + y1 * y1) + (y2 * y2 + y3 * y3);
                u32x2 w; w.x = pkbf(y0, y1); w.y = pkbf(y2, y3);
                *(GAS u32x2*)((bf16*)(ws + WS_YCAT) + (size_t)t * D + col) = w;
            }
        }
        ssq += __shfl_xor(ssq, 32);
        if (h == 0) ((float*)(ws + WS_YSSQ))[(size_t)t * 16 + hd] = ssq;
    }
}

#define LOG2E 1.4426950408889634f
__device__ __forceinline__ s16x8 trv_frag(const LAS unsigned char* vimg, int key0, int ks, int dt, int lane) {
    const int h = lane >> 5, i16 = lane & 15, blk = (lane >> 4) & 1;
    const LAS unsigned char* p = vimg + (key0 + 16 * ks + 4 * h + (i16 >> 2)) * 144 + (dt * 32 + 16 * blk) * 2 + 8 * (i16 & 3);
    const s16x4 lo = __builtin_amdgcn_ds_read_tr16_b64_v4i16((LAS s16x4*)p), hi = __builtin_amdgcn_ds_read_tr16_b64_v4i16((LAS s16x4*)(p + 8 * 144));
    return cat4(lo, hi);
}
__device__ __forceinline__ void mem_unit(const Args& a, unsigned char* ws, LAS unsigned char* lds, int l_, int b, int hd, int qb, int tid, int wave, int lane) {
    const bf16* proj = (const bf16*)(ws + WS_PROJ); const bf16* memkv = (const bf16*)(ws + WS_MEMKV);
    const float* qg = AIN(I_MQG) + l_ * 64; const float* kg = AIN(I_MKG) + l_ * 64;
    LAS unsigned char* kimg = lds; LAS unsigned char* vimg = lds + 36864;
#pragma unroll
    for (int it = 0; it < 4; ++it) {
        const int idx = tid + 512 * it, m = idx >> 3, ch = idx & 7;
        const v4u kv = *(const GAS v4u*)(memkv + (size_t)(b * NMEM + m) * 512 + hd * 64 + ch * 8);
        const v4u vv = *(const GAS v4u*)(memkv + (size_t)(b * NMEM + m) * 512 + 256 + hd * 64 + ch * 8);
        float kf[8] = {__uint_as_float(kv.x << 16), __uint_as_float(kv.x & 0xffff0000u), __uint_as_float(kv.y << 16), __uint_as_float(kv.y & 0xffff0000u),
                       __uint_as_float(kv.z << 16), __uint_as_float(kv.z & 0xffff0000u), __uint_as_float(kv.w << 16), __uint_as_float(kv.w & 0xffff0000u)};
        float ss = 0.f;
#pragma unroll
        for (int e = 0; e < 8; ++e) ss += kf[e] * kf[e];
        ss += __shfl_xor(ss, 1); ss += __shfl_xor(ss, 2); ss += __shfl_xor(ss, 4);
        const float rk = rsqrtf(ss * (1.f / 64.f) + EPS);
        const f32x4 g0 = *(const f32x4*)(kg + ch * 8), g1 = *(const f32x4*)(kg + ch * 8 + 4);
        v4u pk; pk.x = pkbf(kf[0] * rk * g0.x, kf[1] * rk * g0.y); pk.y = pkbf(kf[2] * rk * g0.z, kf[3] * rk * g0.w); pk.z = pkbf(kf[4] * rk * g1.x, kf[5] * rk * g1.y); pk.w = pkbf(kf[6] * rk * g1.z, kf[7] * rk * g1.w);
        *(LAS v4u*)(kimg + (m * 72 + ch * 8) * 2) = pk;
        *(LAS v4u*)(vimg + (m * 72 + ch * 8) * 2) = vv;
    }
    __syncthreads();
    const int r = lane & 31, h = lane >> 5;
    const int t = b * S + qb * 256 + wave * 32 + r;
    s16x8 qf[4];
    {
        f32x8 qv[4]; float ss = 0.f;
#pragma unroll
        for (int ks = 0; ks < 4; ++ks) {
            const v4u q = *(const GAS v4u*)(proj + (size_t)t * NPROJ + PC_QMEM + hd * 64 + ks * 16 + 8 * h);
            qv[ks] = (f32x8){__uint_as_float(q.x << 16), __uint_as_float(q.x & 0xffff0000u), __uint_as_float(q.y << 16), __uint_as_float(q.y & 0xffff0000u),
                             __uint_as_float(q.z << 16), __uint_as_float(q.z & 0xffff0000u), __uint_as_float(q.w << 16), __uint_as_float(q.w & 0xffff0000u)};
#pragma unroll
            for (int e = 0; e < 8; ++e) ss += qv[ks][e] * qv[ks][e];
        }
        ss += __shfl_xor(ss, 32);
        const float rq = rsqrtf(ss * (1.f / 64.f) + EPS) * (0.125f * LOG2E);
#pragma unroll
        for (int ks = 0; ks < 4; ++ks) {
            const f32x4 g0 = *(const f32x4*)(qg + ks * 16 + 8 * h), g1 = *(const f32x4*)(qg + ks * 16 + 8 * h + 4);
            qf[ks] = cvt8(qv[ks] * rq * (f32x8){g0.x, g0.y, g0.z, g0.w, g1.x, g1.y, g1.z, g1.w});
        }
    }
    f32x16 st[8];
    float mx = -INFINITY;
#pragma unroll
    for (int kt = 0; kt < 8; ++kt) {
        st[kt] = zero16();
#pragma unroll
        for (int ks = 0; ks < 4; ++ks) st[kt] = MFMA32(*(const LAS s16x8*)(kimg + ((kt * 32 + r) * 72 + ks * 16 + 8 * h) * 2), qf[ks], st[kt]);
#pragma unroll
        for (int i = 0; i < 16; ++i) mx = fmaxf(mx, st[kt][i]);
    }
    mx = fmaxf(mx, __shfl_xor(mx, 32));
    float lsum = 0.f;
    f32x16 o0 = zero16(), o1 = zero16();
#pragma unroll
    for (int kt = 0; kt < 8; ++kt) {
#pragma unroll
        for (int i = 0; i < 16; ++i) { st[kt][i] = __builtin_amdgcn_exp2f(st[kt][i] - mx); lsum += st[kt][i]; }
#pragma unroll
        for (int ks = 0; ks < 2; ++ks) {
            const s16x8 pf = pack_acc(st[kt], ks);
            o0 = MFMA32(trv_frag(vimg, kt * 32, ks, 0, lane), pf, o0);
            o1 = MFMA32(trv_frag(vimg, kt * 32, ks, 1, lane), pf, o1);
        }
    }
    lsum += __shfl_xor(lsum, 32);
    const float il = 1.f / lsum; float ssq = 0.f;
    bf16* yc = (bf16*)(ws + WS_YCAT) + (size_t)t * D + 768 + hd * 64 + 4 * h;
#pragma unroll
    for (int i4 = 0; i4 < 4; ++i4) {
        const float a0 = o0[4 * i4] * il, a1 = o0[4 * i4 + 1] * il, a2 = o0[4 * i4 + 2] * il, a3 = o0[4 * i4 + 3] * il;
        const float b0 = o1[4 * i4] * il, b1 = o1[4 * i4 + 1] * il, b2 = o1[4 * i4 + 2] * il, b3 = o1[4 * i4 + 3] * il;
        ssq += (a0 * a0 + a1 * a1) + (a2 * a2 + a3 * a3) + (b0 * b0 + b1 * b1) + (b2 * b2 + b3 * b3);
        u32x2 w; w.x = pkbf(a0, a1); w.y = pkbf(a2, a3); *(GAS u32x2*)(yc + 8 * i4) = w;
        w.x = pkbf(b0, b1); w.y = pkbf(b2, b3); *(GAS u32x2*)(yc + 32 + 8 * i4) = w;
    }
    ssq += __shfl_xor(ssq, 32);
    if (h == 0) ((float*)(ws + WS_YSSQ))[(size_t)t * 16 + 12 + hd] = ssq;
    __syncthreads();
}
__device__ __forceinline__ void sb_unit(unsigned char* ws, LAS unsigned char* lds, int b, int hd, int qb, int tid, int wave, int lane) {
    const bf16* proj = (const bf16*)(ws + WS_PROJ);
    const int r = lane & 31, h = lane >> 5;
    const int q0w = qb * 256 + wave * 32, t = b * S + q0w + r;
    s16x8 qf[4];
#pragma unroll
    for (int ks = 0; ks < 4; ++ks) {
        const v4u q = *(const GAS v4u*)(proj + (size_t)t * NPROJ + PC_QSB + hd * 64 + ks * 16 + 8 * h);
        const f32x8 qv = (f32x8){__uint_as_float(q.x << 16), __uint_as_float(q.x & 0xffff0000u), __uint_as_float(q.y << 16), __uint_as_float(q.y & 0xffff0000u),
                                 __uint_as_float(q.z << 16), __uint_as_float(q.z & 0xffff0000u), __uint_as_float(q.w << 16), __uint_as_float(q.w & 0xffff0000u)};
        qf[ks] = cvt8(qv * (0.125f * LOG2E));
    }
    const int srow = tid >> 3, sch = tid & 7;
    const bf16* kbase = proj + (size_t)(b * S) * NPROJ + PC_KSB + hd * 64 + sch * 8;
    const int ktop = qb * 4 + 3;
    v4u kr = *(const GAS v4u*)(kbase + (size_t)(ktop * 64 + srow) * NPROJ), vr = *(const GAS v4u*)(kbase + (size_t)(ktop * 64 + srow) * NPROJ + (PC_VSB - PC_KSB));
    *(LAS v4u*)(lds + (srow * 72 + sch * 8) * 2) = kr; *(LAS v4u*)(lds + 9216 + (srow * 72 + sch * 8) * 2) = vr;
    __syncthreads();
    f32x16 o0 = zero16(), o1 = zero16();
    float R = 0.f;
    for (int kt = ktop; kt >= 0; --kt) {
        LAS unsigned char* kimg = lds + ((ktop - kt) & 1) * 18432; LAS unsigned char* vimg = kimg + 9216;
        if (kt > 0) { kr = *(const GAS v4u*)(kbase + (size_t)((kt - 1) * 64 + srow) * NPROJ); vr = *(const GAS v4u*)(kbase + (size_t)((kt - 1) * 64 + srow) * NPROJ + (PC_VSB - PC_KSB)); }
#pragma unroll
        for (int sub = 1; sub >= 0; --sub) {
            const int kb = kt * 64 + sub * 32;
            if (kb <= q0w) {
                const bool diag = (kb == q0w);
                f32x16 z = zero16();
#pragma unroll
                for (int ks = 0; ks < 4; ++ks) z = MFMA32(*(const LAS s16x8*)(kimg + ((sub * 32 + r) * 72 + ks * 16 + 8 * h) * 2), qf[ks], z);
                float lk[16];
#pragma unroll
                for (int i = 0; i < 16; ++i) {
                    const float sp = fmaxf(z[i], 0.f) + __builtin_amdgcn_logf(1.f + __builtin_amdgcn_exp2f(-fabsf(z[i])));
                    const bool ok = !diag || (crow(i, h) < r);
                    lk[i] = ok ? -sp : 0.f;
                    z[i] = ok ? z[i] : -INFINITY;
                }
                float g[4], pg[4];
#pragma unroll
                for (int j = 0; j < 4; ++j) { g[j] = (lk[4 * j] + lk[4 * j + 1]) + (lk[4 * j + 2] + lk[4 * j + 3]); pg[j] = __shfl_xor(g[j], 32); }
                float ab[4];
                ab[3] = R + (h == 0 ? pg[3] : 0.f);
#pragma unroll
                for (int j = 2; j >= 0; --j) ab[j] = ab[j + 1] + g[j + 1] + (h == 0 ? pg[j] : pg[j + 1]);
#pragma unroll
                for (int j = 0; j < 4; ++j) {
                    const float s3 = ab[j], s2 = s3 + lk[4 * j + 3], s1 = s2 + lk[4 * j + 2], s0 = s1 + lk[4 * j + 1];
                    z[4 * j + 3] = __builtin_amdgcn_exp2f(z[4 * j + 3] + lk[4 * j + 3] + s3);
                    z[4 * j + 2] = __builtin_amdgcn_exp2f(z[4 * j + 2] + lk[4 * j + 2] + s2);
                    z[4 * j + 1] = __builtin_amdgcn_exp2f(z[4 * j + 1] + lk[4 * j + 1] + s1);
                    z[4 * j + 0] = __builtin_amdgcn_exp2f(z[4 * j + 0] + lk[4 * j + 0] + s0);
                }
                R = ab[0] + g[0] + (h == 0 ? 0.f : pg[0]);
#pragma unroll
                for (int ks = 0; ks < 2; ++ks) {
                    const s16x8 pf = pack_acc(z, ks);
                    o0 = MFMA32(trv_frag(vimg, sub * 32, ks, 0, lane), pf, o0);
                    o1 = MFMA32(trv_frag(vimg, sub * 32, ks, 1, lane), pf, o1);
                }
            }
        }
        if (kt > 0) { LAS unsigned char* nimg = lds + ((ktop - kt + 1) & 1) * 18432; *(LAS v4u*)(nimg + (srow * 72 + sch * 8) * 2) = kr; *(LAS v4u*)(nimg + 9216 + (srow * 72 + sch * 8) * 2) = vr; }
        __syncthreads();
    }
    float ssq = 0.f;
    bf16* yc = (bf16*)(ws + WS_YCAT) + (size_t)t * D + 384 + hd * 64 + 4 * h;
#pragma unroll
    for (int i4 = 0; i4 < 4; ++i4) {
        const float a0 = o0[4 * i4], a1 = o0[4 * i4 + 1], a2 = o0[4 * i4 + 2], a3 = o0[4 * i4 + 3];
        const float b0 = o1[4 * i4], b1 = o1[4 * i4 + 1], b2 = o1[4 * i4 + 2], b3 = o1[4 * i4 + 3];
        ssq += (a0 * a0 + a1 * a1) + (a2 * a2 + a3 * a3) + (b0 * b0 + b1 * b1) + (b2 * b2 + b3 * b3);
        u32x2 w; w.x = pkbf(a0, a1); w.y = pkbf(a2, a3); *(GAS u32x2*)(yc + 8 * i4) = w;
        w.x = pkbf(b0, b1); w.y = pkbf(b2, b3); *(GAS u32x2*)(yc + 32 + 8 * i4) = w;
    }
    ssq += __shfl_xor(ssq, 32);
    if (h == 0) ((float*)(ws + WS_YSSQ))[(size_t)t * 16 + 6 + hd] = ssq;
}
constexpr int CW_Q = 8192;
__device__ __forceinline__ void ph_mix(const Args& a, unsigned char* ws, LAS unsigned char* lds, int l, int qoff, int tid, int wave, int lane) {
    unsigned* head = (unsigned*)(ws + WS_CTL) + CW_Q + 64 * l + qoff;
    volatile LAS unsigned* slot = (volatile LAS unsigned*)(lds + MISC_OFF);
    for (int it = 0;; ++it) {
        if (tid == 0) slot[it & 1] = __hip_atomic_fetch_add(head, 1u, __ATOMIC_RELAXED, __HIP_MEMORY_SCOPE_AGENT);
        __syncthreads();
        const int n = (int)slot[it & 1];
        if (n >= 896) break;
        asm volatile("" : "+s"(ws), "+v"(tid));
        lane = tid & 63; wave = __builtin_amdgcn_readfirstlane(tid >> 6);
        if (n < 384) { const int qb = 15 - n / 24, bh = n % 24; sb_unit(ws, lds, bh / 6, bh % 6, qb, tid, wave, lane); }
        else if (n < 640) { const int m = n - 384; mem_unit(a, ws, lds, l, m >> 6, (m >> 4) & 3, m & 15, tid, wave, lane); }
        else ssd_chunk_unit(a, ws, lds, l, n - 640, tid, wave, lane);
    }
}

__device__ __forceinline__ unsigned f2o(float f) { const unsigned b = __float_as_uint(f); return b ^ ((unsigned)((int)b >> 31) | 0x80000000u); }
__device__ __forceinline__ float o2f(unsigned k) { return __uint_as_float(k ^ ((k & 0x80000000u) ? 0x80000000u : 0xffffffffu)); }
#define TK_CE(a, b) do { const unsigned _mx = (a) > (b) ? (a) : (b), _mn = (a) > (b) ? (b) : (a); (a) = _mx; (b) = _mn; } while (0)
template <int N, int BASE> __device__ __forceinline__ void tk_sort16(unsigned (&k)[N]) {
#pragma unroll
    for (int sz = 2; sz <= 16; sz <<= 1)
#pragma unroll
        for (int j = sz >> 1; j > 0; j >>= 1)
#pragma unroll
            for (int i = 0; i < 16; ++i) { const int l = i ^ j; if (l > i) { if ((i & sz) == 0) TK_CE(k[BASE + i], k[BASE + l]); else TK_CE(k[BASE + l], k[BASE + i]); } }
}
template <int NA, int A, int NB_, int B> __device__ __forceinline__ void tk_merge16(unsigned (&ka)[NA], const unsigned (&kb)[NB_]) {
#pragma unroll
    for (int i = 0; i < 16; ++i) ka[A + i] = ka[A + i] > kb[B + 15 - i] ? ka[A + i] : kb[B + 15 - i];
#pragma unroll
    for (int j = 8; j > 0; j >>= 1)
#pragma unroll
        for (int i = 0; i < 16; ++i) { const int l = i ^ j; if (l > i) TK_CE(ka[A + i], ka[A + l]); }
}
__device__ __forceinline__ void ph_topk(unsigned char* ws, LAS unsigned char* lds, int gw, int NGW, int wave, int lane) {
    const float* scores = (const float*)(ws + WS_SCORES); int* eidx = (int*)(ws + WS_EIDX); float* gate = (float*)(ws + WS_GATE);
    LAS float* tr = (LAS float*)(lds + wave * WSCR);
    for (int b = gw; b < T * 8 / 64; b += NGW) {
        const float* sb = scores + (size_t)b * 64 * 256;
        unsigned top[2][16];
#pragma unroll
        for (int c = 0; c < 2; ++c) {
#pragma unroll
            for (int half = 0; half < 2; ++half) {
#pragma unroll 4
                for (int i = 0; i < 16; ++i) {
                    const int pp = 4 * i + (lane >> 4), vq = (lane & 15) * 4;
                    const f32x4 x = *(const GAS f32x4*)(sb + pp * 256 + c * 128 + half * 64 + vq);
                    LAS float* r = tr + pp * 65 + vq;
                    r[0] = x.x; r[1] = x.y; r[2] = x.z; r[3] = x.w;
                }
                asm volatile("s_waitcnt lgkmcnt(0)" ::: "memory");
                unsigned k[64];
#pragma unroll
                for (int v = 0; v < 64; ++v) k[v] = (f2o(tr[lane * 65 + v]) & ~127u) | (unsigned)(127 - (half * 64 + v));
                asm volatile("s_waitcnt lgkmcnt(0)" ::: "memory");
                tk_sort16<64, 0>(k); tk_sort16<64, 16>(k); tk_sort16<64, 32>(k); tk_sort16<64, 48>(k);
                tk_merge16<64, 0, 64, 16>(k, k); tk_merge16<64, 32, 64, 48>(k, k); tk_merge16<64, 0, 64, 32>(k, k);
                if (half == 0) {
#pragma unroll
                    for (int i = 0; i < 16; ++i) top[c][i] = k[i];
                } else tk_merge16<16, 0, 64, 0>(top[c], k);
            }
        }
        float av[16], bv[16];
#pragma unroll
        for (int i = 0; i < 16; ++i) { av[i] = o2f(top[0][i] & ~127u); bv[i] = o2f(top[1][i] & ~127u); }
        LAS int* li = (LAS int*)tr + lane * 32;
#pragma unroll
        for (int i = 0; i < 16; ++i) { li[i] = 127 - (int)(top[0][i] & 127u); li[16 + i] = 127 - (int)(top[1][i] & 127u); }
        unsigned key[64];
        key[0] = (f2o(av[0] + bv[0]) & ~255u) | 255u;
        key[1] = (f2o(av[0] + bv[1]) & ~255u) | 254u;
        key[2] = (f2o(av[0] + bv[2]) & ~255u) | 253u;
        key[3] = (f2o(av[0] + bv[3]) & ~255u) | 252u;
        key[4] = (f2o(av[0] + bv[4]) & ~255u) | 251u;
        key[5] = (f2o(av[0] + bv[5]) & ~255u) | 250u;
        key[6] = (f2o(av[0] + bv[6]) & ~255u) | 249u;
        key[7] = (f2o(av[0] + bv[7]) & ~255u) | 248u;
        key[8] = (f2o(av[0] + bv[8]) & ~255u) | 247u;
        key[9] = (f2o(av[0] + bv[9]) & ~255u) | 246u;
        key[10] = (f2o(av[0] + bv[10]) & ~255u) | 245u;
        key[11] = (f2o(av[0] + bv[11]) & ~255u) | 244u;
        key[12] = (f2o(av[0] + bv[12]) & ~255u) | 243u;
        key[13] = (f2o(av[0] + bv[13]) & ~255u) | 242u;
        key[14] = (f2o(av[0] + bv[14]) & ~255u) | 241u;
        key[15] = (f2o(av[0] + bv[15]) & ~255u) | 240u;
        key[16] = (f2o(av[1] + bv[0]) & ~255u) | 239u;
        key[17] = (f2o(av[1] + bv[1]) & ~255u) | 238u;
        key[18] = (f2o(av[1] + bv[2]) & ~255u) | 237u;
        key[19] = (f2o(av[1] + bv[3]) & ~255u) | 236u;
        key[20] = (f2o(av[1] + bv[4]) & ~255u) | 235u;
        key[21] = (f2o(av[1] + bv[5]) & ~255u) | 234u;
        key[22] = (f2o(av[1] + bv[6]) & ~255u) | 233u;
        key[23] = (f2o(av[1] + bv[7]) & ~255u) | 232u;
        key[24] = (f2o(av[2] + bv[0]) & ~255u) | 223u;
        key[25] = (f2o(av[2] + bv[1]) & ~255u) | 222u;
        key[26] = (f2o(av[2] + bv[2]) & ~255u) | 221u;
        key[27] = (f2o(av[2] + bv[3]) & ~255u) | 220u;
        key[28] = (f2o(av[2] + bv[4]) & ~255u) | 219u;
        key[29] = (f2o(av[3] + bv[0]) & ~255u) | 207u;
        key[30] = (f2o(av[3] + bv[1]) & ~255u) | 206u;
        key[31] = (f2o(av[3] + bv[2]) & ~255u) | 205u;
        key[32] = (f2o(av[3] + bv[3]) & ~255u) | 204u;
        key[33] = (f2o(av[4] + bv[0]) & ~255u) | 191u;
        key[34] = (f2o(av[4] + bv[1]) & ~255u) | 190u;
        key[35] = (f2o(av[4] + bv[2]) & ~255u) | 189u;
        key[36] = (f2o(av[5] + bv[0]) & ~255u) | 175u;
        key[37] = (f2o(av[5] + bv[1]) & ~255u) | 174u;
        key[38] = (f2o(av[6] + bv[0]) & ~255u) | 159u;
        key[39] = (f2o(av[6] + bv[1]) & ~255u) | 158u;
        key[40] = (f2o(av[7] + bv[0]) & ~255u) | 143u;
        key[41] = (f2o(av[7] + bv[1]) & ~255u) | 142u;
        key[42] = (f2o(av[8] + bv[0]) & ~255u) | 127u;
        key[43] = (f2o(av[9] + bv[0]) & ~255u) | 111u;
        key[44] = (f2o(av[10] + bv[0]) & ~255u) | 95u;
        key[45] = (f2o(av[11] + bv[0]) & ~255u) | 79u;
        key[46] = (f2o(av[12] + bv[0]) & ~255u) | 63u;
        key[47] = (f2o(av[13] + bv[0]) & ~255u) | 47u;
        key[48] = (f2o(av[14] + bv[0]) & ~255u) | 31u;
        key[49] = (f2o(av[15] + bv[0]) & ~255u) | 15u;
#pragma unroll
        for (int i = 50; i < 64; ++i) key[i] = 0u;
        tk_sort16<64, 0>(key); tk_sort16<64, 16>(key); tk_sort16<64, 32>(key); tk_sort16<64, 48>(key);
        tk_merge16<64, 0, 64, 16>(key, key); tk_merge16<64, 32, 64, 48>(key, key); tk_merge16<64, 0, 64, 32>(key, key);
        asm volatile("s_waitcnt lgkmcnt(0)" ::: "memory");
        const float s0 = o2f(key[0] & ~255u);
        float ev[16]; int ei[16]; float den = 0.f;
#pragma unroll
        for (int w = 0; w < 16; ++w) {
            const unsigned ij = 255u - (key[w] & 255u);
            ev[w] = __expf(o2f(key[w] & ~255u) - s0); den += ev[w];
            ei[w] = li[ij >> 4] * 128 + li[16 + (ij & 15)];
        }
        const float inv = 1.f / den;
        const size_t ob = ((size_t)b * 64 + lane) * 16;
#pragma unroll
        for (int q = 0; q < 4; ++q) {
            typedef int i32x4 __attribute__((ext_vector_type(4)));
            *(GAS i32x4*)(eidx + ob + 4 * q) = (i32x4){ei[4 * q], ei[4 * q + 1], ei[4 * q + 2], ei[4 * q + 3]};
            *(GAS f32x4*)(gate + ob + 4 * q) = (f32x4){ev[4 * q] * inv, ev[4 * q + 1] * inv, ev[4 * q + 2] * inv, ev[4 * q + 3] * inv};
        }
        asm volatile("s_waitcnt lgkmcnt(0)" ::: "memory");
    }
}
typedef __attribute__((ext_vector_type(2))) __bf16 bf16x2_t;
__device__ __forceinline__ float dot2bf(unsigned a, unsigned b, float c) { return __builtin_amdgcn_fdot2_f32_bf16(__builtin_bit_cast(bf16x2_t, a), __builtin_bit_cast(bf16x2_t, b), c, false); }
__device__ __forceinline__ float gelu_erf(float v) { return 0.5f * v * (1.f + erff(v * 0.70710678118654752f)); }
typedef __attribute__((ext_vector_type(2))) float f32x2v;
template <bool DRY> __device__ __forceinline__ void ph_gather(unsigned char* ws, float* x, int l, int gw, int NGW, int lane) {
    const int* eidx = (const int*)(ws + WS_EIDX); const float* gate = (const float*)(ws + WS_GATE);
    const unsigned char* ut = ws + WS_UT + (size_t)l * 16384 * D; const unsigned char* vt = ws + WS_VT + (size_t)l * 16384 * D;
    const float* usc = (const float*)(ws + WS_USC) + l * 16384; const float* vsc = (const float*)(ws + WS_VSC) + l * 16384;
    bf16* xb = (bf16*)(ws + WS_XB); const float* xssq = (const float*)(ws + WS_XSSQ);
    const bool hi5 = (lane & 32) != 0, hi4 = (lane & 16) != 0, hi3 = (lane & 8) != 0;
    const int myj = (hi5 ? 4 : 0) + (hi4 ? 2 : 0) + (hi3 ? 1 : 0);
    for (int t = gw; t < T; t += NGW) {
        float xv[16];
        { const v4u xa = *(const GAS v4u*)(xb + (size_t)t * D + 16 * lane), xc = *(const GAS v4u*)(xb + (size_t)t * D + 16 * lane + 8);
          const unsigned xw[8] = {xa.x, xa.y, xa.z, xa.w, xc.x, xc.y, xc.z, xc.w};
#pragma unroll
          for (int i = 0; i < 8; ++i) { xv[2 * i] = __uint_as_float(xw[i] << 16); xv[2 * i + 1] = __uint_as_float(xw[i] & 0xffff0000u); } }
        float ss = xssq[(size_t)t * 16 + (lane & 15)];
        ss += __shfl_xor(ss, 1); ss += __shfl_xor(ss, 2); ss += __shfl_xor(ss, 4); ss += __shfl_xor(ss, 8);
        const float r2 = rsqrtf(ss * (1.f / 1024.f) + EPS);
        const int e_lo = eidx[(size_t)t * 128 + lane], e_hi = eidx[(size_t)t * 128 + 64 + lane];
        const float g_lo = gate[(size_t)t * 128 + lane], g_hi = gate[(size_t)t * 128 + 64 + lane];
        float acc[16];
#pragma unroll
        for (int i = 0; i < 16; ++i) acc[i] = 0.f;
#pragma unroll 1
        for (int c = 0; c < 16; ++c) {
            v4u ur[8], vr[8]; float su[8], sv[8];
#pragma unroll
            for (int j = 0; j < 8; ++j) {
                const int e = __builtin_amdgcn_readlane(c < 8 ? e_lo : e_hi, (8 * c + j) & 63);
                ur[j] = *(const GAS v4u*)(ut + (size_t)e * D + 16 * lane); vr[j] = *(const GAS v4u*)(vt + (size_t)e * D + 16 * lane);
                su[j] = usc[e]; sv[j] = vsc[e];
            }
            float p[8];
#pragma unroll
            for (int j = 0; j < 8; ++j) {
                const unsigned uw[4] = {ur[j].x, ur[j].y, ur[j].z, ur[j].w};
                float a = 0.f;
#pragma unroll
                for (int i = 0; i < 4; ++i) { const f32x2v lo = __builtin_amdgcn_cvt_pk_f32_fp8((int)uw[i], false), hi = __builtin_amdgcn_cvt_pk_f32_fp8((int)uw[i], true);
                    a += xv[4 * i] * lo.x; a += xv[4 * i + 1] * lo.y; a += xv[4 * i + 2] * hi.x; a += xv[4 * i + 3] * hi.y; }
                p[j] = a * su[j];
            }
            float q4[4], q2[2], q1;
#pragma unroll
            for (int j = 0; j < 4; ++j) { const float keep = hi5 ? p[j + 4] : p[j], send = hi5 ? p[j] : p[j + 4]; q4[j] = keep + __shfl_xor(send, 32); }
#pragma unroll
            for (int j = 0; j < 2; ++j) { const float keep = hi4 ? q4[j + 2] : q4[j], send = hi4 ? q4[j] : q4[j + 2]; q2[j] = keep + __shfl_xor(send, 16); }
            { const float keep = hi3 ? q2[1] : q2[0], send = hi3 ? q2[0] : q2[1]; q1 = keep + __shfl_xor(send, 8); }
            q1 += __shfl_xor(q1, 4); q1 += __shfl_xor(q1, 2); q1 += __shfl_xor(q1, 1);
            const float gsel = __shfl(c < 8 ? g_lo : g_hi, (8 * c + myj) & 63);
            const float wv = gsel * gelu_erf(q1 * r2);
#pragma unroll
            for (int j = 0; j < 8; ++j) {
                const float w = __uint_as_float((unsigned)__builtin_amdgcn_readlane((int)__float_as_uint(wv), ((j >> 2) << 5) | (((j >> 1) & 1) << 4) | ((j & 1) << 3))) * sv[j];
                const unsigned vw[4] = {vr[j].x, vr[j].y, vr[j].z, vr[j].w};
#pragma unroll
                for (int i = 0; i < 4; ++i) { const f32x2v lo = __builtin_amdgcn_cvt_pk_f32_fp8((int)vw[i], false), hi = __builtin_amdgcn_cvt_pk_f32_fp8((int)vw[i], true);
                    acc[4 * i] += w * lo.x; acc[4 * i + 1] += w * lo.y; acc[4 * i + 2] += w * hi.x; acc[4 * i + 3] += w * hi.y; }
            }
        }
        float* xr = x + (size_t)t * D + 16 * lane; float s2 = 0.f; float o[16];
#pragma unroll
        for (int q = 0; q < 4; ++q) {
            const f32x4 xo = *(const GAS f32x4*)(xr + 4 * q);
            f32x4 ov; ov.x = xo.x + acc[4 * q]; ov.y = xo.y + acc[4 * q + 1]; ov.z = xo.z + acc[4 * q + 2]; ov.w = xo.w + acc[4 * q + 3];
            if (!DRY || ov.x == 1.2345e30f) *(GAS f32x4*)(xr + 4 * q) = ov;
            o[4 * q] = ov.x; o[4 * q + 1] = ov.y; o[4 * q + 2] = ov.z; o[4 * q + 3] = ov.w;
            s2 += (ov.x * ov.x + ov.y * ov.y) + (ov.z * ov.z + ov.w * ov.w);
        }
        if (!DRY) {
#pragma unroll
            for (int hh = 0; hh < 2; ++hh) { v4u w; w.x = pkbf(o[hh * 8 + 0], o[hh * 8 + 1]); w.y = pkbf(o[hh * 8 + 2], o[hh * 8 + 3]); w.z = pkbf(o[hh * 8 + 4], o[hh * 8 + 5]); w.w = pkbf(o[hh * 8 + 6], o[hh * 8 + 7]);
                *(GAS v4u*)(xb + (size_t)t * D + 16 * lane + 8 * hh) = w; }
        }
        s2 = wave_sum(s2);
        if (!DRY && lane == 0) ((float*)(ws + WS_RS1))[t] = rsqrtf(s2 * (1.f / 1024.f) + EPS);
    }
}

constexpr int NPH_L = 8, NPHASES = 1 + NL * NPH_L;
#ifndef MK_PHMASK
#define MK_PHMASK 0x1ff
#endif
#define PH_ON(j) ((MK_PHMASK >> (j)) & 1)
#ifndef MK_REP
#define MK_REP 0
#endif
#define PH_REP(j) ((MK_REP >> (j)) & 1)
__global__ void __launch_bounds__(NWAVES * 64, 2) mega(Args a) {
    extern __shared__ __attribute__((aligned(16))) unsigned char lds_raw[];
    {
        LAS unsigned char* lds0 = (LAS unsigned char*)lds_raw;
        for (int u = threadIdx.x; u < (LDS_BYTES - LDSCTL_OFF) / 4; u += NWAVES * 64) ((LAS unsigned*)(lds0 + LDSCTL_OFF))[u] = 0u;
        __syncthreads();
    }
    const bool multi = (a.ph_hi - a.ph_lo) > 1;
    XcdBarrier bar; bar.bar = (unsigned*)(a.ws + WS_CTL) + CW_BAR + a.li * XCD_BAR_WORDS; bar.x = 0; bar.st = nullptr;
    if (multi) bar = xcd_barrier_post((unsigned*)(a.ws + WS_CTL) + CW_BAR + a.li * XCD_BAR_WORDS, (volatile LAS unsigned*)((LAS unsigned char*)lds_raw + MISC_OFF) + 8);

    for (int ph = a.ph_lo; ph < a.ph_hi; ++ph) {
        unsigned char* ws = a.ws; asm volatile("" : "+s"(ws));
        int G = (int)gridDim.x; asm volatile("" : "+s"(G));
        int bx = (int)blockIdx.x; asm volatile("" : "+s"(bx));
        int tid = (int)threadIdx.x; asm volatile("" : "+v"(tid));
        LAS unsigned char* lds = (LAS unsigned char*)lds_raw;
        const int lane = tid & 63, wave = __builtin_amdgcn_readfirstlane(tid >> 6);
        const int vcu = (G % 8 == 0) ? (bx % 8) * (G / 8) + bx / 8 : bx;
        const int gw = vcu * NWAVES + wave, NGW = G * NWAVES;
        if (ph == 0) {
            if (PH_ON(8)) for (int rep = 0; rep < 1 + PH_REP(8); ++rep) ph_prologue(a, ws, lds, gw, NGW, wave, lane);
        } else {
            const int l = (ph - 1) / NPH_L, j = (ph - 1) % NPH_L;
            if (j == 0 && PH_ON(0)) {
              for (int rep = 0; rep < 1 + PH_REP(0); ++rep) {
                { pg8::Gemm g{(const pg8::bf16_t*)(ws + WS_XB), (const pg8::bf16_t*)(ws + WS_WIN) + (size_t)l * NPROJ * D, T, NPROJ, D};
                  pg8::StaticOrder So; So.init(T, NPROJ, G, bx);
                  pg8::EpiInProj E{(pg8::bf16_t*)(ws + WS_PROJ), NPROJ, (const float*)(ws + WS_RS1), (float*)(ws + WS_DTF), AIN(I_DTBIAS) + l * 6};
                  pg8::gemm_phase<pg8::EpiInProj, pg8::StaticOrder, true, true>(lds, g, So, E); }
                { pg8::Gemm g{(const pg8::bf16_t*)(ws + WS_MEMB), (const pg8::bf16_t*)(ws + WS_WMEM) + (size_t)l * 512 * D, MROWS, 512, D};
                  pg8::StaticOrder So; So.init(MROWS, 512, G, bx);
                  pg8::EpiInProj E{(pg8::bf16_t*)(ws + WS_MEMKV), 512, (const float*)(ws + WS_RSM), nullptr, nullptr};
                  pg8::gemm_phase<pg8::EpiInProj, pg8::StaticOrder, true, true>(lds, g, So, E); }
              }
            } else if (j == 1 && PH_ON(1)) {
                for (int rep = 0; rep < 1 + PH_REP(1); ++rep) { ph_mix(a, ws, lds, l, 32 * rep, tid, wave, lane); __syncthreads(); }
            } else if (j == 2 && PH_ON(2)) {
                ph_ssd_scan(ws, bx, G, tid);
            } else if (j == 3 && PH_ON(3)) {
                for (int rep = 0; rep < 1 + PH_REP(3); ++rep) for (int u = vcu; u < 256; u += G) ssd_finish_unit(a, ws, l, u, wave, lane);
            } else if (j == 4 && PH_ON(4)) {
                pg8::Gemm g{(const pg8::bf16_t*)(ws + WS_YCAT), (const pg8::bf16_t*)(ws + WS_WOUT) + (size_t)l * D * D, T, D, D};
                pg8::StaticOrder So; So.init(T, D, G, bx);
                LAS float* gtab = (LAS float*)(lds + GTAB_OFF);
                { pg8::Unit u0; if (So.next(0, u0) && tid < 256) { float r0, r1, r2; pg8::group_rstd((const float*)(ws + WS_YSSQ), u0.pm * 256 + tid, r0, r1, r2); gtab[tid] = r0 / r1; gtab[256 + tid] = r1 / r2; gtab[512 + tid] = r2; } }
                __syncthreads();
                pg8::EpiOut E{l == 0 ? AIN(I_X) : a.out, a.out, (pg8::bf16_t*)(ws + WS_XB), (float*)(ws + WS_XSSQ), gtab};
                pg8::gemm_phase<pg8::EpiOut, pg8::StaticOrder, true, true>(lds, g, So, E);
            } else if (j == 5 && PH_ON(5)) {
                pg8::Gemm g{(const pg8::bf16_t*)(ws + WS_XB), (const pg8::bf16_t*)(ws + WS_WSC) + (size_t)l * 2048 * D, T, 2048, D};
                pg8::StaticOrder So; So.init(T, 2048, G, bx);
                pg8::EpiScores E{(float*)(ws + WS_SCORES), (const float*)(ws + WS_XSSQ)};
                for (int rep = 0; rep < 1 + PH_REP(5); ++rep) pg8::gemm_phase<pg8::EpiScores, pg8::StaticOrder, true, true>(lds, g, So, E);
            } else if (j == 6 && PH_ON(6)) {
                for (int rep = 0; rep < 1 + PH_REP(6); ++rep) ph_topk(ws, lds, gw, NGW, wave, lane);
            } else if (j == 7 && PH_ON(7)) {
                if (PH_REP(7)) ph_gather<true>(ws, a.out, l, gw, NGW, lane);
                ph_gather<false>(ws, a.out, l, gw, NGW, lane);
            }
        }
        if (ph + 1 < a.ph_hi) { XcdBarrier b2 = bar; { unsigned* p = b2.bar; unsigned x = b2.x; asm volatile("" : "+s"(p), "+s"(x)); b2.bar = p; b2.x = x; } xcd_barrier(b2); }
    }
}

#ifndef MK_ONE_LAUNCH
#define MK_ONE_LAUNCH 1
#endif
extern "C" void kernel_launch(void* const* d_in, const int* in_sizes, int n_in, void* d_out, int out_size, void* d_ws, size_t ws_size, hipStream_t stream) {
    static int grid = 0;
    if (grid == 0) {
        if (n_in != 22 || out_size != T * D || ws_size < WS_END) { fprintf(stderr, "kernel_launch: unexpected problem (n_in %d out %d ws %zu)\n", n_in, out_size, ws_size); grid = -1; return; }
        int dev = 0, cus = 0, per_cu = 0;
        if (hipGetDevice(&dev) != hipSuccess || hipDeviceGetAttribute(&cus, hipDeviceAttributeMultiprocessorCount, dev) != hipSuccess) { grid = -1; return; }
        if (hipFuncSetAttribute((const void*)mega, hipFuncAttributeMaxDynamicSharedMemorySize, LDS_BYTES) != hipSuccess) { fprintf(stderr, "kernel_launch: hipFuncSetAttribute failed\n"); grid = -1; return; }
        if (hipOccupancyMaxActiveBlocksPerMultiprocessor(&per_cu, (const void*)mega, NWAVES * 64, LDS_BYTES) != hipSuccess || per_cu < 1) { fprintf(stderr, "kernel_launch: occupancy query says %d\n", per_cu); (void)hipGetLastError(); per_cu = 1; }
        grid = cus;
    }
    if (grid < 0) return;
    (void)hipMemsetAsync((char*)d_ws + WS_CTL, 0, CTL_ZERO_BYTES, stream);
    Args a{};
    for (int i = 0; i < 22; ++i) a.in[i] = (const float*)d_in[i];
    a.out = (float*)d_out; a.ws = (unsigned char*)d_ws;
#if MK_ONE_LAUNCH
    a.ph_lo = 0; a.ph_hi = NPHASES; a.li = 0;
    hipLaunchKernelGGL(mega, dim3(grid), dim3(NWAVES * 64), LDS_BYTES, stream, a);
#else
    for (int ph = 0; ph < NPHASES; ++ph) { a.ph_lo = ph; a.ph_hi = ph + 1; a.li = 0; hipLaunchKernelGGL(mega, dim3(grid), dim3(NWAVES * 64), LDS_BYTES, stream, a); }
#endif
}
```

```cpp
#include <hip/hip_runtime.h>
#include <cstdio>
#include <cstdint>
#include <cmath>
namespace pg8 {
#define PG8_LAS __attribute__((address_space(3)))
typedef unsigned short bf16_t;
typedef short bf16x8 __attribute__((ext_vector_type(8)));
typedef float f32x4 __attribute__((ext_vector_type(4)));
typedef unsigned u32x4 __attribute__((ext_vector_type(4)));
constexpr int BM = 256, BK = 64, HALF = 128, HTB = HALF * BK * 2  , STAGE_BYTES = 8 * HTB, NXCD = 8, WGM = 8;

__host__ __device__ __forceinline__ int lds_byte(int r, int c) { const int st = (r >> 4) * 2 + (c >> 5), rr = r & 15, cc = c & 31, ob = rr * 64 + cc * 2; return st * 1024 + (ob ^ (((ob >> 9) & 1) << 5)); }
__host__ __device__ __forceinline__ void stage_rc(int b, int& R, int& C) { const int st = b / 1024, sb = b % 1024, swz = sb ^ (((sb >> 9) & 1) << 5); R = (st >> 1) * 16 + swz / 64; C = (st & 1) * 32 + (swz % 64) / 2; }
__host__ __device__ __forceinline__ int perm32(int rho) { const int n = rho >> 4, i = rho & 15; return 8 * (i >> 2) + 4 * n + (i & 3); }

struct Unit { int pm, pn; };
struct Gemm { const bf16_t* A; const bf16_t* Bt; int M, N, K; };

struct StaticOrder {
    int nM, nN, nwg, G, c;
    __host__ __device__ void init(int M, int N, int G_, int c_) { nM = M / BM; nN = N / BM; nwg = nM * nN; G = G_; c = c_; }
    __host__ __device__ bool next(int i, Unit& u) const {
        const long L = (long)i * G + c; if (L >= nwg) return false;
        int wgid = (int)L; { const int q = nwg / NXCD, r = nwg % NXCD, xcd = wgid % NXCD, off = wgid / NXCD; wgid = (xcd < r ? xcd * (q + 1) : r * (q + 1) + (xcd - r) * q) + off; }
        const int nig = WGM * nN, gid = wgid / nig, fm = gid * WGM, gsz = (nM - fm) < WGM ? (nM - fm) : WGM;
        u.pm = fm + ((wgid % nig) % gsz); u.pn = (wgid % nig) / gsz; return true;
    }
    __device__ __forceinline__ void a_ready(const Unit&) const {}
    __device__ __forceinline__ void done(const Unit&) const {}
};

__device__ __forceinline__ unsigned cvt_pk_bf16(float lo, float hi) { unsigned r; asm volatile("v_cvt_pk_bf16_f32 %0, %1, %2" : "=v"(r) : "v"(lo), "v"(hi)); return r; }
template <class Epi, class Sched, bool ALIGN_EPI = false, bool SP2 = false>
__device__ __forceinline__ void gemm_phase(PG8_LAS unsigned char* lds, const Gemm g, const Sched& S, const Epi& E, const int tid_in) {
    int tid_ = tid_in; asm volatile("" : "+v"(tid_));
    const int tid = tid_, wid = __builtin_amdgcn_readfirstlane(tid >> 6), lane = tid & 63, wr = wid >> 2, wc = wid & 3, fr = lane & 15, fq = lane >> 4;
    const int K = g.K, nt = K / BK;
    unsigned voffA[2], voffB[2];
#pragma unroll
    for (int i = 0; i < 2; ++i) { int R, C; stage_rc(tid * 16 + i * 8192, R, C); const int Rb = Epi::PERM ? ((R & ~31) + perm32(R & 31)) : R;
        voffA[i] = (unsigned)(R * K + C) * 2u; voffB[i] = (unsigned)(Rb * K + C) * 2u; }
    const size_t kstep = (size_t)(BK * 2);
    const size_t hstep = (size_t)HALF * K * 2;
    const size_t tstep = 2 * hstep;
    const unsigned ldsw = (unsigned)wid * 1024u;
    const int aoff = lds_byte(wr * 64 + fr, fq * 8), boff = lds_byte(wc * 32 + fr, fq * 8);
#define PG8_SA(b, h) (((b) * 2 + (h)) * HTB)
#define PG8_SB(b, h) ((4 + (b) * 2 + (h)) * HTB)
#define PG8_STAGE(bufoff, gbase, voff) do { _Pragma("unroll") for (int _i = 0; _i < 2; ++_i) \
        __builtin_amdgcn_global_load_lds((const unsigned*)((const char*)(gbase) + (voff)[_i]), (PG8_LAS unsigned*)(lds + (bufoff) + ldsw + _i * 8192), 16, 0, 0); } while (0)
#define PG8_LDA(dst, b, h) do { _Pragma("unroll") for (int m = 0; m < 4; ++m) _Pragma("unroll") for (int k = 0; k < 2; ++k) dst[m][k] = *(const PG8_LAS bf16x8*)(lds + PG8_SA(b, h) + aoff + m * 2048 + k * 1024); } while (0)
#define PG8_LDB(dst, b, h) do { _Pragma("unroll") for (int n = 0; n < 2; ++n) _Pragma("unroll") for (int k = 0; k < 2; ++k) dst[n][k] = *(const PG8_LAS bf16x8*)(lds + PG8_SB(b, h) + boff + n * 2048 + k * 1024); } while (0)
#define PG8_MMA(ai, bj, At, Bt) do { __builtin_amdgcn_s_setprio(1); _Pragma("unroll") for (int m = 0; m < 4; ++m) _Pragma("unroll") for (int n = 0; n < 2; ++n) _Pragma("unroll") for (int k = 0; k < 2; ++k) \
        acc[ai][bj][m][n] = __builtin_amdgcn_mfma_f32_16x16x32_bf16(Bt[n][k], At[m][k], acc[ai][bj][m][n], 0, 0, 0); __builtin_amdgcn_s_setprio(0); } while (0)
#define PG8_WAIT_V(n) asm volatile("s_waitcnt vmcnt(" #n ")" ::: "memory")
#define PG8_WAIT_L(n) asm volatile("s_waitcnt lgkmcnt(" #n ")" ::: "memory")
#define PG8_BAR __builtin_amdgcn_s_barrier()
#define PG8_SCHED __builtin_amdgcn_sched_barrier(0)
    Unit cur, nxt; int ui = 0;
    if (!S.next(0, cur)) return;
    f32x4 acc[2][2][4][2];
#pragma unroll
    for (int a = 0; a < 2; ++a)
#pragma unroll
        for (int b = 0; b < 2; ++b)
#pragma unroll
            for (int m = 0; m < 4; ++m)
#pragma unroll
                for (int n = 0; n < 2; ++n) acc[a][b][m][n] = (f32x4){0.f, 0.f, 0.f, 0.f};
    bf16x8 At[4][2], B0[2][2], B1[2][2];
    const char* cA = (const char*)g.A + (size_t)cur.pm * tstep; const char* cB = (const char*)g.Bt + (size_t)cur.pn * tstep;
    S.a_ready(cur);
    if constexpr (SP2) {
        PG8_STAGE(PG8_SB(0, 0), cB, voffB); PG8_STAGE(PG8_SB(0, 1), cB + hstep, voffB); PG8_STAGE(PG8_SA(0, 0), cA, voffA); PG8_STAGE(PG8_SA(0, 1), cA + hstep, voffA);
        if (wr == 1) PG8_BAR;
        PG8_WAIT_V(2); PG8_BAR;
        PG8_STAGE(PG8_SB(1, 0), cB + kstep, voffB); PG8_STAGE(PG8_SA(1, 0), cA + kstep, voffA); PG8_STAGE(PG8_SB(1, 1), cB + hstep + kstep, voffB);
        PG8_WAIT_V(6); PG8_BAR;
    } else {
        PG8_STAGE(PG8_SB(0, 0), cB, voffB); PG8_STAGE(PG8_SA(0, 0), cA, voffA); PG8_STAGE(PG8_SB(0, 1), cB + hstep, voffB); PG8_STAGE(PG8_SA(0, 1), cA + hstep, voffA);
        if (wr == 1) PG8_BAR;
        PG8_WAIT_V(4); PG8_BAR;
        PG8_STAGE(PG8_SB(1, 0), cB + kstep, voffB); PG8_STAGE(PG8_SA(1, 0), cA + kstep, voffA); PG8_STAGE(PG8_SB(1, 1), cB + hstep + kstep, voffB);
        PG8_WAIT_V(6); PG8_BAR;
    }
    for (;;) {
        const bool has_next = S.next(ui + 1, nxt);
        const char* nA = has_next ? (const char*)g.A + (size_t)nxt.pm * tstep : cA; const char* nB = has_next ? (const char*)g.Bt + (size_t)nxt.pn * tstep : cB;
        for (int t = 0; t < nt; t += 2) {
            const bool last = (t == nt - 2);
            const char* a1 = cA + (size_t)(t + 1) * kstep;
            const char* a2 = last ? nA : cA + (size_t)(t + 2) * kstep; const char* b2 = last ? nB : cB + (size_t)(t + 2) * kstep;
            const char* a3 = a2 + kstep; const char* b3 = b2 + kstep;
            if (last && has_next) S.a_ready(nxt);
            if constexpr (Epi::KHOOK) E.khook(acc, cur, t, wr, fr);
            if constexpr (SP2) {
            PG8_LDB(B0, 0, 0); PG8_LDB(B1, 0, 1); PG8_SCHED; PG8_LDA(At, 0, 0); PG8_STAGE(PG8_SA(1, 1), a1 + hstep, voffA);
            PG8_WAIT_V(8); PG8_WAIT_L(0); PG8_BAR; PG8_MMA(0, 0, At, B0); PG8_MMA(0, 1, At, B1); PG8_BAR; PG8_SCHED;
            PG8_LDA(At, 0, 1); PG8_STAGE(PG8_SB(0, 0), b2, voffB); PG8_STAGE(PG8_SB(0, 1), b2 + hstep, voffB); PG8_STAGE(PG8_SA(0, 0), a2, voffA);
            PG8_WAIT_V(8); PG8_WAIT_L(0); PG8_BAR; PG8_MMA(1, 0, At, B0); PG8_MMA(1, 1, At, B1); PG8_BAR; PG8_SCHED;
            PG8_LDB(B0, 1, 0); PG8_LDB(B1, 1, 1); PG8_SCHED; PG8_LDA(At, 1, 0); PG8_STAGE(PG8_SA(0, 1), a2 + hstep, voffA);
            PG8_WAIT_V(8); PG8_WAIT_L(0); PG8_BAR; PG8_MMA(0, 0, At, B0); PG8_MMA(0, 1, At, B1); PG8_BAR; PG8_SCHED;
            PG8_LDA(At, 1, 1); PG8_STAGE(PG8_SB(1, 0), b3, voffB); PG8_STAGE(PG8_SB(1, 1), b3 + hstep, voffB); PG8_STAGE(PG8_SA(1, 0), a3, voffA);
            PG8_WAIT_V(8); PG8_WAIT_L(0); PG8_BAR; PG8_MMA(1, 0, At, B0); PG8_MMA(1, 1, At, B1); PG8_BAR; PG8_SCHED;
            } else {
            PG8_LDB(B0, 0, 0); PG8_SCHED; PG8_LDA(At, 0, 0); PG8_STAGE(PG8_SA(1, 1), a1 + hstep, voffA);
            PG8_WAIT_L(8); PG8_BAR; PG8_WAIT_L(0); PG8_MMA(0, 0, At, B0); PG8_BAR; PG8_SCHED;
            PG8_LDB(B1, 0, 1); PG8_STAGE(PG8_SB(0, 0), b2, voffB);
            PG8_BAR; PG8_WAIT_L(0); PG8_MMA(0, 1, At, B1); PG8_BAR;
            PG8_LDA(At, 0, 1); PG8_STAGE(PG8_SA(0, 0), a2, voffA);
            PG8_BAR; PG8_WAIT_L(0); PG8_MMA(1, 0, At, B0); PG8_BAR; PG8_SCHED;
            PG8_STAGE(PG8_SB(0, 1), b2 + hstep, voffB);
            PG8_WAIT_V(6); PG8_BAR; PG8_MMA(1, 1, At, B1); PG8_BAR;
            PG8_LDB(B0, 1, 0); PG8_SCHED; PG8_LDA(At, 1, 0); PG8_STAGE(PG8_SA(0, 1), a2 + hstep, voffA);
            PG8_WAIT_L(8); PG8_BAR; PG8_WAIT_L(0); PG8_MMA(0, 0, At, B0); PG8_BAR; PG8_SCHED;
            PG8_LDB(B1, 1, 1); PG8_STAGE(PG8_SB(1, 0), b3, voffB);
            PG8_BAR; PG8_WAIT_L(0); PG8_MMA(0, 1, At, B1); PG8_BAR;
            PG8_LDA(At, 1, 1); PG8_STAGE(PG8_SA(1, 0), a3, voffA);
            PG8_BAR; PG8_WAIT_L(0); PG8_MMA(1, 0, At, B0); PG8_BAR; PG8_SCHED;
            PG8_STAGE(PG8_SB(1, 1), b3 + hstep, voffB);
            PG8_WAIT_V(6); PG8_BAR; PG8_MMA(1, 1, At, B1); PG8_BAR;
            }
        }
        if constexpr (ALIGN_EPI) { if (wr == 0) PG8_BAR; }
        if constexpr (!Epi::AFTER_DRAIN) { E(acc, cur, wr, wc, fr, fq); S.done(cur); }
        if (!has_next) break;
#pragma unroll
        for (int a = 0; a < 2; ++a)
#pragma unroll
            for (int b = 0; b < 2; ++b)
#pragma unroll
                for (int m = 0; m < 4; ++m)
#pragma unroll
                    for (int n = 0; n < 2; ++n) acc[a][b][m][n] = (f32x4){0.f, 0.f, 0.f, 0.f};
        cur = nxt; cA = nA; cB = nB; ++ui;
        if constexpr (ALIGN_EPI) { if (wr == 1) PG8_BAR; }
    }
    PG8_WAIT_V(0);
    if constexpr (!ALIGN_EPI) { if (wr == 0) PG8_BAR; }
    PG8_BAR;
    if constexpr (Epi::AFTER_DRAIN) { E.fused(acc, cur, wr, wc, fr, fq, lds, wid, lane); S.done(cur); }
#undef PG8_SA
#undef PG8_SB
#undef PG8_STAGE
#undef PG8_LDA
#undef PG8_LDB
#undef PG8_MMA
#undef PG8_WAIT_V
#undef PG8_WAIT_L
#undef PG8_BAR
#undef PG8_SCHED
}
}
#define GAS __attribute__((address_space(1)))
#define LAS __attribute__((address_space(3)))
typedef unsigned short bf16;
typedef unsigned v4u __attribute__((ext_vector_type(4)));
typedef float f32x4 __attribute__((ext_vector_type(4)));
typedef short bf16x8 __attribute__((ext_vector_type(8)));
typedef GAS unsigned gu32;
typedef GAS unsigned long long gu64;
#define RLX_AGENT __ATOMIC_RELAXED, __HIP_MEMORY_SCOPE_AGENT
#define LDS_WAIT() asm volatile("s_waitcnt lgkmcnt(0)" ::: "memory")
#define VM_WAIT() asm volatile("s_waitcnt vmcnt(0)" ::: "memory")
__device__ __forceinline__ unsigned long long rt() { return __builtin_amdgcn_s_memrealtime(); }
__device__ __forceinline__ unsigned f2bf(float f) { unsigned u = __builtin_bit_cast(unsigned, f); return (u + 0x7fffu + ((u >> 16) & 1u)) >> 16; }
__device__ __forceinline__ unsigned pk2(float lo, float hi) { return f2bf(lo) | (f2bf(hi) << 16); }

#define XB_TMO      128
#define XB_XCNT(j)  (256  + 64 * (j))
#define XB_XSUB(j)  (1280 + 64 * (j))
#define XB_XGEN(j)  (2304 + 64 * (j))
#define XB_TOP      3328
#define XB_TOPGEN   3392
#define XCD_BAR_WORDS 3456
#define XB_SPIN_CAP (1u << 18)

__device__ __forceinline__ unsigned xb_ld(unsigned* p)              { return __hip_atomic_load(p, __ATOMIC_RELAXED, __HIP_MEMORY_SCOPE_AGENT); }
__device__ __forceinline__ unsigned xb_add(unsigned* p, unsigned v) { return __hip_atomic_fetch_add(p, v, __ATOMIC_RELAXED, __HIP_MEMORY_SCOPE_AGENT); }
__device__ __forceinline__ unsigned xb_xcc_id() { return (unsigned)__builtin_amdgcn_s_getreg((3 << 11) | 20) & 0xFu; }
#define XB_SPIN(cond, bar) do { unsigned _sp = 0; while (cond) { __builtin_amdgcn_s_sleep(1); \
    if ((++_sp & 255u) == 0u) { if (xb_ld(&(bar)[XB_TMO])) break; if (_sp > XB_SPIN_CAP) { atomicAdd(&(bar)[XB_TMO], 1u); break; } } } } while (0)

struct XcdBarrier {
    unsigned* bar; unsigned x;
    volatile LAS unsigned* st;
};

__device__ __forceinline__ XcdBarrier xcd_barrier_post(unsigned* bar, volatile LAS unsigned* st) {
    XcdBarrier b; b.bar = bar; b.x = xb_xcc_id(); b.st = st;
    if (threadIdx.x == 0) (void)xb_add(&bar[XB_XCNT(b.x)], 1u);
    return b;
}
__device__ __forceinline__ void xcd_barrier_complete(unsigned* bar, unsigned x, unsigned& nloc, unsigned& nx) {
    const unsigned G = gridDim.x * gridDim.y * gridDim.z;
    unsigned sum, cnt, mine, sp = 0u;
    for (;;) {
        sum = 0u; cnt = 0u; mine = 0u;
#pragma unroll
        for (unsigned j = 0; j < 16; ++j) { const unsigned c = xb_ld(&bar[XB_XCNT(j)]); sum += c; cnt += (c > 0u) ? 1u : 0u; mine = (j == x) ? c : mine; }
        if (sum == G) break;
        __builtin_amdgcn_s_sleep(1);
        if ((++sp & 255u) == 0u) { if (xb_ld(&bar[XB_TMO])) break; if (sp > XB_SPIN_CAP) { atomicAdd(&bar[XB_TMO], 1u); break; } }
    }
    nloc = mine > 0u ? mine : 1u; nx = cnt > 0u ? cnt : 1u;
}

__device__ __forceinline__ void xcd_barrier(const XcdBarrier& b, const int tid) {
    asm volatile("s_waitcnt vmcnt(0)" ::: "memory");
    __syncthreads();
    if (tid == 0) {
        unsigned* bar = b.bar;
        __builtin_amdgcn_s_waitcnt(0);
        unsigned nloc = b.st[0], nx = b.st[1];
        if (nloc == 0u) { xcd_barrier_complete(bar, b.x, nloc, nx); b.st[0] = nloc; b.st[1] = nx; }
        const unsigned old = xb_add(&bar[XB_XSUB(b.x)], 1u);
        const unsigned gen = old / nloc;
        if (old + 1u == (gen + 1u) * nloc) {
            __builtin_amdgcn_fence(__ATOMIC_RELEASE, "agent");
            asm volatile("s_waitcnt vmcnt(0)" ::: "memory");
            const unsigned og = xb_add(&bar[XB_TOP], 1u);
            const unsigned tg = og / nx;
            if (og + 1u == (tg + 1u) * nx) xb_add(&bar[XB_TOPGEN], 1u);
            else XB_SPIN(xb_ld(&bar[XB_TOPGEN]) == tg, bar);
            __builtin_amdgcn_fence(__ATOMIC_ACQUIRE, "agent");
            xb_add(&bar[XB_XGEN(b.x)], 1u);
            asm volatile("s_waitcnt vmcnt(0)" ::: "memory");
        } else {
            XB_SPIN(xb_ld(&bar[XB_XGEN(b.x)]) == gen, bar);
            __builtin_amdgcn_fence(__ATOMIC_ACQUIRE, "agent");
            asm volatile("s_waitcnt vmcnt(0)" ::: "memory");
        }
    }
    __syncthreads();
}

constexpr int NWAVES = 8;
constexpr int D = 1024, NB = 4, S = 4096, T = NB * S, NL = 2, NMEM = 256, MROWS = NB * NMEM;
constexpr int DIN = 2438, NPROJ = 2560;
constexpr int PC_Z = 0, PC_XBC = 384, PC_QSB = 1024, PC_KSB = 1408, PC_VSB = 1792, PC_QMEM = 2176, PC_DT = 2432;
constexpr int CONV_CH = 640;
constexpr float EPS = 1e-6f;

constexpr int RING_BYTES = 131072;
constexpr int WSCR = 17408;
constexpr int LDSCTL_OFF = 8 * WSCR, MISC_OFF = LDSCTL_OFF + 320;
constexpr int LDS_BYTES = 147456;
constexpr int GTAB_OFF = LDSCTL_OFF + 1024;

constexpr size_t MiB = 1u << 20;
constexpr size_t WS_CTL = 0, CTL_ZERO_BYTES = 1 * MiB;
constexpr size_t WS_WIN = 2 * MiB;
constexpr size_t WS_WMEM = 12 * MiB;
constexpr size_t WS_WOUT = 14 * MiB;
constexpr size_t WS_WSC = 18 * MiB;
constexpr size_t WS_MEMB = 26 * MiB;
constexpr size_t WS_RSM = 28 * MiB;
constexpr size_t WS_RS1 = WS_RSM + 64 * 1024;
constexpr size_t WS_DTF = WS_RS1 + 64 * 1024;
constexpr size_t WS_XSSQ = 29 * MiB;
constexpr size_t WS_YSSQ = 30 * MiB;
constexpr size_t WS_MEMKV = 31 * MiB;
constexpr size_t WS_RS1P = 32 * MiB;
constexpr size_t WS_PART = 178 * MiB;
constexpr size_t WS_XB = 34 * MiB;
constexpr size_t WS_YCAT = 66 * MiB;
constexpr size_t WS_PROJ = 98 * MiB;
constexpr size_t WS_SCORES = 178 * MiB;
constexpr size_t WS_YPART = WS_SCORES;
constexpr size_t WS_XCONV = WS_SCORES + 24 * MiB;
constexpr size_t WS_CMG = WS_SCORES + 36 * MiB;
constexpr size_t WS_ACSG = WS_SCORES + 40 * MiB;
constexpr size_t WS_HS = WS_SCORES + 41 * MiB;
constexpr size_t WS_CD = WS_SCORES + 53 * MiB;
constexpr size_t WS_EIDX = 306 * MiB;
constexpr size_t WS_GATE = 314 * MiB;
constexpr size_t WS_STOP = 322 * MiB;
constexpr size_t WS_ITOP = 338 * MiB;
constexpr size_t WS_UT = 354 * MiB;
constexpr size_t WS_USC = 386 * MiB;
constexpr size_t WS_VT = 418 * MiB;
constexpr size_t WS_VSC = 450 * MiB;
constexpr size_t WS_END = 482 * MiB;
constexpr int CW_BAR = 4096;

__device__ __forceinline__ float bf2f(bf16 v) { return __uint_as_float((unsigned)v << 16); }
__device__ __forceinline__ unsigned pkbf(float lo, float hi) { return pg8::cvt_pk_bf16(lo, hi); }
template <int CTRL> __device__ __forceinline__ float dpp_f(float v) { return __uint_as_float((unsigned)__builtin_amdgcn_update_dpp(0, (int)__float_as_uint(v), CTRL, 0xf, 0xf, true)); }
__device__ __forceinline__ float swap32_add(float a, float b) {
    const auto r = __builtin_amdgcn_permlane32_swap(__float_as_uint(a), __float_as_uint(b), false, false); return __uint_as_float(r[0]) + __uint_as_float(r[1]); }
__device__ __forceinline__ float swap16_add(float a, float b) {
    const auto r = __builtin_amdgcn_permlane16_swap(__float_as_uint(a), __float_as_uint(b), false, false); return __uint_as_float(r[0]) + __uint_as_float(r[1]); }
__device__ __forceinline__ float swap32_max(float a) { const auto r = __builtin_amdgcn_permlane32_swap(__float_as_uint(a), __float_as_uint(a), false, false); return fmaxf(__uint_as_float(r[0]), __uint_as_float(r[1])); }
__device__ __forceinline__ float swap16_max(float a) { const auto r = __builtin_amdgcn_permlane16_swap(__float_as_uint(a), __float_as_uint(a), false, false); return fmaxf(__uint_as_float(r[0]), __uint_as_float(r[1])); }
__device__ __forceinline__ float partner32(float a, bool hi) { const auto r = __builtin_amdgcn_permlane32_swap(__float_as_uint(a), __float_as_uint(a), false, false); return __uint_as_float(hi ? r[0] : r[1]); }
__device__ __forceinline__ float sum8(float v) { v += dpp_f<0xB1>(v); v += dpp_f<0x4E>(v); v += dpp_f<0x141>(v); return v; }
__device__ __forceinline__ float sum16(float v) { v = sum8(v); v += dpp_f<0x140>(v); return v; }
__device__ __forceinline__ float wave_sum(float v) { v = sum16(v); v = swap16_add(v, v); return swap32_add(v, v); }
__device__ __forceinline__ float wave_max(float v) { v = fmaxf(v, dpp_f<0xB1>(v)); v = fmaxf(v, dpp_f<0x4E>(v)); v = fmaxf(v, dpp_f<0x141>(v)); v = fmaxf(v, dpp_f<0x140>(v)); v = swap16_max(v); return swap32_max(v); }
__device__ __forceinline__ float bperm_f(float v, int src_lane) { return __uint_as_float((unsigned)__builtin_amdgcn_ds_bpermute(src_lane << 2, (int)__float_as_uint(v))); }
__device__ __forceinline__ int bperm_i(int v, int src_lane) { return __builtin_amdgcn_ds_bpermute(src_lane << 2, v); }
__device__ __forceinline__ float softplus_f(float x) { return fmaxf(x, 0.f) + log1pf(expf(-fabsf(x))); }
__device__ __forceinline__ float silu_f(float x) { return x / (1.f + expf(-x)); }

namespace pg8 {
struct EpiInProj {
    static constexpr bool PERM = true, AFTER_DRAIN = false, KHOOK = false;
    bf16_t* O; int ldc; const float* rs; float* dtf; const float* dtb; int npart;
    __device__ __forceinline__ void operator()(const f32x4 (&acc)[2][2][4][2], const Unit& u, int wr, int wc, int fr, int fq) const {
        const int row0 = u.pm * BM + wr * 64 + fr, col0 = u.pn * BM + wc * 32 + 8 * fq;
        const bool dtl = dtf && (u.pn * BM == PC_DT - 128) && wc == 0 && fq == 0;
#pragma unroll
        for (int ai = 0; ai < 2; ++ai)
#pragma unroll
            for (int m = 0; m < 4; ++m) {
                const int row = row0 + ai * HALF + m * 16; float s;
                if (npart == 8) { const f32x4 p0 = *(const f32x4*)(rs + (size_t)row * 8), p1 = *(const f32x4*)(rs + (size_t)row * 8 + 4); s = rsqrtf((((p0[0] + p0[1]) + (p0[2] + p0[3])) + ((p1[0] + p1[1]) + (p1[2] + p1[3]))) * (1.f / 1024.f) + EPS); }
                else s = rs[row];
#pragma unroll
                for (int bj = 0; bj < 2; ++bj) {
                    const f32x4 v0 = acc[ai][bj][m][0] * s, v1 = acc[ai][bj][m][1] * s;
                    u32x4 w; w.x = cvt_pk_bf16(v0[0], v0[1]); w.y = cvt_pk_bf16(v0[2], v0[3]); w.z = cvt_pk_bf16(v1[0], v1[1]); w.w = cvt_pk_bf16(v1[2], v1[3]);
                    *(u32x4*)(O + (size_t)row * ldc + col0 + bj * HALF) = w;
                    if (bj == 1 && dtl) {
                        f32x4 d0; d0[0] = softplus_f(v0[0] + dtb[0]); d0[1] = softplus_f(v0[1] + dtb[1]); d0[2] = softplus_f(v0[2] + dtb[2]); d0[3] = softplus_f(v0[3] + dtb[3]);
                        f32x4 d1; d1[0] = softplus_f(v1[0] + dtb[4]); d1[1] = softplus_f(v1[1] + dtb[5]); d1[2] = 0.f; d1[3] = 0.f;
                        *(f32x4*)(dtf + (size_t)row * 8) = d0; *(f32x4*)(dtf + (size_t)row * 8 + 4) = d1;
                    }
                }
            }
    }
};
__device__ __forceinline__ void group_rstd(const float* yssq, int row, float& r_ssd, float& r_sb, float& r_mem) {
    const f32x4 a = *(const f32x4*)(yssq + (size_t)row * 16), b = *(const f32x4*)(yssq + (size_t)row * 16 + 4), c = *(const f32x4*)(yssq + (size_t)row * 16 + 8), d = *(const f32x4*)(yssq + (size_t)row * 16 + 12);
    const float s0 = (a[0] + a[1]) + (a[2] + a[3]) + (b[0] + b[1]), s1 = (b[2] + b[3]) + (c[0] + c[1]) + (c[2] + c[3]), s2 = (d[0] + d[1]) + (d[2] + d[3]);
    r_ssd = rsqrtf(s0 * (1.f / 384.f) + EPS); r_sb = rsqrtf(s1 * (1.f / 384.f) + EPS); r_mem = rsqrtf(s2 * (1.f / 256.f) + EPS);
}
struct EpiOut {
    static constexpr bool PERM = false, AFTER_DRAIN = false, KHOOK = true;
    const float* base; float* out; bf16_t* xb; float* xssq; const PG8_LAS float* gtab;
    __device__ __forceinline__ void khook(f32x4 (&acc)[2][2][4][2], const Unit& u, int t, int wr, int fr) const {
        if (t != 6 && t != 12) return;
#pragma unroll
        for (int ai = 0; ai < 2; ++ai)
#pragma unroll
            for (int m = 0; m < 4; ++m) {
                const float f = gtab[(t == 6 ? 0 : 256) + ai * HALF + wr * 64 + m * 16 + fr];
#pragma unroll
                for (int bj = 0; bj < 2; ++bj)
#pragma unroll
                    for (int n = 0; n < 2; ++n) acc[ai][bj][m][n] = acc[ai][bj][m][n] * f;
            }
    }
    __device__ __forceinline__ void operator()(const f32x4 (&acc)[2][2][4][2], const Unit& u, int wr, int wc, int fr, int fq) const {
        const int col0 = u.pn * BM + wc * 32 + 4 * fq;
#pragma unroll
        for (int ai = 0; ai < 2; ++ai)
#pragma unroll
            for (int m = 0; m < 4; ++m) {
                const int row = u.pm * BM + ai * HALF + wr * 64 + m * 16 + fr; const float r2 = gtab[512 + ai * HALF + wr * 64 + m * 16 + fr];
                float q = 0.f;
#pragma unroll
                for (int bj = 0; bj < 2; ++bj)
#pragma unroll
                    for (int n = 0; n < 2; ++n) {
                        const size_t off = (size_t)row * D + col0 + bj * HALF + n * 16;
                        const f32x4 x1 = *(const f32x4*)(base + off) + acc[ai][bj][m][n] * r2;
                        *(f32x4*)(out + off) = x1;
                        typedef unsigned u32x2v __attribute__((ext_vector_type(2)));
                        u32x2v w; w.x = cvt_pk_bf16(x1[0], x1[1]); w.y = cvt_pk_bf16(x1[2], x1[3]); *(u32x2v*)(xb + off) = w;
                        q += (x1[0] * x1[0] + x1[1] * x1[1]) + (x1[2] * x1[2] + x1[3] * x1[3]);
                    }
                q = swap16_add(q, q); q = swap32_add(q, q);
                if (fq == 0) xssq[(size_t)row * 16 + u.pn * 4 + wc] = q;
            }
    }
};
struct EpiScores {
    static constexpr bool PERM = false, AFTER_DRAIN = false, KHOOK = false;
    float* O; const float* xssq;
    __device__ __forceinline__ void operator()(const f32x4 (&acc)[2][2][4][2], const Unit& u, int wr, int wc, int fr, int fq) const {
        const int col0 = u.pn * BM + wc * 32 + 4 * fq;
#pragma unroll
        for (int ai = 0; ai < 2; ++ai)
#pragma unroll
            for (int m = 0; m < 4; ++m) {
                const int row = u.pm * BM + ai * HALF + wr * 64 + m * 16 + fr;
                const f32x4 a = *(const f32x4*)(xssq + (size_t)row * 16), b = *(const f32x4*)(xssq + (size_t)row * 16 + 4), c = *(const f32x4*)(xssq + (size_t)row * 16 + 8), d = *(const f32x4*)(xssq + (size_t)row * 16 + 12);
                const float ss = ((a[0] + a[1]) + (a[2] + a[3])) + ((b[0] + b[1]) + (b[2] + b[3])) + ((c[0] + c[1]) + (c[2] + c[3])) + ((d[0] + d[1]) + (d[2] + d[3]));
                const float r = rsqrtf(ss * (1.f / 1024.f) + EPS);
#pragma unroll
                for (int bj = 0; bj < 2; ++bj)
#pragma unroll
                    for (int n = 0; n < 2; ++n) *(f32x4*)(O + (size_t)row * 2048 + col0 + bj * HALF + n * 16) = acc[ai][bj][m][n] * r;
            }
    }
};
}

struct Args { const float* in[22]; float* out; unsigned char* ws; int ph_lo, ph_hi, li, pad; };
enum { I_X = 0, I_MEM, I_NORM1G, I_WIN, I_CONVW, I_CONVB, I_DTBIAS, I_ALOG, I_DSKIP, I_SSDG, I_SBG, I_MEMNG, I_WMEMKV, I_MQG, I_MKG, I_MEMOG, I_WOUT, I_NORM2G, I_WQ, I_KEYS, I_PU, I_PV };

__device__ __forceinline__ int opq(int i) { asm volatile("" : "+s"(i)); return i; }
#define AIN(i) (a.in[opq(i)])
__device__ __forceinline__ void transpose_item(const float* W, int ldw, int src_c0, int nvalid, const float* g, bf16* WT, int K, int dst_r0, int k0, LAS float* scr, int lane) {
    const int c = lane & 31;
#pragma unroll 8
    for (int i = 0; i < 32; ++i) {
        const int kk = 2 * i + (lane >> 5);
        float v = (c < nvalid) ? W[(size_t)(k0 + kk) * ldw + src_c0 + c] : 0.f;
        if (g) v *= g[k0 + kk];
        scr[kk * 33 + c] = v;
    }
    LDS_WAIT(); asm volatile("" ::: "memory");
    const int c8 = lane & 7;
#pragma unroll
    for (int j = 0; j < 4; ++j) {
        const int n = (lane >> 3) + 8 * j; const LAS float* s = scr + (8 * c8) * 33 + n;
        v4u o; o.x = pkbf(s[0 * 33], s[1 * 33]); o.y = pkbf(s[2 * 33], s[3 * 33]); o.z = pkbf(s[4 * 33], s[5 * 33]); o.w = pkbf(s[6 * 33], s[7 * 33]);
        *(GAS v4u*)(WT + (size_t)(dst_r0 + n) * K + k0 + 8 * c8) = o;
    }
    LDS_WAIT(); asm volatile("" ::: "memory");
}
__device__ __forceinline__ void wsc_item(const float* wq, const float* keys, const float* g2, bf16* WscT, int hc, int kb, int nq, LAS float* scr, int lane) {
    const int k0 = kb * 64;
#pragma unroll 8
    for (int kk = 0; kk < 64; ++kk) scr[kk * 64 + ((lane + kk) & 63)] = wq[(size_t)(k0 + kk) * D + hc * 64 + lane] * g2[k0 + kk];
    LDS_WAIT(); asm volatile("" ::: "memory");
    for (int n = nq * 32; n < nq * 32 + 32; ++n) {
        const float* kp = keys + ((size_t)hc * 128 + n) * 64;
        float a = 0.f;
#pragma unroll
        for (int d = 0; d < 64; ++d) a += scr[lane * 64 + ((d + lane) & 63)] * kp[d];
        WscT[(size_t)(hc * 128 + n) * D + k0 + lane] = (bf16)(pkbf(a, 0.f) & 0xffffu);
    }
    LDS_WAIT(); asm volatile("" ::: "memory");
}
__device__ __forceinline__ void row_to_bf16(const float* xrow, bf16* orow, float* rs, bool partials, int lane) {
    const GAS f32x4* xr = (const GAS f32x4*)xrow + lane;
    f32x4 v[4]; float s = 0.f;
#pragma unroll
    for (int j = 0; j < 4; ++j) { v[j] = xr[64 * j]; s += (v[j].x * v[j].x + v[j].y * v[j].y) + (v[j].z * v[j].z + v[j].w * v[j].w); }
    s = wave_sum(s);
    GAS unsigned long long* o8 = (GAS unsigned long long*)orow + lane;
#pragma unroll
    for (int j = 0; j < 4; ++j) o8[64 * j] = (unsigned long long)pkbf(v[j].x, v[j].y) | ((unsigned long long)pkbf(v[j].z, v[j].w) << 32);
    if (partials) { if (lane < 8) rs[lane] = lane == 0 ? s : 0.f; }
    else if (lane == 0) *rs = rsqrtf(s * (1.f / 1024.f) + EPS);
}
__device__ __forceinline__ void ph_prologue(const Args& a, unsigned char* ws, LAS unsigned char* lds, int gw, int NGW, int wave, int lane) {
    LAS float* scr = (LAS float*)(lds + wave * 16384);
    constexpr int I_IN = 80 * 16, I_MEMW = 16 * 16, I_OUT = 32 * 16, I_SC = 16 * 16 * 4, PER_L = I_IN + I_MEMW + I_OUT + I_SC;
    constexpr int NW_ITEMS = NL * PER_L, NITEMS = NW_ITEMS + T + MROWS + 2 * NL * 16384;
    for (int it = gw; it < NITEMS; it += NGW) {
        if (it < NW_ITEMS) {
            const int l = it / PER_L; int r = it % PER_L;
            if (r < I_IN) {
                const int j = r / 16, kb = r % 16;
                const int src = (j < 32) ? 32 * j : (j < 76 ? 32 * j + 6 : 1024), nv = (j < 76) ? 32 : (j == 76 ? 6 : 0);
                transpose_item(AIN(I_WIN) + (size_t)l * D * DIN, DIN, src, nv, AIN(I_NORM1G) + l * D, (bf16*)(ws + WS_WIN) + (size_t)l * NPROJ * D, D, 32 * j, 64 * kb, scr, lane);
                continue;
            }
            r -= I_IN;
            if (r < I_MEMW) {
                const int j = r / 16, kb = r % 16;
                transpose_item(AIN(I_WMEMKV) + (size_t)l * D * 512, 512, 32 * j, 32, AIN(I_MEMNG) + l * D, (bf16*)(ws + WS_WMEM) + (size_t)l * 512 * D, D, 32 * j, 64 * kb, scr, lane);
                continue;
            }
            r -= I_MEMW;
            if (r < I_OUT) {
                const int j = r / 16, kb = r % 16;
                const float* g = (kb < 6) ? AIN(I_SSDG) + l * 384 : (kb < 12 ? AIN(I_SBG) + l * 384 - 384 : AIN(I_MEMOG) + l * 256 - 768);
                transpose_item(AIN(I_WOUT) + (size_t)l * D * D, D, 32 * j, 32, g, (bf16*)(ws + WS_WOUT) + (size_t)l * D * D, D, 32 * j, 64 * kb, scr, lane);
                continue;
            }
            r -= I_OUT;
            { const int nq = r & 3, kb = (r >> 2) & 15, hc = r >> 6;
              wsc_item(AIN(I_WQ) + (size_t)l * D * D, AIN(I_KEYS) + (size_t)l * 16 * 128 * 64, AIN(I_NORM2G) + l * D, (bf16*)(ws + WS_WSC) + (size_t)l * 2048 * D, hc, kb, nq, scr, lane); }
            continue;
        }
        int r = it - NW_ITEMS;
        if (r < T) { row_to_bf16(AIN(I_X) + (size_t)r * D, (bf16*)(ws + WS_XB) + (size_t)r * D, (float*)(ws + WS_RS1P) + (size_t)r * 8, true, lane); continue; }
        r -= T;
        if (r < MROWS) { row_to_bf16(AIN(I_MEM) + (size_t)r * D, (bf16*)(ws + WS_MEMB) + (size_t)r * D, (float*)(ws + WS_RSM) + r, false, lane); continue; }
        r -= MROWS;
        { const int tb = r >> 15, e = r & 32767;
          const float* src = (tb == 0 ? AIN(I_PU) : AIN(I_PV)) + (size_t)e * D;
          unsigned* dst = (unsigned*)(ws + (tb == 0 ? WS_UT : WS_VT) + (size_t)(e >> 14) * 16384 * D + (size_t)(e & 16383) * 128) + (lane & 31);
          const float* g = AIN(I_NORM2G) + (e >> 14) * D;
          f32x4 v[4]; float am = 0.f;
#pragma unroll
          for (int j = 0; j < 4; ++j) { v[j] = *((const GAS f32x4*)src + 64 * j + lane); if (tb == 0) v[j] = v[j] * *((const GAS f32x4*)g + 64 * j + lane);
              am = fmaxf(fmaxf(am, fmaxf(fabsf(v[j].x), fabsf(v[j].y))), fmaxf(fabsf(v[j].z), fabsf(v[j].w))); }
          am = wave_max(am);
          const float sc = am > 0.f ? 256.f / am : 1.f;
#pragma unroll
          for (int j = 0; j < 4; ++j) { int pk = 0; pk = __builtin_amdgcn_cvt_pk_fp8_f32(v[j].x * sc, v[j].y * sc, pk, false); pk = __builtin_amdgcn_cvt_pk_fp8_f32(v[j].z * sc, v[j].w * sc, pk, true); dst[(size_t)(2 * j + (lane >> 5)) * (16384 * 128 / 4)] = (unsigned)pk; }
          if (lane == 0) ((float*)(ws + (tb == 0 ? WS_USC : WS_VSC)))[e] = am > 0.f ? am * (1.f / 256.f) : 1.f; }
    }
}


typedef __attribute__((ext_vector_type(8))) __bf16 bf8_t;
typedef __attribute__((ext_vector_type(8))) float f32x8;
typedef __attribute__((ext_vector_type(8))) short s16x8;
typedef __attribute__((ext_vector_type(4))) short s16x4;
typedef __attribute__((ext_vector_type(16))) float f32x16;
typedef unsigned u32x2 __attribute__((ext_vector_type(2)));
#define MFMA32(a, b, c) __builtin_amdgcn_mfma_f32_32x32x16_bf16((a), (b), (c), 0, 0, 0)
__device__ __forceinline__ int crow(int i, int h) { return (i & 3) + 8 * (i >> 2) + 4 * h; }
__device__ __forceinline__ s16x8 cvt8(const f32x8 x) { return __builtin_bit_cast(s16x8, __builtin_convertvector(x, bf8_t)); }
__device__ __forceinline__ s16x8 pack_acc(const f32x16& x, int s) { f32x8 v;
#pragma unroll
    for (int j = 0; j < 8; ++j) v[j] = x[8 * s + j];
    return cvt8(v); }
__device__ __forceinline__ s16x8 cat4(const s16x4 lo, const s16x4 hi) { return __builtin_shufflevector(lo, hi, 0, 1, 2, 3, 4, 5, 6, 7); }
__device__ __forceinline__ f32x16 zero16() { f32x16 z;
#pragma unroll
    for (int i = 0; i < 16; ++i) z[i] = 0.f;
    return z; }
constexpr int L_BM = 0, L_CM = 18432, L_BMT = 36864, L_XDT = 54272, L_ACS = 106496, L_DT = 108032, L_TOT = 109568;

__device__ __forceinline__ void ssd_chunk_unit(const Args& a, unsigned char* ws, LAS unsigned char* lds, int l_, int unit, int tid, int wave, int lane) {
    const int g = unit & 1, c = (unit >> 1) & 31, b = unit >> 6, t0 = b * S + c * 128;
    const bf16* proj = (const bf16*)(ws + WS_PROJ); const float* dtf = (const float*)(ws + WS_DTF);
    LAS float* acs = (LAS float*)(lds + L_ACS); LAS float* dts = (LAS float*)(lds + L_DT); LAS float* tot = (LAS float*)(lds + L_TOT);
    float cs = 0.f, dtv = 0.f;
    if (wave < 6) {
        const int hh = wave >> 1, l = (wave & 1) * 64 + lane;
        dtv = dtf[(size_t)(t0 + l) * 8 + 3 * g + hh];
        cs = dtv * -expf(AIN(I_ALOG)[l_ * 6 + 3 * g + hh]);
#pragma unroll
        for (int o = 1; o < 64; o <<= 1) { const float t = bperm_f(cs, lane - o); if (lane >= o) cs += t; }
        if (lane == 63) tot[wave] = cs;
    }
    __syncthreads();
    if (wave < 6) {
        const int hh = wave >> 1, l = (wave & 1) * 64 + lane;
        if (wave & 1) cs += tot[wave - 1];
        acs[hh * 128 + l] = cs; dts[hh * 128 + l] = dtv;
        ((float*)(ws + WS_ACSG))[(size_t)(t0 + l) * 8 + 3 * g + hh] = cs;
    }
    __syncthreads();
    const float* cw = AIN(I_CONVW) + l_ * 4 * CONV_CH; const float* cb = AIN(I_CONVB) + l_ * CONV_CH;
#pragma unroll 2
    for (int it = 0; it < 10; ++it) {
        const int idx = tid + 512 * it, l = idx / 40, ck = idx % 40;
        int cc, kind, hh = 0, e0;
        if (ck < 24) { hh = ck >> 3; e0 = (ck & 7) * 8; cc = (3 * g + hh) * 64 + e0; kind = 0; }
        else if (ck < 32) { e0 = (ck - 24) * 8; cc = 384 + g * 64 + e0; kind = 1; }
        else { e0 = (ck - 32) * 8; cc = 512 + g * 64 + e0; kind = 2; }
        float acc[8];
        { const f32x4 b0 = *(const f32x4*)(cb + cc), b1 = *(const f32x4*)(cb + cc + 4); acc[0] = b0.x; acc[1] = b0.y; acc[2] = b0.z; acc[3] = b0.w; acc[4] = b1.x; acc[5] = b1.y; acc[6] = b1.z; acc[7] = b1.w; }
#pragma unroll
        for (int k = 0; k < 4; ++k) {
            const int sl = c * 128 + l - 3 + k;
            if (sl >= 0) {
                const v4u xv = *(const GAS v4u*)(proj + (size_t)(t0 + l - 3 + k) * NPROJ + PC_XBC + cc);
                const f32x4 w0 = *(const f32x4*)(cw + k * CONV_CH + cc), w1 = *(const f32x4*)(cw + k * CONV_CH + cc + 4);
                acc[0] += w0.x * __uint_as_float(xv.x << 16); acc[1] += w0.y * __uint_as_float(xv.x & 0xffff0000u);
                acc[2] += w0.z * __uint_as_float(xv.y << 16); acc[3] += w0.w * __uint_as_float(xv.y & 0xffff0000u);
                acc[4] += w1.x * __uint_as_float(xv.z << 16); acc[5] += w1.y * __uint_as_float(xv.z & 0xffff0000u);
                acc[6] += w1.z * __uint_as_float(xv.w << 16); acc[7] += w1.w * __uint_as_float(xv.w & 0xffff0000u);
            }
        }
#pragma unroll
        for (int e = 0; e < 8; ++e) acc[e] = silu_f(acc[e]);
        v4u pk; pk.x = pkbf(acc[0], acc[1]); pk.y = pkbf(acc[2], acc[3]); pk.z = pkbf(acc[4], acc[5]); pk.w = pkbf(acc[6], acc[7]);
        if (kind == 0) {
            *(GAS v4u*)((bf16*)(ws + WS_XCONV) + (size_t)(t0 + l) * 384 + (3 * g + hh) * 64 + e0) = pk;
            const float d = dts[hh * 128 + l];
            LAS bf16* xd = (LAS bf16*)(lds + L_XDT) + (hh * 64 + e0) * 136 + l;
#pragma unroll
            for (int e = 0; e < 8; e += 2) { const unsigned w = pkbf(acc[e] * d, acc[e + 1] * d); xd[e * 136] = (bf16)(w & 0xffffu); xd[(e + 1) * 136] = (bf16)(w >> 16); }
        } else if (kind == 1) {
            *(LAS v4u*)(lds + L_BM + (l * 72 + e0) * 2) = pk;
            LAS bf16* bt = (LAS bf16*)(lds + L_BMT) + e0 * 136 + l;
            bt[0 * 136] = (bf16)(pk.x & 0xffffu); bt[1 * 136] = (bf16)(pk.x >> 16); bt[2 * 136] = (bf16)(pk.y & 0xffffu); bt[3 * 136] = (bf16)(pk.y >> 16);
            bt[4 * 136] = (bf16)(pk.z & 0xffffu); bt[5 * 136] = (bf16)(pk.z >> 16); bt[6 * 136] = (bf16)(pk.w & 0xffffu); bt[7 * 136] = (bf16)(pk.w >> 16);
        } else {
            *(LAS v4u*)(lds + L_CM + (l * 72 + e0) * 2) = pk;
            *(GAS v4u*)((bf16*)(ws + WS_CMG) + (size_t)(t0 + l) * 128 + g * 64 + e0) = pk;
        }
    }
    __syncthreads();
    const int r = lane & 31, h = lane >> 5, lb = wave & 3, pt = wave >> 2;
    {
        s16x8 cf[4];
#pragma unroll
        for (int ks = 0; ks < 4; ++ks) cf[ks] = *(const LAS s16x8*)(lds + L_CM + ((lb * 32 + r) * 72 + ks * 16 + 8 * h) * 2);
        f32x16 gt[4];
#pragma unroll
        for (int sb = 0; sb < 4; ++sb) {
            gt[sb] = zero16();
            if (sb <= lb) {
#pragma unroll
                for (int ks = 0; ks < 4; ++ks) gt[sb] = MFMA32(*(const LAS s16x8*)(lds + L_BM + ((sb * 32 + r) * 72 + ks * 16 + 8 * h) * 2), cf[ks], gt[sb]);
            }
        }
#pragma unroll
        for (int hh = 0; hh < 3; ++hh) {
            const float al = acs[hh * 128 + lb * 32 + r];
            f32x16 yacc = zero16();
#pragma unroll
            for (int sb = 0; sb < 4; ++sb) {
                if (sb <= lb) {
                    f32x16 m;
#pragma unroll
                    for (int i = 0; i < 16; ++i) {
                        const int sl = crow(i, h);
                        const float v = gt[sb][i] * __expf(al - acs[hh * 128 + sb * 32 + sl]);
                        m[i] = (sb < lb || sl <= r) ? v : 0.f;
                    }
#pragma unroll
                    for (int ks = 0; ks < 2; ++ks) {
                        const LAS unsigned char* xp = lds + L_XDT + ((hh * 64 + pt * 32 + r) * 136 + sb * 32 + 16 * ks + 4 * h) * 2;
                        yacc = MFMA32(cat4(*(const LAS s16x4*)xp, *(const LAS s16x4*)(xp + 16)), pack_acc(m, ks), yacc);
                    }
                }
            }
            float* yp = (float*)(ws + WS_YPART) + (size_t)(t0 + lb * 32 + r) * 384 + (3 * g + hh) * 64 + pt * 32 + 4 * h;
#pragma unroll
            for (int i4 = 0; i4 < 4; ++i4) *(f32x4*)(yp + 8 * i4) = (f32x4){yacc[4 * i4], yacc[4 * i4 + 1], yacc[4 * i4 + 2], yacc[4 * i4 + 3]};
        }
    }
    for (int tl = wave; tl < 12; tl += 8) {
        const int hh = tl >> 2, nt = (tl >> 1) & 1, pt2 = tl & 1;
        const float alast = acs[hh * 128 + 127];
        f32x16 acc = zero16();
#pragma unroll
        for (int ks = 0; ks < 8; ++ks) {
            const s16x8 af = *(const LAS s16x8*)(lds + L_BMT + ((nt * 32 + r) * 136 + ks * 16 + 8 * h) * 2);
            const v4u xr = *(const LAS v4u*)(lds + L_XDT + ((hh * 64 + pt2 * 32 + r) * 136 + ks * 16 + 8 * h) * 2);
            const LAS float* ap = acs + hh * 128 + ks * 16 + 8 * h;
            f32x8 xf;
            xf[0] = __uint_as_float(xr.x << 16) * __expf(alast - ap[0]); xf[1] = __uint_as_float(xr.x & 0xffff0000u) * __expf(alast - ap[1]);
            xf[2] = __uint_as_float(xr.y << 16) * __expf(alast - ap[2]); xf[3] = __uint_as_float(xr.y & 0xffff0000u) * __expf(alast - ap[3]);
            xf[4] = __uint_as_float(xr.z << 16) * __expf(alast - ap[4]); xf[5] = __uint_as_float(xr.z & 0xffff0000u) * __expf(alast - ap[5]);
            xf[6] = __uint_as_float(xr.w << 16) * __expf(alast - ap[6]); xf[7] = __uint_as_float(xr.w & 0xffff0000u) * __expf(alast - ap[7]);
            acc = MFMA32(af, cvt8(xf), acc);
        }
        float* hp = (float*)(ws + WS_HS) + ((size_t)((b * 32 + c) * 6 + 3 * g + hh) * 64 + pt2 * 32 + r) * 64 + nt * 32 + 4 * h;
#pragma unroll
        for (int i4 = 0; i4 < 4; ++i4) *(f32x4*)(hp + 8 * i4) = (f32x4){acc[4 * i4], acc[4 * i4 + 1], acc[4 * i4 + 2], acc[4 * i4 + 3]};
    }
    if (tid < 3) ((float*)(ws + WS_CD))[(b * 32 + c) * 6 + 3 * g + tid] = __expf(acs[tid * 128 + 127]);
    __syncthreads();
}
__device__ __forceinline__ void ph_ssd_scan(unsigned char* ws, int bx, int G, int tid) {
    float* hs = (float*)(ws + WS_HS); const float* cd = (const float*)(ws + WS_CD);
    for (int e = bx * 512 + tid; e < 24 * 4096; e += G * 512) {
        const int bh = e >> 12, el = e & 4095, b = bh / 6, hh = bh % 6;
        float run = 0.f;
#pragma unroll 4
        for (int c = 0; c < 32; ++c) {
            const int idx = (b * 32 + c) * 6 + hh;
            const float v = hs[(size_t)idx * 4096 + el], d = cd[idx];
            hs[(size_t)idx * 4096 + el] = run; run = run * d + v;
        }
    }
}
__device__ __forceinline__ void ssd_finish_unit(const Args& a, unsigned char* ws, int l_, int unit, int wave, int lane) {
    const int g = unit & 1, c = (unit >> 1) & 31, b = unit >> 6, t0 = b * S + c * 128;
    const int r = lane & 31, h = lane >> 5, lb = wave & 3, hsel = wave >> 2;
    const int t = t0 + lb * 32 + r;
    const bf16* proj = (const bf16*)(ws + WS_PROJ); const bf16* cmg = (const bf16*)(ws + WS_CMG) + (size_t)t * 128 + g * 64;
    s16x8 cf[4];
#pragma unroll
    for (int ks = 0; ks < 4; ++ks) cf[ks] = *(const GAS s16x8*)(cmg + ks * 16 + 8 * h);
    for (int hh = hsel ? 2 : 0; hh < (hsel ? 3 : 2); ++hh) {
        const int hd = 3 * g + hh;
        const float* hin = (const float*)(ws + WS_HS) + (size_t)((b * 32 + c) * 6 + hd) * 4096;
        const float ea = __expf(((const float*)(ws + WS_ACSG))[(size_t)t * 8 + hd]), dsk = AIN(I_DSKIP)[l_ * 6 + hd];
        float ssq = 0.f;
#pragma unroll
        for (int pt = 0; pt < 2; ++pt) {
            f32x16 acc = zero16();
#pragma unroll
            for (int ks = 0; ks < 4; ++ks) {
                const float* hp = hin + (pt * 32 + r) * 64 + ks * 16 + 8 * h;
                const f32x4 h0 = *(const GAS f32x4*)hp, h1 = *(const GAS f32x4*)(hp + 4);
                acc = MFMA32(cvt8((f32x8){h0.x, h0.y, h0.z, h0.w, h1.x, h1.y, h1.z, h1.w}), cf[ks], acc);
            }
#pragma unroll
            for (int i4 = 0; i4 < 4; ++i4) {
                const int col = hd * 64 + pt * 32 + 8 * i4 + 4 * h;
                const f32x4 yp = *(const GAS f32x4*)((const float*)(ws + WS_YPART) + (size_t)t * 384 + col);
                const u32x2 xc = *(const GAS u32x2*)((const bf16*)(ws + WS_XCONV) + (size_t)t * 384 + col);
                const u32x2 zz = *(const GAS u32x2*)(proj + (size_t)t * NPROJ + PC_Z + col);
                const float y0 = (yp.x + acc[4 * i4 + 0] * ea + dsk * __uint_as_float(xc.x << 16)) * silu_f(__uint_as_float(zz.x << 16));
                const float y1 = (yp.y + acc[4 * i4 + 1] * ea + dsk * __uint_as_float(xc.x & 0xffff0000u)) * silu_f(__uint_as_float(zz.x & 0xffff0000u));
                const float y2 = (yp.z + acc[4 * i4 + 2] * ea + dsk * __uint_as_float(xc.y << 16)) * silu_f(__uint_as_float(zz.y << 16));
                const float y3 = (yp.w + acc[4 * i4 + 3] * ea + dsk * __uint_as_float(xc.y & 0xffff0000u)) * silu_f(__uint_as_float(zz.y & 0xffff0000u));
                ssq += (y0 * y0 + y1 * y1) + (y2 * y2 + y3 * y3);
                u32x2 w; w.x = pkbf(y0, y1); w.y = pkbf(y2, y3);
                *(GAS u32x2*)((bf16*)(ws + WS_YCAT) + (size_t)t * D + col) = w;
            }
        }
        ssq = swap32_add(ssq, ssq);
        if (h == 0) ((float*)(ws + WS_YSSQ))[(size_t)t * 16 + hd] = ssq;
    }
}

#define LOG2E 1.4426950408889634f
__device__ __forceinline__ s16x8 trv_frag(const LAS unsigned char* vimg, int key0, int ks, int dt, int lane) {
    const int h = lane >> 5, i16 = lane & 15, blk = (lane >> 4) & 1;
    const LAS unsigned char* p = vimg + (key0 + 16 * ks + 4 * h + (i16 >> 2)) * 144 + (dt * 32 + 16 * blk) * 2 + 8 * (i16 & 3);
    const s16x4 lo = __builtin_amdgcn_ds_read_tr16_b64_v4i16((LAS s16x4*)p), hi = __builtin_amdgcn_ds_read_tr16_b64_v4i16((LAS s16x4*)(p + 8 * 144));
    return cat4(lo, hi);
}
__device__ __forceinline__ void mem_unit(const Args& a, unsigned char* ws, LAS unsigned char* lds, int l_, int b, int hd, int qb, int tid, int wave, int lane) {
    const bf16* proj = (const bf16*)(ws + WS_PROJ); const bf16* memkv = (const bf16*)(ws + WS_MEMKV);
    const float* qg = AIN(I_MQG) + l_ * 64; const float* kg = AIN(I_MKG) + l_ * 64;
    LAS unsigned char* kimg = lds; LAS unsigned char* vimg = lds + 36864;
#pragma unroll
    for (int it = 0; it < 4; ++it) {
        const int idx = tid + 512 * it, m = idx >> 3, ch = idx & 7;
        const v4u kv = *(const GAS v4u*)(memkv + (size_t)(b * NMEM + m) * 512 + hd * 64 + ch * 8);
        const v4u vv = *(const GAS v4u*)(memkv + (size_t)(b * NMEM + m) * 512 + 256 + hd * 64 + ch * 8);
        float kf[8] = {__uint_as_float(kv.x << 16), __uint_as_float(kv.x & 0xffff0000u), __uint_as_float(kv.y << 16), __uint_as_float(kv.y & 0xffff0000u),
                       __uint_as_float(kv.z << 16), __uint_as_float(kv.z & 0xffff0000u), __uint_as_float(kv.w << 16), __uint_as_float(kv.w & 0xffff0000u)};
        float ss = 0.f;
#pragma unroll
        for (int e = 0; e < 8; ++e) ss += kf[e] * kf[e];
        ss = sum8(ss);
        const float rk = rsqrtf(ss * (1.f / 64.f) + EPS);
        const f32x4 g0 = *(const f32x4*)(kg + ch * 8), g1 = *(const f32x4*)(kg + ch * 8 + 4);
        v4u pk; pk.x = pkbf(kf[0] * rk * g0.x, kf[1] * rk * g0.y); pk.y = pkbf(kf[2] * rk * g0.z, kf[3] * rk * g0.w); pk.z = pkbf(kf[4] * rk * g1.x, kf[5] * rk * g1.y); pk.w = pkbf(kf[6] * rk * g1.z, kf[7] * rk * g1.w);
        *(LAS v4u*)(kimg + (m * 72 + ch * 8) * 2) = pk;
        *(LAS v4u*)(vimg + (m * 72 + ch * 8) * 2) = vv;
    }
    __syncthreads();
    const int r = lane & 31, h = lane >> 5;
    const int t = b * S + qb * 256 + wave * 32 + r;
    s16x8 qf[4];
    {
        f32x8 qv[4]; float ss = 0.f;
#pragma unroll
        for (int ks = 0; ks < 4; ++ks) {
            const v4u q = *(const GAS v4u*)(proj + (size_t)t * NPROJ + PC_QMEM + hd * 64 + ks * 16 + 8 * h);
            qv[ks] = (f32x8){__uint_as_float(q.x << 16), __uint_as_float(q.x & 0xffff0000u), __uint_as_float(q.y << 16), __uint_as_float(q.y & 0xffff0000u),
                             __uint_as_float(q.z << 16), __uint_as_float(q.z & 0xffff0000u), __uint_as_float(q.w << 16), __uint_as_float(q.w & 0xffff0000u)};
#pragma unroll
            for (int e = 0; e < 8; ++e) ss += qv[ks][e] * qv[ks][e];
        }
        ss = swap32_add(ss, ss);
        const float rq = rsqrtf(ss * (1.f / 64.f) + EPS) * (0.125f * LOG2E);
#pragma unroll
        for (int ks = 0; ks < 4; ++ks) {
            const f32x4 g0 = *(const f32x4*)(qg + ks * 16 + 8 * h), g1 = *(const f32x4*)(qg + ks * 16 + 8 * h + 4);
            qf[ks] = cvt8(qv[ks] * rq * (f32x8){g0.x, g0.y, g0.z, g0.w, g1.x, g1.y, g1.z, g1.w});
        }
    }
    f32x16 st[8];
    float mx = -INFINITY;
#pragma unroll
    for (int kt = 0; kt < 8; ++kt) {
        st[kt] = zero16();
#pragma unroll
        for (int ks = 0; ks < 4; ++ks) st[kt] = MFMA32(*(const LAS s16x8*)(kimg + ((kt * 32 + r) * 72 + ks * 16 + 8 * h) * 2), qf[ks], st[kt]);
#pragma unroll
        for (int i = 0; i < 16; ++i) mx = fmaxf(mx, st[kt][i]);
    }
    mx = swap32_max(mx);
    float lsum = 0.f;
    f32x16 o0 = zero16(), o1 = zero16();
#pragma unroll
    for (int kt = 0; kt < 8; ++kt) {
#pragma unroll
        for (int i = 0; i < 16; ++i) { st[kt][i] = __builtin_amdgcn_exp2f(st[kt][i] - mx); lsum += st[kt][i]; }
#pragma unroll
        for (int ks = 0; ks < 2; ++ks) {
            const s16x8 pf = pack_acc(st[kt], ks);
            o0 = MFMA32(trv_frag(vimg, kt * 32, ks, 0, lane), pf, o0);
            o1 = MFMA32(trv_frag(vimg, kt * 32, ks, 1, lane), pf, o1);
        }
    }
    lsum = swap32_add(lsum, lsum);
    const float il = 1.f / lsum; float ssq = 0.f;
    bf16* yc = (bf16*)(ws + WS_YCAT) + (size_t)t * D + 768 + hd * 64 + 4 * h;
#pragma unroll
    for (int i4 = 0; i4 < 4; ++i4) {
        const float a0 = o0[4 * i4] * il, a1 = o0[4 * i4 + 1] * il, a2 = o0[4 * i4 + 2] * il, a3 = o0[4 * i4 + 3] * il;
        const float b0 = o1[4 * i4] * il, b1 = o1[4 * i4 + 1] * il, b2 = o1[4 * i4 + 2] * il, b3 = o1[4 * i4 + 3] * il;
        ssq += (a0 * a0 + a1 * a1) + (a2 * a2 + a3 * a3) + (b0 * b0 + b1 * b1) + (b2 * b2 + b3 * b3);
        u32x2 w; w.x = pkbf(a0, a1); w.y = pkbf(a2, a3); *(GAS u32x2*)(yc + 8 * i4) = w;
        w.x = pkbf(b0, b1); w.y = pkbf(b2, b3); *(GAS u32x2*)(yc + 32 + 8 * i4) = w;
    }
    ssq = swap32_add(ssq, ssq);
    if (h == 0) ((float*)(ws + WS_YSSQ))[(size_t)t * 16 + 12 + hd] = ssq;
    __syncthreads();
}
__device__ __forceinline__ void sb_unit(unsigned char* ws, LAS unsigned char* lds, int b, int hd, int qb, int tid, int wave, int lane) {
    const bf16* proj = (const bf16*)(ws + WS_PROJ);
    const int r = lane & 31, h = lane >> 5;
    const int q0w = qb * 256 + wave * 32, t = b * S + q0w + r;
    s16x8 qf[4];
#pragma unroll
    for (int ks = 0; ks < 4; ++ks) {
        const v4u q = *(const GAS v4u*)(proj + (size_t)t * NPROJ + PC_QSB + hd * 64 + ks * 16 + 8 * h);
        const f32x8 qv = (f32x8){__uint_as_float(q.x << 16), __uint_as_float(q.x & 0xffff0000u), __uint_as_float(q.y << 16), __uint_as_float(q.y & 0xffff0000u),
                                 __uint_as_float(q.z << 16), __uint_as_float(q.z & 0xffff0000u), __uint_as_float(q.w << 16), __uint_as_float(q.w & 0xffff0000u)};
        qf[ks] = cvt8(qv * (0.125f * LOG2E));
    }
    const int srow = tid >> 3, sch = tid & 7;
    const bf16* kbase = proj + (size_t)(b * S) * NPROJ + PC_KSB + hd * 64 + sch * 8;
    const int ktop = qb * 4 + 3;
    v4u kr = *(const GAS v4u*)(kbase + (size_t)(ktop * 64 + srow) * NPROJ), vr = *(const GAS v4u*)(kbase + (size_t)(ktop * 64 + srow) * NPROJ + (PC_VSB - PC_KSB));
    *(LAS v4u*)(lds + (srow * 72 + sch * 8) * 2) = kr; *(LAS v4u*)(lds + 9216 + (srow * 72 + sch * 8) * 2) = vr;
    __syncthreads();
    f32x16 o0 = zero16(), o1 = zero16();
    float R = 0.f;
    volatile LAS unsigned* live = (volatile LAS unsigned*)(lds + 36864);
    bool mylive = true;
    for (int kt = ktop; kt >= 0; --kt) {
        LAS unsigned char* kimg = lds + ((ktop - kt) & 1) * 18432; LAS unsigned char* vimg = kimg + 9216;
        if (kt > 0) { kr = *(const GAS v4u*)(kbase + (size_t)((kt - 1) * 64 + srow) * NPROJ); vr = *(const GAS v4u*)(kbase + (size_t)((kt - 1) * 64 + srow) * NPROJ + (PC_VSB - PC_KSB)); }
#pragma unroll
        for (int sub = 1; sub >= 0; --sub) {
            const int kb = kt * 64 + sub * 32;
            if (kb <= q0w && mylive) {
                const bool diag = (kb == q0w);
                f32x16 z = zero16();
#pragma unroll
                for (int ks = 0; ks < 4; ++ks) z = MFMA32(*(const LAS s16x8*)(kimg + ((sub * 32 + r) * 72 + ks * 16 + 8 * h) * 2), qf[ks], z);
                float lk[16];
#pragma unroll
                for (int i = 0; i < 16; ++i) {
                    const float sp = fmaxf(z[i], 0.f) + __builtin_amdgcn_logf(1.f + __builtin_amdgcn_exp2f(-fabsf(z[i])));
                    const bool ok = !diag || (crow(i, h) < r);
                    lk[i] = ok ? -sp : 0.f;
                    z[i] = ok ? z[i] : -INFINITY;
                }
                float g[4], pg[4];
#pragma unroll
                for (int j = 0; j < 4; ++j) { g[j] = (lk[4 * j] + lk[4 * j + 1]) + (lk[4 * j + 2] + lk[4 * j + 3]); pg[j] = partner32(g[j], h != 0); }
                float ab[4];
                ab[3] = R + (h == 0 ? pg[3] : 0.f);
#pragma unroll
                for (int j = 2; j >= 0; --j) ab[j] = ab[j + 1] + g[j + 1] + (h == 0 ? pg[j] : pg[j + 1]);
#pragma unroll
                for (int j = 0; j < 4; ++j) {
                    const float s3 = ab[j], s2 = s3 + lk[4 * j + 3], s1 = s2 + lk[4 * j + 2], s0 = s1 + lk[4 * j + 1];
                    z[4 * j + 3] = __builtin_amdgcn_exp2f(z[4 * j + 3] + lk[4 * j + 3] + s3);
                    z[4 * j + 2] = __builtin_amdgcn_exp2f(z[4 * j + 2] + lk[4 * j + 2] + s2);
                    z[4 * j + 1] = __builtin_amdgcn_exp2f(z[4 * j + 1] + lk[4 * j + 1] + s1);
                    z[4 * j + 0] = __builtin_amdgcn_exp2f(z[4 * j + 0] + lk[4 * j + 0] + s0);
                }
                R = ab[0] + g[0] + (h == 0 ? 0.f : pg[0]);
#pragma unroll
                for (int ks = 0; ks < 2; ++ks) {
                    const s16x8 pf = pack_acc(z, ks);
                    o0 = MFMA32(trv_frag(vimg, sub * 32, ks, 0, lane), pf, o0);
                    o1 = MFMA32(trv_frag(vimg, sub * 32, ks, 1, lane), pf, o1);
                }
            }
        }
        if (kt > 0) { LAS unsigned char* nimg = lds + ((ktop - kt + 1) & 1) * 18432; *(LAS v4u*)(nimg + (srow * 72 + sch * 8) * 2) = kr; *(LAS v4u*)(nimg + 9216 + (srow * 72 + sch * 8) * 2) = vr; }
        mylive = mylive && (__builtin_amdgcn_ballot_w64(R >= -150.f) != 0ull);
        if (lane == 0) live[((ktop - kt) & 1) * 8 + wave] = mylive ? 1u : 0u;
        __syncthreads();
        { unsigned any = 0u;
#pragma unroll
          for (int w = 0; w < 8; ++w) any |= live[((ktop - kt) & 1) * 8 + w];
          if (any == 0u) break; }
    }
    float ssq = 0.f;
    bf16* yc = (bf16*)(ws + WS_YCAT) + (size_t)t * D + 384 + hd * 64 + 4 * h;
#pragma unroll
    for (int i4 = 0; i4 < 4; ++i4) {
        const float a0 = o0[4 * i4], a1 = o0[4 * i4 + 1], a2 = o0[4 * i4 + 2], a3 = o0[4 * i4 + 3];
        const float b0 = o1[4 * i4], b1 = o1[4 * i4 + 1], b2 = o1[4 * i4 + 2], b3 = o1[4 * i4 + 3];
        ssq += (a0 * a0 + a1 * a1) + (a2 * a2 + a3 * a3) + (b0 * b0 + b1 * b1) + (b2 * b2 + b3 * b3);
        u32x2 w; w.x = pkbf(a0, a1); w.y = pkbf(a2, a3); *(GAS u32x2*)(yc + 8 * i4) = w;
        w.x = pkbf(b0, b1); w.y = pkbf(b2, b3); *(GAS u32x2*)(yc + 32 + 8 * i4) = w;
    }
    ssq = swap32_add(ssq, ssq);
    if (h == 0) ((float*)(ws + WS_YSSQ))[(size_t)t * 16 + 6 + hd] = ssq;
}
constexpr int CW_Q = 8192;
__device__ __forceinline__ void ph_mix(const Args& a, unsigned char* ws, LAS unsigned char* lds, int l, int qoff, int tid, int wave, int lane) {
    unsigned* head = (unsigned*)(ws + WS_CTL) + CW_Q + 64 * l + qoff;
    volatile LAS unsigned* slot = (volatile LAS unsigned*)(lds + MISC_OFF);
    for (int it = 0;; ++it) {
        if (tid == 0) slot[it & 1] = __hip_atomic_fetch_add(head, 1u, __ATOMIC_RELAXED, __HIP_MEMORY_SCOPE_AGENT);
        __syncthreads();
        const int n = (int)slot[it & 1];
        if (n >= 896) break;
        asm volatile("" : "+s"(ws), "+v"(tid));
        lane = tid & 63; wave = __builtin_amdgcn_readfirstlane(tid >> 6);
        if (n < 384) { const int qb = 15 - n / 24, bh = n % 24; sb_unit(ws, lds, bh / 6, bh % 6, qb, tid, wave, lane); }
        else if (n < 640) { const int m = n - 384; mem_unit(a, ws, lds, l, m >> 6, (m >> 4) & 3, m & 15, tid, wave, lane); }
        else ssd_chunk_unit(a, ws, lds, l, n - 640, tid, wave, lane);
    }
}

__device__ __forceinline__ unsigned f2o(float f) { const unsigned b = __float_as_uint(f); return b ^ ((unsigned)((int)b >> 31) | 0x80000000u); }
__device__ __forceinline__ float o2f(unsigned k) { return __uint_as_float(k ^ ((k & 0x80000000u) ? 0x80000000u : 0xffffffffu)); }
#define TK_CE(a, b) do { const unsigned _mx = (a) > (b) ? (a) : (b), _mn = (a) > (b) ? (b) : (a); (a) = _mx; (b) = _mn; } while (0)
template <int N, int BASE> __device__ __forceinline__ void tk_sort16(unsigned (&k)[N]) {
#pragma unroll
    for (int sz = 2; sz <= 16; sz <<= 1)
#pragma unroll
        for (int j = sz >> 1; j > 0; j >>= 1)
#pragma unroll
            for (int i = 0; i < 16; ++i) { const int l = i ^ j; if (l > i) { if ((i & sz) == 0) TK_CE(k[BASE + i], k[BASE + l]); else TK_CE(k[BASE + l], k[BASE + i]); } }
}
template <int NA, int A, int NB_, int B> __device__ __forceinline__ void tk_merge16(unsigned (&ka)[NA], const unsigned (&kb)[NB_]) {
#pragma unroll
    for (int i = 0; i < 16; ++i) ka[A + i] = ka[A + i] > kb[B + 15 - i] ? ka[A + i] : kb[B + 15 - i];
#pragma unroll
    for (int j = 8; j > 0; j >>= 1)
#pragma unroll
        for (int i = 0; i < 16; ++i) { const int l = i ^ j; if (l > i) TK_CE(ka[A + i], ka[A + l]); }
}
__device__ __forceinline__ void ph_topk(unsigned char* ws, LAS unsigned char* lds, int gw, int NGW, int wave, int lane) {
    const float* scores = (const float*)(ws + WS_SCORES); int* eidx = (int*)(ws + WS_EIDX); float* gate = (float*)(ws + WS_GATE);
    LAS float* tr = (LAS float*)(lds + wave * WSCR);
    for (int b = gw; b < T * 8 / 64; b += NGW) {
        const float* sb = scores + (size_t)b * 64 * 256;
        unsigned top[2][16];
#pragma unroll
        for (int c = 0; c < 2; ++c) {
#pragma unroll
            for (int half = 0; half < 2; ++half) {
#pragma unroll 4
                for (int i = 0; i < 16; ++i) {
                    const int pp = 4 * i + (lane >> 4), vq = (lane & 15) * 4;
                    const f32x4 x = *(const GAS f32x4*)(sb + pp * 256 + c * 128 + half * 64 + vq);
                    LAS float* r = tr + pp * 65 + vq;
                    r[0] = x.x; r[1] = x.y; r[2] = x.z; r[3] = x.w;
                }
                asm volatile("s_waitcnt lgkmcnt(0)" ::: "memory");
                unsigned k[64];
#pragma unroll
                for (int v = 0; v < 64; ++v) k[v] = (f2o(tr[lane * 65 + v]) & ~127u) | (unsigned)(127 - (half * 64 + v));
                asm volatile("s_waitcnt lgkmcnt(0)" ::: "memory");
                tk_sort16<64, 0>(k); tk_sort16<64, 16>(k); tk_sort16<64, 32>(k); tk_sort16<64, 48>(k);
                tk_merge16<64, 0, 64, 16>(k, k); tk_merge16<64, 32, 64, 48>(k, k); tk_merge16<64, 0, 64, 32>(k, k);
                if (half == 0) {
#pragma unroll
                    for (int i = 0; i < 16; ++i) top[c][i] = k[i];
                } else tk_merge16<16, 0, 64, 0>(top[c], k);
            }
        }
        float av[16], bv[16];
#pragma unroll
        for (int i = 0; i < 16; ++i) { av[i] = o2f(top[0][i] & ~127u); bv[i] = o2f(top[1][i] & ~127u); }
        LAS int* li = (LAS int*)tr + lane * 32;
#pragma unroll
        for (int i = 0; i < 16; ++i) { li[i] = 127 - (int)(top[0][i] & 127u); li[16 + i] = 127 - (int)(top[1][i] & 127u); }
        unsigned key[64];
        key[0] = (f2o(av[0] + bv[0]) & ~255u) | 255u;
        key[1] = (f2o(av[0] + bv[1]) & ~255u) | 254u;
        key[2] = (f2o(av[0] + bv[2]) & ~255u) | 253u;
        key[3] = (f2o(av[0] + bv[3]) & ~255u) | 252u;
        key[4] = (f2o(av[0] + bv[4]) & ~255u) | 251u;
        key[5] = (f2o(av[0] + bv[5]) & ~255u) | 250u;
        key[6] = (f2o(av[0] + bv[6]) & ~255u) | 249u;
        key[7] = (f2o(av[0] + bv[7]) & ~255u) | 248u;
        key[8] = (f2o(av[0] + bv[8]) & ~255u) | 247u;
        key[9] = (f2o(av[0] + bv[9]) & ~255u) | 246u;
        key[10] = (f2o(av[0] + bv[10]) & ~255u) | 245u;
        key[11] = (f2o(av[0] + bv[11]) & ~255u) | 244u;
        key[12] = (f2o(av[0] + bv[12]) & ~255u) | 243u;
        key[13] = (f2o(av[0] + bv[13]) & ~255u) | 242u;
        key[14] = (f2o(av[0] + bv[14]) & ~255u) | 241u;
        key[15] = (f2o(av[0] + bv[15]) & ~255u) | 240u;
        key[16] = (f2o(av[1] + bv[0]) & ~255u) | 239u;
        key[17] = (f2o(av[1] + bv[1]) & ~255u) | 238u;
        key[18] = (f2o(av[1] + bv[2]) & ~255u) | 237u;
        key[19] = (f2o(av[1] + bv[3]) & ~255u) | 236u;
        key[20] = (f2o(av[1] + bv[4]) & ~255u) | 235u;
        key[21] = (f2o(av[1] + bv[5]) & ~255u) | 234u;
        key[22] = (f2o(av[1] + bv[6]) & ~255u) | 233u;
        key[23] = (f2o(av[1] + bv[7]) & ~255u) | 232u;
        key[24] = (f2o(av[2] + bv[0]) & ~255u) | 223u;
        key[25] = (f2o(av[2] + bv[1]) & ~255u) | 222u;
        key[26] = (f2o(av[2] + bv[2]) & ~255u) | 221u;
        key[27] = (f2o(av[2] + bv[3]) & ~255u) | 220u;
        key[28] = (f2o(av[2] + bv[4]) & ~255u) | 219u;
        key[29] = (f2o(av[3] + bv[0]) & ~255u) | 207u;
        key[30] = (f2o(av[3] + bv[1]) & ~255u) | 206u;
        key[31] = (f2o(av[3] + bv[2]) & ~255u) | 205u;
        key[32] = (f2o(av[3] + bv[3]) & ~255u) | 204u;
        key[33] = (f2o(av[4] + bv[0]) & ~255u) | 191u;
        key[34] = (f2o(av[4] + bv[1]) & ~255u) | 190u;
        key[35] = (f2o(av[4] + bv[2]) & ~255u) | 189u;
        key[36] = (f2o(av[5] + bv[0]) & ~255u) | 175u;
        key[37] = (f2o(av[5] + bv[1]) & ~255u) | 174u;
        key[38] = (f2o(av[6] + bv[0]) & ~255u) | 159u;
        key[39] = (f2o(av[6] + bv[1]) & ~255u) | 158u;
        key[40] = (f2o(av[7] + bv[0]) & ~255u) | 143u;
        key[41] = (f2o(av[7] + bv[1]) & ~255u) | 142u;
        key[42] = (f2o(av[8] + bv[0]) & ~255u) | 127u;
        key[43] = (f2o(av[9] + bv[0]) & ~255u) | 111u;
        key[44] = (f2o(av[10] + bv[0]) & ~255u) | 95u;
        key[45] = (f2o(av[11] + bv[0]) & ~255u) | 79u;
        key[46] = (f2o(av[12] + bv[0]) & ~255u) | 63u;
        key[47] = (f2o(av[13] + bv[0]) & ~255u) | 47u;
        key[48] = (f2o(av[14] + bv[0]) & ~255u) | 31u;
        key[49] = (f2o(av[15] + bv[0]) & ~255u) | 15u;
#pragma unroll
        for (int i = 50; i < 64; ++i) key[i] = 0u;
        tk_sort16<64, 0>(key); tk_sort16<64, 16>(key); tk_sort16<64, 32>(key); tk_sort16<64, 48>(key);
        tk_merge16<64, 0, 64, 16>(key, key); tk_merge16<64, 32, 64, 48>(key, key); tk_merge16<64, 0, 64, 32>(key, key);
        asm volatile("s_waitcnt lgkmcnt(0)" ::: "memory");
        const float s0 = o2f(key[0] & ~255u);
        float ev[16]; int ei[16]; float den = 0.f;
#pragma unroll
        for (int w = 0; w < 16; ++w) {
            const unsigned ij = 255u - (key[w] & 255u);
            ev[w] = __expf(o2f(key[w] & ~255u) - s0); den += ev[w];
            ei[w] = li[ij >> 4] * 128 + li[16 + (ij & 15)];
        }
        const float inv = 1.f / den;
        const size_t ob = ((size_t)b * 64 + lane) * 16;
#pragma unroll
        for (int q = 0; q < 4; ++q) {
            typedef int i32x4 __attribute__((ext_vector_type(4)));
            *(GAS i32x4*)(eidx + ob + 4 * q) = (i32x4){ei[4 * q], ei[4 * q + 1], ei[4 * q + 2], ei[4 * q + 3]};
            *(GAS f32x4*)(gate + ob + 4 * q) = (f32x4){ev[4 * q] * inv, ev[4 * q + 1] * inv, ev[4 * q + 2] * inv, ev[4 * q + 3] * inv};
        }
        asm volatile("s_waitcnt lgkmcnt(0)" ::: "memory");
    }
}
typedef __attribute__((ext_vector_type(2))) __bf16 bf16x2_t;
__device__ __forceinline__ float dot2bf(unsigned a, unsigned b, float c) { return __builtin_amdgcn_fdot2_f32_bf16(__builtin_bit_cast(bf16x2_t, a), __builtin_bit_cast(bf16x2_t, b), c, false); }
__device__ __forceinline__ float gelu_erf(float v) { return 0.5f * v * (1.f + erff(v * 0.70710678118654752f)); }
typedef __attribute__((ext_vector_type(2))) float f32x2v;
constexpr int CW_Q2 = 12288;
__device__ __forceinline__ void cvt16(const v4u r, float (&f)[16]) {
    const unsigned w[4] = {r.x, r.y, r.z, r.w};
#pragma unroll
    for (int i = 0; i < 4; ++i) { const f32x2v lo = __builtin_amdgcn_cvt_pk_f32_fp8((int)w[i], false), hi = __builtin_amdgcn_cvt_pk_f32_fp8((int)w[i], true); f[4 * i] = lo.x; f[4 * i + 1] = lo.y; f[4 * i + 2] = hi.x; f[4 * i + 3] = hi.y; }
}
__device__ __forceinline__ void peer_u_token(const GAS unsigned char* us, const GAS int* eidx, const GAS bf16* xb, GAS float* part, int t, int s, int lane) {
    const int g = lane >> 3, j = lane & 7;
    const int e_lo = eidx[(size_t)t * 128 + lane], e_hi = eidx[(size_t)t * 128 + 64 + lane];
    const GAS unsigned char* xrow = (const GAS unsigned char*)(xb + (size_t)t * D + s * 128 + 16 * j);
    const v4u xa = *(const GAS v4u*)xrow, xc = *(const GAS v4u*)(xrow + 16);
    v4u r[16];
#pragma unroll
    for (int i = 0; i < 16; ++i) { const int e = bperm_i(i < 8 ? e_lo : e_hi, (8 * i + g) & 63); r[i] = *(const GAS v4u*)(us + (size_t)(unsigned)e * 128 + 16 * j); }
    float xv[16];
    { const unsigned xw[8] = {xa.x, xa.y, xa.z, xa.w, xc.x, xc.y, xc.z, xc.w};
#pragma unroll
      for (int i = 0; i < 8; ++i) { xv[2 * i] = __uint_as_float(xw[i] << 16); xv[2 * i + 1] = __uint_as_float(xw[i] & 0xffff0000u); } }
    float res_lo = 0.f, res_hi = 0.f;
#pragma unroll
    for (int i = 0; i < 16; ++i) {
        float f[16]; cvt16(r[i], f);
        float a0 = 0.f, a1 = 0.f;
#pragma unroll
        for (int k = 0; k < 16; k += 2) { a0 += xv[k] * f[k]; a1 += xv[k + 1] * f[k + 1]; }
        const float d = sum8(a0 + a1);
        if (i < 8) res_lo = (j == i) ? d : res_lo; else res_hi = (j == i - 8) ? d : res_hi;
    }
    part[(size_t)t * 128 + 8 * j + g] = res_lo; part[(size_t)t * 128 + 64 + 8 * j + g] = res_hi;
}
__device__ __forceinline__ void peer_v_token(const GAS unsigned char* vs, const GAS int* eidx, const GAS float* wgt, GAS float* x, GAS bf16* xb, GAS float* rs1p, int t, int s, int lane) {
    const int g = lane >> 3, j = lane & 7;
    const int e_lo = eidx[(size_t)t * 128 + lane], e_hi = eidx[(size_t)t * 128 + 64 + lane];
    const float w_lo = wgt[(size_t)t * 128 + lane], w_hi = wgt[(size_t)t * 128 + 64 + lane];
    v4u r[16]; float wi[16];
#pragma unroll
    for (int i = 0; i < 16; ++i) { const int src = (8 * i + g) & 63; const int e = bperm_i(i < 8 ? e_lo : e_hi, src); wi[i] = bperm_f(i < 8 ? w_lo : w_hi, src); r[i] = *(const GAS v4u*)(vs + (size_t)(unsigned)e * 128 + 16 * j); }
    GAS float* xr = x + (size_t)t * D + s * 128 + 16 * j;
    f32x4 xo[4];
    if (g == 0) {
#pragma unroll
        for (int q = 0; q < 4; ++q) xo[q] = *(const GAS f32x4*)(xr + 4 * q);
    }
    float acc[16];
#pragma unroll
    for (int k = 0; k < 16; ++k) acc[k] = 0.f;
#pragma unroll
    for (int i = 0; i < 16; ++i) {
        float f[16]; cvt16(r[i], f);
#pragma unroll
        for (int k = 0; k < 16; ++k) acc[k] += wi[i] * f[k];
    }
#pragma unroll
    for (int k = 0; k < 16; ++k) { float a = acc[k]; a += dpp_f<0x128>(a); a = swap16_add(a, a); acc[k] = swap32_add(a, a); }
    if (g == 0) {
        float o[16]; float s2 = 0.f;
#pragma unroll
        for (int q = 0; q < 4; ++q) {
            f32x4 ov; ov.x = xo[q].x + acc[4 * q]; ov.y = xo[q].y + acc[4 * q + 1]; ov.z = xo[q].z + acc[4 * q + 2]; ov.w = xo[q].w + acc[4 * q + 3];
            *(GAS f32x4*)(xr + 4 * q) = ov;
            o[4 * q] = ov.x; o[4 * q + 1] = ov.y; o[4 * q + 2] = ov.z; o[4 * q + 3] = ov.w;
            s2 += (ov.x * ov.x + ov.y * ov.y) + (ov.z * ov.z + ov.w * ov.w);
        }
        GAS bf16* xbr = xb + (size_t)t * D + s * 128 + 16 * j;
#pragma unroll
        for (int hh = 0; hh < 2; ++hh) { v4u w; w.x = pkbf(o[hh * 8 + 0], o[hh * 8 + 1]); w.y = pkbf(o[hh * 8 + 2], o[hh * 8 + 3]); w.z = pkbf(o[hh * 8 + 4], o[hh * 8 + 5]); w.w = pkbf(o[hh * 8 + 6], o[hh * 8 + 7]);
            *(GAS v4u*)(xbr + 8 * hh) = w; }
        s2 = sum8(s2);
        if (j == 0) rs1p[(size_t)t * 8 + s] = s2;
    }
}
__device__ __forceinline__ void ph_peer_sliced(const int phase, unsigned char* ws, LAS unsigned char* lds, float* xout, int l, int tid, int wave, int lane) {
    unsigned* heads = (unsigned*)(ws + WS_CTL) + CW_Q2 + (l * 2 + phase) * 8 * 64;
    volatile LAS unsigned* slot = (volatile LAS unsigned*)(lds + MISC_OFF);
    const GAS int* eidx = (const GAS int*)(ws + WS_EIDX);
    const int myx = (int)(xb_xcc_id() & 7u);
    int it = 0;
    for (int k = 0; k < 8; ++k) {
        const int s = (myx + k) & 7;
        const GAS unsigned char* tab = (const GAS unsigned char*)(ws + (phase == 0 ? WS_UT : WS_VT) + (size_t)l * 16384 * D + (size_t)s * 16384 * 128);
        for (;; ++it) {
            if (tid == 0) slot[it & 1] = __hip_atomic_fetch_add(heads + 64 * s, 1u, __ATOMIC_RELAXED, __HIP_MEMORY_SCOPE_AGENT);
            __syncthreads();
            const int c = (int)slot[it & 1];
            if (c >= T / 64) { ++it; break; }
            for (int i = 0; i < 8; ++i) {
                const int t = c * 64 + wave * 8 + i;
                if (phase == 0) peer_u_token(tab, eidx, (const GAS bf16*)(ws + WS_XB), (GAS float*)(ws + WS_PART) + (size_t)s * T * 128, t, s, lane);
                else peer_v_token(tab, eidx, (const GAS float*)(ws + WS_GATE), (GAS float*)xout, (GAS bf16*)(ws + WS_XB), (GAS float*)(ws + WS_RS1P), t, s, lane);
            }
        }
    }
}
__device__ __forceinline__ void ph_peer_w(unsigned char* ws, int l, int gw, int NGW, int lane) {
    const GAS int* eidx = (const GAS int*)(ws + WS_EIDX); GAS float* gate = (GAS float*)(ws + WS_GATE); const GAS float* part = (const GAS float*)(ws + WS_PART);
    const GAS float* usc = (const GAS float*)(ws + WS_USC) + l * 16384; const GAS float* vsc = (const GAS float*)(ws + WS_VSC) + l * 16384; const GAS float* xssq = (const GAS float*)(ws + WS_XSSQ);
    for (int t = gw; t < T; t += NGW) {
        const float r2 = rsqrtf(sum16(xssq[(size_t)t * 16 + (lane & 15)]) * (1.f / 1024.f) + EPS);
#pragma unroll
        for (int hh = 0; hh < 2; ++hh) {
            const size_t q = (size_t)t * 128 + 64 * hh + lane;
            float a = 0.f;
#pragma unroll
            for (int s = 0; s < 8; ++s) a += part[(size_t)s * T * 128 + q];
            const int e = eidx[q];
            gate[q] = gate[q] * gelu_erf(a * (r2 * usc[e])) * vsc[e];
        }
    }
}

constexpr int NPH_L = 10, NPHASES = 1 + NL * NPH_L;
#ifndef MK_PHMASK
#define MK_PHMASK 0x7ff
#endif
#define PH_ON(j) ((MK_PHMASK >> (j)) & 1)
#ifndef MK_REP
#define MK_REP 0
#endif
#define PH_REP(j) ((MK_REP >> (j)) & 1)
__global__ void __launch_bounds__(NWAVES * 64, 2) mega(Args a) {
    extern __shared__ __attribute__((aligned(16))) unsigned char lds_raw[];
    {
        LAS unsigned char* lds0 = (LAS unsigned char*)lds_raw;
        for (int u = threadIdx.x; u < (LDS_BYTES - LDSCTL_OFF) / 4; u += NWAVES * 64) ((LAS unsigned*)(lds0 + LDSCTL_OFF))[u] = 0u;
        __syncthreads();
    }
    int wave0 = __builtin_amdgcn_readfirstlane((int)threadIdx.x >> 6); asm volatile("" : "+s"(wave0));
    int ph_lo = a.ph_lo, ph_hi = a.ph_hi; asm volatile("" : "+s"(ph_lo), "+s"(ph_hi));
    const bool multi = (ph_hi - ph_lo) > 1;
    XcdBarrier bar; bar.bar = (unsigned*)(a.ws + WS_CTL) + CW_BAR + a.li * XCD_BAR_WORDS; bar.x = 0; bar.st = nullptr;
    if (multi) bar = xcd_barrier_post((unsigned*)(a.ws + WS_CTL) + CW_BAR + a.li * XCD_BAR_WORDS, (volatile LAS unsigned*)((LAS unsigned char*)lds_raw + MISC_OFF) + 8);

    for (int ph = ph_lo; ph < ph_hi; ++ph) {
        unsigned char* ws = a.ws; asm volatile("" : "+s"(ws));
        int G = (int)gridDim.x; asm volatile("" : "+s"(G));
        int bx = (int)blockIdx.x; asm volatile("" : "+s"(bx));
        int tid; asm volatile("v_mbcnt_lo_u32_b32 %0, -1, 0\n\tv_mbcnt_hi_u32_b32 %0, -1, %0" : "=v"(tid)); tid |= wave0 << 6;
        LAS unsigned char* lds = (LAS unsigned char*)lds_raw;
        const int lane = tid & 63, wave = __builtin_amdgcn_readfirstlane(tid >> 6);
        const int vcu = (G % 8 == 0) ? (bx % 8) * (G / 8) + bx / 8 : bx;
        const int gw = vcu * NWAVES + wave, NGW = G * NWAVES;
        if (ph == 0) {
            if (PH_ON(10)) for (int rep = 0; rep < 1 + PH_REP(10); ++rep) ph_prologue(a, ws, lds, gw, NGW, wave, lane);
        } else {
            const int l = (ph - 1) / NPH_L, j = (ph - 1) % NPH_L;
            if (j == 0 && PH_ON(0)) {
              for (int rep = 0; rep < 1 + PH_REP(0); ++rep) {
                { pg8::Gemm g{(const pg8::bf16_t*)(ws + WS_XB), (const pg8::bf16_t*)(ws + WS_WIN) + (size_t)l * NPROJ * D, T, NPROJ, D};
                  pg8::StaticOrder So; So.init(T, NPROJ, G, bx);
                  pg8::EpiInProj E{(pg8::bf16_t*)(ws + WS_PROJ), NPROJ, (const float*)(ws + WS_RS1P), (float*)(ws + WS_DTF), AIN(I_DTBIAS) + l * 6, 8};
                  pg8::gemm_phase<pg8::EpiInProj, pg8::StaticOrder, true, true>(lds, g, So, E, tid); }
                { pg8::Gemm g{(const pg8::bf16_t*)(ws + WS_MEMB), (const pg8::bf16_t*)(ws + WS_WMEM) + (size_t)l * 512 * D, MROWS, 512, D};
                  pg8::StaticOrder So; So.init(MROWS, 512, G, bx);
                  pg8::EpiInProj E{(pg8::bf16_t*)(ws + WS_MEMKV), 512, (const float*)(ws + WS_RSM), nullptr, nullptr, 0};
                  pg8::gemm_phase<pg8::EpiInProj, pg8::StaticOrder, true, true>(lds, g, So, E, tid); }
              }
            } else if (j == 1 && PH_ON(1)) {
                for (int rep = 0; rep < 1 + PH_REP(1); ++rep) { ph_mix(a, ws, lds, l, 32 * rep, tid, wave, lane); __syncthreads(); }
            } else if (j == 2 && PH_ON(2)) {
                ph_ssd_scan(ws, bx, G, tid);
            } else if (j == 3 && PH_ON(3)) {
                for (int rep = 0; rep < 1 + PH_REP(3); ++rep) for (int u = vcu; u < 256; u += G) ssd_finish_unit(a, ws, l, u, wave, lane);
            } else if (j == 4 && PH_ON(4)) {
                pg8::Gemm g{(const pg8::bf16_t*)(ws + WS_YCAT), (const pg8::bf16_t*)(ws + WS_WOUT) + (size_t)l * D * D, T, D, D};
                pg8::StaticOrder So; So.init(T, D, G, bx);
                LAS float* gtab = (LAS float*)(lds + GTAB_OFF);
                { pg8::Unit u0; if (So.next(0, u0) && tid < 256) { float r0, r1, r2; pg8::group_rstd((const float*)(ws + WS_YSSQ), u0.pm * 256 + tid, r0, r1, r2); gtab[tid] = r0 / r1; gtab[256 + tid] = r1 / r2; gtab[512 + tid] = r2; } }
                __syncthreads();
                pg8::EpiOut E{l == 0 ? AIN(I_X) : a.out, a.out, (pg8::bf16_t*)(ws + WS_XB), (float*)(ws + WS_XSSQ), gtab};
                pg8::gemm_phase<pg8::EpiOut, pg8::StaticOrder, true, true>(lds, g, So, E, tid);
            } else if (j == 5 && PH_ON(5)) {
                pg8::Gemm g{(const pg8::bf16_t*)(ws + WS_XB), (const pg8::bf16_t*)(ws + WS_WSC) + (size_t)l * 2048 * D, T, 2048, D};
                pg8::StaticOrder So; So.init(T, 2048, G, bx);
                pg8::EpiScores E{(float*)(ws + WS_SCORES), (const float*)(ws + WS_XSSQ)};
                for (int rep = 0; rep < 1 + PH_REP(5); ++rep) pg8::gemm_phase<pg8::EpiScores, pg8::StaticOrder, true, true>(lds, g, So, E, tid);
            } else if (j == 6 && PH_ON(6)) {
                for (int rep = 0; rep < 1 + PH_REP(6); ++rep) ph_topk(ws, lds, gw, NGW, wave, lane);
            } else if (j == 7 && PH_ON(7)) {
                ph_peer_sliced(0, ws, lds, a.out, l, tid, wave, lane);
            } else if (j == 8 && PH_ON(8)) {
                ph_peer_w(ws, l, gw, NGW, lane);
            } else if (j == 9 && PH_ON(9)) {
                ph_peer_sliced(1, ws, lds, a.out, l, tid, wave, lane);
            }
        }
        if (ph + 1 < ph_hi) { XcdBarrier b2 = bar; { unsigned* p = b2.bar; unsigned x = b2.x; asm volatile("" : "+s"(p), "+s"(x)); b2.bar = p; b2.x = x; } xcd_barrier(b2, tid); }
    }
}

#ifndef MK_ONE_LAUNCH
#define MK_ONE_LAUNCH 1
#endif
extern "C" void kernel_launch(void* const* d_in, const int* in_sizes, int n_in, void* d_out, int out_size, void* d_ws, size_t ws_size, hipStream_t stream) {
    static int grid = 0;
    if (grid == 0) {
        if (n_in != 22 || out_size != T * D || ws_size < WS_END) { fprintf(stderr, "kernel_launch: unexpected problem (n_in %d out %d ws %zu)\n", n_in, out_size, ws_size); grid = -1; return; }
        int dev = 0, cus = 0, per_cu = 0;
        if (hipGetDevice(&dev) != hipSuccess || hipDeviceGetAttribute(&cus, hipDeviceAttributeMultiprocessorCount, dev) != hipSuccess) { grid = -1; return; }
        if (hipFuncSetAttribute((const void*)mega, hipFuncAttributeMaxDynamicSharedMemorySize, LDS_BYTES) != hipSuccess) { fprintf(stderr, "kernel_launch: hipFuncSetAttribute failed\n"); grid = -1; return; }
        if (hipOccupancyMaxActiveBlocksPerMultiprocessor(&per_cu, (const void*)mega, NWAVES * 64, LDS_BYTES) != hipSuccess || per_cu < 1) { fprintf(stderr, "kernel_launch: occupancy query says %d\n", per_cu); (void)hipGetLastError(); per_cu = 1; }
        grid = cus;
    }
    if (grid < 0) return;
    (void)hipMemsetAsync((char*)d_ws + WS_CTL, 0, CTL_ZERO_BYTES, stream);
    Args a{};
    for (int i = 0; i < 22; ++i) a.in[i] = (const float*)d_in[i];
    a.out = (float*)d_out; a.ws = (unsigned char*)d_ws;
#if MK_ONE_LAUNCH
    a.ph_lo = 0; a.ph_hi = NPHASES; a.li = 0;
    hipLaunchKernelGGL(mega, dim3(grid), dim3(NWAVES * 64), LDS_BYTES, stream, a);
#else
    for (int ph = 0; ph < NPHASES; ++ph) { a.ph_lo = ph; a.ph_hi = ph + 1; a.li = 0; hipLaunchKernelGGL(mega, dim3(grid), dim3(NWAVES * 64), LDS_BYTES, stream, a); }
#endif
}
```

```cpp
#include <hip/hip_runtime.h>
#include <cstdio>
#include <cstdint>
#include <cmath>
namespace pg8 {
#define PG8_LAS __attribute__((address_space(3)))
typedef unsigned short bf16_t;
typedef short bf16x8 __attribute__((ext_vector_type(8)));
typedef float f32x4 __attribute__((ext_vector_type(4)));
typedef unsigned u32x4 __attribute__((ext_vector_type(4)));
constexpr int BM = 256, BK = 64, HALF = 128, HTB = HALF * BK * 2  , STAGE_BYTES = 8 * HTB, NXCD = 8, WGM = 8;

__host__ __device__ __forceinline__ int lds_byte(int r, int c) { const int st = (r >> 4) * 2 + (c >> 5), rr = r & 15, cc = c & 31, ob = rr * 64 + cc * 2; return st * 1024 + (ob ^ (((ob >> 9) & 1) << 5)); }
__host__ __device__ __forceinline__ void stage_rc(int b, int& R, int& C) { const int st = b / 1024, sb = b % 1024, swz = sb ^ (((sb >> 9) & 1) << 5); R = (st >> 1) * 16 + swz / 64; C = (st & 1) * 32 + (swz % 64) / 2; }
__host__ __device__ __forceinline__ int perm32(int rho) { const int n = rho >> 4, i = rho & 15; return 8 * (i >> 2) + 4 * n + (i & 3); }

struct Unit { int pm, pn; };
struct Gemm { const bf16_t* A; const bf16_t* Bt; int M, N, K; };

struct StaticOrder {
    int nM, nN, nwg, G, c;
    __host__ __device__ void init(int M, int N, int G_, int c_) { nM = M / BM; nN = N / BM; nwg = nM * nN; G = G_; c = c_; }
    __host__ __device__ bool next(int i, Unit& u) const {
        const long L = (long)i * G + c; if (L >= nwg) return false;
        int wgid = (int)L; { const int q = nwg / NXCD, r = nwg % NXCD, xcd = wgid % NXCD, off = wgid / NXCD; wgid = (xcd < r ? xcd * (q + 1) : r * (q + 1) + (xcd - r) * q) + off; }
        const int nig = WGM * nN, gid = wgid / nig, fm = gid * WGM, gsz = (nM - fm) < WGM ? (nM - fm) : WGM;
        u.pm = fm + ((wgid % nig) % gsz); u.pn = (wgid % nig) / gsz; return true;
    }
    __device__ __forceinline__ void a_ready(const Unit&) const {}
    __device__ __forceinline__ void done(const Unit&) const {}
};

__device__ __forceinline__ unsigned cvt_pk_bf16(float lo, float hi) { unsigned r; asm volatile("v_cvt_pk_bf16_f32 %0, %1, %2" : "=v"(r) : "v"(lo), "v"(hi)); return r; }
template <class Epi, class Sched, bool ALIGN_EPI = false, bool SP2 = false>
__device__ __forceinline__ void gemm_phase(PG8_LAS unsigned char* lds, const Gemm g, const Sched& S, const Epi& E, const int tid_in) {
    int tid_ = tid_in; asm volatile("" : "+v"(tid_));
    const int tid = tid_, wid = __builtin_amdgcn_readfirstlane(tid >> 6), lane = tid & 63, wr = wid >> 2, wc = wid & 3, fr = lane & 15, fq = lane >> 4;
    const int K = g.K, nt = K / BK;
    unsigned voffA[2], voffB[2];
#pragma unroll
    for (int i = 0; i < 2; ++i) { int R, C; stage_rc(tid * 16 + i * 8192, R, C); const int Rb = Epi::PERM ? ((R & ~31) + perm32(R & 31)) : R;
        voffA[i] = (unsigned)(R * K + C) * 2u; voffB[i] = (unsigned)(Rb * K + C) * 2u; }
    const size_t kstep = (size_t)(BK * 2);
    const size_t hstep = (size_t)HALF * K * 2;
    const size_t tstep = 2 * hstep;
    const unsigned ldsw = (unsigned)wid * 1024u;
    const int aoff = lds_byte(wr * 64 + fr, fq * 8), boff = lds_byte(wc * 32 + fr, fq * 8);
#define PG8_SA(b, h) (((b) * 2 + (h)) * HTB)
#define PG8_SB(b, h) ((4 + (b) * 2 + (h)) * HTB)
#define PG8_STAGE(bufoff, gbase, voff) do { _Pragma("unroll") for (int _i = 0; _i < 2; ++_i) \
        __builtin_amdgcn_global_load_lds((const unsigned*)((const char*)(gbase) + (voff)[_i]), (PG8_LAS unsigned*)(lds + (bufoff) + ldsw + _i * 8192), 16, 0, 0); } while (0)
#define PG8_LDA(dst, b, h) do { _Pragma("unroll") for (int m = 0; m < 4; ++m) _Pragma("unroll") for (int k = 0; k < 2; ++k) dst[m][k] = *(const PG8_LAS bf16x8*)(lds + PG8_SA(b, h) + aoff + m * 2048 + k * 1024); } while (0)
#define PG8_LDB(dst, b, h) do { _Pragma("unroll") for (int n = 0; n < 2; ++n) _Pragma("unroll") for (int k = 0; k < 2; ++k) dst[n][k] = *(const PG8_LAS bf16x8*)(lds + PG8_SB(b, h) + boff + n * 2048 + k * 1024); } while (0)
#define PG8_MMA(ai, bj, At, Bt) do { __builtin_amdgcn_s_setprio(1); _Pragma("unroll") for (int m = 0; m < 4; ++m) _Pragma("unroll") for (int n = 0; n < 2; ++n) _Pragma("unroll") for (int k = 0; k < 2; ++k) \
        acc[ai][bj][m][n] = __builtin_amdgcn_mfma_f32_16x16x32_bf16(Bt[n][k], At[m][k], acc[ai][bj][m][n], 0, 0, 0); __builtin_amdgcn_s_setprio(0); } while (0)
#define PG8_WAIT_V(n) asm volatile("s_waitcnt vmcnt(" #n ")" ::: "memory")
#define PG8_WAIT_L(n) asm volatile("s_waitcnt lgkmcnt(" #n ")" ::: "memory")
#define PG8_BAR __builtin_amdgcn_s_barrier()
#define PG8_SCHED __builtin_amdgcn_sched_barrier(0)
    Unit cur, nxt; int ui = 0;
    if (!S.next(0, cur)) return;
    f32x4 acc[2][2][4][2];
#pragma unroll
    for (int a = 0; a < 2; ++a)
#pragma unroll
        for (int b = 0; b < 2; ++b)
#pragma unroll
            for (int m = 0; m < 4; ++m)
#pragma unroll
                for (int n = 0; n < 2; ++n) acc[a][b][m][n] = (f32x4){0.f, 0.f, 0.f, 0.f};
    bf16x8 At[4][2], B0[2][2], B1[2][2];
    const char* cA = (const char*)g.A + (size_t)cur.pm * tstep; const char* cB = (const char*)g.Bt + (size_t)cur.pn * tstep;
    S.a_ready(cur);
    if constexpr (SP2) {
        PG8_STAGE(PG8_SB(0, 0), cB, voffB); PG8_STAGE(PG8_SB(0, 1), cB + hstep, voffB); PG8_STAGE(PG8_SA(0, 0), cA, voffA); PG8_STAGE(PG8_SA(0, 1), cA + hstep, voffA);
        if (wr == 1) PG8_BAR;
        PG8_WAIT_V(2); PG8_BAR;
        PG8_STAGE(PG8_SB(1, 0), cB + kstep, voffB); PG8_STAGE(PG8_SA(1, 0), cA + kstep, voffA); PG8_STAGE(PG8_SB(1, 1), cB + hstep + kstep, voffB);
        PG8_WAIT_V(6); PG8_BAR;
    } else {
        PG8_STAGE(PG8_SB(0, 0), cB, voffB); PG8_STAGE(PG8_SA(0, 0), cA, voffA); PG8_STAGE(PG8_SB(0, 1), cB + hstep, voffB); PG8_STAGE(PG8_SA(0, 1), cA + hstep, voffA);
        if (wr == 1) PG8_BAR;
        PG8_WAIT_V(4); PG8_BAR;
        PG8_STAGE(PG8_SB(1, 0), cB + kstep, voffB); PG8_STAGE(PG8_SA(1, 0), cA + kstep, voffA); PG8_STAGE(PG8_SB(1, 1), cB + hstep + kstep, voffB);
        PG8_WAIT_V(6); PG8_BAR;
    }
    for (;;) {
        const bool has_next = S.next(ui + 1, nxt);
        const char* nA = has_next ? (const char*)g.A + (size_t)nxt.pm * tstep : cA; const char* nB = has_next ? (const char*)g.Bt + (size_t)nxt.pn * tstep : cB;
        for (int t = 0; t < nt; t += 2) {
            const bool last = (t == nt - 2);
            const char* a1 = cA + (size_t)(t + 1) * kstep;
            const char* a2 = last ? nA : cA + (size_t)(t + 2) * kstep; const char* b2 = last ? nB : cB + (size_t)(t + 2) * kstep;
            const char* a3 = a2 + kstep; const char* b3 = b2 + kstep;
            if (last && has_next) S.a_ready(nxt);
            if constexpr (Epi::KHOOK) E.khook(acc, cur, t, wr, fr);
            if constexpr (SP2) {
            PG8_LDB(B0, 0, 0); PG8_LDB(B1, 0, 1); PG8_SCHED; PG8_LDA(At, 0, 0); PG8_STAGE(PG8_SA(1, 1), a1 + hstep, voffA);
            PG8_WAIT_V(8); PG8_WAIT_L(0); PG8_BAR; PG8_MMA(0, 0, At, B0); PG8_MMA(0, 1, At, B1); PG8_BAR; PG8_SCHED;
            PG8_LDA(At, 0, 1); PG8_STAGE(PG8_SB(0, 0), b2, voffB); PG8_STAGE(PG8_SB(0, 1), b2 + hstep, voffB); PG8_STAGE(PG8_SA(0, 0), a2, voffA);
            PG8_WAIT_V(8); PG8_WAIT_L(0); PG8_BAR; PG8_MMA(1, 0, At, B0); PG8_MMA(1, 1, At, B1); PG8_BAR; PG8_SCHED;
            PG8_LDB(B0, 1, 0); PG8_LDB(B1, 1, 1); PG8_SCHED; PG8_LDA(At, 1, 0); PG8_STAGE(PG8_SA(0, 1), a2 + hstep, voffA);
            PG8_WAIT_V(8); PG8_WAIT_L(0); PG8_BAR; PG8_MMA(0, 0, At, B0); PG8_MMA(0, 1, At, B1); PG8_BAR; PG8_SCHED;
            PG8_LDA(At, 1, 1); PG8_STAGE(PG8_SB(1, 0), b3, voffB); PG8_STAGE(PG8_SB(1, 1), b3 + hstep, voffB); PG8_STAGE(PG8_SA(1, 0), a3, voffA);
            PG8_WAIT_V(8); PG8_WAIT_L(0); PG8_BAR; PG8_MMA(1, 0, At, B0); PG8_MMA(1, 1, At, B1); PG8_BAR; PG8_SCHED;
            } else {
            PG8_LDB(B0, 0, 0); PG8_SCHED; PG8_LDA(At, 0, 0); PG8_STAGE(PG8_SA(1, 1), a1 + hstep, voffA);
            PG8_WAIT_L(8); PG8_BAR; PG8_WAIT_L(0); PG8_MMA(0, 0, At, B0); PG8_BAR; PG8_SCHED;
            PG8_LDB(B1, 0, 1); PG8_STAGE(PG8_SB(0, 0), b2, voffB);
            PG8_BAR; PG8_WAIT_L(0); PG8_MMA(0, 1, At, B1); PG8_BAR;
            PG8_LDA(At, 0, 1); PG8_STAGE(PG8_SA(0, 0), a2, voffA);
            PG8_BAR; PG8_WAIT_L(0); PG8_MMA(1, 0, At, B0); PG8_BAR; PG8_SCHED;
            PG8_STAGE(PG8_SB(0, 1), b2 + hstep, voffB);
            PG8_WAIT_V(6); PG8_BAR; PG8_MMA(1, 1, At, B1); PG8_BAR;
            PG8_LDB(B0, 1, 0); PG8_SCHED; PG8_LDA(At, 1, 0); PG8_STAGE(PG8_SA(0, 1), a2 + hstep, voffA);
            PG8_WAIT_L(8); PG8_BAR; PG8_WAIT_L(0); PG8_MMA(0, 0, At, B0); PG8_BAR; PG8_SCHED;
            PG8_LDB(B1, 1, 1); PG8_STAGE(PG8_SB(1, 0), b3, voffB);
            PG8_BAR; PG8_WAIT_L(0); PG8_MMA(0, 1, At, B1); PG8_BAR;
            PG8_LDA(At, 1, 1); PG8_STAGE(PG8_SA(1, 0), a3, voffA);
            PG8_BAR; PG8_WAIT_L(0); PG8_MMA(1, 0, At, B0); PG8_BAR; PG8_SCHED;
            PG8_STAGE(PG8_SB(1, 1), b3 + hstep, voffB);
            PG8_WAIT_V(6); PG8_BAR; PG8_MMA(1, 1, At, B1); PG8_BAR;
            }
        }
        if constexpr (ALIGN_EPI) { if (wr == 0) PG8_BAR; }
        if constexpr (!Epi::AFTER_DRAIN) { E(acc, cur, wr, wc, fr, fq); S.done(cur); }
        if (!has_next) break;
#pragma unroll
        for (int a = 0; a < 2; ++a)
#pragma unroll
            for (int b = 0; b < 2; ++b)
#pragma unroll
                for (int m = 0; m < 4; ++m)
#pragma unroll
                    for (int n = 0; n < 2; ++n) acc[a][b][m][n] = (f32x4){0.f, 0.f, 0.f, 0.f};
        cur = nxt; cA = nA; cB = nB; ++ui;
        if constexpr (ALIGN_EPI) { if (wr == 1) PG8_BAR; }
    }
    PG8_WAIT_V(0);
    if constexpr (!ALIGN_EPI) { if (wr == 0) PG8_BAR; }
    PG8_BAR;
    if constexpr (Epi::AFTER_DRAIN) { E.fused(acc, cur, wr, wc, fr, fq, lds, wid, lane); S.done(cur); }
#undef PG8_SA
#undef PG8_SB
#undef PG8_STAGE
#undef PG8_LDA
#undef PG8_LDB
#undef PG8_MMA
#undef PG8_WAIT_V
#undef PG8_WAIT_L
#undef PG8_BAR
#undef PG8_SCHED
}
}
#define GAS __attribute__((address_space(1)))
#define LAS __attribute__((address_space(3)))
typedef unsigned short bf16;
typedef unsigned v4u __attribute__((ext_vector_type(4)));
typedef float f32x4 __attribute__((ext_vector_type(4)));
typedef short bf16x8 __attribute__((ext_vector_type(8)));
typedef GAS unsigned gu32;
typedef GAS unsigned long long gu64;
#define RLX_AGENT __ATOMIC_RELAXED, __HIP_MEMORY_SCOPE_AGENT
#define LDS_WAIT() asm volatile("s_waitcnt lgkmcnt(0)" ::: "memory")
#define VM_WAIT() asm volatile("s_waitcnt vmcnt(0)" ::: "memory")
__device__ __forceinline__ unsigned long long rt() { return __builtin_amdgcn_s_memrealtime(); }
__device__ __forceinline__ unsigned f2bf(float f) { unsigned u = __builtin_bit_cast(unsigned, f); return (u + 0x7fffu + ((u >> 16) & 1u)) >> 16; }
__device__ __forceinline__ unsigned pk2(float lo, float hi) { return f2bf(lo) | (f2bf(hi) << 16); }

#define XB_TMO      128
#define XB_XCNT(j)  (256  + 64 * (j))
#define XB_XSUB(j)  (1280 + 64 * (j))
#define XB_XGEN(j)  (2304 + 64 * (j))
#define XB_TOP      3328
#define XB_TOPGEN   3392
#define XCD_BAR_WORDS 3456
#define XB_SPIN_CAP (1u << 18)

__device__ __forceinline__ unsigned xb_ld(unsigned* p)              { return __hip_atomic_load(p, __ATOMIC_RELAXED, __HIP_MEMORY_SCOPE_AGENT); }
__device__ __forceinline__ unsigned xb_add(unsigned* p, unsigned v) { return __hip_atomic_fetch_add(p, v, __ATOMIC_RELAXED, __HIP_MEMORY_SCOPE_AGENT); }
__device__ __forceinline__ unsigned xb_xcc_id() { return (unsigned)__builtin_amdgcn_s_getreg((3 << 11) | 20) & 0xFu; }
#define XB_SPIN(cond, bar) do { unsigned _sp = 0; while (cond) { __builtin_amdgcn_s_sleep(1); \
    if ((++_sp & 255u) == 0u) { if (xb_ld(&(bar)[XB_TMO])) break; if (_sp > XB_SPIN_CAP) { atomicAdd(&(bar)[XB_TMO], 1u); break; } } } } while (0)

struct XcdBarrier {
    unsigned* bar; unsigned x;
    volatile LAS unsigned* st;
};

__device__ __forceinline__ XcdBarrier xcd_barrier_post(unsigned* bar, volatile LAS unsigned* st) {
    XcdBarrier b; b.bar = bar; b.x = xb_xcc_id(); b.st = st;
    if (threadIdx.x == 0) (void)xb_add(&bar[XB_XCNT(b.x)], 1u);
    return b;
}
__device__ __forceinline__ void xcd_barrier_complete(unsigned* bar, unsigned x, unsigned& nloc, unsigned& nx) {
    const unsigned G = gridDim.x * gridDim.y * gridDim.z;
    unsigned sum, cnt, mine, sp = 0u;
    for (;;) {
        sum = 0u; cnt = 0u; mine = 0u;
#pragma unroll
        for (unsigned j = 0; j < 16; ++j) { const unsigned c = xb_ld(&bar[XB_XCNT(j)]); sum += c; cnt += (c > 0u) ? 1u : 0u; mine = (j == x) ? c : mine; }
        if (sum == G) break;
        __builtin_amdgcn_s_sleep(1);
        if ((++sp & 255u) == 0u) { if (xb_ld(&bar[XB_TMO])) break; if (sp > XB_SPIN_CAP) { atomicAdd(&bar[XB_TMO], 1u); break; } }
    }
    nloc = mine > 0u ? mine : 1u; nx = cnt > 0u ? cnt : 1u;
}

__device__ __forceinline__ void xcd_barrier(const XcdBarrier& b, const int tid) {
    asm volatile("s_waitcnt vmcnt(0)" ::: "memory");
    __syncthreads();
    if (tid == 0) {
        unsigned* bar = b.bar;
        __builtin_amdgcn_s_waitcnt(0);
        unsigned nloc = b.st[0], nx = b.st[1];
        if (nloc == 0u) { xcd_barrier_complete(bar, b.x, nloc, nx); b.st[0] = nloc; b.st[1] = nx; }
        const unsigned old = xb_add(&bar[XB_XSUB(b.x)], 1u);
        const unsigned gen = old / nloc;
        if (old + 1u == (gen + 1u) * nloc) {
            __builtin_amdgcn_fence(__ATOMIC_RELEASE, "agent");
            asm volatile("s_waitcnt vmcnt(0)" ::: "memory");
            const unsigned og = xb_add(&bar[XB_TOP], 1u);
            const unsigned tg = og / nx;
            if (og + 1u == (tg + 1u) * nx) xb_add(&bar[XB_TOPGEN], 1u);
            else XB_SPIN(xb_ld(&bar[XB_TOPGEN]) == tg, bar);
            __builtin_amdgcn_fence(__ATOMIC_ACQUIRE, "agent");
            xb_add(&bar[XB_XGEN(b.x)], 1u);
            asm volatile("s_waitcnt vmcnt(0)" ::: "memory");
        } else {
            XB_SPIN(xb_ld(&bar[XB_XGEN(b.x)]) == gen, bar);
            __builtin_amdgcn_fence(__ATOMIC_ACQUIRE, "agent");
            asm volatile("s_waitcnt vmcnt(0)" ::: "memory");
        }
    }
    __syncthreads();
}

constexpr int NWAVES = 8;
constexpr int D = 1024, NB = 4, S = 4096, T = NB * S, NL = 2, NMEM = 256, MROWS = NB * NMEM;
constexpr int DIN = 2438, NPROJ = 2560;
constexpr int PC_Z = 0, PC_XBC = 384, PC_QSB = 1024, PC_KSB = 1408, PC_VSB = 1792, PC_QMEM = 2176, PC_DT = 2432;
constexpr int CONV_CH = 640;
constexpr float EPS = 1e-6f;

constexpr int RING_BYTES = 131072;
constexpr int WSCR = 17408;
constexpr int LDSCTL_OFF = 8 * WSCR, MISC_OFF = LDSCTL_OFF + 320;
constexpr int LDS_BYTES = 147456;
constexpr int GTAB_OFF = LDSCTL_OFF + 1024;

constexpr size_t MiB = 1u << 20;
constexpr size_t WS_CTL = 0, CTL_ZERO_BYTES = 1 * MiB;
constexpr size_t WS_WIN = 2 * MiB;
constexpr size_t WS_WMEM = 12 * MiB;
constexpr size_t WS_WOUT = 14 * MiB;
constexpr size_t WS_WSC = 18 * MiB;
constexpr size_t WS_MEMB = 26 * MiB;
constexpr size_t WS_RSM = 28 * MiB;
constexpr size_t WS_RS1 = WS_RSM + 64 * 1024;
constexpr size_t WS_DTF = WS_RS1 + 64 * 1024;
constexpr size_t WS_XSSQ = 29 * MiB;
constexpr size_t WS_YSSQ = 30 * MiB;
constexpr size_t WS_MEMKV = 31 * MiB;
constexpr size_t WS_RS1P = 32 * MiB;
constexpr size_t WS_PART = 178 * MiB;
constexpr size_t WS_XB = 34 * MiB;
constexpr size_t WS_YCAT = 66 * MiB;
constexpr size_t WS_PROJ = 98 * MiB;
constexpr size_t WS_SCORES = 178 * MiB;
constexpr size_t WS_YPART = WS_SCORES;
constexpr size_t WS_XCONV = WS_SCORES + 24 * MiB;
constexpr size_t WS_CMG = WS_SCORES + 36 * MiB;
constexpr size_t WS_ACSG = WS_SCORES + 40 * MiB;
constexpr size_t WS_HS = WS_SCORES + 41 * MiB;
constexpr size_t WS_CD = WS_SCORES + 53 * MiB;
constexpr size_t WS_EIDX = 306 * MiB;
constexpr size_t WS_GATE = 314 * MiB;
constexpr size_t WS_STOP = 322 * MiB;
constexpr size_t WS_ITOP = 338 * MiB;
constexpr size_t WS_UT = 354 * MiB;
constexpr size_t WS_USC = 386 * MiB;
constexpr size_t WS_VT = 418 * MiB;
constexpr size_t WS_VSC = 450 * MiB;
constexpr size_t WS_END = 482 * MiB;
constexpr int CW_BAR = 4096;

__device__ __forceinline__ float bf2f(bf16 v) { return __uint_as_float((unsigned)v << 16); }
__device__ __forceinline__ unsigned pkbf(float lo, float hi) { return pg8::cvt_pk_bf16(lo, hi); }
template <int CTRL> __device__ __forceinline__ float dpp_f(float v) { return __uint_as_float((unsigned)__builtin_amdgcn_update_dpp(0, (int)__float_as_uint(v), CTRL, 0xf, 0xf, true)); }
__device__ __forceinline__ float swap32_add(float a, float b) {
    const auto r = __builtin_amdgcn_permlane32_swap(__float_as_uint(a), __float_as_uint(b), false, false); return __uint_as_float(r[0]) + __uint_as_float(r[1]); }
__device__ __forceinline__ float swap16_add(float a, float b) {
    const auto r = __builtin_amdgcn_permlane16_swap(__float_as_uint(a), __float_as_uint(b), false, false); return __uint_as_float(r[0]) + __uint_as_float(r[1]); }
__device__ __forceinline__ float swap32_max(float a) { const auto r = __builtin_amdgcn_permlane32_swap(__float_as_uint(a), __float_as_uint(a), false, false); return fmaxf(__uint_as_float(r[0]), __uint_as_float(r[1])); }
__device__ __forceinline__ float swap16_max(float a) { const auto r = __builtin_amdgcn_permlane16_swap(__float_as_uint(a), __float_as_uint(a), false, false); return fmaxf(__uint_as_float(r[0]), __uint_as_float(r[1])); }
__device__ __forceinline__ float partner32(float a, bool hi) { const auto r = __builtin_amdgcn_permlane32_swap(__float_as_uint(a), __float_as_uint(a), false, false); return __uint_as_float(hi ? r[0] : r[1]); }
__device__ __forceinline__ float sum8(float v) { v += dpp_f<0xB1>(v); v += dpp_f<0x4E>(v); v += dpp_f<0x141>(v); return v; }
__device__ __forceinline__ float sum16(float v) { v = sum8(v); v += dpp_f<0x140>(v); return v; }
__device__ __forceinline__ float wave_sum(float v) { v = sum16(v); v = swap16_add(v, v); return swap32_add(v, v); }
__device__ __forceinline__ float wave_max(float v) { v = fmaxf(v, dpp_f<0xB1>(v)); v = fmaxf(v, dpp_f<0x4E>(v)); v = fmaxf(v, dpp_f<0x141>(v)); v = fmaxf(v, dpp_f<0x140>(v)); v = swap16_max(v); return swap32_max(v); }
__device__ __forceinline__ float bperm_f(float v, int src_lane) { return __uint_as_float((unsigned)__builtin_amdgcn_ds_bpermute(src_lane << 2, (int)__float_as_uint(v))); }
__device__ __forceinline__ int bperm_i(int v, int src_lane) { return __builtin_amdgcn_ds_bpermute(src_lane << 2, v); }
__device__ __forceinline__ float softplus_f(float x) { return fmaxf(x, 0.f) + log1pf(expf(-fabsf(x))); }
__device__ __forceinline__ float silu_f(float x) { return x / (1.f + expf(-x)); }

namespace pg8 {
struct EpiInProj {
    static constexpr bool PERM = true, AFTER_DRAIN = false, KHOOK = false;
    bf16_t* O; int ldc; const float* rs; float* dtf; const float* dtb; int npart;
    __device__ __forceinline__ void operator()(const f32x4 (&acc)[2][2][4][2], const Unit& u, int wr, int wc, int fr, int fq) const {
        const int row0 = u.pm * BM + wr * 64 + fr, col0 = u.pn * BM + wc * 32 + 8 * fq;
        const bool dtl = dtf && (u.pn * BM == PC_DT - 128) && wc == 0 && fq == 0;
#pragma unroll
        for (int ai = 0; ai < 2; ++ai)
#pragma unroll
            for (int m = 0; m < 4; ++m) {
                const int row = row0 + ai * HALF + m * 16; float s;
                if (npart == 8) { const f32x4 p0 = *(const f32x4*)(rs + (size_t)row * 8), p1 = *(const f32x4*)(rs + (size_t)row * 8 + 4); s = rsqrtf((((p0[0] + p0[1]) + (p0[2] + p0[3])) + ((p1[0] + p1[1]) + (p1[2] + p1[3]))) * (1.f / 1024.f) + EPS); }
                else s = rs[row];
#pragma unroll
                for (int bj = 0; bj < 2; ++bj) {
                    const f32x4 v0 = acc[ai][bj][m][0] * s, v1 = acc[ai][bj][m][1] * s;
                    u32x4 w; w.x = cvt_pk_bf16(v0[0], v0[1]); w.y = cvt_pk_bf16(v0[2], v0[3]); w.z = cvt_pk_bf16(v1[0], v1[1]); w.w = cvt_pk_bf16(v1[2], v1[3]);
                    *(u32x4*)(O + (size_t)row * ldc + col0 + bj * HALF) = w;
                    if (bj == 1 && dtl) {
                        f32x4 d0; d0[0] = softplus_f(v0[0] + dtb[0]); d0[1] = softplus_f(v0[1] + dtb[1]); d0[2] = softplus_f(v0[2] + dtb[2]); d0[3] = softplus_f(v0[3] + dtb[3]);
                        f32x4 d1; d1[0] = softplus_f(v1[0] + dtb[4]); d1[1] = softplus_f(v1[1] + dtb[5]); d1[2] = 0.f; d1[3] = 0.f;
                        *(f32x4*)(dtf + (size_t)row * 8) = d0; *(f32x4*)(dtf + (size_t)row * 8 + 4) = d1;
                    }
                }
            }
    }
};
__device__ __forceinline__ void group_rstd(const float* yssq, int row, float& r_ssd, float& r_sb, float& r_mem) {
    const f32x4 a = *(const f32x4*)(yssq + (size_t)row * 16), b = *(const f32x4*)(yssq + (size_t)row * 16 + 4), c = *(const f32x4*)(yssq + (size_t)row * 16 + 8), d = *(const f32x4*)(yssq + (size_t)row * 16 + 12);
    const float s0 = (a[0] + a[1]) + (a[2] + a[3]) + (b[0] + b[1]), s1 = (b[2] + b[3]) + (c[0] + c[1]) + (c[2] + c[3]), s2 = (d[0] + d[1]) + (d[2] + d[3]);
    r_ssd = rsqrtf(s0 * (1.f / 384.f) + EPS); r_sb = rsqrtf(s1 * (1.f / 384.f) + EPS); r_mem = rsqrtf(s2 * (1.f / 256.f) + EPS);
}
struct EpiOut {
    static constexpr bool PERM = false, AFTER_DRAIN = false, KHOOK = true;
    const float* base; float* out; bf16_t* xb; float* xssq; const PG8_LAS float* gtab;
    __device__ __forceinline__ void khook(f32x4 (&acc)[2][2][4][2], const Unit& u, int t, int wr, int fr) const {
        if (t != 6 && t != 12) return;
#pragma unroll
        for (int ai = 0; ai < 2; ++ai)
#pragma unroll
            for (int m = 0; m < 4; ++m) {
                const float f = gtab[(t == 6 ? 0 : 256) + ai * HALF + wr * 64 + m * 16 + fr];
#pragma unroll
                for (int bj = 0; bj < 2; ++bj)
#pragma unroll
                    for (int n = 0; n < 2; ++n) acc[ai][bj][m][n] = acc[ai][bj][m][n] * f;
            }
    }
    __device__ __forceinline__ void operator()(const f32x4 (&acc)[2][2][4][2], const Unit& u, int wr, int wc, int fr, int fq) const {
        const int col0 = u.pn * BM + wc * 32 + 4 * fq;
#pragma unroll
        for (int ai = 0; ai < 2; ++ai)
#pragma unroll
            for (int m = 0; m < 4; ++m) {
                const int row = u.pm * BM + ai * HALF + wr * 64 + m * 16 + fr; const float r2 = gtab[512 + ai * HALF + wr * 64 + m * 16 + fr];
                float q = 0.f;
#pragma unroll
                for (int bj = 0; bj < 2; ++bj)
#pragma unroll
                    for (int n = 0; n < 2; ++n) {
                        const size_t off = (size_t)row * D + col0 + bj * HALF + n * 16;
                        const f32x4 x1 = *(const f32x4*)(base + off) + acc[ai][bj][m][n] * r2;
                        *(f32x4*)(out + off) = x1;
                        typedef unsigned u32x2v __attribute__((ext_vector_type(2)));
                        u32x2v w; w.x = cvt_pk_bf16(x1[0], x1[1]); w.y = cvt_pk_bf16(x1[2], x1[3]); *(u32x2v*)(xb + off) = w;
                        q += (x1[0] * x1[0] + x1[1] * x1[1]) + (x1[2] * x1[2] + x1[3] * x1[3]);
                    }
                q = swap16_add(q, q); q = swap32_add(q, q);
                if (fq == 0) xssq[(size_t)row * 16 + u.pn * 4 + wc] = q;
            }
    }
};
struct EpiScores {
    static constexpr bool PERM = false, AFTER_DRAIN = false, KHOOK = false;
    float* O; const float* xssq;
    __device__ __forceinline__ void operator()(const f32x4 (&acc)[2][2][4][2], const Unit& u, int wr, int wc, int fr, int fq) const {
        const int col0 = u.pn * BM + wc * 32 + 4 * fq;
#pragma unroll
        for (int ai = 0; ai < 2; ++ai)
#pragma unroll
            for (int m = 0; m < 4; ++m) {
                const int row = u.pm * BM + ai * HALF + wr * 64 + m * 16 + fr;
                const f32x4 a = *(const f32x4*)(xssq + (size_t)row * 16), b = *(const f32x4*)(xssq + (size_t)row * 16 + 4), c = *(const f32x4*)(xssq + (size_t)row * 16 + 8), d = *(const f32x4*)(xssq + (size_t)row * 16 + 12);
                const float ss = ((a[0] + a[1]) + (a[2] + a[3])) + ((b[0] + b[1]) + (b[2] + b[3])) + ((c[0] + c[1]) + (c[2] + c[3])) + ((d[0] + d[1]) + (d[2] + d[3]));
                const float r = rsqrtf(ss * (1.f / 1024.f) + EPS);
#pragma unroll
                for (int bj = 0; bj < 2; ++bj)
#pragma unroll
                    for (int n = 0; n < 2; ++n) *(f32x4*)(O + (size_t)row * 2048 + col0 + bj * HALF + n * 16) = acc[ai][bj][m][n] * r;
            }
    }
};
}

struct Args { const float* in[22]; float* out; unsigned char* ws; int ph_lo, ph_hi, li, pad; };
enum { I_X = 0, I_MEM, I_NORM1G, I_WIN, I_CONVW, I_CONVB, I_DTBIAS, I_ALOG, I_DSKIP, I_SSDG, I_SBG, I_MEMNG, I_WMEMKV, I_MQG, I_MKG, I_MEMOG, I_WOUT, I_NORM2G, I_WQ, I_KEYS, I_PU, I_PV };

__device__ __forceinline__ int opq(int i) { asm volatile("" : "+s"(i)); return i; }
#define AIN(i) (a.in[opq(i)])
__device__ __forceinline__ void transpose_item(const float* W, int ldw, int src_c0, int nvalid, const float* g, bf16* WT, int K, int dst_r0, int k0, LAS float* scr, int lane) {
    const int c = lane & 31;
#pragma unroll 8
    for (int i = 0; i < 32; ++i) {
        const int kk = 2 * i + (lane >> 5);
        float v = (c < nvalid) ? W[(size_t)(k0 + kk) * ldw + src_c0 + c] : 0.f;
        if (g) v *= g[k0 + kk];
        scr[kk * 33 + c] = v;
    }
    LDS_WAIT(); asm volatile("" ::: "memory");
    const int c8 = lane & 7;
#pragma unroll
    for (int j = 0; j < 4; ++j) {
        const int n = (lane >> 3) + 8 * j; const LAS float* s = scr + (8 * c8) * 33 + n;
        v4u o; o.x = pkbf(s[0 * 33], s[1 * 33]); o.y = pkbf(s[2 * 33], s[3 * 33]); o.z = pkbf(s[4 * 33], s[5 * 33]); o.w = pkbf(s[6 * 33], s[7 * 33]);
        *(GAS v4u*)(WT + (size_t)(dst_r0 + n) * K + k0 + 8 * c8) = o;
    }
    LDS_WAIT(); asm volatile("" ::: "memory");
}
__device__ __forceinline__ void wsc_item(const float* wq, const float* keys, const float* g2, bf16* WscT, int hc, int kb, int nq, LAS float* scr, int lane) {
    const int k0 = kb * 64;
#pragma unroll 8
    for (int kk = 0; kk < 64; ++kk) scr[kk * 64 + ((lane + kk) & 63)] = wq[(size_t)(k0 + kk) * D + hc * 64 + lane] * g2[k0 + kk];
    LDS_WAIT(); asm volatile("" ::: "memory");
    for (int n = nq * 32; n < nq * 32 + 32; ++n) {
        const float* kp = keys + ((size_t)hc * 128 + n) * 64;
        float a = 0.f;
#pragma unroll
        for (int d = 0; d < 64; ++d) a += scr[lane * 64 + ((d + lane) & 63)] * kp[d];
        WscT[(size_t)(hc * 128 + n) * D + k0 + lane] = (bf16)(pkbf(a, 0.f) & 0xffffu);
    }
    LDS_WAIT(); asm volatile("" ::: "memory");
}
__device__ __forceinline__ void row_to_bf16(const float* xrow, bf16* orow, float* rs, bool partials, int lane) {
    const GAS f32x4* xr = (const GAS f32x4*)xrow + lane;
    f32x4 v[4]; float s = 0.f;
#pragma unroll
    for (int j = 0; j < 4; ++j) { v[j] = xr[64 * j]; s += (v[j].x * v[j].x + v[j].y * v[j].y) + (v[j].z * v[j].z + v[j].w * v[j].w); }
    s = wave_sum(s);
    GAS unsigned long long* o8 = (GAS unsigned long long*)orow + lane;
#pragma unroll
    for (int j = 0; j < 4; ++j) o8[64 * j] = (unsigned long long)pkbf(v[j].x, v[j].y) | ((unsigned long long)pkbf(v[j].z, v[j].w) << 32);
    if (partials) { if (lane < 8) rs[lane] = lane == 0 ? s : 0.f; }
    else if (lane == 0) *rs = rsqrtf(s * (1.f / 1024.f) + EPS);
}
__device__ __forceinline__ void ph_prologue(const Args& a, unsigned char* ws, LAS unsigned char* lds, int gw, int NGW, int wave, int lane) {
    LAS float* scr = (LAS float*)(lds + wave * 16384);
    constexpr int I_IN = 80 * 16, I_MEMW = 16 * 16, I_OUT = 32 * 16, I_SC = 16 * 16 * 4, PER_L = I_IN + I_MEMW + I_OUT + I_SC;
    constexpr int NW_ITEMS = NL * PER_L, NITEMS = NW_ITEMS + T + MROWS;
    for (int it = gw; it < NITEMS; it += NGW) {
        if (it < NW_ITEMS) {
            const int l = it / PER_L; int r = it % PER_L;
            if (r < I_IN) {
                const int j = r / 16, kb = r % 16;
                const int src = (j < 32) ? 32 * j : (j < 76 ? 32 * j + 6 : 1024), nv = (j < 76) ? 32 : (j == 76 ? 6 : 0);
                transpose_item(AIN(I_WIN) + (size_t)l * D * DIN, DIN, src, nv, AIN(I_NORM1G) + l * D, (bf16*)(ws + WS_WIN) + (size_t)l * NPROJ * D, D, 32 * j, 64 * kb, scr, lane);
                continue;
            }
            r -= I_IN;
            if (r < I_MEMW) {
                const int j = r / 16, kb = r % 16;
                transpose_item(AIN(I_WMEMKV) + (size_t)l * D * 512, 512, 32 * j, 32, AIN(I_MEMNG) + l * D, (bf16*)(ws + WS_WMEM) + (size_t)l * 512 * D, D, 32 * j, 64 * kb, scr, lane);
                continue;
            }
            r -= I_MEMW;
            if (r < I_OUT) {
                const int j = r / 16, kb = r % 16;
                const float* g = (kb < 6) ? AIN(I_SSDG) + l * 384 : (kb < 12 ? AIN(I_SBG) + l * 384 - 384 : AIN(I_MEMOG) + l * 256 - 768);
                transpose_item(AIN(I_WOUT) + (size_t)l * D * D, D, 32 * j, 32, g, (bf16*)(ws + WS_WOUT) + (size_t)l * D * D, D, 32 * j, 64 * kb, scr, lane);
                continue;
            }
            r -= I_OUT;
            { const int nq = r & 3, kb = (r >> 2) & 15, hc = r >> 6;
              wsc_item(AIN(I_WQ) + (size_t)l * D * D, AIN(I_KEYS) + (size_t)l * 16 * 128 * 64, AIN(I_NORM2G) + l * D, (bf16*)(ws + WS_WSC) + (size_t)l * 2048 * D, hc, kb, nq, scr, lane); }
            continue;
        }
        int r = it - NW_ITEMS;
        if (r < T) { row_to_bf16(AIN(I_X) + (size_t)r * D, (bf16*)(ws + WS_XB) + (size_t)r * D, (float*)(ws + WS_RS1P) + (size_t)r * 8, true, lane); continue; }
        r -= T;
        row_to_bf16(AIN(I_MEM) + (size_t)r * D, (bf16*)(ws + WS_MEMB) + (size_t)r * D, (float*)(ws + WS_RSM) + r, false, lane);
    }
    for (int r0 = gw; r0 < 2 * NL * 16384; r0 += 4 * NGW) {
        f32x4 v[4][4];
#pragma unroll
        for (int q = 0; q < 4; ++q) {
            const int r = r0 + q * NGW; const int tb = r >> 15, e = r & 32767;
            const float* src = (tb == 0 ? AIN(I_PU) : AIN(I_PV)) + (size_t)e * D;
#pragma unroll
            for (int j = 0; j < 4; ++j) v[q][j] = *((const GAS f32x4*)src + 64 * j + lane);
        }
#pragma unroll
        for (int q = 0; q < 4; ++q) {
            const int r = r0 + q * NGW; const int tb = r >> 15, e = r & 32767;
            unsigned* dst = (unsigned*)(ws + (tb == 0 ? WS_UT : WS_VT) + (size_t)(e >> 14) * 16384 * D + (size_t)(e & 16383) * 128) + (lane & 31);
            const float* g = AIN(I_NORM2G) + (e >> 14) * D;
            float am = 0.f;
#pragma unroll
            for (int j = 0; j < 4; ++j) { if (tb == 0) v[q][j] = v[q][j] * *((const GAS f32x4*)g + 64 * j + lane);
                am = fmaxf(fmaxf(am, fmaxf(fabsf(v[q][j].x), fabsf(v[q][j].y))), fmaxf(fabsf(v[q][j].z), fabsf(v[q][j].w))); }
            am = wave_max(am);
            const float sc = am > 0.f ? 256.f / am : 1.f;
#pragma unroll
            for (int j = 0; j < 4; ++j) { int pk = 0; pk = __builtin_amdgcn_cvt_pk_fp8_f32(v[q][j].x * sc, v[q][j].y * sc, pk, false); pk = __builtin_amdgcn_cvt_pk_fp8_f32(v[q][j].z * sc, v[q][j].w * sc, pk, true); dst[(size_t)(2 * j + (lane >> 5)) * (16384 * 128 / 4)] = (unsigned)pk; }
            if (lane == 0) ((float*)(ws + (tb == 0 ? WS_USC : WS_VSC)))[e] = am > 0.f ? am * (1.f / 256.f) : 1.f;
        }
    }
}


typedef __attribute__((ext_vector_type(8))) __bf16 bf8_t;
typedef __attribute__((ext_vector_type(8))) float f32x8;
typedef __attribute__((ext_vector_type(8))) short s16x8;
typedef __attribute__((ext_vector_type(4))) short s16x4;
typedef __attribute__((ext_vector_type(16))) float f32x16;
typedef unsigned u32x2 __attribute__((ext_vector_type(2)));
#define MFMA32(a, b, c) __builtin_amdgcn_mfma_f32_32x32x16_bf16((a), (b), (c), 0, 0, 0)
__device__ __forceinline__ int crow(int i, int h) { return (i & 3) + 8 * (i >> 2) + 4 * h; }
__device__ __forceinline__ s16x8 cvt8(const f32x8 x) { return __builtin_bit_cast(s16x8, __builtin_convertvector(x, bf8_t)); }
__device__ __forceinline__ s16x8 pack_acc(const f32x16& x, int s) { f32x8 v;
#pragma unroll
    for (int j = 0; j < 8; ++j) v[j] = x[8 * s + j];
    return cvt8(v); }
__device__ __forceinline__ s16x8 cat4(const s16x4 lo, const s16x4 hi) { return __builtin_shufflevector(lo, hi, 0, 1, 2, 3, 4, 5, 6, 7); }
__device__ __forceinline__ f32x16 zero16() { f32x16 z;
#pragma unroll
    for (int i = 0; i < 16; ++i) z[i] = 0.f;
    return z; }
constexpr int L_BM = 0, L_CM = 18432, L_BMT = 36864, L_XDT = 54272, L_ACS = 106496, L_DT = 108032, L_TOT = 109568;

__device__ __forceinline__ void ssd_chunk_unit(const Args& a, unsigned char* ws, LAS unsigned char* lds, int l_, int unit, int tid, int wave, int lane) {
    const int g = unit & 1, c = (unit >> 1) & 31, b = unit >> 6, t0 = b * S + c * 128;
    const bf16* proj = (const bf16*)(ws + WS_PROJ); const float* dtf = (const float*)(ws + WS_DTF);
    LAS float* acs = (LAS float*)(lds + L_ACS); LAS float* dts = (LAS float*)(lds + L_DT); LAS float* tot = (LAS float*)(lds + L_TOT);
    float cs = 0.f, dtv = 0.f;
    if (wave < 6) {
        const int hh = wave >> 1, l = (wave & 1) * 64 + lane;
        dtv = dtf[(size_t)(t0 + l) * 8 + 3 * g + hh];
        cs = dtv * -expf(AIN(I_ALOG)[l_ * 6 + 3 * g + hh]);
#pragma unroll
        for (int o = 1; o < 64; o <<= 1) { const float t = bperm_f(cs, lane - o); if (lane >= o) cs += t; }
        if (lane == 63) tot[wave] = cs;
    }
    __syncthreads();
    if (wave < 6) {
        const int hh = wave >> 1, l = (wave & 1) * 64 + lane;
        if (wave & 1) cs += tot[wave - 1];
        acs[hh * 128 + l] = cs; dts[hh * 128 + l] = dtv;
        ((float*)(ws + WS_ACSG))[(size_t)(t0 + l) * 8 + 3 * g + hh] = cs;
    }
    __syncthreads();
    const float* cw = AIN(I_CONVW) + l_ * 4 * CONV_CH; const float* cb = AIN(I_CONVB) + l_ * CONV_CH;
#pragma unroll 2
    for (int it = 0; it < 10; ++it) {
        const int idx = tid + 512 * it, l = idx / 40, ck = idx % 40;
        int cc, kind, hh = 0, e0;
        if (ck < 24) { hh = ck >> 3; e0 = (ck & 7) * 8; cc = (3 * g + hh) * 64 + e0; kind = 0; }
        else if (ck < 32) { e0 = (ck - 24) * 8; cc = 384 + g * 64 + e0; kind = 1; }
        else { e0 = (ck - 32) * 8; cc = 512 + g * 64 + e0; kind = 2; }
        float acc[8];
        { const f32x4 b0 = *(const f32x4*)(cb + cc), b1 = *(const f32x4*)(cb + cc + 4); acc[0] = b0.x; acc[1] = b0.y; acc[2] = b0.z; acc[3] = b0.w; acc[4] = b1.x; acc[5] = b1.y; acc[6] = b1.z; acc[7] = b1.w; }
#pragma unroll
        for (int k = 0; k < 4; ++k) {
            const int sl = c * 128 + l - 3 + k;
            if (sl >= 0) {
                const v4u xv = *(const GAS v4u*)(proj + (size_t)(t0 + l - 3 + k) * NPROJ + PC_XBC + cc);
                const f32x4 w0 = *(const f32x4*)(cw + k * CONV_CH + cc), w1 = *(const f32x4*)(cw + k * CONV_CH + cc + 4);
                acc[0] += w0.x * __uint_as_float(xv.x << 16); acc[1] += w0.y * __uint_as_float(xv.x & 0xffff0000u);
                acc[2] += w0.z * __uint_as_float(xv.y << 16); acc[3] += w0.w * __uint_as_float(xv.y & 0xffff0000u);
                acc[4] += w1.x * __uint_as_float(xv.z << 16); acc[5] += w1.y * __uint_as_float(xv.z & 0xffff0000u);
                acc[6] += w1.z * __uint_as_float(xv.w << 16); acc[7] += w1.w * __uint_as_float(xv.w & 0xffff0000u);
            }
        }
#pragma unroll
        for (int e = 0; e < 8; ++e) acc[e] = silu_f(acc[e]);
        v4u pk; pk.x = pkbf(acc[0], acc[1]); pk.y = pkbf(acc[2], acc[3]); pk.z = pkbf(acc[4], acc[5]); pk.w = pkbf(acc[6], acc[7]);
        if (kind == 0) {
            *(GAS v4u*)((bf16*)(ws + WS_XCONV) + (size_t)(t0 + l) * 384 + (3 * g + hh) * 64 + e0) = pk;
            const float d = dts[hh * 128 + l];
            LAS bf16* xd = (LAS bf16*)(lds + L_XDT) + (hh * 64 + e0) * 136 + l;
#pragma unroll
            for (int e = 0; e < 8; e += 2) { const unsigned w = pkbf(acc[e] * d, acc[e + 1] * d); xd[e * 136] = (bf16)(w & 0xffffu); xd[(e + 1) * 136] = (bf16)(w >> 16); }
        } else if (kind == 1) {
            *(LAS v4u*)(lds + L_BM + (l * 72 + e0) * 2) = pk;
            LAS bf16* bt = (LAS bf16*)(lds + L_BMT) + e0 * 136 + l;
            bt[0 * 136] = (bf16)(pk.x & 0xffffu); bt[1 * 136] = (bf16)(pk.x >> 16); bt[2 * 136] = (bf16)(pk.y & 0xffffu); bt[3 * 136] = (bf16)(pk.y >> 16);
            bt[4 * 136] = (bf16)(pk.z & 0xffffu); bt[5 * 136] = (bf16)(pk.z >> 16); bt[6 * 136] = (bf16)(pk.w & 0xffffu); bt[7 * 136] = (bf16)(pk.w >> 16);
        } else {
            *(LAS v4u*)(lds + L_CM + (l * 72 + e0) * 2) = pk;
            *(GAS v4u*)((bf16*)(ws + WS_CMG) + (size_t)(t0 + l) * 128 + g * 64 + e0) = pk;
        }
    }
    __syncthreads();
    const int r = lane & 31, h = lane >> 5, lb = wave & 3, pt = wave >> 2;
    {
        s16x8 cf[4];
#pragma unroll
        for (int ks = 0; ks < 4; ++ks) cf[ks] = *(const LAS s16x8*)(lds + L_CM + ((lb * 32 + r) * 72 + ks * 16 + 8 * h) * 2);
        f32x16 gt[4];
#pragma unroll
        for (int sb = 0; sb < 4; ++sb) {
            gt[sb] = zero16();
            if (sb <= lb) {
#pragma unroll
                for (int ks = 0; ks < 4; ++ks) gt[sb] = MFMA32(*(const LAS s16x8*)(lds + L_BM + ((sb * 32 + r) * 72 + ks * 16 + 8 * h) * 2), cf[ks], gt[sb]);
            }
        }
#pragma unroll
        for (int hh = 0; hh < 3; ++hh) {
            const float al = acs[hh * 128 + lb * 32 + r];
            f32x16 yacc = zero16();
#pragma unroll
            for (int sb = 0; sb < 4; ++sb) {
                if (sb <= lb) {
                    f32x16 m;
#pragma unroll
                    for (int i = 0; i < 16; ++i) {
                        const int sl = crow(i, h);
                        const float v = gt[sb][i] * __expf(al - acs[hh * 128 + sb * 32 + sl]);
                        m[i] = (sb < lb || sl <= r) ? v : 0.f;
                    }
#pragma unroll
                    for (int ks = 0; ks < 2; ++ks) {
                        const LAS unsigned char* xp = lds + L_XDT + ((hh * 64 + pt * 32 + r) * 136 + sb * 32 + 16 * ks + 4 * h) * 2;
                        yacc = MFMA32(cat4(*(const LAS s16x4*)xp, *(const LAS s16x4*)(xp + 16)), pack_acc(m, ks), yacc);
                    }
                }
            }
            float* yp = (float*)(ws + WS_YPART) + (size_t)(t0 + lb * 32 + r) * 384 + (3 * g + hh) * 64 + pt * 32 + 4 * h;
#pragma unroll
            for (int i4 = 0; i4 < 4; ++i4) *(f32x4*)(yp + 8 * i4) = (f32x4){yacc[4 * i4], yacc[4 * i4 + 1], yacc[4 * i4 + 2], yacc[4 * i4 + 3]};
        }
    }
    for (int tl = wave; tl < 12; tl += 8) {
        const int hh = tl >> 2, nt = (tl >> 1) & 1, pt2 = tl & 1;
        const float alast = acs[hh * 128 + 127];
        f32x16 acc = zero16();
#pragma unroll
        for (int ks = 0; ks < 8; ++ks) {
            const s16x8 af = *(const LAS s16x8*)(lds + L_BMT + ((nt * 32 + r) * 136 + ks * 16 + 8 * h) * 2);
            const v4u xr = *(const LAS v4u*)(lds + L_XDT + ((hh * 64 + pt2 * 32 + r) * 136 + ks * 16 + 8 * h) * 2);
            const LAS float* ap = acs + hh * 128 + ks * 16 + 8 * h;
            f32x8 xf;
            xf[0] = __uint_as_float(xr.x << 16) * __expf(alast - ap[0]); xf[1] = __uint_as_float(xr.x & 0xffff0000u) * __expf(alast - ap[1]);
            xf[2] = __uint_as_float(xr.y << 16) * __expf(alast - ap[2]); xf[3] = __uint_as_float(xr.y & 0xffff0000u) * __expf(alast - ap[3]);
            xf[4] = __uint_as_float(xr.z << 16) * __expf(alast - ap[4]); xf[5] = __uint_as_float(xr.z & 0xffff0000u) * __expf(alast - ap[5]);
            xf[6] = __uint_as_float(xr.w << 16) * __expf(alast - ap[6]); xf[7] = __uint_as_float(xr.w & 0xffff0000u) * __expf(alast - ap[7]);
            acc = MFMA32(af, cvt8(xf), acc);
        }
        float* hp = (float*)(ws + WS_HS) + ((size_t)((b * 32 + c) * 6 + 3 * g + hh) * 64 + pt2 * 32 + r) * 64 + nt * 32 + 4 * h;
#pragma unroll
        for (int i4 = 0; i4 < 4; ++i4) *(f32x4*)(hp + 8 * i4) = (f32x4){acc[4 * i4], acc[4 * i4 + 1], acc[4 * i4 + 2], acc[4 * i4 + 3]};
    }
    if (tid < 3) ((float*)(ws + WS_CD))[(b * 32 + c) * 6 + 3 * g + tid] = __expf(acs[tid * 128 + 127]);
    __syncthreads();
}
__device__ __forceinline__ void ph_ssd_scan(unsigned char* ws, int bx, int G, int tid) {
    float* hs = (float*)(ws + WS_HS); const float* cd = (const float*)(ws + WS_CD);
    for (int e = bx * 512 + tid; e < 24 * 4096; e += G * 512) {
        const int bh = e >> 12, el = e & 4095, b = bh / 6, hh = bh % 6;
        float run = 0.f;
#pragma unroll 4
        for (int c = 0; c < 32; ++c) {
            const int idx = (b * 32 + c) * 6 + hh;
            const float v = hs[(size_t)idx * 4096 + el], d = cd[idx];
            hs[(size_t)idx * 4096 + el] = run; run = run * d + v;
        }
    }
}
__device__ __forceinline__ void ssd_finish_unit(const Args& a, unsigned char* ws, int l_, int unit, int wave, int lane) {
    const int g = unit & 1, c = (unit >> 1) & 31, b = unit >> 6, t0 = b * S + c * 128;
    const int r = lane & 31, h = lane >> 5, lb = wave & 3, hsel = wave >> 2;
    const int t = t0 + lb * 32 + r;
    const bf16* proj = (const bf16*)(ws + WS_PROJ); const bf16* cmg = (const bf16*)(ws + WS_CMG) + (size_t)t * 128 + g * 64;
    s16x8 cf[4];
#pragma unroll
    for (int ks = 0; ks < 4; ++ks) cf[ks] = *(const GAS s16x8*)(cmg + ks * 16 + 8 * h);
    for (int hh = hsel ? 2 : 0; hh < (hsel ? 3 : 2); ++hh) {
        const int hd = 3 * g + hh;
        const float* hin = (const float*)(ws + WS_HS) + (size_t)((b * 32 + c) * 6 + hd) * 4096;
        const float ea = __expf(((const float*)(ws + WS_ACSG))[(size_t)t * 8 + hd]), dsk = AIN(I_DSKIP)[l_ * 6 + hd];
        float ssq = 0.f;
#pragma unroll
        for (int pt = 0; pt < 2; ++pt) {
            f32x16 acc = zero16();
#pragma unroll
            for (int ks = 0; ks < 4; ++ks) {
                const float* hp = hin + (pt * 32 + r) * 64 + ks * 16 + 8 * h;
                const f32x4 h0 = *(const GAS f32x4*)hp, h1 = *(const GAS f32x4*)(hp + 4);
                acc = MFMA32(cvt8((f32x8){h0.x, h0.y, h0.z, h0.w, h1.x, h1.y, h1.z, h1.w}), cf[ks], acc);
            }
#pragma unroll
            for (int i4 = 0; i4 < 4; ++i4) {
                const int col = hd * 64 + pt * 32 + 8 * i4 + 4 * h;
                const f32x4 yp = *(const GAS f32x4*)((const float*)(ws + WS_YPART) + (size_t)t * 384 + col);
                const u32x2 xc = *(const GAS u32x2*)((const bf16*)(ws + WS_XCONV) + (size_t)t * 384 + col);
                const u32x2 zz = *(const GAS u32x2*)(proj + (size_t)t * NPROJ + PC_Z + col);
                const float y0 = (yp.x + acc[4 * i4 + 0] * ea + dsk * __uint_as_float(xc.x << 16)) * silu_f(__uint_as_float(zz.x << 16));
                const float y1 = (yp.y + acc[4 * i4 + 1] * ea + dsk * __uint_as_float(xc.x & 0xffff0000u)) * silu_f(__uint_as_float(zz.x & 0xffff0000u));
                const float y2 = (yp.z + acc[4 * i4 + 2] * ea + dsk * __uint_as_float(xc.y << 16)) * silu_f(__uint_as_float(zz.y << 16));
                const float y3 = (yp.w + acc[4 * i4 + 3] * ea + dsk * __uint_as_float(xc.y & 0xffff0000u)) * silu_f(__uint_as_float(zz.y & 0xffff0000u));
                ssq += (y0 * y0 + y1 * y1) + (y2 * y2 + y3 * y3);
                u32x2 w; w.x = pkbf(y0, y1); w.y = pkbf(y2, y3);
                *(GAS u32x2*)((bf16*)(ws + WS_YCAT) + (size_t)t * D + col) = w;
            }
        }
        ssq = swap32_add(ssq, ssq);
        if (h == 0) ((float*)(ws + WS_YSSQ))[(size_t)t * 16 + hd] = ssq;
    }
}

#define LOG2E 1.4426950408889634f
__device__ __forceinline__ s16x8 trv_frag(const LAS unsigned char* vimg, int key0, int ks, int dt, int lane) {
    const int h = lane >> 5, i16 = lane & 15, blk = (lane >> 4) & 1;
    const LAS unsigned char* p = vimg + (key0 + 16 * ks + 4 * h + (i16 >> 2)) * 144 + (dt * 32 + 16 * blk) * 2 + 8 * (i16 & 3);
    const s16x4 lo = __builtin_amdgcn_ds_read_tr16_b64_v4i16((LAS s16x4*)p), hi = __builtin_amdgcn_ds_read_tr16_b64_v4i16((LAS s16x4*)(p + 8 * 144));
    return cat4(lo, hi);
}
__device__ __forceinline__ void mem_unit(const Args& a, unsigned char* ws, LAS unsigned char* lds, int l_, int b, int hd, int qb, int tid, int wave, int lane) {
    const bf16* proj = (const bf16*)(ws + WS_PROJ); const bf16* memkv = (const bf16*)(ws + WS_MEMKV);
    const float* qg = AIN(I_MQG) + l_ * 64; const float* kg = AIN(I_MKG) + l_ * 64;
    LAS unsigned char* kimg = lds; LAS unsigned char* vimg = lds + 36864;
#pragma unroll
    for (int it = 0; it < 4; ++it) {
        const int idx = tid + 512 * it, m = idx >> 3, ch = idx & 7;
        const v4u kv = *(const GAS v4u*)(memkv + (size_t)(b * NMEM + m) * 512 + hd * 64 + ch * 8);
        const v4u vv = *(const GAS v4u*)(memkv + (size_t)(b * NMEM + m) * 512 + 256 + hd * 64 + ch * 8);
        float kf[8] = {__uint_as_float(kv.x << 16), __uint_as_float(kv.x & 0xffff0000u), __uint_as_float(kv.y << 16), __uint_as_float(kv.y & 0xffff0000u),
                       __uint_as_float(kv.z << 16), __uint_as_float(kv.z & 0xffff0000u), __uint_as_float(kv.w << 16), __uint_as_float(kv.w & 0xffff0000u)};
        float ss = 0.f;
#pragma unroll
        for (int e = 0; e < 8; ++e) ss += kf[e] * kf[e];
        ss = sum8(ss);
        const float rk = rsqrtf(ss * (1.f / 64.f) + EPS);
        const f32x4 g0 = *(const f32x4*)(kg + ch * 8), g1 = *(const f32x4*)(kg + ch * 8 + 4);
        v4u pk; pk.x = pkbf(kf[0] * rk * g0.x, kf[1] * rk * g0.y); pk.y = pkbf(kf[2] * rk * g0.z, kf[3] * rk * g0.w); pk.z = pkbf(kf[4] * rk * g1.x, kf[5] * rk * g1.y); pk.w = pkbf(kf[6] * rk * g1.z, kf[7] * rk * g1.w);
        *(LAS v4u*)(kimg + (m * 72 + ch * 8) * 2) = pk;
        *(LAS v4u*)(vimg + (m * 72 + ch * 8) * 2) = vv;
    }
    __syncthreads();
    const int r = lane & 31, h = lane >> 5;
    const int t = b * S + qb * 256 + wave * 32 + r;
    s16x8 qf[4];
    {
        f32x8 qv[4]; float ss = 0.f;
#pragma unroll
        for (int ks = 0; ks < 4; ++ks) {
            const v4u q = *(const GAS v4u*)(proj + (size_t)t * NPROJ + PC_QMEM + hd * 64 + ks * 16 + 8 * h);
            qv[ks] = (f32x8){__uint_as_float(q.x << 16), __uint_as_float(q.x & 0xffff0000u), __uint_as_float(q.y << 16), __uint_as_float(q.y & 0xffff0000u),
                             __uint_as_float(q.z << 16), __uint_as_float(q.z & 0xffff0000u), __uint_as_float(q.w << 16), __uint_as_float(q.w & 0xffff0000u)};
#pragma unroll
            for (int e = 0; e < 8; ++e) ss += qv[ks][e] * qv[ks][e];
        }
        ss = swap32_add(ss, ss);
        const float rq = rsqrtf(ss * (1.f / 64.f) + EPS) * (0.125f * LOG2E);
#pragma unroll
        for (int ks = 0; ks < 4; ++ks) {
            const f32x4 g0 = *(const f32x4*)(qg + ks * 16 + 8 * h), g1 = *(const f32x4*)(qg + ks * 16 + 8 * h + 4);
            qf[ks] = cvt8(qv[ks] * rq * (f32x8){g0.x, g0.y, g0.z, g0.w, g1.x, g1.y, g1.z, g1.w});
        }
    }
    f32x16 st[8];
    float mx = -INFINITY;
#pragma unroll
    for (int kt = 0; kt < 8; ++kt) {
        st[kt] = zero16();
#pragma unroll
        for (int ks = 0; ks < 4; ++ks) st[kt] = MFMA32(*(const LAS s16x8*)(kimg + ((kt * 32 + r) * 72 + ks * 16 + 8 * h) * 2), qf[ks], st[kt]);
#pragma unroll
        for (int i = 0; i < 16; ++i) mx = fmaxf(mx, st[kt][i]);
    }
    mx = swap32_max(mx);
    float lsum = 0.f;
    f32x16 o0 = zero16(), o1 = zero16();
#pragma unroll
    for (int kt = 0; kt < 8; ++kt) {
#pragma unroll
        for (int i = 0; i < 16; ++i) { st[kt][i] = __builtin_amdgcn_exp2f(st[kt][i] - mx); lsum += st[kt][i]; }
#pragma unroll
        for (int ks = 0; ks < 2; ++ks) {
            const s16x8 pf = pack_acc(st[kt], ks);
            o0 = MFMA32(trv_frag(vimg, kt * 32, ks, 0, lane), pf, o0);
            o1 = MFMA32(trv_frag(vimg, kt * 32, ks, 1, lane), pf, o1);
        }
    }
    lsum = swap32_add(lsum, lsum);
    const float il = 1.f / lsum; float ssq = 0.f;
    bf16* yc = (bf16*)(ws + WS_YCAT) + (size_t)t * D + 768 + hd * 64 + 4 * h;
#pragma unroll
    for (int i4 = 0; i4 < 4; ++i4) {
        const float a0 = o0[4 * i4] * il, a1 = o0[4 * i4 + 1] * il, a2 = o0[4 * i4 + 2] * il, a3 = o0[4 * i4 + 3] * il;
        const float b0 = o1[4 * i4] * il, b1 = o1[4 * i4 + 1] * il, b2 = o1[4 * i4 + 2] * il, b3 = o1[4 * i4 + 3] * il;
        ssq += (a0 * a0 + a1 * a1) + (a2 * a2 + a3 * a3) + (b0 * b0 + b1 * b1) + (b2 * b2 + b3 * b3);
        u32x2 w; w.x = pkbf(a0, a1); w.y = pkbf(a2, a3); *(GAS u32x2*)(yc + 8 * i4) = w;
        w.x = pkbf(b0, b1); w.y = pkbf(b2, b3); *(GAS u32x2*)(yc + 32 + 8 * i4) = w;
    }
    ssq = swap32_add(ssq, ssq);
    if (h == 0) ((float*)(ws + WS_YSSQ))[(size_t)t * 16 + 12 + hd] = ssq;
    __syncthreads();
}
__device__ __forceinline__ void sb_unit(unsigned char* ws, LAS unsigned char* lds, int b, int hd, int qb, int tid, int wave, int lane) {
    const bf16* proj = (const bf16*)(ws + WS_PROJ);
    const int r = lane & 31, h = lane >> 5;
    const int q0w = qb * 256 + wave * 32, t = b * S + q0w + r;
    s16x8 qf[4];
#pragma unroll
    for (int ks = 0; ks < 4; ++ks) {
        const v4u q = *(const GAS v4u*)(proj + (size_t)t * NPROJ + PC_QSB + hd * 64 + ks * 16 + 8 * h);
        const f32x8 qv = (f32x8){__uint_as_float(q.x << 16), __uint_as_float(q.x & 0xffff0000u), __uint_as_float(q.y << 16), __uint_as_float(q.y & 0xffff0000u),
                                 __uint_as_float(q.z << 16), __uint_as_float(q.z & 0xffff0000u), __uint_as_float(q.w << 16), __uint_as_float(q.w & 0xffff0000u)};
        qf[ks] = cvt8(qv * (0.125f * LOG2E));
    }
    const int srow = tid >> 3, sch = tid & 7;
    const bf16* kbase = proj + (size_t)(b * S) * NPROJ + PC_KSB + hd * 64 + sch * 8;
    const int ktop = qb * 4 + 3;
    v4u kr = *(const GAS v4u*)(kbase + (size_t)(ktop * 64 + srow) * NPROJ), vr = *(const GAS v4u*)(kbase + (size_t)(ktop * 64 + srow) * NPROJ + (PC_VSB - PC_KSB));
    *(LAS v4u*)(lds + (srow * 72 + sch * 8) * 2) = kr; *(LAS v4u*)(lds + 9216 + (srow * 72 + sch * 8) * 2) = vr;
    __syncthreads();
    f32x16 o0 = zero16(), o1 = zero16();
    float R = 0.f;
    volatile LAS unsigned* live = (volatile LAS unsigned*)(lds + 36864);
    bool mylive = true;
    for (int kt = ktop; kt >= 0; --kt) {
        LAS unsigned char* kimg = lds + ((ktop - kt) & 1) * 18432; LAS unsigned char* vimg = kimg + 9216;
        if (kt > 0) { kr = *(const GAS v4u*)(kbase + (size_t)((kt - 1) * 64 + srow) * NPROJ); vr = *(const GAS v4u*)(kbase + (size_t)((kt - 1) * 64 + srow) * NPROJ + (PC_VSB - PC_KSB)); }
#pragma unroll
        for (int sub = 1; sub >= 0; --sub) {
            const int kb = kt * 64 + sub * 32;
            if (kb <= q0w && mylive) {
                const bool diag = (kb == q0w);
                f32x16 z = zero16();
#pragma unroll
                for (int ks = 0; ks < 4; ++ks) z = MFMA32(*(const LAS s16x8*)(kimg + ((sub * 32 + r) * 72 + ks * 16 + 8 * h) * 2), qf[ks], z);
                float lk[16];
#pragma unroll
                for (int i = 0; i < 16; ++i) {
                    const float sp = fmaxf(z[i], 0.f) + __builtin_amdgcn_logf(1.f + __builtin_amdgcn_exp2f(-fabsf(z[i])));
                    const bool ok = !diag || (crow(i, h) < r);
                    lk[i] = ok ? -sp : 0.f;
                    z[i] = ok ? z[i] : -INFINITY;
                }
                float g[4], pg[4];
#pragma unroll
                for (int j = 0; j < 4; ++j) { g[j] = (lk[4 * j] + lk[4 * j + 1]) + (lk[4 * j + 2] + lk[4 * j + 3]); pg[j] = partner32(g[j], h != 0); }
                float ab[4];
                ab[3] = R + (h == 0 ? pg[3] : 0.f);
#pragma unroll
                for (int j = 2; j >= 0; --j) ab[j] = ab[j + 1] + g[j + 1] + (h == 0 ? pg[j] : pg[j + 1]);
#pragma unroll
                for (int j = 0; j < 4; ++j) {
                    const float s3 = ab[j], s2 = s3 + lk[4 * j + 3], s1 = s2 + lk[4 * j + 2], s0 = s1 + lk[4 * j + 1];
                    z[4 * j + 3] = __builtin_amdgcn_exp2f(z[4 * j + 3] + lk[4 * j + 3] + s3);
                    z[4 * j + 2] = __builtin_amdgcn_exp2f(z[4 * j + 2] + lk[4 * j + 2] + s2);
                    z[4 * j + 1] = __builtin_amdgcn_exp2f(z[4 * j + 1] + lk[4 * j + 1] + s1);
                    z[4 * j + 0] = __builtin_amdgcn_exp2f(z[4 * j + 0] + lk[4 * j + 0] + s0);
                }
                R = ab[0] + g[0] + (h == 0 ? 0.f : pg[0]);
#pragma unroll
                for (int ks = 0; ks < 2; ++ks) {
                    const s16x8 pf = pack_acc(z, ks);
                    o0 = MFMA32(trv_frag(vimg, sub * 32, ks, 0, lane), pf, o0);
                    o1 = MFMA32(trv_frag(vimg, sub * 32, ks, 1, lane), pf, o1);
                }
            }
        }
        if (kt > 0) { LAS unsigned char* nimg = lds + ((ktop - kt + 1) & 1) * 18432; *(LAS v4u*)(nimg + (srow * 72 + sch * 8) * 2) = kr; *(LAS v4u*)(nimg + 9216 + (srow * 72 + sch * 8) * 2) = vr; }
        mylive = mylive && (__builtin_amdgcn_ballot_w64(R >= -150.f) != 0ull);
        if (lane == 0) live[((ktop - kt) & 1) * 8 + wave] = mylive ? 1u : 0u;
        __syncthreads();
        { unsigned any = 0u;
#pragma unroll
          for (int w = 0; w < 8; ++w) any |= live[((ktop - kt) & 1) * 8 + w];
          if (any == 0u) break; }
    }
    float ssq = 0.f;
    bf16* yc = (bf16*)(ws + WS_YCAT) + (size_t)t * D + 384 + hd * 64 + 4 * h;
#pragma unroll
    for (int i4 = 0; i4 < 4; ++i4) {
        const float a0 = o0[4 * i4], a1 = o0[4 * i4 + 1], a2 = o0[4 * i4 + 2], a3 = o0[4 * i4 + 3];
        const float b0 = o1[4 * i4], b1 = o1[4 * i4 + 1], b2 = o1[4 * i4 + 2], b3 = o1[4 * i4 + 3];
        ssq += (a0 * a0 + a1 * a1) + (a2 * a2 + a3 * a3) + (b0 * b0 + b1 * b1) + (b2 * b2 + b3 * b3);
        u32x2 w; w.x = pkbf(a0, a1); w.y = pkbf(a2, a3); *(GAS u32x2*)(yc + 8 * i4) = w;
        w.x = pkbf(b0, b1); w.y = pkbf(b2, b3); *(GAS u32x2*)(yc + 32 + 8 * i4) = w;
    }
    ssq = swap32_add(ssq, ssq);
    if (h == 0) ((float*)(ws + WS_YSSQ))[(size_t)t * 16 + 6 + hd] = ssq;
}
constexpr int CW_Q = 8192;
__device__ __forceinline__ void ph_mix(const Args& a, unsigned char* ws, LAS unsigned char* lds, int l, int qoff, int tid, int wave, int lane) {
    unsigned* head = (unsigned*)(ws + WS_CTL) + CW_Q + 64 * l + qoff;
    volatile LAS unsigned* slot = (volatile LAS unsigned*)(lds + MISC_OFF);
    for (int it = 0;; ++it) {
        if (tid == 0) slot[it & 1] = __hip_atomic_fetch_add(head, 1u, __ATOMIC_RELAXED, __HIP_MEMORY_SCOPE_AGENT);
        __syncthreads();
        const int n = (int)slot[it & 1];
        if (n >= 896) break;
        asm volatile("" : "+s"(ws), "+v"(tid));
        lane = tid & 63; wave = __builtin_amdgcn_readfirstlane(tid >> 6);
        if (n < 384) { const int qb = 15 - n / 24, bh = n % 24; sb_unit(ws, lds, bh / 6, bh % 6, qb, tid, wave, lane); }
        else if (n < 640) { const int m = n - 384; mem_unit(a, ws, lds, l, m >> 6, (m >> 4) & 3, m & 15, tid, wave, lane); }
        else ssd_chunk_unit(a, ws, lds, l, n - 640, tid, wave, lane);
    }
}

__device__ __forceinline__ unsigned f2o(float f) { const unsigned b = __float_as_uint(f); return b ^ ((unsigned)((int)b >> 31) | 0x80000000u); }
__device__ __forceinline__ float o2f(unsigned k) { return __uint_as_float(k ^ ((k & 0x80000000u) ? 0x80000000u : 0xffffffffu)); }
#define TK_CE(a, b) do { const unsigned _mx = (a) > (b) ? (a) : (b), _mn = (a) > (b) ? (b) : (a); (a) = _mx; (b) = _mn; } while (0)
template <int N, int BASE> __device__ __forceinline__ void tk_sort16(unsigned (&k)[N]) {
#pragma unroll
    for (int sz = 2; sz <= 16; sz <<= 1)
#pragma unroll
        for (int j = sz >> 1; j > 0; j >>= 1)
#pragma unroll
            for (int i = 0; i < 16; ++i) { const int l = i ^ j; if (l > i) { if ((i & sz) == 0) TK_CE(k[BASE + i], k[BASE + l]); else TK_CE(k[BASE + l], k[BASE + i]); } }
}
template <int NA, int A, int NB_, int B> __device__ __forceinline__ void tk_merge16(unsigned (&ka)[NA], const unsigned (&kb)[NB_]) {
#pragma unroll
    for (int i = 0; i < 16; ++i) ka[A + i] = ka[A + i] > kb[B + 15 - i] ? ka[A + i] : kb[B + 15 - i];
#pragma unroll
    for (int j = 8; j > 0; j >>= 1)
#pragma unroll
        for (int i = 0; i < 16; ++i) { const int l = i ^ j; if (l > i) TK_CE(ka[A + i], ka[A + l]); }
}
__device__ __forceinline__ void ph_topk(unsigned char* ws, LAS unsigned char* lds, int gw, int NGW, int wave, int lane) {
    const float* scores = (const float*)(ws + WS_SCORES); int* eidx = (int*)(ws + WS_EIDX); float* gate = (float*)(ws + WS_GATE);
    LAS float* tr = (LAS float*)(lds + wave * WSCR);
    for (int b = gw; b < T * 8 / 64; b += NGW) {
        const float* sb = scores + (size_t)b * 64 * 256;
        unsigned top[2][16];
#pragma unroll
        for (int c = 0; c < 2; ++c) {
#pragma unroll
            for (int half = 0; half < 2; ++half) {
#pragma unroll 4
                for (int i = 0; i < 16; ++i) {
                    const int pp = 4 * i + (lane >> 4), vq = (lane & 15) * 4;
                    const f32x4 x = *(const GAS f32x4*)(sb + pp * 256 + c * 128 + half * 64 + vq);
                    LAS float* r = tr + pp * 65 + vq;
                    r[0] = x.x; r[1] = x.y; r[2] = x.z; r[3] = x.w;
                }
                asm volatile("s_waitcnt lgkmcnt(0)" ::: "memory");
                unsigned k[64];
#pragma unroll
                for (int v = 0; v < 64; ++v) k[v] = (f2o(tr[lane * 65 + v]) & ~127u) | (unsigned)(127 - (half * 64 + v));
                asm volatile("s_waitcnt lgkmcnt(0)" ::: "memory");
                tk_sort16<64, 0>(k); tk_sort16<64, 16>(k); tk_sort16<64, 32>(k); tk_sort16<64, 48>(k);
                tk_merge16<64, 0, 64, 16>(k, k); tk_merge16<64, 32, 64, 48>(k, k); tk_merge16<64, 0, 64, 32>(k, k);
                if (half == 0) {
#pragma unroll
                    for (int i = 0; i < 16; ++i) top[c][i] = k[i];
                } else tk_merge16<16, 0, 64, 0>(top[c], k);
            }
        }
        float av[16], bv[16];
#pragma unroll
        for (int i = 0; i < 16; ++i) { av[i] = o2f(top[0][i] & ~127u); bv[i] = o2f(top[1][i] & ~127u); }
        LAS int* li = (LAS int*)tr + lane * 32;
#pragma unroll
        for (int i = 0; i < 16; ++i) { li[i] = 127 - (int)(top[0][i] & 127u); li[16 + i] = 127 - (int)(top[1][i] & 127u); }
        unsigned key[64];
        key[0] = (f2o(av[0] + bv[0]) & ~255u) | 255u;
        key[1] = (f2o(av[0] + bv[1]) & ~255u) | 254u;
        key[2] = (f2o(av[0] + bv[2]) & ~255u) | 253u;
        key[3] = (f2o(av[0] + bv[3]) & ~255u) | 252u;
        key[4] = (f2o(av[0] + bv[4]) & ~255u) | 251u;
        key[5] = (f2o(av[0] + bv[5]) & ~255u) | 250u;
        key[6] = (f2o(av[0] + bv[6]) & ~255u) | 249u;
        key[7] = (f2o(av[0] + bv[7]) & ~255u) | 248u;
        key[8] = (f2o(av[0] + bv[8]) & ~255u) | 247u;
        key[9] = (f2o(av[0] + bv[9]) & ~255u) | 246u;
        key[10] = (f2o(av[0] + bv[10]) & ~255u) | 245u;
        key[11] = (f2o(av[0] + bv[11]) & ~255u) | 244u;
        key[12] = (f2o(av[0] + bv[12]) & ~255u) | 243u;
        key[13] = (f2o(av[0] + bv[13]) & ~255u) | 242u;
        key[14] = (f2o(av[0] + bv[14]) & ~255u) | 241u;
        key[15] = (f2o(av[0] + bv[15]) & ~255u) | 240u;
        key[16] = (f2o(av[1] + bv[0]) & ~255u) | 239u;
        key[17] = (f2o(av[1] + bv[1]) & ~255u) | 238u;
        key[18] = (f2o(av[1] + bv[2]) & ~255u) | 237u;
        key[19] = (f2o(av[1] + bv[3]) & ~255u) | 236u;
        key[20] = (f2o(av[1] + bv[4]) & ~255u) | 235u;
        key[21] = (f2o(av[1] + bv[5]) & ~255u) | 234u;
        key[22] = (f2o(av[1] + bv[6]) & ~255u) | 233u;
        key[23] = (f2o(av[1] + bv[7]) & ~255u) | 232u;
        key[24] = (f2o(av[2] + bv[0]) & ~255u) | 223u;
        key[25] = (f2o(av[2] + bv[1]) & ~255u) | 222u;
        key[26] = (f2o(av[2] + bv[2]) & ~255u) | 221u;
        key[27] = (f2o(av[2] + bv[3]) & ~255u) | 220u;
        key[28] = (f2o(av[2] + bv[4]) & ~255u) | 219u;
        key[29] = (f2o(av[3] + bv[0]) & ~255u) | 207u;
        key[30] = (f2o(av[3] + bv[1]) & ~255u) | 206u;
        key[31] = (f2o(av[3] + bv[2]) & ~255u) | 205u;
        key[32] = (f2o(av[3] + bv[3]) & ~255u) | 204u;
        key[33] = (f2o(av[4] + bv[0]) & ~255u) | 191u;
        key[34] = (f2o(av[4] + bv[1]) & ~255u) | 190u;
        key[35] = (f2o(av[4] + bv[2]) & ~255u) | 189u;
        key[36] = (f2o(av[5] + bv[0]) & ~255u) | 175u;
        key[37] = (f2o(av[5] + bv[1]) & ~255u) | 174u;
        key[38] = (f2o(av[6] + bv[0]) & ~255u) | 159u;
        key[39] = (f2o(av[6] + bv[1]) & ~255u) | 158u;
        key[40] = (f2o(av[7] + bv[0]) & ~255u) | 143u;
        key[41] = (f2o(av[7] + bv[1]) & ~255u) | 142u;
        key[42] = (f2o(av[8] + bv[0]) & ~255u) | 127u;
        key[43] = (f2o(av[9] + bv[0]) & ~255u) | 111u;
        key[44] = (f2o(av[10] + bv[0]) & ~255u) | 95u;
        key[45] = (f2o(av[11] + bv[0]) & ~255u) | 79u;
        key[46] = (f2o(av[12] + bv[0]) & ~255u) | 63u;
        key[47] = (f2o(av[13] + bv[0]) & ~255u) | 47u;
        key[48] = (f2o(av[14] + bv[0]) & ~255u) | 31u;
        key[49] = (f2o(av[15] + bv[0]) & ~255u) | 15u;
#pragma unroll
        for (int i = 50; i < 64; ++i) key[i] = 0u;
        tk_sort16<64, 0>(key); tk_sort16<64, 16>(key); tk_sort16<64, 32>(key); tk_sort16<64, 48>(key);
        tk_merge16<64, 0, 64, 16>(key, key); tk_merge16<64, 32, 64, 48>(key, key); tk_merge16<64, 0, 64, 32>(key, key);
        asm volatile("s_waitcnt lgkmcnt(0)" ::: "memory");
        const float s0 = o2f(key[0] & ~255u);
        float ev[16]; int ei[16]; float den = 0.f;
#pragma unroll
        for (int w = 0; w < 16; ++w) {
            const unsigned ij = 255u - (key[w] & 255u);
            ev[w] = __expf(o2f(key[w] & ~255u) - s0); den += ev[w];
            ei[w] = li[ij >> 4] * 128 + li[16 + (ij & 15)];
        }
        const float inv = 1.f / den;
        const size_t ob = ((size_t)b * 64 + lane) * 16;
#pragma unroll
        for (int q = 0; q < 4; ++q) {
            typedef int i32x4 __attribute__((ext_vector_type(4)));
            *(GAS i32x4*)(eidx + ob + 4 * q) = (i32x4){ei[4 * q], ei[4 * q + 1], ei[4 * q + 2], ei[4 * q + 3]};
            *(GAS f32x4*)(gate + ob + 4 * q) = (f32x4){ev[4 * q] * inv, ev[4 * q + 1] * inv, ev[4 * q + 2] * inv, ev[4 * q + 3] * inv};
        }
        asm volatile("s_waitcnt lgkmcnt(0)" ::: "memory");
    }
}
typedef __attribute__((ext_vector_type(2))) __bf16 bf16x2_t;
__device__ __forceinline__ float dot2bf(unsigned a, unsigned b, float c) { return __builtin_amdgcn_fdot2_f32_bf16(__builtin_bit_cast(bf16x2_t, a), __builtin_bit_cast(bf16x2_t, b), c, false); }
__device__ __forceinline__ float gelu_erf(float v) { return 0.5f * v * (1.f + erff(v * 0.70710678118654752f)); }
typedef __attribute__((ext_vector_type(2))) float f32x2v;
constexpr int CW_Q2 = 12288;
__device__ __forceinline__ void cvt16(const v4u r, float (&f)[16]) {
    const unsigned w[4] = {r.x, r.y, r.z, r.w};
#pragma unroll
    for (int i = 0; i < 4; ++i) { const f32x2v lo = __builtin_amdgcn_cvt_pk_f32_fp8((int)w[i], false), hi = __builtin_amdgcn_cvt_pk_f32_fp8((int)w[i], true); f[4 * i] = lo.x; f[4 * i + 1] = lo.y; f[4 * i + 2] = hi.x; f[4 * i + 3] = hi.y; }
}
constexpr int PCH = 128, PTW = PCH / 8;
typedef __attribute__((ext_vector_type(4))) int i32x4;
struct PIdx { i32x4 e[4]; };
struct PTok { v4u r[16]; f32x4 w[4]; v4u xa, xc; };
template <int QSET> __device__ __forceinline__ void peer_idx(PIdx& I, const GAS int* eidx, int t, int lane) {
    const GAS i32x4* ep = (const GAS i32x4*)(eidx + (size_t)t * 128 + 16 * (lane >> 3));
#pragma unroll
    for (int q = 0; q < 4; ++q) I.e[q] = ep[q];
#if defined(MK_PROBE_EMASK)
    if (QSET == 1) {
#pragma unroll
        for (int q = 0; q < 4; ++q) I.e[q] = I.e[q] & MK_PROBE_EMASK;
    }
#endif
}
template <int PHASE> __device__ __forceinline__ void peer_rows(PTok& K, const PIdx& I, const GAS unsigned char* tab, const GAS float* wgt, const GAS bf16* xb, int t, int s, int lane) {
    const int g = lane >> 3, j = lane & 7;
#pragma unroll
    for (int i = 0; i < 16; ++i) K.r[i] = *(const GAS v4u*)(tab + (size_t)(unsigned)I.e[i >> 2][i & 3] * 128 + 16 * j);
    if (PHASE == 0) { const GAS unsigned char* xrow = (const GAS unsigned char*)(xb + (size_t)t * D + s * 128 + 16 * j); K.xa = *(const GAS v4u*)xrow; K.xc = *(const GAS v4u*)(xrow + 16); }
    else { const GAS f32x4* wp = (const GAS f32x4*)(wgt + (size_t)t * 128 + 16 * g);
#pragma unroll
        for (int q = 0; q < 4; ++q) K.w[q] = wp[q]; }
}
__device__ __forceinline__ void cvt16p(const v4u r, f32x2v (&f)[8]) {
    const unsigned w[4] = {r.x, r.y, r.z, r.w};
#pragma unroll
    for (int i = 0; i < 4; ++i) { f[2 * i] = __builtin_amdgcn_cvt_pk_f32_fp8((int)w[i], false); f[2 * i + 1] = __builtin_amdgcn_cvt_pk_f32_fp8((int)w[i], true); }
}
__device__ __forceinline__ void peer_u_compute(const PTok& K, LAS float* lpart, int lane) {
    const int g = lane >> 3, j = lane & 7;
    f32x2v xv[8];
    { const unsigned xw[8] = {K.xa.x, K.xa.y, K.xa.z, K.xa.w, K.xc.x, K.xc.y, K.xc.z, K.xc.w};
#pragma unroll
      for (int i = 0; i < 8; ++i) xv[i] = (f32x2v){__uint_as_float(xw[i] << 16), __uint_as_float(xw[i] & 0xffff0000u)}; }
    float res_lo = 0.f, res_hi = 0.f;
#pragma unroll
    for (int i = 0; i < 16; ++i) {
        f32x2v f[8]; cvt16p(K.r[i], f);
        f32x2v a0 = xv[0] * f[0], a1 = xv[1] * f[1];
#pragma unroll
        for (int k = 2; k < 8; k += 2) { a0 = a0 + xv[k] * f[k]; a1 = a1 + xv[k + 1] * f[k + 1]; }
        const f32x2v a = a0 + a1;
        const float d = sum8(a.x + a.y);
        if (i < 8) res_lo = (j == i) ? d : res_lo; else res_hi = (j == i - 8) ? d : res_hi;
    }
    lpart[16 * g + j] = res_lo; lpart[16 * g + 8 + j] = res_hi;
}
__device__ __forceinline__ void peer_v_compute(const PTok& K, LAS float* lout, int lane) {
    const int g = lane >> 3, j = lane & 7;
    f32x2v acc[8];
#pragma unroll
    for (int k = 0; k < 8; ++k) acc[k] = (f32x2v){0.f, 0.f};
#pragma unroll
    for (int i = 0; i < 16; ++i) {
        f32x2v f[8]; cvt16p(K.r[i], f);
        const float wi = K.w[i >> 2][i & 3]; const f32x2v w2 = {wi, wi};
#pragma unroll
        for (int k = 0; k < 8; ++k) acc[k] = acc[k] + w2 * f[k];
    }
    float o[16];
#pragma unroll
    for (int k = 0; k < 8; ++k) {
        float a = acc[k].x, b = acc[k].y;
        a += dpp_f<0x128>(a); b += dpp_f<0x128>(b); a = swap16_add(a, a); b = swap16_add(b, b); o[2 * k] = swap32_add(a, a); o[2 * k + 1] = swap32_add(b, b);
    }
    if (g == 0) {
#pragma unroll
        for (int q = 0; q < 4; ++q) *(LAS f32x4*)(lout + 16 * j + 4 * q) = (f32x4){o[4 * q], o[4 * q + 1], o[4 * q + 2], o[4 * q + 3]};
    }
}
template <int PHASE, int QSET = 0> __device__ __forceinline__ void ph_peer_sliced(unsigned char* ws, LAS unsigned char* lds, float* xout, int l, int tid, int wave, int lane) {
    unsigned* heads = (unsigned*)(ws + WS_CTL) + CW_Q2 + ((QSET * 2 + l) * 2 + PHASE) * 8 * 64;
    volatile LAS unsigned* slot = (volatile LAS unsigned*)(lds + MISC_OFF);
    const GAS int* eidx = (const GAS int*)(ws + WS_EIDX); const GAS float* wgt = (const GAS float*)(ws + WS_GATE); GAS bf16* xb = (GAS bf16*)(ws + WS_XB);
    const int myx = (int)(xb_xcc_id() & 7u);
    int it = 0;
    for (int k = 0; k < 8; ++k) {
        const int s = (myx + k) & 7;
        const GAS unsigned char* tab = (const GAS unsigned char*)(ws + (PHASE == 0 ? WS_UT : WS_VT) + (size_t)l * 16384 * D + (size_t)s * 16384 * 128);
        GAS float* part = (GAS float*)(ws + WS_PART) + (size_t)s * T * 128;
        for (;; ++it) {
            if (tid == 0) slot[it & 1] = __hip_atomic_fetch_add(heads + 64 * s, 1u, __ATOMIC_RELAXED, __HIP_MEMORY_SCOPE_AGENT);
            __syncthreads();
            const int c = (int)slot[it & 1];
            if (c >= T / PCH) { ++it; break; }
            const int t0 = c * PCH + wave * PTW;
            LAS float* stg = (LAS float*)(lds + wave * WSCR);
            PIdx iB, iC; PTok A, B;
            peer_idx<QSET>(iB, eidx, t0, lane);
            peer_rows<PHASE>(A, iB, tab, wgt, xb, t0, s, lane);
            peer_idx<QSET>(iB, eidx, t0 + 1, lane);
#pragma unroll 2
            for (int i = 0; i < PTW; ++i) {
                peer_idx<QSET>(iC, eidx, t0 + (i + 2 < PTW ? i + 2 : PTW - 1), lane);
                peer_rows<PHASE>(B, iB, tab, wgt, xb, t0 + (i + 1 < PTW ? i + 1 : PTW - 1), s, lane);
                if (PHASE == 0) peer_u_compute(A, stg + i * 128, lane); else peer_v_compute(A, stg + i * 128, lane);
                A = B; iB = iC;
            }
            asm volatile("s_waitcnt lgkmcnt(0)" ::: "memory");
            if (PHASE == 0) {
#pragma unroll
                for (int q = 0; q < PTW * 128 / 256; ++q) *(GAS f32x4*)(part + (size_t)t0 * 128 + q * 256 + lane * 4) = *(const LAS f32x4*)(stg + q * 256 + lane * 4);
            } else {
                GAS float* xo = (GAS float*)xout; GAS float* rs1p = (GAS float*)(ws + WS_RS1P);
#pragma unroll 4
                for (int q = 0; q < PTW / 2; ++q) {
                    const int tk = 2 * q + (lane >> 5), cq = lane & 31, t = t0 + tk;
                    GAS float* xr = xo + (size_t)t * D + s * 128 + 4 * cq;
                    const f32x4 av = *(const LAS f32x4*)(stg + tk * 128 + 4 * cq); f32x4 xv = *(const GAS f32x4*)xr;
                    xv = xv + av;
                    *(GAS f32x4*)xr = xv;
                    u32x2 w; w.x = pkbf(xv.x, xv.y); w.y = pkbf(xv.z, xv.w); *(GAS u32x2*)(xb + (size_t)t * D + s * 128 + 4 * cq) = w;
                    float s2 = (xv.x * xv.x + xv.y * xv.y) + (xv.z * xv.z + xv.w * xv.w);
                    s2 = sum16(s2); s2 = swap16_add(s2, s2);
                    if (cq == 0) rs1p[(size_t)t * 8 + s] = s2;
                }
            }
            asm volatile("s_waitcnt lgkmcnt(0)" ::: "memory");
        }
    }
}
__device__ __forceinline__ void ph_peer_w(unsigned char* ws, int l, int gw, int NGW, int lane) {
    const GAS int* eidx = (const GAS int*)(ws + WS_EIDX); GAS float* gate = (GAS float*)(ws + WS_GATE); const GAS float* part = (const GAS float*)(ws + WS_PART);
    const GAS float* usc = (const GAS float*)(ws + WS_USC) + l * 16384; const GAS float* vsc = (const GAS float*)(ws + WS_VSC) + l * 16384; const GAS float* xssq = (const GAS float*)(ws + WS_XSSQ);
    for (int t = gw; t < T; t += NGW) {
        const float r2 = rsqrtf(sum16(xssq[(size_t)t * 16 + (lane & 15)]) * (1.f / 1024.f) + EPS);
#pragma unroll
        for (int hh = 0; hh < 2; ++hh) {
            const size_t q = (size_t)t * 128 + 64 * hh + lane;
            float a = 0.f;
#pragma unroll
            for (int s = 0; s < 8; ++s) a += part[(size_t)s * T * 128 + q];
            const int e = eidx[q];
            gate[q] = gate[q] * gelu_erf(a * (r2 * usc[e])) * vsc[e];
        }
    }
}

constexpr int NPH_L = 10, NPHASES = 1 + NL * NPH_L;
#ifndef MK_PHMASK
#define MK_PHMASK 0x7ff
#endif
#define PH_ON(j) ((MK_PHMASK >> (j)) & 1)
#ifndef MK_REP
#define MK_REP 0
#endif
#define PH_REP(j) ((MK_REP >> (j)) & 1)
__global__ void __launch_bounds__(NWAVES * 64, 2) mega(Args a) {
    extern __shared__ __attribute__((aligned(16))) unsigned char lds_raw[];
    {
        LAS unsigned char* lds0 = (LAS unsigned char*)lds_raw;
        for (int u = threadIdx.x; u < (LDS_BYTES - LDSCTL_OFF) / 4; u += NWAVES * 64) ((LAS unsigned*)(lds0 + LDSCTL_OFF))[u] = 0u;
        __syncthreads();
    }
    int wave0 = __builtin_amdgcn_readfirstlane((int)threadIdx.x >> 6); asm volatile("" : "+s"(wave0));
    int ph_lo = a.ph_lo, ph_hi = a.ph_hi; asm volatile("" : "+s"(ph_lo), "+s"(ph_hi));
    const bool multi = (ph_hi - ph_lo) > 1;
    XcdBarrier bar; bar.bar = (unsigned*)(a.ws + WS_CTL) + CW_BAR + a.li * XCD_BAR_WORDS; bar.x = 0; bar.st = nullptr;
    if (multi) bar = xcd_barrier_post((unsigned*)(a.ws + WS_CTL) + CW_BAR + a.li * XCD_BAR_WORDS, (volatile LAS unsigned*)((LAS unsigned char*)lds_raw + MISC_OFF) + 8);

#if defined(MK_UBENCH)
    {
        unsigned v0 = threadIdx.x * 2654435761u, v1 = v0 ^ 0x3c3c3c3cu; float f0 = 1.0f + (float)(threadIdx.x & 7), f1 = 2.0f; unsigned long long pp = v0, qq = v1;
        for (int it = 0; it < 2500; ++it) {
#pragma unroll
            for (int k = 0; k < 8; ++k) {
#if MK_UBENCH == 1
                asm volatile("v_cvt_pk_f32_fp8 %0, %1\n" : "=v"(pp) : "v"(v0));
#elif MK_UBENCH == 2
                asm volatile("v_cvt_pk_f32_fp8_sdwa %0, %1 src0_sel:WORD_1\n" : "=v"(pp) : "v"(v0));
#elif MK_UBENCH == 3
                asm volatile("v_cvt_pk_fp8_f32 %0, %1, %2\n" : "+v"(v0) : "v"(f0), "v"(f1));
#elif MK_UBENCH == 4
                asm volatile("v_fma_f32 %0, %1, %2, %0\n" : "+v"(f0) : "v"(f1), "v"(f1));
#elif MK_UBENCH == 5
                asm volatile("ds_bpermute_b32 %0, %1, %0\n s_waitcnt lgkmcnt(0)\n" : "+v"(v0) : "v"(v1));
#elif MK_UBENCH == 7
                { typedef __attribute__((ext_vector_type(8))) int i32x8b; i32x8b aa = {(int)v0, (int)v1, (int)v0, (int)v1, (int)v0, (int)v1, (int)v0, (int)v1};
                  f32x4 cc = {f0, f1, f0, f1}; cc = __builtin_amdgcn_mfma_scale_f32_16x16x128_f8f6f4(aa, aa, cc, 0, 0, 0, 0x7f7f7f7f, 0, 0x7f7f7f7f); f0 = cc[0]; f1 = cc[1]; asm volatile("" : "+v"(f0), "+v"(f1)); }
#elif MK_UBENCH == 6
                asm volatile("v_pk_fma_f32 %0, %1, %1, %0\n" : "+v"(pp) : "v"(qq));
#endif
            }
        }
        if (f0 == 1.2345e30f && v0 == 0x12345u && pp == 77ull && qq == 78ull) a.out[0] = f0;
    }
#endif
    for (int ph = ph_lo; ph < ph_hi; ++ph) {
        unsigned char* ws = a.ws; asm volatile("" : "+s"(ws));
        int G = (int)gridDim.x; asm volatile("" : "+s"(G));
        int bx = (int)blockIdx.x; asm volatile("" : "+s"(bx));
        int tid; asm volatile("v_mbcnt_lo_u32_b32 %0, -1, 0\n\tv_mbcnt_hi_u32_b32 %0, -1, %0" : "=v"(tid)); tid |= wave0 << 6;
        LAS unsigned char* lds = (LAS unsigned char*)lds_raw;
        const int lane = tid & 63, wave = __builtin_amdgcn_readfirstlane(tid >> 6);
        const int vcu = (G % 8 == 0) ? (bx % 8) * (G / 8) + bx / 8 : bx;
        const int gw = vcu * NWAVES + wave, NGW = G * NWAVES;
        if (ph == 0) {
            if (PH_ON(10)) for (int rep = 0; rep < 1 + PH_REP(10); ++rep) ph_prologue(a, ws, lds, gw, NGW, wave, lane);
        } else {
            const int l = (ph - 1) / NPH_L, j = (ph - 1) % NPH_L;
            if (j == 0 && PH_ON(0)) {
              for (int rep = 0; rep < 1 + PH_REP(0); ++rep) {
                { pg8::Gemm g{(const pg8::bf16_t*)(ws + WS_XB), (const pg8::bf16_t*)(ws + WS_WIN) + (size_t)l * NPROJ * D, T, NPROJ, D};
                  pg8::StaticOrder So; So.init(T, NPROJ, G, bx);
                  pg8::EpiInProj E{(pg8::bf16_t*)(ws + WS_PROJ), NPROJ, (const float*)(ws + WS_RS1P), (float*)(ws + WS_DTF), AIN(I_DTBIAS) + l * 6, 8};
                  pg8::gemm_phase<pg8::EpiInProj, pg8::StaticOrder, true, true>(lds, g, So, E, tid); }
                { pg8::Gemm g{(const pg8::bf16_t*)(ws + WS_MEMB), (const pg8::bf16_t*)(ws + WS_WMEM) + (size_t)l * 512 * D, MROWS, 512, D};
                  pg8::StaticOrder So; So.init(MROWS, 512, G, bx);
                  pg8::EpiInProj E{(pg8::bf16_t*)(ws + WS_MEMKV), 512, (const float*)(ws + WS_RSM), nullptr, nullptr, 0};
                  pg8::gemm_phase<pg8::EpiInProj, pg8::StaticOrder, true, true>(lds, g, So, E, tid); }
              }
            } else if (j == 1 && PH_ON(1)) {
                for (int rep = 0; rep < 1 + PH_REP(1); ++rep) { ph_mix(a, ws, lds, l, 32 * rep, tid, wave, lane); __syncthreads(); }
            } else if (j == 2 && PH_ON(2)) {
                ph_ssd_scan(ws, bx, G, tid);
            } else if (j == 3 && PH_ON(3)) {
                for (int rep = 0; rep < 1 + PH_REP(3); ++rep) for (int u = vcu; u < 256; u += G) ssd_finish_unit(a, ws, l, u, wave, lane);
            } else if (j == 4 && PH_ON(4)) {
                pg8::Gemm g{(const pg8::bf16_t*)(ws + WS_YCAT), (const pg8::bf16_t*)(ws + WS_WOUT) + (size_t)l * D * D, T, D, D};
                pg8::StaticOrder So; So.init(T, D, G, bx);
                LAS float* gtab = (LAS float*)(lds + GTAB_OFF);
                { pg8::Unit u0; if (So.next(0, u0) && tid < 256) { float r0, r1, r2; pg8::group_rstd((const float*)(ws + WS_YSSQ), u0.pm * 256 + tid, r0, r1, r2); gtab[tid] = r0 / r1; gtab[256 + tid] = r1 / r2; gtab[512 + tid] = r2; } }
                __syncthreads();
                pg8::EpiOut E{l == 0 ? AIN(I_X) : a.out, a.out, (pg8::bf16_t*)(ws + WS_XB), (float*)(ws + WS_XSSQ), gtab};
                pg8::gemm_phase<pg8::EpiOut, pg8::StaticOrder, true, true>(lds, g, So, E, tid);
            } else if (j == 5 && PH_ON(5)) {
                pg8::Gemm g{(const pg8::bf16_t*)(ws + WS_XB), (const pg8::bf16_t*)(ws + WS_WSC) + (size_t)l * 2048 * D, T, 2048, D};
                pg8::StaticOrder So; So.init(T, 2048, G, bx);
                pg8::EpiScores E{(float*)(ws + WS_SCORES), (const float*)(ws + WS_XSSQ)};
                for (int rep = 0; rep < 1 + PH_REP(5); ++rep) pg8::gemm_phase<pg8::EpiScores, pg8::StaticOrder, true, true>(lds, g, So, E, tid);
            } else if (j == 6 && PH_ON(6)) {
                for (int rep = 0; rep < 1 + PH_REP(6); ++rep) ph_topk(ws, lds, gw, NGW, wave, lane);
            } else if (j == 7 && PH_ON(7)) {
                ph_peer_sliced<0>(ws, lds, a.out, l, tid, wave, lane);
#if MK_REP & 0x80
                __syncthreads(); ph_peer_sliced<0, 1>(ws, lds, a.out, l, tid, wave, lane);
#endif
            } else if (j == 8 && PH_ON(8)) {
                ph_peer_w(ws, l, gw, NGW, lane);
            } else if (j == 9 && PH_ON(9)) {
                ph_peer_sliced<1>(ws, lds, a.out, l, tid, wave, lane);
            }
        }
        if (ph + 1 < ph_hi) { XcdBarrier b2 = bar; { unsigned* p = b2.bar; unsigned x = b2.x; asm volatile("" : "+s"(p), "+s"(x)); b2.bar = p; b2.x = x; } xcd_barrier(b2, tid); }
    }
}

#ifndef MK_ONE_LAUNCH
#define MK_ONE_LAUNCH 1
#endif
extern "C" void kernel_launch(void* const* d_in, const int* in_sizes, int n_in, void* d_out, int out_size, void* d_ws, size_t ws_size, hipStream_t stream) {
    static int grid = 0;
    if (grid == 0) {
        if (n_in != 22 || out_size != T * D || ws_size < WS_END) { fprintf(stderr, "kernel_launch: unexpected problem (n_in %d out %d ws %zu)\n", n_in, out_size, ws_size); grid = -1; return; }
        int dev = 0, cus = 0, per_cu = 0;
        if (hipGetDevice(&dev) != hipSuccess || hipDeviceGetAttribute(&cus, hipDeviceAttributeMultiprocessorCount, dev) != hipSuccess) { grid = -1; return; }
        if (hipFuncSetAttribute((const void*)mega, hipFuncAttributeMaxDynamicSharedMemorySize, LDS_BYTES) != hipSuccess) { fprintf(stderr, "kernel_launch: hipFuncSetAttribute failed\n"); grid = -1; return; }
        if (hipOccupancyMaxActiveBlocksPerMultiprocessor(&per_cu, (const void*)mega, NWAVES * 64, LDS_BYTES) != hipSuccess || per_cu < 1) { fprintf(stderr, "kernel_launch: occupancy query says %d\n", per_cu); (void)hipGetLastError(); per_cu = 1; }
        grid = cus;
    }
    if (grid < 0) return;
    (void)hipMemsetAsync((char*)d_ws + WS_CTL, 0, CTL_ZERO_BYTES, stream);
    Args a{};
    for (int i = 0; i < 22; ++i) a.in[i] = (const float*)d_in[i];
    a.out = (float*)d_out; a.ws = (unsigned char*)d_ws;
#if MK_ONE_LAUNCH
    a.ph_lo = 0; a.ph_hi = NPHASES; a.li = 0;
    hipLaunchKernelGGL(mega, dim3(grid), dim3(NWAVES * 64), LDS_BYTES, stream, a);
#else
    for (int ph = 0; ph < NPHASES; ++ph) { a.ph_lo = ph; a.ph_hi = ph + 1; a.li = 0; hipLaunchKernelGGL(mega, dim3(grid), dim3(NWAVES * 64), LDS_BYTES, stream, a); }
#endif
}
```

```cpp
#include <hip/hip_runtime.h>
#include <cstdio>
#include <cstdint>
#include <cmath>
namespace pg8 {
#define PG8_LAS __attribute__((address_space(3)))
typedef unsigned short bf16_t;
typedef short bf16x8 __attribute__((ext_vector_type(8)));
typedef float f32x4 __attribute__((ext_vector_type(4)));
typedef unsigned u32x4 __attribute__((ext_vector_type(4)));
constexpr int BM = 256, BK = 64, HALF = 128, HTB = HALF * BK * 2  , STAGE_BYTES = 8 * HTB, NXCD = 8, WGM = 8;

__host__ __device__ __forceinline__ int lds_byte(int r, int c) { const int st = (r >> 4) * 2 + (c >> 5), rr = r & 15, cc = c & 31, ob = rr * 64 + cc * 2; return st * 1024 + (ob ^ (((ob >> 9) & 1) << 5)); }
__host__ __device__ __forceinline__ void stage_rc(int b, int& R, int& C) { const int st = b / 1024, sb = b % 1024, swz = sb ^ (((sb >> 9) & 1) << 5); R = (st >> 1) * 16 + swz / 64; C = (st & 1) * 32 + (swz % 64) / 2; }
__host__ __device__ __forceinline__ int perm32(int rho) { const int n = rho >> 4, i = rho & 15; return 8 * (i >> 2) + 4 * n + (i & 3); }

struct Unit { int pm, pn; };
struct Gemm { const bf16_t* A; const bf16_t* Bt; int M, N, K; };

struct StaticOrder {
    int nM, nN, nwg, G, c;
    __host__ __device__ void init(int M, int N, int G_, int c_) { nM = M / BM; nN = N / BM; nwg = nM * nN; G = G_; c = c_; }
    __host__ __device__ bool next(int i, Unit& u) const {
        const long L = (long)i * G + c; if (L >= nwg) return false;
        int wgid = (int)L; { const int q = nwg / NXCD, r = nwg % NXCD, xcd = wgid % NXCD, off = wgid / NXCD; wgid = (xcd < r ? xcd * (q + 1) : r * (q + 1) + (xcd - r) * q) + off; }
        const int nig = WGM * nN, gid = wgid / nig, fm = gid * WGM, gsz = (nM - fm) < WGM ? (nM - fm) : WGM;
        u.pm = fm + ((wgid % nig) % gsz); u.pn = (wgid % nig) / gsz; return true;
    }
    __device__ __forceinline__ void a_ready(const Unit&) const {}
    __device__ __forceinline__ void done(const Unit&) const {}
};

__device__ __forceinline__ unsigned cvt_pk_bf16(float lo, float hi) { unsigned r; asm volatile("v_cvt_pk_bf16_f32 %0, %1, %2" : "=v"(r) : "v"(lo), "v"(hi)); return r; }
template <class Epi, class Sched, bool ALIGN_EPI = false, bool SP2 = false>
__device__ __forceinline__ void gemm_phase(PG8_LAS unsigned char* lds, const Gemm g, const Sched& S, const Epi& E, const int tid_in) {
    int tid_ = tid_in; asm volatile("" : "+v"(tid_));
    const int tid = tid_, wid = __builtin_amdgcn_readfirstlane(tid >> 6), lane = tid & 63, wr = wid >> 2, wc = wid & 3, fr = lane & 15, fq = lane >> 4;
    const int K = g.K, nt = K / BK;
    unsigned voffA[2], voffB[2];
#pragma unroll
    for (int i = 0; i < 2; ++i) { int R, C; stage_rc(tid * 16 + i * 8192, R, C); const int Rb = Epi::PERM ? ((R & ~31) + perm32(R & 31)) : R;
        voffA[i] = (unsigned)(R * K + C) * 2u; voffB[i] = (unsigned)(Rb * K + C) * 2u; }
    const size_t kstep = (size_t)(BK * 2);
    const size_t hstep = (size_t)HALF * K * 2;
    const size_t tstep = 2 * hstep;
    const unsigned ldsw = (unsigned)wid * 1024u;
    const int aoff = lds_byte(wr * 64 + fr, fq * 8), boff = lds_byte(wc * 32 + fr, fq * 8);
#define PG8_SA(b, h) (((b) * 2 + (h)) * HTB)
#define PG8_SB(b, h) ((4 + (b) * 2 + (h)) * HTB)
#define PG8_STAGE(bufoff, gbase, voff) do { _Pragma("unroll") for (int _i = 0; _i < 2; ++_i) \
        __builtin_amdgcn_global_load_lds((const unsigned*)((const char*)(gbase) + (voff)[_i]), (PG8_LAS unsigned*)(lds + (bufoff) + ldsw + _i * 8192), 16, 0, 0); } while (0)
#define PG8_LDA(dst, b, h) do { _Pragma("unroll") for (int m = 0; m < 4; ++m) _Pragma("unroll") for (int k = 0; k < 2; ++k) dst[m][k] = *(const PG8_LAS bf16x8*)(lds + PG8_SA(b, h) + aoff + m * 2048 + k * 1024); } while (0)
#define PG8_LDB(dst, b, h) do { _Pragma("unroll") for (int n = 0; n < 2; ++n) _Pragma("unroll") for (int k = 0; k < 2; ++k) dst[n][k] = *(const PG8_LAS bf16x8*)(lds + PG8_SB(b, h) + boff + n * 2048 + k * 1024); } while (0)
#define PG8_MMA(ai, bj, At, Bt) do { __builtin_amdgcn_s_setprio(1); _Pragma("unroll") for (int m = 0; m < 4; ++m) _Pragma("unroll") for (int n = 0; n < 2; ++n) _Pragma("unroll") for (int k = 0; k < 2; ++k) \
        acc[ai][bj][m][n] = __builtin_amdgcn_mfma_f32_16x16x32_bf16(Bt[n][k], At[m][k], acc[ai][bj][m][n], 0, 0, 0); __builtin_amdgcn_s_setprio(0); } while (0)
#define PG8_WAIT_V(n) asm volatile("s_waitcnt vmcnt(" #n ")" ::: "memory")
#define PG8_WAIT_L(n) asm volatile("s_waitcnt lgkmcnt(" #n ")" ::: "memory")
#define PG8_BAR __builtin_amdgcn_s_barrier()
#define PG8_SCHED __builtin_amdgcn_sched_barrier(0)
    Unit cur, nxt; int ui = 0;
    if (!S.next(0, cur)) return;
    f32x4 acc[2][2][4][2];
#pragma unroll
    for (int a = 0; a < 2; ++a)
#pragma unroll
        for (int b = 0; b < 2; ++b)
#pragma unroll
            for (int m = 0; m < 4; ++m)
#pragma unroll
                for (int n = 0; n < 2; ++n) acc[a][b][m][n] = (f32x4){0.f, 0.f, 0.f, 0.f};
    bf16x8 At[4][2], B0[2][2], B1[2][2];
    const char* cA = (const char*)g.A + (size_t)cur.pm * tstep; const char* cB = (const char*)g.Bt + (size_t)cur.pn * tstep;
    S.a_ready(cur);
    if constexpr (SP2) {
        PG8_STAGE(PG8_SB(0, 0), cB, voffB); PG8_STAGE(PG8_SB(0, 1), cB + hstep, voffB); PG8_STAGE(PG8_SA(0, 0), cA, voffA); PG8_STAGE(PG8_SA(0, 1), cA + hstep, voffA);
        if (wr == 1) PG8_BAR;
        PG8_WAIT_V(2); PG8_BAR;
        PG8_STAGE(PG8_SB(1, 0), cB + kstep, voffB); PG8_STAGE(PG8_SA(1, 0), cA + kstep, voffA); PG8_STAGE(PG8_SB(1, 1), cB + hstep + kstep, voffB);
        PG8_WAIT_V(6); PG8_BAR;
    } else {
        PG8_STAGE(PG8_SB(0, 0), cB, voffB); PG8_STAGE(PG8_SA(0, 0), cA, voffA); PG8_STAGE(PG8_SB(0, 1), cB + hstep, voffB); PG8_STAGE(PG8_SA(0, 1), cA + hstep, voffA);
        if (wr == 1) PG8_BAR;
        PG8_WAIT_V(4); PG8_BAR;
        PG8_STAGE(PG8_SB(1, 0), cB + kstep, voffB); PG8_STAGE(PG8_SA(1, 0), cA + kstep, voffA); PG8_STAGE(PG8_SB(1, 1), cB + hstep + kstep, voffB);
        PG8_WAIT_V(6); PG8_BAR;
    }
    for (;;) {
        const bool has_next = S.next(ui + 1, nxt);
        const char* nA = has_next ? (const char*)g.A + (size_t)nxt.pm * tstep : cA; const char* nB = has_next ? (const char*)g.Bt + (size_t)nxt.pn * tstep : cB;
        for (int t = 0; t < nt; t += 2) {
            const bool last = (t == nt - 2);
            const char* a1 = cA + (size_t)(t + 1) * kstep;
            const char* a2 = last ? nA : cA + (size_t)(t + 2) * kstep; const char* b2 = last ? nB : cB + (size_t)(t + 2) * kstep;
            const char* a3 = a2 + kstep; const char* b3 = b2 + kstep;
            if (last && has_next) S.a_ready(nxt);
            if constexpr (Epi::KHOOK) E.khook(acc, cur, t, wr, fr);
            if constexpr (SP2) {
            PG8_LDB(B0, 0, 0); PG8_LDB(B1, 0, 1); PG8_SCHED; PG8_LDA(At, 0, 0); PG8_STAGE(PG8_SA(1, 1), a1 + hstep, voffA);
            PG8_WAIT_V(8); PG8_WAIT_L(0); PG8_BAR; PG8_MMA(0, 0, At, B0); PG8_MMA(0, 1, At, B1); PG8_BAR; PG8_SCHED;
            PG8_LDA(At, 0, 1); PG8_STAGE(PG8_SB(0, 0), b2, voffB); PG8_STAGE(PG8_SB(0, 1), b2 + hstep, voffB); PG8_STAGE(PG8_SA(0, 0), a2, voffA);
            PG8_WAIT_V(8); PG8_WAIT_L(0); PG8_BAR; PG8_MMA(1, 0, At, B0); PG8_MMA(1, 1, At, B1); PG8_BAR; PG8_SCHED;
            PG8_LDB(B0, 1, 0); PG8_LDB(B1, 1, 1); PG8_SCHED; PG8_LDA(At, 1, 0); PG8_STAGE(PG8_SA(0, 1), a2 + hstep, voffA);
            PG8_WAIT_V(8); PG8_WAIT_L(0); PG8_BAR; PG8_MMA(0, 0, At, B0); PG8_MMA(0, 1, At, B1); PG8_BAR; PG8_SCHED;
            PG8_LDA(At, 1, 1); PG8_STAGE(PG8_SB(1, 0), b3, voffB); PG8_STAGE(PG8_SB(1, 1), b3 + hstep, voffB); PG8_STAGE(PG8_SA(1, 0), a3, voffA);
            PG8_WAIT_V(8); PG8_WAIT_L(0); PG8_BAR; PG8_MMA(1, 0, At, B0); PG8_MMA(1, 1, At, B1); PG8_BAR; PG8_SCHED;
            } else {
            PG8_LDB(B0, 0, 0); PG8_SCHED; PG8_LDA(At, 0, 0); PG8_STAGE(PG8_SA(1, 1), a1 + hstep, voffA);
            PG8_WAIT_L(8); PG8_BAR; PG8_WAIT_L(0); PG8_MMA(0, 0, At, B0); PG8_BAR; PG8_SCHED;
            PG8_LDB(B1, 0, 1); PG8_STAGE(PG8_SB(0, 0), b2, voffB);
            PG8_BAR; PG8_WAIT_L(0); PG8_MMA(0, 1, At, B1); PG8_BAR;
            PG8_LDA(At, 0, 1); PG8_STAGE(PG8_SA(0, 0), a2, voffA);
            PG8_BAR; PG8_WAIT_L(0); PG8_MMA(1, 0, At, B0); PG8_BAR; PG8_SCHED;
            PG8_STAGE(PG8_SB(0, 1), b2 + hstep, voffB);
            PG8_WAIT_V(6); PG8_BAR; PG8_MMA(1, 1, At, B1); PG8_BAR;
            PG8_LDB(B0, 1, 0); PG8_SCHED; PG8_LDA(At, 1, 0); PG8_STAGE(PG8_SA(0, 1), a2 + hstep, voffA);
            PG8_WAIT_L(8); PG8_BAR; PG8_WAIT_L(0); PG8_MMA(0, 0, At, B0); PG8_BAR; PG8_SCHED;
            PG8_LDB(B1, 1, 1); PG8_STAGE(PG8_SB(1, 0), b3, voffB);
            PG8_BAR; PG8_WAIT_L(0); PG8_MMA(0, 1, At, B1); PG8_BAR;
            PG8_LDA(At, 1, 1); PG8_STAGE(PG8_SA(1, 0), a3, voffA);
            PG8_BAR; PG8_WAIT_L(0); PG8_MMA(1, 0, At, B0); PG8_BAR; PG8_SCHED;
            PG8_STAGE(PG8_SB(1, 1), b3 + hstep, voffB);
            PG8_WAIT_V(6); PG8_BAR; PG8_MMA(1, 1, At, B1); PG8_BAR;
            }
        }
        if constexpr (ALIGN_EPI) { if (wr == 0) PG8_BAR; }
        if constexpr (!Epi::AFTER_DRAIN) { E(acc, cur, wr, wc, fr, fq); S.done(cur); }
        if (!has_next) break;
#pragma unroll
        for (int a = 0; a < 2; ++a)
#pragma unroll
            for (int b = 0; b < 2; ++b)
#pragma unroll
                for (int m = 0; m < 4; ++m)
#pragma unroll
                    for (int n = 0; n < 2; ++n) acc[a][b][m][n] = (f32x4){0.f, 0.f, 0.f, 0.f};
        cur = nxt; cA = nA; cB = nB; ++ui;
        if constexpr (ALIGN_EPI) { if (wr == 1) PG8_BAR; }
    }
    PG8_WAIT_V(0);
    if constexpr (!ALIGN_EPI) { if (wr == 0) PG8_BAR; }
    PG8_BAR;
    if constexpr (Epi::AFTER_DRAIN) { E.fused(acc, cur, wr, wc, fr, fq, lds, wid, lane); S.done(cur); }
#undef PG8_SA
#undef PG8_SB
#undef PG8_STAGE
#undef PG8_LDA
#undef PG8_LDB
#undef PG8_MMA
#undef PG8_WAIT_V
#undef PG8_WAIT_L
#undef PG8_BAR
#undef PG8_SCHED
}
}
#define GAS __attribute__((address_space(1)))
#define LAS __attribute__((address_space(3)))
typedef unsigned short bf16;
typedef unsigned v4u __attribute__((ext_vector_type(4)));
typedef float f32x4 __attribute__((ext_vector_type(4)));
typedef short bf16x8 __attribute__((ext_vector_type(8)));
typedef GAS unsigned gu32;
typedef GAS unsigned long long gu64;
#define RLX_AGENT __ATOMIC_RELAXED, __HIP_MEMORY_SCOPE_AGENT
#define LDS_WAIT() asm volatile("s_waitcnt lgkmcnt(0)" ::: "memory")
#define VM_WAIT() asm volatile("s_waitcnt vmcnt(0)" ::: "memory")
__device__ __forceinline__ unsigned long long rt() { return __builtin_amdgcn_s_memrealtime(); }
__device__ __forceinline__ unsigned f2bf(float f) { unsigned u = __builtin_bit_cast(unsigned, f); return (u + 0x7fffu + ((u >> 16) & 1u)) >> 16; }
__device__ __forceinline__ unsigned pk2(float lo, float hi) { return f2bf(lo) | (f2bf(hi) << 16); }

#define XB_TMO      128
#define XB_XCNT(j)  (256  + 64 * (j))
#define XB_XSUB(j)  (1280 + 64 * (j))
#define XB_XGEN(j)  (2304 + 64 * (j))
#define XB_TOP      3328
#define XB_TOPGEN   3392
#define XCD_BAR_WORDS 3456
#define XB_SPIN_CAP (1u << 18)

__device__ __forceinline__ unsigned xb_ld(unsigned* p)              { return __hip_atomic_load(p, __ATOMIC_RELAXED, __HIP_MEMORY_SCOPE_AGENT); }
__device__ __forceinline__ unsigned xb_add(unsigned* p, unsigned v) { return __hip_atomic_fetch_add(p, v, __ATOMIC_RELAXED, __HIP_MEMORY_SCOPE_AGENT); }
__device__ __forceinline__ unsigned xb_xcc_id() { return (unsigned)__builtin_amdgcn_s_getreg((3 << 11) | 20) & 0xFu; }
#define XB_SPIN(cond, bar) do { unsigned _sp = 0; while (cond) { __builtin_amdgcn_s_sleep(1); \
    if ((++_sp & 255u) == 0u) { if (xb_ld(&(bar)[XB_TMO])) break; if (_sp > XB_SPIN_CAP) { atomicAdd(&(bar)[XB_TMO], 1u); break; } } } } while (0)

struct XcdBarrier {
    unsigned* bar; unsigned x;
    volatile LAS unsigned* st;
};

__device__ __forceinline__ XcdBarrier xcd_barrier_post(unsigned* bar, volatile LAS unsigned* st) {
    XcdBarrier b; b.bar = bar; b.x = xb_xcc_id(); b.st = st;
    if (threadIdx.x == 0) (void)xb_add(&bar[XB_XCNT(b.x)], 1u);
    return b;
}
__device__ __forceinline__ void xcd_barrier_complete(unsigned* bar, unsigned x, unsigned& nloc, unsigned& nx) {
    const unsigned G = gridDim.x * gridDim.y * gridDim.z;
    unsigned sum, cnt, mine, sp = 0u;
    for (;;) {
        sum = 0u; cnt = 0u; mine = 0u;
#pragma unroll
        for (unsigned j = 0; j < 16; ++j) { const unsigned c = xb_ld(&bar[XB_XCNT(j)]); sum += c; cnt += (c > 0u) ? 1u : 0u; mine = (j == x) ? c : mine; }
        if (sum == G) break;
        __builtin_amdgcn_s_sleep(1);
        if ((++sp & 255u) == 0u) { if (xb_ld(&bar[XB_TMO])) break; if (sp > XB_SPIN_CAP) { atomicAdd(&bar[XB_TMO], 1u); break; } }
    }
    nloc = mine > 0u ? mine : 1u; nx = cnt > 0u ? cnt : 1u;
}

__device__ __forceinline__ void xcd_barrier(const XcdBarrier& b, const int tid) {
    asm volatile("s_waitcnt vmcnt(0)" ::: "memory");
    __syncthreads();
    if (tid == 0) {
        unsigned* bar = b.bar;
        __builtin_amdgcn_s_waitcnt(0);
        unsigned nloc = b.st[0], nx = b.st[1];
        if (nloc == 0u) { xcd_barrier_complete(bar, b.x, nloc, nx); b.st[0] = nloc; b.st[1] = nx; }
        const unsigned old = xb_add(&bar[XB_XSUB(b.x)], 1u);
        const unsigned gen = old / nloc;
        if (old + 1u == (gen + 1u) * nloc) {
            __builtin_amdgcn_fence(__ATOMIC_RELEASE, "agent");
            asm volatile("s_waitcnt vmcnt(0)" ::: "memory");
            const unsigned og = xb_add(&bar[XB_TOP], 1u);
            const unsigned tg = og / nx;
            if (og + 1u == (tg + 1u) * nx) xb_add(&bar[XB_TOPGEN], 1u);
            else XB_SPIN(xb_ld(&bar[XB_TOPGEN]) == tg, bar);
            __builtin_amdgcn_fence(__ATOMIC_ACQUIRE, "agent");
            xb_add(&bar[XB_XGEN(b.x)], 1u);
            asm volatile("s_waitcnt vmcnt(0)" ::: "memory");
        } else {
            XB_SPIN(xb_ld(&bar[XB_XGEN(b.x)]) == gen, bar);
            __builtin_amdgcn_fence(__ATOMIC_ACQUIRE, "agent");
            asm volatile("s_waitcnt vmcnt(0)" ::: "memory");
        }
    }
    __syncthreads();
}

constexpr int NWAVES = 8;
constexpr int D = 1024, NB = 4, S = 4096, T = NB * S, NL = 2, NMEM = 256, MROWS = NB * NMEM;
constexpr int DIN = 2438, NPROJ = 2560;
constexpr int PC_Z = 0, PC_XBC = 384, PC_QSB = 1024, PC_KSB = 1408, PC_VSB = 1792, PC_QMEM = 2176, PC_DT = 2432;
constexpr int CONV_CH = 640;
constexpr float EPS = 1e-6f;

constexpr int RING_BYTES = 131072;
constexpr int WSCR = 17408;
constexpr int LDSCTL_OFF = 8 * WSCR, MISC_OFF = LDSCTL_OFF + 320;
constexpr int LDS_BYTES = 147456;
constexpr int GTAB_OFF = LDSCTL_OFF + 1024;

constexpr size_t MiB = 1u << 20;
constexpr size_t WS_CTL = 0, CTL_ZERO_BYTES = 1 * MiB;
constexpr size_t WS_WIN = 2 * MiB;
constexpr size_t WS_WMEM = 12 * MiB;
constexpr size_t WS_WOUT = 14 * MiB;
constexpr size_t WS_WSC = 18 * MiB;
constexpr size_t WS_KB = 22 * MiB;
constexpr size_t WS_MEMB = 26 * MiB;
constexpr size_t WS_RSM = 28 * MiB;
constexpr size_t WS_RS1 = WS_RSM + 64 * 1024;
constexpr size_t WS_DTF = WS_RS1 + 64 * 1024;
constexpr size_t WS_XSSQ = 29 * MiB;
constexpr size_t WS_YSSQ = 30 * MiB;
constexpr size_t WS_MEMKV = 31 * MiB;
constexpr size_t WS_RS1P = 32 * MiB;
constexpr size_t WS_PART = 178 * MiB;
constexpr size_t WS_XB = 34 * MiB;
constexpr size_t WS_YCAT = 66 * MiB;
constexpr size_t WS_PROJ = 98 * MiB;
constexpr size_t WS_SCORES = 178 * MiB;
constexpr size_t WS_YPART = WS_SCORES;
constexpr size_t WS_XCONV = WS_SCORES + 24 * MiB;
constexpr size_t WS_CMG = WS_SCORES + 36 * MiB;
constexpr size_t WS_ACSG = WS_SCORES + 40 * MiB;
constexpr size_t WS_HS = WS_SCORES + 41 * MiB;
constexpr size_t WS_CD = WS_SCORES + 53 * MiB;
constexpr size_t WS_EIDX = 306 * MiB;
constexpr size_t WS_GATE = 314 * MiB;
constexpr size_t WS_STOP = 322 * MiB;
constexpr size_t WS_ITOP = 338 * MiB;
constexpr size_t WS_UT = 354 * MiB;
constexpr size_t WS_USC = 386 * MiB;
constexpr size_t WS_VT = 418 * MiB;
constexpr size_t WS_VSC = 450 * MiB;
constexpr size_t WS_END = 482 * MiB;
constexpr int CW_BAR = 4096;

__device__ __forceinline__ float bf2f(bf16 v) { return __uint_as_float((unsigned)v << 16); }
__device__ __forceinline__ unsigned pkbf(float lo, float hi) { return pg8::cvt_pk_bf16(lo, hi); }
template <int CTRL> __device__ __forceinline__ float dpp_f(float v) { return __uint_as_float((unsigned)__builtin_amdgcn_update_dpp(0, (int)__float_as_uint(v), CTRL, 0xf, 0xf, true)); }
__device__ __forceinline__ float swap32_add(float a, float b) {
    const auto r = __builtin_amdgcn_permlane32_swap(__float_as_uint(a), __float_as_uint(b), false, false); return __uint_as_float(r[0]) + __uint_as_float(r[1]); }
__device__ __forceinline__ float swap16_add(float a, float b) {
    const auto r = __builtin_amdgcn_permlane16_swap(__float_as_uint(a), __float_as_uint(b), false, false); return __uint_as_float(r[0]) + __uint_as_float(r[1]); }
__device__ __forceinline__ float swap32_max(float a) { const auto r = __builtin_amdgcn_permlane32_swap(__float_as_uint(a), __float_as_uint(a), false, false); return fmaxf(__uint_as_float(r[0]), __uint_as_float(r[1])); }
__device__ __forceinline__ float swap16_max(float a) { const auto r = __builtin_amdgcn_permlane16_swap(__float_as_uint(a), __float_as_uint(a), false, false); return fmaxf(__uint_as_float(r[0]), __uint_as_float(r[1])); }
__device__ __forceinline__ float partner32(float a, bool hi) { const auto r = __builtin_amdgcn_permlane32_swap(__float_as_uint(a), __float_as_uint(a), false, false); return __uint_as_float(hi ? r[0] : r[1]); }
__device__ __forceinline__ float sum8(float v) { v += dpp_f<0xB1>(v); v += dpp_f<0x4E>(v); v += dpp_f<0x141>(v); return v; }
__device__ __forceinline__ float sum16(float v) { v = sum8(v); v += dpp_f<0x140>(v); return v; }
__device__ __forceinline__ float wave_sum(float v) { v = sum16(v); v = swap16_add(v, v); return swap32_add(v, v); }
__device__ __forceinline__ float wave_max(float v) { v = fmaxf(v, dpp_f<0xB1>(v)); v = fmaxf(v, dpp_f<0x4E>(v)); v = fmaxf(v, dpp_f<0x141>(v)); v = fmaxf(v, dpp_f<0x140>(v)); v = swap16_max(v); return swap32_max(v); }
__device__ __forceinline__ float bperm_f(float v, int src_lane) { return __uint_as_float((unsigned)__builtin_amdgcn_ds_bpermute(src_lane << 2, (int)__float_as_uint(v))); }
__device__ __forceinline__ int bperm_i(int v, int src_lane) { return __builtin_amdgcn_ds_bpermute(src_lane << 2, v); }
__device__ __forceinline__ float softplus_f(float x) { return fmaxf(x, 0.f) + log1pf(expf(-fabsf(x))); }
__device__ __forceinline__ float silu_f(float x) { return x / (1.f + expf(-x)); }

namespace pg8 {
struct EpiInProj {
    static constexpr bool PERM = true, AFTER_DRAIN = false, KHOOK = false;
    bf16_t* O; int ldc; const float* rs; float* dtf; const float* dtb; int npart;
    __device__ __forceinline__ void operator()(const f32x4 (&acc)[2][2][4][2], const Unit& u, int wr, int wc, int fr, int fq) const {
        const int row0 = u.pm * BM + wr * 64 + fr, col0 = u.pn * BM + wc * 32 + 8 * fq;
        const bool dtl = dtf && (u.pn * BM == PC_DT - 128) && wc == 0 && fq == 0;
#pragma unroll
        for (int ai = 0; ai < 2; ++ai)
#pragma unroll
            for (int m = 0; m < 4; ++m) {
                const int row = row0 + ai * HALF + m * 16; float s;
                if (npart == 8) { const f32x4 p0 = *(const f32x4*)(rs + (size_t)row * 8), p1 = *(const f32x4*)(rs + (size_t)row * 8 + 4); s = rsqrtf((((p0[0] + p0[1]) + (p0[2] + p0[3])) + ((p1[0] + p1[1]) + (p1[2] + p1[3]))) * (1.f / 1024.f) + EPS); }
                else if (npart == 16) { const f32x4 p0 = *(const f32x4*)(rs + (size_t)row * 16), p1 = *(const f32x4*)(rs + (size_t)row * 16 + 4), p2 = *(const f32x4*)(rs + (size_t)row * 16 + 8), p3 = *(const f32x4*)(rs + (size_t)row * 16 + 12);
                    s = rsqrtf(((((p0[0] + p0[1]) + (p0[2] + p0[3])) + ((p1[0] + p1[1]) + (p1[2] + p1[3]))) + (((p2[0] + p2[1]) + (p2[2] + p2[3])) + ((p3[0] + p3[1]) + (p3[2] + p3[3])))) * (1.f / 1024.f) + EPS); }
                else s = rs[row];
#pragma unroll
                for (int bj = 0; bj < 2; ++bj) {
                    const f32x4 v0 = acc[ai][bj][m][0] * s, v1 = acc[ai][bj][m][1] * s;
                    u32x4 w; w.x = cvt_pk_bf16(v0[0], v0[1]); w.y = cvt_pk_bf16(v0[2], v0[3]); w.z = cvt_pk_bf16(v1[0], v1[1]); w.w = cvt_pk_bf16(v1[2], v1[3]);
                    *(u32x4*)(O + (size_t)row * ldc + col0 + bj * HALF) = w;
                    if (bj == 1 && dtl) {
                        f32x4 d0; d0[0] = softplus_f(v0[0] + dtb[0]); d0[1] = softplus_f(v0[1] + dtb[1]); d0[2] = softplus_f(v0[2] + dtb[2]); d0[3] = softplus_f(v0[3] + dtb[3]);
                        f32x4 d1; d1[0] = softplus_f(v1[0] + dtb[4]); d1[1] = softplus_f(v1[1] + dtb[5]); d1[2] = 0.f; d1[3] = 0.f;
                        *(f32x4*)(dtf + (size_t)row * 8) = d0; *(f32x4*)(dtf + (size_t)row * 8 + 4) = d1;
                    }
                }
            }
    }
};
__device__ __forceinline__ void group_rstd(const float* yssq, int row, float& r_ssd, float& r_sb, float& r_mem) {
    const f32x4 a = *(const f32x4*)(yssq + (size_t)row * 16), b = *(const f32x4*)(yssq + (size_t)row * 16 + 4), c = *(const f32x4*)(yssq + (size_t)row * 16 + 8), d = *(const f32x4*)(yssq + (size_t)row * 16 + 12);
    const float s0 = (a[0] + a[1]) + (a[2] + a[3]) + (b[0] + b[1]), s1 = (b[2] + b[3]) + (c[0] + c[1]) + (c[2] + c[3]), s2 = (d[0] + d[1]) + (d[2] + d[3]);
    r_ssd = rsqrtf(s0 * (1.f / 384.f) + EPS); r_sb = rsqrtf(s1 * (1.f / 384.f) + EPS); r_mem = rsqrtf(s2 * (1.f / 256.f) + EPS);
}
struct EpiOut {
    static constexpr bool PERM = false, AFTER_DRAIN = false, KHOOK = true;
    const float* base; float* out; bf16_t* xb; float* xssq; const PG8_LAS float* gtab;
    __device__ __forceinline__ void khook(f32x4 (&acc)[2][2][4][2], const Unit& u, int t, int wr, int fr) const {
        if (t != 6 && t != 12) return;
#pragma unroll
        for (int ai = 0; ai < 2; ++ai)
#pragma unroll
            for (int m = 0; m < 4; ++m) {
                const float f = gtab[(t == 6 ? 0 : 256) + ai * HALF + wr * 64 + m * 16 + fr];
#pragma unroll
                for (int bj = 0; bj < 2; ++bj)
#pragma unroll
                    for (int n = 0; n < 2; ++n) acc[ai][bj][m][n] = acc[ai][bj][m][n] * f;
            }
    }
    __device__ __forceinline__ void operator()(const f32x4 (&acc)[2][2][4][2], const Unit& u, int wr, int wc, int fr, int fq) const {
        const int col0 = u.pn * BM + wc * 32 + 4 * fq;
#pragma unroll
        for (int ai = 0; ai < 2; ++ai)
#pragma unroll
            for (int m = 0; m < 4; ++m) {
                const int row = u.pm * BM + ai * HALF + wr * 64 + m * 16 + fr; const float r2 = gtab[512 + ai * HALF + wr * 64 + m * 16 + fr];
                float q = 0.f;
#pragma unroll
                for (int bj = 0; bj < 2; ++bj)
#pragma unroll
                    for (int n = 0; n < 2; ++n) {
                        const size_t off = (size_t)row * D + col0 + bj * HALF + n * 16;
                        const f32x4 x1 = *(const f32x4*)(base + off) + acc[ai][bj][m][n] * r2;
                        *(f32x4*)(out + off) = x1;
                        typedef unsigned u32x2v __attribute__((ext_vector_type(2)));
                        u32x2v w; w.x = cvt_pk_bf16(x1[0], x1[1]); w.y = cvt_pk_bf16(x1[2], x1[3]); *(u32x2v*)(xb + off) = w;
                        q += (x1[0] * x1[0] + x1[1] * x1[1]) + (x1[2] * x1[2] + x1[3] * x1[3]);
                    }
                q = swap16_add(q, q); q = swap32_add(q, q);
                if (fq == 0) xssq[(size_t)row * 16 + u.pn * 4 + wc] = q;
            }
    }
};
struct EpiScores {
    static constexpr bool PERM = false, AFTER_DRAIN = false, KHOOK = false;
    float* O; const float* xssq;
    __device__ __forceinline__ void operator()(const f32x4 (&acc)[2][2][4][2], const Unit& u, int wr, int wc, int fr, int fq) const {
        const int col0 = u.pn * BM + wc * 32 + 4 * fq;
#pragma unroll
        for (int ai = 0; ai < 2; ++ai)
#pragma unroll
            for (int m = 0; m < 4; ++m) {
                const int row = u.pm * BM + ai * HALF + wr * 64 + m * 16 + fr;
                const f32x4 a = *(const f32x4*)(xssq + (size_t)row * 16), b = *(const f32x4*)(xssq + (size_t)row * 16 + 4), c = *(const f32x4*)(xssq + (size_t)row * 16 + 8), d = *(const f32x4*)(xssq + (size_t)row * 16 + 12);
                const float ss = ((a[0] + a[1]) + (a[2] + a[3])) + ((b[0] + b[1]) + (b[2] + b[3])) + ((c[0] + c[1]) + (c[2] + c[3])) + ((d[0] + d[1]) + (d[2] + d[3]));
                const float r = rsqrtf(ss * (1.f / 1024.f) + EPS);
#pragma unroll
                for (int bj = 0; bj < 2; ++bj)
#pragma unroll
                    for (int n = 0; n < 2; ++n) *(f32x4*)(O + (size_t)row * 2048 + col0 + bj * HALF + n * 16) = acc[ai][bj][m][n] * r;
            }
    }
};
}

struct Args { const float* in[22]; float* out; unsigned char* ws; int ph_lo, ph_hi, li, pad; };
enum { I_X = 0, I_MEM, I_NORM1G, I_WIN, I_CONVW, I_CONVB, I_DTBIAS, I_ALOG, I_DSKIP, I_SSDG, I_SBG, I_MEMNG, I_WMEMKV, I_MQG, I_MKG, I_MEMOG, I_WOUT, I_NORM2G, I_WQ, I_KEYS, I_PU, I_PV };

__device__ __forceinline__ int opq(int i) { asm volatile("" : "+s"(i)); return i; }
#define AIN(i) (a.in[opq(i)])
__device__ __forceinline__ void transpose_item(const float* W, int ldw, int src_c0, int nvalid, const float* g, bf16* WT, int K, int dst_r0, int k0, LAS float* scr, int lane) {
    const int c = lane & 31;
#pragma unroll 8
    for (int i = 0; i < 32; ++i) {
        const int kk = 2 * i + (lane >> 5);
        float v = (c < nvalid) ? W[(size_t)(k0 + kk) * ldw + src_c0 + c] : 0.f;
        if (g) v *= g[k0 + kk];
        scr[kk * 33 + c] = v;
    }
    LDS_WAIT(); asm volatile("" ::: "memory");
    const int c8 = lane & 7;
#pragma unroll
    for (int j = 0; j < 4; ++j) {
        const int n = (lane >> 3) + 8 * j; const LAS float* s = scr + (8 * c8) * 33 + n;
        v4u o; o.x = pkbf(s[0 * 33], s[1 * 33]); o.y = pkbf(s[2 * 33], s[3 * 33]); o.z = pkbf(s[4 * 33], s[5 * 33]); o.w = pkbf(s[6 * 33], s[7 * 33]);
        *(GAS v4u*)(WT + (size_t)(dst_r0 + n) * K + k0 + 8 * c8) = o;
    }
    LDS_WAIT(); asm volatile("" ::: "memory");
}
__device__ __forceinline__ void row_to_bf16(const float* xrow, bf16* orow, float* rs, bool partials, int lane) {
    const GAS f32x4* xr = (const GAS f32x4*)xrow + lane;
    f32x4 v[4]; float s = 0.f;
#pragma unroll
    for (int j = 0; j < 4; ++j) { v[j] = xr[64 * j]; s += (v[j].x * v[j].x + v[j].y * v[j].y) + (v[j].z * v[j].z + v[j].w * v[j].w); }
    s = wave_sum(s);
    GAS unsigned long long* o8 = (GAS unsigned long long*)orow + lane;
#pragma unroll
    for (int j = 0; j < 4; ++j) o8[64 * j] = (unsigned long long)pkbf(v[j].x, v[j].y) | ((unsigned long long)pkbf(v[j].z, v[j].w) << 32);
    if (partials) { if (lane < 8) rs[lane] = lane == 0 ? s : 0.f; }
    else if (lane == 0) *rs = rsqrtf(s * (1.f / 1024.f) + EPS);
}
__device__ __forceinline__ void ph_prologue(const Args& a, unsigned char* ws, LAS unsigned char* lds, int gw, int NGW, int wave, int lane) {
    LAS float* scr = (LAS float*)(lds + wave * 16384);
    constexpr int I_IN = 80 * 16, I_MEMW = 16 * 16, I_OUT = 32 * 16, I_SC = 32 * 16 + 128, PER_L = I_IN + I_MEMW + I_OUT + I_SC;
    constexpr int NW_ITEMS = NL * PER_L, NITEMS = NW_ITEMS + T + MROWS;
    for (int it = gw; it < NITEMS; it += NGW) {
        if (it < NW_ITEMS) {
            const int l = it / PER_L; int r = it % PER_L;
            if (r < I_IN) {
                const int j = r / 16, kb = r % 16;
                const int src = (j < 32) ? 32 * j : (j < 76 ? 32 * j + 6 : 1024), nv = (j < 76) ? 32 : (j == 76 ? 6 : 0);
                transpose_item(AIN(I_WIN) + (size_t)l * D * DIN, DIN, src, nv, AIN(I_NORM1G) + l * D, (bf16*)(ws + WS_WIN) + (size_t)l * NPROJ * D, D, 32 * j, 64 * kb, scr, lane);
                continue;
            }
            r -= I_IN;
            if (r < I_MEMW) {
                const int j = r / 16, kb = r % 16;
                transpose_item(AIN(I_WMEMKV) + (size_t)l * D * 512, 512, 32 * j, 32, AIN(I_MEMNG) + l * D, (bf16*)(ws + WS_WMEM) + (size_t)l * 512 * D, D, 32 * j, 64 * kb, scr, lane);
                continue;
            }
            r -= I_MEMW;
            if (r < I_OUT) {
                const int j = r / 16, kb = r % 16;
                const float* g = (kb < 6) ? AIN(I_SSDG) + l * 384 : (kb < 12 ? AIN(I_SBG) + l * 384 - 384 : AIN(I_MEMOG) + l * 256 - 768);
                transpose_item(AIN(I_WOUT) + (size_t)l * D * D, D, 32 * j, 32, g, (bf16*)(ws + WS_WOUT) + (size_t)l * D * D, D, 32 * j, 64 * kb, scr, lane);
                continue;
            }
            r -= I_OUT;
            if (r < 32 * 16) { const int j = r / 16, kb = r % 16;
                transpose_item(AIN(I_WQ) + (size_t)l * D * D, D, 32 * j, 32, AIN(I_NORM2G) + l * D, (bf16*)(ws + WS_WSC) + (size_t)l * D * D, D, 32 * j, 64 * kb, scr, lane); }
            else { r -= 32 * 16;
                const GAS f32x4* kr = (const GAS f32x4*)(AIN(I_KEYS) + (size_t)l * 16 * 128 * 64 + (size_t)r * 1024) + lane; GAS unsigned long long* o8 = (GAS unsigned long long*)((bf16*)(ws + WS_KB) + (size_t)l * 16 * 128 * 64 + (size_t)r * 1024) + lane;
#pragma unroll
                for (int j = 0; j < 4; ++j) { const f32x4 v = kr[64 * j]; o8[64 * j] = (unsigned long long)pkbf(v.x, v.y) | ((unsigned long long)pkbf(v.z, v.w) << 32); } }
            continue;
        }
        int r = it - NW_ITEMS;
        if (r < T) { row_to_bf16(AIN(I_X) + (size_t)r * D, (bf16*)(ws + WS_XB) + (size_t)r * D, (float*)(ws + WS_RS1P) + (size_t)r * 8, true, lane); continue; }
        r -= T;
        row_to_bf16(AIN(I_MEM) + (size_t)r * D, (bf16*)(ws + WS_MEMB) + (size_t)r * D, (float*)(ws + WS_RSM) + r, false, lane);
    }
    for (int r0 = gw; r0 < 2 * NL * 16384; r0 += 4 * NGW) {
        f32x4 v[4][4];
#pragma unroll
        for (int q = 0; q < 4; ++q) {
            const int r = r0 + q * NGW; const int tb = r >> 15, e = r & 32767;
            const float* src = (tb == 0 ? AIN(I_PU) : AIN(I_PV)) + (size_t)e * D;
#pragma unroll
            for (int j = 0; j < 4; ++j) v[q][j] = *((const GAS f32x4*)src + 64 * j + lane);
        }
#pragma unroll
        for (int q = 0; q < 4; ++q) {
            const int r = r0 + q * NGW; const int tb = r >> 15, e = r & 32767;
            unsigned* dst = (unsigned*)(ws + (tb == 0 ? WS_UT : WS_VT) + (size_t)(e >> 14) * 16384 * D + (size_t)(e & 16383) * 128) + (lane & 31);
            const float* g = AIN(I_NORM2G) + (e >> 14) * D;
            float am = 0.f;
#pragma unroll
            for (int j = 0; j < 4; ++j) { if (tb == 0) v[q][j] = v[q][j] * *((const GAS f32x4*)g + 64 * j + lane);
                am = fmaxf(fmaxf(am, fmaxf(fabsf(v[q][j].x), fabsf(v[q][j].y))), fmaxf(fabsf(v[q][j].z), fabsf(v[q][j].w))); }
            am = wave_max(am);
            const float sc = am > 0.f ? 256.f / am : 1.f;
#pragma unroll
            for (int j = 0; j < 4; ++j) { int pk = 0; pk = __builtin_amdgcn_cvt_pk_fp8_f32(v[q][j].x * sc, v[q][j].y * sc, pk, false); pk = __builtin_amdgcn_cvt_pk_fp8_f32(v[q][j].z * sc, v[q][j].w * sc, pk, true); dst[(size_t)(2 * j + (lane >> 5)) * (16384 * 128 / 4)] = (unsigned)pk; }
            if (lane == 0) ((float*)(ws + (tb == 0 ? WS_USC : WS_VSC)))[e] = am > 0.f ? am * (1.f / 256.f) : 1.f;
        }
    }
}


typedef __attribute__((ext_vector_type(8))) __bf16 bf8_t;
typedef __attribute__((ext_vector_type(8))) float f32x8;
typedef __attribute__((ext_vector_type(8))) short s16x8;
typedef __attribute__((ext_vector_type(4))) short s16x4;
typedef __attribute__((ext_vector_type(16))) float f32x16;
typedef unsigned u32x2 __attribute__((ext_vector_type(2)));
#define MFMA32(a, b, c) __builtin_amdgcn_mfma_f32_32x32x16_bf16((a), (b), (c), 0, 0, 0)
__device__ __forceinline__ int crow(int i, int h) { return (i & 3) + 8 * (i >> 2) + 4 * h; }
__device__ __forceinline__ s16x8 cvt8(const f32x8 x) { return __builtin_bit_cast(s16x8, __builtin_convertvector(x, bf8_t)); }
__device__ __forceinline__ s16x8 pack_acc(const f32x16& x, int s) { f32x8 v;
#pragma unroll
    for (int j = 0; j < 8; ++j) v[j] = x[8 * s + j];
    return cvt8(v); }
__device__ __forceinline__ s16x8 cat4(const s16x4 lo, const s16x4 hi) { return __builtin_shufflevector(lo, hi, 0, 1, 2, 3, 4, 5, 6, 7); }
__device__ __forceinline__ f32x16 zero16() { f32x16 z;
#pragma unroll
    for (int i = 0; i < 16; ++i) z[i] = 0.f;
    return z; }
constexpr int L_BM = 0, L_CM = 18432, L_BMT = 36864, L_XDT = 54272, L_ACS = 106496, L_DT = 108032, L_TOT = 109568;

__device__ __forceinline__ void ssd_chunk_unit(const Args& a, unsigned char* ws, LAS unsigned char* lds, int l_, int unit, int tid, int wave, int lane) {
    const int g = unit & 1, c = (unit >> 1) & 31, b = unit >> 6, t0 = b * S + c * 128;
    const bf16* proj = (const bf16*)(ws + WS_PROJ); const float* dtf = (const float*)(ws + WS_DTF);
    LAS float* acs = (LAS float*)(lds + L_ACS); LAS float* dts = (LAS float*)(lds + L_DT); LAS float* tot = (LAS float*)(lds + L_TOT);
    float cs = 0.f, dtv = 0.f;
    if (wave < 6) {
        const int hh = wave >> 1, l = (wave & 1) * 64 + lane;
        dtv = dtf[(size_t)(t0 + l) * 8 + 3 * g + hh];
        cs = dtv * -expf(AIN(I_ALOG)[l_ * 6 + 3 * g + hh]);
#pragma unroll
        for (int o = 1; o < 64; o <<= 1) { const float t = bperm_f(cs, lane - o); if (lane >= o) cs += t; }
        if (lane == 63) tot[wave] = cs;
    }
    __syncthreads();
    if (wave < 6) {
        const int hh = wave >> 1, l = (wave & 1) * 64 + lane;
        if (wave & 1) cs += tot[wave - 1];
        acs[hh * 128 + l] = cs; dts[hh * 128 + l] = dtv;
        ((float*)(ws + WS_ACSG))[(size_t)(t0 + l) * 8 + 3 * g + hh] = cs;
    }
    __syncthreads();
    const float* cw = AIN(I_CONVW) + l_ * 4 * CONV_CH; const float* cb = AIN(I_CONVB) + l_ * CONV_CH;
#pragma unroll 2
    for (int it = 0; it < 10; ++it) {
        const int idx = tid + 512 * it, l = idx / 40, ck = idx % 40;
        int cc, kind, hh = 0, e0;
        if (ck < 24) { hh = ck >> 3; e0 = (ck & 7) * 8; cc = (3 * g + hh) * 64 + e0; kind = 0; }
        else if (ck < 32) { e0 = (ck - 24) * 8; cc = 384 + g * 64 + e0; kind = 1; }
        else { e0 = (ck - 32) * 8; cc = 512 + g * 64 + e0; kind = 2; }
        float acc[8];
        { const f32x4 b0 = *(const f32x4*)(cb + cc), b1 = *(const f32x4*)(cb + cc + 4); acc[0] = b0.x; acc[1] = b0.y; acc[2] = b0.z; acc[3] = b0.w; acc[4] = b1.x; acc[5] = b1.y; acc[6] = b1.z; acc[7] = b1.w; }
#pragma unroll
        for (int k = 0; k < 4; ++k) {
            const int sl = c * 128 + l - 3 + k;
            if (sl >= 0) {
                const v4u xv = *(const GAS v4u*)(proj + (size_t)(t0 + l - 3 + k) * NPROJ + PC_XBC + cc);
                const f32x4 w0 = *(const f32x4*)(cw + k * CONV_CH + cc), w1 = *(const f32x4*)(cw + k * CONV_CH + cc + 4);
                acc[0] += w0.x * __uint_as_float(xv.x << 16); acc[1] += w0.y * __uint_as_float(xv.x & 0xffff0000u);
                acc[2] += w0.z * __uint_as_float(xv.y << 16); acc[3] += w0.w * __uint_as_float(xv.y & 0xffff0000u);
                acc[4] += w1.x * __uint_as_float(xv.z << 16); acc[5] += w1.y * __uint_as_float(xv.z & 0xffff0000u);
                acc[6] += w1.z * __uint_as_float(xv.w << 16); acc[7] += w1.w * __uint_as_float(xv.w & 0xffff0000u);
            }
        }
#pragma unroll
        for (int e = 0; e < 8; ++e) acc[e] = silu_f(acc[e]);
        v4u pk; pk.x = pkbf(acc[0], acc[1]); pk.y = pkbf(acc[2], acc[3]); pk.z = pkbf(acc[4], acc[5]); pk.w = pkbf(acc[6], acc[7]);
        if (kind == 0) {
            *(GAS v4u*)((bf16*)(ws + WS_XCONV) + (size_t)(t0 + l) * 384 + (3 * g + hh) * 64 + e0) = pk;
            const float d = dts[hh * 128 + l];
            LAS bf16* xd = (LAS bf16*)(lds + L_XDT) + (hh * 64 + e0) * 136 + l;
#pragma unroll
            for (int e = 0; e < 8; e += 2) { const unsigned w = pkbf(acc[e] * d, acc[e + 1] * d); xd[e * 136] = (bf16)(w & 0xffffu); xd[(e + 1) * 136] = (bf16)(w >> 16); }
        } else if (kind == 1) {
            *(LAS v4u*)(lds + L_BM + (l * 72 + e0) * 2) = pk;
            LAS bf16* bt = (LAS bf16*)(lds + L_BMT) + e0 * 136 + l;
            bt[0 * 136] = (bf16)(pk.x & 0xffffu); bt[1 * 136] = (bf16)(pk.x >> 16); bt[2 * 136] = (bf16)(pk.y & 0xffffu); bt[3 * 136] = (bf16)(pk.y >> 16);
            bt[4 * 136] = (bf16)(pk.z & 0xffffu); bt[5 * 136] = (bf16)(pk.z >> 16); bt[6 * 136] = (bf16)(pk.w & 0xffffu); bt[7 * 136] = (bf16)(pk.w >> 16);
        } else {
            *(LAS v4u*)(lds + L_CM + (l * 72 + e0) * 2) = pk;
            *(GAS v4u*)((bf16*)(ws + WS_CMG) + (size_t)(t0 + l) * 128 + g * 64 + e0) = pk;
        }
    }
    __syncthreads();
    const int r = lane & 31, h = lane >> 5, lb = wave & 3, pt = wave >> 2;
    {
        s16x8 cf[4];
#pragma unroll
        for (int ks = 0; ks < 4; ++ks) cf[ks] = *(const LAS s16x8*)(lds + L_CM + ((lb * 32 + r) * 72 + ks * 16 + 8 * h) * 2);
        f32x16 gt[4];
#pragma unroll
        for (int sb = 0; sb < 4; ++sb) {
            gt[sb] = zero16();
            if (sb <= lb) {
#pragma unroll
                for (int ks = 0; ks < 4; ++ks) gt[sb] = MFMA32(*(const LAS s16x8*)(lds + L_BM + ((sb * 32 + r) * 72 + ks * 16 + 8 * h) * 2), cf[ks], gt[sb]);
            }
        }
#pragma unroll
        for (int hh = 0; hh < 3; ++hh) {
            const float al = acs[hh * 128 + lb * 32 + r];
            f32x16 yacc = zero16();
#pragma unroll
            for (int sb = 0; sb < 4; ++sb) {
                if (sb <= lb) {
                    f32x16 m;
#pragma unroll
                    for (int i = 0; i < 16; ++i) {
                        const int sl = crow(i, h);
                        const float v = gt[sb][i] * __expf(al - acs[hh * 128 + sb * 32 + sl]);
                        m[i] = (sb < lb || sl <= r) ? v : 0.f;
                    }
#pragma unroll
                    for (int ks = 0; ks < 2; ++ks) {
                        const LAS unsigned char* xp = lds + L_XDT + ((hh * 64 + pt * 32 + r) * 136 + sb * 32 + 16 * ks + 4 * h) * 2;
                        yacc = MFMA32(cat4(*(const LAS s16x4*)xp, *(const LAS s16x4*)(xp + 16)), pack_acc(m, ks), yacc);
                    }
                }
            }
            float* yp = (float*)(ws + WS_YPART) + (size_t)(t0 + lb * 32 + r) * 384 + (3 * g + hh) * 64 + pt * 32 + 4 * h;
#pragma unroll
            for (int i4 = 0; i4 < 4; ++i4) *(f32x4*)(yp + 8 * i4) = (f32x4){yacc[4 * i4], yacc[4 * i4 + 1], yacc[4 * i4 + 2], yacc[4 * i4 + 3]};
        }
    }
    for (int tl = wave; tl < 12; tl += 8) {
        const int hh = tl >> 2, nt = (tl >> 1) & 1, pt2 = tl & 1;
        const float alast = acs[hh * 128 + 127];
        f32x16 acc = zero16();
#pragma unroll
        for (int ks = 0; ks < 8; ++ks) {
            const s16x8 af = *(const LAS s16x8*)(lds + L_BMT + ((nt * 32 + r) * 136 + ks * 16 + 8 * h) * 2);
            const v4u xr = *(const LAS v4u*)(lds + L_XDT + ((hh * 64 + pt2 * 32 + r) * 136 + ks * 16 + 8 * h) * 2);
            const LAS float* ap = acs + hh * 128 + ks * 16 + 8 * h;
            f32x8 xf;
            xf[0] = __uint_as_float(xr.x << 16) * __expf(alast - ap[0]); xf[1] = __uint_as_float(xr.x & 0xffff0000u) * __expf(alast - ap[1]);
            xf[2] = __uint_as_float(xr.y << 16) * __expf(alast - ap[2]); xf[3] = __uint_as_float(xr.y & 0xffff0000u) * __expf(alast - ap[3]);
            xf[4] = __uint_as_float(xr.z << 16) * __expf(alast - ap[4]); xf[5] = __uint_as_float(xr.z & 0xffff0000u) * __expf(alast - ap[5]);
            xf[6] = __uint_as_float(xr.w << 16) * __expf(alast - ap[6]); xf[7] = __uint_as_float(xr.w & 0xffff0000u) * __expf(alast - ap[7]);
            acc = MFMA32(af, cvt8(xf), acc);
        }
        float* hp = (float*)(ws + WS_HS) + ((size_t)((b * 32 + c) * 6 + 3 * g + hh) * 64 + pt2 * 32 + r) * 64 + nt * 32 + 4 * h;
#pragma unroll
        for (int i4 = 0; i4 < 4; ++i4) *(f32x4*)(hp + 8 * i4) = (f32x4){acc[4 * i4], acc[4 * i4 + 1], acc[4 * i4 + 2], acc[4 * i4 + 3]};
    }
    if (tid < 3) ((float*)(ws + WS_CD))[(b * 32 + c) * 6 + 3 * g + tid] = __expf(acs[tid * 128 + 127]);
    __syncthreads();
}
__device__ __forceinline__ void ph_ssd_scan(unsigned char* ws, int bx, int G, int tid) {
    float* hs = (float*)(ws + WS_HS); const float* cd = (const float*)(ws + WS_CD);
    for (int e = bx * 512 + tid; e < 24 * 4096; e += G * 512) {
        const int bh = e >> 12, el = e & 4095, b = bh / 6, hh = bh % 6;
        float run = 0.f;
#pragma unroll 4
        for (int c = 0; c < 32; ++c) {
            const int idx = (b * 32 + c) * 6 + hh;
            const float v = hs[(size_t)idx * 4096 + el], d = cd[idx];
            hs[(size_t)idx * 4096 + el] = run; run = run * d + v;
        }
    }
}
__device__ __forceinline__ void ssd_finish_unit(const Args& a, unsigned char* ws, int l_, int unit, int wave, int lane) {
    const int g = unit & 1, c = (unit >> 1) & 31, b = unit >> 6, t0 = b * S + c * 128;
    const int r = lane & 31, h = lane >> 5, lb = wave & 3, hsel = wave >> 2;
    const int t = t0 + lb * 32 + r;
    const bf16* proj = (const bf16*)(ws + WS_PROJ); const bf16* cmg = (const bf16*)(ws + WS_CMG) + (size_t)t * 128 + g * 64;
    s16x8 cf[4];
#pragma unroll
    for (int ks = 0; ks < 4; ++ks) cf[ks] = *(const GAS s16x8*)(cmg + ks * 16 + 8 * h);
    for (int hh = hsel ? 2 : 0; hh < (hsel ? 3 : 2); ++hh) {
        const int hd = 3 * g + hh;
        const float* hin = (const float*)(ws + WS_HS) + (size_t)((b * 32 + c) * 6 + hd) * 4096;
        const float ea = __expf(((const float*)(ws + WS_ACSG))[(size_t)t * 8 + hd]), dsk = AIN(I_DSKIP)[l_ * 6 + hd];
        float ssq = 0.f;
#pragma unroll
        for (int pt = 0; pt < 2; ++pt) {
            f32x16 acc = zero16();
#pragma unroll
            for (int ks = 0; ks < 4; ++ks) {
                const float* hp = hin + (pt * 32 + r) * 64 + ks * 16 + 8 * h;
                const f32x4 h0 = *(const GAS f32x4*)hp, h1 = *(const GAS f32x4*)(hp + 4);
                acc = MFMA32(cvt8((f32x8){h0.x, h0.y, h0.z, h0.w, h1.x, h1.y, h1.z, h1.w}), cf[ks], acc);
            }
#pragma unroll
            for (int i4 = 0; i4 < 4; ++i4) {
                const int col = hd * 64 + pt * 32 + 8 * i4 + 4 * h;
                const f32x4 yp = *(const GAS f32x4*)((const float*)(ws + WS_YPART) + (size_t)t * 384 + col);
                const u32x2 xc = *(const GAS u32x2*)((const bf16*)(ws + WS_XCONV) + (size_t)t * 384 + col);
                const u32x2 zz = *(const GAS u32x2*)(proj + (size_t)t * NPROJ + PC_Z + col);
                const float y0 = (yp.x + acc[4 * i4 + 0] * ea + dsk * __uint_as_float(xc.x << 16)) * silu_f(__uint_as_float(zz.x << 16));
                const float y1 = (yp.y + acc[4 * i4 + 1] * ea + dsk * __uint_as_float(xc.x & 0xffff0000u)) * silu_f(__uint_as_float(zz.x & 0xffff0000u));
                const float y2 = (yp.z + acc[4 * i4 + 2] * ea + dsk * __uint_as_float(xc.y << 16)) * silu_f(__uint_as_float(zz.y << 16));
                const float y3 = (yp.w + acc[4 * i4 + 3] * ea + dsk * __uint_as_float(xc.y & 0xffff0000u)) * silu_f(__uint_as_float(zz.y & 0xffff0000u));
                ssq += (y0 * y0 + y1 * y1) + (y2 * y2 + y3 * y3);
                u32x2 w; w.x = pkbf(y0, y1); w.y = pkbf(y2, y3);
                *(GAS u32x2*)((bf16*)(ws + WS_YCAT) + (size_t)t * D + col) = w;
            }
        }
        ssq = swap32_add(ssq, ssq);
        if (h == 0) ((float*)(ws + WS_YSSQ))[(size_t)t * 16 + hd] = ssq;
    }
}

#define LOG2E 1.4426950408889634f
__device__ __forceinline__ s16x8 trv_frag(const LAS unsigned char* vimg, int key0, int ks, int dt, int lane) {
    const int h = lane >> 5, i16 = lane & 15, blk = (lane >> 4) & 1;
    const LAS unsigned char* p = vimg + (key0 + 16 * ks + 4 * h + (i16 >> 2)) * 144 + (dt * 32 + 16 * blk) * 2 + 8 * (i16 & 3);
    const s16x4 lo = __builtin_amdgcn_ds_read_tr16_b64_v4i16((LAS s16x4*)p), hi = __builtin_amdgcn_ds_read_tr16_b64_v4i16((LAS s16x4*)(p + 8 * 144));
    return cat4(lo, hi);
}
__device__ __forceinline__ void mem_unit(const Args& a, unsigned char* ws, LAS unsigned char* lds, int l_, int b, int hd, int qb, int tid, int wave, int lane) {
    const bf16* proj = (const bf16*)(ws + WS_PROJ); const bf16* memkv = (const bf16*)(ws + WS_MEMKV);
    const float* qg = AIN(I_MQG) + l_ * 64; const float* kg = AIN(I_MKG) + l_ * 64;
    LAS unsigned char* kimg = lds; LAS unsigned char* vimg = lds + 36864;
#pragma unroll
    for (int it = 0; it < 4; ++it) {
        const int idx = tid + 512 * it, m = idx >> 3, ch = idx & 7;
        const v4u kv = *(const GAS v4u*)(memkv + (size_t)(b * NMEM + m) * 512 + hd * 64 + ch * 8);
        const v4u vv = *(const GAS v4u*)(memkv + (size_t)(b * NMEM + m) * 512 + 256 + hd * 64 + ch * 8);
        float kf[8] = {__uint_as_float(kv.x << 16), __uint_as_float(kv.x & 0xffff0000u), __uint_as_float(kv.y << 16), __uint_as_float(kv.y & 0xffff0000u),
                       __uint_as_float(kv.z << 16), __uint_as_float(kv.z & 0xffff0000u), __uint_as_float(kv.w << 16), __uint_as_float(kv.w & 0xffff0000u)};
        float ss = 0.f;
#pragma unroll
        for (int e = 0; e < 8; ++e) ss += kf[e] * kf[e];
        ss = sum8(ss);
        const float rk = rsqrtf(ss * (1.f / 64.f) + EPS);
        const f32x4 g0 = *(const f32x4*)(kg + ch * 8), g1 = *(const f32x4*)(kg + ch * 8 + 4);
        v4u pk; pk.x = pkbf(kf[0] * rk * g0.x, kf[1] * rk * g0.y); pk.y = pkbf(kf[2] * rk * g0.z, kf[3] * rk * g0.w); pk.z = pkbf(kf[4] * rk * g1.x, kf[5] * rk * g1.y); pk.w = pkbf(kf[6] * rk * g1.z, kf[7] * rk * g1.w);
        *(LAS v4u*)(kimg + (m * 72 + ch * 8) * 2) = pk;
        *(LAS v4u*)(vimg + (m * 72 + ch * 8) * 2) = vv;
    }
    __syncthreads();
    const int r = lane & 31, h = lane >> 5;
    const int t = b * S + qb * 256 + wave * 32 + r;
    s16x8 qf[4];
    {
        f32x8 qv[4]; float ss = 0.f;
#pragma unroll
        for (int ks = 0; ks < 4; ++ks) {
            const v4u q = *(const GAS v4u*)(proj + (size_t)t * NPROJ + PC_QMEM + hd * 64 + ks * 16 + 8 * h);
            qv[ks] = (f32x8){__uint_as_float(q.x << 16), __uint_as_float(q.x & 0xffff0000u), __uint_as_float(q.y << 16), __uint_as_float(q.y & 0xffff0000u),
                             __uint_as_float(q.z << 16), __uint_as_float(q.z & 0xffff0000u), __uint_as_float(q.w << 16), __uint_as_float(q.w & 0xffff0000u)};
#pragma unroll
            for (int e = 0; e < 8; ++e) ss += qv[ks][e] * qv[ks][e];
        }
        ss = swap32_add(ss, ss);
        const float rq = rsqrtf(ss * (1.f / 64.f) + EPS) * (0.125f * LOG2E);
#pragma unroll
        for (int ks = 0; ks < 4; ++ks) {
            const f32x4 g0 = *(const f32x4*)(qg + ks * 16 + 8 * h), g1 = *(const f32x4*)(qg + ks * 16 + 8 * h + 4);
            qf[ks] = cvt8(qv[ks] * rq * (f32x8){g0.x, g0.y, g0.z, g0.w, g1.x, g1.y, g1.z, g1.w});
        }
    }
    f32x16 st[8];
    float mx = -INFINITY;
#pragma unroll
    for (int kt = 0; kt < 8; ++kt) {
        st[kt] = zero16();
#pragma unroll
        for (int ks = 0; ks < 4; ++ks) st[kt] = MFMA32(*(const LAS s16x8*)(kimg + ((kt * 32 + r) * 72 + ks * 16 + 8 * h) * 2), qf[ks], st[kt]);
#pragma unroll
        for (int i = 0; i < 16; ++i) mx = fmaxf(mx, st[kt][i]);
    }
    mx = swap32_max(mx);
    float lsum = 0.f;
    f32x16 o0 = zero16(), o1 = zero16();
#pragma unroll
    for (int kt = 0; kt < 8; ++kt) {
#pragma unroll
        for (int i = 0; i < 16; ++i) { st[kt][i] = __builtin_amdgcn_exp2f(st[kt][i] - mx); lsum += st[kt][i]; }
#pragma unroll
        for (int ks = 0; ks < 2; ++ks) {
            const s16x8 pf = pack_acc(st[kt], ks);
            o0 = MFMA32(trv_frag(vimg, kt * 32, ks, 0, lane), pf, o0);
            o1 = MFMA32(trv_frag(vimg, kt * 32, ks, 1, lane), pf, o1);
        }
    }
    lsum = swap32_add(lsum, lsum);
    const float il = 1.f / lsum; float ssq = 0.f;
    bf16* yc = (bf16*)(ws + WS_YCAT) + (size_t)t * D + 768 + hd * 64 + 4 * h;
#pragma unroll
    for (int i4 = 0; i4 < 4; ++i4) {
        const float a0 = o0[4 * i4] * il, a1 = o0[4 * i4 + 1] * il, a2 = o0[4 * i4 + 2] * il, a3 = o0[4 * i4 + 3] * il;
        const float b0 = o1[4 * i4] * il, b1 = o1[4 * i4 + 1] * il, b2 = o1[4 * i4 + 2] * il, b3 = o1[4 * i4 + 3] * il;
        ssq += (a0 * a0 + a1 * a1) + (a2 * a2 + a3 * a3) + (b0 * b0 + b1 * b1) + (b2 * b2 + b3 * b3);
        u32x2 w; w.x = pkbf(a0, a1); w.y = pkbf(a2, a3); *(GAS u32x2*)(yc + 8 * i4) = w;
        w.x = pkbf(b0, b1); w.y = pkbf(b2, b3); *(GAS u32x2*)(yc + 32 + 8 * i4) = w;
    }
    ssq = swap32_add(ssq, ssq);
    if (h == 0) ((float*)(ws + WS_YSSQ))[(size_t)t * 16 + 12 + hd] = ssq;
    __syncthreads();
}
__device__ __forceinline__ void sb_unit(unsigned char* ws, LAS unsigned char* lds, int b, int hd, int qb, int tid, int wave, int lane) {
    const bf16* proj = (const bf16*)(ws + WS_PROJ);
    const int r = lane & 31, h = lane >> 5;
    const int q0w = qb * 256 + wave * 32, t = b * S + q0w + r;
    s16x8 qf[4];
#pragma unroll
    for (int ks = 0; ks < 4; ++ks) {
        const v4u q = *(const GAS v4u*)(proj + (size_t)t * NPROJ + PC_QSB + hd * 64 + ks * 16 + 8 * h);
        const f32x8 qv = (f32x8){__uint_as_float(q.x << 16), __uint_as_float(q.x & 0xffff0000u), __uint_as_float(q.y << 16), __uint_as_float(q.y & 0xffff0000u),
                                 __uint_as_float(q.z << 16), __uint_as_float(q.z & 0xffff0000u), __uint_as_float(q.w << 16), __uint_as_float(q.w & 0xffff0000u)};
        qf[ks] = cvt8(qv * (0.125f * LOG2E));
    }
    const int srow = tid >> 3, sch = tid & 7;
    const bf16* kbase = proj + (size_t)(b * S) * NPROJ + PC_KSB + hd * 64 + sch * 8;
    const int ktop = qb * 4 + 3;
    v4u kr = *(const GAS v4u*)(kbase + (size_t)(ktop * 64 + srow) * NPROJ), vr = *(const GAS v4u*)(kbase + (size_t)(ktop * 64 + srow) * NPROJ + (PC_VSB - PC_KSB));
    *(LAS v4u*)(lds + (srow * 72 + sch * 8) * 2) = kr; *(LAS v4u*)(lds + 9216 + (srow * 72 + sch * 8) * 2) = vr;
    __syncthreads();
    f32x16 o0 = zero16(), o1 = zero16();
    float R = 0.f;
    volatile LAS unsigned* live = (volatile LAS unsigned*)(lds + 36864);
    bool mylive = true;
    for (int kt = ktop; kt >= 0; --kt) {
        LAS unsigned char* kimg = lds + ((ktop - kt) & 1) * 18432; LAS unsigned char* vimg = kimg + 9216;
        if (kt > 0) { kr = *(const GAS v4u*)(kbase + (size_t)((kt - 1) * 64 + srow) * NPROJ); vr = *(const GAS v4u*)(kbase + (size_t)((kt - 1) * 64 + srow) * NPROJ + (PC_VSB - PC_KSB)); }
#pragma unroll
        for (int sub = 1; sub >= 0; --sub) {
            const int kb = kt * 64 + sub * 32;
            if (kb <= q0w && mylive) {
                const bool diag = (kb == q0w);
                f32x16 z = zero16();
#pragma unroll
                for (int ks = 0; ks < 4; ++ks) z = MFMA32(*(const LAS s16x8*)(kimg + ((sub * 32 + r) * 72 + ks * 16 + 8 * h) * 2), qf[ks], z);
                float lk[16];
#pragma unroll
                for (int i = 0; i < 16; ++i) {
                    const float sp = fmaxf(z[i], 0.f) + __builtin_amdgcn_logf(1.f + __builtin_amdgcn_exp2f(-fabsf(z[i])));
                    const bool ok = !diag || (crow(i, h) < r);
                    lk[i] = ok ? -sp : 0.f;
                    z[i] = ok ? z[i] : -INFINITY;
                }
                float g[4], pg[4];
#pragma unroll
                for (int j = 0; j < 4; ++j) { g[j] = (lk[4 * j] + lk[4 * j + 1]) + (lk[4 * j + 2] + lk[4 * j + 3]); pg[j] = partner32(g[j], h != 0); }
                float ab[4];
                ab[3] = R + (h == 0 ? pg[3] : 0.f);
#pragma unroll
                for (int j = 2; j >= 0; --j) ab[j] = ab[j + 1] + g[j + 1] + (h == 0 ? pg[j] : pg[j + 1]);
#pragma unroll
                for (int j = 0; j < 4; ++j) {
                    const float s3 = ab[j], s2 = s3 + lk[4 * j + 3], s1 = s2 + lk[4 * j + 2], s0 = s1 + lk[4 * j + 1];
                    z[4 * j + 3] = __builtin_amdgcn_exp2f(z[4 * j + 3] + lk[4 * j + 3] + s3);
                    z[4 * j + 2] = __builtin_amdgcn_exp2f(z[4 * j + 2] + lk[4 * j + 2] + s2);
                    z[4 * j + 1] = __builtin_amdgcn_exp2f(z[4 * j + 1] + lk[4 * j + 1] + s1);
                    z[4 * j + 0] = __builtin_amdgcn_exp2f(z[4 * j + 0] + lk[4 * j + 0] + s0);
                }
                R = ab[0] + g[0] + (h == 0 ? 0.f : pg[0]);
#pragma unroll
                for (int ks = 0; ks < 2; ++ks) {
                    const s16x8 pf = pack_acc(z, ks);
                    o0 = MFMA32(trv_frag(vimg, sub * 32, ks, 0, lane), pf, o0);
                    o1 = MFMA32(trv_frag(vimg, sub * 32, ks, 1, lane), pf, o1);
                }
            }
        }
        if (kt > 0) { LAS unsigned char* nimg = lds + ((ktop - kt + 1) & 1) * 18432; *(LAS v4u*)(nimg + (srow * 72 + sch * 8) * 2) = kr; *(LAS v4u*)(nimg + 9216 + (srow * 72 + sch * 8) * 2) = vr; }
        mylive = mylive && (__builtin_amdgcn_ballot_w64(R >= -150.f) != 0ull);
        if (lane == 0) live[((ktop - kt) & 1) * 8 + wave] = mylive ? 1u : 0u;
        __syncthreads();
        { unsigned any = 0u;
#pragma unroll
          for (int w = 0; w < 8; ++w) any |= live[((ktop - kt) & 1) * 8 + w];
          if (any == 0u) break; }
    }
    float ssq = 0.f;
    bf16* yc = (bf16*)(ws + WS_YCAT) + (size_t)t * D + 384 + hd * 64 + 4 * h;
#pragma unroll
    for (int i4 = 0; i4 < 4; ++i4) {
        const float a0 = o0[4 * i4], a1 = o0[4 * i4 + 1], a2 = o0[4 * i4 + 2], a3 = o0[4 * i4 + 3];
        const float b0 = o1[4 * i4], b1 = o1[4 * i4 + 1], b2 = o1[4 * i4 + 2], b3 = o1[4 * i4 + 3];
        ssq += (a0 * a0 + a1 * a1) + (a2 * a2 + a3 * a3) + (b0 * b0 + b1 * b1) + (b2 * b2 + b3 * b3);
        u32x2 w; w.x = pkbf(a0, a1); w.y = pkbf(a2, a3); *(GAS u32x2*)(yc + 8 * i4) = w;
        w.x = pkbf(b0, b1); w.y = pkbf(b2, b3); *(GAS u32x2*)(yc + 32 + 8 * i4) = w;
    }
    ssq = swap32_add(ssq, ssq);
    if (h == 0) ((float*)(ws + WS_YSSQ))[(size_t)t * 16 + 6 + hd] = ssq;
}
constexpr int CW_Q = 8192;
__device__ __forceinline__ void ph_mix(const Args& a, unsigned char* ws, LAS unsigned char* lds, int l, int qoff, int tid, int wave, int lane) {
    unsigned* head = (unsigned*)(ws + WS_CTL) + CW_Q + 64 * l + qoff;
    volatile LAS unsigned* slot = (volatile LAS unsigned*)(lds + MISC_OFF);
    for (int it = 0;; ++it) {
        if (tid == 0) slot[it & 1] = __hip_atomic_fetch_add(head, 1u, __ATOMIC_RELAXED, __HIP_MEMORY_SCOPE_AGENT);
        __syncthreads();
        const int n = (int)slot[it & 1];
        if (n >= 896) break;
        asm volatile("" : "+s"(ws), "+v"(tid));
        lane = tid & 63; wave = __builtin_amdgcn_readfirstlane(tid >> 6);
        if (n < 384) { const int qb = 15 - n / 24, bh = n % 24; sb_unit(ws, lds, bh / 6, bh % 6, qb, tid, wave, lane); }
        else if (n < 640) { const int m = n - 384; mem_unit(a, ws, lds, l, m >> 6, (m >> 4) & 3, m & 15, tid, wave, lane); }
        else ssd_chunk_unit(a, ws, lds, l, n - 640, tid, wave, lane);
    }
}

__device__ __forceinline__ unsigned f2o(float f) { const unsigned b = __float_as_uint(f); return b ^ ((unsigned)((int)b >> 31) | 0x80000000u); }
__device__ __forceinline__ float o2f(unsigned k) { return __uint_as_float(k ^ ((k & 0x80000000u) ? 0x80000000u : 0xffffffffu)); }
#define TK_CE(a, b) do { const unsigned _mx = (a) > (b) ? (a) : (b), _mn = (a) > (b) ? (b) : (a); (a) = _mx; (b) = _mn; } while (0)
template <int N, int BASE> __device__ __forceinline__ void tk_sort16(unsigned (&k)[N]) {
#pragma unroll
    for (int sz = 2; sz <= 16; sz <<= 1)
#pragma unroll
        for (int j = sz >> 1; j > 0; j >>= 1)
#pragma unroll
            for (int i = 0; i < 16; ++i) { const int l = i ^ j; if (l > i) { if ((i & sz) == 0) TK_CE(k[BASE + i], k[BASE + l]); else TK_CE(k[BASE + l], k[BASE + i]); } }
}
template <int NA, int A, int NB_, int B> __device__ __forceinline__ void tk_merge16(unsigned (&ka)[NA], const unsigned (&kb)[NB_]) {
#pragma unroll
    for (int i = 0; i < 16; ++i) ka[A + i] = ka[A + i] > kb[B + 15 - i] ? ka[A + i] : kb[B + 15 - i];
#pragma unroll
    for (int j = 8; j > 0; j >>= 1)
#pragma unroll
        for (int i = 0; i < 16; ++i) { const int l = i ^ j; if (l > i) TK_CE(ka[A + i], ka[A + l]); }
}
__device__ __forceinline__ unsigned partner32_u(unsigned a, bool hi) { const auto r = __builtin_amdgcn_permlane32_swap(a, a, false, false); return hi ? r[0] : r[1]; }
__device__ __forceinline__ void ph_topk(unsigned char* ws, LAS unsigned char* lds, int l, int gw, int NGW, int wave, int lane) {
    const bf16* qb = (const bf16*)(ws + WS_YCAT); const bf16* kb = (const bf16*)(ws + WS_KB) + (size_t)l * 16 * 128 * 64;
    int* eidx = (int*)(ws + WS_EIDX); float* gate = (float*)(ws + WS_GATE);
    LAS float* tr = (LAS float*)(lds + wave * WSCR);
    const int r = lane & 31, h = lane >> 5;
    for (int item = gw; item < (T / 32) * 8; item += NGW) {
        const int hd = item & 7, t = (item >> 3) * 32 + r;
        unsigned top[2][16];
#pragma unroll
        for (int c = 0; c < 2; ++c) {
            const int hc = 2 * hd + c;
            s16x8 qf[4];
#pragma unroll
            for (int ks = 0; ks < 4; ++ks) qf[ks] = *(const GAS s16x8*)(qb + (size_t)t * D + hc * 64 + ks * 16 + 8 * h);
            unsigned k[64];
#pragma unroll
            for (int nt = 0; nt < 4; ++nt) {
                f32x16 acc = zero16();
#pragma unroll
                for (int ks = 0; ks < 4; ++ks) acc = MFMA32(*(const GAS s16x8*)(kb + (size_t)(hc * 128 + nt * 32 + r) * 64 + ks * 16 + 8 * h), qf[ks], acc);
#pragma unroll
                for (int i = 0; i < 16; ++i) k[16 * nt + i] = (f2o(acc[i]) & ~127u) | (unsigned)((127 - 32 * nt - 8 * (i >> 2) - (i & 3)) - 4 * h);
            }
            tk_sort16<64, 0>(k); tk_sort16<64, 16>(k); tk_sort16<64, 32>(k); tk_sort16<64, 48>(k);
            tk_merge16<64, 0, 64, 16>(k, k); tk_merge16<64, 32, 64, 48>(k, k); tk_merge16<64, 0, 64, 32>(k, k);
            unsigned pk[16];
#pragma unroll
            for (int i = 0; i < 16; ++i) { top[c][i] = k[i]; pk[i] = partner32_u(k[i], h != 0); }
            tk_merge16<16, 0, 16, 0>(top[c], pk);
        }
        const int b = 0; (void)b;
        float av[16], bv[16];
#pragma unroll
        for (int i = 0; i < 16; ++i) { av[i] = o2f(top[0][i] & ~127u); bv[i] = o2f(top[1][i] & ~127u); }
        LAS int* li = (LAS int*)tr + lane * 32;
#pragma unroll
        for (int i = 0; i < 16; ++i) { li[i] = 127 - (int)(top[0][i] & 127u); li[16 + i] = 127 - (int)(top[1][i] & 127u); }
        unsigned key[64];
        key[0] = (f2o(av[0] + bv[0]) & ~255u) | 255u;
        key[1] = (f2o(av[0] + bv[1]) & ~255u) | 254u;
        key[2] = (f2o(av[0] + bv[2]) & ~255u) | 253u;
        key[3] = (f2o(av[0] + bv[3]) & ~255u) | 252u;
        key[4] = (f2o(av[0] + bv[4]) & ~255u) | 251u;
        key[5] = (f2o(av[0] + bv[5]) & ~255u) | 250u;
        key[6] = (f2o(av[0] + bv[6]) & ~255u) | 249u;
        key[7] = (f2o(av[0] + bv[7]) & ~255u) | 248u;
        key[8] = (f2o(av[0] + bv[8]) & ~255u) | 247u;
        key[9] = (f2o(av[0] + bv[9]) & ~255u) | 246u;
        key[10] = (f2o(av[0] + bv[10]) & ~255u) | 245u;
        key[11] = (f2o(av[0] + bv[11]) & ~255u) | 244u;
        key[12] = (f2o(av[0] + bv[12]) & ~255u) | 243u;
        key[13] = (f2o(av[0] + bv[13]) & ~255u) | 242u;
        key[14] = (f2o(av[0] + bv[14]) & ~255u) | 241u;
        key[15] = (f2o(av[0] + bv[15]) & ~255u) | 240u;
        key[16] = (f2o(av[1] + bv[0]) & ~255u) | 239u;
        key[17] = (f2o(av[1] + bv[1]) & ~255u) | 238u;
        key[18] = (f2o(av[1] + bv[2]) & ~255u) | 237u;
        key[19] = (f2o(av[1] + bv[3]) & ~255u) | 236u;
        key[20] = (f2o(av[1] + bv[4]) & ~255u) | 235u;
        key[21] = (f2o(av[1] + bv[5]) & ~255u) | 234u;
        key[22] = (f2o(av[1] + bv[6]) & ~255u) | 233u;
        key[23] = (f2o(av[1] + bv[7]) & ~255u) | 232u;
        key[24] = (f2o(av[2] + bv[0]) & ~255u) | 223u;
        key[25] = (f2o(av[2] + bv[1]) & ~255u) | 222u;
        key[26] = (f2o(av[2] + bv[2]) & ~255u) | 221u;
        key[27] = (f2o(av[2] + bv[3]) & ~255u) | 220u;
        key[28] = (f2o(av[2] + bv[4]) & ~255u) | 219u;
        key[29] = (f2o(av[3] + bv[0]) & ~255u) | 207u;
        key[30] = (f2o(av[3] + bv[1]) & ~255u) | 206u;
        key[31] = (f2o(av[3] + bv[2]) & ~255u) | 205u;
        key[32] = (f2o(av[3] + bv[3]) & ~255u) | 204u;
        key[33] = (f2o(av[4] + bv[0]) & ~255u) | 191u;
        key[34] = (f2o(av[4] + bv[1]) & ~255u) | 190u;
        key[35] = (f2o(av[4] + bv[2]) & ~255u) | 189u;
        key[36] = (f2o(av[5] + bv[0]) & ~255u) | 175u;
        key[37] = (f2o(av[5] + bv[1]) & ~255u) | 174u;
        key[38] = (f2o(av[6] + bv[0]) & ~255u) | 159u;
        key[39] = (f2o(av[6] + bv[1]) & ~255u) | 158u;
        key[40] = (f2o(av[7] + bv[0]) & ~255u) | 143u;
        key[41] = (f2o(av[7] + bv[1]) & ~255u) | 142u;
        key[42] = (f2o(av[8] + bv[0]) & ~255u) | 127u;
        key[43] = (f2o(av[9] + bv[0]) & ~255u) | 111u;
        key[44] = (f2o(av[10] + bv[0]) & ~255u) | 95u;
        key[45] = (f2o(av[11] + bv[0]) & ~255u) | 79u;
        key[46] = (f2o(av[12] + bv[0]) & ~255u) | 63u;
        key[47] = (f2o(av[13] + bv[0]) & ~255u) | 47u;
        key[48] = (f2o(av[14] + bv[0]) & ~255u) | 31u;
        key[49] = (f2o(av[15] + bv[0]) & ~255u) | 15u;
#pragma unroll
        for (int i = 50; i < 64; ++i) key[i] = 0u;
        tk_sort16<64, 0>(key); tk_sort16<64, 16>(key); tk_sort16<64, 32>(key); tk_sort16<64, 48>(key);
        tk_merge16<64, 0, 64, 16>(key, key); tk_merge16<64, 32, 64, 48>(key, key); tk_merge16<64, 0, 64, 32>(key, key);
        asm volatile("s_waitcnt lgkmcnt(0)" ::: "memory");
        const float s0 = o2f(key[0] & ~255u);
        float ev[16]; int ei[16]; float den = 0.f;
#pragma unroll
        for (int w = 0; w < 16; ++w) {
            const unsigned ij = 255u - (key[w] & 255u);
            ev[w] = __expf(o2f(key[w] & ~255u) - s0); den += ev[w];
            ei[w] = li[ij >> 4] * 128 + li[16 + (ij & 15)];
        }
        const float inv = 1.f / den;
        const size_t ob = ((size_t)t * 8 + hd) * 16;
        if (h == 0) {
#pragma unroll
            for (int q = 0; q < 4; ++q) {
                typedef int i32x4 __attribute__((ext_vector_type(4)));
                *(GAS i32x4*)(eidx + ob + 4 * q) = (i32x4){ei[4 * q], ei[4 * q + 1], ei[4 * q + 2], ei[4 * q + 3]};
                *(GAS f32x4*)(gate + ob + 4 * q) = (f32x4){ev[4 * q] * inv, ev[4 * q + 1] * inv, ev[4 * q + 2] * inv, ev[4 * q + 3] * inv};
            }
        }
        asm volatile("s_waitcnt lgkmcnt(0)" ::: "memory");
    }
}

__device__ __forceinline__ float gelu_erf(float v) { return 0.5f * v * (1.f + erff(v * 0.70710678118654752f)); }
typedef __attribute__((ext_vector_type(2))) float f32x2v;
constexpr int CW_Q2 = 12288;
__device__ __forceinline__ void cvt16(const v4u r, float (&f)[16]) {
    const unsigned w[4] = {r.x, r.y, r.z, r.w};
#pragma unroll
    for (int i = 0; i < 4; ++i) { const f32x2v lo = __builtin_amdgcn_cvt_pk_f32_fp8((int)w[i], false), hi = __builtin_amdgcn_cvt_pk_f32_fp8((int)w[i], true); f[4 * i] = lo.x; f[4 * i + 1] = lo.y; f[4 * i + 2] = hi.x; f[4 * i + 3] = hi.y; }
}
constexpr int PCH = 128, PTW = PCH / 8;
typedef __attribute__((ext_vector_type(4))) int i32x4;
struct PIdx { i32x4 e[4]; };
struct PTok { v4u r[16]; f32x4 w[4]; v4u xa, xc; };
template <int QSET> __device__ __forceinline__ void peer_idx(PIdx& I, const GAS int* eidx, int t, int lane) {
    const GAS i32x4* ep = (const GAS i32x4*)(eidx + (size_t)t * 128 + 16 * (lane >> 3));
#pragma unroll
    for (int q = 0; q < 4; ++q) I.e[q] = ep[q];
#if defined(MK_PROBE_EMASK)
    if (QSET == 1) {
#pragma unroll
        for (int q = 0; q < 4; ++q) I.e[q] = I.e[q] & MK_PROBE_EMASK;
    }
#endif
}
template <int PHASE> __device__ __forceinline__ void peer_rows(PTok& K, const PIdx& I, const GAS unsigned char* tab, const GAS float* wgt, const GAS bf16* xb, int t, int s, int lane) {
    const int g = lane >> 3, j = lane & 7;
#pragma unroll
    for (int i = 0; i < 16; ++i) K.r[i] = *(const GAS v4u*)(tab + (size_t)(unsigned)I.e[i >> 2][i & 3] * 128 + 16 * j);
    if (PHASE == 0) { const GAS unsigned char* xrow = (const GAS unsigned char*)(xb + (size_t)t * D + s * 128 + 16 * j); K.xa = *(const GAS v4u*)xrow; K.xc = *(const GAS v4u*)(xrow + 16); }
    else { const GAS f32x4* wp = (const GAS f32x4*)(wgt + (size_t)t * 128 + 16 * g);
#pragma unroll
        for (int q = 0; q < 4; ++q) K.w[q] = wp[q]; }
}
__device__ __forceinline__ void cvt16p(const v4u r, f32x2v (&f)[8]) {
    const unsigned w[4] = {r.x, r.y, r.z, r.w};
#pragma unroll
    for (int i = 0; i < 4; ++i) { f[2 * i] = __builtin_amdgcn_cvt_pk_f32_fp8((int)w[i], false); f[2 * i + 1] = __builtin_amdgcn_cvt_pk_f32_fp8((int)w[i], true); }
}
__device__ __forceinline__ void peer_u_compute(const PTok& K, LAS float* lpart, int lane) {
    const int g = lane >> 3, j = lane & 7;
    f32x2v xv[8];
    { const unsigned xw[8] = {K.xa.x, K.xa.y, K.xa.z, K.xa.w, K.xc.x, K.xc.y, K.xc.z, K.xc.w};
#pragma unroll
      for (int i = 0; i < 8; ++i) xv[i] = (f32x2v){__uint_as_float(xw[i] << 16), __uint_as_float(xw[i] & 0xffff0000u)}; }
    float res_lo = 0.f, res_hi = 0.f;
#pragma unroll
    for (int i = 0; i < 16; ++i) {
        f32x2v f[8]; cvt16p(K.r[i], f);
        f32x2v a0 = xv[0] * f[0], a1 = xv[1] * f[1];
#pragma unroll
        for (int k = 2; k < 8; k += 2) { a0 = a0 + xv[k] * f[k]; a1 = a1 + xv[k + 1] * f[k + 1]; }
        const f32x2v a = a0 + a1;
        const float d = sum8(a.x + a.y);
        if (i < 8) res_lo = (j == i) ? d : res_lo; else res_hi = (j == i - 8) ? d : res_hi;
    }
    lpart[16 * g + j] = res_lo; lpart[16 * g + 8 + j] = res_hi;
}
__device__ __forceinline__ void peer_v_compute(const PTok& K, LAS float* lout, int lane) {
    const int g = lane >> 3, j = lane & 7;
    f32x2v acc[8];
#pragma unroll
    for (int k = 0; k < 8; ++k) acc[k] = (f32x2v){0.f, 0.f};
#pragma unroll
    for (int i = 0; i < 16; ++i) {
        f32x2v f[8]; cvt16p(K.r[i], f);
        const float wi = K.w[i >> 2][i & 3]; const f32x2v w2 = {wi, wi};
#pragma unroll
        for (int k = 0; k < 8; ++k) acc[k] = acc[k] + w2 * f[k];
    }
    float o[16];
#pragma unroll
    for (int k = 0; k < 8; ++k) {
        float a = acc[k].x, b = acc[k].y;
        a += dpp_f<0x128>(a); b += dpp_f<0x128>(b); a = swap16_add(a, a); b = swap16_add(b, b); o[2 * k] = swap32_add(a, a); o[2 * k + 1] = swap32_add(b, b);
    }
    if (g == 0) {
#pragma unroll
        for (int q = 0; q < 4; ++q) *(LAS f32x4*)(lout + 16 * j + 4 * q) = (f32x4){o[4 * q], o[4 * q + 1], o[4 * q + 2], o[4 * q + 3]};
    }
}
template <int PHASE, int QSET = 0> __device__ __forceinline__ void ph_peer_sliced(unsigned char* ws, LAS unsigned char* lds, float* xout, int l, int tid, int wave, int lane) {
    unsigned* heads = (unsigned*)(ws + WS_CTL) + CW_Q2 + ((QSET * 2 + l) * 2 + PHASE) * 8 * 64;
    volatile LAS unsigned* slot = (volatile LAS unsigned*)(lds + MISC_OFF);
    const GAS int* eidx = (const GAS int*)(ws + WS_EIDX); const GAS float* wgt = (const GAS float*)(ws + WS_GATE); GAS bf16* xb = (GAS bf16*)(ws + WS_XB);
    const int myx = (int)(xb_xcc_id() & 7u);
    int it = 0;
    for (int k = 0; k < 8; ++k) {
        const int s = (myx + k) & 7;
        const GAS unsigned char* tab = (const GAS unsigned char*)(ws + (PHASE == 0 ? WS_UT : WS_VT) + (size_t)l * 16384 * D + (size_t)s * 16384 * 128);
        GAS float* part = (GAS float*)(ws + WS_PART) + (size_t)s * T * 128;
        for (;; ++it) {
            if (tid == 0) slot[it & 1] = __hip_atomic_fetch_add(heads + 64 * s, 1u, __ATOMIC_RELAXED, __HIP_MEMORY_SCOPE_AGENT);
            __syncthreads();
            const int c = (int)slot[it & 1];
            if (c >= T / PCH) { ++it; break; }
            const int t0 = c * PCH + wave * PTW;
            LAS float* stg = (LAS float*)(lds + wave * WSCR);
            PIdx iB, iC; PTok A, B;
            peer_idx<QSET>(iB, eidx, t0, lane);
            peer_rows<PHASE>(A, iB, tab, wgt, xb, t0, s, lane);
            peer_idx<QSET>(iB, eidx, t0 + 1, lane);
#pragma unroll 2
            for (int i = 0; i < PTW; ++i) {
                peer_idx<QSET>(iC, eidx, t0 + (i + 2 < PTW ? i + 2 : PTW - 1), lane);
                peer_rows<PHASE>(B, iB, tab, wgt, xb, t0 + (i + 1 < PTW ? i + 1 : PTW - 1), s, lane);
                if (PHASE == 0) peer_u_compute(A, stg + i * 128, lane); else peer_v_compute(A, stg + i * 128, lane);
                A = B; iB = iC;
            }
            asm volatile("s_waitcnt lgkmcnt(0)" ::: "memory");
            if (PHASE == 0) {
#pragma unroll
                for (int q = 0; q < PTW * 128 / 256; ++q) *(GAS f32x4*)(part + (size_t)t0 * 128 + q * 256 + lane * 4) = *(const LAS f32x4*)(stg + q * 256 + lane * 4);
            } else {
                GAS float* xo = (GAS float*)xout; GAS float* rs1p = (GAS float*)(ws + WS_RS1P);
#pragma unroll 4
                for (int q = 0; q < PTW / 2; ++q) {
                    const int tk = 2 * q + (lane >> 5), cq = lane & 31, t = t0 + tk;
                    GAS float* xr = xo + (size_t)t * D + s * 128 + 4 * cq;
                    const f32x4 av = *(const LAS f32x4*)(stg + tk * 128 + 4 * cq); f32x4 xv = *(const GAS f32x4*)xr;
                    xv = xv + av;
                    *(GAS f32x4*)xr = xv;
                    u32x2 w; w.x = pkbf(xv.x, xv.y); w.y = pkbf(xv.z, xv.w); *(GAS u32x2*)(xb + (size_t)t * D + s * 128 + 4 * cq) = w;
                    float s2 = (xv.x * xv.x + xv.y * xv.y) + (xv.z * xv.z + xv.w * xv.w);
                    s2 = sum16(s2); s2 = swap16_add(s2, s2);
                    if (cq == 0) rs1p[(size_t)t * 8 + s] = s2;
                }
            }
            asm volatile("s_waitcnt lgkmcnt(0)" ::: "memory");
        }
    }
}
__device__ __forceinline__ void ph_peer_w(unsigned char* ws, int l, int gw, int NGW, int lane) {
    const GAS int* eidx = (const GAS int*)(ws + WS_EIDX); GAS float* gate = (GAS float*)(ws + WS_GATE); const GAS float* part = (const GAS float*)(ws + WS_PART);
    const GAS float* usc = (const GAS float*)(ws + WS_USC) + l * 16384; const GAS float* vsc = (const GAS float*)(ws + WS_VSC) + l * 16384; const GAS float* xssq = (const GAS float*)(ws + WS_XSSQ);
    for (int t = gw; t < T; t += NGW) {
        const float r2 = rsqrtf(sum16(xssq[(size_t)t * 16 + (lane & 15)]) * (1.f / 1024.f) + EPS);
#pragma unroll
        for (int hh = 0; hh < 2; ++hh) {
            const size_t q = (size_t)t * 128 + 64 * hh + lane;
            float a = 0.f;
#pragma unroll
            for (int s = 0; s < 8; ++s) a += part[(size_t)s * T * 128 + q];
            const int e = eidx[q];
            gate[q] = gate[q] * gelu_erf(a * (r2 * usc[e])) * vsc[e];
        }
    }
}

constexpr int NPH_L = 10, NPHASES = 1 + NL * NPH_L;
#ifndef MK_PHMASK
#define MK_PHMASK 0x7ff
#endif
#define PH_ON(j) ((MK_PHMASK >> (j)) & 1)
#ifndef MK_REP
#define MK_REP 0
#endif
#define PH_REP(j) ((MK_REP >> (j)) & 1)
__global__ void __launch_bounds__(NWAVES * 64, 2) mega(Args a) {
    extern __shared__ __attribute__((aligned(16))) unsigned char lds_raw[];
    {
        LAS unsigned char* lds0 = (LAS unsigned char*)lds_raw;
        for (int u = threadIdx.x; u < (LDS_BYTES - LDSCTL_OFF) / 4; u += NWAVES * 64) ((LAS unsigned*)(lds0 + LDSCTL_OFF))[u] = 0u;
        __syncthreads();
    }
    int wave0 = __builtin_amdgcn_readfirstlane((int)threadIdx.x >> 6); asm volatile("" : "+s"(wave0));
    int ph_lo = a.ph_lo, ph_hi = a.ph_hi; asm volatile("" : "+s"(ph_lo), "+s"(ph_hi));
    const bool multi = (ph_hi - ph_lo) > 1;
    XcdBarrier bar; bar.bar = (unsigned*)(a.ws + WS_CTL) + CW_BAR + a.li * XCD_BAR_WORDS; bar.x = 0; bar.st = nullptr;
    if (multi) bar = xcd_barrier_post((unsigned*)(a.ws + WS_CTL) + CW_BAR + a.li * XCD_BAR_WORDS, (volatile LAS unsigned*)((LAS unsigned char*)lds_raw + MISC_OFF) + 8);

#if defined(MK_UBENCH)
    {
        unsigned v0 = threadIdx.x * 2654435761u, v1 = v0 ^ 0x3c3c3c3cu; float f0 = 1.0f + (float)(threadIdx.x & 7), f1 = 2.0f; unsigned long long pp = v0, qq = v1;
        for (int it = 0; it < 2500; ++it) {
#pragma unroll
            for (int k = 0; k < 8; ++k) {
#if MK_UBENCH == 1
                asm volatile("v_cvt_pk_f32_fp8 %0, %1\n" : "=v"(pp) : "v"(v0));
#elif MK_UBENCH == 2
                asm volatile("v_cvt_pk_f32_fp8_sdwa %0, %1 src0_sel:WORD_1\n" : "=v"(pp) : "v"(v0));
#elif MK_UBENCH == 3
                asm volatile("v_cvt_pk_fp8_f32 %0, %1, %2\n" : "+v"(v0) : "v"(f0), "v"(f1));
#elif MK_UBENCH == 4
                asm volatile("v_fma_f32 %0, %1, %2, %0\n" : "+v"(f0) : "v"(f1), "v"(f1));
#elif MK_UBENCH == 5
                asm volatile("ds_bpermute_b32 %0, %1, %0\n s_waitcnt lgkmcnt(0)\n" : "+v"(v0) : "v"(v1));
#elif MK_UBENCH == 7
                { typedef __attribute__((ext_vector_type(8))) int i32x8b; i32x8b aa = {(int)v0, (int)v1, (int)v0, (int)v1, (int)v0, (int)v1, (int)v0, (int)v1};
                  f32x4 cc = {f0, f1, f0, f1}; cc = __builtin_amdgcn_mfma_scale_f32_16x16x128_f8f6f4(aa, aa, cc, 0, 0, 0, 0x7f7f7f7f, 0, 0x7f7f7f7f); f0 = cc[0]; f1 = cc[1]; asm volatile("" : "+v"(f0), "+v"(f1)); }
#elif MK_UBENCH == 6
                asm volatile("v_pk_fma_f32 %0, %1, %1, %0\n" : "+v"(pp) : "v"(qq));
#endif
            }
        }
        if (f0 == 1.2345e30f && v0 == 0x12345u && pp == 77ull && qq == 78ull) a.out[0] = f0;
    }
#endif
    for (int ph = ph_lo; ph < ph_hi; ++ph) {
        unsigned char* ws = a.ws; asm volatile("" : "+s"(ws));
        int G = (int)gridDim.x; asm volatile("" : "+s"(G));
        int bx = (int)blockIdx.x; asm volatile("" : "+s"(bx));
        int tid; asm volatile("v_mbcnt_lo_u32_b32 %0, -1, 0\n\tv_mbcnt_hi_u32_b32 %0, -1, %0" : "=v"(tid)); tid |= wave0 << 6;
        LAS unsigned char* lds = (LAS unsigned char*)lds_raw;
        const int lane = tid & 63, wave = __builtin_amdgcn_readfirstlane(tid >> 6);
        const int vcu = (G % 8 == 0) ? (bx % 8) * (G / 8) + bx / 8 : bx;
        const int gw = vcu * NWAVES + wave, NGW = G * NWAVES;
        if (ph == 0) {
            if (PH_ON(10)) for (int rep = 0; rep < 1 + PH_REP(10); ++rep) ph_prologue(a, ws, lds, gw, NGW, wave, lane);
        } else {
            const int l = (ph - 1) / NPH_L, j = (ph - 1) % NPH_L;
            if (j == 0 && PH_ON(0)) {
              for (int rep = 0; rep < 1 + PH_REP(0); ++rep) {
                { pg8::Gemm g{(const pg8::bf16_t*)(ws + WS_XB), (const pg8::bf16_t*)(ws + WS_WIN) + (size_t)l * NPROJ * D, T, NPROJ, D};
                  pg8::StaticOrder So; So.init(T, NPROJ, G, bx);
                  pg8::EpiInProj E{(pg8::bf16_t*)(ws + WS_PROJ), NPROJ, (const float*)(ws + WS_RS1P), (float*)(ws + WS_DTF), AIN(I_DTBIAS) + l * 6, 8};
                  pg8::gemm_phase<pg8::EpiInProj, pg8::StaticOrder, true, true>(lds, g, So, E, tid); }
                { pg8::Gemm g{(const pg8::bf16_t*)(ws + WS_MEMB), (const pg8::bf16_t*)(ws + WS_WMEM) + (size_t)l * 512 * D, MROWS, 512, D};
                  pg8::StaticOrder So; So.init(MROWS, 512, G, bx);
                  pg8::EpiInProj E{(pg8::bf16_t*)(ws + WS_MEMKV), 512, (const float*)(ws + WS_RSM), nullptr, nullptr, 0};
                  pg8::gemm_phase<pg8::EpiInProj, pg8::StaticOrder, true, true>(lds, g, So, E, tid); }
              }
            } else if (j == 1 && PH_ON(1)) {
                for (int rep = 0; rep < 1 + PH_REP(1); ++rep) { ph_mix(a, ws, lds, l, 32 * rep, tid, wave, lane); __syncthreads(); }
            } else if (j == 2 && PH_ON(2)) {
                ph_ssd_scan(ws, bx, G, tid);
            } else if (j == 3 && PH_ON(3)) {
                for (int rep = 0; rep < 1 + PH_REP(3); ++rep) for (int u = vcu; u < 256; u += G) ssd_finish_unit(a, ws, l, u, wave, lane);
            } else if (j == 4 && PH_ON(4)) {
                pg8::Gemm g{(const pg8::bf16_t*)(ws + WS_YCAT), (const pg8::bf16_t*)(ws + WS_WOUT) + (size_t)l * D * D, T, D, D};
                pg8::StaticOrder So; So.init(T, D, G, bx);
                LAS float* gtab = (LAS float*)(lds + GTAB_OFF);
                { pg8::Unit u0; if (So.next(0, u0) && tid < 256) { float r0, r1, r2; pg8::group_rstd((const float*)(ws + WS_YSSQ), u0.pm * 256 + tid, r0, r1, r2); gtab[tid] = r0 / r1; gtab[256 + tid] = r1 / r2; gtab[512 + tid] = r2; } }
                __syncthreads();
                pg8::EpiOut E{l == 0 ? AIN(I_X) : a.out, a.out, (pg8::bf16_t*)(ws + WS_XB), (float*)(ws + WS_XSSQ), gtab};
                pg8::gemm_phase<pg8::EpiOut, pg8::StaticOrder, true, true>(lds, g, So, E, tid);
            } else if (j == 5 && PH_ON(5)) {
                pg8::Gemm g{(const pg8::bf16_t*)(ws + WS_XB), (const pg8::bf16_t*)(ws + WS_WSC) + (size_t)l * D * D, T, D, D};
                pg8::StaticOrder So; So.init(T, D, G, bx);
                pg8::EpiInProj E{(pg8::bf16_t*)(ws + WS_YCAT), D, (const float*)(ws + WS_XSSQ), nullptr, nullptr, 16};
                for (int rep = 0; rep < 1 + PH_REP(5); ++rep) pg8::gemm_phase<pg8::EpiInProj, pg8::StaticOrder, true, true>(lds, g, So, E, tid);
            } else if (j == 6 && PH_ON(6)) {
                for (int rep = 0; rep < 1 + PH_REP(6); ++rep) ph_topk(ws, lds, l, gw, NGW, wave, lane);
            } else if (j == 7 && PH_ON(7)) {
                ph_peer_sliced<0>(ws, lds, a.out, l, tid, wave, lane);
#if MK_REP & 0x80
                __syncthreads(); ph_peer_sliced<0, 1>(ws, lds, a.out, l, tid, wave, lane);
#endif
            } else if (j == 8 && PH_ON(8)) {
                ph_peer_w(ws, l, gw, NGW, lane);
            } else if (j == 9 && PH_ON(9)) {
                ph_peer_sliced<1>(ws, lds, a.out, l, tid, wave, lane);
            }
        }
        if (ph + 1 < ph_hi) { XcdBarrier b2 = bar; { unsigned* p = b2.bar; unsigned x = b2.x; asm volatile("" : "+s"(p), "+s"(x)); b2.bar = p; b2.x = x; } xcd_barrier(b2, tid); }
    }
}

#ifndef MK_ONE_LAUNCH
#define MK_ONE_LAUNCH 1
#endif
extern "C" void kernel_launch(void* const* d_in, const int* in_sizes, int n_in, void* d_out, int out_size, void* d_ws, size_t ws_size, hipStream_t stream) {
    static int grid = 0;
    if (grid == 0) {
        if (n_in != 22 || out_size != T * D || ws_size < WS_END) { fprintf(stderr, "kernel_launch: unexpected problem (n_in %d out %d ws %zu)\n", n_in, out_size, ws_size); grid = -1; return; }
        int dev = 0, cus = 0, per_cu = 0;
        if (hipGetDevice(&dev) != hipSuccess || hipDeviceGetAttribute(&cus, hipDeviceAttributeMultiprocessorCount, dev) != hipSuccess) { grid = -1; return; }
        if (hipFuncSetAttribute((const void*)mega, hipFuncAttributeMaxDynamicSharedMemorySize, LDS_BYTES) != hipSuccess) { fprintf(stderr, "kernel_launch: hipFuncSetAttribute failed\n"); grid = -1; return; }
        if (hipOccupancyMaxActiveBlocksPerMultiprocessor(&per_cu, (const void*)mega, NWAVES * 64, LDS_BYTES) != hipSuccess || per_cu < 1) { fprintf(stderr, "kernel_launch: occupancy query says %d\n", per_cu); (void)hipGetLastError(); per_cu = 1; }
        grid = cus;
    }
    if (grid < 0) return;
    (void)hipMemsetAsync((char*)d_ws + WS_CTL, 0, CTL_ZERO_BYTES, stream);
    Args a{};
    for (int i = 0; i < 22; ++i) a.in[i] = (const float*)d_in[i];
    a.out = (float*)d_out; a.ws = (unsigned char*)d_ws;
#if MK_ONE_LAUNCH
    a.ph_lo = 0; a.ph_hi = NPHASES; a.li = 0;
    hipLaunchKernelGGL(mega, dim3(grid), dim3(NWAVES * 64), LDS_BYTES, stream, a);
#else
    for (int ph = 0; ph < NPHASES; ++ph) { a.ph_lo = ph; a.ph_hi = ph + 1; a.li = 0; hipLaunchKernelGGL(mega, dim3(grid), dim3(NWAVES * 64), LDS_BYTES, stream, a); }
#endif
}
```

```cpp
#include <hip/hip_runtime.h>
#include <cstdio>
#include <cstdint>
#include <cmath>
namespace pg8 {
#define PG8_LAS __attribute__((address_space(3)))
typedef unsigned short bf16_t;
typedef short bf16x8 __attribute__((ext_vector_type(8)));
typedef float f32x4 __attribute__((ext_vector_type(4)));
typedef unsigned u32x4 __attribute__((ext_vector_type(4)));
constexpr int BM = 256, BK = 64, HALF = 128, HTB = HALF * BK * 2  , STAGE_BYTES = 8 * HTB, NXCD = 8, WGM = 8;

__host__ __device__ __forceinline__ int lds_byte(int r, int c) { const int st = (r >> 4) * 2 + (c >> 5), rr = r & 15, cc = c & 31, ob = rr * 64 + cc * 2; return st * 1024 + (ob ^ (((ob >> 9) & 1) << 5)); }
__host__ __device__ __forceinline__ void stage_rc(int b, int& R, int& C) { const int st = b / 1024, sb = b % 1024, swz = sb ^ (((sb >> 9) & 1) << 5); R = (st >> 1) * 16 + swz / 64; C = (st & 1) * 32 + (swz % 64) / 2; }
__host__ __device__ __forceinline__ int perm32(int rho) { const int n = rho >> 4, i = rho & 15; return 8 * (i >> 2) + 4 * n + (i & 3); }

struct Unit { int pm, pn; };
struct Gemm { const bf16_t* A; const bf16_t* Bt; int M, N, K; };

struct StaticOrder {
    int nM, nN, nwg, G, c;
    __host__ __device__ void init(int M, int N, int G_, int c_) { nM = M / BM; nN = N / BM; nwg = nM * nN; G = G_; c = c_; }
    __host__ __device__ bool next(int i, Unit& u) const {
        const long L = (long)i * G + c; if (L >= nwg) return false;
        int wgid = (int)L; { const int q = nwg / NXCD, r = nwg % NXCD, xcd = wgid % NXCD, off = wgid / NXCD; wgid = (xcd < r ? xcd * (q + 1) : r * (q + 1) + (xcd - r) * q) + off; }
        const int nig = WGM * nN, gid = wgid / nig, fm = gid * WGM, gsz = (nM - fm) < WGM ? (nM - fm) : WGM;
        u.pm = fm + ((wgid % nig) % gsz); u.pn = (wgid % nig) / gsz; return true;
    }
    __device__ __forceinline__ void a_ready(const Unit&) const {}
    __device__ __forceinline__ void done(const Unit&) const {}
};

__device__ __forceinline__ unsigned cvt_pk_bf16(float lo, float hi) { unsigned r; asm volatile("v_cvt_pk_bf16_f32 %0, %1, %2" : "=v"(r) : "v"(lo), "v"(hi)); return r; }
template <class Epi, class Sched, bool ALIGN_EPI = false, bool SP2 = false>
__device__ __forceinline__ void gemm_phase(PG8_LAS unsigned char* lds, const Gemm g, const Sched& S, const Epi& E, const int tid_in) {
    int tid_ = tid_in; asm volatile("" : "+v"(tid_));
    const int tid = tid_, wid = __builtin_amdgcn_readfirstlane(tid >> 6), lane = tid & 63, wr = wid >> 2, wc = wid & 3, fr = lane & 15, fq = lane >> 4;
    const int K = g.K, nt = K / BK;
    unsigned voffA[2], voffB[2];
#pragma unroll
    for (int i = 0; i < 2; ++i) { int R, C; stage_rc(tid * 16 + i * 8192, R, C); const int Rb = Epi::PERM ? ((R & ~31) + perm32(R & 31)) : R;
        voffA[i] = (unsigned)(R * K + C) * 2u; voffB[i] = (unsigned)(Rb * K + C) * 2u; }
    const size_t kstep = (size_t)(BK * 2);
    const size_t hstep = (size_t)HALF * K * 2;
    const size_t tstep = 2 * hstep;
    const unsigned ldsw = (unsigned)wid * 1024u;
    const int aoff = lds_byte(wr * 64 + fr, fq * 8), boff = lds_byte(wc * 32 + fr, fq * 8);
#define PG8_SA(b, h) (((b) * 2 + (h)) * HTB)
#define PG8_SB(b, h) ((4 + (b) * 2 + (h)) * HTB)
#define PG8_STAGE(bufoff, gbase, voff) do { _Pragma("unroll") for (int _i = 0; _i < 2; ++_i) \
        __builtin_amdgcn_global_load_lds((const unsigned*)((const char*)(gbase) + (voff)[_i]), (PG8_LAS unsigned*)(lds + (bufoff) + ldsw + _i * 8192), 16, 0, 0); } while (0)
#define PG8_LDA(dst, b, h) do { _Pragma("unroll") for (int m = 0; m < 4; ++m) _Pragma("unroll") for (int k = 0; k < 2; ++k) dst[m][k] = *(const PG8_LAS bf16x8*)(lds + PG8_SA(b, h) + aoff + m * 2048 + k * 1024); } while (0)
#define PG8_LDB(dst, b, h) do { _Pragma("unroll") for (int n = 0; n < 2; ++n) _Pragma("unroll") for (int k = 0; k < 2; ++k) dst[n][k] = *(const PG8_LAS bf16x8*)(lds + PG8_SB(b, h) + boff + n * 2048 + k * 1024); } while (0)
#define PG8_MMA(ai, bj, At, Bt) do { __builtin_amdgcn_s_setprio(1); _Pragma("unroll") for (int m = 0; m < 4; ++m) _Pragma("unroll") for (int n = 0; n < 2; ++n) _Pragma("unroll") for (int k = 0; k < 2; ++k) \
        acc[ai][bj][m][n] = __builtin_amdgcn_mfma_f32_16x16x32_bf16(Bt[n][k], At[m][k], acc[ai][bj][m][n], 0, 0, 0); __builtin_amdgcn_s_setprio(0); } while (0)
#define PG8_WAIT_V(n) asm volatile("s_waitcnt vmcnt(" #n ")" ::: "memory")
#define PG8_WAIT_L(n) asm volatile("s_waitcnt lgkmcnt(" #n ")" ::: "memory")
#define PG8_BAR __builtin_amdgcn_s_barrier()
#define PG8_SCHED __builtin_amdgcn_sched_barrier(0)
    Unit cur, nxt; int ui = 0;
    if (!S.next(0, cur)) return;
    f32x4 acc[2][2][4][2];
#pragma unroll
    for (int a = 0; a < 2; ++a)
#pragma unroll
        for (int b = 0; b < 2; ++b)
#pragma unroll
            for (int m = 0; m < 4; ++m)
#pragma unroll
                for (int n = 0; n < 2; ++n) acc[a][b][m][n] = (f32x4){0.f, 0.f, 0.f, 0.f};
    bf16x8 At[4][2], B0[2][2], B1[2][2];
    const char* cA = (const char*)g.A + (size_t)cur.pm * tstep; const char* cB = (const char*)g.Bt + (size_t)cur.pn * tstep;
    S.a_ready(cur);
    if constexpr (SP2) {
        PG8_STAGE(PG8_SB(0, 0), cB, voffB); PG8_STAGE(PG8_SB(0, 1), cB + hstep, voffB); PG8_STAGE(PG8_SA(0, 0), cA, voffA); PG8_STAGE(PG8_SA(0, 1), cA + hstep, voffA);
        if (wr == 1) PG8_BAR;
        PG8_WAIT_V(2); PG8_BAR;
        PG8_STAGE(PG8_SB(1, 0), cB + kstep, voffB); PG8_STAGE(PG8_SA(1, 0), cA + kstep, voffA); PG8_STAGE(PG8_SB(1, 1), cB + hstep + kstep, voffB);
        PG8_WAIT_V(6); PG8_BAR;
    } else {
        PG8_STAGE(PG8_SB(0, 0), cB, voffB); PG8_STAGE(PG8_SA(0, 0), cA, voffA); PG8_STAGE(PG8_SB(0, 1), cB + hstep, voffB); PG8_STAGE(PG8_SA(0, 1), cA + hstep, voffA);
        if (wr == 1) PG8_BAR;
        PG8_WAIT_V(4); PG8_BAR;
        PG8_STAGE(PG8_SB(1, 0), cB + kstep, voffB); PG8_STAGE(PG8_SA(1, 0), cA + kstep, voffA); PG8_STAGE(PG8_SB(1, 1), cB + hstep + kstep, voffB);
        PG8_WAIT_V(6); PG8_BAR;
    }
    for (;;) {
        const bool has_next = S.next(ui + 1, nxt);
        const char* nA = has_next ? (const char*)g.A + (size_t)nxt.pm * tstep : cA; const char* nB = has_next ? (const char*)g.Bt + (size_t)nxt.pn * tstep : cB;
        for (int t = 0; t < nt; t += 2) {
            const bool last = (t == nt - 2);
            const char* a1 = cA + (size_t)(t + 1) * kstep;
            const char* a2 = last ? nA : cA + (size_t)(t + 2) * kstep; const char* b2 = last ? nB : cB + (size_t)(t + 2) * kstep;
            const char* a3 = a2 + kstep; const char* b3 = b2 + kstep;
            if (last && has_next) S.a_ready(nxt);
            if constexpr (Epi::KHOOK) E.khook(acc, cur, t, wr, fr);
            if constexpr (SP2) {
            PG8_LDB(B0, 0, 0); PG8_LDB(B1, 0, 1); PG8_SCHED; PG8_LDA(At, 0, 0); PG8_STAGE(PG8_SA(1, 1), a1 + hstep, voffA);
            PG8_WAIT_V(8); PG8_WAIT_L(0); PG8_BAR; PG8_MMA(0, 0, At, B0); PG8_MMA(0, 1, At, B1); PG8_BAR; PG8_SCHED;
            PG8_LDA(At, 0, 1); PG8_STAGE(PG8_SB(0, 0), b2, voffB); PG8_STAGE(PG8_SB(0, 1), b2 + hstep, voffB); PG8_STAGE(PG8_SA(0, 0), a2, voffA);
            PG8_WAIT_V(8); PG8_WAIT_L(0); PG8_BAR; PG8_MMA(1, 0, At, B0); PG8_MMA(1, 1, At, B1); PG8_BAR; PG8_SCHED;
            PG8_LDB(B0, 1, 0); PG8_LDB(B1, 1, 1); PG8_SCHED; PG8_LDA(At, 1, 0); PG8_STAGE(PG8_SA(0, 1), a2 + hstep, voffA);
            PG8_WAIT_V(8); PG8_WAIT_L(0); PG8_BAR; PG8_MMA(0, 0, At, B0); PG8_MMA(0, 1, At, B1); PG8_BAR; PG8_SCHED;
            PG8_LDA(At, 1, 1); PG8_STAGE(PG8_SB(1, 0), b3, voffB); PG8_STAGE(PG8_SB(1, 1), b3 + hstep, voffB); PG8_STAGE(PG8_SA(1, 0), a3, voffA);
            PG8_WAIT_V(8); PG8_WAIT_L(0); PG8_BAR; PG8_MMA(1, 0, At, B0); PG8_MMA(1, 1, At, B1); PG8_BAR; PG8_SCHED;
            } else {
            PG8_LDB(B0, 0, 0); PG8_SCHED; PG8_LDA(At, 0, 0); PG8_STAGE(PG8_SA(1, 1), a1 + hstep, voffA);
            PG8_WAIT_L(8); PG8_BAR; PG8_WAIT_L(0); PG8_MMA(0, 0, At, B0); PG8_BAR; PG8_SCHED;
            PG8_LDB(B1, 0, 1); PG8_STAGE(PG8_SB(0, 0), b2, voffB);
            PG8_BAR; PG8_WAIT_L(0); PG8_MMA(0, 1, At, B1); PG8_BAR;
            PG8_LDA(At, 0, 1); PG8_STAGE(PG8_SA(0, 0), a2, voffA);
            PG8_BAR; PG8_WAIT_L(0); PG8_MMA(1, 0, At, B0); PG8_BAR; PG8_SCHED;
            PG8_STAGE(PG8_SB(0, 1), b2 + hstep, voffB);
            PG8_WAIT_V(6); PG8_BAR; PG8_MMA(1, 1, At, B1); PG8_BAR;
            PG8_LDB(B0, 1, 0); PG8_SCHED; PG8_LDA(At, 1, 0); PG8_STAGE(PG8_SA(0, 1), a2 + hstep, voffA);
            PG8_WAIT_L(8); PG8_BAR; PG8_WAIT_L(0); PG8_MMA(0, 0, At, B0); PG8_BAR; PG8_SCHED;
            PG8_LDB(B1, 1, 1); PG8_STAGE(PG8_SB(1, 0), b3, voffB);
            PG8_BAR; PG8_WAIT_L(0); PG8_MMA(0, 1, At, B1); PG8_BAR;
            PG8_LDA(At, 1, 1); PG8_STAGE(PG8_SA(1, 0), a3, voffA);
            PG8_BAR; PG8_WAIT_L(0); PG8_MMA(1, 0, At, B0); PG8_BAR; PG8_SCHED;
            PG8_STAGE(PG8_SB(1, 1), b3 + hstep, voffB);
            PG8_WAIT_V(6); PG8_BAR; PG8_MMA(1, 1, At, B1); PG8_BAR;
            }
        }
        if constexpr (ALIGN_EPI) { if (wr == 0) PG8_BAR; }
        if constexpr (!Epi::AFTER_DRAIN) { E(acc, cur, wr, wc, fr, fq); S.done(cur); }
        if (!has_next) break;
#pragma unroll
        for (int a = 0; a < 2; ++a)
#pragma unroll
            for (int b = 0; b < 2; ++b)
#pragma unroll
                for (int m = 0; m < 4; ++m)
#pragma unroll
                    for (int n = 0; n < 2; ++n) acc[a][b][m][n] = (f32x4){0.f, 0.f, 0.f, 0.f};
        cur = nxt; cA = nA; cB = nB; ++ui;
        if constexpr (ALIGN_EPI) { if (wr == 1) PG8_BAR; }
    }
    PG8_WAIT_V(0);
    if constexpr (!ALIGN_EPI) { if (wr == 0) PG8_BAR; }
    PG8_BAR;
    if constexpr (Epi::AFTER_DRAIN) { E.fused(acc, cur, wr, wc, fr, fq, lds, wid, lane); S.done(cur); }
#undef PG8_SA
#undef PG8_SB
#undef PG8_STAGE
#undef PG8_LDA
#undef PG8_LDB
#undef PG8_MMA
#undef PG8_WAIT_V
#undef PG8_WAIT_L
#undef PG8_BAR
#undef PG8_SCHED
}
}
#define GAS __attribute__((address_space(1)))
#define LAS __attribute__((address_space(3)))
typedef unsigned short bf16;
typedef unsigned v4u __attribute__((ext_vector_type(4)));
typedef float f32x4 __attribute__((ext_vector_type(4)));
typedef short bf16x8 __attribute__((ext_vector_type(8)));
typedef GAS unsigned gu32;
typedef GAS unsigned long long gu64;
#define RLX_AGENT __ATOMIC_RELAXED, __HIP_MEMORY_SCOPE_AGENT
#define LDS_WAIT() asm volatile("s_waitcnt lgkmcnt(0)" ::: "memory")
#define VM_WAIT() asm volatile("s_waitcnt vmcnt(0)" ::: "memory")
__device__ __forceinline__ unsigned long long rt() { return __builtin_amdgcn_s_memrealtime(); }
__device__ __forceinline__ unsigned f2bf(float f) { unsigned u = __builtin_bit_cast(unsigned, f); return (u + 0x7fffu + ((u >> 16) & 1u)) >> 16; }
__device__ __forceinline__ unsigned pk2(float lo, float hi) { return f2bf(lo) | (f2bf(hi) << 16); }

#define XB_TMO      128
#define XB_XCNT(j)  (256  + 64 * (j))
#define XB_XSUB(j)  (1280 + 64 * (j))
#define XB_XGEN(j)  (2304 + 64 * (j))
#define XB_TOP      3328
#define XB_TOPGEN   3392
#define XCD_BAR_WORDS 3456
#define XB_SPIN_CAP (1u << 18)

__device__ __forceinline__ unsigned xb_ld(unsigned* p)              { return __hip_atomic_load(p, __ATOMIC_RELAXED, __HIP_MEMORY_SCOPE_AGENT); }
__device__ __forceinline__ unsigned xb_add(unsigned* p, unsigned v) { return __hip_atomic_fetch_add(p, v, __ATOMIC_RELAXED, __HIP_MEMORY_SCOPE_AGENT); }
__device__ __forceinline__ unsigned xb_xcc_id() { return (unsigned)__builtin_amdgcn_s_getreg((3 << 11) | 20) & 0xFu; }
#define XB_SPIN(cond, bar) do { unsigned _sp = 0; while (cond) { __builtin_amdgcn_s_sleep(1); \
    if ((++_sp & 255u) == 0u) { if (xb_ld(&(bar)[XB_TMO])) break; if (_sp > XB_SPIN_CAP) { atomicAdd(&(bar)[XB_TMO], 1u); break; } } } } while (0)

struct XcdBarrier {
    unsigned* bar; unsigned x;
    volatile LAS unsigned* st;
};

__device__ __forceinline__ XcdBarrier xcd_barrier_post(unsigned* bar, volatile LAS unsigned* st) {
    XcdBarrier b; b.bar = bar; b.x = xb_xcc_id(); b.st = st;
    if (threadIdx.x == 0) (void)xb_add(&bar[XB_XCNT(b.x)], 1u);
    return b;
}
__device__ __forceinline__ void xcd_barrier_complete(unsigned* bar, unsigned x, unsigned& nloc, unsigned& nx) {
    const unsigned G = gridDim.x * gridDim.y * gridDim.z;
    unsigned sum, cnt, mine, sp = 0u;
    for (;;) {
        sum = 0u; cnt = 0u; mine = 0u;
#pragma unroll
        for (unsigned j = 0; j < 16; ++j) { const unsigned c = xb_ld(&bar[XB_XCNT(j)]); sum += c; cnt += (c > 0u) ? 1u : 0u; mine = (j == x) ? c : mine; }
        if (sum == G) break;
        __builtin_amdgcn_s_sleep(1);
        if ((++sp & 255u) == 0u) { if (xb_ld(&bar[XB_TMO])) break; if (sp > XB_SPIN_CAP) { atomicAdd(&bar[XB_TMO], 1u); break; } }
    }
    nloc = mine > 0u ? mine : 1u; nx = cnt > 0u ? cnt : 1u;
}

__device__ __forceinline__ void xcd_barrier(const XcdBarrier& b, const int tid) {
    asm volatile("s_waitcnt vmcnt(0)" ::: "memory");
    __syncthreads();
    if (tid == 0) {
        unsigned* bar = b.bar;
        __builtin_amdgcn_s_waitcnt(0);
        unsigned nloc = b.st[0], nx = b.st[1];
        if (nloc == 0u) { xcd_barrier_complete(bar, b.x, nloc, nx); b.st[0] = nloc; b.st[1] = nx; }
        const unsigned old = xb_add(&bar[XB_XSUB(b.x)], 1u);
        const unsigned gen = old / nloc;
        if (old + 1u == (gen + 1u) * nloc) {
            __builtin_amdgcn_fence(__ATOMIC_RELEASE, "agent");
            asm volatile("s_waitcnt vmcnt(0)" ::: "memory");
            const unsigned og = xb_add(&bar[XB_TOP], 1u);
            const unsigned tg = og / nx;
            if (og + 1u == (tg + 1u) * nx) xb_add(&bar[XB_TOPGEN], 1u);
            else XB_SPIN(xb_ld(&bar[XB_TOPGEN]) == tg, bar);
            __builtin_amdgcn_fence(__ATOMIC_ACQUIRE, "agent");
            xb_add(&bar[XB_XGEN(b.x)], 1u);
            asm volatile("s_waitcnt vmcnt(0)" ::: "memory");
        } else {
            XB_SPIN(xb_ld(&bar[XB_XGEN(b.x)]) == gen, bar);
            __builtin_amdgcn_fence(__ATOMIC_ACQUIRE, "agent");
            asm volatile("s_waitcnt vmcnt(0)" ::: "memory");
        }
    }
    __syncthreads();
}

constexpr int NWAVES = 8;
constexpr int D = 1024, NB = 4, S = 4096, T = NB * S, NL = 2, NMEM = 256, MROWS = NB * NMEM;
constexpr int DIN = 2438, NPROJ = 2560;
constexpr int PC_Z = 0, PC_XBC = 384, PC_QSB = 1024, PC_KSB = 1408, PC_VSB = 1792, PC_QMEM = 2176, PC_DT = 2432;
constexpr int CONV_CH = 640;
constexpr float EPS = 1e-6f;

constexpr int RING_BYTES = 131072;
constexpr int WSCR = 17408;
constexpr int LDSCTL_OFF = 8 * WSCR, MISC_OFF = LDSCTL_OFF + 320;
constexpr int LDS_BYTES = 147456;
constexpr int GTAB_OFF = LDSCTL_OFF + 1024;

constexpr size_t MiB = 1u << 20;
constexpr size_t WS_CTL = 0, CTL_ZERO_BYTES = 1 * MiB;
constexpr size_t WS_WIN = 2 * MiB;
constexpr size_t WS_WMEM = 12 * MiB;
constexpr size_t WS_WOUT = 14 * MiB;
constexpr size_t WS_WSC = 18 * MiB;
constexpr size_t WS_KB = 22 * MiB;
constexpr size_t WS_MEMB = 26 * MiB;
constexpr size_t WS_RSM = 28 * MiB;
constexpr size_t WS_RS1 = WS_RSM + 64 * 1024;
constexpr size_t WS_DTF = WS_RS1 + 64 * 1024;
constexpr size_t WS_XSSQ = 29 * MiB;
constexpr size_t WS_YSSQ = 30 * MiB;
constexpr size_t WS_MEMKV = 31 * MiB;
constexpr size_t WS_RS1P = 32 * MiB;
constexpr size_t WS_PART = 178 * MiB;
constexpr size_t WS_XB = 34 * MiB;
constexpr size_t WS_YCAT = 66 * MiB;
constexpr size_t WS_PROJ = 98 * MiB;
constexpr size_t WS_SCORES = 178 * MiB;
constexpr size_t WS_YPART = WS_SCORES;
constexpr size_t WS_XCONV = WS_SCORES + 24 * MiB;
constexpr size_t WS_CMG = WS_SCORES + 36 * MiB;
constexpr size_t WS_ACSG = WS_SCORES + 40 * MiB;
constexpr size_t WS_HS = WS_SCORES + 41 * MiB;
constexpr size_t WS_CD = WS_SCORES + 53 * MiB;
constexpr size_t WS_EIDX = 306 * MiB;
constexpr size_t WS_GATE = 314 * MiB;
constexpr size_t WS_STOP = 322 * MiB;
constexpr size_t WS_ITOP = 338 * MiB;
constexpr size_t WS_UT = 354 * MiB;
constexpr size_t WS_USC = 386 * MiB;
constexpr size_t WS_VT = 418 * MiB;
constexpr size_t WS_VSC = 450 * MiB;
constexpr size_t WS_END = 482 * MiB;
constexpr int CW_BAR = 4096;

__device__ __forceinline__ float bf2f(bf16 v) { return __uint_as_float((unsigned)v << 16); }
__device__ __forceinline__ unsigned pkbf(float lo, float hi) { return pg8::cvt_pk_bf16(lo, hi); }
template <int CTRL> __device__ __forceinline__ float dpp_f(float v) { return __uint_as_float((unsigned)__builtin_amdgcn_update_dpp(0, (int)__float_as_uint(v), CTRL, 0xf, 0xf, true)); }
__device__ __forceinline__ float swap32_add(float a, float b) {
    const auto r = __builtin_amdgcn_permlane32_swap(__float_as_uint(a), __float_as_uint(b), false, false); return __uint_as_float(r[0]) + __uint_as_float(r[1]); }
__device__ __forceinline__ float swap16_add(float a, float b) {
    const auto r = __builtin_amdgcn_permlane16_swap(__float_as_uint(a), __float_as_uint(b), false, false); return __uint_as_float(r[0]) + __uint_as_float(r[1]); }
__device__ __forceinline__ float swap32_max(float a) { const auto r = __builtin_amdgcn_permlane32_swap(__float_as_uint(a), __float_as_uint(a), false, false); return fmaxf(__uint_as_float(r[0]), __uint_as_float(r[1])); }
__device__ __forceinline__ float swap16_max(float a) { const auto r = __builtin_amdgcn_permlane16_swap(__float_as_uint(a), __float_as_uint(a), false, false); return fmaxf(__uint_as_float(r[0]), __uint_as_float(r[1])); }
__device__ __forceinline__ float partner32(float a, bool hi) { const auto r = __builtin_amdgcn_permlane32_swap(__float_as_uint(a), __float_as_uint(a), false, false); return __uint_as_float(hi ? r[0] : r[1]); }
__device__ __forceinline__ float sum8(float v) { v += dpp_f<0xB1>(v); v += dpp_f<0x4E>(v); v += dpp_f<0x141>(v); return v; }
__device__ __forceinline__ float sum16(float v) { v = sum8(v); v += dpp_f<0x140>(v); return v; }
__device__ __forceinline__ float wave_sum(float v) { v = sum16(v); v = swap16_add(v, v); return swap32_add(v, v); }
__device__ __forceinline__ float wave_max(float v) { v = fmaxf(v, dpp_f<0xB1>(v)); v = fmaxf(v, dpp_f<0x4E>(v)); v = fmaxf(v, dpp_f<0x141>(v)); v = fmaxf(v, dpp_f<0x140>(v)); v = swap16_max(v); return swap32_max(v); }
__device__ __forceinline__ float bperm_f(float v, int src_lane) { return __uint_as_float((unsigned)__builtin_amdgcn_ds_bpermute(src_lane << 2, (int)__float_as_uint(v))); }
__device__ __forceinline__ int bperm_i(int v, int src_lane) { return __builtin_amdgcn_ds_bpermute(src_lane << 2, v); }
__device__ __forceinline__ float softplus_f(float x) { return fmaxf(x, 0.f) + log1pf(expf(-fabsf(x))); }
__device__ __forceinline__ float silu_f(float x) { return x / (1.f + expf(-x)); }

namespace pg8 {
struct EpiInProj {
    static constexpr bool PERM = true, AFTER_DRAIN = false, KHOOK = false;
    bf16_t* O; int ldc; const float* rs; float* dtf; const float* dtb; int npart;
    __device__ __forceinline__ void operator()(const f32x4 (&acc)[2][2][4][2], const Unit& u, int wr, int wc, int fr, int fq) const {
        const int row0 = u.pm * BM + wr * 64 + fr, col0 = u.pn * BM + wc * 32 + 8 * fq;
        const bool dtl = dtf && (u.pn * BM == PC_DT - 128) && wc == 0 && fq == 0;
#pragma unroll
        for (int ai = 0; ai < 2; ++ai)
#pragma unroll
            for (int m = 0; m < 4; ++m) {
                const int row = row0 + ai * HALF + m * 16; float s;
                if (npart == 8) { const f32x4 p0 = *(const f32x4*)(rs + (size_t)row * 8), p1 = *(const f32x4*)(rs + (size_t)row * 8 + 4); s = rsqrtf((((p0[0] + p0[1]) + (p0[2] + p0[3])) + ((p1[0] + p1[1]) + (p1[2] + p1[3]))) * (1.f / 1024.f) + EPS); }
                else if (npart == 16) { const f32x4 p0 = *(const f32x4*)(rs + (size_t)row * 16), p1 = *(const f32x4*)(rs + (size_t)row * 16 + 4), p2 = *(const f32x4*)(rs + (size_t)row * 16 + 8), p3 = *(const f32x4*)(rs + (size_t)row * 16 + 12);
                    s = rsqrtf(((((p0[0] + p0[1]) + (p0[2] + p0[3])) + ((p1[0] + p1[1]) + (p1[2] + p1[3]))) + (((p2[0] + p2[1]) + (p2[2] + p2[3])) + ((p3[0] + p3[1]) + (p3[2] + p3[3])))) * (1.f / 1024.f) + EPS); }
                else s = rs[row];
#pragma unroll
                for (int bj = 0; bj < 2; ++bj) {
                    const f32x4 v0 = acc[ai][bj][m][0] * s, v1 = acc[ai][bj][m][1] * s;
                    u32x4 w; w.x = cvt_pk_bf16(v0[0], v0[1]); w.y = cvt_pk_bf16(v0[2], v0[3]); w.z = cvt_pk_bf16(v1[0], v1[1]); w.w = cvt_pk_bf16(v1[2], v1[3]);
                    *(u32x4*)(O + (size_t)row * ldc + col0 + bj * HALF) = w;
                    if (bj == 1 && dtl) {
                        f32x4 d0; d0[0] = softplus_f(v0[0] + dtb[0]); d0[1] = softplus_f(v0[1] + dtb[1]); d0[2] = softplus_f(v0[2] + dtb[2]); d0[3] = softplus_f(v0[3] + dtb[3]);
                        f32x4 d1; d1[0] = softplus_f(v1[0] + dtb[4]); d1[1] = softplus_f(v1[1] + dtb[5]); d1[2] = 0.f; d1[3] = 0.f;
                        *(f32x4*)(dtf + (size_t)row * 8) = d0; *(f32x4*)(dtf + (size_t)row * 8 + 4) = d1;
                    }
                }
            }
    }
};
__device__ __forceinline__ void group_rstd(const float* yssq, int row, float& r_ssd, float& r_sb, float& r_mem) {
    const f32x4 a = *(const f32x4*)(yssq + (size_t)row * 16), b = *(const f32x4*)(yssq + (size_t)row * 16 + 4), c = *(const f32x4*)(yssq + (size_t)row * 16 + 8), d = *(const f32x4*)(yssq + (size_t)row * 16 + 12);
    const float s0 = (a[0] + a[1]) + (a[2] + a[3]) + (b[0] + b[1]), s1 = (b[2] + b[3]) + (c[0] + c[1]) + (c[2] + c[3]), s2 = (d[0] + d[1]) + (d[2] + d[3]);
    r_ssd = rsqrtf(s0 * (1.f / 384.f) + EPS); r_sb = rsqrtf(s1 * (1.f / 384.f) + EPS); r_mem = rsqrtf(s2 * (1.f / 256.f) + EPS);
}
struct EpiOut {
    static constexpr bool PERM = false, AFTER_DRAIN = false, KHOOK = true;
    const float* base; float* out; bf16_t* xb; float* xssq; const PG8_LAS float* gtab;
    __device__ __forceinline__ void khook(f32x4 (&acc)[2][2][4][2], const Unit& u, int t, int wr, int fr) const {
        if (t != 6 && t != 12) return;
#pragma unroll
        for (int ai = 0; ai < 2; ++ai)
#pragma unroll
            for (int m = 0; m < 4; ++m) {
                const float f = gtab[(t == 6 ? 0 : 256) + ai * HALF + wr * 64 + m * 16 + fr];
#pragma unroll
                for (int bj = 0; bj < 2; ++bj)
#pragma unroll
                    for (int n = 0; n < 2; ++n) acc[ai][bj][m][n] = acc[ai][bj][m][n] * f;
            }
    }
    __device__ __forceinline__ void operator()(const f32x4 (&acc)[2][2][4][2], const Unit& u, int wr, int wc, int fr, int fq) const {
        const int col0 = u.pn * BM + wc * 32 + 4 * fq;
#pragma unroll
        for (int ai = 0; ai < 2; ++ai)
#pragma unroll
            for (int m = 0; m < 4; ++m) {
                const int row = u.pm * BM + ai * HALF + wr * 64 + m * 16 + fr; const float r2 = gtab[512 + ai * HALF + wr * 64 + m * 16 + fr];
                float q = 0.f;
#pragma unroll
                for (int bj = 0; bj < 2; ++bj)
#pragma unroll
                    for (int n = 0; n < 2; ++n) {
                        const size_t off = (size_t)row * D + col0 + bj * HALF + n * 16;
                        const f32x4 x1 = *(const f32x4*)(base + off) + acc[ai][bj][m][n] * r2;
                        *(f32x4*)(out + off) = x1;
                        typedef unsigned u32x2v __attribute__((ext_vector_type(2)));
                        u32x2v w; w.x = cvt_pk_bf16(x1[0], x1[1]); w.y = cvt_pk_bf16(x1[2], x1[3]); *(u32x2v*)(xb + off) = w;
                        q += (x1[0] * x1[0] + x1[1] * x1[1]) + (x1[2] * x1[2] + x1[3] * x1[3]);
                    }
                q = swap16_add(q, q); q = swap32_add(q, q);
                if (fq == 0) xssq[(size_t)row * 16 + u.pn * 4 + wc] = q;
            }
    }
};
struct EpiScores {
    static constexpr bool PERM = false, AFTER_DRAIN = false, KHOOK = false;
    float* O; const float* xssq;
    __device__ __forceinline__ void operator()(const f32x4 (&acc)[2][2][4][2], const Unit& u, int wr, int wc, int fr, int fq) const {
        const int col0 = u.pn * BM + wc * 32 + 4 * fq;
#pragma unroll
        for (int ai = 0; ai < 2; ++ai)
#pragma unroll
            for (int m = 0; m < 4; ++m) {
                const int row = u.pm * BM + ai * HALF + wr * 64 + m * 16 + fr;
                const f32x4 a = *(const f32x4*)(xssq + (size_t)row * 16), b = *(const f32x4*)(xssq + (size_t)row * 16 + 4), c = *(const f32x4*)(xssq + (size_t)row * 16 + 8), d = *(const f32x4*)(xssq + (size_t)row * 16 + 12);
                const float ss = ((a[0] + a[1]) + (a[2] + a[3])) + ((b[0] + b[1]) + (b[2] + b[3])) + ((c[0] + c[1]) + (c[2] + c[3])) + ((d[0] + d[1]) + (d[2] + d[3]));
                const float r = rsqrtf(ss * (1.f / 1024.f) + EPS);
#pragma unroll
                for (int bj = 0; bj < 2; ++bj)
#pragma unroll
                    for (int n = 0; n < 2; ++n) *(f32x4*)(O + (size_t)row * 2048 + col0 + bj * HALF + n * 16) = acc[ai][bj][m][n] * r;
            }
    }
};
}

struct Args { const float* in[22]; float* out; unsigned char* ws; int ph_lo, ph_hi, li, pad; };
enum { I_X = 0, I_MEM, I_NORM1G, I_WIN, I_CONVW, I_CONVB, I_DTBIAS, I_ALOG, I_DSKIP, I_SSDG, I_SBG, I_MEMNG, I_WMEMKV, I_MQG, I_MKG, I_MEMOG, I_WOUT, I_NORM2G, I_WQ, I_KEYS, I_PU, I_PV };

__device__ __forceinline__ int opq(int i) { asm volatile("" : "+s"(i)); return i; }
#define AIN(i) (a.in[opq(i)])
__device__ __forceinline__ void transpose_item(const float* W, int ldw, int src_c0, int nvalid, const float* g, bf16* WT, int K, int dst_r0, int k0, LAS float* scr, int lane) {
    const int c = lane & 31;
#pragma unroll 8
    for (int i = 0; i < 32; ++i) {
        const int kk = 2 * i + (lane >> 5);
        float v = (c < nvalid) ? W[(size_t)(k0 + kk) * ldw + src_c0 + c] : 0.f;
        if (g) v *= g[k0 + kk];
        scr[kk * 33 + c] = v;
    }
    LDS_WAIT(); asm volatile("" ::: "memory");
    const int c8 = lane & 7;
#pragma unroll
    for (int j = 0; j < 4; ++j) {
        const int n = (lane >> 3) + 8 * j; const LAS float* s = scr + (8 * c8) * 33 + n;
        v4u o; o.x = pkbf(s[0 * 33], s[1 * 33]); o.y = pkbf(s[2 * 33], s[3 * 33]); o.z = pkbf(s[4 * 33], s[5 * 33]); o.w = pkbf(s[6 * 33], s[7 * 33]);
        *(GAS v4u*)(WT + (size_t)(dst_r0 + n) * K + k0 + 8 * c8) = o;
    }
    LDS_WAIT(); asm volatile("" ::: "memory");
}
__device__ __forceinline__ void row_to_bf16(const float* xrow, bf16* orow, float* rs, bool partials, int lane) {
    const GAS f32x4* xr = (const GAS f32x4*)xrow + lane;
    f32x4 v[4]; float s = 0.f;
#pragma unroll
    for (int j = 0; j < 4; ++j) { v[j] = xr[64 * j]; s += (v[j].x * v[j].x + v[j].y * v[j].y) + (v[j].z * v[j].z + v[j].w * v[j].w); }
    s = wave_sum(s);
    GAS unsigned long long* o8 = (GAS unsigned long long*)orow + lane;
#pragma unroll
    for (int j = 0; j < 4; ++j) o8[64 * j] = (unsigned long long)pkbf(v[j].x, v[j].y) | ((unsigned long long)pkbf(v[j].z, v[j].w) << 32);
    if (partials) { if (lane < 8) rs[lane] = lane == 0 ? s : 0.f; }
    else if (lane == 0) *rs = rsqrtf(s * (1.f / 1024.f) + EPS);
}
__device__ __forceinline__ void ph_prologue(const Args& a, unsigned char* ws, LAS unsigned char* lds, int gw, int NGW, int wave, int lane) {
    LAS float* scr = (LAS float*)(lds + wave * 16384);
    constexpr int I_IN = 80 * 16, I_MEMW = 16 * 16, I_OUT = 32 * 16, I_SC = 32 * 16 + 128, PER_L = I_IN + I_MEMW + I_OUT + I_SC;
    constexpr int NW_ITEMS = NL * PER_L, NITEMS = NW_ITEMS + T + MROWS;
    for (int it = gw; it < NITEMS; it += NGW) {
        if (it < NW_ITEMS) {
            const int l = it / PER_L; int r = it % PER_L;
            if (r < I_IN) {
                const int j = r / 16, kb = r % 16;
                const int src = (j < 32) ? 32 * j : (j < 76 ? 32 * j + 6 : 1024), nv = (j < 76) ? 32 : (j == 76 ? 6 : 0);
                transpose_item(AIN(I_WIN) + (size_t)l * D * DIN, DIN, src, nv, AIN(I_NORM1G) + l * D, (bf16*)(ws + WS_WIN) + (size_t)l * NPROJ * D, D, 32 * j, 64 * kb, scr, lane);
                continue;
            }
            r -= I_IN;
            if (r < I_MEMW) {
                const int j = r / 16, kb = r % 16;
                transpose_item(AIN(I_WMEMKV) + (size_t)l * D * 512, 512, 32 * j, 32, AIN(I_MEMNG) + l * D, (bf16*)(ws + WS_WMEM) + (size_t)l * 512 * D, D, 32 * j, 64 * kb, scr, lane);
                continue;
            }
            r -= I_MEMW;
            if (r < I_OUT) {
                const int j = r / 16, kb = r % 16;
                const float* g = (kb < 6) ? AIN(I_SSDG) + l * 384 : (kb < 12 ? AIN(I_SBG) + l * 384 - 384 : AIN(I_MEMOG) + l * 256 - 768);
                transpose_item(AIN(I_WOUT) + (size_t)l * D * D, D, 32 * j, 32, g, (bf16*)(ws + WS_WOUT) + (size_t)l * D * D, D, 32 * j, 64 * kb, scr, lane);
                continue;
            }
            r -= I_OUT;
            if (r < 32 * 16) { const int j = r / 16, kb = r % 16;
                transpose_item(AIN(I_WQ) + (size_t)l * D * D, D, 32 * j, 32, AIN(I_NORM2G) + l * D, (bf16*)(ws + WS_WSC) + (size_t)l * D * D, D, 32 * j, 64 * kb, scr, lane); }
            else { r -= 32 * 16;
                const GAS f32x4* kr = (const GAS f32x4*)(AIN(I_KEYS) + (size_t)l * 16 * 128 * 64 + (size_t)r * 1024) + lane; GAS unsigned long long* o8 = (GAS unsigned long long*)((bf16*)(ws + WS_KB) + (size_t)l * 16 * 128 * 64 + (size_t)r * 1024) + lane;
#pragma unroll
                for (int j = 0; j < 4; ++j) { const f32x4 v = kr[64 * j]; o8[64 * j] = (unsigned long long)pkbf(v.x, v.y) | ((unsigned long long)pkbf(v.z, v.w) << 32); } }
            continue;
        }
        int r = it - NW_ITEMS;
        if (r < T) { row_to_bf16(AIN(I_X) + (size_t)r * D, (bf16*)(ws + WS_XB) + (size_t)r * D, (float*)(ws + WS_RS1P) + (size_t)r * 8, true, lane); continue; }
        r -= T;
        row_to_bf16(AIN(I_MEM) + (size_t)r * D, (bf16*)(ws + WS_MEMB) + (size_t)r * D, (float*)(ws + WS_RSM) + r, false, lane);
    }
}


__device__ __forceinline__ void convert_tables(const Args& a, unsigned char* ws, int l, int widx, int nw, int lane) {
    for (int r0 = widx; r0 < 2 * 16384; r0 += 4 * nw) {
        f32x4 v[4][4];
#pragma unroll
        for (int q = 0; q < 4; ++q) {
            const int r = r0 + q * nw; const int tb = r >> 14, e = (r & 16383) + l * 16384;
            const float* src = (tb == 0 ? AIN(I_PU) : AIN(I_PV)) + (size_t)e * D;
#pragma unroll
            for (int j = 0; j < 4; ++j) v[q][j] = (r < 2 * 16384) ? *((const GAS f32x4*)src + 64 * j + lane) : (f32x4){0.f, 0.f, 0.f, 0.f};
        }
#pragma unroll
        for (int q = 0; q < 4; ++q) {
            const int r = r0 + q * nw; const int tb = r >> 14, e = (r & 16383) + l * 16384;
            if (r >= 2 * 16384) continue;
            unsigned* dst = (unsigned*)(ws + (tb == 0 ? WS_UT : WS_VT) + (size_t)l * 16384 * D + (size_t)(e & 16383) * 128) + (lane & 31);
            const float* g = AIN(I_NORM2G) + l * D;
            float am = 0.f;
#pragma unroll
            for (int j = 0; j < 4; ++j) { if (tb == 0) v[q][j] = v[q][j] * *((const GAS f32x4*)g + 64 * j + lane);
                am = fmaxf(fmaxf(am, fmaxf(fabsf(v[q][j].x), fabsf(v[q][j].y))), fmaxf(fabsf(v[q][j].z), fabsf(v[q][j].w))); }
            am = wave_max(am);
            const float sc = am > 0.f ? 256.f / am : 1.f;
#pragma unroll
            for (int j = 0; j < 4; ++j) { int pk = 0; pk = __builtin_amdgcn_cvt_pk_fp8_f32(v[q][j].x * sc, v[q][j].y * sc, pk, false); pk = __builtin_amdgcn_cvt_pk_fp8_f32(v[q][j].z * sc, v[q][j].w * sc, pk, true); dst[(size_t)(2 * j + (lane >> 5)) * (16384 * 128 / 4)] = (unsigned)pk; }
            if (lane == 0) ((float*)(ws + (tb == 0 ? WS_USC : WS_VSC)))[e] = am > 0.f ? am * (1.f / 256.f) : 1.f;
        }
    }
}

typedef __attribute__((ext_vector_type(8))) __bf16 bf8_t;
typedef __attribute__((ext_vector_type(8))) float f32x8;
typedef __attribute__((ext_vector_type(8))) short s16x8;
typedef __attribute__((ext_vector_type(4))) short s16x4;
typedef __attribute__((ext_vector_type(16))) float f32x16;
typedef unsigned u32x2 __attribute__((ext_vector_type(2)));
#define MFMA32(a, b, c) __builtin_amdgcn_mfma_f32_32x32x16_bf16((a), (b), (c), 0, 0, 0)
__device__ __forceinline__ int crow(int i, int h) { return (i & 3) + 8 * (i >> 2) + 4 * h; }
__device__ __forceinline__ s16x8 cvt8(const f32x8 x) { return __builtin_bit_cast(s16x8, __builtin_convertvector(x, bf8_t)); }
__device__ __forceinline__ s16x8 pack_acc(const f32x16& x, int s) { f32x8 v;
#pragma unroll
    for (int j = 0; j < 8; ++j) v[j] = x[8 * s + j];
    return cvt8(v); }
__device__ __forceinline__ s16x8 cat4(const s16x4 lo, const s16x4 hi) { return __builtin_shufflevector(lo, hi, 0, 1, 2, 3, 4, 5, 6, 7); }
__device__ __forceinline__ f32x16 zero16() { f32x16 z;
#pragma unroll
    for (int i = 0; i < 16; ++i) z[i] = 0.f;
    return z; }
constexpr int L_BM = 0, L_CM = 18432, L_BMT = 36864, L_XDT = 54272, L_ACS = 106496, L_DT = 108032, L_TOT = 109568;

__device__ __forceinline__ void ssd_chunk_unit(const Args& a, unsigned char* ws, LAS unsigned char* lds, int l_, int unit, int tid, int wave, int lane) {
    const int g = unit & 1, c = (unit >> 1) & 31, b = unit >> 6, t0 = b * S + c * 128;
    const bf16* proj = (const bf16*)(ws + WS_PROJ); const float* dtf = (const float*)(ws + WS_DTF);
    LAS float* acs = (LAS float*)(lds + L_ACS); LAS float* dts = (LAS float*)(lds + L_DT); LAS float* tot = (LAS float*)(lds + L_TOT);
    float cs = 0.f, dtv = 0.f;
    if (wave < 6) {
        const int hh = wave >> 1, l = (wave & 1) * 64 + lane;
        dtv = dtf[(size_t)(t0 + l) * 8 + 3 * g + hh];
        cs = dtv * -expf(AIN(I_ALOG)[l_ * 6 + 3 * g + hh]);
#pragma unroll
        for (int o = 1; o < 64; o <<= 1) { const float t = bperm_f(cs, lane - o); if (lane >= o) cs += t; }
        if (lane == 63) tot[wave] = cs;
    }
    __syncthreads();
    if (wave < 6) {
        const int hh = wave >> 1, l = (wave & 1) * 64 + lane;
        if (wave & 1) cs += tot[wave - 1];
        acs[hh * 128 + l] = cs; dts[hh * 128 + l] = dtv;
        ((float*)(ws + WS_ACSG))[(size_t)(t0 + l) * 8 + 3 * g + hh] = cs;
    }
    __syncthreads();
    const float* cw = AIN(I_CONVW) + l_ * 4 * CONV_CH; const float* cb = AIN(I_CONVB) + l_ * CONV_CH;
#pragma unroll 2
    for (int it = 0; it < 10; ++it) {
        const int idx = tid + 512 * it, l = idx / 40, ck = idx % 40;
        int cc, kind, hh = 0, e0;
        if (ck < 24) { hh = ck >> 3; e0 = (ck & 7) * 8; cc = (3 * g + hh) * 64 + e0; kind = 0; }
        else if (ck < 32) { e0 = (ck - 24) * 8; cc = 384 + g * 64 + e0; kind = 1; }
        else { e0 = (ck - 32) * 8; cc = 512 + g * 64 + e0; kind = 2; }
        float acc[8];
        { const f32x4 b0 = *(const f32x4*)(cb + cc), b1 = *(const f32x4*)(cb + cc + 4); acc[0] = b0.x; acc[1] = b0.y; acc[2] = b0.z; acc[3] = b0.w; acc[4] = b1.x; acc[5] = b1.y; acc[6] = b1.z; acc[7] = b1.w; }
#pragma unroll
        for (int k = 0; k < 4; ++k) {
            const int sl = c * 128 + l - 3 + k;
            if (sl >= 0) {
                const v4u xv = *(const GAS v4u*)(proj + (size_t)(t0 + l - 3 + k) * NPROJ + PC_XBC + cc);
                const f32x4 w0 = *(const f32x4*)(cw + k * CONV_CH + cc), w1 = *(const f32x4*)(cw + k * CONV_CH + cc + 4);
                acc[0] += w0.x * __uint_as_float(xv.x << 16); acc[1] += w0.y * __uint_as_float(xv.x & 0xffff0000u);
                acc[2] += w0.z * __uint_as_float(xv.y << 16); acc[3] += w0.w * __uint_as_float(xv.y & 0xffff0000u);
                acc[4] += w1.x * __uint_as_float(xv.z << 16); acc[5] += w1.y * __uint_as_float(xv.z & 0xffff0000u);
                acc[6] += w1.z * __uint_as_float(xv.w << 16); acc[7] += w1.w * __uint_as_float(xv.w & 0xffff0000u);
            }
        }
#pragma unroll
        for (int e = 0; e < 8; ++e) acc[e] = silu_f(acc[e]);
        v4u pk; pk.x = pkbf(acc[0], acc[1]); pk.y = pkbf(acc[2], acc[3]); pk.z = pkbf(acc[4], acc[5]); pk.w = pkbf(acc[6], acc[7]);
        if (kind == 0) {
            *(GAS v4u*)((bf16*)(ws + WS_XCONV) + (size_t)(t0 + l) * 384 + (3 * g + hh) * 64 + e0) = pk;
            const float d = dts[hh * 128 + l];
            LAS bf16* xd = (LAS bf16*)(lds + L_XDT) + (hh * 64 + e0) * 136 + l;
#pragma unroll
            for (int e = 0; e < 8; e += 2) { const unsigned w = pkbf(acc[e] * d, acc[e + 1] * d); xd[e * 136] = (bf16)(w & 0xffffu); xd[(e + 1) * 136] = (bf16)(w >> 16); }
        } else if (kind == 1) {
            *(LAS v4u*)(lds + L_BM + (l * 72 + e0) * 2) = pk;
            LAS bf16* bt = (LAS bf16*)(lds + L_BMT) + e0 * 136 + l;
            bt[0 * 136] = (bf16)(pk.x & 0xffffu); bt[1 * 136] = (bf16)(pk.x >> 16); bt[2 * 136] = (bf16)(pk.y & 0xffffu); bt[3 * 136] = (bf16)(pk.y >> 16);
            bt[4 * 136] = (bf16)(pk.z & 0xffffu); bt[5 * 136] = (bf16)(pk.z >> 16); bt[6 * 136] = (bf16)(pk.w & 0xffffu); bt[7 * 136] = (bf16)(pk.w >> 16);
        } else {
            *(LAS v4u*)(lds + L_CM + (l * 72 + e0) * 2) = pk;
            *(GAS v4u*)((bf16*)(ws + WS_CMG) + (size_t)(t0 + l) * 128 + g * 64 + e0) = pk;
        }
    }
    __syncthreads();
    const int r = lane & 31, h = lane >> 5, lb = wave & 3, pt = wave >> 2;
    {
        s16x8 cf[4];
#pragma unroll
        for (int ks = 0; ks < 4; ++ks) cf[ks] = *(const LAS s16x8*)(lds + L_CM + ((lb * 32 + r) * 72 + ks * 16 + 8 * h) * 2);
        f32x16 gt[4];
#pragma unroll
        for (int sb = 0; sb < 4; ++sb) {
            gt[sb] = zero16();
            if (sb <= lb) {
#pragma unroll
                for (int ks = 0; ks < 4; ++ks) gt[sb] = MFMA32(*(const LAS s16x8*)(lds + L_BM + ((sb * 32 + r) * 72 + ks * 16 + 8 * h) * 2), cf[ks], gt[sb]);
            }
        }
#pragma unroll
        for (int hh = 0; hh < 3; ++hh) {
            const float al = acs[hh * 128 + lb * 32 + r];
            f32x16 yacc = zero16();
#pragma unroll
            for (int sb = 0; sb < 4; ++sb) {
                if (sb <= lb) {
                    f32x16 m;
#pragma unroll
                    for (int i = 0; i < 16; ++i) {
                        const int sl = crow(i, h);
                        const float v = gt[sb][i] * __expf(al - acs[hh * 128 + sb * 32 + sl]);
                        m[i] = (sb < lb || sl <= r) ? v : 0.f;
                    }
#pragma unroll
                    for (int ks = 0; ks < 2; ++ks) {
                        const LAS unsigned char* xp = lds + L_XDT + ((hh * 64 + pt * 32 + r) * 136 + sb * 32 + 16 * ks + 4 * h) * 2;
                        yacc = MFMA32(cat4(*(const LAS s16x4*)xp, *(const LAS s16x4*)(xp + 16)), pack_acc(m, ks), yacc);
                    }
                }
            }
            float* yp = (float*)(ws + WS_YPART) + (size_t)(t0 + lb * 32 + r) * 384 + (3 * g + hh) * 64 + pt * 32 + 4 * h;
#pragma unroll
            for (int i4 = 0; i4 < 4; ++i4) *(f32x4*)(yp + 8 * i4) = (f32x4){yacc[4 * i4], yacc[4 * i4 + 1], yacc[4 * i4 + 2], yacc[4 * i4 + 3]};
        }
    }
    for (int tl = wave; tl < 12; tl += 8) {
        const int hh = tl >> 2, nt = (tl >> 1) & 1, pt2 = tl & 1;
        const float alast = acs[hh * 128 + 127];
        f32x16 acc = zero16();
#pragma unroll
        for (int ks = 0; ks < 8; ++ks) {
            const s16x8 af = *(const LAS s16x8*)(lds + L_BMT + ((nt * 32 + r) * 136 + ks * 16 + 8 * h) * 2);
            const v4u xr = *(const LAS v4u*)(lds + L_XDT + ((hh * 64 + pt2 * 32 + r) * 136 + ks * 16 + 8 * h) * 2);
            const LAS float* ap = acs + hh * 128 + ks * 16 + 8 * h;
            f32x8 xf;
            xf[0] = __uint_as_float(xr.x << 16) * __expf(alast - ap[0]); xf[1] = __uint_as_float(xr.x & 0xffff0000u) * __expf(alast - ap[1]);
            xf[2] = __uint_as_float(xr.y << 16) * __expf(alast - ap[2]); xf[3] = __uint_as_float(xr.y & 0xffff0000u) * __expf(alast - ap[3]);
            xf[4] = __uint_as_float(xr.z << 16) * __expf(alast - ap[4]); xf[5] = __uint_as_float(xr.z & 0xffff0000u) * __expf(alast - ap[5]);
            xf[6] = __uint_as_float(xr.w << 16) * __expf(alast - ap[6]); xf[7] = __uint_as_float(xr.w & 0xffff0000u) * __expf(alast - ap[7]);
            acc = MFMA32(af, cvt8(xf), acc);
        }
        float* hp = (float*)(ws + WS_HS) + ((size_t)((b * 32 + c) * 6 + 3 * g + hh) * 64 + pt2 * 32 + r) * 64 + nt * 32 + 4 * h;
#pragma unroll
        for (int i4 = 0; i4 < 4; ++i4) *(f32x4*)(hp + 8 * i4) = (f32x4){acc[4 * i4], acc[4 * i4 + 1], acc[4 * i4 + 2], acc[4 * i4 + 3]};
    }
    if (tid < 3) ((float*)(ws + WS_CD))[(b * 32 + c) * 6 + 3 * g + tid] = __expf(acs[tid * 128 + 127]);
    __syncthreads();
}
__device__ __forceinline__ void ph_ssd_scan(unsigned char* ws, int bx, int G, int tid) {
    float* hs = (float*)(ws + WS_HS); const float* cd = (const float*)(ws + WS_CD);
    for (int e = bx * 512 + tid; e < 24 * 4096; e += G * 512) {
        const int bh = e >> 12, el = e & 4095, b = bh / 6, hh = bh % 6;
        float run = 0.f;
#pragma unroll 4
        for (int c = 0; c < 32; ++c) {
            const int idx = (b * 32 + c) * 6 + hh;
            const float v = hs[(size_t)idx * 4096 + el], d = cd[idx];
            hs[(size_t)idx * 4096 + el] = run; run = run * d + v;
        }
    }
}
__device__ __forceinline__ void ssd_finish_unit(const Args& a, unsigned char* ws, int l_, int unit, int wave, int lane) {
    const int g = unit & 1, c = (unit >> 1) & 31, b = unit >> 6, t0 = b * S + c * 128;
    const int r = lane & 31, h = lane >> 5, lb = wave & 3, hsel = wave >> 2;
    const int t = t0 + lb * 32 + r;
    const bf16* proj = (const bf16*)(ws + WS_PROJ); const bf16* cmg = (const bf16*)(ws + WS_CMG) + (size_t)t * 128 + g * 64;
    s16x8 cf[4];
#pragma unroll
    for (int ks = 0; ks < 4; ++ks) cf[ks] = *(const GAS s16x8*)(cmg + ks * 16 + 8 * h);
    for (int hh = hsel ? 2 : 0; hh < (hsel ? 3 : 2); ++hh) {
        const int hd = 3 * g + hh;
        const float* hin = (const float*)(ws + WS_HS) + (size_t)((b * 32 + c) * 6 + hd) * 4096;
        const float ea = __expf(((const float*)(ws + WS_ACSG))[(size_t)t * 8 + hd]), dsk = AIN(I_DSKIP)[l_ * 6 + hd];
        float ssq = 0.f;
#pragma unroll
        for (int pt = 0; pt < 2; ++pt) {
            f32x16 acc = zero16();
#pragma unroll
            for (int ks = 0; ks < 4; ++ks) {
                const float* hp = hin + (pt * 32 + r) * 64 + ks * 16 + 8 * h;
                const f32x4 h0 = *(const GAS f32x4*)hp, h1 = *(const GAS f32x4*)(hp + 4);
                acc = MFMA32(cvt8((f32x8){h0.x, h0.y, h0.z, h0.w, h1.x, h1.y, h1.z, h1.w}), cf[ks], acc);
            }
#pragma unroll
            for (int i4 = 0; i4 < 4; ++i4) {
                const int col = hd * 64 + pt * 32 + 8 * i4 + 4 * h;
                const f32x4 yp = *(const GAS f32x4*)((const float*)(ws + WS_YPART) + (size_t)t * 384 + col);
                const u32x2 xc = *(const GAS u32x2*)((const bf16*)(ws + WS_XCONV) + (size_t)t * 384 + col);
                const u32x2 zz = *(const GAS u32x2*)(proj + (size_t)t * NPROJ + PC_Z + col);
                const float y0 = (yp.x + acc[4 * i4 + 0] * ea + dsk * __uint_as_float(xc.x << 16)) * silu_f(__uint_as_float(zz.x << 16));
                const float y1 = (yp.y + acc[4 * i4 + 1] * ea + dsk * __uint_as_float(xc.x & 0xffff0000u)) * silu_f(__uint_as_float(zz.x & 0xffff0000u));
                const float y2 = (yp.z + acc[4 * i4 + 2] * ea + dsk * __uint_as_float(xc.y << 16)) * silu_f(__uint_as_float(zz.y << 16));
                const float y3 = (yp.w + acc[4 * i4 + 3] * ea + dsk * __uint_as_float(xc.y & 0xffff0000u)) * silu_f(__uint_as_float(zz.y & 0xffff0000u));
                ssq += (y0 * y0 + y1 * y1) + (y2 * y2 + y3 * y3);
                u32x2 w; w.x = pkbf(y0, y1); w.y = pkbf(y2, y3);
                *(GAS u32x2*)((bf16*)(ws + WS_YCAT) + (size_t)t * D + col) = w;
            }
        }
        ssq = swap32_add(ssq, ssq);
        if (h == 0) ((float*)(ws + WS_YSSQ))[(size_t)t * 16 + hd] = ssq;
    }
}

#define LOG2E 1.4426950408889634f
__device__ __forceinline__ s16x8 trv_frag(const LAS unsigned char* vimg, int key0, int ks, int dt, int lane) {
    const int h = lane >> 5, i16 = lane & 15, blk = (lane >> 4) & 1;
    const LAS unsigned char* p = vimg + (key0 + 16 * ks + 4 * h + (i16 >> 2)) * 144 + (dt * 32 + 16 * blk) * 2 + 8 * (i16 & 3);
    const s16x4 lo = __builtin_amdgcn_ds_read_tr16_b64_v4i16((LAS s16x4*)p), hi = __builtin_amdgcn_ds_read_tr16_b64_v4i16((LAS s16x4*)(p + 8 * 144));
    return cat4(lo, hi);
}
__device__ __forceinline__ void mem_unit(const Args& a, unsigned char* ws, LAS unsigned char* lds, int l_, int b, int hd, int qb, int tid, int wave, int lane) {
    const bf16* proj = (const bf16*)(ws + WS_PROJ); const bf16* memkv = (const bf16*)(ws + WS_MEMKV);
    const float* qg = AIN(I_MQG) + l_ * 64; const float* kg = AIN(I_MKG) + l_ * 64;
    LAS unsigned char* kimg = lds; LAS unsigned char* vimg = lds + 36864;
#pragma unroll
    for (int it = 0; it < 4; ++it) {
        const int idx = tid + 512 * it, m = idx >> 3, ch = idx & 7;
        const v4u kv = *(const GAS v4u*)(memkv + (size_t)(b * NMEM + m) * 512 + hd * 64 + ch * 8);
        const v4u vv = *(const GAS v4u*)(memkv + (size_t)(b * NMEM + m) * 512 + 256 + hd * 64 + ch * 8);
        float kf[8] = {__uint_as_float(kv.x << 16), __uint_as_float(kv.x & 0xffff0000u), __uint_as_float(kv.y << 16), __uint_as_float(kv.y & 0xffff0000u),
                       __uint_as_float(kv.z << 16), __uint_as_float(kv.z & 0xffff0000u), __uint_as_float(kv.w << 16), __uint_as_float(kv.w & 0xffff0000u)};
        float ss = 0.f;
#pragma unroll
        for (int e = 0; e < 8; ++e) ss += kf[e] * kf[e];
        ss = sum8(ss);
        const float rk = rsqrtf(ss * (1.f / 64.f) + EPS);
        const f32x4 g0 = *(const f32x4*)(kg + ch * 8), g1 = *(const f32x4*)(kg + ch * 8 + 4);
        v4u pk; pk.x = pkbf(kf[0] * rk * g0.x, kf[1] * rk * g0.y); pk.y = pkbf(kf[2] * rk * g0.z, kf[3] * rk * g0.w); pk.z = pkbf(kf[4] * rk * g1.x, kf[5] * rk * g1.y); pk.w = pkbf(kf[6] * rk * g1.z, kf[7] * rk * g1.w);
        *(LAS v4u*)(kimg + (m * 72 + ch * 8) * 2) = pk;
        *(LAS v4u*)(vimg + (m * 72 + ch * 8) * 2) = vv;
    }
    __syncthreads();
    const int r = lane & 31, h = lane >> 5;
    const int t = b * S + qb * 256 + wave * 32 + r;
    s16x8 qf[4];
    {
        f32x8 qv[4]; float ss = 0.f;
#pragma unroll
        for (int ks = 0; ks < 4; ++ks) {
            const v4u q = *(const GAS v4u*)(proj + (size_t)t * NPROJ + PC_QMEM + hd * 64 + ks * 16 + 8 * h);
            qv[ks] = (f32x8){__uint_as_float(q.x << 16), __uint_as_float(q.x & 0xffff0000u), __uint_as_float(q.y << 16), __uint_as_float(q.y & 0xffff0000u),
                             __uint_as_float(q.z << 16), __uint_as_float(q.z & 0xffff0000u), __uint_as_float(q.w << 16), __uint_as_float(q.w & 0xffff0000u)};
#pragma unroll
            for (int e = 0; e < 8; ++e) ss += qv[ks][e] * qv[ks][e];
        }
        ss = swap32_add(ss, ss);
        const float rq = rsqrtf(ss * (1.f / 64.f) + EPS) * (0.125f * LOG2E);
#pragma unroll
        for (int ks = 0; ks < 4; ++ks) {
            const f32x4 g0 = *(const f32x4*)(qg + ks * 16 + 8 * h), g1 = *(const f32x4*)(qg + ks * 16 + 8 * h + 4);
            qf[ks] = cvt8(qv[ks] * rq * (f32x8){g0.x, g0.y, g0.z, g0.w, g1.x, g1.y, g1.z, g1.w});
        }
    }
    f32x16 st[8];
    float mx = -INFINITY;
#pragma unroll
    for (int kt = 0; kt < 8; ++kt) {
        st[kt] = zero16();
#pragma unroll
        for (int ks = 0; ks < 4; ++ks) st[kt] = MFMA32(*(const LAS s16x8*)(kimg + ((kt * 32 + r) * 72 + ks * 16 + 8 * h) * 2), qf[ks], st[kt]);
#pragma unroll
        for (int i = 0; i < 16; ++i) mx = fmaxf(mx, st[kt][i]);
    }
    mx = swap32_max(mx);
    float lsum = 0.f;
    f32x16 o0 = zero16(), o1 = zero16();
#pragma unroll
    for (int kt = 0; kt < 8; ++kt) {
#pragma unroll
        for (int i = 0; i < 16; ++i) { st[kt][i] = __builtin_amdgcn_exp2f(st[kt][i] - mx); lsum += st[kt][i]; }
#pragma unroll
        for (int ks = 0; ks < 2; ++ks) {
            const s16x8 pf = pack_acc(st[kt], ks);
            o0 = MFMA32(trv_frag(vimg, kt * 32, ks, 0, lane), pf, o0);
            o1 = MFMA32(trv_frag(vimg, kt * 32, ks, 1, lane), pf, o1);
        }
    }
    lsum = swap32_add(lsum, lsum);
    const float il = 1.f / lsum; float ssq = 0.f;
    bf16* yc = (bf16*)(ws + WS_YCAT) + (size_t)t * D + 768 + hd * 64 + 4 * h;
#pragma unroll
    for (int i4 = 0; i4 < 4; ++i4) {
        const float a0 = o0[4 * i4] * il, a1 = o0[4 * i4 + 1] * il, a2 = o0[4 * i4 + 2] * il, a3 = o0[4 * i4 + 3] * il;
        const float b0 = o1[4 * i4] * il, b1 = o1[4 * i4 + 1] * il, b2 = o1[4 * i4 + 2] * il, b3 = o1[4 * i4 + 3] * il;
        ssq += (a0 * a0 + a1 * a1) + (a2 * a2 + a3 * a3) + (b0 * b0 + b1 * b1) + (b2 * b2 + b3 * b3);
        u32x2 w; w.x = pkbf(a0, a1); w.y = pkbf(a2, a3); *(GAS u32x2*)(yc + 8 * i4) = w;
        w.x = pkbf(b0, b1); w.y = pkbf(b2, b3); *(GAS u32x2*)(yc + 32 + 8 * i4) = w;
    }
    ssq = swap32_add(ssq, ssq);
    if (h == 0) ((float*)(ws + WS_YSSQ))[(size_t)t * 16 + 12 + hd] = ssq;
    __syncthreads();
}
__device__ __forceinline__ void sb_unit(unsigned char* ws, LAS unsigned char* lds, int b, int hd, int qb, int tid, int wave, int lane) {
    const bf16* proj = (const bf16*)(ws + WS_PROJ);
    const int r = lane & 31, h = lane >> 5;
    const int q0w = qb * 256 + wave * 32, t = b * S + q0w + r;
    s16x8 qf[4];
#pragma unroll
    for (int ks = 0; ks < 4; ++ks) {
        const v4u q = *(const GAS v4u*)(proj + (size_t)t * NPROJ + PC_QSB + hd * 64 + ks * 16 + 8 * h);
        const f32x8 qv = (f32x8){__uint_as_float(q.x << 16), __uint_as_float(q.x & 0xffff0000u), __uint_as_float(q.y << 16), __uint_as_float(q.y & 0xffff0000u),
                                 __uint_as_float(q.z << 16), __uint_as_float(q.z & 0xffff0000u), __uint_as_float(q.w << 16), __uint_as_float(q.w & 0xffff0000u)};
        qf[ks] = cvt8(qv * (0.125f * LOG2E));
    }
    const int srow = tid >> 3, sch = tid & 7;
    const bf16* kbase = proj + (size_t)(b * S) * NPROJ + PC_KSB + hd * 64 + sch * 8;
    const int ktop = qb * 4 + 3;
    v4u kr = *(const GAS v4u*)(kbase + (size_t)(ktop * 64 + srow) * NPROJ), vr = *(const GAS v4u*)(kbase + (size_t)(ktop * 64 + srow) * NPROJ + (PC_VSB - PC_KSB));
    *(LAS v4u*)(lds + (srow * 72 + sch * 8) * 2) = kr; *(LAS v4u*)(lds + 9216 + (srow * 72 + sch * 8) * 2) = vr;
    __syncthreads();
    f32x16 o0 = zero16(), o1 = zero16();
    float R = 0.f;
    volatile LAS unsigned* live = (volatile LAS unsigned*)(lds + 36864);
    bool mylive = true;
    for (int kt = ktop; kt >= 0; --kt) {
        LAS unsigned char* kimg = lds + ((ktop - kt) & 1) * 18432; LAS unsigned char* vimg = kimg + 9216;
        if (kt > 0) { kr = *(const GAS v4u*)(kbase + (size_t)((kt - 1) * 64 + srow) * NPROJ); vr = *(const GAS v4u*)(kbase + (size_t)((kt - 1) * 64 + srow) * NPROJ + (PC_VSB - PC_KSB)); }
#pragma unroll
        for (int sub = 1; sub >= 0; --sub) {
            const int kb = kt * 64 + sub * 32;
            if (kb <= q0w && mylive) {
                const bool diag = (kb == q0w);
                f32x16 z = zero16();
#pragma unroll
                for (int ks = 0; ks < 4; ++ks) z = MFMA32(*(const LAS s16x8*)(kimg + ((sub * 32 + r) * 72 + ks * 16 + 8 * h) * 2), qf[ks], z);
                float lk[16];
#pragma unroll
                for (int i = 0; i < 16; ++i) {
                    const float sp = fmaxf(z[i], 0.f) + __builtin_amdgcn_logf(1.f + __builtin_amdgcn_exp2f(-fabsf(z[i])));
                    const bool ok = !diag || (crow(i, h) < r);
                    lk[i] = ok ? -sp : 0.f;
                    z[i] = ok ? z[i] : -INFINITY;
                }
                float g[4], pg[4];
#pragma unroll
                for (int j = 0; j < 4; ++j) { g[j] = (lk[4 * j] + lk[4 * j + 1]) + (lk[4 * j + 2] + lk[4 * j + 3]); pg[j] = partner32(g[j], h != 0); }
                float ab[4];
                ab[3] = R + (h == 0 ? pg[3] : 0.f);
#pragma unroll
                for (int j = 2; j >= 0; --j) ab[j] = ab[j + 1] + g[j + 1] + (h == 0 ? pg[j] : pg[j + 1]);
#pragma unroll
                for (int j = 0; j < 4; ++j) {
                    const float s3 = ab[j], s2 = s3 + lk[4 * j + 3], s1 = s2 + lk[4 * j + 2], s0 = s1 + lk[4 * j + 1];
                    z[4 * j + 3] = __builtin_amdgcn_exp2f(z[4 * j + 3] + lk[4 * j + 3] + s3);
                    z[4 * j + 2] = __builtin_amdgcn_exp2f(z[4 * j + 2] + lk[4 * j + 2] + s2);
                    z[4 * j + 1] = __builtin_amdgcn_exp2f(z[4 * j + 1] + lk[4 * j + 1] + s1);
                    z[4 * j + 0] = __builtin_amdgcn_exp2f(z[4 * j + 0] + lk[4 * j + 0] + s0);
                }
                R = ab[0] + g[0] + (h == 0 ? 0.f : pg[0]);
#pragma unroll
                for (int ks = 0; ks < 2; ++ks) {
                    const s16x8 pf = pack_acc(z, ks);
                    o0 = MFMA32(trv_frag(vimg, sub * 32, ks, 0, lane), pf, o0);
                    o1 = MFMA32(trv_frag(vimg, sub * 32, ks, 1, lane), pf, o1);
                }
            }
        }
        if (kt > 0) { LAS unsigned char* nimg = lds + ((ktop - kt + 1) & 1) * 18432; *(LAS v4u*)(nimg + (srow * 72 + sch * 8) * 2) = kr; *(LAS v4u*)(nimg + 9216 + (srow * 72 + sch * 8) * 2) = vr; }
        mylive = mylive && (__builtin_amdgcn_ballot_w64(R >= -150.f) != 0ull);
        if (lane == 0) live[((ktop - kt) & 1) * 8 + wave] = mylive ? 1u : 0u;
        __syncthreads();
        { unsigned any = 0u;
#pragma unroll
          for (int w = 0; w < 8; ++w) any |= live[((ktop - kt) & 1) * 8 + w];
          if (any == 0u) break; }
    }
    float ssq = 0.f;
    bf16* yc = (bf16*)(ws + WS_YCAT) + (size_t)t * D + 384 + hd * 64 + 4 * h;
#pragma unroll
    for (int i4 = 0; i4 < 4; ++i4) {
        const float a0 = o0[4 * i4], a1 = o0[4 * i4 + 1], a2 = o0[4 * i4 + 2], a3 = o0[4 * i4 + 3];
        const float b0 = o1[4 * i4], b1 = o1[4 * i4 + 1], b2 = o1[4 * i4 + 2], b3 = o1[4 * i4 + 3];
        ssq += (a0 * a0 + a1 * a1) + (a2 * a2 + a3 * a3) + (b0 * b0 + b1 * b1) + (b2 * b2 + b3 * b3);
        u32x2 w; w.x = pkbf(a0, a1); w.y = pkbf(a2, a3); *(GAS u32x2*)(yc + 8 * i4) = w;
        w.x = pkbf(b0, b1); w.y = pkbf(b2, b3); *(GAS u32x2*)(yc + 32 + 8 * i4) = w;
    }
    ssq = swap32_add(ssq, ssq);
    if (h == 0) ((float*)(ws + WS_YSSQ))[(size_t)t * 16 + 6 + hd] = ssq;
}
constexpr int CW_Q = 8192;
__device__ __forceinline__ void ph_mix(const Args& a, unsigned char* ws, LAS unsigned char* lds, int l, int qoff, int tid, int wave, int lane) {
    unsigned* head = (unsigned*)(ws + WS_CTL) + CW_Q + 64 * l + qoff;
    volatile LAS unsigned* slot = (volatile LAS unsigned*)(lds + MISC_OFF);
    for (int it = 0;; ++it) {
        if (tid == 0) slot[it & 1] = __hip_atomic_fetch_add(head, 1u, __ATOMIC_RELAXED, __HIP_MEMORY_SCOPE_AGENT);
        __syncthreads();
        const int n = (int)slot[it & 1];
        if (n >= 896) break;
        asm volatile("" : "+s"(ws), "+v"(tid));
        lane = tid & 63; wave = __builtin_amdgcn_readfirstlane(tid >> 6);
        if (n < 384) { const int qb = 15 - n / 24, bh = n % 24; sb_unit(ws, lds, bh / 6, bh % 6, qb, tid, wave, lane); }
        else if (n < 640) { const int m = n - 384; mem_unit(a, ws, lds, l, m >> 6, (m >> 4) & 3, m & 15, tid, wave, lane); }
        else ssd_chunk_unit(a, ws, lds, l, n - 640, tid, wave, lane);
    }
}

__device__ __forceinline__ unsigned f2o(float f) { const unsigned b = __float_as_uint(f); return b ^ ((unsigned)((int)b >> 31) | 0x80000000u); }
__device__ __forceinline__ float o2f(unsigned k) { return __uint_as_float(k ^ ((k & 0x80000000u) ? 0x80000000u : 0xffffffffu)); }
#define TK_CE(a, b) do { const unsigned _mx = (a) > (b) ? (a) : (b), _mn = (a) > (b) ? (b) : (a); (a) = _mx; (b) = _mn; } while (0)
template <int N, int BASE> __device__ __forceinline__ void tk_sort16(unsigned (&k)[N]) {
#pragma unroll
    for (int sz = 2; sz <= 16; sz <<= 1)
#pragma unroll
        for (int j = sz >> 1; j > 0; j >>= 1)
#pragma unroll
            for (int i = 0; i < 16; ++i) { const int l = i ^ j; if (l > i) { if ((i & sz) == 0) TK_CE(k[BASE + i], k[BASE + l]); else TK_CE(k[BASE + l], k[BASE + i]); } }
}
template <int NA, int A, int NB_, int B> __device__ __forceinline__ void tk_merge16(unsigned (&ka)[NA], const unsigned (&kb)[NB_]) {
#pragma unroll
    for (int i = 0; i < 16; ++i) ka[A + i] = ka[A + i] > kb[B + 15 - i] ? ka[A + i] : kb[B + 15 - i];
#pragma unroll
    for (int j = 8; j > 0; j >>= 1)
#pragma unroll
        for (int i = 0; i < 16; ++i) { const int l = i ^ j; if (l > i) TK_CE(ka[A + i], ka[A + l]); }
}
__device__ __forceinline__ unsigned partner32_u(unsigned a, bool hi) { const auto r = __builtin_amdgcn_permlane32_swap(a, a, false, false); return hi ? r[0] : r[1]; }
__device__ __forceinline__ void ph_topk(unsigned char* ws, LAS unsigned char* lds, int l, int pm, int pn, int wave, int lane) {
    const bf16* qb = (const bf16*)(ws + WS_YCAT); const bf16* kb = (const bf16*)(ws + WS_KB) + (size_t)l * 16 * 128 * 64;
    int* eidx = (int*)(ws + WS_EIDX); float* gate = (float*)(ws + WS_GATE);
    LAS float* tr = (LAS float*)(lds + wave * WSCR);
    const int r = lane & 31, h = lane >> 5;
    for (int item = wave; item < 16; item += NWAVES) {
        const int hd = 2 * pn + (item & 1), t = pm * 256 + (item >> 1) * 32 + r;
        unsigned top[2][16];
#pragma unroll
        for (int c = 0; c < 2; ++c) {
            const int hc = 2 * hd + c;
            s16x8 qf[4];
#pragma unroll
            for (int ks = 0; ks < 4; ++ks) qf[ks] = *(const GAS s16x8*)(qb + (size_t)t * D + hc * 64 + ks * 16 + 8 * h);
            unsigned k[64];
#pragma unroll
            for (int nt = 0; nt < 4; ++nt) {
                f32x16 acc = zero16();
#pragma unroll
                for (int ks = 0; ks < 4; ++ks) acc = MFMA32(*(const GAS s16x8*)(kb + (size_t)(hc * 128 + nt * 32 + r) * 64 + ks * 16 + 8 * h), qf[ks], acc);
#pragma unroll
                for (int i = 0; i < 16; ++i) k[16 * nt + i] = (f2o(acc[i]) & ~127u) | (unsigned)((127 - 32 * nt - 8 * (i >> 2) - (i & 3)) - 4 * h);
            }
            tk_sort16<64, 0>(k); tk_sort16<64, 16>(k); tk_sort16<64, 32>(k); tk_sort16<64, 48>(k);
            tk_merge16<64, 0, 64, 16>(k, k); tk_merge16<64, 32, 64, 48>(k, k); tk_merge16<64, 0, 64, 32>(k, k);
            unsigned pk[16];
#pragma unroll
            for (int i = 0; i < 16; ++i) { top[c][i] = k[i]; pk[i] = partner32_u(k[i], h != 0); }
            tk_merge16<16, 0, 16, 0>(top[c], pk);
        }
        const int b = 0; (void)b;
        float av[16], bv[16];
#pragma unroll
        for (int i = 0; i < 16; ++i) { av[i] = o2f(top[0][i] & ~127u); bv[i] = o2f(top[1][i] & ~127u); }
        LAS int* li = (LAS int*)tr + lane * 32;
#pragma unroll
        for (int i = 0; i < 16; ++i) { li[i] = 127 - (int)(top[0][i] & 127u); li[16 + i] = 127 - (int)(top[1][i] & 127u); }
        unsigned key[64];
        key[0] = (f2o(av[0] + bv[0]) & ~255u) | 255u;
        key[1] = (f2o(av[0] + bv[1]) & ~255u) | 254u;
        key[2] = (f2o(av[0] + bv[2]) & ~255u) | 253u;
        key[3] = (f2o(av[0] + bv[3]) & ~255u) | 252u;
        key[4] = (f2o(av[0] + bv[4]) & ~255u) | 251u;
        key[5] = (f2o(av[0] + bv[5]) & ~255u) | 250u;
        key[6] = (f2o(av[0] + bv[6]) & ~255u) | 249u;
        key[7] = (f2o(av[0] + bv[7]) & ~255u) | 248u;
        key[8] = (f2o(av[0] + bv[8]) & ~255u) | 247u;
        key[9] = (f2o(av[0] + bv[9]) & ~255u) | 246u;
        key[10] = (f2o(av[0] + bv[10]) & ~255u) | 245u;
        key[11] = (f2o(av[0] + bv[11]) & ~255u) | 244u;
        key[12] = (f2o(av[0] + bv[12]) & ~255u) | 243u;
        key[13] = (f2o(av[0] + bv[13]) & ~255u) | 242u;
        key[14] = (f2o(av[0] + bv[14]) & ~255u) | 241u;
        key[15] = (f2o(av[0] + bv[15]) & ~255u) | 240u;
        key[16] = (f2o(av[1] + bv[0]) & ~255u) | 239u;
        key[17] = (f2o(av[1] + bv[1]) & ~255u) | 238u;
        key[18] = (f2o(av[1] + bv[2]) & ~255u) | 237u;
        key[19] = (f2o(av[1] + bv[3]) & ~255u) | 236u;
        key[20] = (f2o(av[1] + bv[4]) & ~255u) | 235u;
        key[21] = (f2o(av[1] + bv[5]) & ~255u) | 234u;
        key[22] = (f2o(av[1] + bv[6]) & ~255u) | 233u;
        key[23] = (f2o(av[1] + bv[7]) & ~255u) | 232u;
        key[24] = (f2o(av[2] + bv[0]) & ~255u) | 223u;
        key[25] = (f2o(av[2] + bv[1]) & ~255u) | 222u;
        key[26] = (f2o(av[2] + bv[2]) & ~255u) | 221u;
        key[27] = (f2o(av[2] + bv[3]) & ~255u) | 220u;
        key[28] = (f2o(av[2] + bv[4]) & ~255u) | 219u;
        key[29] = (f2o(av[3] + bv[0]) & ~255u) | 207u;
        key[30] = (f2o(av[3] + bv[1]) & ~255u) | 206u;
        key[31] = (f2o(av[3] + bv[2]) & ~255u) | 205u;
        key[32] = (f2o(av[3] + bv[3]) & ~255u) | 204u;
        key[33] = (f2o(av[4] + bv[0]) & ~255u) | 191u;
        key[34] = (f2o(av[4] + bv[1]) & ~255u) | 190u;
        key[35] = (f2o(av[4] + bv[2]) & ~255u) | 189u;
        key[36] = (f2o(av[5] + bv[0]) & ~255u) | 175u;
        key[37] = (f2o(av[5] + bv[1]) & ~255u) | 174u;
        key[38] = (f2o(av[6] + bv[0]) & ~255u) | 159u;
        key[39] = (f2o(av[6] + bv[1]) & ~255u) | 158u;
        key[40] = (f2o(av[7] + bv[0]) & ~255u) | 143u;
        key[41] = (f2o(av[7] + bv[1]) & ~255u) | 142u;
        key[42] = (f2o(av[8] + bv[0]) & ~255u) | 127u;
        key[43] = (f2o(av[9] + bv[0]) & ~255u) | 111u;
        key[44] = (f2o(av[10] + bv[0]) & ~255u) | 95u;
        key[45] = (f2o(av[11] + bv[0]) & ~255u) | 79u;
        key[46] = (f2o(av[12] + bv[0]) & ~255u) | 63u;
        key[47] = (f2o(av[13] + bv[0]) & ~255u) | 47u;
        key[48] = (f2o(av[14] + bv[0]) & ~255u) | 31u;
        key[49] = (f2o(av[15] + bv[0]) & ~255u) | 15u;
#pragma unroll
        for (int i = 50; i < 64; ++i) key[i] = 0u;
        tk_sort16<64, 0>(key); tk_sort16<64, 16>(key); tk_sort16<64, 32>(key); tk_sort16<64, 48>(key);
        tk_merge16<64, 0, 64, 16>(key, key); tk_merge16<64, 32, 64, 48>(key, key); tk_merge16<64, 0, 64, 32>(key, key);
        asm volatile("s_waitcnt lgkmcnt(0)" ::: "memory");
        const float s0 = o2f(key[0] & ~255u);
        float ev[16]; int ei[16]; float den = 0.f;
#pragma unroll
        for (int w = 0; w < 16; ++w) {
            const unsigned ij = 255u - (key[w] & 255u);
            ev[w] = __expf(o2f(key[w] & ~255u) - s0); den += ev[w];
            ei[w] = li[ij >> 4] * 128 + li[16 + (ij & 15)];
        }
        const float inv = 1.f / den;
        const size_t ob = ((size_t)t * 8 + hd) * 16;
        if (h == 0) {
#pragma unroll
            for (int q = 0; q < 4; ++q) {
                typedef int i32x4 __attribute__((ext_vector_type(4)));
                *(GAS i32x4*)(eidx + ob + 4 * q) = (i32x4){ei[4 * q], ei[4 * q + 1], ei[4 * q + 2], ei[4 * q + 3]};
                *(GAS f32x4*)(gate + ob + 4 * q) = (f32x4){ev[4 * q] * inv, ev[4 * q + 1] * inv, ev[4 * q + 2] * inv, ev[4 * q + 3] * inv};
            }
        }
        asm volatile("s_waitcnt lgkmcnt(0)" ::: "memory");
    }
}

__device__ __forceinline__ float gelu_erf(float v) { return 0.5f * v * (1.f + erff(v * 0.70710678118654752f)); }
typedef __attribute__((ext_vector_type(2))) float f32x2v;
constexpr int CW_Q2 = 12288;
__device__ __forceinline__ void cvt16(const v4u r, float (&f)[16]) {
    const unsigned w[4] = {r.x, r.y, r.z, r.w};
#pragma unroll
    for (int i = 0; i < 4; ++i) { const f32x2v lo = __builtin_amdgcn_cvt_pk_f32_fp8((int)w[i], false), hi = __builtin_amdgcn_cvt_pk_f32_fp8((int)w[i], true); f[4 * i] = lo.x; f[4 * i + 1] = lo.y; f[4 * i + 2] = hi.x; f[4 * i + 3] = hi.y; }
}
constexpr int PCH = 256, PTW = PCH / 8;
typedef __attribute__((ext_vector_type(4))) int i32x4;
struct PIdx { i32x4 e[4]; };
struct PTok { v4u r[16]; f32x4 w[4]; v4u xa, xc; };
template <int QSET> __device__ __forceinline__ void peer_idx(PIdx& I, const GAS int* eidx, int t, int lane) {
    const GAS i32x4* ep = (const GAS i32x4*)(eidx + (size_t)t * 128 + 16 * (lane >> 3));
#pragma unroll
    for (int q = 0; q < 4; ++q) I.e[q] = ep[q];
#if defined(MK_PROBE_EMASK)
    if (QSET == 1) {
#pragma unroll
        for (int q = 0; q < 4; ++q) I.e[q] = I.e[q] & MK_PROBE_EMASK;
    }
#endif
}
template <int PHASE> __device__ __forceinline__ void peer_rows(PTok& K, const PIdx& I, const GAS unsigned char* tab, const GAS float* wgt, const GAS bf16* xb, int t, int s, int lane) {
    const int g = lane >> 3, j = lane & 7;
#pragma unroll
    for (int i = 0; i < 16; ++i) K.r[i] = *(const GAS v4u*)(tab + (size_t)(unsigned)I.e[i >> 2][i & 3] * 128 + 16 * j);
    if (PHASE == 0) { const GAS unsigned char* xrow = (const GAS unsigned char*)(xb + (size_t)t * D + s * 128 + 16 * j); K.xa = *(const GAS v4u*)xrow; K.xc = *(const GAS v4u*)(xrow + 16); }
    else { const GAS f32x4* wp = (const GAS f32x4*)(wgt + (size_t)t * 128 + 16 * g);
#pragma unroll
        for (int q = 0; q < 4; ++q) K.w[q] = wp[q]; }
}
__device__ __forceinline__ void cvt16p(const v4u r, f32x2v (&f)[8]) {
    const unsigned w[4] = {r.x, r.y, r.z, r.w};
#pragma unroll
    for (int i = 0; i < 4; ++i) { f[2 * i] = __builtin_amdgcn_cvt_pk_f32_fp8((int)w[i], false); f[2 * i + 1] = __builtin_amdgcn_cvt_pk_f32_fp8((int)w[i], true); }
}
__device__ __forceinline__ void peer_u_compute(const PTok& K, LAS float* lpart, int lane) {
    const int g = lane >> 3, j = lane & 7;
    f32x2v xv[8];
    { const unsigned xw[8] = {K.xa.x, K.xa.y, K.xa.z, K.xa.w, K.xc.x, K.xc.y, K.xc.z, K.xc.w};
#pragma unroll
      for (int i = 0; i < 8; ++i) xv[i] = (f32x2v){__uint_as_float(xw[i] << 16), __uint_as_float(xw[i] & 0xffff0000u)}; }
    float res_lo = 0.f, res_hi = 0.f;
#pragma unroll
    for (int i = 0; i < 16; ++i) {
        f32x2v f[8]; cvt16p(K.r[i], f);
        f32x2v a0 = xv[0] * f[0], a1 = xv[1] * f[1];
#pragma unroll
        for (int k = 2; k < 8; k += 2) { a0 = a0 + xv[k] * f[k]; a1 = a1 + xv[k + 1] * f[k + 1]; }
        const f32x2v a = a0 + a1;
        const float d = sum8(a.x + a.y);
        if (i < 8) res_lo = (j == i) ? d : res_lo; else res_hi = (j == i - 8) ? d : res_hi;
    }
    lpart[16 * g + j] = res_lo; lpart[16 * g + 8 + j] = res_hi;
}
__device__ __forceinline__ void peer_v_compute(const PTok& K, LAS float* lout, int lane) {
    const int g = lane >> 3, j = lane & 7;
    f32x2v acc[8];
#pragma unroll
    for (int k = 0; k < 8; ++k) acc[k] = (f32x2v){0.f, 0.f};
#pragma unroll
    for (int i = 0; i < 16; ++i) {
        f32x2v f[8]; cvt16p(K.r[i], f);
        const float wi = K.w[i >> 2][i & 3]; const f32x2v w2 = {wi, wi};
#pragma unroll
        for (int k = 0; k < 8; ++k) acc[k] = acc[k] + w2 * f[k];
    }
    float o[16];
#pragma unroll
    for (int k = 0; k < 8; ++k) {
        float a = acc[k].x, b = acc[k].y;
        a += dpp_f<0x128>(a); b += dpp_f<0x128>(b); a = swap16_add(a, a); b = swap16_add(b, b); o[2 * k] = swap32_add(a, a); o[2 * k + 1] = swap32_add(b, b);
    }
    if (g == 0) {
#pragma unroll
        for (int q = 0; q < 4; ++q) *(LAS f32x4*)(lout + 16 * j + 4 * q) = (f32x4){o[4 * q], o[4 * q + 1], o[4 * q + 2], o[4 * q + 3]};
    }
}
template <int PHASE, int QSET = 0> __device__ __forceinline__ void ph_peer_sliced(unsigned char* ws, LAS unsigned char* lds, float* xout, int l, int tid, int wave, int lane) {
    unsigned* heads = (unsigned*)(ws + WS_CTL) + CW_Q2 + ((QSET * 2 + l) * 2 + PHASE) * 8 * 64;
    volatile LAS unsigned* slot = (volatile LAS unsigned*)(lds + MISC_OFF);
    const GAS int* eidx = (const GAS int*)(ws + WS_EIDX); const GAS float* wgt = (const GAS float*)(ws + WS_GATE); GAS bf16* xb = (GAS bf16*)(ws + WS_XB);
    const int myx = (int)(xb_xcc_id() & 7u);
    int it = 0;
    for (int k = 0; k < 8; ++k) {
        const int s = (myx + k) & 7;
        const GAS unsigned char* tab = (const GAS unsigned char*)(ws + (PHASE == 0 ? WS_UT : WS_VT) + (size_t)l * 16384 * D + (size_t)s * 16384 * 128);
        GAS float* part = (GAS float*)(ws + WS_PART) + (size_t)s * T * 128;
        for (;; ++it) {
            if (tid == 0) slot[it & 1] = __hip_atomic_fetch_add(heads + 64 * s, 1u, __ATOMIC_RELAXED, __HIP_MEMORY_SCOPE_AGENT);
            __syncthreads();
            const int c = (int)slot[it & 1];
            if (c >= T / PCH) { ++it; break; }
            const int t0 = c * PCH + wave * PTW;
            LAS float* stg = (LAS float*)(lds + wave * WSCR);
            PIdx iB, iC; PTok A, B;
            peer_idx<QSET>(iB, eidx, t0, lane);
            peer_rows<PHASE>(A, iB, tab, wgt, xb, t0, s, lane);
            peer_idx<QSET>(iB, eidx, t0 + 1, lane);
#pragma unroll 2
            for (int i = 0; i < PTW; ++i) {
                peer_idx<QSET>(iC, eidx, t0 + (i + 2 < PTW ? i + 2 : PTW - 1), lane);
                peer_rows<PHASE>(B, iB, tab, wgt, xb, t0 + (i + 1 < PTW ? i + 1 : PTW - 1), s, lane);
                if (PHASE == 0) peer_u_compute(A, stg + i * 128, lane); else peer_v_compute(A, stg + i * 128, lane);
                A = B; iB = iC;
            }
            asm volatile("s_waitcnt lgkmcnt(0)" ::: "memory");
            if (PHASE == 0) {
#pragma unroll
                for (int q = 0; q < PTW * 128 / 256; ++q) *(GAS f32x4*)(part + (size_t)t0 * 128 + q * 256 + lane * 4) = *(const LAS f32x4*)(stg + q * 256 + lane * 4);
            } else {
                GAS float* xo = (GAS float*)xout; GAS float* rs1p = (GAS float*)(ws + WS_RS1P); GAS bf16* xbo = xb;
                if (QSET == 1) { xo = (GAS float*)(ws + WS_PART); xbo = (GAS bf16*)(ws + WS_PART + 64 * MiB); rs1p = (GAS float*)(ws + WS_PART + 100 * MiB); }
#pragma unroll 4
                for (int q = 0; q < PTW / 2; ++q) {
                    const int tk = 2 * q + (lane >> 5), cq = lane & 31, t = t0 + tk;
                    GAS float* xr = xo + (size_t)t * D + s * 128 + 4 * cq;
                    const f32x4 av = *(const LAS f32x4*)(stg + tk * 128 + 4 * cq); f32x4 xv = *(const GAS f32x4*)((GAS float*)xout + (size_t)t * D + s * 128 + 4 * cq);
                    xv = xv + av;
                    *(GAS f32x4*)xr = xv;
                    u32x2 w; w.x = pkbf(xv.x, xv.y); w.y = pkbf(xv.z, xv.w); *(GAS u32x2*)(xbo + (size_t)t * D + s * 128 + 4 * cq) = w;
                    float s2 = (xv.x * xv.x + xv.y * xv.y) + (xv.z * xv.z + xv.w * xv.w);
                    s2 = sum16(s2); s2 = swap16_add(s2, s2);
                    if (cq == 0) rs1p[(size_t)t * 8 + s] = s2;
                }
            }
            asm volatile("s_waitcnt lgkmcnt(0)" ::: "memory");
        }
    }
}
__device__ __forceinline__ void ph_peer_w(unsigned char* ws, int l, int gw, int NGW, int lane) {
    const GAS int* eidx = (const GAS int*)(ws + WS_EIDX); GAS float* gate = (GAS float*)(ws + WS_GATE); const GAS float* part = (const GAS float*)(ws + WS_PART);
    const GAS float* usc = (const GAS float*)(ws + WS_USC) + l * 16384; const GAS float* vsc = (const GAS float*)(ws + WS_VSC) + l * 16384; const GAS float* xssq = (const GAS float*)(ws + WS_XSSQ);
    for (int t = gw; t < T; t += NGW) {
        const float r2 = rsqrtf(sum16(xssq[(size_t)t * 16 + (lane & 15)]) * (1.f / 1024.f) + EPS);
#pragma unroll
        for (int hh = 0; hh < 2; ++hh) {
            const size_t q = (size_t)t * 128 + 64 * hh + lane;
            float a = 0.f;
#pragma unroll
            for (int s = 0; s < 8; ++s) a += part[(size_t)s * T * 128 + q];
            const int e = eidx[q];
            gate[q] = gate[q] * gelu_erf(a * (r2 * usc[e])) * vsc[e];
        }
    }
}

constexpr int NPH_L = 9, NPHASES = 1 + NL * NPH_L;
#ifndef MK_PHMASK
#define MK_PHMASK 0x7ff
#endif
#define PH_ON(j) ((MK_PHMASK >> (j)) & 1)
#ifndef MK_REP
#define MK_REP 0
#endif
#define PH_REP(j) ((MK_REP >> (j)) & 1)
__global__ void __launch_bounds__(NWAVES * 64, 2) mega(Args a) {
    extern __shared__ __attribute__((aligned(16))) unsigned char lds_raw[];
    {
        LAS unsigned char* lds0 = (LAS unsigned char*)lds_raw;
        for (int u = threadIdx.x; u < (LDS_BYTES - LDSCTL_OFF) / 4; u += NWAVES * 64) ((LAS unsigned*)(lds0 + LDSCTL_OFF))[u] = 0u;
        __syncthreads();
    }
    int wave0 = __builtin_amdgcn_readfirstlane((int)threadIdx.x >> 6); asm volatile("" : "+s"(wave0));
    int ph_lo = a.ph_lo, ph_hi = a.ph_hi; asm volatile("" : "+s"(ph_lo), "+s"(ph_hi));
    const bool multi = (ph_hi - ph_lo) > 1;
    XcdBarrier bar; bar.bar = (unsigned*)(a.ws + WS_CTL) + CW_BAR + a.li * XCD_BAR_WORDS; bar.x = 0; bar.st = nullptr;
    if (multi) bar = xcd_barrier_post((unsigned*)(a.ws + WS_CTL) + CW_BAR + a.li * XCD_BAR_WORDS, (volatile LAS unsigned*)((LAS unsigned char*)lds_raw + MISC_OFF) + 8);

#if defined(MK_UBENCH)
    {
        unsigned v0 = threadIdx.x * 2654435761u, v1 = v0 ^ 0x3c3c3c3cu; float f0 = 1.0f + (float)(threadIdx.x & 7), f1 = 2.0f; unsigned long long pp = v0, qq = v1;
        for (int it = 0; it < 2500; ++it) {
#pragma unroll
            for (int k = 0; k < 8; ++k) {
#if MK_UBENCH == 1
                asm volatile("v_cvt_pk_f32_fp8 %0, %1\n" : "=v"(pp) : "v"(v0));
#elif MK_UBENCH == 2
                asm volatile("v_cvt_pk_f32_fp8_sdwa %0, %1 src0_sel:WORD_1\n" : "=v"(pp) : "v"(v0));
#elif MK_UBENCH == 3
                asm volatile("v_cvt_pk_fp8_f32 %0, %1, %2\n" : "+v"(v0) : "v"(f0), "v"(f1));
#elif MK_UBENCH == 4
                asm volatile("v_fma_f32 %0, %1, %2, %0\n" : "+v"(f0) : "v"(f1), "v"(f1));
#elif MK_UBENCH == 5
                asm volatile("ds_bpermute_b32 %0, %1, %0\n s_waitcnt lgkmcnt(0)\n" : "+v"(v0) : "v"(v1));
#elif MK_UBENCH == 7
                { typedef __attribute__((ext_vector_type(8))) int i32x8b; i32x8b aa = {(int)v0, (int)v1, (int)v0, (int)v1, (int)v0, (int)v1, (int)v0, (int)v1};
                  f32x4 cc = {f0, f1, f0, f1}; cc = __builtin_amdgcn_mfma_scale_f32_16x16x128_f8f6f4(aa, aa, cc, 0, 0, 0, 0x7f7f7f7f, 0, 0x7f7f7f7f); f0 = cc[0]; f1 = cc[1]; asm volatile("" : "+v"(f0), "+v"(f1)); }
#elif MK_UBENCH == 6
                asm volatile("v_pk_fma_f32 %0, %1, %1, %0\n" : "+v"(pp) : "v"(qq));
#endif
            }
        }
        if (f0 == 1.2345e30f && v0 == 0x12345u && pp == 77ull && qq == 78ull) a.out[0] = f0;
    }
#endif
    for (int ph = ph_lo; ph < ph_hi; ++ph) {
        unsigned char* ws = a.ws; asm volatile("" : "+s"(ws));
        int G = (int)gridDim.x; asm volatile("" : "+s"(G));
        int bx = (int)blockIdx.x; asm volatile("" : "+s"(bx));
        int tid; asm volatile("v_mbcnt_lo_u32_b32 %0, -1, 0\n\tv_mbcnt_hi_u32_b32 %0, -1, %0" : "=v"(tid)); tid |= wave0 << 6;
        LAS unsigned char* lds = (LAS unsigned char*)lds_raw;
        const int lane = tid & 63, wave = __builtin_amdgcn_readfirstlane(tid >> 6);
        const int vcu = (G % 8 == 0) ? (bx % 8) * (G / 8) + bx / 8 : bx;
        const int gw = vcu * NWAVES + wave, NGW = G * NWAVES;
        if (ph == 0) {
            if (PH_ON(10)) for (int rep = 0; rep < 1 + PH_REP(10); ++rep) ph_prologue(a, ws, lds, gw, NGW, wave, lane);
        } else {
            const int l = (ph - 1) / NPH_L, j = (ph - 1) % NPH_L;
            if (j == 0 && PH_ON(0)) {
              for (int rep = 0; rep < 1 + PH_REP(0); ++rep) {
                { pg8::Gemm g{(const pg8::bf16_t*)(ws + WS_XB), (const pg8::bf16_t*)(ws + WS_WIN) + (size_t)l * NPROJ * D, T, NPROJ, D};
                  pg8::StaticOrder So; So.init(T, NPROJ, G, bx);
                  pg8::EpiInProj E{(pg8::bf16_t*)(ws + WS_PROJ), NPROJ, (const float*)(ws + WS_RS1P), (float*)(ws + WS_DTF), AIN(I_DTBIAS) + l * 6, 8};
                  pg8::gemm_phase<pg8::EpiInProj, pg8::StaticOrder, true, true>(lds, g, So, E, tid); }
                if (rep == 0) { const int nfull = ((T / 256) * (NPROJ / 256)) % G;
                    if (nfull == 0) convert_tables(a, ws, l, gw, NGW, lane); else if (bx >= nfull + 8) convert_tables(a, ws, l, (bx - nfull - 8) * NWAVES + wave, (G - nfull - 8) * NWAVES, lane); }
                { pg8::Gemm g{(const pg8::bf16_t*)(ws + WS_MEMB), (const pg8::bf16_t*)(ws + WS_WMEM) + (size_t)l * 512 * D, MROWS, 512, D};
                  pg8::StaticOrder So; So.init(MROWS, 512, G, (bx + G - (((T / 256) * (NPROJ / 256)) % G)) % G);
                  pg8::EpiInProj E{(pg8::bf16_t*)(ws + WS_MEMKV), 512, (const float*)(ws + WS_RSM), nullptr, nullptr, 0};
                  pg8::gemm_phase<pg8::EpiInProj, pg8::StaticOrder, true, true>(lds, g, So, E, tid); }
              }
            } else if (j == 1 && PH_ON(1)) {
                for (int rep = 0; rep < 1 + PH_REP(1); ++rep) { ph_mix(a, ws, lds, l, 32 * rep, tid, wave, lane); __syncthreads(); }
            } else if (j == 2 && PH_ON(2)) {
                ph_ssd_scan(ws, bx, G, tid);
            } else if (j == 3 && PH_ON(3)) {
                for (int rep = 0; rep < 1 + PH_REP(3); ++rep) for (int u = vcu; u < 256; u += G) ssd_finish_unit(a, ws, l, u, wave, lane);
            } else if (j == 4 && PH_ON(4)) {
                pg8::Gemm g{(const pg8::bf16_t*)(ws + WS_YCAT), (const pg8::bf16_t*)(ws + WS_WOUT) + (size_t)l * D * D, T, D, D};
                pg8::StaticOrder So; So.init(T, D, G, bx);
                LAS float* gtab = (LAS float*)(lds + GTAB_OFF);
                { pg8::Unit u0; if (So.next(0, u0) && tid < 256) { float r0, r1, r2; pg8::group_rstd((const float*)(ws + WS_YSSQ), u0.pm * 256 + tid, r0, r1, r2); gtab[tid] = r0 / r1; gtab[256 + tid] = r1 / r2; gtab[512 + tid] = r2; } }
                __syncthreads();
                pg8::EpiOut E{l == 0 ? AIN(I_X) : a.out, a.out, (pg8::bf16_t*)(ws + WS_XB), (float*)(ws + WS_XSSQ), gtab};
                for (int rep = 0; rep < 1 + ((PH_REP(4) && l == 0) ? 1 : 0); ++rep) pg8::gemm_phase<pg8::EpiOut, pg8::StaticOrder, true, true>(lds, g, So, E, tid);
            } else if (j == 5 && PH_ON(5)) {
                pg8::Gemm g{(const pg8::bf16_t*)(ws + WS_XB), (const pg8::bf16_t*)(ws + WS_WSC) + (size_t)l * D * D, T, D, D};
                pg8::StaticOrder So; So.init(T, D, G, bx);
                pg8::EpiInProj E{(pg8::bf16_t*)(ws + WS_YCAT), D, (const float*)(ws + WS_XSSQ), nullptr, nullptr, 16};
                for (int rep = 0; rep < 1 + PH_REP(5); ++rep) pg8::gemm_phase<pg8::EpiInProj, pg8::StaticOrder, true, true>(lds, g, So, E, tid);
                asm volatile("s_waitcnt vmcnt(0)" ::: "memory"); __syncthreads();
                if (tid == 0) __builtin_amdgcn_fence(__ATOMIC_ACQUIRE, "agent");
                asm volatile("s_waitcnt vmcnt(0)" ::: "memory"); __syncthreads();
                { pg8::Unit u0; if (So.next(0, u0)) for (int rep = 0; rep < 1 + PH_REP(6); ++rep) ph_topk(ws, lds, l, u0.pm, u0.pn, wave, lane); }
            } else if (j == 6 && PH_ON(7)) {
                ph_peer_sliced<0>(ws, lds, a.out, l, tid, wave, lane);
#if MK_REP & 0x80
                __syncthreads(); ph_peer_sliced<0, 1>(ws, lds, a.out, l, tid, wave, lane);
#endif
            } else if (j == 7 && PH_ON(8)) {
                ph_peer_w(ws, l, gw, NGW, lane);
            } else if (j == 8 && PH_ON(9)) {
#if MK_REP & 0x200
                ph_peer_sliced<1, 1>(ws, lds, a.out, l, tid, wave, lane); __syncthreads();
#endif
                ph_peer_sliced<1>(ws, lds, a.out, l, tid, wave, lane);
            }
        }
        if (ph + 1 < ph_hi) { XcdBarrier b2 = bar; { unsigned* p = b2.bar; unsigned x = b2.x; asm volatile("" : "+s"(p), "+s"(x)); b2.bar = p; b2.x = x; } xcd_barrier(b2, tid);
#if defined(MK_XBAR)
            for (int xb_ = 0; xb_ < MK_XBAR; ++xb_) xcd_barrier(b2, tid);
#endif
        }
    }
}

#ifndef MK_ONE_LAUNCH
#define MK_ONE_LAUNCH 1
#endif
extern "C" void kernel_launch(void* const* d_in, const int* in_sizes, int n_in, void* d_out, int out_size, void* d_ws, size_t ws_size, hipStream_t stream) {
    static int grid = 0;
    if (grid == 0) {
        if (n_in != 22 || out_size != T * D || ws_size < WS_END) { fprintf(stderr, "kernel_launch: unexpected problem (n_in %d out %d ws %zu)\n", n_in, out_size, ws_size); grid = -1; return; }
        int dev = 0, cus = 0, per_cu = 0;
        if (hipGetDevice(&dev) != hipSuccess || hipDeviceGetAttribute(&cus, hipDeviceAttributeMultiprocessorCount, dev) != hipSuccess) { grid = -1; return; }
        if (hipFuncSetAttribute((const void*)mega, hipFuncAttributeMaxDynamicSharedMemorySize, LDS_BYTES) != hipSuccess) { fprintf(stderr, "kernel_launch: hipFuncSetAttribute failed\n"); grid = -1; return; }
        if (hipOccupancyMaxActiveBlocksPerMultiprocessor(&per_cu, (const void*)mega, NWAVES * 64, LDS_BYTES) != hipSuccess || per_cu < 1) { fprintf(stderr, "kernel_launch: occupancy query says %d\n", per_cu); (void)hipGetLastError(); per_cu = 1; }
        if (cus != 256) { fprintf(stderr, "kernel_launch: built for a 256-CU device (one 256x256 tile per workgroup in the output-projection / query phases); this device reports %d CUs\n", cus); grid = -1; return; }
        grid = cus;
    }
    if (grid < 0) return;
    (void)hipMemsetAsync((char*)d_ws + WS_CTL, 0, CTL_ZERO_BYTES, stream);
    Args a{};
    for (int i = 0; i < 22; ++i) a.in[i] = (const float*)d_in[i];
    a.out = (float*)d_out; a.ws = (unsigned char*)d_ws;
#if MK_ONE_LAUNCH
    a.ph_lo = 0; a.ph_hi = NPHASES; a.li = 0;
    hipLaunchKernelGGL(mega, dim3(grid), dim3(NWAVES * 64), LDS_BYTES, stream, a);
#else
    for (int ph = 0; ph < NPHASES; ++ph) { a.ph_lo = ph; a.ph_hi = ph + 1; a.li = 0; hipLaunchKernelGGL(mega, dim3(grid), dim3(NWAVES * 64), LDS_BYTES, stream, a); }
#endif
}
```

```cpp
#include <hip/hip_runtime.h>
#include <cstdio>
#include <cstdint>
#include <cmath>
namespace pg8 {
#define PG8_LAS __attribute__((address_space(3)))
typedef unsigned short bf16_t;
typedef short bf16x8 __attribute__((ext_vector_type(8)));
typedef float f32x4 __attribute__((ext_vector_type(4)));
typedef unsigned u32x4 __attribute__((ext_vector_type(4)));
constexpr int BM = 256, BK = 64, HALF = 128, HTB = HALF * BK * 2  , STAGE_BYTES = 8 * HTB, NXCD = 8, WGM = 8;

__host__ __device__ __forceinline__ int lds_byte(int r, int c) { const int st = (r >> 4) * 2 + (c >> 5), rr = r & 15, cc = c & 31, ob = rr * 64 + cc * 2; return st * 1024 + (ob ^ (((ob >> 9) & 1) << 5)); }
__host__ __device__ __forceinline__ void stage_rc(int b, int& R, int& C) { const int st = b / 1024, sb = b % 1024, swz = sb ^ (((sb >> 9) & 1) << 5); R = (st >> 1) * 16 + swz / 64; C = (st & 1) * 32 + (swz % 64) / 2; }
__host__ __device__ __forceinline__ int perm32(int rho) { const int n = rho >> 4, i = rho & 15; return 8 * (i >> 2) + 4 * n + (i & 3); }

struct Unit { int pm, pn; };
struct Gemm { const bf16_t* A; const bf16_t* Bt; int M, N, K; };

struct StaticOrder {
    int nM, nN, nwg, G, c;
    __host__ __device__ void init(int M, int N, int G_, int c_) { nM = M / BM; nN = N / BM; nwg = nM * nN; G = G_; c = c_; }
    __host__ __device__ bool next(int i, Unit& u) const {
        const long L = (long)i * G + c; if (L >= nwg) return false;
        int wgid = (int)L; { const int q = nwg / NXCD, r = nwg % NXCD, xcd = wgid % NXCD, off = wgid / NXCD; wgid = (xcd < r ? xcd * (q + 1) : r * (q + 1) + (xcd - r) * q) + off; }
        const int nig = WGM * nN, gid = wgid / nig, fm = gid * WGM, gsz = (nM - fm) < WGM ? (nM - fm) : WGM;
        u.pm = fm + ((wgid % nig) % gsz); u.pn = (wgid % nig) / gsz; return true;
    }
    __device__ __forceinline__ void a_ready(const Unit&) const {}
    __device__ __forceinline__ void done(const Unit&) const {}
};

__device__ __forceinline__ unsigned cvt_pk_bf16(float lo, float hi) { unsigned r; asm volatile("v_cvt_pk_bf16_f32 %0, %1, %2" : "=v"(r) : "v"(lo), "v"(hi)); return r; }
template <class Epi, class Sched, bool ALIGN_EPI = false, bool SP2 = false>
__device__ __forceinline__ void gemm_phase(PG8_LAS unsigned char* lds, const Gemm g, const Sched& S, const Epi& E, const int tid_in) {
    int tid_ = tid_in; asm volatile("" : "+v"(tid_));
    const int tid = tid_, wid = __builtin_amdgcn_readfirstlane(tid >> 6), lane = tid & 63, wr = wid >> 2, wc = wid & 3, fr = lane & 15, fq = lane >> 4;
    const int K = g.K, nt = K / BK;
    unsigned voffA[2], voffB[2];
#pragma unroll
    for (int i = 0; i < 2; ++i) { int R, C; stage_rc(tid * 16 + i * 8192, R, C); const int Rb = Epi::PERM ? ((R & ~31) + perm32(R & 31)) : R;
        voffA[i] = (unsigned)(R * K + C) * 2u; voffB[i] = (unsigned)(Rb * K + C) * 2u; }
    const size_t kstep = (size_t)(BK * 2);
    const size_t hstep = (size_t)HALF * K * 2;
    const size_t tstep = 2 * hstep;
    const unsigned ldsw = (unsigned)wid * 1024u;
    const int aoff = lds_byte(wr * 64 + fr, fq * 8), boff = lds_byte(wc * 32 + fr, fq * 8);
#define PG8_SA(b, h) (((b) * 2 + (h)) * HTB)
#define PG8_SB(b, h) ((4 + (b) * 2 + (h)) * HTB)
#define PG8_STAGE(bufoff, gbase, voff) do { _Pragma("unroll") for (int _i = 0; _i < 2; ++_i) \
        __builtin_amdgcn_global_load_lds((const unsigned*)((const char*)(gbase) + (voff)[_i]), (PG8_LAS unsigned*)(lds + (bufoff) + ldsw + _i * 8192), 16, 0, 0); } while (0)
#define PG8_LDA(dst, b, h) do { _Pragma("unroll") for (int m = 0; m < 4; ++m) _Pragma("unroll") for (int k = 0; k < 2; ++k) dst[m][k] = *(const PG8_LAS bf16x8*)(lds + PG8_SA(b, h) + aoff + m * 2048 + k * 1024); } while (0)
#define PG8_LDB(dst, b, h) do { _Pragma("unroll") for (int n = 0; n < 2; ++n) _Pragma("unroll") for (int k = 0; k < 2; ++k) dst[n][k] = *(const PG8_LAS bf16x8*)(lds + PG8_SB(b, h) + boff + n * 2048 + k * 1024); } while (0)
#define PG8_MMA(ai, bj, At, Bt) do { __builtin_amdgcn_s_setprio(1); _Pragma("unroll") for (int m = 0; m < 4; ++m) _Pragma("unroll") for (int n = 0; n < 2; ++n) _Pragma("unroll") for (int k = 0; k < 2; ++k) \
        acc[ai][bj][m][n] = __builtin_amdgcn_mfma_f32_16x16x32_bf16(Bt[n][k], At[m][k], acc[ai][bj][m][n], 0, 0, 0); __builtin_amdgcn_s_setprio(0); } while (0)
#define PG8_WAIT_V(n) asm volatile("s_waitcnt vmcnt(" #n ")" ::: "memory")
#define PG8_WAIT_L(n) asm volatile("s_waitcnt lgkmcnt(" #n ")" ::: "memory")
#define PG8_BAR __builtin_amdgcn_s_barrier()
#define PG8_SCHED __builtin_amdgcn_sched_barrier(0)
    Unit cur, nxt; int ui = 0;
    if (!S.next(0, cur)) return;
    f32x4 acc[2][2][4][2];
#pragma unroll
    for (int a = 0; a < 2; ++a)
#pragma unroll
        for (int b = 0; b < 2; ++b)
#pragma unroll
            for (int m = 0; m < 4; ++m)
#pragma unroll
                for (int n = 0; n < 2; ++n) acc[a][b][m][n] = (f32x4){0.f, 0.f, 0.f, 0.f};
    bf16x8 At[4][2], B0[2][2], B1[2][2];
    const char* cA = (const char*)g.A + (size_t)cur.pm * tstep; const char* cB = (const char*)g.Bt + (size_t)cur.pn * tstep;
    S.a_ready(cur);
    if constexpr (SP2) {
        PG8_STAGE(PG8_SB(0, 0), cB, voffB); PG8_STAGE(PG8_SB(0, 1), cB + hstep, voffB); PG8_STAGE(PG8_SA(0, 0), cA, voffA); PG8_STAGE(PG8_SA(0, 1), cA + hstep, voffA);
        if (wr == 1) PG8_BAR;
        PG8_WAIT_V(2); PG8_BAR;
        PG8_STAGE(PG8_SB(1, 0), cB + kstep, voffB); PG8_STAGE(PG8_SA(1, 0), cA + kstep, voffA); PG8_STAGE(PG8_SB(1, 1), cB + hstep + kstep, voffB);
        PG8_WAIT_V(6); PG8_BAR;
    } else {
        PG8_STAGE(PG8_SB(0, 0), cB, voffB); PG8_STAGE(PG8_SA(0, 0), cA, voffA); PG8_STAGE(PG8_SB(0, 1), cB + hstep, voffB); PG8_STAGE(PG8_SA(0, 1), cA + hstep, voffA);
        if (wr == 1) PG8_BAR;
        PG8_WAIT_V(4); PG8_BAR;
        PG8_STAGE(PG8_SB(1, 0), cB + kstep, voffB); PG8_STAGE(PG8_SA(1, 0), cA + kstep, voffA); PG8_STAGE(PG8_SB(1, 1), cB + hstep + kstep, voffB);
        PG8_WAIT_V(6); PG8_BAR;
    }
    for (;;) {
        const bool has_next = S.next(ui + 1, nxt);
        const char* nA = has_next ? (const char*)g.A + (size_t)nxt.pm * tstep : cA; const char* nB = has_next ? (const char*)g.Bt + (size_t)nxt.pn * tstep : cB;
        for (int t = 0; t < nt; t += 2) {
            const bool last = (t == nt - 2);
            const char* a1 = cA + (size_t)(t + 1) * kstep;
            const char* a2 = last ? nA : cA + (size_t)(t + 2) * kstep; const char* b2 = last ? nB : cB + (size_t)(t + 2) * kstep;
            const char* a3 = a2 + kstep; const char* b3 = b2 + kstep;
            if (last && has_next) S.a_ready(nxt);
            if constexpr (Epi::KHOOK) E.khook(acc, cur, t, wr, fr);
            if constexpr (SP2) {
            PG8_LDB(B0, 0, 0); PG8_LDB(B1, 0, 1); PG8_SCHED; PG8_LDA(At, 0, 0); PG8_STAGE(PG8_SA(1, 1), a1 + hstep, voffA);
            PG8_WAIT_V(8); PG8_WAIT_L(0); PG8_BAR; PG8_MMA(0, 0, At, B0); PG8_MMA(0, 1, At, B1); PG8_BAR; PG8_SCHED;
            PG8_LDA(At, 0, 1); PG8_STAGE(PG8_SB(0, 0), b2, voffB); PG8_STAGE(PG8_SB(0, 1), b2 + hstep, voffB); PG8_STAGE(PG8_SA(0, 0), a2, voffA);
            PG8_WAIT_V(8); PG8_WAIT_L(0); PG8_BAR; PG8_MMA(1, 0, At, B0); PG8_MMA(1, 1, At, B1); PG8_BAR; PG8_SCHED;
            PG8_LDB(B0, 1, 0); PG8_LDB(B1, 1, 1); PG8_SCHED; PG8_LDA(At, 1, 0); PG8_STAGE(PG8_SA(0, 1), a2 + hstep, voffA);
            PG8_WAIT_V(8); PG8_WAIT_L(0); PG8_BAR; PG8_MMA(0, 0, At, B0); PG8_MMA(0, 1, At, B1); PG8_BAR; PG8_SCHED;
            PG8_LDA(At, 1, 1); PG8_STAGE(PG8_SB(1, 0), b3, voffB); PG8_STAGE(PG8_SB(1, 1), b3 + hstep, voffB); PG8_STAGE(PG8_SA(1, 0), a3, voffA);
            PG8_WAIT_V(8); PG8_WAIT_L(0); PG8_BAR; PG8_MMA(1, 0, At, B0); PG8_MMA(1, 1, At, B1); PG8_BAR; PG8_SCHED;
            } else {
            PG8_LDB(B0, 0, 0); PG8_SCHED; PG8_LDA(At, 0, 0); PG8_STAGE(PG8_SA(1, 1), a1 + hstep, voffA);
            PG8_WAIT_L(8); PG8_BAR; PG8_WAIT_L(0); PG8_MMA(0, 0, At, B0); PG8_BAR; PG8_SCHED;
            PG8_LDB(B1, 0, 1); PG8_STAGE(PG8_SB(0, 0), b2, voffB);
            PG8_BAR; PG8_WAIT_L(0); PG8_MMA(0, 1, At, B1); PG8_BAR;
            PG8_LDA(At, 0, 1); PG8_STAGE(PG8_SA(0, 0), a2, voffA);
            PG8_BAR; PG8_WAIT_L(0); PG8_MMA(1, 0, At, B0); PG8_BAR; PG8_SCHED;
            PG8_STAGE(PG8_SB(0, 1), b2 + hstep, voffB);
            PG8_WAIT_V(6); PG8_BAR; PG8_MMA(1, 1, At, B1); PG8_BAR;
            PG8_LDB(B0, 1, 0); PG8_SCHED; PG8_LDA(At, 1, 0); PG8_STAGE(PG8_SA(0, 1), a2 + hstep, voffA);
            PG8_WAIT_L(8); PG8_BAR; PG8_WAIT_L(0); PG8_MMA(0, 0, At, B0); PG8_BAR; PG8_SCHED;
            PG8_LDB(B1, 1, 1); PG8_STAGE(PG8_SB(1, 0), b3, voffB);
            PG8_BAR; PG8_WAIT_L(0); PG8_MMA(0, 1, At, B1); PG8_BAR;
            PG8_LDA(At, 1, 1); PG8_STAGE(PG8_SA(1, 0), a3, voffA);
            PG8_BAR; PG8_WAIT_L(0); PG8_MMA(1, 0, At, B0); PG8_BAR; PG8_SCHED;
            PG8_STAGE(PG8_SB(1, 1), b3 + hstep, voffB);
            PG8_WAIT_V(6); PG8_BAR; PG8_MMA(1, 1, At, B1); PG8_BAR;
            }
        }
        if constexpr (ALIGN_EPI) { if (wr == 0) PG8_BAR; }
        if constexpr (!Epi::AFTER_DRAIN) { E(acc, cur, wr, wc, fr, fq); S.done(cur); }
        if (!has_next) break;
#pragma unroll
        for (int a = 0; a < 2; ++a)
#pragma unroll
            for (int b = 0; b < 2; ++b)
#pragma unroll
                for (int m = 0; m < 4; ++m)
#pragma unroll
                    for (int n = 0; n < 2; ++n) acc[a][b][m][n] = (f32x4){0.f, 0.f, 0.f, 0.f};
        cur = nxt; cA = nA; cB = nB; ++ui;
        if constexpr (ALIGN_EPI) { if (wr == 1) PG8_BAR; }
    }
    PG8_WAIT_V(0);
    if constexpr (!ALIGN_EPI) { if (wr == 0) PG8_BAR; }
    PG8_BAR;
    if constexpr (Epi::AFTER_DRAIN) { E.fused(acc, cur, wr, wc, fr, fq, lds, wid, lane); S.done(cur); }
#undef PG8_SA
#undef PG8_SB
#undef PG8_STAGE
#undef PG8_LDA
#undef PG8_LDB
#undef PG8_MMA
#undef PG8_WAIT_V
#undef PG8_WAIT_L
#undef PG8_BAR
#undef PG8_SCHED
}
}
#define GAS __attribute__((address_space(1)))
#define LAS __attribute__((address_space(3)))
typedef unsigned short bf16;
typedef unsigned v4u __attribute__((ext_vector_type(4)));
typedef float f32x4 __attribute__((ext_vector_type(4)));
typedef short bf16x8 __attribute__((ext_vector_type(8)));
typedef GAS unsigned gu32;
typedef GAS unsigned long long gu64;
#define RLX_AGENT __ATOMIC_RELAXED, __HIP_MEMORY_SCOPE_AGENT
#define LDS_WAIT() asm volatile("s_waitcnt lgkmcnt(0)" ::: "memory")
#define VM_WAIT() asm volatile("s_waitcnt vmcnt(0)" ::: "memory")
__device__ __forceinline__ unsigned long long rt() { return __builtin_amdgcn_s_memrealtime(); }
__device__ __forceinline__ unsigned f2bf(float f) { unsigned u = __builtin_bit_cast(unsigned, f); return (u + 0x7fffu + ((u >> 16) & 1u)) >> 16; }
__device__ __forceinline__ unsigned pk2(float lo, float hi) { return f2bf(lo) | (f2bf(hi) << 16); }

#define XB_TMO      128
#define XB_XCNT(j)  (256  + 64 * (j))
#define XB_XSUB(j)  (1280 + 64 * (j))
#define XB_XGEN(j)  (2304 + 64 * (j))
#define XB_TOP      3328
#define XB_TOPGEN   3392
#define XCD_BAR_WORDS 3456
#define XB_SPIN_CAP (1u << 18)

__device__ __forceinline__ unsigned xb_ld(unsigned* p)              { return __hip_atomic_load(p, __ATOMIC_RELAXED, __HIP_MEMORY_SCOPE_AGENT); }
__device__ __forceinline__ unsigned xb_add(unsigned* p, unsigned v) { return __hip_atomic_fetch_add(p, v, __ATOMIC_RELAXED, __HIP_MEMORY_SCOPE_AGENT); }
__device__ __forceinline__ unsigned xb_xcc_id() { return (unsigned)__builtin_amdgcn_s_getreg((3 << 11) | 20) & 0xFu; }
#define XB_SPIN(cond, bar) do { unsigned _sp = 0; while (cond) { __builtin_amdgcn_s_sleep(1); \
    if ((++_sp & 255u) == 0u) { if (xb_ld(&(bar)[XB_TMO])) break; if (_sp > XB_SPIN_CAP) { atomicAdd(&(bar)[XB_TMO], 1u); break; } } } } while (0)

struct XcdBarrier {
    unsigned* bar; unsigned x;
    volatile LAS unsigned* st;
};

__device__ __forceinline__ XcdBarrier xcd_barrier_post(unsigned* bar, volatile LAS unsigned* st) {
    XcdBarrier b; b.bar = bar; b.x = xb_xcc_id(); b.st = st;
    if (threadIdx.x == 0) (void)xb_add(&bar[XB_XCNT(b.x)], 1u);
    return b;
}
__device__ __forceinline__ void xcd_barrier_complete(unsigned* bar, unsigned x, unsigned& nloc, unsigned& nx) {
    const unsigned G = gridDim.x * gridDim.y * gridDim.z;
    unsigned sum, cnt, mine, sp = 0u;
    for (;;) {
        sum = 0u; cnt = 0u; mine = 0u;
#pragma unroll
        for (unsigned j = 0; j < 16; ++j) { const unsigned c = xb_ld(&bar[XB_XCNT(j)]); sum += c; cnt += (c > 0u) ? 1u : 0u; mine = (j == x) ? c : mine; }
        if (sum == G) break;
        __builtin_amdgcn_s_sleep(1);
        if ((++sp & 255u) == 0u) { if (xb_ld(&bar[XB_TMO])) break; if (sp > XB_SPIN_CAP) { atomicAdd(&bar[XB_TMO], 1u); break; } }
    }
    nloc = mine > 0u ? mine : 1u; nx = cnt > 0u ? cnt : 1u;
}

__device__ __forceinline__ void xcd_barrier(const XcdBarrier& b, const int tid) {
    asm volatile("s_waitcnt vmcnt(0)" ::: "memory");
    __syncthreads();
    if (tid == 0) {
        unsigned* bar = b.bar;
        __builtin_amdgcn_s_waitcnt(0);
        unsigned nloc = b.st[0], nx = b.st[1];
        if (nloc == 0u) { xcd_barrier_complete(bar, b.x, nloc, nx); b.st[0] = nloc; b.st[1] = nx; }
        const unsigned old = xb_add(&bar[XB_XSUB(b.x)], 1u);
        const unsigned gen = old / nloc;
        if (old + 1u == (gen + 1u) * nloc) {
            __builtin_amdgcn_fence(__ATOMIC_RELEASE, "agent");
            asm volatile("s_waitcnt vmcnt(0)" ::: "memory");
            const unsigned og = xb_add(&bar[XB_TOP], 1u);
            const unsigned tg = og / nx;
            if (og + 1u == (tg + 1u) * nx) xb_add(&bar[XB_TOPGEN], 1u);
            else XB_SPIN(xb_ld(&bar[XB_TOPGEN]) == tg, bar);
            __builtin_amdgcn_fence(__ATOMIC_ACQUIRE, "agent");
            xb_add(&bar[XB_XGEN(b.x)], 1u);
            asm volatile("s_waitcnt vmcnt(0)" ::: "memory");
        } else {
            XB_SPIN(xb_ld(&bar[XB_XGEN(b.x)]) == gen, bar);
            __builtin_amdgcn_fence(__ATOMIC_ACQUIRE, "agent");
            asm volatile("s_waitcnt vmcnt(0)" ::: "memory");
        }
    }
    __syncthreads();
}

constexpr int NWAVES = 8;
constexpr int D = 1024, NB = 4, S = 4096, T = NB * S, NL = 2, NMEM = 256, MROWS = NB * NMEM;
constexpr int DIN = 2438, NPROJ = 2560;
constexpr int PC_Z = 0, PC_XBC = 384, PC_QSB = 1024, PC_KSB = 1408, PC_VSB = 1792, PC_QMEM = 2176, PC_DT = 2432;
constexpr int CONV_CH = 640;
constexpr float EPS = 1e-6f;

constexpr int RING_BYTES = 131072;
constexpr int WSCR = 17408;
constexpr int LDSCTL_OFF = 8 * WSCR, MISC_OFF = LDSCTL_OFF + 320;
constexpr int LDS_BYTES = 147456;
constexpr int GTAB_OFF = LDSCTL_OFF + 1024;

constexpr size_t MiB = 1u << 20;
constexpr size_t WS_CTL = 0, CTL_ZERO_BYTES = 1 * MiB;
constexpr size_t WS_WIN = 2 * MiB;
constexpr size_t WS_WMEM = 12 * MiB;
constexpr size_t WS_WOUT = 14 * MiB;
constexpr size_t WS_WSC = 18 * MiB;
constexpr size_t WS_KB = 22 * MiB;
constexpr size_t WS_MEMB = 26 * MiB;
constexpr size_t WS_RSM = 28 * MiB;
constexpr size_t WS_RS1 = WS_RSM + 64 * 1024;
constexpr size_t WS_DTF = WS_RS1 + 64 * 1024;
constexpr size_t WS_XSSQ = 29 * MiB;
constexpr size_t WS_YSSQ = 30 * MiB;
constexpr size_t WS_MEMKV = 31 * MiB;
constexpr size_t WS_RS1P = 32 * MiB;
constexpr size_t WS_PART = 178 * MiB;
constexpr size_t WS_XB = 34 * MiB;
constexpr size_t WS_YCAT = 66 * MiB;
constexpr size_t WS_PROJ = 98 * MiB;
constexpr size_t WS_SCORES = 178 * MiB;
constexpr size_t WS_YPART = WS_SCORES;
constexpr size_t WS_XCONV = WS_SCORES + 24 * MiB;
constexpr size_t WS_CMG = WS_SCORES + 36 * MiB;
constexpr size_t WS_ACSG = WS_SCORES + 40 * MiB;
constexpr size_t WS_HS = WS_SCORES + 41 * MiB;
constexpr size_t WS_CD = WS_SCORES + 53 * MiB;
constexpr size_t WS_EIDX = 306 * MiB;
constexpr size_t WS_GATE = 314 * MiB;
constexpr size_t WS_WV = 322 * MiB;
constexpr size_t WS_STOP = 330 * MiB;
constexpr size_t WS_ITOP = 338 * MiB;
constexpr size_t WS_UT = 354 * MiB;
constexpr size_t WS_USC = 386 * MiB;
constexpr size_t WS_VT = 418 * MiB;
constexpr size_t WS_VSC = 450 * MiB;
constexpr size_t WS_END = 482 * MiB;
constexpr int CW_BAR = 4096;

__device__ __forceinline__ float bf2f(bf16 v) { return __uint_as_float((unsigned)v << 16); }
__device__ __forceinline__ unsigned pkbf(float lo, float hi) { return pg8::cvt_pk_bf16(lo, hi); }
template <int CTRL> __device__ __forceinline__ float dpp_f(float v) { return __uint_as_float((unsigned)__builtin_amdgcn_update_dpp(0, (int)__float_as_uint(v), CTRL, 0xf, 0xf, true)); }
__device__ __forceinline__ float swap32_add(float a, float b) {
    const auto r = __builtin_amdgcn_permlane32_swap(__float_as_uint(a), __float_as_uint(b), false, false); return __uint_as_float(r[0]) + __uint_as_float(r[1]); }
__device__ __forceinline__ float swap16_add(float a, float b) {
    const auto r = __builtin_amdgcn_permlane16_swap(__float_as_uint(a), __float_as_uint(b), false, false); return __uint_as_float(r[0]) + __uint_as_float(r[1]); }
__device__ __forceinline__ float swap32_max(float a) { const auto r = __builtin_amdgcn_permlane32_swap(__float_as_uint(a), __float_as_uint(a), false, false); return fmaxf(__uint_as_float(r[0]), __uint_as_float(r[1])); }
__device__ __forceinline__ float swap16_max(float a) { const auto r = __builtin_amdgcn_permlane16_swap(__float_as_uint(a), __float_as_uint(a), false, false); return fmaxf(__uint_as_float(r[0]), __uint_as_float(r[1])); }
__device__ __forceinline__ float partner32(float a, bool hi) { const auto r = __builtin_amdgcn_permlane32_swap(__float_as_uint(a), __float_as_uint(a), false, false); return __uint_as_float(hi ? r[0] : r[1]); }
__device__ __forceinline__ float sum8(float v) { v += dpp_f<0xB1>(v); v += dpp_f<0x4E>(v); v += dpp_f<0x141>(v); return v; }
__device__ __forceinline__ float sum16(float v) { v = sum8(v); v += dpp_f<0x140>(v); return v; }
__device__ __forceinline__ float wave_sum(float v) { v = sum16(v); v = swap16_add(v, v); return swap32_add(v, v); }
__device__ __forceinline__ float wave_max(float v) { v = fmaxf(v, dpp_f<0xB1>(v)); v = fmaxf(v, dpp_f<0x4E>(v)); v = fmaxf(v, dpp_f<0x141>(v)); v = fmaxf(v, dpp_f<0x140>(v)); v = swap16_max(v); return swap32_max(v); }
__device__ __forceinline__ float bperm_f(float v, int src_lane) { return __uint_as_float((unsigned)__builtin_amdgcn_ds_bpermute(src_lane << 2, (int)__float_as_uint(v))); }
__device__ __forceinline__ int bperm_i(int v, int src_lane) { return __builtin_amdgcn_ds_bpermute(src_lane << 2, v); }
__device__ __forceinline__ float softplus_f(float x) { return fmaxf(x, 0.f) + log1pf(expf(-fabsf(x))); }
__device__ __forceinline__ float silu_f(float x) { return x / (1.f + expf(-x)); }

namespace pg8 {
struct EpiInProj {
    static constexpr bool PERM = true, AFTER_DRAIN = false, KHOOK = false;
    bf16_t* O; int ldc; const float* rs; float* dtf; const float* dtb; int npart;
    __device__ __forceinline__ void operator()(const f32x4 (&acc)[2][2][4][2], const Unit& u, int wr, int wc, int fr, int fq) const {
        const int row0 = u.pm * BM + wr * 64 + fr, col0 = u.pn * BM + wc * 32 + 8 * fq;
        const bool dtl = dtf && (u.pn * BM == PC_DT - 128) && wc == 0 && fq == 0;
#pragma unroll
        for (int ai = 0; ai < 2; ++ai)
#pragma unroll
            for (int m = 0; m < 4; ++m) {
                const int row = row0 + ai * HALF + m * 16; float s;
                if (npart == 8) { const f32x4 p0 = *(const f32x4*)(rs + (size_t)row * 8), p1 = *(const f32x4*)(rs + (size_t)row * 8 + 4); s = rsqrtf((((p0[0] + p0[1]) + (p0[2] + p0[3])) + ((p1[0] + p1[1]) + (p1[2] + p1[3]))) * (1.f / 1024.f) + EPS); }
                else if (npart == 16) { const f32x4 p0 = *(const f32x4*)(rs + (size_t)row * 16), p1 = *(const f32x4*)(rs + (size_t)row * 16 + 4), p2 = *(const f32x4*)(rs + (size_t)row * 16 + 8), p3 = *(const f32x4*)(rs + (size_t)row * 16 + 12);
                    s = rsqrtf(((((p0[0] + p0[1]) + (p0[2] + p0[3])) + ((p1[0] + p1[1]) + (p1[2] + p1[3]))) + (((p2[0] + p2[1]) + (p2[2] + p2[3])) + ((p3[0] + p3[1]) + (p3[2] + p3[3])))) * (1.f / 1024.f) + EPS); }
                else s = rs[row];
#pragma unroll
                for (int bj = 0; bj < 2; ++bj) {
                    const f32x4 v0 = acc[ai][bj][m][0] * s, v1 = acc[ai][bj][m][1] * s;
                    u32x4 w; w.x = cvt_pk_bf16(v0[0], v0[1]); w.y = cvt_pk_bf16(v0[2], v0[3]); w.z = cvt_pk_bf16(v1[0], v1[1]); w.w = cvt_pk_bf16(v1[2], v1[3]);
                    *(u32x4*)(O + (size_t)row * ldc + col0 + bj * HALF) = w;
                    if (bj == 1 && dtl) {
                        f32x4 d0; d0[0] = softplus_f(v0[0] + dtb[0]); d0[1] = softplus_f(v0[1] + dtb[1]); d0[2] = softplus_f(v0[2] + dtb[2]); d0[3] = softplus_f(v0[3] + dtb[3]);
                        f32x4 d1; d1[0] = softplus_f(v1[0] + dtb[4]); d1[1] = softplus_f(v1[1] + dtb[5]); d1[2] = 0.f; d1[3] = 0.f;
                        *(f32x4*)(dtf + (size_t)row * 8) = d0; *(f32x4*)(dtf + (size_t)row * 8 + 4) = d1;
                    }
                }
            }
    }
};
__device__ __forceinline__ void group_rstd(const float* yssq, int row, float& r_ssd, float& r_sb, float& r_mem) {
    const f32x4 a = *(const f32x4*)(yssq + (size_t)row * 16), b = *(const f32x4*)(yssq + (size_t)row * 16 + 4), c = *(const f32x4*)(yssq + (size_t)row * 16 + 8), d = *(const f32x4*)(yssq + (size_t)row * 16 + 12);
    const float s0 = (a[0] + a[1]) + (a[2] + a[3]) + (b[0] + b[1]), s1 = (b[2] + b[3]) + (c[0] + c[1]) + (c[2] + c[3]), s2 = (d[0] + d[1]) + (d[2] + d[3]);
    r_ssd = rsqrtf(s0 * (1.f / 384.f) + EPS); r_sb = rsqrtf(s1 * (1.f / 384.f) + EPS); r_mem = rsqrtf(s2 * (1.f / 256.f) + EPS);
}
struct EpiOut {
    static constexpr bool PERM = false, AFTER_DRAIN = false, KHOOK = true;
    bf16_t* xb; float* xssq; const PG8_LAS float* gtab;
    __device__ __forceinline__ void khook(f32x4 (&acc)[2][2][4][2], const Unit& u, int t, int wr, int fr) const {
        if (t != 6 && t != 12) return;
#pragma unroll
        for (int ai = 0; ai < 2; ++ai)
#pragma unroll
            for (int m = 0; m < 4; ++m) {
                const float f = gtab[(t == 6 ? 0 : 256) + ai * HALF + wr * 64 + m * 16 + fr];
#pragma unroll
                for (int bj = 0; bj < 2; ++bj)
#pragma unroll
                    for (int n = 0; n < 2; ++n) acc[ai][bj][m][n] = acc[ai][bj][m][n] * f;
            }
    }
    __device__ __forceinline__ void operator()(const f32x4 (&acc)[2][2][4][2], const Unit& u, int wr, int wc, int fr, int fq) const {
        const int col0 = u.pn * BM + wc * 32 + 4 * fq;
#pragma unroll
        for (int ai = 0; ai < 2; ++ai)
#pragma unroll
            for (int m = 0; m < 4; ++m) {
                const int row = u.pm * BM + ai * HALF + wr * 64 + m * 16 + fr; const float r2 = gtab[512 + ai * HALF + wr * 64 + m * 16 + fr];
                float q = 0.f;
#pragma unroll
                for (int bj = 0; bj < 2; ++bj)
#pragma unroll
                    for (int n = 0; n < 2; ++n) {
                        const size_t off = (size_t)row * D + col0 + bj * HALF + n * 16;
                        typedef unsigned u32x2v __attribute__((ext_vector_type(2)));
                        const u32x2v bw = *(const u32x2v*)(xb + off);
                        const f32x4 x1 = (f32x4){__uint_as_float(bw.x << 16), __uint_as_float(bw.x & 0xffff0000u), __uint_as_float(bw.y << 16), __uint_as_float(bw.y & 0xffff0000u)} + acc[ai][bj][m][n] * r2;
                        u32x2v w; w.x = cvt_pk_bf16(x1[0], x1[1]); w.y = cvt_pk_bf16(x1[2], x1[3]); *(u32x2v*)(xb + off) = w;
                        q += (x1[0] * x1[0] + x1[1] * x1[1]) + (x1[2] * x1[2] + x1[3] * x1[3]);
                    }
                q = swap16_add(q, q); q = swap32_add(q, q);
                if (fq == 0) xssq[(size_t)row * 16 + u.pn * 4 + wc] = q;
            }
    }
};
struct EpiScores {
    static constexpr bool PERM = false, AFTER_DRAIN = false, KHOOK = false;
    float* O; const float* xssq;
    __device__ __forceinline__ void operator()(const f32x4 (&acc)[2][2][4][2], const Unit& u, int wr, int wc, int fr, int fq) const {
        const int col0 = u.pn * BM + wc * 32 + 4 * fq;
#pragma unroll
        for (int ai = 0; ai < 2; ++ai)
#pragma unroll
            for (int m = 0; m < 4; ++m) {
                const int row = u.pm * BM + ai * HALF + wr * 64 + m * 16 + fr;
                const f32x4 a = *(const f32x4*)(xssq + (size_t)row * 16), b = *(const f32x4*)(xssq + (size_t)row * 16 + 4), c = *(const f32x4*)(xssq + (size_t)row * 16 + 8), d = *(const f32x4*)(xssq + (size_t)row * 16 + 12);
                const float ss = ((a[0] + a[1]) + (a[2] + a[3])) + ((b[0] + b[1]) + (b[2] + b[3])) + ((c[0] + c[1]) + (c[2] + c[3])) + ((d[0] + d[1]) + (d[2] + d[3]));
                const float r = rsqrtf(ss * (1.f / 1024.f) + EPS);
#pragma unroll
                for (int bj = 0; bj < 2; ++bj)
#pragma unroll
                    for (int n = 0; n < 2; ++n) *(f32x4*)(O + (size_t)row * 2048 + col0 + bj * HALF + n * 16) = acc[ai][bj][m][n] * r;
            }
    }
};
}

struct Args { const float* in[22]; float* out; unsigned char* ws; int ph_lo, ph_hi, li, pad; };
enum { I_X = 0, I_MEM, I_NORM1G, I_WIN, I_CONVW, I_CONVB, I_DTBIAS, I_ALOG, I_DSKIP, I_SSDG, I_SBG, I_MEMNG, I_WMEMKV, I_MQG, I_MKG, I_MEMOG, I_WOUT, I_NORM2G, I_WQ, I_KEYS, I_PU, I_PV };

__device__ __forceinline__ int opq(int i) { asm volatile("" : "+s"(i)); return i; }
#define AIN(i) (a.in[opq(i)])
__device__ __forceinline__ void transpose_item(const float* W, int ldw, int src_c0, int nvalid, const float* g, bf16* WT, int K, int dst_r0, int k0, LAS float* scr, int lane) {
    const int c = lane & 31;
#pragma unroll 8
    for (int i = 0; i < 32; ++i) {
        const int kk = 2 * i + (lane >> 5);
        float v = (c < nvalid) ? W[(size_t)(k0 + kk) * ldw + src_c0 + c] : 0.f;
        if (g) v *= g[k0 + kk];
        scr[kk * 33 + c] = v;
    }
    LDS_WAIT(); asm volatile("" ::: "memory");
    const int c8 = lane & 7;
#pragma unroll
    for (int j = 0; j < 4; ++j) {
        const int n = (lane >> 3) + 8 * j; const LAS float* s = scr + (8 * c8) * 33 + n;
        v4u o; o.x = pkbf(s[0 * 33], s[1 * 33]); o.y = pkbf(s[2 * 33], s[3 * 33]); o.z = pkbf(s[4 * 33], s[5 * 33]); o.w = pkbf(s[6 * 33], s[7 * 33]);
        *(GAS v4u*)(WT + (size_t)(dst_r0 + n) * K + k0 + 8 * c8) = o;
    }
    LDS_WAIT(); asm volatile("" ::: "memory");
}
__device__ __forceinline__ void row_to_bf16(const float* xrow, bf16* orow, float* rs, bool partials, int lane) {
    const GAS f32x4* xr = (const GAS f32x4*)xrow + lane;
    f32x4 v[4]; float s = 0.f;
#pragma unroll
    for (int j = 0; j < 4; ++j) { v[j] = xr[64 * j]; s += (v[j].x * v[j].x + v[j].y * v[j].y) + (v[j].z * v[j].z + v[j].w * v[j].w); }
    s = wave_sum(s);
    GAS unsigned long long* o8 = (GAS unsigned long long*)orow + lane;
#pragma unroll
    for (int j = 0; j < 4; ++j) o8[64 * j] = (unsigned long long)pkbf(v[j].x, v[j].y) | ((unsigned long long)pkbf(v[j].z, v[j].w) << 32);
    if (partials) { if (lane < 8) rs[lane] = lane == 0 ? s : 0.f; }
    else if (lane == 0) *rs = rsqrtf(s * (1.f / 1024.f) + EPS);
}
__device__ __forceinline__ void ph_prologue(const Args& a, unsigned char* ws, LAS unsigned char* lds, int gw, int NGW, int wave, int lane) {
    LAS float* scr = (LAS float*)(lds + wave * 16384);
    constexpr int I_IN = 80 * 16, I_MEMW = 16 * 16, I_OUT = 32 * 16, I_SC = 32 * 16 + 128, PER_L = I_IN + I_MEMW + I_OUT + I_SC;
    constexpr int NW_ITEMS = NL * PER_L, NITEMS = NW_ITEMS;
    for (int it = gw; it < NITEMS; it += NGW) {
        if (it < NW_ITEMS) {
            const int l = it / PER_L; int r = it % PER_L;
            if (r < I_IN) {
                const int j = r / 16, kb = r % 16;
                const int src = (j < 32) ? 32 * j : (j < 76 ? 32 * j + 6 : 1024), nv = (j < 76) ? 32 : (j == 76 ? 6 : 0);
                transpose_item(AIN(I_WIN) + (size_t)l * D * DIN, DIN, src, nv, AIN(I_NORM1G) + l * D, (bf16*)(ws + WS_WIN) + (size_t)l * NPROJ * D, D, 32 * j, 64 * kb, scr, lane);
                continue;
            }
            r -= I_IN;
            if (r < I_MEMW) {
                const int j = r / 16, kb = r % 16;
                transpose_item(AIN(I_WMEMKV) + (size_t)l * D * 512, 512, 32 * j, 32, AIN(I_MEMNG) + l * D, (bf16*)(ws + WS_WMEM) + (size_t)l * 512 * D, D, 32 * j, 64 * kb, scr, lane);
                continue;
            }
            r -= I_MEMW;
            if (r < I_OUT) {
                const int j = r / 16, kb = r % 16;
                const float* g = (kb < 6) ? AIN(I_SSDG) + l * 384 : (kb < 12 ? AIN(I_SBG) + l * 384 - 384 : AIN(I_MEMOG) + l * 256 - 768);
                transpose_item(AIN(I_WOUT) + (size_t)l * D * D, D, 32 * j, 32, g, (bf16*)(ws + WS_WOUT) + (size_t)l * D * D, D, 32 * j, 64 * kb, scr, lane);
                continue;
            }
            r -= I_OUT;
            if (r < 32 * 16) { const int j = r / 16, kb = r % 16;
                transpose_item(AIN(I_WQ) + (size_t)l * D * D, D, 32 * j, 32, AIN(I_NORM2G) + l * D, (bf16*)(ws + WS_WSC) + (size_t)l * D * D, D, 32 * j, 64 * kb, scr, lane); }
            else { r -= 32 * 16;
                const GAS f32x4* kr = (const GAS f32x4*)(AIN(I_KEYS) + (size_t)l * 16 * 128 * 64 + (size_t)r * 1024) + lane; GAS unsigned long long* o8 = (GAS unsigned long long*)((bf16*)(ws + WS_KB) + (size_t)l * 16 * 128 * 64 + (size_t)r * 1024) + lane;
#pragma unroll
                for (int j = 0; j < 4; ++j) { const f32x4 v = kr[64 * j]; o8[64 * j] = (unsigned long long)pkbf(v.x, v.y) | ((unsigned long long)pkbf(v.z, v.w) << 32); } }
            continue;
        }
        (void)0;
    }
    for (int r0 = gw; r0 < T + MROWS; r0 += 4 * NGW) {
        f32x4 v[4][4];
#pragma unroll
        for (int q = 0; q < 4; ++q) { const int r = r0 + q * NGW; const float* src = r < T ? AIN(I_X) + (size_t)r * D : AIN(I_MEM) + (size_t)(r - T) * D;
#pragma unroll
            for (int j = 0; j < 4; ++j) v[q][j] = (r < T + MROWS) ? *((const GAS f32x4*)src + 64 * j + lane) : (f32x4){0.f, 0.f, 0.f, 0.f}; }
#pragma unroll
        for (int q = 0; q < 4; ++q) { const int r = r0 + q * NGW; if (r >= T + MROWS) continue;
            float ss = 0.f;
#pragma unroll
            for (int j = 0; j < 4; ++j) ss += (v[q][j].x * v[q][j].x + v[q][j].y * v[q][j].y) + (v[q][j].z * v[q][j].z + v[q][j].w * v[q][j].w);
            ss = wave_sum(ss);
            GAS unsigned long long* o8 = (GAS unsigned long long*)(r < T ? (bf16*)(ws + WS_XB) + (size_t)r * D : (bf16*)(ws + WS_MEMB) + (size_t)(r - T) * D) + lane;
#pragma unroll
            for (int j = 0; j < 4; ++j) o8[64 * j] = (unsigned long long)pkbf(v[q][j].x, v[q][j].y) | ((unsigned long long)pkbf(v[q][j].z, v[q][j].w) << 32);
            if (r < T) { if (lane < 8) ((float*)(ws + WS_RS1P))[(size_t)r * 8 + lane] = lane == 0 ? ss : 0.f; }
            else if (lane == 0) ((float*)(ws + WS_RSM))[r - T] = rsqrtf(ss * (1.f / 1024.f) + EPS);
        }
    }
}


__device__ __forceinline__ void convert_tables(const Args& a, unsigned char* ws, int l, int widx, int nw, int lane) {
    for (int r0 = widx; r0 < 2 * 16384; r0 += 4 * nw) {
        f32x4 v[4][4];
#pragma unroll
        for (int q = 0; q < 4; ++q) {
            const int r = r0 + q * nw; const int tb = r >> 14, e = (r & 16383) + l * 16384;
            const float* src = (tb == 0 ? AIN(I_PU) : AIN(I_PV)) + (size_t)e * D;
#pragma unroll
            for (int j = 0; j < 4; ++j) v[q][j] = (r < 2 * 16384) ? *((const GAS f32x4*)src + 64 * j + lane) : (f32x4){0.f, 0.f, 0.f, 0.f};
        }
#pragma unroll
        for (int q = 0; q < 4; ++q) {
            const int r = r0 + q * nw; const int tb = r >> 14, e = (r & 16383) + l * 16384;
            if (r >= 2 * 16384) continue;
            unsigned* dst = (unsigned*)(ws + (tb == 0 ? WS_UT : WS_VT) + (size_t)l * 16384 * D + (size_t)(e & 16383) * 128) + (lane & 31);
            const float* g = AIN(I_NORM2G) + l * D;
            float am = 0.f;
#pragma unroll
            for (int j = 0; j < 4; ++j) { if (tb == 0) v[q][j] = v[q][j] * *((const GAS f32x4*)g + 64 * j + lane);
                am = fmaxf(fmaxf(am, fmaxf(fabsf(v[q][j].x), fabsf(v[q][j].y))), fmaxf(fabsf(v[q][j].z), fabsf(v[q][j].w))); }
            am = wave_max(am);
            const float sc = am > 0.f ? 256.f / am : 1.f;
#pragma unroll
            for (int j = 0; j < 4; ++j) { int pk = 0; pk = __builtin_amdgcn_cvt_pk_fp8_f32(v[q][j].x * sc, v[q][j].y * sc, pk, false); pk = __builtin_amdgcn_cvt_pk_fp8_f32(v[q][j].z * sc, v[q][j].w * sc, pk, true); dst[(size_t)(2 * j + (lane >> 5)) * (16384 * 128 / 4)] = (unsigned)pk; }
            if (lane == 0) ((float*)(ws + (tb == 0 ? WS_USC : WS_VSC)))[e] = am > 0.f ? am * (1.f / 256.f) : 1.f;
        }
    }
}

typedef __attribute__((ext_vector_type(8))) __bf16 bf8_t;
typedef __attribute__((ext_vector_type(8))) float f32x8;
typedef __attribute__((ext_vector_type(8))) short s16x8;
typedef __attribute__((ext_vector_type(4))) short s16x4;
typedef __attribute__((ext_vector_type(16))) float f32x16;
typedef unsigned u32x2 __attribute__((ext_vector_type(2)));
#define MFMA32(a, b, c) __builtin_amdgcn_mfma_f32_32x32x16_bf16((a), (b), (c), 0, 0, 0)
__device__ __forceinline__ int crow(int i, int h) { return (i & 3) + 8 * (i >> 2) + 4 * h; }
__device__ __forceinline__ s16x8 cvt8(const f32x8 x) { return __builtin_bit_cast(s16x8, __builtin_convertvector(x, bf8_t)); }
__device__ __forceinline__ s16x8 pack_acc(const f32x16& x, int s) { f32x8 v;
#pragma unroll
    for (int j = 0; j < 8; ++j) v[j] = x[8 * s + j];
    return cvt8(v); }
__device__ __forceinline__ s16x8 cat4(const s16x4 lo, const s16x4 hi) { return __builtin_shufflevector(lo, hi, 0, 1, 2, 3, 4, 5, 6, 7); }
__device__ __forceinline__ f32x16 zero16() { f32x16 z;
#pragma unroll
    for (int i = 0; i < 16; ++i) z[i] = 0.f;
    return z; }
constexpr int L_BM = 0, L_CM = 18432, L_BMT = 36864, L_XDT = 54272, L_ACS = 106496, L_DT = 108032, L_TOT = 109568;

__device__ __forceinline__ void ssd_chunk_unit(const Args& a, unsigned char* ws, LAS unsigned char* lds, int l_, int unit, int tid, int wave, int lane) {
    const int g = unit & 1, c = (unit >> 1) & 31, b = unit >> 6, t0 = b * S + c * 128;
    const bf16* proj = (const bf16*)(ws + WS_PROJ); const float* dtf = (const float*)(ws + WS_DTF);
    LAS float* acs = (LAS float*)(lds + L_ACS); LAS float* dts = (LAS float*)(lds + L_DT); LAS float* tot = (LAS float*)(lds + L_TOT);
    float cs = 0.f, dtv = 0.f;
    if (wave < 6) {
        const int hh = wave >> 1, l = (wave & 1) * 64 + lane;
        dtv = dtf[(size_t)(t0 + l) * 8 + 3 * g + hh];
        cs = dtv * -expf(AIN(I_ALOG)[l_ * 6 + 3 * g + hh]);
#pragma unroll
        for (int o = 1; o < 64; o <<= 1) { const float t = bperm_f(cs, lane - o); if (lane >= o) cs += t; }
        if (lane == 63) tot[wave] = cs;
    }
    __syncthreads();
    if (wave < 6) {
        const int hh = wave >> 1, l = (wave & 1) * 64 + lane;
        if (wave & 1) cs += tot[wave - 1];
        acs[hh * 128 + l] = cs; dts[hh * 128 + l] = dtv;
        ((float*)(ws + WS_ACSG))[(size_t)(t0 + l) * 8 + 3 * g + hh] = cs;
    }
    __syncthreads();
    const float* cw = AIN(I_CONVW) + l_ * 4 * CONV_CH; const float* cb = AIN(I_CONVB) + l_ * CONV_CH;
#pragma unroll 2
    for (int it = 0; it < 10; ++it) {
        const int idx = tid + 512 * it, l = idx / 40, ck = idx % 40;
        int cc, kind, hh = 0, e0;
        if (ck < 24) { hh = ck >> 3; e0 = (ck & 7) * 8; cc = (3 * g + hh) * 64 + e0; kind = 0; }
        else if (ck < 32) { e0 = (ck - 24) * 8; cc = 384 + g * 64 + e0; kind = 1; }
        else { e0 = (ck - 32) * 8; cc = 512 + g * 64 + e0; kind = 2; }
        float acc[8];
        { const f32x4 b0 = *(const f32x4*)(cb + cc), b1 = *(const f32x4*)(cb + cc + 4); acc[0] = b0.x; acc[1] = b0.y; acc[2] = b0.z; acc[3] = b0.w; acc[4] = b1.x; acc[5] = b1.y; acc[6] = b1.z; acc[7] = b1.w; }
#pragma unroll
        for (int k = 0; k < 4; ++k) {
            const int sl = c * 128 + l - 3 + k;
            if (sl >= 0) {
                const v4u xv = *(const GAS v4u*)(proj + (size_t)(t0 + l - 3 + k) * NPROJ + PC_XBC + cc);
                const f32x4 w0 = *(const f32x4*)(cw + k * CONV_CH + cc), w1 = *(const f32x4*)(cw + k * CONV_CH + cc + 4);
                acc[0] += w0.x * __uint_as_float(xv.x << 16); acc[1] += w0.y * __uint_as_float(xv.x & 0xffff0000u);
                acc[2] += w0.z * __uint_as_float(xv.y << 16); acc[3] += w0.w * __uint_as_float(xv.y & 0xffff0000u);
                acc[4] += w1.x * __uint_as_float(xv.z << 16); acc[5] += w1.y * __uint_as_float(xv.z & 0xffff0000u);
                acc[6] += w1.z * __uint_as_float(xv.w << 16); acc[7] += w1.w * __uint_as_float(xv.w & 0xffff0000u);
            }
        }
#pragma unroll
        for (int e = 0; e < 8; ++e) acc[e] = silu_f(acc[e]);
        v4u pk; pk.x = pkbf(acc[0], acc[1]); pk.y = pkbf(acc[2], acc[3]); pk.z = pkbf(acc[4], acc[5]); pk.w = pkbf(acc[6], acc[7]);
        if (kind == 0) {
            *(GAS v4u*)((bf16*)(ws + WS_XCONV) + (size_t)(t0 + l) * 384 + (3 * g + hh) * 64 + e0) = pk;
            const float d = dts[hh * 128 + l];
            LAS bf16* xd = (LAS bf16*)(lds + L_XDT) + (hh * 64 + e0) * 136 + l;
#pragma unroll
            for (int e = 0; e < 8; e += 2) { const unsigned w = pkbf(acc[e] * d, acc[e + 1] * d); xd[e * 136] = (bf16)(w & 0xffffu); xd[(e + 1) * 136] = (bf16)(w >> 16); }
        } else if (kind == 1) {
            *(LAS v4u*)(lds + L_BM + (l * 72 + e0) * 2) = pk;
            LAS bf16* bt = (LAS bf16*)(lds + L_BMT) + e0 * 136 + l;
            bt[0 * 136] = (bf16)(pk.x & 0xffffu); bt[1 * 136] = (bf16)(pk.x >> 16); bt[2 * 136] = (bf16)(pk.y & 0xffffu); bt[3 * 136] = (bf16)(pk.y >> 16);
            bt[4 * 136] = (bf16)(pk.z & 0xffffu); bt[5 * 136] = (bf16)(pk.z >> 16); bt[6 * 136] = (bf16)(pk.w & 0xffffu); bt[7 * 136] = (bf16)(pk.w >> 16);
        } else {
            *(LAS v4u*)(lds + L_CM + (l * 72 + e0) * 2) = pk;
            *(GAS v4u*)((bf16*)(ws + WS_CMG) + (size_t)(t0 + l) * 128 + g * 64 + e0) = pk;
        }
    }
    __syncthreads();
    const int r = lane & 31, h = lane >> 5, lb = wave & 3, pt = wave >> 2;
    {
        s16x8 cf[4];
#pragma unroll
        for (int ks = 0; ks < 4; ++ks) cf[ks] = *(const LAS s16x8*)(lds + L_CM + ((lb * 32 + r) * 72 + ks * 16 + 8 * h) * 2);
        f32x16 gt[4];
#pragma unroll
        for (int sb = 0; sb < 4; ++sb) {
            gt[sb] = zero16();
            if (sb <= lb) {
#pragma unroll
                for (int ks = 0; ks < 4; ++ks) gt[sb] = MFMA32(*(const LAS s16x8*)(lds + L_BM + ((sb * 32 + r) * 72 + ks * 16 + 8 * h) * 2), cf[ks], gt[sb]);
            }
        }
#pragma unroll
        for (int hh = 0; hh < 3; ++hh) {
            const float al = acs[hh * 128 + lb * 32 + r];
            f32x16 yacc = zero16();
#pragma unroll
            for (int sb = 0; sb < 4; ++sb) {
                if (sb <= lb) {
                    f32x16 m;
#pragma unroll
                    for (int i = 0; i < 16; ++i) {
                        const int sl = crow(i, h);
                        const float v = gt[sb][i] * __expf(al - acs[hh * 128 + sb * 32 + sl]);
                        m[i] = (sb < lb || sl <= r) ? v : 0.f;
                    }
#pragma unroll
                    for (int ks = 0; ks < 2; ++ks) {
                        const LAS unsigned char* xp = lds + L_XDT + ((hh * 64 + pt * 32 + r) * 136 + sb * 32 + 16 * ks + 4 * h) * 2;
                        yacc = MFMA32(cat4(*(const LAS s16x4*)xp, *(const LAS s16x4*)(xp + 16)), pack_acc(m, ks), yacc);
                    }
                }
            }
            float* yp = (float*)(ws + WS_YPART) + (size_t)(t0 + lb * 32 + r) * 384 + (3 * g + hh) * 64 + pt * 32 + 4 * h;
#pragma unroll
            for (int i4 = 0; i4 < 4; ++i4) *(f32x4*)(yp + 8 * i4) = (f32x4){yacc[4 * i4], yacc[4 * i4 + 1], yacc[4 * i4 + 2], yacc[4 * i4 + 3]};
        }
    }
    for (int tl = wave; tl < 12; tl += 8) {
        const int hh = tl >> 2, nt = (tl >> 1) & 1, pt2 = tl & 1;
        const float alast = acs[hh * 128 + 127];
        f32x16 acc = zero16();
#pragma unroll
        for (int ks = 0; ks < 8; ++ks) {
            const s16x8 af = *(const LAS s16x8*)(lds + L_BMT + ((nt * 32 + r) * 136 + ks * 16 + 8 * h) * 2);
            const v4u xr = *(const LAS v4u*)(lds + L_XDT + ((hh * 64 + pt2 * 32 + r) * 136 + ks * 16 + 8 * h) * 2);
            const LAS float* ap = acs + hh * 128 + ks * 16 + 8 * h;
            f32x8 xf;
            xf[0] = __uint_as_float(xr.x << 16) * __expf(alast - ap[0]); xf[1] = __uint_as_float(xr.x & 0xffff0000u) * __expf(alast - ap[1]);
            xf[2] = __uint_as_float(xr.y << 16) * __expf(alast - ap[2]); xf[3] = __uint_as_float(xr.y & 0xffff0000u) * __expf(alast - ap[3]);
            xf[4] = __uint_as_float(xr.z << 16) * __expf(alast - ap[4]); xf[5] = __uint_as_float(xr.z & 0xffff0000u) * __expf(alast - ap[5]);
            xf[6] = __uint_as_float(xr.w << 16) * __expf(alast - ap[6]); xf[7] = __uint_as_float(xr.w & 0xffff0000u) * __expf(alast - ap[7]);
            acc = MFMA32(af, cvt8(xf), acc);
        }
        float* hp = (float*)(ws + WS_HS) + ((size_t)((b * 32 + c) * 6 + 3 * g + hh) * 64 + pt2 * 32 + r) * 64 + nt * 32 + 4 * h;
#pragma unroll
        for (int i4 = 0; i4 < 4; ++i4) *(f32x4*)(hp + 8 * i4) = (f32x4){acc[4 * i4], acc[4 * i4 + 1], acc[4 * i4 + 2], acc[4 * i4 + 3]};
    }
    if (tid < 3) ((float*)(ws + WS_CD))[(b * 32 + c) * 6 + 3 * g + tid] = __expf(acs[tid * 128 + 127]);
    __syncthreads();
}
__device__ __forceinline__ void ph_ssd_scan(unsigned char* ws, int bx, int G, int tid) {
    float* hs = (float*)(ws + WS_HS); const float* cd = (const float*)(ws + WS_CD);
    for (int e = bx * 512 + tid; e < 24 * 4096; e += G * 512) {
        const int bh = e >> 12, el = e & 4095, b = bh / 6, hh = bh % 6;
        float run = 0.f;
#pragma unroll 4
        for (int c = 0; c < 32; ++c) {
            const int idx = (b * 32 + c) * 6 + hh;
            const float v = hs[(size_t)idx * 4096 + el], d = cd[idx];
            hs[(size_t)idx * 4096 + el] = run; run = run * d + v;
        }
    }
}
__device__ __forceinline__ void ssd_finish_unit(const Args& a, unsigned char* ws, LAS unsigned char* lds, int l_, int unit, int tid, int wave, int lane) {
    const int g = unit & 1, c = (unit >> 1) & 31, b = unit >> 6, t0 = b * S + c * 128;
    const int r = lane & 31, h = lane >> 5;
    const bf16* proj = (const bf16*)(ws + WS_PROJ);
    LAS float* sq = (LAS float*)lds;
    for (int item = wave; item < 24; item += NWAVES) {
        const int pt = item & 1, hh = (item >> 1) % 3, lb = item / 6, hd = 3 * g + hh;
        const int t = t0 + lb * 32 + r;
        const bf16* cmg = (const bf16*)(ws + WS_CMG) + (size_t)t * 128 + g * 64;
        const float* hin = (const float*)(ws + WS_HS) + (size_t)((b * 32 + c) * 6 + hd) * 4096;
        s16x8 cf[4]; f32x4 h0[4], h1[4];
#pragma unroll
        for (int ks = 0; ks < 4; ++ks) { cf[ks] = *(const GAS s16x8*)(cmg + ks * 16 + 8 * h); const float* hp = hin + (pt * 32 + r) * 64 + ks * 16 + 8 * h; h0[ks] = *(const GAS f32x4*)hp; h1[ks] = *(const GAS f32x4*)(hp + 4); }
        const float ea = __expf(((const float*)(ws + WS_ACSG))[(size_t)t * 8 + hd]), dsk = AIN(I_DSKIP)[l_ * 6 + hd];
        f32x4 yp[4]; u32x2 xc[4], zz[4];
#pragma unroll
        for (int i4 = 0; i4 < 4; ++i4) {
            const int col = hd * 64 + pt * 32 + 8 * i4 + 4 * h;
            yp[i4] = *(const GAS f32x4*)((const float*)(ws + WS_YPART) + (size_t)t * 384 + col);
            xc[i4] = *(const GAS u32x2*)((const bf16*)(ws + WS_XCONV) + (size_t)t * 384 + col);
            zz[i4] = *(const GAS u32x2*)(proj + (size_t)t * NPROJ + PC_Z + col);
        }
        f32x16 acc = zero16();
#pragma unroll
        for (int ks = 0; ks < 4; ++ks) acc = MFMA32(cvt8((f32x8){h0[ks].x, h0[ks].y, h0[ks].z, h0[ks].w, h1[ks].x, h1[ks].y, h1[ks].z, h1[ks].w}), cf[ks], acc);
        float ssq = 0.f;
#pragma unroll
        for (int i4 = 0; i4 < 4; ++i4) {
            const int col = hd * 64 + pt * 32 + 8 * i4 + 4 * h;
            const float y0 = (yp[i4].x + acc[4 * i4 + 0] * ea + dsk * __uint_as_float(xc[i4].x << 16)) * silu_f(__uint_as_float(zz[i4].x << 16));
            const float y1 = (yp[i4].y + acc[4 * i4 + 1] * ea + dsk * __uint_as_float(xc[i4].x & 0xffff0000u)) * silu_f(__uint_as_float(zz[i4].x & 0xffff0000u));
            const float y2 = (yp[i4].z + acc[4 * i4 + 2] * ea + dsk * __uint_as_float(xc[i4].y << 16)) * silu_f(__uint_as_float(zz[i4].y << 16));
            const float y3 = (yp[i4].w + acc[4 * i4 + 3] * ea + dsk * __uint_as_float(xc[i4].y & 0xffff0000u)) * silu_f(__uint_as_float(zz[i4].y & 0xffff0000u));
            ssq += (y0 * y0 + y1 * y1) + (y2 * y2 + y3 * y3);
            u32x2 w; w.x = pkbf(y0, y1); w.y = pkbf(y2, y3);
            *(GAS u32x2*)((bf16*)(ws + WS_YCAT) + (size_t)t * D + col) = w;
        }
        ssq = swap32_add(ssq, ssq);
        if (h == 0) sq[((lb * 32 + r) * 3 + hh) * 2 + pt] = ssq;
    }
    __syncthreads();
    if (tid < 384) { const int tk = tid & 127, hh = tid >> 7; ((float*)(ws + WS_YSSQ))[(size_t)(t0 + tk) * 16 + 3 * g + hh] = sq[(tk * 3 + hh) * 2] + sq[(tk * 3 + hh) * 2 + 1]; }
    __syncthreads();
}

#define LOG2E 1.4426950408889634f
__device__ __forceinline__ s16x8 trv_frag(const LAS unsigned char* vimg, int key0, int ks, int dt, int lane) {
    const int h = lane >> 5, i16 = lane & 15, blk = (lane >> 4) & 1;
    const LAS unsigned char* p = vimg + (key0 + 16 * ks + 4 * h + (i16 >> 2)) * 144 + (dt * 32 + 16 * blk) * 2 + 8 * (i16 & 3);
    const s16x4 lo = __builtin_amdgcn_ds_read_tr16_b64_v4i16((LAS s16x4*)p), hi = __builtin_amdgcn_ds_read_tr16_b64_v4i16((LAS s16x4*)(p + 8 * 144));
    return cat4(lo, hi);
}
__device__ __forceinline__ void mem_unit(const Args& a, unsigned char* ws, LAS unsigned char* lds, int l_, int b, int hd, int qb, int tid, int wave, int lane) {
    const bf16* proj = (const bf16*)(ws + WS_PROJ); const bf16* memkv = (const bf16*)(ws + WS_MEMKV);
    const float* qg = AIN(I_MQG) + l_ * 64; const float* kg = AIN(I_MKG) + l_ * 64;
    LAS unsigned char* kimg = lds; LAS unsigned char* vimg = lds + 36864;
#pragma unroll
    for (int it = 0; it < 4; ++it) {
        const int idx = tid + 512 * it, m = idx >> 3, ch = idx & 7;
        const v4u kv = *(const GAS v4u*)(memkv + (size_t)(b * NMEM + m) * 512 + hd * 64 + ch * 8);
        const v4u vv = *(const GAS v4u*)(memkv + (size_t)(b * NMEM + m) * 512 + 256 + hd * 64 + ch * 8);
        float kf[8] = {__uint_as_float(kv.x << 16), __uint_as_float(kv.x & 0xffff0000u), __uint_as_float(kv.y << 16), __uint_as_float(kv.y & 0xffff0000u),
                       __uint_as_float(kv.z << 16), __uint_as_float(kv.z & 0xffff0000u), __uint_as_float(kv.w << 16), __uint_as_float(kv.w & 0xffff0000u)};
        float ss = 0.f;
#pragma unroll
        for (int e = 0; e < 8; ++e) ss += kf[e] * kf[e];
        ss = sum8(ss);
        const float rk = rsqrtf(ss * (1.f / 64.f) + EPS);
        const f32x4 g0 = *(const f32x4*)(kg + ch * 8), g1 = *(const f32x4*)(kg + ch * 8 + 4);
        v4u pk; pk.x = pkbf(kf[0] * rk * g0.x, kf[1] * rk * g0.y); pk.y = pkbf(kf[2] * rk * g0.z, kf[3] * rk * g0.w); pk.z = pkbf(kf[4] * rk * g1.x, kf[5] * rk * g1.y); pk.w = pkbf(kf[6] * rk * g1.z, kf[7] * rk * g1.w);
        *(LAS v4u*)(kimg + (m * 72 + ch * 8) * 2) = pk;
        *(LAS v4u*)(vimg + (m * 72 + ch * 8) * 2) = vv;
    }
    __syncthreads();
    const int r = lane & 31, h = lane >> 5;
    const int t = b * S + qb * 256 + wave * 32 + r;
    s16x8 qf[4];
    {
        f32x8 qv[4]; float ss = 0.f;
#pragma unroll
        for (int ks = 0; ks < 4; ++ks) {
            const v4u q = *(const GAS v4u*)(proj + (size_t)t * NPROJ + PC_QMEM + hd * 64 + ks * 16 + 8 * h);
            qv[ks] = (f32x8){__uint_as_float(q.x << 16), __uint_as_float(q.x & 0xffff0000u), __uint_as_float(q.y << 16), __uint_as_float(q.y & 0xffff0000u),
                             __uint_as_float(q.z << 16), __uint_as_float(q.z & 0xffff0000u), __uint_as_float(q.w << 16), __uint_as_float(q.w & 0xffff0000u)};
#pragma unroll
            for (int e = 0; e < 8; ++e) ss += qv[ks][e] * qv[ks][e];
        }
        ss = swap32_add(ss, ss);
        const float rq = rsqrtf(ss * (1.f / 64.f) + EPS) * (0.125f * LOG2E);
#pragma unroll
        for (int ks = 0; ks < 4; ++ks) {
            const f32x4 g0 = *(const f32x4*)(qg + ks * 16 + 8 * h), g1 = *(const f32x4*)(qg + ks * 16 + 8 * h + 4);
            qf[ks] = cvt8(qv[ks] * rq * (f32x8){g0.x, g0.y, g0.z, g0.w, g1.x, g1.y, g1.z, g1.w});
        }
    }
    f32x16 st[8];
    float mx = -INFINITY;
#pragma unroll
    for (int kt = 0; kt < 8; ++kt) {
        st[kt] = zero16();
#pragma unroll
        for (int ks = 0; ks < 4; ++ks) st[kt] = MFMA32(*(const LAS s16x8*)(kimg + ((kt * 32 + r) * 72 + ks * 16 + 8 * h) * 2), qf[ks], st[kt]);
#pragma unroll
        for (int i = 0; i < 16; ++i) mx = fmaxf(mx, st[kt][i]);
    }
    mx = swap32_max(mx);
    float lsum = 0.f;
    f32x16 o0 = zero16(), o1 = zero16();
#pragma unroll
    for (int kt = 0; kt < 8; ++kt) {
#pragma unroll
        for (int i = 0; i < 16; ++i) { st[kt][i] = __builtin_amdgcn_exp2f(st[kt][i] - mx); lsum += st[kt][i]; }
#pragma unroll
        for (int ks = 0; ks < 2; ++ks) {
            const s16x8 pf = pack_acc(st[kt], ks);
            o0 = MFMA32(trv_frag(vimg, kt * 32, ks, 0, lane), pf, o0);
            o1 = MFMA32(trv_frag(vimg, kt * 32, ks, 1, lane), pf, o1);
        }
    }
    lsum = swap32_add(lsum, lsum);
    const float il = 1.f / lsum; float ssq = 0.f;
    bf16* yc = (bf16*)(ws + WS_YCAT) + (size_t)t * D + 768 + hd * 64 + 4 * h;
#pragma unroll
    for (int i4 = 0; i4 < 4; ++i4) {
        const float a0 = o0[4 * i4] * il, a1 = o0[4 * i4 + 1] * il, a2 = o0[4 * i4 + 2] * il, a3 = o0[4 * i4 + 3] * il;
        const float b0 = o1[4 * i4] * il, b1 = o1[4 * i4 + 1] * il, b2 = o1[4 * i4 + 2] * il, b3 = o1[4 * i4 + 3] * il;
        ssq += (a0 * a0 + a1 * a1) + (a2 * a2 + a3 * a3) + (b0 * b0 + b1 * b1) + (b2 * b2 + b3 * b3);
        u32x2 w; w.x = pkbf(a0, a1); w.y = pkbf(a2, a3); *(GAS u32x2*)(yc + 8 * i4) = w;
        w.x = pkbf(b0, b1); w.y = pkbf(b2, b3); *(GAS u32x2*)(yc + 32 + 8 * i4) = w;
    }
    ssq = swap32_add(ssq, ssq);
    if (h == 0) ((float*)(ws + WS_YSSQ))[(size_t)t * 16 + 12 + hd] = ssq;
    __syncthreads();
}
__device__ __forceinline__ void sb_unit(unsigned char* ws, LAS unsigned char* lds, int b, int hd, int qb, int tid, int wave, int lane) {
    const bf16* proj = (const bf16*)(ws + WS_PROJ);
    const int r = lane & 31, h = lane >> 5;
    const int q0w = qb * 256 + wave * 32, t = b * S + q0w + r;
    s16x8 qf[4];
#pragma unroll
    for (int ks = 0; ks < 4; ++ks) {
        const v4u q = *(const GAS v4u*)(proj + (size_t)t * NPROJ + PC_QSB + hd * 64 + ks * 16 + 8 * h);
        const f32x8 qv = (f32x8){__uint_as_float(q.x << 16), __uint_as_float(q.x & 0xffff0000u), __uint_as_float(q.y << 16), __uint_as_float(q.y & 0xffff0000u),
                                 __uint_as_float(q.z << 16), __uint_as_float(q.z & 0xffff0000u), __uint_as_float(q.w << 16), __uint_as_float(q.w & 0xffff0000u)};
        qf[ks] = cvt8(qv * (0.125f * LOG2E));
    }
    const int srow = tid >> 3, sch = tid & 7;
    const bf16* kbase = proj + (size_t)(b * S) * NPROJ + PC_KSB + hd * 64 + sch * 8;
    const int ktop = qb * 4 + 3;
    v4u kr = *(const GAS v4u*)(kbase + (size_t)(ktop * 64 + srow) * NPROJ), vr = *(const GAS v4u*)(kbase + (size_t)(ktop * 64 + srow) * NPROJ + (PC_VSB - PC_KSB));
    *(LAS v4u*)(lds + (srow * 72 + sch * 8) * 2) = kr; *(LAS v4u*)(lds + 9216 + (srow * 72 + sch * 8) * 2) = vr;
    __syncthreads();
    f32x16 o0 = zero16(), o1 = zero16();
    float R = 0.f;
    volatile LAS unsigned* live = (volatile LAS unsigned*)(lds + 36864);
    bool mylive = true;
    for (int kt = ktop; kt >= 0; --kt) {
        LAS unsigned char* kimg = lds + ((ktop - kt) & 1) * 18432; LAS unsigned char* vimg = kimg + 9216;
        if (kt > 0) { kr = *(const GAS v4u*)(kbase + (size_t)((kt - 1) * 64 + srow) * NPROJ); vr = *(const GAS v4u*)(kbase + (size_t)((kt - 1) * 64 + srow) * NPROJ + (PC_VSB - PC_KSB)); }
#pragma unroll
        for (int sub = 1; sub >= 0; --sub) {
            const int kb = kt * 64 + sub * 32;
            if (kb <= q0w && mylive) {
                const bool diag = (kb == q0w);
                f32x16 z = zero16();
#pragma unroll
                for (int ks = 0; ks < 4; ++ks) z = MFMA32(*(const LAS s16x8*)(kimg + ((sub * 32 + r) * 72 + ks * 16 + 8 * h) * 2), qf[ks], z);
                float lk[16];
#pragma unroll
                for (int i = 0; i < 16; ++i) {
                    const float sp = fmaxf(z[i], 0.f) + __builtin_amdgcn_logf(1.f + __builtin_amdgcn_exp2f(-fabsf(z[i])));
                    const bool ok = !diag || (crow(i, h) < r);
                    lk[i] = ok ? -sp : 0.f;
                    z[i] = ok ? z[i] : -INFINITY;
                }
                float g[4], pg[4];
#pragma unroll
                for (int j = 0; j < 4; ++j) { g[j] = (lk[4 * j] + lk[4 * j + 1]) + (lk[4 * j + 2] + lk[4 * j + 3]); pg[j] = partner32(g[j], h != 0); }
                float ab[4];
                ab[3] = R + (h == 0 ? pg[3] : 0.f);
#pragma unroll
                for (int j = 2; j >= 0; --j) ab[j] = ab[j + 1] + g[j + 1] + (h == 0 ? pg[j] : pg[j + 1]);
#pragma unroll
                for (int j = 0; j < 4; ++j) {
                    const float s3 = ab[j], s2 = s3 + lk[4 * j + 3], s1 = s2 + lk[4 * j + 2], s0 = s1 + lk[4 * j + 1];
                    z[4 * j + 3] = __builtin_amdgcn_exp2f(z[4 * j + 3] + lk[4 * j + 3] + s3);
                    z[4 * j + 2] = __builtin_amdgcn_exp2f(z[4 * j + 2] + lk[4 * j + 2] + s2);
                    z[4 * j + 1] = __builtin_amdgcn_exp2f(z[4 * j + 1] + lk[4 * j + 1] + s1);
                    z[4 * j + 0] = __builtin_amdgcn_exp2f(z[4 * j + 0] + lk[4 * j + 0] + s0);
                }
                R = ab[0] + g[0] + (h == 0 ? 0.f : pg[0]);
#pragma unroll
                for (int ks = 0; ks < 2; ++ks) {
                    const s16x8 pf = pack_acc(z, ks);
                    o0 = MFMA32(trv_frag(vimg, sub * 32, ks, 0, lane), pf, o0);
                    o1 = MFMA32(trv_frag(vimg, sub * 32, ks, 1, lane), pf, o1);
                }
            }
        }
        if (kt > 0) { LAS unsigned char* nimg = lds + ((ktop - kt + 1) & 1) * 18432; *(LAS v4u*)(nimg + (srow * 72 + sch * 8) * 2) = kr; *(LAS v4u*)(nimg + 9216 + (srow * 72 + sch * 8) * 2) = vr; }
        mylive = mylive && (__builtin_amdgcn_ballot_w64(R >= -150.f) != 0ull);
        if (lane == 0) live[((ktop - kt) & 1) * 8 + wave] = mylive ? 1u : 0u;
        __syncthreads();
        { unsigned any = 0u;
#pragma unroll
          for (int w = 0; w < 8; ++w) any |= live[((ktop - kt) & 1) * 8 + w];
          if (any == 0u) break; }
    }
    float ssq = 0.f;
    bf16* yc = (bf16*)(ws + WS_YCAT) + (size_t)t * D + 384 + hd * 64 + 4 * h;
#pragma unroll
    for (int i4 = 0; i4 < 4; ++i4) {
        const float a0 = o0[4 * i4], a1 = o0[4 * i4 + 1], a2 = o0[4 * i4 + 2], a3 = o0[4 * i4 + 3];
        const float b0 = o1[4 * i4], b1 = o1[4 * i4 + 1], b2 = o1[4 * i4 + 2], b3 = o1[4 * i4 + 3];
        ssq += (a0 * a0 + a1 * a1) + (a2 * a2 + a3 * a3) + (b0 * b0 + b1 * b1) + (b2 * b2 + b3 * b3);
        u32x2 w; w.x = pkbf(a0, a1); w.y = pkbf(a2, a3); *(GAS u32x2*)(yc + 8 * i4) = w;
        w.x = pkbf(b0, b1); w.y = pkbf(b2, b3); *(GAS u32x2*)(yc + 32 + 8 * i4) = w;
    }
    ssq = swap32_add(ssq, ssq);
    if (h == 0) ((float*)(ws + WS_YSSQ))[(size_t)t * 16 + 6 + hd] = ssq;
}
constexpr int CW_Q = 8192;
__device__ __forceinline__ void ph_mix(const Args& a, unsigned char* ws, LAS unsigned char* lds, int l, int qoff, int tid, int wave, int lane) {
    unsigned* head = (unsigned*)(ws + WS_CTL) + CW_Q + 64 * l + qoff;
    volatile LAS unsigned* slot = (volatile LAS unsigned*)(lds + MISC_OFF);
    for (int it = 0;; ++it) {
        if (tid == 0) slot[it & 1] = __hip_atomic_fetch_add(head, 1u, __ATOMIC_RELAXED, __HIP_MEMORY_SCOPE_AGENT);
        __syncthreads();
        const int n = (int)slot[it & 1];
        if (n >= 896) break;
        asm volatile("" : "+s"(ws), "+v"(tid));
        lane = tid & 63; wave = __builtin_amdgcn_readfirstlane(tid >> 6);
        if (n < 384) { const int qb = 15 - n / 24, bh = n % 24; sb_unit(ws, lds, bh / 6, bh % 6, qb, tid, wave, lane); }
        else if (n < 640) { const int m = n - 384; mem_unit(a, ws, lds, l, m >> 6, (m >> 4) & 3, m & 15, tid, wave, lane); }
        else ssd_chunk_unit(a, ws, lds, l, n - 640, tid, wave, lane);
    }
}

__device__ __forceinline__ unsigned f2o(float f) { const unsigned b = __float_as_uint(f); return b ^ ((unsigned)((int)b >> 31) | 0x80000000u); }
__device__ __forceinline__ float o2f(unsigned k) { return __uint_as_float(k ^ ((k & 0x80000000u) ? 0x80000000u : 0xffffffffu)); }
#define TK_CE(a, b) do { const unsigned _mx = (a) > (b) ? (a) : (b), _mn = (a) > (b) ? (b) : (a); (a) = _mx; (b) = _mn; } while (0)
template <int N, int BASE> __device__ __forceinline__ void tk_sort16(unsigned (&k)[N]) {
#pragma unroll
    for (int sz = 2; sz <= 16; sz <<= 1)
#pragma unroll
        for (int j = sz >> 1; j > 0; j >>= 1)
#pragma unroll
            for (int i = 0; i < 16; ++i) { const int l = i ^ j; if (l > i) { if ((i & sz) == 0) TK_CE(k[BASE + i], k[BASE + l]); else TK_CE(k[BASE + l], k[BASE + i]); } }
}
template <int NA, int A, int NB_, int B> __device__ __forceinline__ void tk_merge16(unsigned (&ka)[NA], const unsigned (&kb)[NB_]) {
#pragma unroll
    for (int i = 0; i < 16; ++i) ka[A + i] = ka[A + i] > kb[B + 15 - i] ? ka[A + i] : kb[B + 15 - i];
#pragma unroll
    for (int j = 8; j > 0; j >>= 1)
#pragma unroll
        for (int i = 0; i < 16; ++i) { const int l = i ^ j; if (l > i) TK_CE(ka[A + i], ka[A + l]); }
}
__device__ __forceinline__ unsigned partner32_u(unsigned a, bool hi) { const auto r = __builtin_amdgcn_permlane32_swap(a, a, false, false); return hi ? r[0] : r[1]; }
__device__ __forceinline__ void ph_topk(unsigned char* ws, LAS unsigned char* lds, int l, int pm, int pn, int wave, int lane) {
    const bf16* qb = (const bf16*)(ws + WS_YCAT); const bf16* kb = (const bf16*)(ws + WS_KB) + (size_t)l * 16 * 128 * 64;
    int* eidx = (int*)(ws + WS_EIDX); float* gate = (float*)(ws + WS_GATE);
    LAS float* tr = (LAS float*)(lds + wave * WSCR);
    const int r = lane & 31, h = lane >> 5;
    for (int item = wave; item < 16; item += NWAVES) {
        const int hd = 2 * pn + (item & 1), t = pm * 256 + (item >> 1) * 32 + r;
        unsigned top[2][16];
#pragma unroll
        for (int c = 0; c < 2; ++c) {
            const int hc = 2 * hd + c;
            s16x8 qf[4];
#pragma unroll
            for (int ks = 0; ks < 4; ++ks) qf[ks] = *(const GAS s16x8*)(qb + (size_t)t * D + hc * 64 + ks * 16 + 8 * h);
            unsigned k[64];
#pragma unroll
            for (int nt = 0; nt < 4; ++nt) {
                f32x16 acc = zero16();
#pragma unroll
                for (int ks = 0; ks < 4; ++ks) acc = MFMA32(*(const GAS s16x8*)(kb + (size_t)(hc * 128 + nt * 32 + r) * 64 + ks * 16 + 8 * h), qf[ks], acc);
#pragma unroll
                for (int i = 0; i < 16; ++i) k[16 * nt + i] = (f2o(acc[i]) & ~127u) | (unsigned)((127 - 32 * nt - 8 * (i >> 2) - (i & 3)) - 4 * h);
            }
            tk_sort16<64, 0>(k); tk_sort16<64, 16>(k); tk_sort16<64, 32>(k); tk_sort16<64, 48>(k);
            tk_merge16<64, 0, 64, 16>(k, k); tk_merge16<64, 32, 64, 48>(k, k); tk_merge16<64, 0, 64, 32>(k, k);
            unsigned pk[16];
#pragma unroll
            for (int i = 0; i < 16; ++i) { top[c][i] = k[i]; pk[i] = partner32_u(k[i], h != 0); }
            tk_merge16<16, 0, 16, 0>(top[c], pk);
        }
        const int b = 0; (void)b;
        float av[16], bv[16];
#pragma unroll
        for (int i = 0; i < 16; ++i) { av[i] = o2f(top[0][i] & ~127u); bv[i] = o2f(top[1][i] & ~127u); }
        LAS int* li = (LAS int*)tr + lane * 32;
#pragma unroll
        for (int i = 0; i < 16; ++i) { li[i] = 127 - (int)(top[0][i] & 127u); li[16 + i] = 127 - (int)(top[1][i] & 127u); }
        unsigned key[64];
        key[0] = (f2o(av[0] + bv[0]) & ~255u) | 255u;
        key[1] = (f2o(av[0] + bv[1]) & ~255u) | 254u;
        key[2] = (f2o(av[0] + bv[2]) & ~255u) | 253u;
        key[3] = (f2o(av[0] + bv[3]) & ~255u) | 252u;
        key[4] = (f2o(av[0] + bv[4]) & ~255u) | 251u;
        key[5] = (f2o(av[0] + bv[5]) & ~255u) | 250u;
        key[6] = (f2o(av[0] + bv[6]) & ~255u) | 249u;
        key[7] = (f2o(av[0] + bv[7]) & ~255u) | 248u;
        key[8] = (f2o(av[0] + bv[8]) & ~255u) | 247u;
        key[9] = (f2o(av[0] + bv[9]) & ~255u) | 246u;
        key[10] = (f2o(av[0] + bv[10]) & ~255u) | 245u;
        key[11] = (f2o(av[0] + bv[11]) & ~255u) | 244u;
        key[12] = (f2o(av[0] + bv[12]) & ~255u) | 243u;
        key[13] = (f2o(av[0] + bv[13]) & ~255u) | 242u;
        key[14] = (f2o(av[0] + bv[14]) & ~255u) | 241u;
        key[15] = (f2o(av[0] + bv[15]) & ~255u) | 240u;
        key[16] = (f2o(av[1] + bv[0]) & ~255u) | 239u;
        key[17] = (f2o(av[1] + bv[1]) & ~255u) | 238u;
        key[18] = (f2o(av[1] + bv[2]) & ~255u) | 237u;
        key[19] = (f2o(av[1] + bv[3]) & ~255u) | 236u;
        key[20] = (f2o(av[1] + bv[4]) & ~255u) | 235u;
        key[21] = (f2o(av[1] + bv[5]) & ~255u) | 234u;
        key[22] = (f2o(av[1] + bv[6]) & ~255u) | 233u;
        key[23] = (f2o(av[1] + bv[7]) & ~255u) | 232u;
        key[24] = (f2o(av[2] + bv[0]) & ~255u) | 223u;
        key[25] = (f2o(av[2] + bv[1]) & ~255u) | 222u;
        key[26] = (f2o(av[2] + bv[2]) & ~255u) | 221u;
        key[27] = (f2o(av[2] + bv[3]) & ~255u) | 220u;
        key[28] = (f2o(av[2] + bv[4]) & ~255u) | 219u;
        key[29] = (f2o(av[3] + bv[0]) & ~255u) | 207u;
        key[30] = (f2o(av[3] + bv[1]) & ~255u) | 206u;
        key[31] = (f2o(av[3] + bv[2]) & ~255u) | 205u;
        key[32] = (f2o(av[3] + bv[3]) & ~255u) | 204u;
        key[33] = (f2o(av[4] + bv[0]) & ~255u) | 191u;
        key[34] = (f2o(av[4] + bv[1]) & ~255u) | 190u;
        key[35] = (f2o(av[4] + bv[2]) & ~255u) | 189u;
        key[36] = (f2o(av[5] + bv[0]) & ~255u) | 175u;
        key[37] = (f2o(av[5] + bv[1]) & ~255u) | 174u;
        key[38] = (f2o(av[6] + bv[0]) & ~255u) | 159u;
        key[39] = (f2o(av[6] + bv[1]) & ~255u) | 158u;
        key[40] = (f2o(av[7] + bv[0]) & ~255u) | 143u;
        key[41] = (f2o(av[7] + bv[1]) & ~255u) | 142u;
        key[42] = (f2o(av[8] + bv[0]) & ~255u) | 127u;
        key[43] = (f2o(av[9] + bv[0]) & ~255u) | 111u;
        key[44] = (f2o(av[10] + bv[0]) & ~255u) | 95u;
        key[45] = (f2o(av[11] + bv[0]) & ~255u) | 79u;
        key[46] = (f2o(av[12] + bv[0]) & ~255u) | 63u;
        key[47] = (f2o(av[13] + bv[0]) & ~255u) | 47u;
        key[48] = (f2o(av[14] + bv[0]) & ~255u) | 31u;
        key[49] = (f2o(av[15] + bv[0]) & ~255u) | 15u;
#pragma unroll
        for (int i = 50; i < 64; ++i) key[i] = 0u;
        tk_sort16<64, 0>(key); tk_sort16<64, 16>(key); tk_sort16<64, 32>(key); tk_sort16<64, 48>(key);
        tk_merge16<64, 0, 64, 16>(key, key); tk_merge16<64, 32, 64, 48>(key, key); tk_merge16<64, 0, 64, 32>(key, key);
        asm volatile("s_waitcnt lgkmcnt(0)" ::: "memory");
        const float s0 = o2f(key[0] & ~255u);
        float ev[16]; int ei[16]; float den = 0.f;
#pragma unroll
        for (int w = 0; w < 16; ++w) {
            const unsigned ij = 255u - (key[w] & 255u);
            ev[w] = __expf(o2f(key[w] & ~255u) - s0); den += ev[w];
            ei[w] = li[ij >> 4] * 128 + li[16 + (ij & 15)];
        }
        const float inv = 1.f / den;
        const size_t ob = ((size_t)t * 8 + hd) * 16;
        if (h == 0) {
#pragma unroll
            for (int q = 0; q < 4; ++q) {
                typedef int i32x4 __attribute__((ext_vector_type(4)));
                *(GAS i32x4*)(eidx + ob + 4 * q) = (i32x4){ei[4 * q], ei[4 * q + 1], ei[4 * q + 2], ei[4 * q + 3]};
                *(GAS f32x4*)(gate + ob + 4 * q) = (f32x4){ev[4 * q] * inv, ev[4 * q + 1] * inv, ev[4 * q + 2] * inv, ev[4 * q + 3] * inv};
            }
        }
        asm volatile("s_waitcnt lgkmcnt(0)" ::: "memory");
    }
}

__device__ __forceinline__ float gelu_erf(float v) { return 0.5f * v * (1.f + erff(v * 0.70710678118654752f)); }
typedef __attribute__((ext_vector_type(2))) float f32x2v;
constexpr int CW_Q2 = 12288;
__device__ __forceinline__ void cvt16(const v4u r, float (&f)[16]) {
    const unsigned w[4] = {r.x, r.y, r.z, r.w};
#pragma unroll
    for (int i = 0; i < 4; ++i) { const f32x2v lo = __builtin_amdgcn_cvt_pk_f32_fp8((int)w[i], false), hi = __builtin_amdgcn_cvt_pk_f32_fp8((int)w[i], true); f[4 * i] = lo.x; f[4 * i + 1] = lo.y; f[4 * i + 2] = hi.x; f[4 * i + 3] = hi.y; }
}
constexpr int PCH = 256, PTW = PCH / 8;
typedef __attribute__((ext_vector_type(4))) int i32x4;
struct PIdx { i32x4 e[4]; };
struct PTok { v4u r[16]; f32x4 w[4]; v4u xa, xc; };
template <int QSET> __device__ __forceinline__ void peer_idx(PIdx& I, const GAS int* eidx, int t, int lane) {
    const GAS i32x4* ep = (const GAS i32x4*)(eidx + (size_t)t * 128 + 16 * (lane >> 3));
#pragma unroll
    for (int q = 0; q < 4; ++q) I.e[q] = ep[q];
#if defined(MK_PROBE_EMASK)
    if (QSET == 1) {
#pragma unroll
        for (int q = 0; q < 4; ++q) I.e[q] = I.e[q] & MK_PROBE_EMASK;
    }
#endif
}
template <int PHASE> __device__ __forceinline__ void peer_rows(PTok& K, const PIdx& I, const GAS unsigned char* tab, const GAS float* wgt, const GAS bf16* xb, int t, int s, int lane) {
    const int g = lane >> 3, j = lane & 7;
#pragma unroll
    for (int i = 0; i < 16; ++i) K.r[i] = *(const GAS v4u*)(tab + (size_t)(unsigned)I.e[i >> 2][i & 3] * 128 + 16 * j);
    if (PHASE == 0) { const GAS unsigned char* xrow = (const GAS unsigned char*)(xb + (size_t)t * D + s * 128 + 16 * j); K.xa = *(const GAS v4u*)xrow; K.xc = *(const GAS v4u*)(xrow + 16); }
    else { const GAS f32x4* wp = (const GAS f32x4*)(wgt + (size_t)t * 128 + 16 * g);
#pragma unroll
        for (int q = 0; q < 4; ++q) K.w[q] = wp[q]; }
}
__device__ __forceinline__ void cvt16p(const v4u r, f32x2v (&f)[8]) {
    const unsigned w[4] = {r.x, r.y, r.z, r.w};
#pragma unroll
    for (int i = 0; i < 4; ++i) { f[2 * i] = __builtin_amdgcn_cvt_pk_f32_fp8((int)w[i], false); f[2 * i + 1] = __builtin_amdgcn_cvt_pk_f32_fp8((int)w[i], true); }
}
__device__ __forceinline__ void peer_u_compute(const PTok& K, LAS float* lpart, int lane) {
    const int g = lane >> 3, j = lane & 7;
    f32x2v xv[8];
    { const unsigned xw[8] = {K.xa.x, K.xa.y, K.xa.z, K.xa.w, K.xc.x, K.xc.y, K.xc.z, K.xc.w};
#pragma unroll
      for (int i = 0; i < 8; ++i) xv[i] = (f32x2v){__uint_as_float(xw[i] << 16), __uint_as_float(xw[i] & 0xffff0000u)}; }
    float res_lo = 0.f, res_hi = 0.f;
#pragma unroll
    for (int i = 0; i < 16; ++i) {
        f32x2v f[8]; cvt16p(K.r[i], f);
        f32x2v a0 = xv[0] * f[0], a1 = xv[1] * f[1];
#pragma unroll
        for (int k = 2; k < 8; k += 2) { a0 = a0 + xv[k] * f[k]; a1 = a1 + xv[k + 1] * f[k + 1]; }
        const f32x2v a = a0 + a1;
        const float d = sum8(a.x + a.y);
        if (i < 8) res_lo = (j == i) ? d : res_lo; else res_hi = (j == i - 8) ? d : res_hi;
    }
    lpart[16 * g + j] = res_lo; lpart[16 * g + 8 + j] = res_hi;
}
__device__ __forceinline__ void peer_v_compute(const PTok& K, LAS float* lout, int lane) {
    const int g = lane >> 3, j = lane & 7;
    f32x2v acc[8];
#pragma unroll
    for (int k = 0; k < 8; ++k) acc[k] = (f32x2v){0.f, 0.f};
#pragma unroll
    for (int i = 0; i < 16; ++i) {
        f32x2v f[8]; cvt16p(K.r[i], f);
        const float wi = K.w[i >> 2][i & 3]; const f32x2v w2 = {wi, wi};
#pragma unroll
        for (int k = 0; k < 8; ++k) acc[k] = acc[k] + w2 * f[k];
    }
    float o[16];
#pragma unroll
    for (int k = 0; k < 8; ++k) {
        float a = acc[k].x, b = acc[k].y;
        a += dpp_f<0x128>(a); b += dpp_f<0x128>(b); a = swap16_add(a, a); b = swap16_add(b, b); o[2 * k] = swap32_add(a, a); o[2 * k + 1] = swap32_add(b, b);
    }
    if (g == 0) {
#pragma unroll
        for (int q = 0; q < 4; ++q) *(LAS f32x4*)(lout + 16 * j + 4 * q) = (f32x4){o[4 * q], o[4 * q + 1], o[4 * q + 2], o[4 * q + 3]};
    }
}
template <int PHASE, int QSET = 0> __device__ __forceinline__ void ph_peer_sliced(unsigned char* ws, LAS unsigned char* lds, float* xout, int l, int tid, int wave, int lane) {
    unsigned* heads = (unsigned*)(ws + WS_CTL) + CW_Q2 + ((QSET * 2 + l) * 2 + PHASE) * 8 * 64;
    volatile LAS unsigned* slot = (volatile LAS unsigned*)(lds + MISC_OFF);
    const GAS int* eidx = (const GAS int*)(ws + WS_EIDX); const GAS float* wgt = (const GAS float*)(ws + WS_WV); GAS bf16* xb = (GAS bf16*)(ws + WS_XB);
    const int myx = (int)(xb_xcc_id() & 7u);
    int it = 0;
    for (int k = 0; k < 8; ++k) {
        const int s = (myx + k) & 7;
        const GAS unsigned char* tab = (const GAS unsigned char*)(ws + (PHASE == 0 ? WS_UT : WS_VT) + (size_t)l * 16384 * D + (size_t)s * 16384 * 128);
        GAS float* part = (GAS float*)(ws + WS_PART) + (size_t)s * T * 128;
        for (;; ++it) {
            if (tid == 0) slot[it & 1] = __hip_atomic_fetch_add(heads + 64 * s, 1u, __ATOMIC_RELAXED, __HIP_MEMORY_SCOPE_AGENT);
            __syncthreads();
            const int c = (int)slot[it & 1];
            if (c >= T / PCH) { ++it; break; }
            const int t0 = c * PCH + wave * PTW;
            LAS float* stg = (LAS float*)(lds + wave * WSCR);
            PIdx iB, iC; PTok A, B;
            peer_idx<QSET>(iB, eidx, t0, lane);
            peer_rows<PHASE>(A, iB, tab, wgt, xb, t0, s, lane);
            peer_idx<QSET>(iB, eidx, t0 + 1, lane);
#pragma unroll 2
            for (int i = 0; i < PTW; ++i) {
                peer_idx<QSET>(iC, eidx, t0 + (i + 2 < PTW ? i + 2 : PTW - 1), lane);
                peer_rows<PHASE>(B, iB, tab, wgt, xb, t0 + (i + 1 < PTW ? i + 1 : PTW - 1), s, lane);
                if (PHASE == 0) peer_u_compute(A, stg + i * 128, lane); else peer_v_compute(A, stg + i * 128, lane);
                A = B; iB = iC;
            }
            asm volatile("s_waitcnt lgkmcnt(0)" ::: "memory");
            if (PHASE == 0) {
#pragma unroll
                for (int q = 0; q < PTW * 128 / 256; ++q) *(GAS f32x4*)(part + (size_t)t0 * 128 + q * 256 + lane * 4) = *(const LAS f32x4*)(stg + q * 256 + lane * 4);
            } else {
                GAS float* xo = (GAS float*)xout; GAS float* rs1p = (GAS float*)(ws + WS_RS1P); GAS bf16* xbo = xb;
                if (QSET == 1) { xo = (GAS float*)(ws + WS_PART); xbo = (GAS bf16*)(ws + WS_PART + 64 * MiB); rs1p = (GAS float*)(ws + WS_PART + 100 * MiB); }
#pragma unroll 4
                for (int q = 0; q < PTW / 2; ++q) {
                    const int tk = 2 * q + (lane >> 5), cq = lane & 31, t = t0 + tk;
                    GAS float* xr = xo + (size_t)t * D + s * 128 + 4 * cq;
                    const f32x4 av = *(const LAS f32x4*)(stg + tk * 128 + 4 * cq); const u32x2 bw = *(const GAS u32x2*)(xb + (size_t)t * D + s * 128 + 4 * cq);
                    const f32x4 xv = (f32x4){__uint_as_float(bw.x << 16), __uint_as_float(bw.x & 0xffff0000u), __uint_as_float(bw.y << 16), __uint_as_float(bw.y & 0xffff0000u)} + av;
                    if (l == NL - 1) *(GAS f32x4*)xr = xv;
                    else { u32x2 w; w.x = pkbf(xv.x, xv.y); w.y = pkbf(xv.z, xv.w); *(GAS u32x2*)(xbo + (size_t)t * D + s * 128 + 4 * cq) = w; }
                    float s2 = (xv.x * xv.x + xv.y * xv.y) + (xv.z * xv.z + xv.w * xv.w);
                    s2 = sum16(s2); s2 = swap16_add(s2, s2);
                    if (cq == 0) rs1p[(size_t)t * 8 + s] = s2;
                }
            }
            asm volatile("s_waitcnt lgkmcnt(0)" ::: "memory");
        }
    }
}
__device__ __forceinline__ void ph_peer_w(unsigned char* ws, int l, int gw, int NGW, int lane) {
    const GAS int* __restrict__ eidx = (const GAS int*)(ws + WS_EIDX); const GAS float* __restrict__ gate = (const GAS float*)(ws + WS_GATE); const GAS float* __restrict__ part = (const GAS float*)(ws + WS_PART);
    GAS float* __restrict__ wv = (GAS float*)(ws + WS_WV);
    const GAS float* __restrict__ usc = (const GAS float*)(ws + WS_USC) + l * 16384; const GAS float* __restrict__ vsc = (const GAS float*)(ws + WS_VSC) + l * 16384; const GAS float* __restrict__ xssq = (const GAS float*)(ws + WS_XSSQ);
    for (int t0 = gw; t0 < T; t0 += 4 * NGW) {
        float a[4][2], g[4][2], xs[4]; int e[4][2];
#pragma unroll
        for (int u = 0; u < 4; ++u) {
            const int t = t0 + u * NGW; xs[u] = xssq[(size_t)t * 16 + (lane & 15)];
#pragma unroll
            for (int hh = 0; hh < 2; ++hh) {
                const size_t q = (size_t)t * 128 + 64 * hh + lane;
                e[u][hh] = eidx[q]; g[u][hh] = gate[q];
                float acc = 0.f;
#pragma unroll
                for (int s = 0; s < 8; ++s) acc += part[(size_t)s * T * 128 + q];
                a[u][hh] = acc;
            }
        }
#pragma unroll
        for (int u = 0; u < 4; ++u) {
            const int t = t0 + u * NGW;
            const float r2 = rsqrtf(sum16(xs[u]) * (1.f / 1024.f) + EPS);
#pragma unroll
            for (int hh = 0; hh < 2; ++hh) wv[(size_t)t * 128 + 64 * hh + lane] = g[u][hh] * gelu_erf(a[u][hh] * (r2 * usc[e[u][hh]])) * vsc[e[u][hh]];
        }
    }
}

constexpr int NPH_L = 9, NPHASES = 1 + NL * NPH_L;
#ifndef MK_PHMASK
#define MK_PHMASK 0x7ff
#endif
#define PH_ON(j) ((MK_PHMASK >> (j)) & 1)
#ifndef MK_REP
#define MK_REP 0
#endif
#define PH_REP(j) ((MK_REP >> (j)) & 1)
__global__ void __launch_bounds__(NWAVES * 64, 2) mega(Args a) {
    extern __shared__ __attribute__((aligned(16))) unsigned char lds_raw[];
    {
        LAS unsigned char* lds0 = (LAS unsigned char*)lds_raw;
        for (int u = threadIdx.x; u < (LDS_BYTES - LDSCTL_OFF) / 4; u += NWAVES * 64) ((LAS unsigned*)(lds0 + LDSCTL_OFF))[u] = 0u;
        __syncthreads();
    }
    int wave0 = __builtin_amdgcn_readfirstlane((int)threadIdx.x >> 6); asm volatile("" : "+s"(wave0));
    int ph_lo = a.ph_lo, ph_hi = a.ph_hi; asm volatile("" : "+s"(ph_lo), "+s"(ph_hi));
    const bool multi = (ph_hi - ph_lo) > 1;
    XcdBarrier bar; bar.bar = (unsigned*)(a.ws + WS_CTL) + CW_BAR + a.li * XCD_BAR_WORDS; bar.x = 0; bar.st = nullptr;
    if (multi) bar = xcd_barrier_post((unsigned*)(a.ws + WS_CTL) + CW_BAR + a.li * XCD_BAR_WORDS, (volatile LAS unsigned*)((LAS unsigned char*)lds_raw + MISC_OFF) + 8);

#if defined(MK_UBENCH)
    {
        unsigned v0 = threadIdx.x * 2654435761u, v1 = v0 ^ 0x3c3c3c3cu; float f0 = 1.0f + (float)(threadIdx.x & 7), f1 = 2.0f; unsigned long long pp = v0, qq = v1;
        for (int it = 0; it < 2500; ++it) {
#pragma unroll
            for (int k = 0; k < 8; ++k) {
#if MK_UBENCH == 1
                asm volatile("v_cvt_pk_f32_fp8 %0, %1\n" : "=v"(pp) : "v"(v0));
#elif MK_UBENCH == 2
                asm volatile("v_cvt_pk_f32_fp8_sdwa %0, %1 src0_sel:WORD_1\n" : "=v"(pp) : "v"(v0));
#elif MK_UBENCH == 3
                asm volatile("v_cvt_pk_fp8_f32 %0, %1, %2\n" : "+v"(v0) : "v"(f0), "v"(f1));
#elif MK_UBENCH == 4
                asm volatile("v_fma_f32 %0, %1, %2, %0\n" : "+v"(f0) : "v"(f1), "v"(f1));
#elif MK_UBENCH == 5
                asm volatile("ds_bpermute_b32 %0, %1, %0\n s_waitcnt lgkmcnt(0)\n" : "+v"(v0) : "v"(v1));
#elif MK_UBENCH == 7
                { typedef __attribute__((ext_vector_type(8))) int i32x8b; i32x8b aa = {(int)v0, (int)v1, (int)v0, (int)v1, (int)v0, (int)v1, (int)v0, (int)v1};
                  f32x4 cc = {f0, f1, f0, f1}; cc = __builtin_amdgcn_mfma_scale_f32_16x16x128_f8f6f4(aa, aa, cc, 0, 0, 0, 0x7f7f7f7f, 0, 0x7f7f7f7f); f0 = cc[0]; f1 = cc[1]; asm volatile("" : "+v"(f0), "+v"(f1)); }
#elif MK_UBENCH == 6
                asm volatile("v_pk_fma_f32 %0, %1, %1, %0\n" : "+v"(pp) : "v"(qq));
#endif
            }
        }
        if (f0 == 1.2345e30f && v0 == 0x12345u && pp == 77ull && qq == 78ull) a.out[0] = f0;
    }
#endif
    for (int ph = ph_lo; ph < ph_hi; ++ph) {
        unsigned char* ws = a.ws; asm volatile("" : "+s"(ws));
        int G = (int)gridDim.x; asm volatile("" : "+s"(G));
        int bx = (int)blockIdx.x; asm volatile("" : "+s"(bx));
        int tid; asm volatile("v_mbcnt_lo_u32_b32 %0, -1, 0\n\tv_mbcnt_hi_u32_b32 %0, -1, %0" : "=v"(tid)); tid |= wave0 << 6;
        LAS unsigned char* lds = (LAS unsigned char*)lds_raw;
        const int lane = tid & 63, wave = __builtin_amdgcn_readfirstlane(tid >> 6);
        const int vcu = (G % 8 == 0) ? (bx % 8) * (G / 8) + bx / 8 : bx;
        const int gw = vcu * NWAVES + wave, NGW = G * NWAVES;
        if (ph == 0) {
            if (PH_ON(10)) for (int rep = 0; rep < 1 + PH_REP(10); ++rep) ph_prologue(a, ws, lds, gw, NGW, wave, lane);
        } else {
            const int l = (ph - 1) / NPH_L, j = (ph - 1) % NPH_L;
            if (j == 0 && PH_ON(0)) {
              for (int rep = 0; rep < 1 + PH_REP(0); ++rep) {
                { pg8::Gemm g{(const pg8::bf16_t*)(ws + WS_XB), (const pg8::bf16_t*)(ws + WS_WIN) + (size_t)l * NPROJ * D, T, NPROJ, D};
                  pg8::StaticOrder So; So.init(T, NPROJ, G, bx);
                  pg8::EpiInProj E{(pg8::bf16_t*)(ws + WS_PROJ), NPROJ, (const float*)(ws + WS_RS1P), (float*)(ws + WS_DTF), AIN(I_DTBIAS) + l * 6, 8};
                  pg8::gemm_phase<pg8::EpiInProj, pg8::StaticOrder, true, true>(lds, g, So, E, tid); }
                if (rep == 0) { const int nfull = ((T / 256) * (NPROJ / 256)) % G;
                    if (nfull == 0) convert_tables(a, ws, l, gw, NGW, lane); else if (bx >= nfull + 8) convert_tables(a, ws, l, (bx - nfull - 8) * NWAVES + wave, (G - nfull - 8) * NWAVES, lane); }
                { pg8::Gemm g{(const pg8::bf16_t*)(ws + WS_MEMB), (const pg8::bf16_t*)(ws + WS_WMEM) + (size_t)l * 512 * D, MROWS, 512, D};
                  pg8::StaticOrder So; So.init(MROWS, 512, G, (bx + G - (((T / 256) * (NPROJ / 256)) % G)) % G);
                  pg8::EpiInProj E{(pg8::bf16_t*)(ws + WS_MEMKV), 512, (const float*)(ws + WS_RSM), nullptr, nullptr, 0};
                  pg8::gemm_phase<pg8::EpiInProj, pg8::StaticOrder, true, true>(lds, g, So, E, tid); }
              }
            } else if (j == 1 && PH_ON(1)) {
                for (int rep = 0; rep < 1 + PH_REP(1); ++rep) { ph_mix(a, ws, lds, l, 32 * rep, tid, wave, lane); __syncthreads(); }
            } else if (j == 2 && PH_ON(2)) {
                ph_ssd_scan(ws, bx, G, tid);
            } else if (j == 3 && PH_ON(3)) {
                for (int rep = 0; rep < 1 + PH_REP(3); ++rep) for (int u = vcu; u < 256; u += G) ssd_finish_unit(a, ws, lds, l, u, tid, wave, lane);
            } else if (j == 4 && PH_ON(4)) {
                pg8::Gemm g{(const pg8::bf16_t*)(ws + WS_YCAT), (const pg8::bf16_t*)(ws + WS_WOUT) + (size_t)l * D * D, T, D, D};
                pg8::StaticOrder So; So.init(T, D, G, bx);
                LAS float* gtab = (LAS float*)(lds + GTAB_OFF);
                { pg8::Unit u0; if (So.next(0, u0) && tid < 256) { float r0, r1, r2; pg8::group_rstd((const float*)(ws + WS_YSSQ), u0.pm * 256 + tid, r0, r1, r2); gtab[tid] = r0 / r1; gtab[256 + tid] = r1 / r2; gtab[512 + tid] = r2; } }
                __syncthreads();
                pg8::EpiOut E{(pg8::bf16_t*)(ws + WS_XB), (float*)(ws + WS_XSSQ), gtab};
                pg8::gemm_phase<pg8::EpiOut, pg8::StaticOrder, true, true>(lds, g, So, E, tid);
            } else if (j == 5 && PH_ON(5)) {
                pg8::Gemm g{(const pg8::bf16_t*)(ws + WS_XB), (const pg8::bf16_t*)(ws + WS_WSC) + (size_t)l * D * D, T, D, D};
                pg8::StaticOrder So; So.init(T, D, G, bx);
                pg8::EpiInProj E{(pg8::bf16_t*)(ws + WS_YCAT), D, (const float*)(ws + WS_XSSQ), nullptr, nullptr, 16};
                for (int rep = 0; rep < 1 + PH_REP(5); ++rep) pg8::gemm_phase<pg8::EpiInProj, pg8::StaticOrder, true, true>(lds, g, So, E, tid);
                asm volatile("s_waitcnt vmcnt(0)" ::: "memory"); __syncthreads();
                if (tid == 0) __builtin_amdgcn_fence(__ATOMIC_ACQUIRE, "agent");
                asm volatile("s_waitcnt vmcnt(0)" ::: "memory"); __syncthreads();
                { pg8::Unit u0; if (So.next(0, u0)) for (int rep = 0; rep < 1 + PH_REP(6); ++rep) ph_topk(ws, lds, l, u0.pm, u0.pn, wave, lane); }
            } else if (j == 6 && PH_ON(7)) {
                ph_peer_sliced<0>(ws, lds, a.out, l, tid, wave, lane);
#if MK_REP & 0x80
                __syncthreads(); ph_peer_sliced<0, 1>(ws, lds, a.out, l, tid, wave, lane);
#endif
            } else if (j == 7 && PH_ON(8)) {
                ph_peer_w(ws, l, gw, NGW, lane);
            } else if (j == 8 && PH_ON(9)) {
#if MK_REP & 0x200
                ph_peer_sliced<1, 1>(ws, lds, a.out, l, tid, wave, lane); __syncthreads();
#endif
                ph_peer_sliced<1>(ws, lds, a.out, l, tid, wave, lane);
            }
        }
        if (ph + 1 < ph_hi) { XcdBarrier b2 = bar; { unsigned* p = b2.bar; unsigned x = b2.x; asm volatile("" : "+s"(p), "+s"(x)); b2.bar = p; b2.x = x; } xcd_barrier(b2, tid);
#if defined(MK_XBAR)
            for (int xb_ = 0; xb_ < MK_XBAR; ++xb_) xcd_barrier(b2, tid);
#endif
        }
    }
}

#ifndef MK_ONE_LAUNCH
#define MK_ONE_LAUNCH 1
#endif
extern "C" void kernel_launch(void* const* d_in, const int* in_sizes, int n_in, void* d_out, int out_size, void* d_ws, size_t ws_size, hipStream_t stream) {
    static int grid = 0;
    if (grid == 0) {
        if (n_in != 22 || out_size != T * D || ws_size < WS_END) { fprintf(stderr, "kernel_launch: unexpected problem (n_in %d out %d ws %zu)\n", n_in, out_size, ws_size); grid = -1; return; }
        int dev = 0, cus = 0, per_cu = 0;
        if (hipGetDevice(&dev) != hipSuccess || hipDeviceGetAttribute(&cus, hipDeviceAttributeMultiprocessorCount, dev) != hipSuccess) { grid = -1; return; }
        if (hipFuncSetAttribute((const void*)mega, hipFuncAttributeMaxDynamicSharedMemorySize, LDS_BYTES) != hipSuccess) { fprintf(stderr, "kernel_launch: hipFuncSetAttribute failed\n"); grid = -1; return; }
        if (hipOccupancyMaxActiveBlocksPerMultiprocessor(&per_cu, (const void*)mega, NWAVES * 64, LDS_BYTES) != hipSuccess || per_cu < 1) { fprintf(stderr, "kernel_launch: occupancy query says %d\n", per_cu); (void)hipGetLastError(); per_cu = 1; }
        if (cus != 256) { fprintf(stderr, "kernel_launch: built for a 256-CU device (one 256x256 tile per workgroup in the output-projection / query phases); this device reports %d CUs\n", cus); grid = -1; return; }
        grid = cus;
    }
    if (grid < 0) return;
    (void)hipMemsetAsync((char*)d_ws + WS_CTL, 0, CTL_ZERO_BYTES, stream);
    Args a{};
    for (int i = 0; i < 22; ++i) a.in[i] = (const float*)d_in[i];
    a.out = (float*)d_out; a.ws = (unsigned char*)d_ws;
#if MK_ONE_LAUNCH
    a.ph_lo = 0; a.ph_hi = NPHASES; a.li = 0;
    hipLaunchKernelGGL(mega, dim3(grid), dim3(NWAVES * 64), LDS_BYTES, stream, a);
#else
    for (int ph = 0; ph < NPHASES; ++ph) { a.ph_lo = ph; a.ph_hi = ph + 1; a.li = 0; hipLaunchKernelGGL(mega, dim3(grid), dim3(NWAVES * 64), LDS_BYTES, stream, a); }
#endif
}
```

```cpp
#include <hip/hip_runtime.h>
#include <cstdio>
#include <cstdint>
#include <cmath>
namespace pg8 {
#define PG8_LAS __attribute__((address_space(3)))
typedef unsigned short bf16_t;
typedef short bf16x8 __attribute__((ext_vector_type(8)));
typedef float f32x4 __attribute__((ext_vector_type(4)));
typedef unsigned u32x4 __attribute__((ext_vector_type(4)));
constexpr int BM = 256, BK = 64, HALF = 128, HTB = HALF * BK * 2  , STAGE_BYTES = 8 * HTB, NXCD = 8, WGM = 8;

__host__ __device__ __forceinline__ int lds_byte(int r, int c) { const int st = (r >> 4) * 2 + (c >> 5), rr = r & 15, cc = c & 31, ob = rr * 64 + cc * 2; return st * 1024 + (ob ^ (((ob >> 9) & 1) << 5)); }
__host__ __device__ __forceinline__ void stage_rc(int b, int& R, int& C) { const int st = b / 1024, sb = b % 1024, swz = sb ^ (((sb >> 9) & 1) << 5); R = (st >> 1) * 16 + swz / 64; C = (st & 1) * 32 + (swz % 64) / 2; }
__host__ __device__ __forceinline__ int perm32(int rho) { const int n = rho >> 4, i = rho & 15; return 8 * (i >> 2) + 4 * n + (i & 3); }

struct Unit { int pm, pn; };
struct Gemm { const bf16_t* A; const bf16_t* Bt; int M, N, K; };

struct StaticOrder {
    int nM, nN, nwg, G, c;
    __host__ __device__ void init(int M, int N, int G_, int c_) { nM = M / BM; nN = N / BM; nwg = nM * nN; G = G_; c = c_; }
    __host__ __device__ bool next(int i, Unit& u) const {
        const long L = (long)i * G + c; if (L >= nwg) return false;
        int wgid = (int)L; { const int q = nwg / NXCD, r = nwg % NXCD, xcd = wgid % NXCD, off = wgid / NXCD; wgid = (xcd < r ? xcd * (q + 1) : r * (q + 1) + (xcd - r) * q) + off; }
        const int nig = WGM * nN, gid = wgid / nig, fm = gid * WGM, gsz = (nM - fm) < WGM ? (nM - fm) : WGM;
        u.pm = fm + ((wgid % nig) % gsz); u.pn = (wgid % nig) / gsz; return true;
    }
    __device__ __forceinline__ void a_ready(const Unit&) const {}
    __device__ __forceinline__ void done(const Unit&) const {}
};

__device__ __forceinline__ unsigned cvt_pk_bf16(float lo, float hi) { unsigned r; asm volatile("v_cvt_pk_bf16_f32 %0, %1, %2" : "=v"(r) : "v"(lo), "v"(hi)); return r; }
template <class Epi, class Sched, bool ALIGN_EPI = false, bool SP2 = false>
__device__ __forceinline__ void gemm_phase(PG8_LAS unsigned char* lds, const Gemm g, const Sched& S, const Epi& E, const int tid_in) {
    int tid_ = tid_in; asm volatile("" : "+v"(tid_));
    const int tid = tid_, wid = __builtin_amdgcn_readfirstlane(tid >> 6), lane = tid & 63, wr = wid >> 2, wc = wid & 3, fr = lane & 15, fq = lane >> 4;
    const int K = g.K, nt = K / BK;
    unsigned voffA[2], voffB[2];
#pragma unroll
    for (int i = 0; i < 2; ++i) { int R, C; stage_rc(tid * 16 + i * 8192, R, C); const int Rb = Epi::PERM ? ((R & ~31) + perm32(R & 31)) : R;
        voffA[i] = (unsigned)(R * K + C) * 2u; voffB[i] = (unsigned)(Rb * K + C) * 2u; }
    const size_t kstep = (size_t)(BK * 2);
    const size_t hstep = (size_t)HALF * K * 2;
    const size_t tstep = 2 * hstep;
    const unsigned ldsw = (unsigned)wid * 1024u;
    const int aoff = lds_byte(wr * 64 + fr, fq * 8), boff = lds_byte(wc * 32 + fr, fq * 8);
#define PG8_SA(b, h) (((b) * 2 + (h)) * HTB)
#define PG8_SB(b, h) ((4 + (b) * 2 + (h)) * HTB)
#define PG8_STAGE(bufoff, gbase, voff) do { _Pragma("unroll") for (int _i = 0; _i < 2; ++_i) \
        __builtin_amdgcn_global_load_lds((const unsigned*)((const char*)(gbase) + (voff)[_i]), (PG8_LAS unsigned*)(lds + (bufoff) + ldsw + _i * 8192), 16, 0, 0); } while (0)
#define PG8_LDA(dst, b, h) do { _Pragma("unroll") for (int m = 0; m < 4; ++m) _Pragma("unroll") for (int k = 0; k < 2; ++k) dst[m][k] = *(const PG8_LAS bf16x8*)(lds + PG8_SA(b, h) + aoff + m * 2048 + k * 1024); } while (0)
#define PG8_LDB(dst, b, h) do { _Pragma("unroll") for (int n = 0; n < 2; ++n) _Pragma("unroll") for (int k = 0; k < 2; ++k) dst[n][k] = *(const PG8_LAS bf16x8*)(lds + PG8_SB(b, h) + boff + n * 2048 + k * 1024); } while (0)
#define PG8_MMA(ai, bj, At, Bt) do { __builtin_amdgcn_s_setprio(1); _Pragma("unroll") for (int m = 0; m < 4; ++m) _Pragma("unroll") for (int n = 0; n < 2; ++n) _Pragma("unroll") for (int k = 0; k < 2; ++k) \
        acc[ai][bj][m][n] = __builtin_amdgcn_mfma_f32_16x16x32_bf16(Bt[n][k], At[m][k], acc[ai][bj][m][n], 0, 0, 0); __builtin_amdgcn_s_setprio(0); } while (0)
#define PG8_WAIT_V(n) asm volatile("s_waitcnt vmcnt(" #n ")" ::: "memory")
#define PG8_WAIT_L(n) asm volatile("s_waitcnt lgkmcnt(" #n ")" ::: "memory")
#define PG8_BAR __builtin_amdgcn_s_barrier()
#define PG8_SCHED __builtin_amdgcn_sched_barrier(0)
    Unit cur, nxt; int ui = 0;
    if (!S.next(0, cur)) return;
    f32x4 acc[2][2][4][2];
#pragma unroll
    for (int a = 0; a < 2; ++a)
#pragma unroll
        for (int b = 0; b < 2; ++b)
#pragma unroll
            for (int m = 0; m < 4; ++m)
#pragma unroll
                for (int n = 0; n < 2; ++n) acc[a][b][m][n] = (f32x4){0.f, 0.f, 0.f, 0.f};
    bf16x8 At[4][2], B0[2][2], B1[2][2];
    const char* cA = (const char*)g.A + (size_t)cur.pm * tstep; const char* cB = (const char*)g.Bt + (size_t)cur.pn * tstep;
    S.a_ready(cur);
    if constexpr (SP2) {
        PG8_STAGE(PG8_SB(0, 0), cB, voffB); PG8_STAGE(PG8_SB(0, 1), cB + hstep, voffB); PG8_STAGE(PG8_SA(0, 0), cA, voffA); PG8_STAGE(PG8_SA(0, 1), cA + hstep, voffA);
        if (wr == 1) PG8_BAR;
        PG8_WAIT_V(2); PG8_BAR;
        PG8_STAGE(PG8_SB(1, 0), cB + kstep, voffB); PG8_STAGE(PG8_SA(1, 0), cA + kstep, voffA); PG8_STAGE(PG8_SB(1, 1), cB + hstep + kstep, voffB);
        PG8_WAIT_V(6); PG8_BAR;
    } else {
        PG8_STAGE(PG8_SB(0, 0), cB, voffB); PG8_STAGE(PG8_SA(0, 0), cA, voffA); PG8_STAGE(PG8_SB(0, 1), cB + hstep, voffB); PG8_STAGE(PG8_SA(0, 1), cA + hstep, voffA);
        if (wr == 1) PG8_BAR;
        PG8_WAIT_V(4); PG8_BAR;
        PG8_STAGE(PG8_SB(1, 0), cB + kstep, voffB); PG8_STAGE(PG8_SA(1, 0), cA + kstep, voffA); PG8_STAGE(PG8_SB(1, 1), cB + hstep + kstep, voffB);
        PG8_WAIT_V(6); PG8_BAR;
    }
    for (;;) {
        const bool has_next = S.next(ui + 1, nxt);
        const char* nA = has_next ? (const char*)g.A + (size_t)nxt.pm * tstep : cA; const char* nB = has_next ? (const char*)g.Bt + (size_t)nxt.pn * tstep : cB;
        for (int t = 0; t < nt; t += 2) {
            const bool last = (t == nt - 2);
            const char* a1 = cA + (size_t)(t + 1) * kstep;
            const char* a2 = last ? nA : cA + (size_t)(t + 2) * kstep; const char* b2 = last ? nB : cB + (size_t)(t + 2) * kstep;
            const char* a3 = a2 + kstep; const char* b3 = b2 + kstep;
            if (last && has_next) S.a_ready(nxt);
            if constexpr (Epi::KHOOK) E.khook(acc, cur, t, wr, fr);
            if constexpr (SP2) {
            PG8_LDB(B0, 0, 0); PG8_LDB(B1, 0, 1); PG8_SCHED; PG8_LDA(At, 0, 0); PG8_STAGE(PG8_SA(1, 1), a1 + hstep, voffA);
            PG8_WAIT_V(8); PG8_WAIT_L(0); PG8_BAR; PG8_MMA(0, 0, At, B0); PG8_MMA(0, 1, At, B1); PG8_BAR; PG8_SCHED;
            PG8_LDA(At, 0, 1); PG8_STAGE(PG8_SB(0, 0), b2, voffB); PG8_STAGE(PG8_SB(0, 1), b2 + hstep, voffB); PG8_STAGE(PG8_SA(0, 0), a2, voffA);
            PG8_WAIT_V(8); PG8_WAIT_L(0); PG8_BAR; PG8_MMA(1, 0, At, B0); PG8_MMA(1, 1, At, B1); PG8_BAR; PG8_SCHED;
            PG8_LDB(B0, 1, 0); PG8_LDB(B1, 1, 1); PG8_SCHED; PG8_LDA(At, 1, 0); PG8_STAGE(PG8_SA(0, 1), a2 + hstep, voffA);
            PG8_WAIT_V(8); PG8_WAIT_L(0); PG8_BAR; PG8_MMA(0, 0, At, B0); PG8_MMA(0, 1, At, B1); PG8_BAR; PG8_SCHED;
            PG8_LDA(At, 1, 1); PG8_STAGE(PG8_SB(1, 0), b3, voffB); PG8_STAGE(PG8_SB(1, 1), b3 + hstep, voffB); PG8_STAGE(PG8_SA(1, 0), a3, voffA);
            PG8_WAIT_V(8); PG8_WAIT_L(0); PG8_BAR; PG8_MMA(1, 0, At, B0); PG8_MMA(1, 1, At, B1); PG8_BAR; PG8_SCHED;
            } else {
            PG8_LDB(B0, 0, 0); PG8_SCHED; PG8_LDA(At, 0, 0); PG8_STAGE(PG8_SA(1, 1), a1 + hstep, voffA);
            PG8_WAIT_L(8); PG8_BAR; PG8_WAIT_L(0); PG8_MMA(0, 0, At, B0); PG8_BAR; PG8_SCHED;
            PG8_LDB(B1, 0, 1); PG8_STAGE(PG8_SB(0, 0), b2, voffB);
            PG8_BAR; PG8_WAIT_L(0); PG8_MMA(0, 1, At, B1); PG8_BAR;
            PG8_LDA(At, 0, 1); PG8_STAGE(PG8_SA(0, 0), a2, voffA);
            PG8_BAR; PG8_WAIT_L(0); PG8_MMA(1, 0, At, B0); PG8_BAR; PG8_SCHED;
            PG8_STAGE(PG8_SB(0, 1), b2 + hstep, voffB);
            PG8_WAIT_V(6); PG8_BAR; PG8_MMA(1, 1, At, B1); PG8_BAR;
            PG8_LDB(B0, 1, 0); PG8_SCHED; PG8_LDA(At, 1, 0); PG8_STAGE(PG8_SA(0, 1), a2 + hstep, voffA);
            PG8_WAIT_L(8); PG8_BAR; PG8_WAIT_L(0); PG8_MMA(0, 0, At, B0); PG8_BAR; PG8_SCHED;
            PG8_LDB(B1, 1, 1); PG8_STAGE(PG8_SB(1, 0), b3, voffB);
            PG8_BAR; PG8_WAIT_L(0); PG8_MMA(0, 1, At, B1); PG8_BAR;
            PG8_LDA(At, 1, 1); PG8_STAGE(PG8_SA(1, 0), a3, voffA);
            PG8_BAR; PG8_WAIT_L(0); PG8_MMA(1, 0, At, B0); PG8_BAR; PG8_SCHED;
            PG8_STAGE(PG8_SB(1, 1), b3 + hstep, voffB);
            PG8_WAIT_V(6); PG8_BAR; PG8_MMA(1, 1, At, B1); PG8_BAR;
            }
        }
        if constexpr (ALIGN_EPI) { if (wr == 0) PG8_BAR; }
        if constexpr (!Epi::AFTER_DRAIN) { E(acc, cur, wr, wc, fr, fq); S.done(cur); }
        if (!has_next) break;
#pragma unroll
        for (int a = 0; a < 2; ++a)
#pragma unroll
            for (int b = 0; b < 2; ++b)
#pragma unroll
                for (int m = 0; m < 4; ++m)
#pragma unroll
                    for (int n = 0; n < 2; ++n) acc[a][b][m][n] = (f32x4){0.f, 0.f, 0.f, 0.f};
        cur = nxt; cA = nA; cB = nB; ++ui;
        if constexpr (ALIGN_EPI) { if (wr == 1) PG8_BAR; }
    }
    PG8_WAIT_V(0);
    if constexpr (!ALIGN_EPI) { if (wr == 0) PG8_BAR; }
    PG8_BAR;
    if constexpr (Epi::AFTER_DRAIN) { E.fused(acc, cur, wr, wc, fr, fq, lds, wid, lane); S.done(cur); }
#undef PG8_SA
#undef PG8_SB
#undef PG8_STAGE
#undef PG8_LDA
#undef PG8_LDB
#undef PG8_MMA
#undef PG8_WAIT_V
#undef PG8_WAIT_L
#undef PG8_BAR
#undef PG8_SCHED
}
}
#define GAS __attribute__((address_space(1)))
#define LAS __attribute__((address_space(3)))
typedef unsigned short bf16;
typedef unsigned v4u __attribute__((ext_vector_type(4)));
typedef float f32x4 __attribute__((ext_vector_type(4)));
typedef short bf16x8 __attribute__((ext_vector_type(8)));
typedef GAS unsigned gu32;
typedef GAS unsigned long long gu64;
#define RLX_AGENT __ATOMIC_RELAXED, __HIP_MEMORY_SCOPE_AGENT
#define LDS_WAIT() asm volatile("s_waitcnt lgkmcnt(0)" ::: "memory")
#define VM_WAIT() asm volatile("s_waitcnt vmcnt(0)" ::: "memory")
__device__ __forceinline__ unsigned long long rt() { return __builtin_amdgcn_s_memrealtime(); }
__device__ __forceinline__ unsigned f2bf(float f) { unsigned u = __builtin_bit_cast(unsigned, f); return (u + 0x7fffu + ((u >> 16) & 1u)) >> 16; }
__device__ __forceinline__ unsigned pk2(float lo, float hi) { return f2bf(lo) | (f2bf(hi) << 16); }

#define XB_TMO      128
#define XB_XCNT(j)  (256  + 64 * (j))
#define XB_XSUB(j)  (1280 + 64 * (j))
#define XB_XGEN(j)  (2304 + 64 * (j))
#define XB_TOP      3328
#define XB_TOPGEN   3392
#define XCD_BAR_WORDS 3456
#define XB_SPIN_CAP (1u << 18)

__device__ __forceinline__ unsigned xb_ld(unsigned* p)              { return __hip_atomic_load(p, __ATOMIC_RELAXED, __HIP_MEMORY_SCOPE_AGENT); }
__device__ __forceinline__ unsigned xb_add(unsigned* p, unsigned v) { return __hip_atomic_fetch_add(p, v, __ATOMIC_RELAXED, __HIP_MEMORY_SCOPE_AGENT); }
__device__ __forceinline__ unsigned xb_xcc_id() { return (unsigned)__builtin_amdgcn_s_getreg((3 << 11) | 20) & 0xFu; }
#define XB_SPIN(cond, bar) do { unsigned _sp = 0; while (cond) { __builtin_amdgcn_s_sleep(1); \
    if ((++_sp & 255u) == 0u) { if (xb_ld(&(bar)[XB_TMO])) break; if (_sp > XB_SPIN_CAP) { atomicAdd(&(bar)[XB_TMO], 1u); break; } } } } while (0)

struct XcdBarrier {
    unsigned* bar; unsigned x;
    volatile LAS unsigned* st;
};

__device__ __forceinline__ XcdBarrier xcd_barrier_post(unsigned* bar, volatile LAS unsigned* st) {
    XcdBarrier b; b.bar = bar; b.x = xb_xcc_id(); b.st = st;
    if (threadIdx.x == 0) (void)xb_add(&bar[XB_XCNT(b.x)], 1u);
    return b;
}
__device__ __forceinline__ void xcd_barrier_complete(unsigned* bar, unsigned x, unsigned& nloc, unsigned& nx) {
    const unsigned G = gridDim.x * gridDim.y * gridDim.z;
    unsigned sum, cnt, mine, sp = 0u;
    for (;;) {
        sum = 0u; cnt = 0u; mine = 0u;
#pragma unroll
        for (unsigned j = 0; j < 16; ++j) { const unsigned c = xb_ld(&bar[XB_XCNT(j)]); sum += c; cnt += (c > 0u) ? 1u : 0u; mine = (j == x) ? c : mine; }
        if (sum == G) break;
        __builtin_amdgcn_s_sleep(1);
        if ((++sp & 255u) == 0u) { if (xb_ld(&bar[XB_TMO])) break; if (sp > XB_SPIN_CAP) { atomicAdd(&bar[XB_TMO], 1u); break; } }
    }
    nloc = mine > 0u ? mine : 1u; nx = cnt > 0u ? cnt : 1u;
}

__device__ __forceinline__ void xcd_barrier(const XcdBarrier& b, const int tid) {
    asm volatile("s_waitcnt vmcnt(0)" ::: "memory");
    __syncthreads();
    if (tid == 0) {
        unsigned* bar = b.bar;
        __builtin_amdgcn_s_waitcnt(0);
        unsigned nloc = b.st[0], nx = b.st[1];
        if (nloc == 0u) { xcd_barrier_complete(bar, b.x, nloc, nx); b.st[0] = nloc; b.st[1] = nx; }
        const unsigned old = xb_add(&bar[XB_XSUB(b.x)], 1u);
        const unsigned gen = old / nloc;
        if (old + 1u == (gen + 1u) * nloc) {
            __builtin_amdgcn_fence(__ATOMIC_RELEASE, "agent");
            asm volatile("s_waitcnt vmcnt(0)" ::: "memory");
            const unsigned og = xb_add(&bar[XB_TOP], 1u);
            const unsigned tg = og / nx;
            if (og + 1u == (tg + 1u) * nx) xb_add(&bar[XB_TOPGEN], 1u);
            else XB_SPIN(xb_ld(&bar[XB_TOPGEN]) == tg, bar);
            __builtin_amdgcn_fence(__ATOMIC_ACQUIRE, "agent");
            xb_add(&bar[XB_XGEN(b.x)], 1u);
            asm volatile("s_waitcnt vmcnt(0)" ::: "memory");
        } else {
            XB_SPIN(xb_ld(&bar[XB_XGEN(b.x)]) == gen, bar);
            __builtin_amdgcn_fence(__ATOMIC_ACQUIRE, "agent");
            asm volatile("s_waitcnt vmcnt(0)" ::: "memory");
        }
    }
    __syncthreads();
}

constexpr int NWAVES = 8;
constexpr int D = 1024, NB = 4, S = 4096, T = NB * S, NL = 2, NMEM = 256, MROWS = NB * NMEM;
constexpr int DIN = 2438, NPROJ = 2560;
constexpr int PC_Z = 0, PC_XBC = 384, PC_QSB = 1024, PC_KSB = 1408, PC_VSB = 1792, PC_QMEM = 2176, PC_DT = 2432;
constexpr int CONV_CH = 640;
constexpr float EPS = 1e-6f;

constexpr int RING_BYTES = 131072;
constexpr int WSCR = 17408;
constexpr int LDSCTL_OFF = 8 * WSCR, MISC_OFF = LDSCTL_OFF + 320;
constexpr int LDS_BYTES = 147456;
constexpr int GTAB_OFF = LDSCTL_OFF + 1024;

constexpr size_t MiB = 1u << 20;
constexpr size_t WS_CTL = 0, CTL_ZERO_BYTES = 64 * 1024;
constexpr size_t WS_WIN = 2 * MiB;
constexpr size_t WS_WMEM = 12 * MiB;
constexpr size_t WS_WOUT = 14 * MiB;
constexpr size_t WS_WSC = 18 * MiB;
constexpr size_t WS_KB = 22 * MiB;
constexpr size_t WS_MEMB = 26 * MiB;
constexpr size_t WS_RSM = 28 * MiB;
constexpr size_t WS_RS1 = WS_RSM + 64 * 1024;
constexpr size_t WS_DTF = WS_RS1 + 64 * 1024;
constexpr size_t WS_XSSQ = 29 * MiB;
constexpr size_t WS_YSSQ = 30 * MiB;
constexpr size_t WS_MEMKV = 31 * MiB;
constexpr size_t WS_RS1P = 32 * MiB;
constexpr size_t WS_PART = 178 * MiB;
constexpr size_t WS_XB = 34 * MiB;
constexpr size_t WS_YCAT = 66 * MiB;
constexpr size_t WS_PROJ = 98 * MiB;
constexpr size_t WS_SCORES = 178 * MiB;
constexpr size_t WS_YPART = WS_SCORES;
constexpr size_t WS_XCONV = WS_SCORES + 24 * MiB;
constexpr size_t WS_CMG = WS_SCORES + 36 * MiB;
constexpr size_t WS_ACSG = WS_SCORES + 40 * MiB;
constexpr size_t WS_HS = WS_SCORES + 41 * MiB;
constexpr size_t WS_CD = WS_SCORES + 53 * MiB;
constexpr size_t WS_EIDX = 306 * MiB;
constexpr size_t WS_GATE = 314 * MiB;
constexpr size_t WS_WV = 322 * MiB;
constexpr size_t WS_STOP = 330 * MiB;
constexpr size_t WS_ITOP = 338 * MiB;
constexpr size_t WS_UT = 354 * MiB;
constexpr size_t WS_USC = 386 * MiB;
constexpr size_t WS_VT = 418 * MiB;
constexpr size_t WS_VSC = 450 * MiB;
constexpr size_t WS_END = 482 * MiB;
constexpr int CW_BAR = 4096;

__device__ __forceinline__ float bf2f(bf16 v) { return __uint_as_float((unsigned)v << 16); }
__device__ __forceinline__ unsigned pkbf(float lo, float hi) { return pg8::cvt_pk_bf16(lo, hi); }
template <int CTRL> __device__ __forceinline__ float dpp_f(float v) { return __uint_as_float((unsigned)__builtin_amdgcn_update_dpp(0, (int)__float_as_uint(v), CTRL, 0xf, 0xf, true)); }
__device__ __forceinline__ float swap32_add(float a, float b) {
    const auto r = __builtin_amdgcn_permlane32_swap(__float_as_uint(a), __float_as_uint(b), false, false); return __uint_as_float(r[0]) + __uint_as_float(r[1]); }
__device__ __forceinline__ float swap16_add(float a, float b) {
    const auto r = __builtin_amdgcn_permlane16_swap(__float_as_uint(a), __float_as_uint(b), false, false); return __uint_as_float(r[0]) + __uint_as_float(r[1]); }
__device__ __forceinline__ float swap32_max(float a) { const auto r = __builtin_amdgcn_permlane32_swap(__float_as_uint(a), __float_as_uint(a), false, false); return fmaxf(__uint_as_float(r[0]), __uint_as_float(r[1])); }
__device__ __forceinline__ float swap16_max(float a) { const auto r = __builtin_amdgcn_permlane16_swap(__float_as_uint(a), __float_as_uint(a), false, false); return fmaxf(__uint_as_float(r[0]), __uint_as_float(r[1])); }
__device__ __forceinline__ float partner32(float a, bool hi) { const auto r = __builtin_amdgcn_permlane32_swap(__float_as_uint(a), __float_as_uint(a), false, false); return __uint_as_float(hi ? r[0] : r[1]); }
__device__ __forceinline__ float sum8(float v) { v += dpp_f<0xB1>(v); v += dpp_f<0x4E>(v); v += dpp_f<0x141>(v); return v; }
__device__ __forceinline__ float sum16(float v) { v = sum8(v); v += dpp_f<0x140>(v); return v; }
__device__ __forceinline__ float wave_sum(float v) { v = sum16(v); v = swap16_add(v, v); return swap32_add(v, v); }
__device__ __forceinline__ float wave_max(float v) { v = fmaxf(v, dpp_f<0xB1>(v)); v = fmaxf(v, dpp_f<0x4E>(v)); v = fmaxf(v, dpp_f<0x141>(v)); v = fmaxf(v, dpp_f<0x140>(v)); v = swap16_max(v); return swap32_max(v); }
__device__ __forceinline__ float bperm_f(float v, int src_lane) { return __uint_as_float((unsigned)__builtin_amdgcn_ds_bpermute(src_lane << 2, (int)__float_as_uint(v))); }
__device__ __forceinline__ int bperm_i(int v, int src_lane) { return __builtin_amdgcn_ds_bpermute(src_lane << 2, v); }
__device__ __forceinline__ float softplus_f(float x) { return fmaxf(x, 0.f) + log1pf(expf(-fabsf(x))); }
__device__ __forceinline__ float silu_f(float x) { return x * __builtin_amdgcn_rcpf(1.f + __builtin_amdgcn_exp2f(-1.4426950408889634f * x)); }

namespace pg8 {
struct EpiInProj {
    static constexpr bool PERM = true, AFTER_DRAIN = false, KHOOK = false;
    bf16_t* O; int ldc; const float* rs; float* dtf; const float* dtb; int npart;
    __device__ __forceinline__ void operator()(const f32x4 (&acc)[2][2][4][2], const Unit& u, int wr, int wc, int fr, int fq) const {
        const int row0 = u.pm * BM + wr * 64 + fr, col0 = u.pn * BM + wc * 32 + 8 * fq;
        const bool dtl = dtf && (u.pn * BM == PC_DT - 128) && wc == 0 && fq == 0;
#pragma unroll
        for (int ai = 0; ai < 2; ++ai)
#pragma unroll
            for (int m = 0; m < 4; ++m) {
                const int row = row0 + ai * HALF + m * 16; float s;
                if (npart == 8) { const f32x4 p0 = *(const f32x4*)(rs + (size_t)row * 8), p1 = *(const f32x4*)(rs + (size_t)row * 8 + 4); s = rsqrtf((((p0[0] + p0[1]) + (p0[2] + p0[3])) + ((p1[0] + p1[1]) + (p1[2] + p1[3]))) * (1.f / 1024.f) + EPS); }
                else if (npart == 16) { const f32x4 p0 = *(const f32x4*)(rs + (size_t)row * 16), p1 = *(const f32x4*)(rs + (size_t)row * 16 + 4), p2 = *(const f32x4*)(rs + (size_t)row * 16 + 8), p3 = *(const f32x4*)(rs + (size_t)row * 16 + 12);
                    s = rsqrtf(((((p0[0] + p0[1]) + (p0[2] + p0[3])) + ((p1[0] + p1[1]) + (p1[2] + p1[3]))) + (((p2[0] + p2[1]) + (p2[2] + p2[3])) + ((p3[0] + p3[1]) + (p3[2] + p3[3])))) * (1.f / 1024.f) + EPS); }
                else s = rs[row];
#pragma unroll
                for (int bj = 0; bj < 2; ++bj) {
                    const f32x4 v0 = acc[ai][bj][m][0] * s, v1 = acc[ai][bj][m][1] * s;
                    u32x4 w; w.x = cvt_pk_bf16(v0[0], v0[1]); w.y = cvt_pk_bf16(v0[2], v0[3]); w.z = cvt_pk_bf16(v1[0], v1[1]); w.w = cvt_pk_bf16(v1[2], v1[3]);
                    *(u32x4*)(O + (size_t)row * ldc + col0 + bj * HALF) = w;
                    if (bj == 1 && dtl) {
                        f32x4 d0; d0[0] = softplus_f(v0[0] + dtb[0]); d0[1] = softplus_f(v0[1] + dtb[1]); d0[2] = softplus_f(v0[2] + dtb[2]); d0[3] = softplus_f(v0[3] + dtb[3]);
                        f32x4 d1; d1[0] = softplus_f(v1[0] + dtb[4]); d1[1] = softplus_f(v1[1] + dtb[5]); d1[2] = 0.f; d1[3] = 0.f;
                        *(f32x4*)(dtf + (size_t)row * 8) = d0; *(f32x4*)(dtf + (size_t)row * 8 + 4) = d1;
                    }
                }
            }
    }
};
__device__ __forceinline__ void group_rstd(const float* yssq, int row, float& r_ssd, float& r_sb, float& r_mem) {
    const f32x4 a = *(const f32x4*)(yssq + (size_t)row * 16), b = *(const f32x4*)(yssq + (size_t)row * 16 + 4), c = *(const f32x4*)(yssq + (size_t)row * 16 + 8), d = *(const f32x4*)(yssq + (size_t)row * 16 + 12);
    const float s0 = (a[0] + a[1]) + (a[2] + a[3]) + (b[0] + b[1]), s1 = (b[2] + b[3]) + (c[0] + c[1]) + (c[2] + c[3]), s2 = (d[0] + d[1]) + (d[2] + d[3]);
    r_ssd = rsqrtf(s0 * (1.f / 384.f) + EPS); r_sb = rsqrtf(s1 * (1.f / 384.f) + EPS); r_mem = rsqrtf(s2 * (1.f / 256.f) + EPS);
}
struct EpiOut {
    static constexpr bool PERM = false, AFTER_DRAIN = false, KHOOK = true;
    bf16_t* xb; float* xssq; const PG8_LAS float* gtab;
    __device__ __forceinline__ void khook(f32x4 (&acc)[2][2][4][2], const Unit& u, int t, int wr, int fr) const {
        if (t != 6 && t != 12) return;
#pragma unroll
        for (int ai = 0; ai < 2; ++ai)
#pragma unroll
            for (int m = 0; m < 4; ++m) {
                const float f = gtab[(t == 6 ? 0 : 256) + ai * HALF + wr * 64 + m * 16 + fr];
#pragma unroll
                for (int bj = 0; bj < 2; ++bj)
#pragma unroll
                    for (int n = 0; n < 2; ++n) acc[ai][bj][m][n] = acc[ai][bj][m][n] * f;
            }
    }
    __device__ __forceinline__ void operator()(const f32x4 (&acc)[2][2][4][2], const Unit& u, int wr, int wc, int fr, int fq) const {
        const int col0 = u.pn * BM + wc * 32 + 4 * fq;
#pragma unroll
        for (int ai = 0; ai < 2; ++ai)
#pragma unroll
            for (int m = 0; m < 4; ++m) {
                const int row = u.pm * BM + ai * HALF + wr * 64 + m * 16 + fr; const float r2 = gtab[512 + ai * HALF + wr * 64 + m * 16 + fr];
                float q = 0.f;
#pragma unroll
                for (int bj = 0; bj < 2; ++bj)
#pragma unroll
                    for (int n = 0; n < 2; ++n) {
                        const size_t off = (size_t)row * D + col0 + bj * HALF + n * 16;
                        typedef unsigned u32x2v __attribute__((ext_vector_type(2)));
                        const u32x2v bw = *(const u32x2v*)(xb + off);
                        const f32x4 x1 = (f32x4){__uint_as_float(bw.x << 16), __uint_as_float(bw.x & 0xffff0000u), __uint_as_float(bw.y << 16), __uint_as_float(bw.y & 0xffff0000u)} + acc[ai][bj][m][n] * r2;
                        u32x2v w; w.x = cvt_pk_bf16(x1[0], x1[1]); w.y = cvt_pk_bf16(x1[2], x1[3]); *(u32x2v*)(xb + off) = w;
                        q += (x1[0] * x1[0] + x1[1] * x1[1]) + (x1[2] * x1[2] + x1[3] * x1[3]);
                    }
                q = swap16_add(q, q); q = swap32_add(q, q);
                if (fq == 0) xssq[(size_t)row * 16 + u.pn * 4 + wc] = q;
            }
    }
};
struct EpiScores {
    static constexpr bool PERM = false, AFTER_DRAIN = false, KHOOK = false;
    float* O; const float* xssq;
    __device__ __forceinline__ void operator()(const f32x4 (&acc)[2][2][4][2], const Unit& u, int wr, int wc, int fr, int fq) const {
        const int col0 = u.pn * BM + wc * 32 + 4 * fq;
#pragma unroll
        for (int ai = 0; ai < 2; ++ai)
#pragma unroll
            for (int m = 0; m < 4; ++m) {
                const int row = u.pm * BM + ai * HALF + wr * 64 + m * 16 + fr;
                const f32x4 a = *(const f32x4*)(xssq + (size_t)row * 16), b = *(const f32x4*)(xssq + (size_t)row * 16 + 4), c = *(const f32x4*)(xssq + (size_t)row * 16 + 8), d = *(const f32x4*)(xssq + (size_t)row * 16 + 12);
                const float ss = ((a[0] + a[1]) + (a[2] + a[3])) + ((b[0] + b[1]) + (b[2] + b[3])) + ((c[0] + c[1]) + (c[2] + c[3])) + ((d[0] + d[1]) + (d[2] + d[3]));
                const float r = rsqrtf(ss * (1.f / 1024.f) + EPS);
#pragma unroll
                for (int bj = 0; bj < 2; ++bj)
#pragma unroll
                    for (int n = 0; n < 2; ++n) *(f32x4*)(O + (size_t)row * 2048 + col0 + bj * HALF + n * 16) = acc[ai][bj][m][n] * r;
            }
    }
};
}

struct Args { const float* in[22]; float* out; unsigned char* ws; int ph_lo, ph_hi, li, pad; };
enum { I_X = 0, I_MEM, I_NORM1G, I_WIN, I_CONVW, I_CONVB, I_DTBIAS, I_ALOG, I_DSKIP, I_SSDG, I_SBG, I_MEMNG, I_WMEMKV, I_MQG, I_MKG, I_MEMOG, I_WOUT, I_NORM2G, I_WQ, I_KEYS, I_PU, I_PV };

__device__ __forceinline__ int opq(int i) { asm volatile("" : "+s"(i)); return i; }
#define AIN(i) (a.in[opq(i)])
__device__ __forceinline__ void transpose_item(const float* W, int ldw, int src_c0, int nvalid, const float* g, bf16* WT, int K, int dst_r0, int k0, LAS float* scr, int lane) {
    const int c = lane & 31;
#pragma unroll 8
    for (int i = 0; i < 32; ++i) {
        const int kk = 2 * i + (lane >> 5);
        float v = (c < nvalid) ? W[(size_t)(k0 + kk) * ldw + src_c0 + c] : 0.f;
        if (g) v *= g[k0 + kk];
        scr[kk * 33 + c] = v;
    }
    LDS_WAIT(); asm volatile("" ::: "memory");
    const int c8 = lane & 7;
#pragma unroll
    for (int j = 0; j < 4; ++j) {
        const int n = (lane >> 3) + 8 * j; const LAS float* s = scr + (8 * c8) * 33 + n;
        v4u o; o.x = pkbf(s[0 * 33], s[1 * 33]); o.y = pkbf(s[2 * 33], s[3 * 33]); o.z = pkbf(s[4 * 33], s[5 * 33]); o.w = pkbf(s[6 * 33], s[7 * 33]);
        *(GAS v4u*)(WT + (size_t)(dst_r0 + n) * K + k0 + 8 * c8) = o;
    }
    LDS_WAIT(); asm volatile("" ::: "memory");
}
__device__ __forceinline__ void row_to_bf16(const float* xrow, bf16* orow, float* rs, bool partials, int lane) {
    const GAS f32x4* xr = (const GAS f32x4*)xrow + lane;
    f32x4 v[4]; float s = 0.f;
#pragma unroll
    for (int j = 0; j < 4; ++j) { v[j] = xr[64 * j]; s += (v[j].x * v[j].x + v[j].y * v[j].y) + (v[j].z * v[j].z + v[j].w * v[j].w); }
    s = wave_sum(s);
    GAS unsigned long long* o8 = (GAS unsigned long long*)orow + lane;
#pragma unroll
    for (int j = 0; j < 4; ++j) o8[64 * j] = (unsigned long long)pkbf(v[j].x, v[j].y) | ((unsigned long long)pkbf(v[j].z, v[j].w) << 32);
    if (partials) { if (lane < 8) rs[lane] = lane == 0 ? s : 0.f; }
    else if (lane == 0) *rs = rsqrtf(s * (1.f / 1024.f) + EPS);
}
__device__ __forceinline__ void ph_prologue(const Args& a, unsigned char* ws, LAS unsigned char* lds, int gw, int NGW, int wave, int lane) {
    LAS float* scr = (LAS float*)(lds + wave * 16384);
    constexpr int I_IN = 80 * 16, I_MEMW = 16 * 16, I_OUT = 32 * 16, I_SC = 32 * 16 + 128, PER_L = I_IN + I_MEMW + I_OUT + I_SC;
    constexpr int NW_ITEMS = NL * PER_L, NITEMS = NW_ITEMS;
    for (int it = gw; it < NITEMS; it += NGW) {
        if (it < NW_ITEMS) {
            const int l = it / PER_L; int r = it % PER_L;
            if (r < I_IN) {
                const int j = r / 16, kb = r % 16;
                const int src = (j < 32) ? 32 * j : (j < 76 ? 32 * j + 6 : 1024), nv = (j < 76) ? 32 : (j == 76 ? 6 : 0);
                transpose_item(AIN(I_WIN) + (size_t)l * D * DIN, DIN, src, nv, AIN(I_NORM1G) + l * D, (bf16*)(ws + WS_WIN) + (size_t)l * NPROJ * D, D, 32 * j, 64 * kb, scr, lane);
                continue;
            }
            r -= I_IN;
            if (r < I_MEMW) {
                const int j = r / 16, kb = r % 16;
                transpose_item(AIN(I_WMEMKV) + (size_t)l * D * 512, 512, 32 * j, 32, AIN(I_MEMNG) + l * D, (bf16*)(ws + WS_WMEM) + (size_t)l * 512 * D, D, 32 * j, 64 * kb, scr, lane);
                continue;
            }
            r -= I_MEMW;
            if (r < I_OUT) {
                const int j = r / 16, kb = r % 16;
                const float* g = (kb < 6) ? AIN(I_SSDG) + l * 384 : (kb < 12 ? AIN(I_SBG) + l * 384 - 384 : AIN(I_MEMOG) + l * 256 - 768);
                transpose_item(AIN(I_WOUT) + (size_t)l * D * D, D, 32 * j, 32, g, (bf16*)(ws + WS_WOUT) + (size_t)l * D * D, D, 32 * j, 64 * kb, scr, lane);
                continue;
            }
            r -= I_OUT;
            if (r < 32 * 16) { const int j = r / 16, kb = r % 16;
                transpose_item(AIN(I_WQ) + (size_t)l * D * D, D, 32 * j, 32, AIN(I_NORM2G) + l * D, (bf16*)(ws + WS_WSC) + (size_t)l * D * D, D, 32 * j, 64 * kb, scr, lane); }
            else { r -= 32 * 16;
                const GAS f32x4* kr = (const GAS f32x4*)(AIN(I_KEYS) + (size_t)l * 16 * 128 * 64 + (size_t)r * 1024) + lane; GAS unsigned long long* o8 = (GAS unsigned long long*)((bf16*)(ws + WS_KB) + (size_t)l * 16 * 128 * 64 + (size_t)r * 1024) + lane;
#pragma unroll
                for (int j = 0; j < 4; ++j) { const f32x4 v = kr[64 * j]; o8[64 * j] = (unsigned long long)pkbf(v.x, v.y) | ((unsigned long long)pkbf(v.z, v.w) << 32); } }
            continue;
        }
        (void)0;
    }
    for (int r0 = gw; r0 < T + MROWS; r0 += 4 * NGW) {
        f32x4 v[4][4];
#pragma unroll
        for (int q = 0; q < 4; ++q) { const int r = r0 + q * NGW; const float* src = r < T ? AIN(I_X) + (size_t)r * D : AIN(I_MEM) + (size_t)(r - T) * D;
#pragma unroll
            for (int j = 0; j < 4; ++j) v[q][j] = (r < T + MROWS) ? *((const GAS f32x4*)src + 64 * j + lane) : (f32x4){0.f, 0.f, 0.f, 0.f}; }
#pragma unroll
        for (int q = 0; q < 4; ++q) { const int r = r0 + q * NGW; if (r >= T + MROWS) continue;
            float ss = 0.f;
#pragma unroll
            for (int j = 0; j < 4; ++j) ss += (v[q][j].x * v[q][j].x + v[q][j].y * v[q][j].y) + (v[q][j].z * v[q][j].z + v[q][j].w * v[q][j].w);
            ss = wave_sum(ss);
            GAS unsigned long long* o8 = (GAS unsigned long long*)(r < T ? (bf16*)(ws + WS_XB) + (size_t)r * D : (bf16*)(ws + WS_MEMB) + (size_t)(r - T) * D) + lane;
#pragma unroll
            for (int j = 0; j < 4; ++j) o8[64 * j] = (unsigned long long)pkbf(v[q][j].x, v[q][j].y) | ((unsigned long long)pkbf(v[q][j].z, v[q][j].w) << 32);
            if (r < T) { if (lane < 8) ((float*)(ws + WS_RS1P))[(size_t)r * 8 + lane] = lane == 0 ? ss : 0.f; }
            else if (lane == 0) ((float*)(ws + WS_RSM))[r - T] = rsqrtf(ss * (1.f / 1024.f) + EPS);
        }
    }
}


__device__ __forceinline__ void convert_tables(const Args& a, unsigned char* ws, int l, int widx, int nw, int lane) {
    for (int r0 = widx; r0 < 2 * 16384; r0 += 4 * nw) {
        f32x4 v[4][4];
#pragma unroll
        for (int q = 0; q < 4; ++q) {
            const int r = r0 + q * nw; const int tb = r >> 14, e = (r & 16383) + l * 16384;
            const float* src = (tb == 0 ? AIN(I_PU) : AIN(I_PV)) + (size_t)e * D;
#pragma unroll
            for (int j = 0; j < 4; ++j) v[q][j] = (r < 2 * 16384) ? *((const GAS f32x4*)src + 64 * j + lane) : (f32x4){0.f, 0.f, 0.f, 0.f};
        }
#pragma unroll
        for (int q = 0; q < 4; ++q) {
            const int r = r0 + q * nw; const int tb = r >> 14, e = (r & 16383) + l * 16384;
            if (r >= 2 * 16384) continue;
            unsigned* dst = (unsigned*)(ws + (tb == 0 ? WS_UT : WS_VT) + (size_t)l * 16384 * D + (size_t)(e & 16383) * 128) + (lane & 31);
            const float* g = AIN(I_NORM2G) + l * D;
            float am = 0.f;
#pragma unroll
            for (int j = 0; j < 4; ++j) { if (tb == 0) v[q][j] = v[q][j] * *((const GAS f32x4*)g + 64 * j + lane);
                am = fmaxf(fmaxf(am, fmaxf(fabsf(v[q][j].x), fabsf(v[q][j].y))), fmaxf(fabsf(v[q][j].z), fabsf(v[q][j].w))); }
            am = wave_max(am);
            const float sc = am > 0.f ? 256.f / am : 1.f;
#pragma unroll
            for (int j = 0; j < 4; ++j) { int pk = 0; pk = __builtin_amdgcn_cvt_pk_fp8_f32(v[q][j].x * sc, v[q][j].y * sc, pk, false); pk = __builtin_amdgcn_cvt_pk_fp8_f32(v[q][j].z * sc, v[q][j].w * sc, pk, true); dst[(size_t)(2 * j + (lane >> 5)) * (16384 * 128 / 4)] = (unsigned)pk; }
            if (lane == 0) ((float*)(ws + (tb == 0 ? WS_USC : WS_VSC)))[e] = am > 0.f ? am * (1.f / 256.f) : 1.f;
        }
    }
}

typedef __attribute__((ext_vector_type(8))) __bf16 bf8_t;
typedef __attribute__((ext_vector_type(8))) float f32x8;
typedef __attribute__((ext_vector_type(8))) short s16x8;
typedef __attribute__((ext_vector_type(4))) short s16x4;
typedef __attribute__((ext_vector_type(16))) float f32x16;
typedef unsigned u32x2 __attribute__((ext_vector_type(2)));
#define MFMA32(a, b, c) __builtin_amdgcn_mfma_f32_32x32x16_bf16((a), (b), (c), 0, 0, 0)
__device__ __forceinline__ int crow(int i, int h) { return (i & 3) + 8 * (i >> 2) + 4 * h; }
__device__ __forceinline__ s16x8 cvt8(const f32x8 x) { return __builtin_bit_cast(s16x8, __builtin_convertvector(x, bf8_t)); }
__device__ __forceinline__ s16x8 pack_acc(const f32x16& x, int s) { f32x8 v;
#pragma unroll
    for (int j = 0; j < 8; ++j) v[j] = x[8 * s + j];
    return cvt8(v); }
__device__ __forceinline__ s16x8 cat4(const s16x4 lo, const s16x4 hi) { return __builtin_shufflevector(lo, hi, 0, 1, 2, 3, 4, 5, 6, 7); }
__device__ __forceinline__ f32x16 zero16() { f32x16 z;
#pragma unroll
    for (int i = 0; i < 16; ++i) z[i] = 0.f;
    return z; }
constexpr int L_BM = 0, L_CM = 18432, L_BMT = 36864, L_XDT = 54272, L_ACS = 106496, L_DT = 108032, L_TOT = 109568;

__device__ __forceinline__ void ssd_chunk_unit(const Args& a, unsigned char* ws, LAS unsigned char* lds, int l_, int unit, int tid, int wave, int lane) {
    const int g = unit & 1, c = (unit >> 1) & 31, b = unit >> 6, t0 = b * S + c * 128;
    const bf16* proj = (const bf16*)(ws + WS_PROJ); const float* dtf = (const float*)(ws + WS_DTF);
    LAS float* acs = (LAS float*)(lds + L_ACS); LAS float* dts = (LAS float*)(lds + L_DT); LAS float* tot = (LAS float*)(lds + L_TOT);
    float cs = 0.f, dtv = 0.f;
    if (wave < 6) {
        const int hh = wave >> 1, l = (wave & 1) * 64 + lane;
        dtv = dtf[(size_t)(t0 + l) * 8 + 3 * g + hh];
        cs = dtv * -expf(AIN(I_ALOG)[l_ * 6 + 3 * g + hh]);
#pragma unroll
        for (int o = 1; o < 64; o <<= 1) { const float t = bperm_f(cs, lane - o); if (lane >= o) cs += t; }
        if (lane == 63) tot[wave] = cs;
    }
    __syncthreads();
    if (wave < 6) {
        const int hh = wave >> 1, l = (wave & 1) * 64 + lane;
        if (wave & 1) cs += tot[wave - 1];
        acs[hh * 128 + l] = cs; dts[hh * 128 + l] = dtv;
        ((float*)(ws + WS_ACSG))[(size_t)(t0 + l) * 8 + 3 * g + hh] = cs;
    }
    __syncthreads();
    const float* cw = AIN(I_CONVW) + l_ * 4 * CONV_CH; const float* cb = AIN(I_CONVB) + l_ * CONV_CH;
#pragma unroll 2
    for (int it = 0; it < 10; ++it) {
        const int idx = tid + 512 * it, l = idx / 40, ck = idx % 40;
        int cc, kind, hh = 0, e0;
        if (ck < 24) { hh = ck >> 3; e0 = (ck & 7) * 8; cc = (3 * g + hh) * 64 + e0; kind = 0; }
        else if (ck < 32) { e0 = (ck - 24) * 8; cc = 384 + g * 64 + e0; kind = 1; }
        else { e0 = (ck - 32) * 8; cc = 512 + g * 64 + e0; kind = 2; }
        float acc[8];
        { const f32x4 b0 = *(const f32x4*)(cb + cc), b1 = *(const f32x4*)(cb + cc + 4); acc[0] = b0.x; acc[1] = b0.y; acc[2] = b0.z; acc[3] = b0.w; acc[4] = b1.x; acc[5] = b1.y; acc[6] = b1.z; acc[7] = b1.w; }
#pragma unroll
        for (int k = 0; k < 4; ++k) {
            const int sl = c * 128 + l - 3 + k;
            if (sl >= 0) {
                const v4u xv = *(const GAS v4u*)(proj + (size_t)(t0 + l - 3 + k) * NPROJ + PC_XBC + cc);
                const f32x4 w0 = *(const f32x4*)(cw + k * CONV_CH + cc), w1 = *(const f32x4*)(cw + k * CONV_CH + cc + 4);
                acc[0] += w0.x * __uint_as_float(xv.x << 16); acc[1] += w0.y * __uint_as_float(xv.x & 0xffff0000u);
                acc[2] += w0.z * __uint_as_float(xv.y << 16); acc[3] += w0.w * __uint_as_float(xv.y & 0xffff0000u);
                acc[4] += w1.x * __uint_as_float(xv.z << 16); acc[5] += w1.y * __uint_as_float(xv.z & 0xffff0000u);
                acc[6] += w1.z * __uint_as_float(xv.w << 16); acc[7] += w1.w * __uint_as_float(xv.w & 0xffff0000u);
            }
        }
#pragma unroll
        for (int e = 0; e < 8; ++e) acc[e] = silu_f(acc[e]);
        v4u pk; pk.x = pkbf(acc[0], acc[1]); pk.y = pkbf(acc[2], acc[3]); pk.z = pkbf(acc[4], acc[5]); pk.w = pkbf(acc[6], acc[7]);
        if (kind == 0) {
            *(GAS v4u*)((bf16*)(ws + WS_XCONV) + (size_t)(t0 + l) * 384 + (3 * g + hh) * 64 + e0) = pk;
            const float d = dts[hh * 128 + l];
            LAS bf16* xd = (LAS bf16*)(lds + L_XDT) + (hh * 64 + e0) * 136 + l;
#pragma unroll
            for (int e = 0; e < 8; e += 2) { const unsigned w = pkbf(acc[e] * d, acc[e + 1] * d); xd[e * 136] = (bf16)(w & 0xffffu); xd[(e + 1) * 136] = (bf16)(w >> 16); }
        } else if (kind == 1) {
            *(LAS v4u*)(lds + L_BM + (l * 72 + e0) * 2) = pk;
            LAS bf16* bt = (LAS bf16*)(lds + L_BMT) + e0 * 136 + l;
            bt[0 * 136] = (bf16)(pk.x & 0xffffu); bt[1 * 136] = (bf16)(pk.x >> 16); bt[2 * 136] = (bf16)(pk.y & 0xffffu); bt[3 * 136] = (bf16)(pk.y >> 16);
            bt[4 * 136] = (bf16)(pk.z & 0xffffu); bt[5 * 136] = (bf16)(pk.z >> 16); bt[6 * 136] = (bf16)(pk.w & 0xffffu); bt[7 * 136] = (bf16)(pk.w >> 16);
        } else {
            *(LAS v4u*)(lds + L_CM + (l * 72 + e0) * 2) = pk;
            *(GAS v4u*)((bf16*)(ws + WS_CMG) + (size_t)(t0 + l) * 128 + g * 64 + e0) = pk;
        }
    }
    __syncthreads();
    const int r = lane & 31, h = lane >> 5, lb = wave & 3, pt = wave >> 2;
    {
        s16x8 cf[4];
#pragma unroll
        for (int ks = 0; ks < 4; ++ks) cf[ks] = *(const LAS s16x8*)(lds + L_CM + ((lb * 32 + r) * 72 + ks * 16 + 8 * h) * 2);
        f32x16 gt[4];
#pragma unroll
        for (int sb = 0; sb < 4; ++sb) {
            gt[sb] = zero16();
            if (sb <= lb) {
#pragma unroll
                for (int ks = 0; ks < 4; ++ks) gt[sb] = MFMA32(*(const LAS s16x8*)(lds + L_BM + ((sb * 32 + r) * 72 + ks * 16 + 8 * h) * 2), cf[ks], gt[sb]);
            }
        }
#pragma unroll
        for (int hh = 0; hh < 3; ++hh) {
            const float al = acs[hh * 128 + lb * 32 + r];
            f32x16 yacc = zero16();
#pragma unroll
            for (int sb = 0; sb < 4; ++sb) {
                if (sb <= lb) {
                    f32x16 m;
#pragma unroll
                    for (int i = 0; i < 16; ++i) {
                        const int sl = crow(i, h);
                        const float v = gt[sb][i] * __expf(al - acs[hh * 128 + sb * 32 + sl]);
                        m[i] = (sb < lb || sl <= r) ? v : 0.f;
                    }
#pragma unroll
                    for (int ks = 0; ks < 2; ++ks) {
                        const LAS unsigned char* xp = lds + L_XDT + ((hh * 64 + pt * 32 + r) * 136 + sb * 32 + 16 * ks + 4 * h) * 2;
                        yacc = MFMA32(cat4(*(const LAS s16x4*)xp, *(const LAS s16x4*)(xp + 16)), pack_acc(m, ks), yacc);
                    }
                }
            }
            float* yp = (float*)(ws + WS_YPART) + (size_t)(t0 + lb * 32 + r) * 384 + (3 * g + hh) * 64 + pt * 32 + 4 * h;
#pragma unroll
            for (int i4 = 0; i4 < 4; ++i4) *(f32x4*)(yp + 8 * i4) = (f32x4){yacc[4 * i4], yacc[4 * i4 + 1], yacc[4 * i4 + 2], yacc[4 * i4 + 3]};
        }
    }
    for (int tl = wave; tl < 12; tl += 8) {
        const int hh = tl >> 2, nt = (tl >> 1) & 1, pt2 = tl & 1;
        const float alast = acs[hh * 128 + 127];
        f32x16 acc = zero16();
#pragma unroll
        for (int ks = 0; ks < 8; ++ks) {
            const s16x8 af = *(const LAS s16x8*)(lds + L_BMT + ((nt * 32 + r) * 136 + ks * 16 + 8 * h) * 2);
            const v4u xr = *(const LAS v4u*)(lds + L_XDT + ((hh * 64 + pt2 * 32 + r) * 136 + ks * 16 + 8 * h) * 2);
            const LAS float* ap = acs + hh * 128 + ks * 16 + 8 * h;
            f32x8 xf;
            xf[0] = __uint_as_float(xr.x << 16) * __expf(alast - ap[0]); xf[1] = __uint_as_float(xr.x & 0xffff0000u) * __expf(alast - ap[1]);
            xf[2] = __uint_as_float(xr.y << 16) * __expf(alast - ap[2]); xf[3] = __uint_as_float(xr.y & 0xffff0000u) * __expf(alast - ap[3]);
            xf[4] = __uint_as_float(xr.z << 16) * __expf(alast - ap[4]); xf[5] = __uint_as_float(xr.z & 0xffff0000u) * __expf(alast - ap[5]);
            xf[6] = __uint_as_float(xr.w << 16) * __expf(alast - ap[6]); xf[7] = __uint_as_float(xr.w & 0xffff0000u) * __expf(alast - ap[7]);
            acc = MFMA32(af, cvt8(xf), acc);
        }
        float* hp = (float*)(ws + WS_HS) + ((size_t)((b * 32 + c) * 6 + 3 * g + hh) * 64 + pt2 * 32 + r) * 64 + nt * 32 + 4 * h;
#pragma unroll
        for (int i4 = 0; i4 < 4; ++i4) *(f32x4*)(hp + 8 * i4) = (f32x4){acc[4 * i4], acc[4 * i4 + 1], acc[4 * i4 + 2], acc[4 * i4 + 3]};
    }
    if (tid < 3) ((float*)(ws + WS_CD))[(b * 32 + c) * 6 + 3 * g + tid] = __expf(acs[tid * 128 + 127]);
    __syncthreads();
}
__device__ __forceinline__ void ph_ssd_scan(unsigned char* ws, int bx, int G, int tid) {
    float* hs = (float*)(ws + WS_HS); const float* cd = (const float*)(ws + WS_CD);
    for (int e = bx * 512 + tid; e < 24 * 4096; e += G * 512) {
        const int bh = e >> 12, el = e & 4095, b = bh / 6, hh = bh % 6;
        float run = 0.f;
#pragma unroll 4
        for (int c = 0; c < 32; ++c) {
            const int idx = (b * 32 + c) * 6 + hh;
            const float v = hs[(size_t)idx * 4096 + el], d = cd[idx];
            hs[(size_t)idx * 4096 + el] = run; run = run * d + v;
        }
    }
}
__device__ __forceinline__ void ssd_finish_unit(const Args& a, unsigned char* ws, LAS unsigned char* lds, int l_, int unit, int tid, int wave, int lane) {
    const int g = unit & 1, c = (unit >> 1) & 31, b = unit >> 6, t0 = b * S + c * 128;
    const int r = lane & 31, h = lane >> 5;
    const bf16* proj = (const bf16*)(ws + WS_PROJ);
    LAS float* sq = (LAS float*)lds;
    for (int item = wave; item < 24; item += NWAVES) {
        const int pt = item & 1, hh = (item >> 1) % 3, lb = item / 6, hd = 3 * g + hh;
        const int t = t0 + lb * 32 + r;
        const bf16* cmg = (const bf16*)(ws + WS_CMG) + (size_t)t * 128 + g * 64;
        const float* hin = (const float*)(ws + WS_HS) + (size_t)((b * 32 + c) * 6 + hd) * 4096;
        s16x8 cf[4]; f32x4 h0[4], h1[4];
#pragma unroll
        for (int ks = 0; ks < 4; ++ks) { cf[ks] = *(const GAS s16x8*)(cmg + ks * 16 + 8 * h); const float* hp = hin + (pt * 32 + r) * 64 + ks * 16 + 8 * h; h0[ks] = *(const GAS f32x4*)hp; h1[ks] = *(const GAS f32x4*)(hp + 4); }
        const float ea = __expf(((const float*)(ws + WS_ACSG))[(size_t)t * 8 + hd]), dsk = AIN(I_DSKIP)[l_ * 6 + hd];
        f32x4 yp[4]; u32x2 xc[4], zz[4];
#pragma unroll
        for (int i4 = 0; i4 < 4; ++i4) {
            const int col = hd * 64 + pt * 32 + 8 * i4 + 4 * h;
            yp[i4] = *(const GAS f32x4*)((const float*)(ws + WS_YPART) + (size_t)t * 384 + col);
            xc[i4] = *(const GAS u32x2*)((const bf16*)(ws + WS_XCONV) + (size_t)t * 384 + col);
            zz[i4] = *(const GAS u32x2*)(proj + (size_t)t * NPROJ + PC_Z + col);
        }
        f32x16 acc = zero16();
#pragma unroll
        for (int ks = 0; ks < 4; ++ks) acc = MFMA32(cvt8((f32x8){h0[ks].x, h0[ks].y, h0[ks].z, h0[ks].w, h1[ks].x, h1[ks].y, h1[ks].z, h1[ks].w}), cf[ks], acc);
        float ssq = 0.f;
#pragma unroll
        for (int i4 = 0; i4 < 4; ++i4) {
            const int col = hd * 64 + pt * 32 + 8 * i4 + 4 * h;
            const float y0 = (yp[i4].x + acc[4 * i4 + 0] * ea + dsk * __uint_as_float(xc[i4].x << 16)) * silu_f(__uint_as_float(zz[i4].x << 16));
            const float y1 = (yp[i4].y + acc[4 * i4 + 1] * ea + dsk * __uint_as_float(xc[i4].x & 0xffff0000u)) * silu_f(__uint_as_float(zz[i4].x & 0xffff0000u));
            const float y2 = (yp[i4].z + acc[4 * i4 + 2] * ea + dsk * __uint_as_float(xc[i4].y << 16)) * silu_f(__uint_as_float(zz[i4].y << 16));
            const float y3 = (yp[i4].w + acc[4 * i4 + 3] * ea + dsk * __uint_as_float(xc[i4].y & 0xffff0000u)) * silu_f(__uint_as_float(zz[i4].y & 0xffff0000u));
            ssq += (y0 * y0 + y1 * y1) + (y2 * y2 + y3 * y3);
            u32x2 w; w.x = pkbf(y0, y1); w.y = pkbf(y2, y3);
            *(GAS u32x2*)((bf16*)(ws + WS_YCAT) + (size_t)t * D + col) = w;
        }
        ssq = swap32_add(ssq, ssq);
        if (h == 0) sq[((lb * 32 + r) * 3 + hh) * 2 + pt] = ssq;
    }
    __syncthreads();
    if (tid < 384) { const int tk = tid & 127, hh = tid >> 7; ((float*)(ws + WS_YSSQ))[(size_t)(t0 + tk) * 16 + 3 * g + hh] = sq[(tk * 3 + hh) * 2] + sq[(tk * 3 + hh) * 2 + 1]; }
    __syncthreads();
}

#define LOG2E 1.4426950408889634f
__device__ __forceinline__ s16x8 trv_frag(const LAS unsigned char* vimg, int key0, int ks, int dt, int lane) {
    const int h = lane >> 5, i16 = lane & 15, blk = (lane >> 4) & 1;
    const LAS unsigned char* p = vimg + (key0 + 16 * ks + 4 * h + (i16 >> 2)) * 144 + (dt * 32 + 16 * blk) * 2 + 8 * (i16 & 3);
    const s16x4 lo = __builtin_amdgcn_ds_read_tr16_b64_v4i16((LAS s16x4*)p), hi = __builtin_amdgcn_ds_read_tr16_b64_v4i16((LAS s16x4*)(p + 8 * 144));
    return cat4(lo, hi);
}
__device__ __forceinline__ void mem_unit(const Args& a, unsigned char* ws, LAS unsigned char* lds, int l_, int b, int hd, int qb, int tid, int wave, int lane) {
    const bf16* proj = (const bf16*)(ws + WS_PROJ); const bf16* memkv = (const bf16*)(ws + WS_MEMKV);
    const float* qg = AIN(I_MQG) + l_ * 64; const float* kg = AIN(I_MKG) + l_ * 64;
    LAS unsigned char* kimg = lds; LAS unsigned char* vimg = lds + 36864;
#pragma unroll
    for (int it = 0; it < 4; ++it) {
        const int idx = tid + 512 * it, m = idx >> 3, ch = idx & 7;
        const v4u kv = *(const GAS v4u*)(memkv + (size_t)(b * NMEM + m) * 512 + hd * 64 + ch * 8);
        const v4u vv = *(const GAS v4u*)(memkv + (size_t)(b * NMEM + m) * 512 + 256 + hd * 64 + ch * 8);
        float kf[8] = {__uint_as_float(kv.x << 16), __uint_as_float(kv.x & 0xffff0000u), __uint_as_float(kv.y << 16), __uint_as_float(kv.y & 0xffff0000u),
                       __uint_as_float(kv.z << 16), __uint_as_float(kv.z & 0xffff0000u), __uint_as_float(kv.w << 16), __uint_as_float(kv.w & 0xffff0000u)};
        float ss = 0.f;
#pragma unroll
        for (int e = 0; e < 8; ++e) ss += kf[e] * kf[e];
        ss = sum8(ss);
        const float rk = rsqrtf(ss * (1.f / 64.f) + EPS);
        const f32x4 g0 = *(const f32x4*)(kg + ch * 8), g1 = *(const f32x4*)(kg + ch * 8 + 4);
        v4u pk; pk.x = pkbf(kf[0] * rk * g0.x, kf[1] * rk * g0.y); pk.y = pkbf(kf[2] * rk * g0.z, kf[3] * rk * g0.w); pk.z = pkbf(kf[4] * rk * g1.x, kf[5] * rk * g1.y); pk.w = pkbf(kf[6] * rk * g1.z, kf[7] * rk * g1.w);
        *(LAS v4u*)(kimg + (m * 72 + ch * 8) * 2) = pk;
        *(LAS v4u*)(vimg + (m * 72 + ch * 8) * 2) = vv;
    }
    __syncthreads();
    const int r = lane & 31, h = lane >> 5;
    const int t = b * S + qb * 256 + wave * 32 + r;
    s16x8 qf[4];
    {
        f32x8 qv[4]; float ss = 0.f;
#pragma unroll
        for (int ks = 0; ks < 4; ++ks) {
            const v4u q = *(const GAS v4u*)(proj + (size_t)t * NPROJ + PC_QMEM + hd * 64 + ks * 16 + 8 * h);
            qv[ks] = (f32x8){__uint_as_float(q.x << 16), __uint_as_float(q.x & 0xffff0000u), __uint_as_float(q.y << 16), __uint_as_float(q.y & 0xffff0000u),
                             __uint_as_float(q.z << 16), __uint_as_float(q.z & 0xffff0000u), __uint_as_float(q.w << 16), __uint_as_float(q.w & 0xffff0000u)};
#pragma unroll
            for (int e = 0; e < 8; ++e) ss += qv[ks][e] * qv[ks][e];
        }
        ss = swap32_add(ss, ss);
        const float rq = rsqrtf(ss * (1.f / 64.f) + EPS) * (0.125f * LOG2E);
#pragma unroll
        for (int ks = 0; ks < 4; ++ks) {
            const f32x4 g0 = *(const f32x4*)(qg + ks * 16 + 8 * h), g1 = *(const f32x4*)(qg + ks * 16 + 8 * h + 4);
            qf[ks] = cvt8(qv[ks] * rq * (f32x8){g0.x, g0.y, g0.z, g0.w, g1.x, g1.y, g1.z, g1.w});
        }
    }
    f32x16 st[8];
    float mx = -INFINITY;
#pragma unroll
    for (int kt = 0; kt < 8; ++kt) {
        st[kt] = zero16();
#pragma unroll
        for (int ks = 0; ks < 4; ++ks) st[kt] = MFMA32(*(const LAS s16x8*)(kimg + ((kt * 32 + r) * 72 + ks * 16 + 8 * h) * 2), qf[ks], st[kt]);
#pragma unroll
        for (int i = 0; i < 16; ++i) mx = fmaxf(mx, st[kt][i]);
    }
    mx = swap32_max(mx);
    float lsum = 0.f;
    f32x16 o0 = zero16(), o1 = zero16();
#pragma unroll
    for (int kt = 0; kt < 8; ++kt) {
#pragma unroll
        for (int i = 0; i < 16; ++i) { st[kt][i] = __builtin_amdgcn_exp2f(st[kt][i] - mx); lsum += st[kt][i]; }
#pragma unroll
        for (int ks = 0; ks < 2; ++ks) {
            const s16x8 pf = pack_acc(st[kt], ks);
            o0 = MFMA32(trv_frag(vimg, kt * 32, ks, 0, lane), pf, o0);
            o1 = MFMA32(trv_frag(vimg, kt * 32, ks, 1, lane), pf, o1);
        }
    }
    lsum = swap32_add(lsum, lsum);
    const float il = 1.f / lsum; float ssq = 0.f;
    bf16* yc = (bf16*)(ws + WS_YCAT) + (size_t)t * D + 768 + hd * 64 + 4 * h;
#pragma unroll
    for (int i4 = 0; i4 < 4; ++i4) {
        const float a0 = o0[4 * i4] * il, a1 = o0[4 * i4 + 1] * il, a2 = o0[4 * i4 + 2] * il, a3 = o0[4 * i4 + 3] * il;
        const float b0 = o1[4 * i4] * il, b1 = o1[4 * i4 + 1] * il, b2 = o1[4 * i4 + 2] * il, b3 = o1[4 * i4 + 3] * il;
        ssq += (a0 * a0 + a1 * a1) + (a2 * a2 + a3 * a3) + (b0 * b0 + b1 * b1) + (b2 * b2 + b3 * b3);
        u32x2 w; w.x = pkbf(a0, a1); w.y = pkbf(a2, a3); *(GAS u32x2*)(yc + 8 * i4) = w;
        w.x = pkbf(b0, b1); w.y = pkbf(b2, b3); *(GAS u32x2*)(yc + 32 + 8 * i4) = w;
    }
    ssq = swap32_add(ssq, ssq);
    if (h == 0) ((float*)(ws + WS_YSSQ))[(size_t)t * 16 + 12 + hd] = ssq;
    __syncthreads();
}
__device__ __forceinline__ void sb_unit(unsigned char* ws, LAS unsigned char* lds, int b, int hd, int qb, int tid, int wave, int lane) {
    const bf16* proj = (const bf16*)(ws + WS_PROJ);
    const int r = lane & 31, h = lane >> 5;
    const int q0w = qb * 256 + wave * 32, t = b * S + q0w + r;
    s16x8 qf[4];
#pragma unroll
    for (int ks = 0; ks < 4; ++ks) {
        const v4u q = *(const GAS v4u*)(proj + (size_t)t * NPROJ + PC_QSB + hd * 64 + ks * 16 + 8 * h);
        const f32x8 qv = (f32x8){__uint_as_float(q.x << 16), __uint_as_float(q.x & 0xffff0000u), __uint_as_float(q.y << 16), __uint_as_float(q.y & 0xffff0000u),
                                 __uint_as_float(q.z << 16), __uint_as_float(q.z & 0xffff0000u), __uint_as_float(q.w << 16), __uint_as_float(q.w & 0xffff0000u)};
        qf[ks] = cvt8(qv * (0.125f * LOG2E));
    }
    const int srow = tid >> 3, sch = tid & 7;
    const bf16* kbase = proj + (size_t)(b * S) * NPROJ + PC_KSB + hd * 64 + sch * 8;
    const int ktop = qb * 4 + 3;
    v4u kr = *(const GAS v4u*)(kbase + (size_t)(ktop * 64 + srow) * NPROJ), vr = *(const GAS v4u*)(kbase + (size_t)(ktop * 64 + srow) * NPROJ + (PC_VSB - PC_KSB));
    *(LAS v4u*)(lds + (srow * 72 + sch * 8) * 2) = kr; *(LAS v4u*)(lds + 9216 + (srow * 72 + sch * 8) * 2) = vr;
    __syncthreads();
    f32x16 o0 = zero16(), o1 = zero16();
    float R = 0.f;
    volatile LAS unsigned* live = (volatile LAS unsigned*)(lds + 36864);
    bool mylive = true;
    for (int kt = ktop; kt >= 0; --kt) {
        LAS unsigned char* kimg = lds + ((ktop - kt) & 1) * 18432; LAS unsigned char* vimg = kimg + 9216;
        if (kt > 0) { kr = *(const GAS v4u*)(kbase + (size_t)((kt - 1) * 64 + srow) * NPROJ); vr = *(const GAS v4u*)(kbase + (size_t)((kt - 1) * 64 + srow) * NPROJ + (PC_VSB - PC_KSB)); }
#pragma unroll
        for (int sub = 1; sub >= 0; --sub) {
            const int kb = kt * 64 + sub * 32;
            if (kb <= q0w && mylive) {
                const bool diag = (kb == q0w);
                f32x16 z = zero16();
#pragma unroll
                for (int ks = 0; ks < 4; ++ks) z = MFMA32(*(const LAS s16x8*)(kimg + ((sub * 32 + r) * 72 + ks * 16 + 8 * h) * 2), qf[ks], z);
                float lk[16];
#pragma unroll
                for (int i = 0; i < 16; ++i) {
                    const float sp = fmaxf(z[i], 0.f) + __builtin_amdgcn_logf(1.f + __builtin_amdgcn_exp2f(-fabsf(z[i])));
                    const bool ok = !diag || (crow(i, h) < r);
                    lk[i] = ok ? -sp : 0.f;
                    z[i] = ok ? z[i] : -INFINITY;
                }
                float g[4], pg[4];
#pragma unroll
                for (int j = 0; j < 4; ++j) { g[j] = (lk[4 * j] + lk[4 * j + 1]) + (lk[4 * j + 2] + lk[4 * j + 3]); pg[j] = partner32(g[j], h != 0); }
                float ab[4];
                ab[3] = R + (h == 0 ? pg[3] : 0.f);
#pragma unroll
                for (int j = 2; j >= 0; --j) ab[j] = ab[j + 1] + g[j + 1] + (h == 0 ? pg[j] : pg[j + 1]);
#pragma unroll
                for (int j = 0; j < 4; ++j) {
                    const float s3 = ab[j], s2 = s3 + lk[4 * j + 3], s1 = s2 + lk[4 * j + 2], s0 = s1 + lk[4 * j + 1];
                    z[4 * j + 3] = __builtin_amdgcn_exp2f(z[4 * j + 3] + lk[4 * j + 3] + s3);
                    z[4 * j + 2] = __builtin_amdgcn_exp2f(z[4 * j + 2] + lk[4 * j + 2] + s2);
                    z[4 * j + 1] = __builtin_amdgcn_exp2f(z[4 * j + 1] + lk[4 * j + 1] + s1);
                    z[4 * j + 0] = __builtin_amdgcn_exp2f(z[4 * j + 0] + lk[4 * j + 0] + s0);
                }
                R = ab[0] + g[0] + (h == 0 ? 0.f : pg[0]);
#pragma unroll
                for (int ks = 0; ks < 2; ++ks) {
                    const s16x8 pf = pack_acc(z, ks);
                    o0 = MFMA32(trv_frag(vimg, sub * 32, ks, 0, lane), pf, o0);
                    o1 = MFMA32(trv_frag(vimg, sub * 32, ks, 1, lane), pf, o1);
                }
            }
        }
        if (kt > 0) { LAS unsigned char* nimg = lds + ((ktop - kt + 1) & 1) * 18432; *(LAS v4u*)(nimg + (srow * 72 + sch * 8) * 2) = kr; *(LAS v4u*)(nimg + 9216 + (srow * 72 + sch * 8) * 2) = vr; }
        mylive = mylive && (__builtin_amdgcn_ballot_w64(R >= -150.f) != 0ull);
        if (lane == 0) live[((ktop - kt) & 1) * 8 + wave] = mylive ? 1u : 0u;
        __syncthreads();
        { unsigned any = 0u;
#pragma unroll
          for (int w = 0; w < 8; ++w) any |= live[((ktop - kt) & 1) * 8 + w];
          if (any == 0u) break; }
    }
    float ssq = 0.f;
    bf16* yc = (bf16*)(ws + WS_YCAT) + (size_t)t * D + 384 + hd * 64 + 4 * h;
#pragma unroll
    for (int i4 = 0; i4 < 4; ++i4) {
        const float a0 = o0[4 * i4], a1 = o0[4 * i4 + 1], a2 = o0[4 * i4 + 2], a3 = o0[4 * i4 + 3];
        const float b0 = o1[4 * i4], b1 = o1[4 * i4 + 1], b2 = o1[4 * i4 + 2], b3 = o1[4 * i4 + 3];
        ssq += (a0 * a0 + a1 * a1) + (a2 * a2 + a3 * a3) + (b0 * b0 + b1 * b1) + (b2 * b2 + b3 * b3);
        u32x2 w; w.x = pkbf(a0, a1); w.y = pkbf(a2, a3); *(GAS u32x2*)(yc + 8 * i4) = w;
        w.x = pkbf(b0, b1); w.y = pkbf(b2, b3); *(GAS u32x2*)(yc + 32 + 8 * i4) = w;
    }
    ssq = swap32_add(ssq, ssq);
    if (h == 0) ((float*)(ws + WS_YSSQ))[(size_t)t * 16 + 6 + hd] = ssq;
}
constexpr int CW_Q = 8192;
__device__ __forceinline__ void ph_mix(const Args& a, unsigned char* ws, LAS unsigned char* lds, int l, int tid, int wave, int lane) {
    unsigned* head = (unsigned*)(ws + WS_CTL) + CW_Q + 64 * l;
    volatile LAS unsigned* slot = (volatile LAS unsigned*)(lds + MISC_OFF);
    for (int it = 0;; ++it) {
        if (tid == 0) slot[it & 1] = __hip_atomic_fetch_add(head, 1u, __ATOMIC_RELAXED, __HIP_MEMORY_SCOPE_AGENT);
        __syncthreads();
        const int n = (int)slot[it & 1];
        if (n >= 896) break;
        asm volatile("" : "+s"(ws), "+v"(tid));
        lane = tid & 63; wave = __builtin_amdgcn_readfirstlane(tid >> 6);
        if (n < 256) ssd_chunk_unit(a, ws, lds, l, n, tid, wave, lane);
        else if (n < 640) { const int m = n - 256; const int qb = 15 - m / 24, bh = m % 24; sb_unit(ws, lds, bh / 6, bh % 6, qb, tid, wave, lane); }
        else { const int m = n - 640; mem_unit(a, ws, lds, l, m >> 6, (m >> 4) & 3, m & 15, tid, wave, lane); }
    }
}

__device__ __forceinline__ unsigned f2o(float f) { const unsigned b = __float_as_uint(f); return b ^ ((unsigned)((int)b >> 31) | 0x80000000u); }
__device__ __forceinline__ float o2f(unsigned k) { return __uint_as_float(k ^ ((k & 0x80000000u) ? 0x80000000u : 0xffffffffu)); }
#define TK_CE(a, b) do { const unsigned _mx = (a) > (b) ? (a) : (b), _mn = (a) > (b) ? (b) : (a); (a) = _mx; (b) = _mn; } while (0)
template <int N, int BASE> __device__ __forceinline__ void tk_sort16(unsigned (&k)[N]) {
#pragma unroll
    for (int sz = 2; sz <= 16; sz <<= 1)
#pragma unroll
        for (int j = sz >> 1; j > 0; j >>= 1)
#pragma unroll
            for (int i = 0; i < 16; ++i) { const int l = i ^ j; if (l > i) { if ((i & sz) == 0) TK_CE(k[BASE + i], k[BASE + l]); else TK_CE(k[BASE + l], k[BASE + i]); } }
}
template <int NA, int A, int NB_, int B> __device__ __forceinline__ void tk_merge16(unsigned (&ka)[NA], const unsigned (&kb)[NB_]) {
#pragma unroll
    for (int i = 0; i < 16; ++i) ka[A + i] = ka[A + i] > kb[B + 15 - i] ? ka[A + i] : kb[B + 15 - i];
#pragma unroll
    for (int j = 8; j > 0; j >>= 1)
#pragma unroll
        for (int i = 0; i < 16; ++i) { const int l = i ^ j; if (l > i) TK_CE(ka[A + i], ka[A + l]); }
}
__device__ __forceinline__ unsigned partner32_u(unsigned a, bool hi) { const auto r = __builtin_amdgcn_permlane32_swap(a, a, false, false); return hi ? r[0] : r[1]; }
__device__ __forceinline__ void ph_topk(unsigned char* ws, LAS unsigned char* lds, int l, int pm, int pn, int wave, int lane) {
    const bf16* qb = (const bf16*)(ws + WS_YCAT); const bf16* kb = (const bf16*)(ws + WS_KB) + (size_t)l * 16 * 128 * 64;
    int* eidx = (int*)(ws + WS_EIDX); float* gate = (float*)(ws + WS_GATE);
    LAS float* tr = (LAS float*)(lds + wave * WSCR);
    const int r = lane & 31, h = lane >> 5;
    for (int item = wave; item < 16; item += NWAVES) {
        const int hd = 2 * pn + (item & 1), t = pm * 256 + (item >> 1) * 32 + r;
        unsigned top[2][16];
#pragma unroll
        for (int c = 0; c < 2; ++c) {
            const int hc = 2 * hd + c;
            s16x8 qf[4];
#pragma unroll
            for (int ks = 0; ks < 4; ++ks) qf[ks] = *(const GAS s16x8*)(qb + (size_t)t * D + hc * 64 + ks * 16 + 8 * h);
            unsigned k[64];
#pragma unroll
            for (int nt = 0; nt < 4; ++nt) {
                f32x16 acc = zero16();
#pragma unroll
                for (int ks = 0; ks < 4; ++ks) acc = MFMA32(*(const GAS s16x8*)(kb + (size_t)(hc * 128 + nt * 32 + r) * 64 + ks * 16 + 8 * h), qf[ks], acc);
#pragma unroll
                for (int i = 0; i < 16; ++i) k[16 * nt + i] = (f2o(acc[i]) & ~127u) | (unsigned)((127 - 32 * nt - 8 * (i >> 2) - (i & 3)) - 4 * h);
            }
            tk_sort16<64, 0>(k); tk_sort16<64, 16>(k); tk_sort16<64, 32>(k); tk_sort16<64, 48>(k);
            tk_merge16<64, 0, 64, 16>(k, k); tk_merge16<64, 32, 64, 48>(k, k); tk_merge16<64, 0, 64, 32>(k, k);
            unsigned pk[16];
#pragma unroll
            for (int i = 0; i < 16; ++i) { top[c][i] = k[i]; pk[i] = partner32_u(k[i], h != 0); }
            tk_merge16<16, 0, 16, 0>(top[c], pk);
        }
        const int b = 0; (void)b;
        float av[16], bv[16];
#pragma unroll
        for (int i = 0; i < 16; ++i) { av[i] = o2f(top[0][i] & ~127u); bv[i] = o2f(top[1][i] & ~127u); }
        LAS int* li = (LAS int*)tr + lane * 32;
#pragma unroll
        for (int i = 0; i < 16; ++i) { li[i] = 127 - (int)(top[0][i] & 127u); li[16 + i] = 127 - (int)(top[1][i] & 127u); }
        unsigned key[64];
        key[0] = (f2o(av[0] + bv[0]) & ~255u) | 255u;
        key[1] = (f2o(av[0] + bv[1]) & ~255u) | 254u;
        key[2] = (f2o(av[0] + bv[2]) & ~255u) | 253u;
        key[3] = (f2o(av[0] + bv[3]) & ~255u) | 252u;
        key[4] = (f2o(av[0] + bv[4]) & ~255u) | 251u;
        key[5] = (f2o(av[0] + bv[5]) & ~255u) | 250u;
        key[6] = (f2o(av[0] + bv[6]) & ~255u) | 249u;
        key[7] = (f2o(av[0] + bv[7]) & ~255u) | 248u;
        key[8] = (f2o(av[0] + bv[8]) & ~255u) | 247u;
        key[9] = (f2o(av[0] + bv[9]) & ~255u) | 246u;
        key[10] = (f2o(av[0] + bv[10]) & ~255u) | 245u;
        key[11] = (f2o(av[0] + bv[11]) & ~255u) | 244u;
        key[12] = (f2o(av[0] + bv[12]) & ~255u) | 243u;
        key[13] = (f2o(av[0] + bv[13]) & ~255u) | 242u;
        key[14] = (f2o(av[0] + bv[14]) & ~255u) | 241u;
        key[15] = (f2o(av[0] + bv[15]) & ~255u) | 240u;
        key[16] = (f2o(av[1] + bv[0]) & ~255u) | 239u;
        key[17] = (f2o(av[1] + bv[1]) & ~255u) | 238u;
        key[18] = (f2o(av[1] + bv[2]) & ~255u) | 237u;
        key[19] = (f2o(av[1] + bv[3]) & ~255u) | 236u;
        key[20] = (f2o(av[1] + bv[4]) & ~255u) | 235u;
        key[21] = (f2o(av[1] + bv[5]) & ~255u) | 234u;
        key[22] = (f2o(av[1] + bv[6]) & ~255u) | 233u;
        key[23] = (f2o(av[1] + bv[7]) & ~255u) | 232u;
        key[24] = (f2o(av[2] + bv[0]) & ~255u) | 223u;
        key[25] = (f2o(av[2] + bv[1]) & ~255u) | 222u;
        key[26] = (f2o(av[2] + bv[2]) & ~255u) | 221u;
        key[27] = (f2o(av[2] + bv[3]) & ~255u) | 220u;
        key[28] = (f2o(av[2] + bv[4]) & ~255u) | 219u;
        key[29] = (f2o(av[3] + bv[0]) & ~255u) | 207u;
        key[30] = (f2o(av[3] + bv[1]) & ~255u) | 206u;
        key[31] = (f2o(av[3] + bv[2]) & ~255u) | 205u;
        key[32] = (f2o(av[3] + bv[3]) & ~255u) | 204u;
        key[33] = (f2o(av[4] + bv[0]) & ~255u) | 191u;
        key[34] = (f2o(av[4] + bv[1]) & ~255u) | 190u;
        key[35] = (f2o(av[4] + bv[2]) & ~255u) | 189u;
        key[36] = (f2o(av[5] + bv[0]) & ~255u) | 175u;
        key[37] = (f2o(av[5] + bv[1]) & ~255u) | 174u;
        key[38] = (f2o(av[6] + bv[0]) & ~255u) | 159u;
        key[39] = (f2o(av[6] + bv[1]) & ~255u) | 158u;
        key[40] = (f2o(av[7] + bv[0]) & ~255u) | 143u;
        key[41] = (f2o(av[7] + bv[1]) & ~255u) | 142u;
        key[42] = (f2o(av[8] + bv[0]) & ~255u) | 127u;
        key[43] = (f2o(av[9] + bv[0]) & ~255u) | 111u;
        key[44] = (f2o(av[10] + bv[0]) & ~255u) | 95u;
        key[45] = (f2o(av[11] + bv[0]) & ~255u) | 79u;
        key[46] = (f2o(av[12] + bv[0]) & ~255u) | 63u;
        key[47] = (f2o(av[13] + bv[0]) & ~255u) | 47u;
        key[48] = (f2o(av[14] + bv[0]) & ~255u) | 31u;
        key[49] = (f2o(av[15] + bv[0]) & ~255u) | 15u;
#pragma unroll
        for (int i = 50; i < 64; ++i) key[i] = 0u;
        tk_sort16<64, 0>(key); tk_sort16<64, 16>(key); tk_sort16<64, 32>(key); tk_sort16<64, 48>(key);
        tk_merge16<64, 0, 64, 16>(key, key); tk_merge16<64, 32, 64, 48>(key, key); tk_merge16<64, 0, 64, 32>(key, key);
        asm volatile("s_waitcnt lgkmcnt(0)" ::: "memory");
        const float s0 = o2f(key[0] & ~255u);
        float ev[16]; int ei[16]; float den = 0.f;
#pragma unroll
        for (int w = 0; w < 16; ++w) {
            const unsigned ij = 255u - (key[w] & 255u);
            ev[w] = __expf(o2f(key[w] & ~255u) - s0); den += ev[w];
            ei[w] = li[ij >> 4] * 128 + li[16 + (ij & 15)];
        }
        const float inv = 1.f / den;
        const size_t ob = ((size_t)t * 8 + hd) * 16;
        if (h == 0) {
#pragma unroll
            for (int q = 0; q < 4; ++q) {
                typedef int i32x4 __attribute__((ext_vector_type(4)));
                *(GAS i32x4*)(eidx + ob + 4 * q) = (i32x4){ei[4 * q], ei[4 * q + 1], ei[4 * q + 2], ei[4 * q + 3]};
                *(GAS f32x4*)(gate + ob + 4 * q) = (f32x4){ev[4 * q] * inv, ev[4 * q + 1] * inv, ev[4 * q + 2] * inv, ev[4 * q + 3] * inv};
            }
        }
        asm volatile("s_waitcnt lgkmcnt(0)" ::: "memory");
    }
}

__device__ __forceinline__ float gelu_erf(float v) { return 0.5f * v * (1.f + erff(v * 0.70710678118654752f)); }
typedef __attribute__((ext_vector_type(2))) float f32x2v;
constexpr int CW_Q2 = 12288;
__device__ __forceinline__ void cvt16(const v4u r, float (&f)[16]) {
    const unsigned w[4] = {r.x, r.y, r.z, r.w};
#pragma unroll
    for (int i = 0; i < 4; ++i) { const f32x2v lo = __builtin_amdgcn_cvt_pk_f32_fp8((int)w[i], false), hi = __builtin_amdgcn_cvt_pk_f32_fp8((int)w[i], true); f[4 * i] = lo.x; f[4 * i + 1] = lo.y; f[4 * i + 2] = hi.x; f[4 * i + 3] = hi.y; }
}
constexpr int PCH = 256, PTW = PCH / 8;
typedef __attribute__((ext_vector_type(4))) int i32x4;
struct PIdx { i32x4 e[4]; };
struct PTok { v4u r[16]; f32x4 w[4]; v4u xa, xc; };
__device__ __forceinline__ void peer_idx(PIdx& I, const GAS int* eidx, int t, int lane) {
    const GAS i32x4* ep = (const GAS i32x4*)(eidx + (size_t)t * 128 + 16 * (lane >> 3));
#pragma unroll
    for (int q = 0; q < 4; ++q) I.e[q] = ep[q];
}
template <int PHASE> __device__ __forceinline__ void peer_rows(PTok& K, const PIdx& I, const GAS unsigned char* tab, const GAS float* wgt, const GAS bf16* xb, int t, int s, int lane) {
    const int g = lane >> 3, j = lane & 7;
#pragma unroll
    for (int i = 0; i < 16; ++i) K.r[i] = *(const GAS v4u*)(tab + (size_t)(unsigned)I.e[i >> 2][i & 3] * 128 + 16 * j);
    if (PHASE == 0) { const GAS unsigned char* xrow = (const GAS unsigned char*)(xb + (size_t)t * D + s * 128 + 16 * j); K.xa = *(const GAS v4u*)xrow; K.xc = *(const GAS v4u*)(xrow + 16); }
    else { const GAS f32x4* wp = (const GAS f32x4*)(wgt + (size_t)t * 128 + 16 * g);
#pragma unroll
        for (int q = 0; q < 4; ++q) K.w[q] = wp[q]; }
}
__device__ __forceinline__ void cvt16p(const v4u r, f32x2v (&f)[8]) {
    const unsigned w[4] = {r.x, r.y, r.z, r.w};
#pragma unroll
    for (int i = 0; i < 4; ++i) { f[2 * i] = __builtin_amdgcn_cvt_pk_f32_fp8((int)w[i], false); f[2 * i + 1] = __builtin_amdgcn_cvt_pk_f32_fp8((int)w[i], true); }
}
__device__ __forceinline__ void peer_u_compute(const PTok& K, LAS float* lpart, int lane) {
    const int g = lane >> 3, j = lane & 7;
    f32x2v xv[8];
    { const unsigned xw[8] = {K.xa.x, K.xa.y, K.xa.z, K.xa.w, K.xc.x, K.xc.y, K.xc.z, K.xc.w};
#pragma unroll
      for (int i = 0; i < 8; ++i) xv[i] = (f32x2v){__uint_as_float(xw[i] << 16), __uint_as_float(xw[i] & 0xffff0000u)}; }
    float res_lo = 0.f, res_hi = 0.f;
#pragma unroll
    for (int i = 0; i < 16; ++i) {
        f32x2v f[8]; cvt16p(K.r[i], f);
        f32x2v a0 = xv[0] * f[0], a1 = xv[1] * f[1];
#pragma unroll
        for (int k = 2; k < 8; k += 2) { a0 = a0 + xv[k] * f[k]; a1 = a1 + xv[k + 1] * f[k + 1]; }
        const f32x2v a = a0 + a1;
        const float d = sum8(a.x + a.y);
        if (i < 8) res_lo = (j == i) ? d : res_lo; else res_hi = (j == i - 8) ? d : res_hi;
    }
    lpart[16 * g + j] = res_lo; lpart[16 * g + 8 + j] = res_hi;
}
__device__ __forceinline__ void peer_v_compute(const PTok& K, LAS float* lout, int lane) {
    const int g = lane >> 3, j = lane & 7;
    f32x2v acc[8];
#pragma unroll
    for (int k = 0; k < 8; ++k) acc[k] = (f32x2v){0.f, 0.f};
#pragma unroll
    for (int i = 0; i < 16; ++i) {
        f32x2v f[8]; cvt16p(K.r[i], f);
        const float wi = K.w[i >> 2][i & 3]; const f32x2v w2 = {wi, wi};
#pragma unroll
        for (int k = 0; k < 8; ++k) acc[k] = acc[k] + w2 * f[k];
    }
    float o[16];
#pragma unroll
    for (int k = 0; k < 8; ++k) {
        float a = acc[k].x, b = acc[k].y;
        a += dpp_f<0x128>(a); b += dpp_f<0x128>(b); a = swap16_add(a, a); b = swap16_add(b, b); o[2 * k] = swap32_add(a, a); o[2 * k + 1] = swap32_add(b, b);
    }
    if (g == 0) {
#pragma unroll
        for (int q = 0; q < 4; ++q) *(LAS f32x4*)(lout + 16 * j + 4 * q) = (f32x4){o[4 * q], o[4 * q + 1], o[4 * q + 2], o[4 * q + 3]};
    }
}
template <int PHASE> __device__ __forceinline__ void ph_peer_sliced(unsigned char* ws, LAS unsigned char* lds, float* xout, int l, int tid, int wave, int lane) {
    unsigned* heads = (unsigned*)(ws + WS_CTL) + CW_Q2 + (l * 2 + PHASE) * 8 * 64;
    volatile LAS unsigned* slot = (volatile LAS unsigned*)(lds + MISC_OFF);
    const GAS int* eidx = (const GAS int*)(ws + WS_EIDX); const GAS float* wgt = (const GAS float*)(ws + WS_WV); GAS bf16* xb = (GAS bf16*)(ws + WS_XB);
    const int myx = (int)(xb_xcc_id() & 7u);
    if (tid == 0) slot[2] = 0xffu;
    int it = 0;
    unsigned avail = 0xffu;
    for (int k = 0; k < 8; ++k) {
        if (k == 1) {
            if (tid < 8) { const unsigned hv = __hip_atomic_load(heads + 64 * ((myx + tid) & 7), __ATOMIC_RELAXED, __HIP_MEMORY_SCOPE_AGENT); if (hv >= (unsigned)(T / PCH)) __hip_atomic_fetch_and((LAS unsigned*)(lds + MISC_OFF) + 2, ~(1u << tid), __ATOMIC_RELAXED, __HIP_MEMORY_SCOPE_WORKGROUP); }
            __syncthreads(); avail = slot[2]; __syncthreads();
        }
        if (!((avail >> k) & 1u)) continue;
        const int s = (myx + k) & 7;
        const GAS unsigned char* tab = (const GAS unsigned char*)(ws + (PHASE == 0 ? WS_UT : WS_VT) + (size_t)l * 16384 * D + (size_t)s * 16384 * 128);
        GAS float* part = (GAS float*)(ws + WS_PART) + (size_t)s * T * 128;
        for (;; ++it) {
            if (tid == 0) slot[it & 1] = __hip_atomic_fetch_add(heads + 64 * s, 1u, __ATOMIC_RELAXED, __HIP_MEMORY_SCOPE_AGENT);
            __syncthreads();
            const int c = (int)slot[it & 1];
            if (c >= T / PCH) { ++it; break; }
            const int t0 = c * PCH + wave * PTW;
            LAS float* stg = (LAS float*)(lds + wave * WSCR);
            PIdx iB, iC; PTok A, B;
            peer_idx(iB, eidx, t0, lane);
            peer_rows<PHASE>(A, iB, tab, wgt, xb, t0, s, lane);
            peer_idx(iB, eidx, t0 + 1, lane);
#pragma unroll 2
            for (int i = 0; i < PTW; ++i) {
                peer_idx(iC, eidx, t0 + (i + 2 < PTW ? i + 2 : PTW - 1), lane);
                peer_rows<PHASE>(B, iB, tab, wgt, xb, t0 + (i + 1 < PTW ? i + 1 : PTW - 1), s, lane);
                if (PHASE == 0) peer_u_compute(A, stg + i * 128, lane); else peer_v_compute(A, stg + i * 128, lane);
                A = B; iB = iC;
            }
            asm volatile("s_waitcnt lgkmcnt(0)" ::: "memory");
            if (PHASE == 0) {
#pragma unroll
                for (int q = 0; q < PTW * 128 / 256; ++q) *(GAS f32x4*)(part + (size_t)t0 * 128 + q * 256 + lane * 4) = *(const LAS f32x4*)(stg + q * 256 + lane * 4);
            } else {
                GAS float* xo = (GAS float*)xout; GAS float* rs1p = (GAS float*)(ws + WS_RS1P); GAS bf16* xbo = xb;
                constexpr int FB = 8;
#pragma unroll 1
                for (int q0 = 0; q0 < PTW / 2; q0 += FB) {
                    u32x2 bw[FB];
#pragma unroll
                    for (int q = 0; q < FB; ++q) { const int tk = 2 * (q0 + q) + (lane >> 5), cq = lane & 31; bw[q] = *(const GAS u32x2*)(xb + (size_t)(t0 + tk) * D + s * 128 + 4 * cq); }
#pragma unroll
                    for (int q = 0; q < FB; ++q) {
                        const int tk = 2 * (q0 + q) + (lane >> 5), cq = lane & 31, t = t0 + tk;
                        const f32x4 av = *(const LAS f32x4*)(stg + tk * 128 + 4 * cq);
                        const f32x4 xv = (f32x4){__uint_as_float(bw[q].x << 16), __uint_as_float(bw[q].x & 0xffff0000u), __uint_as_float(bw[q].y << 16), __uint_as_float(bw[q].y & 0xffff0000u)} + av;
                        if (l == NL - 1) *(GAS f32x4*)(xo + (size_t)t * D + s * 128 + 4 * cq) = xv;
                        else { u32x2 w; w.x = pkbf(xv.x, xv.y); w.y = pkbf(xv.z, xv.w); *(GAS u32x2*)(xbo + (size_t)t * D + s * 128 + 4 * cq) = w; }
                        float s2 = (xv.x * xv.x + xv.y * xv.y) + (xv.z * xv.z + xv.w * xv.w);
                        s2 = sum16(s2); s2 = swap16_add(s2, s2);
                        if (cq == 0) rs1p[(size_t)t * 8 + s] = s2;
                    }
                }
            }
            asm volatile("s_waitcnt lgkmcnt(0)" ::: "memory");
        }
    }
}
__device__ __forceinline__ void ph_peer_w(unsigned char* ws, int l, int gw, int NGW, int lane) {
    const GAS int* __restrict__ eidx = (const GAS int*)(ws + WS_EIDX); const GAS float* __restrict__ gate = (const GAS float*)(ws + WS_GATE); const GAS float* __restrict__ part = (const GAS float*)(ws + WS_PART);
    GAS float* __restrict__ wv = (GAS float*)(ws + WS_WV);
    const GAS float* __restrict__ usc = (const GAS float*)(ws + WS_USC) + l * 16384; const GAS float* __restrict__ vsc = (const GAS float*)(ws + WS_VSC) + l * 16384; const GAS float* __restrict__ xssq = (const GAS float*)(ws + WS_XSSQ);
    for (int t0 = gw; t0 < T; t0 += 4 * NGW) {
        float a[4][2], g[4][2], xs[4]; int e[4][2];
#pragma unroll
        for (int u = 0; u < 4; ++u) {
            const int t = t0 + u * NGW; xs[u] = xssq[(size_t)t * 16 + (lane & 15)];
#pragma unroll
            for (int hh = 0; hh < 2; ++hh) {
                const size_t q = (size_t)t * 128 + 64 * hh + lane;
                e[u][hh] = eidx[q]; g[u][hh] = gate[q];
                float acc = 0.f;
#pragma unroll
                for (int s = 0; s < 8; ++s) acc += part[(size_t)s * T * 128 + q];
                a[u][hh] = acc;
            }
        }
#pragma unroll
        for (int u = 0; u < 4; ++u) {
            const int t = t0 + u * NGW;
            const float r2 = rsqrtf(sum16(xs[u]) * (1.f / 1024.f) + EPS);
#pragma unroll
            for (int hh = 0; hh < 2; ++hh) wv[(size_t)t * 128 + 64 * hh + lane] = g[u][hh] * gelu_erf(a[u][hh] * (r2 * usc[e[u][hh]])) * vsc[e[u][hh]];
        }
    }
}

constexpr int NPH_L = 9, NPHASES = 1 + NL * NPH_L;
__global__ void __launch_bounds__(NWAVES * 64, 2) mega(Args a) {
    extern __shared__ __attribute__((aligned(16))) unsigned char lds_raw[];
    {
        LAS unsigned char* lds0 = (LAS unsigned char*)lds_raw;
        for (int u = threadIdx.x; u < (LDS_BYTES - LDSCTL_OFF) / 4; u += NWAVES * 64) ((LAS unsigned*)(lds0 + LDSCTL_OFF))[u] = 0u;
        __syncthreads();
    }
    int wave0 = __builtin_amdgcn_readfirstlane((int)threadIdx.x >> 6); asm volatile("" : "+s"(wave0));
    int ph_lo = a.ph_lo, ph_hi = a.ph_hi; asm volatile("" : "+s"(ph_lo), "+s"(ph_hi));
    const bool multi = (ph_hi - ph_lo) > 1;
    XcdBarrier bar; bar.bar = (unsigned*)(a.ws + WS_CTL) + CW_BAR + a.li * XCD_BAR_WORDS; bar.x = 0; bar.st = nullptr;
    if (multi) bar = xcd_barrier_post((unsigned*)(a.ws + WS_CTL) + CW_BAR + a.li * XCD_BAR_WORDS, (volatile LAS unsigned*)((LAS unsigned char*)lds_raw + MISC_OFF) + 8);

    for (int ph = ph_lo; ph < ph_hi; ++ph) {
        unsigned char* ws = a.ws; asm volatile("" : "+s"(ws));
        int G = (int)gridDim.x; asm volatile("" : "+s"(G));
        int bx = (int)blockIdx.x; asm volatile("" : "+s"(bx));
        int tid; asm volatile("v_mbcnt_lo_u32_b32 %0, -1, 0\n\tv_mbcnt_hi_u32_b32 %0, -1, %0" : "=v"(tid)); tid |= wave0 << 6;
        LAS unsigned char* lds = (LAS unsigned char*)lds_raw;
        const int lane = tid & 63, wave = __builtin_amdgcn_readfirstlane(tid >> 6);
        const int vcu = (G % 8 == 0) ? (bx % 8) * (G / 8) + bx / 8 : bx;
        const int gw = vcu * NWAVES + wave, NGW = G * NWAVES;
        if (ph == 0) {
            ph_prologue(a, ws, lds, gw, NGW, wave, lane);
        } else {
            const int l = (ph - 1) / NPH_L, j = (ph - 1) % NPH_L;
            if (j == 0) {
              {
                { pg8::Gemm g{(const pg8::bf16_t*)(ws + WS_XB), (const pg8::bf16_t*)(ws + WS_WIN) + (size_t)l * NPROJ * D, T, NPROJ, D};
                  pg8::StaticOrder So; So.init(T, NPROJ, G, bx);
                  pg8::EpiInProj E{(pg8::bf16_t*)(ws + WS_PROJ), NPROJ, (const float*)(ws + WS_RS1P), (float*)(ws + WS_DTF), AIN(I_DTBIAS) + l * 6, 8};
                  pg8::gemm_phase<pg8::EpiInProj, pg8::StaticOrder, true, true>(lds, g, So, E, tid); }
                { const int nfull = ((T / 256) * (NPROJ / 256)) % G;
                    if (nfull == 0) convert_tables(a, ws, l, gw, NGW, lane); else if (bx >= nfull + 8) convert_tables(a, ws, l, (bx - nfull - 8) * NWAVES + wave, (G - nfull - 8) * NWAVES, lane); }
                { pg8::Gemm g{(const pg8::bf16_t*)(ws + WS_MEMB), (const pg8::bf16_t*)(ws + WS_WMEM) + (size_t)l * 512 * D, MROWS, 512, D};
                  pg8::StaticOrder So; So.init(MROWS, 512, G, (bx + G - (((T / 256) * (NPROJ / 256)) % G)) % G);
                  pg8::EpiInProj E{(pg8::bf16_t*)(ws + WS_MEMKV), 512, (const float*)(ws + WS_RSM), nullptr, nullptr, 0};
                  pg8::gemm_phase<pg8::EpiInProj, pg8::StaticOrder, true, true>(lds, g, So, E, tid); }
              }
            } else if (j == 1) {
                ph_mix(a, ws, lds, l, tid, wave, lane);
            } else if (j == 2) {
                ph_ssd_scan(ws, bx, G, tid);
            } else if (j == 3) {
                for (int u = vcu; u < 256; u += G) ssd_finish_unit(a, ws, lds, l, u, tid, wave, lane);
            } else if (j == 4) {
                pg8::Gemm g{(const pg8::bf16_t*)(ws + WS_YCAT), (const pg8::bf16_t*)(ws + WS_WOUT) + (size_t)l * D * D, T, D, D};
                pg8::StaticOrder So; So.init(T, D, G, bx);
                LAS float* gtab = (LAS float*)(lds + GTAB_OFF);
                { pg8::Unit u0; if (So.next(0, u0) && tid < 256) { float r0, r1, r2; pg8::group_rstd((const float*)(ws + WS_YSSQ), u0.pm * 256 + tid, r0, r1, r2); gtab[tid] = r0 / r1; gtab[256 + tid] = r1 / r2; gtab[512 + tid] = r2; } }
                __syncthreads();
                pg8::EpiOut E{(pg8::bf16_t*)(ws + WS_XB), (float*)(ws + WS_XSSQ), gtab};
                pg8::gemm_phase<pg8::EpiOut, pg8::StaticOrder, true, true>(lds, g, So, E, tid);
            } else if (j == 5) {
                pg8::Gemm g{(const pg8::bf16_t*)(ws + WS_XB), (const pg8::bf16_t*)(ws + WS_WSC) + (size_t)l * D * D, T, D, D};
                pg8::StaticOrder So; So.init(T, D, G, bx);
                pg8::EpiInProj E{(pg8::bf16_t*)(ws + WS_YCAT), D, (const float*)(ws + WS_XSSQ), nullptr, nullptr, 16};
                pg8::gemm_phase<pg8::EpiInProj, pg8::StaticOrder, true, true>(lds, g, So, E, tid);
                asm volatile("s_waitcnt vmcnt(0)" ::: "memory"); __syncthreads();
                if (tid == 0) __builtin_amdgcn_fence(__ATOMIC_ACQUIRE, "agent");
                asm volatile("s_waitcnt vmcnt(0)" ::: "memory"); __syncthreads();
                { pg8::Unit u0; if (So.next(0, u0)) ph_topk(ws, lds, l, u0.pm, u0.pn, wave, lane); }
            } else if (j == 6) {
                ph_peer_sliced<0>(ws, lds, a.out, l, tid, wave, lane);
            } else if (j == 7) {
                ph_peer_w(ws, l, gw, NGW, lane);
            } else if (j == 8) {
                ph_peer_sliced<1>(ws, lds, a.out, l, tid, wave, lane);
            }
        }
        if (ph + 1 < ph_hi) { XcdBarrier b2 = bar; { unsigned* p = b2.bar; unsigned x = b2.x; asm volatile("" : "+s"(p), "+s"(x)); b2.bar = p; b2.x = x; } xcd_barrier(b2, tid);
        }
    }
}

#ifndef MK_ONE_LAUNCH
#define MK_ONE_LAUNCH 1
#endif
extern "C" void kernel_launch(void* const* d_in, const int* in_sizes, int n_in, void* d_out, int out_size, void* d_ws, size_t ws_size, hipStream_t stream) {
    static int grid = 0;
    if (grid == 0) {
        if (n_in != 22 || out_size != T * D || ws_size < WS_END) { fprintf(stderr, "kernel_launch: unexpected problem (n_in %d out %d ws %zu)\n", n_in, out_size, ws_size); grid = -1; return; }
        int dev = 0, cus = 0, per_cu = 0;
        if (hipGetDevice(&dev) != hipSuccess || hipDeviceGetAttribute(&cus, hipDeviceAttributeMultiprocessorCount, dev) != hipSuccess) { grid = -1; return; }
        if (hipFuncSetAttribute((const void*)mega, hipFuncAttributeMaxDynamicSharedMemorySize, LDS_BYTES) != hipSuccess) { fprintf(stderr, "kernel_launch: hipFuncSetAttribute failed\n"); grid = -1; return; }
        if (hipOccupancyMaxActiveBlocksPerMultiprocessor(&per_cu, (const void*)mega, NWAVES * 64, LDS_BYTES) != hipSuccess || per_cu < 1) { fprintf(stderr, "kernel_launch: occupancy query says %d\n", per_cu); (void)hipGetLastError(); per_cu = 1; }
        if (cus != 256) { fprintf(stderr, "kernel_launch: built for a 256-CU device (one 256x256 tile per workgroup in the output-projection / query phases); this device reports %d CUs\n", cus); grid = -1; return; }
        grid = cus;
    }
    if (grid < 0) return;
    (void)hipMemsetAsync((char*)d_ws + WS_CTL, 0, CTL_ZERO_BYTES, stream);
    Args a{};
    for (int i = 0; i < 22; ++i) a.in[i] = (const float*)d_in[i];
    a.out = (float*)d_out; a.ws = (unsigned char*)d_ws;
#if MK_ONE_LAUNCH
    a.ph_lo = 0; a.ph_hi = NPHASES; a.li = 0;
    hipLaunchKernelGGL(mega, dim3(grid), dim3(NWAVES * 64), LDS_BYTES, stream, a);
#else
    for (int ph = 0; ph < NPHASES; ++ph) { a.ph_lo = ph; a.ph_hi = ph + 1; a.li = 0; hipLaunchKernelGGL(mega, dim3(grid), dim3(NWAVES * 64), LDS_BYTES, stream, a); }
#endif
}
```

```cpp
#include <hip/hip_runtime.h>
#include <cstdio>
#include <cstdint>
#include <cmath>
namespace pg8 {
#define PG8_LAS __attribute__((address_space(3)))
typedef unsigned short bf16_t;
typedef short bf16x8 __attribute__((ext_vector_type(8)));
typedef float f32x4 __attribute__((ext_vector_type(4)));
typedef unsigned u32x4 __attribute__((ext_vector_type(4)));
constexpr int BM = 256, BK = 64, HALF = 128, HTB = HALF * BK * 2  , STAGE_BYTES = 8 * HTB, NXCD = 8, WGM = 8;

__host__ __device__ __forceinline__ int lds_byte(int r, int c) { const int st = (r >> 4) * 2 + (c >> 5), rr = r & 15, cc = c & 31, ob = rr * 64 + cc * 2; return st * 1024 + (ob ^ (((ob >> 9) & 1) << 5)); }
__host__ __device__ __forceinline__ void stage_rc(int b, int& R, int& C) { const int st = b / 1024, sb = b % 1024, swz = sb ^ (((sb >> 9) & 1) << 5); R = (st >> 1) * 16 + swz / 64; C = (st & 1) * 32 + (swz % 64) / 2; }
__host__ __device__ __forceinline__ int perm32(int rho) { const int n = rho >> 4, i = rho & 15; return 8 * (i >> 2) + 4 * n + (i & 3); }

struct Unit { int pm, pn; };
struct Gemm { const bf16_t* A; const bf16_t* Bt; int M, N, K; };

struct StaticOrder {
    int nM, nN, nwg, G, c;
    __host__ __device__ void init(int M, int N, int G_, int c_) { nM = M / BM; nN = N / BM; nwg = nM * nN; G = G_; c = c_; }
    __host__ __device__ bool next(int i, Unit& u) const {
        const long L = (long)i * G + c; if (L >= nwg) return false;
        int wgid = (int)L; { const int q = nwg / NXCD, r = nwg % NXCD, xcd = wgid % NXCD, off = wgid / NXCD; wgid = (xcd < r ? xcd * (q + 1) : r * (q + 1) + (xcd - r) * q) + off; }
        const int nig = WGM * nN, gid = wgid / nig, fm = gid * WGM, gsz = (nM - fm) < WGM ? (nM - fm) : WGM;
        u.pm = fm + ((wgid % nig) % gsz); u.pn = (wgid % nig) / gsz; return true;
    }
    __device__ __forceinline__ void a_ready(const Unit&) const {}
    __device__ __forceinline__ void done(const Unit&) const {}
};

__device__ __forceinline__ unsigned cvt_pk_bf16(float lo, float hi) { unsigned r; asm volatile("v_cvt_pk_bf16_f32 %0, %1, %2" : "=v"(r) : "v"(lo), "v"(hi)); return r; }
template <class Epi, class Sched, bool ALIGN_EPI = false, bool SP2 = false>
__device__ __forceinline__ void gemm_phase(PG8_LAS unsigned char* lds, const Gemm g, const Sched& S, const Epi& E, const int tid_in) {
    int tid_ = tid_in; asm volatile("" : "+v"(tid_));
    const int tid = tid_, wid = __builtin_amdgcn_readfirstlane(tid >> 6), lane = tid & 63, wr = wid >> 2, wc = wid & 3, fr = lane & 15, fq = lane >> 4;
    const int K = g.K, nt = K / BK;
    unsigned voffA[2], voffB[2];
#pragma unroll
    for (int i = 0; i < 2; ++i) { int R, C; stage_rc(tid * 16 + i * 8192, R, C); const int Rb = Epi::PERM ? ((R & ~31) + perm32(R & 31)) : R;
        voffA[i] = (unsigned)(R * K + C) * 2u; voffB[i] = (unsigned)(Rb * K + C) * 2u; }
    const size_t kstep = (size_t)(BK * 2);
    const size_t hstep = (size_t)HALF * K * 2;
    const size_t tstep = 2 * hstep;
    const unsigned ldsw = (unsigned)wid * 1024u;
    const int aoff = lds_byte(wr * 64 + fr, fq * 8), boff = lds_byte(wc * 32 + fr, fq * 8);
#define PG8_SA(b, h) (((b) * 2 + (h)) * HTB)
#define PG8_SB(b, h) ((4 + (b) * 2 + (h)) * HTB)
#define PG8_STAGE(bufoff, gbase, voff) do { _Pragma("unroll") for (int _i = 0; _i < 2; ++_i) \
        __builtin_amdgcn_global_load_lds((const unsigned*)((const char*)(gbase) + (voff)[_i]), (PG8_LAS unsigned*)(lds + (bufoff) + ldsw + _i * 8192), 16, 0, 0); } while (0)
#define PG8_LDA(dst, b, h) do { _Pragma("unroll") for (int m = 0; m < 4; ++m) _Pragma("unroll") for (int k = 0; k < 2; ++k) dst[m][k] = *(const PG8_LAS bf16x8*)(lds + PG8_SA(b, h) + aoff + m * 2048 + k * 1024); } while (0)
#define PG8_LDB(dst, b, h) do { _Pragma("unroll") for (int n = 0; n < 2; ++n) _Pragma("unroll") for (int k = 0; k < 2; ++k) dst[n][k] = *(const PG8_LAS bf16x8*)(lds + PG8_SB(b, h) + boff + n * 2048 + k * 1024); } while (0)
#define PG8_MMA(ai, bj, At, Bt) do { __builtin_amdgcn_s_setprio(1); _Pragma("unroll") for (int m = 0; m < 4; ++m) _Pragma("unroll") for (int n = 0; n < 2; ++n) _Pragma("unroll") for (int k = 0; k < 2; ++k) \
        acc[ai][bj][m][n] = __builtin_amdgcn_mfma_f32_16x16x32_bf16(Bt[n][k], At[m][k], acc[ai][bj][m][n], 0, 0, 0); __builtin_amdgcn_s_setprio(0); } while (0)
#define PG8_WAIT_V(n) asm volatile("s_waitcnt vmcnt(" #n ")" ::: "memory")
#define PG8_WAIT_L(n) asm volatile("s_waitcnt lgkmcnt(" #n ")" ::: "memory")
#define PG8_BAR __builtin_amdgcn_s_barrier()
#define PG8_SCHED __builtin_amdgcn_sched_barrier(0)
    Unit cur, nxt; int ui = 0;
    if (!S.next(0, cur)) return;
    f32x4 acc[2][2][4][2];
#pragma unroll
    for (int a = 0; a < 2; ++a)
#pragma unroll
        for (int b = 0; b < 2; ++b)
#pragma unroll
            for (int m = 0; m < 4; ++m)
#pragma unroll
                for (int n = 0; n < 2; ++n) acc[a][b][m][n] = (f32x4){0.f, 0.f, 0.f, 0.f};
    bf16x8 At[4][2], B0[2][2], B1[2][2];
    const char* cA = (const char*)g.A + (size_t)cur.pm * tstep; const char* cB = (const char*)g.Bt + (size_t)cur.pn * tstep;
    S.a_ready(cur);
    if constexpr (SP2) {
        PG8_STAGE(PG8_SB(0, 0), cB, voffB); PG8_STAGE(PG8_SB(0, 1), cB + hstep, voffB); PG8_STAGE(PG8_SA(0, 0), cA, voffA); PG8_STAGE(PG8_SA(0, 1), cA + hstep, voffA);
        if (wr == 1) PG8_BAR;
        PG8_WAIT_V(2); PG8_BAR;
        PG8_STAGE(PG8_SB(1, 0), cB + kstep, voffB); PG8_STAGE(PG8_SA(1, 0), cA + kstep, voffA); PG8_STAGE(PG8_SB(1, 1), cB + hstep + kstep, voffB);
        PG8_WAIT_V(6); PG8_BAR;
    } else {
        PG8_STAGE(PG8_SB(0, 0), cB, voffB); PG8_STAGE(PG8_SA(0, 0), cA, voffA); PG8_STAGE(PG8_SB(0, 1), cB + hstep, voffB); PG8_STAGE(PG8_SA(0, 1), cA + hstep, voffA);
        if (wr == 1) PG8_BAR;
        PG8_WAIT_V(4); PG8_BAR;
        PG8_STAGE(PG8_SB(1, 0), cB + kstep, voffB); PG8_STAGE(PG8_SA(1, 0), cA + kstep, voffA); PG8_STAGE(PG8_SB(1, 1), cB + hstep + kstep, voffB);
        PG8_WAIT_V(6); PG8_BAR;
    }
    for (;;) {
        const bool has_next = S.next(ui + 1, nxt);
        const char* nA = has_next ? (const char*)g.A + (size_t)nxt.pm * tstep : cA; const char* nB = has_next ? (const char*)g.Bt + (size_t)nxt.pn * tstep : cB;
        for (int t = 0; t < nt; t += 2) {
            const bool last = (t == nt - 2);
            const char* a1 = cA + (size_t)(t + 1) * kstep;
            const char* a2 = last ? nA : cA + (size_t)(t + 2) * kstep; const char* b2 = last ? nB : cB + (size_t)(t + 2) * kstep;
            const char* a3 = a2 + kstep; const char* b3 = b2 + kstep;
            if (last && has_next) S.a_ready(nxt);
            if constexpr (Epi::KHOOK) E.khook(acc, cur, t, wr, fr);
            if constexpr (SP2) {
            PG8_LDB(B0, 0, 0); PG8_LDB(B1, 0, 1); PG8_SCHED; PG8_LDA(At, 0, 0); PG8_STAGE(PG8_SA(1, 1), a1 + hstep, voffA);
            PG8_WAIT_V(8); PG8_WAIT_L(0); PG8_BAR; PG8_MMA(0, 0, At, B0); PG8_MMA(0, 1, At, B1); PG8_BAR; PG8_SCHED;
            PG8_LDA(At, 0, 1); PG8_STAGE(PG8_SB(0, 0), b2, voffB); PG8_STAGE(PG8_SB(0, 1), b2 + hstep, voffB); PG8_STAGE(PG8_SA(0, 0), a2, voffA);
            PG8_WAIT_V(8); PG8_WAIT_L(0); PG8_BAR; PG8_MMA(1, 0, At, B0); PG8_MMA(1, 1, At, B1); PG8_BAR; PG8_SCHED;
            PG8_LDB(B0, 1, 0); PG8_LDB(B1, 1, 1); PG8_SCHED; PG8_LDA(At, 1, 0); PG8_STAGE(PG8_SA(0, 1), a2 + hstep, voffA);
            PG8_WAIT_V(8); PG8_WAIT_L(0); PG8_BAR; PG8_MMA(0, 0, At, B0); PG8_MMA(0, 1, At, B1); PG8_BAR; PG8_SCHED;
            PG8_LDA(At, 1, 1); PG8_STAGE(PG8_SB(1, 0), b3, voffB); PG8_STAGE(PG8_SB(1, 1), b3 + hstep, voffB); PG8_STAGE(PG8_SA(1, 0), a3, voffA);
            PG8_WAIT_V(8); PG8_WAIT_L(0); PG8_BAR; PG8_MMA(1, 0, At, B0); PG8_MMA(1, 1, At, B1); PG8_BAR; PG8_SCHED;
            } else {
            PG8_LDB(B0, 0, 0); PG8_SCHED; PG8_LDA(At, 0, 0); PG8_STAGE(PG8_SA(1, 1), a1 + hstep, voffA);
            PG8_WAIT_L(8); PG8_BAR; PG8_WAIT_L(0); PG8_MMA(0, 0, At, B0); PG8_BAR; PG8_SCHED;
            PG8_LDB(B1, 0, 1); PG8_STAGE(PG8_SB(0, 0), b2, voffB);
            PG8_BAR; PG8_WAIT_L(0); PG8_MMA(0, 1, At, B1); PG8_BAR;
            PG8_LDA(At, 0, 1); PG8_STAGE(PG8_SA(0, 0), a2, voffA);
            PG8_BAR; PG8_WAIT_L(0); PG8_MMA(1, 0, At, B0); PG8_BAR; PG8_SCHED;
            PG8_STAGE(PG8_SB(0, 1), b2 + hstep, voffB);
            PG8_WAIT_V(6); PG8_BAR; PG8_MMA(1, 1, At, B1); PG8_BAR;
            PG8_LDB(B0, 1, 0); PG8_SCHED; PG8_LDA(At, 1, 0); PG8_STAGE(PG8_SA(0, 1), a2 + hstep, voffA);
            PG8_WAIT_L(8); PG8_BAR; PG8_WAIT_L(0); PG8_MMA(0, 0, At, B0); PG8_BAR; PG8_SCHED;
            PG8_LDB(B1, 1, 1); PG8_STAGE(PG8_SB(1, 0), b3, voffB);
            PG8_BAR; PG8_WAIT_L(0); PG8_MMA(0, 1, At, B1); PG8_BAR;
            PG8_LDA(At, 1, 1); PG8_STAGE(PG8_SA(1, 0), a3, voffA);
            PG8_BAR; PG8_WAIT_L(0); PG8_MMA(1, 0, At, B0); PG8_BAR; PG8_SCHED;
            PG8_STAGE(PG8_SB(1, 1), b3 + hstep, voffB);
            PG8_WAIT_V(6); PG8_BAR; PG8_MMA(1, 1, At, B1); PG8_BAR;
            }
        }
        if constexpr (ALIGN_EPI) { if (wr == 0) PG8_BAR; }
        if constexpr (!Epi::AFTER_DRAIN) { E(acc, cur, wr, wc, fr, fq); S.done(cur); }
        if (!has_next) break;
#pragma unroll
        for (int a = 0; a < 2; ++a)
#pragma unroll
            for (int b = 0; b < 2; ++b)
#pragma unroll
                for (int m = 0; m < 4; ++m)
#pragma unroll
                    for (int n = 0; n < 2; ++n) acc[a][b][m][n] = (f32x4){0.f, 0.f, 0.f, 0.f};
        cur = nxt; cA = nA; cB = nB; ++ui;
        if constexpr (ALIGN_EPI) { if (wr == 1) PG8_BAR; }
    }
    PG8_WAIT_V(0);
    if constexpr (!ALIGN_EPI) { if (wr == 0) PG8_BAR; }
    PG8_BAR;
    if constexpr (Epi::AFTER_DRAIN) { E.fused(acc, cur, wr, wc, fr, fq, lds, wid, lane); S.done(cur); }
#undef PG8_SA
#undef PG8_SB
#undef PG8_STAGE
#undef PG8_LDA
#undef PG8_LDB
#undef PG8_MMA
#undef PG8_WAIT_V
#undef PG8_WAIT_L
#undef PG8_BAR
#undef PG8_SCHED
}
}
#define GAS __attribute__((address_space(1)))
#define LAS __attribute__((address_space(3)))
typedef unsigned short bf16;
typedef unsigned v4u __attribute__((ext_vector_type(4)));
typedef float f32x4 __attribute__((ext_vector_type(4)));
typedef short bf16x8 __attribute__((ext_vector_type(8)));
typedef GAS unsigned gu32;
typedef GAS unsigned long long gu64;
#define RLX_AGENT __ATOMIC_RELAXED, __HIP_MEMORY_SCOPE_AGENT
#define LDS_WAIT() asm volatile("s_waitcnt lgkmcnt(0)" ::: "memory")
#define VM_WAIT() asm volatile("s_waitcnt vmcnt(0)" ::: "memory")
__device__ __forceinline__ unsigned long long rt() { return __builtin_amdgcn_s_memrealtime(); }
__device__ __forceinline__ unsigned f2bf(float f) { unsigned u = __builtin_bit_cast(unsigned, f); return (u + 0x7fffu + ((u >> 16) & 1u)) >> 16; }
__device__ __forceinline__ unsigned pk2(float lo, float hi) { return f2bf(lo) | (f2bf(hi) << 16); }

#define XB_TMO      128
#define XB_XCNT(j)  (256  + 64 * (j))
#define XB_XSUB(j)  (1280 + 64 * (j))
#define XB_XGEN(j)  (2304 + 64 * (j))
#define XB_TOP      3328
#define XB_TOPGEN   3392
#define XCD_BAR_WORDS 3456
#define XB_SPIN_CAP (1u << 18)

__device__ __forceinline__ unsigned xb_ld(unsigned* p)              { return __hip_atomic_load(p, __ATOMIC_RELAXED, __HIP_MEMORY_SCOPE_AGENT); }
__device__ __forceinline__ unsigned xb_add(unsigned* p, unsigned v) { return __hip_atomic_fetch_add(p, v, __ATOMIC_RELAXED, __HIP_MEMORY_SCOPE_AGENT); }
__device__ __forceinline__ unsigned xb_xcc_id() { return (unsigned)__builtin_amdgcn_s_getreg((3 << 11) | 20) & 0xFu; }
#define XB_SPIN(cond, bar) do { unsigned _sp = 0; while (cond) { __builtin_amdgcn_s_sleep(1); \
    if ((++_sp & 255u) == 0u) { if (xb_ld(&(bar)[XB_TMO])) break; if (_sp > XB_SPIN_CAP) { atomicAdd(&(bar)[XB_TMO], 1u); break; } } } } while (0)

struct XcdBarrier {
    unsigned* bar; unsigned x;
    volatile LAS unsigned* st;
};

__device__ __forceinline__ XcdBarrier xcd_barrier_post(unsigned* bar, volatile LAS unsigned* st) {
    XcdBarrier b; b.bar = bar; b.x = xb_xcc_id(); b.st = st;
    if (threadIdx.x == 0) (void)xb_add(&bar[XB_XCNT(b.x)], 1u);
    return b;
}
__device__ __forceinline__ void xcd_barrier_complete(unsigned* bar, unsigned x, unsigned& nloc, unsigned& nx) {
    const unsigned G = gridDim.x * gridDim.y * gridDim.z;
    unsigned sum, cnt, mine, sp = 0u;
    for (;;) {
        sum = 0u; cnt = 0u; mine = 0u;
#pragma unroll
        for (unsigned j = 0; j < 16; ++j) { const unsigned c = xb_ld(&bar[XB_XCNT(j)]); sum += c; cnt += (c > 0u) ? 1u : 0u; mine = (j == x) ? c : mine; }
        if (sum == G) break;
        __builtin_amdgcn_s_sleep(1);
        if ((++sp & 255u) == 0u) { if (xb_ld(&bar[XB_TMO])) break; if (sp > XB_SPIN_CAP) { atomicAdd(&bar[XB_TMO], 1u); break; } }
    }
    nloc = mine > 0u ? mine : 1u; nx = cnt > 0u ? cnt : 1u;
}

__device__ __forceinline__ void xcd_barrier(const XcdBarrier& b, const int tid) {
    asm volatile("s_waitcnt vmcnt(0)" ::: "memory");
    __syncthreads();
    if (tid == 0) {
        unsigned* bar = b.bar;
        __builtin_amdgcn_s_waitcnt(0);
        unsigned nloc = b.st[0], nx = b.st[1];
        if (nloc == 0u) { xcd_barrier_complete(bar, b.x, nloc, nx); b.st[0] = nloc; b.st[1] = nx; }
        const unsigned old = xb_add(&bar[XB_XSUB(b.x)], 1u);
        const unsigned gen = old / nloc;
        if (old + 1u == (gen + 1u) * nloc) {
            __builtin_amdgcn_fence(__ATOMIC_RELEASE, "agent");
            asm volatile("s_waitcnt vmcnt(0)" ::: "memory");
            const unsigned og = xb_add(&bar[XB_TOP], 1u);
            const unsigned tg = og / nx;
            if (og + 1u == (tg + 1u) * nx) xb_add(&bar[XB_TOPGEN], 1u);
            else XB_SPIN(xb_ld(&bar[XB_TOPGEN]) == tg, bar);
            __builtin_amdgcn_fence(__ATOMIC_ACQUIRE, "agent");
            xb_add(&bar[XB_XGEN(b.x)], 1u);
            asm volatile("s_waitcnt vmcnt(0)" ::: "memory");
        } else {
            XB_SPIN(xb_ld(&bar[XB_XGEN(b.x)]) == gen, bar);
            __builtin_amdgcn_fence(__ATOMIC_ACQUIRE, "agent");
            asm volatile("s_waitcnt vmcnt(0)" ::: "memory");
        }
    }
    __syncthreads();
}

constexpr int NWAVES = 8;
constexpr int D = 1024, NB = 4, S = 4096, T = NB * S, NL = 2, NMEM = 256, MROWS = NB * NMEM;
constexpr int DIN = 2438, NPROJ = 2560;
constexpr int PC_Z = 0, PC_XBC = 384, PC_QSB = 1024, PC_KSB = 1408, PC_VSB = 1792, PC_QMEM = 2176, PC_DT = 2432;
constexpr int CONV_CH = 640;
constexpr float EPS = 1e-6f;

constexpr int RING_BYTES = 131072;
constexpr int WSCR = 17408;
constexpr int LDSCTL_OFF = 8 * WSCR, MISC_OFF = LDSCTL_OFF + 320;
constexpr int LDS_BYTES = 147456;
constexpr int GTAB_OFF = LDSCTL_OFF + 1024;

constexpr size_t MiB = 1u << 20;
constexpr size_t WS_CTL = 0, CTL_ZERO_BYTES = 64 * 1024;
constexpr size_t WS_WIN = 2 * MiB;
constexpr size_t WS_WMEM = 12 * MiB;
constexpr size_t WS_WOUT = 14 * MiB;
constexpr size_t WS_WSC = 18 * MiB;
constexpr size_t WS_KB = 22 * MiB;
constexpr size_t WS_MEMB = 26 * MiB;
constexpr size_t WS_RSM = 28 * MiB;
constexpr size_t WS_RS1 = WS_RSM + 64 * 1024;
constexpr size_t WS_DTF = WS_RS1 + 64 * 1024;
constexpr size_t WS_XSSQ = 29 * MiB;
constexpr size_t WS_YSSQ = 30 * MiB;
constexpr size_t WS_MEMKV = 31 * MiB;
constexpr size_t WS_RS1P = 32 * MiB;
constexpr size_t WS_PART = 178 * MiB;
constexpr size_t WS_XB = 34 * MiB;
constexpr size_t WS_YCAT = 66 * MiB;
constexpr size_t WS_PROJ = 98 * MiB;
constexpr size_t WS_SCORES = 178 * MiB;
constexpr size_t WS_YPART = WS_SCORES;
constexpr size_t WS_XCONV = WS_SCORES + 24 * MiB;
constexpr size_t WS_CMG = WS_SCORES + 36 * MiB;
constexpr size_t WS_ACSG = WS_SCORES + 40 * MiB;
constexpr size_t WS_HS = WS_SCORES + 41 * MiB;
constexpr size_t WS_CD = WS_SCORES + 53 * MiB;
constexpr size_t WS_EIDX = 306 * MiB;
constexpr size_t WS_GATE = 314 * MiB;
constexpr size_t WS_WV = 322 * MiB;
constexpr size_t WS_STOP = 330 * MiB;
constexpr size_t WS_ITOP = 338 * MiB;
constexpr size_t WS_UT = 354 * MiB;
constexpr size_t WS_USC = 386 * MiB;
constexpr size_t WS_VT = 418 * MiB;
constexpr size_t WS_VSC = 450 * MiB;
constexpr size_t WS_END = 482 * MiB;
constexpr int CW_BAR = 4096;

__device__ __forceinline__ float bf2f(bf16 v) { return __uint_as_float((unsigned)v << 16); }
__device__ __forceinline__ unsigned pkbf(float lo, float hi) { return pg8::cvt_pk_bf16(lo, hi); }
template <int CTRL> __device__ __forceinline__ float dpp_f(float v) { return __uint_as_float((unsigned)__builtin_amdgcn_update_dpp(0, (int)__float_as_uint(v), CTRL, 0xf, 0xf, true)); }
__device__ __forceinline__ float swap32_add(float a, float b) {
    const auto r = __builtin_amdgcn_permlane32_swap(__float_as_uint(a), __float_as_uint(b), false, false); return __uint_as_float(r[0]) + __uint_as_float(r[1]); }
__device__ __forceinline__ float swap16_add(float a, float b) {
    const auto r = __builtin_amdgcn_permlane16_swap(__float_as_uint(a), __float_as_uint(b), false, false); return __uint_as_float(r[0]) + __uint_as_float(r[1]); }
__device__ __forceinline__ float swap32_max(float a) { const auto r = __builtin_amdgcn_permlane32_swap(__float_as_uint(a), __float_as_uint(a), false, false); return fmaxf(__uint_as_float(r[0]), __uint_as_float(r[1])); }
__device__ __forceinline__ float swap16_max(float a) { const auto r = __builtin_amdgcn_permlane16_swap(__float_as_uint(a), __float_as_uint(a), false, false); return fmaxf(__uint_as_float(r[0]), __uint_as_float(r[1])); }
__device__ __forceinline__ float partner32(float a, bool hi) { const auto r = __builtin_amdgcn_permlane32_swap(__float_as_uint(a), __float_as_uint(a), false, false); return __uint_as_float(hi ? r[0] : r[1]); }
__device__ __forceinline__ float sum8(float v) { v += dpp_f<0xB1>(v); v += dpp_f<0x4E>(v); v += dpp_f<0x141>(v); return v; }
__device__ __forceinline__ float sum16(float v) { v = sum8(v); v += dpp_f<0x140>(v); return v; }
__device__ __forceinline__ float wave_sum(float v) { v = sum16(v); v = swap16_add(v, v); return swap32_add(v, v); }
__device__ __forceinline__ float wave_max(float v) { v = fmaxf(v, dpp_f<0xB1>(v)); v = fmaxf(v, dpp_f<0x4E>(v)); v = fmaxf(v, dpp_f<0x141>(v)); v = fmaxf(v, dpp_f<0x140>(v)); v = swap16_max(v); return swap32_max(v); }
__device__ __forceinline__ float bperm_f(float v, int src_lane) { return __uint_as_float((unsigned)__builtin_amdgcn_ds_bpermute(src_lane << 2, (int)__float_as_uint(v))); }
__device__ __forceinline__ int bperm_i(int v, int src_lane) { return __builtin_amdgcn_ds_bpermute(src_lane << 2, v); }
__device__ __forceinline__ float softplus_f(float x) { return fmaxf(x, 0.f) + log1pf(expf(-fabsf(x))); }
__device__ __forceinline__ float silu_f(float x) { return x * __builtin_amdgcn_rcpf(1.f + __builtin_amdgcn_exp2f(-1.4426950408889634f * x)); }

namespace pg8 {
struct EpiInProj {
    static constexpr bool PERM = true, AFTER_DRAIN = false, KHOOK = false;
    bf16_t* O; int ldc; const float* rs; float* dtf; const float* dtb; int npart;
    __device__ __forceinline__ void operator()(const f32x4 (&acc)[2][2][4][2], const Unit& u, int wr, int wc, int fr, int fq) const {
        const int row0 = u.pm * BM + wr * 64 + fr, col0 = u.pn * BM + wc * 32 + 8 * fq;
        const bool dtl = dtf && (u.pn * BM == PC_DT - 128) && wc == 0 && fq == 0;
#pragma unroll
        for (int ai = 0; ai < 2; ++ai)
#pragma unroll
            for (int m = 0; m < 4; ++m) {
                const int row = row0 + ai * HALF + m * 16; float s;
                if (npart == 8) { const f32x4 p0 = *(const f32x4*)(rs + (size_t)row * 8), p1 = *(const f32x4*)(rs + (size_t)row * 8 + 4); s = rsqrtf((((p0[0] + p0[1]) + (p0[2] + p0[3])) + ((p1[0] + p1[1]) + (p1[2] + p1[3]))) * (1.f / 1024.f) + EPS); }
                else if (npart == 16) { const f32x4 p0 = *(const f32x4*)(rs + (size_t)row * 16), p1 = *(const f32x4*)(rs + (size_t)row * 16 + 4), p2 = *(const f32x4*)(rs + (size_t)row * 16 + 8), p3 = *(const f32x4*)(rs + (size_t)row * 16 + 12);
                    s = rsqrtf(((((p0[0] + p0[1]) + (p0[2] + p0[3])) + ((p1[0] + p1[1]) + (p1[2] + p1[3]))) + (((p2[0] + p2[1]) + (p2[2] + p2[3])) + ((p3[0] + p3[1]) + (p3[2] + p3[3])))) * (1.f / 1024.f) + EPS); }
                else s = rs[row];
#pragma unroll
                for (int bj = 0; bj < 2; ++bj) {
                    const f32x4 v0 = acc[ai][bj][m][0] * s, v1 = acc[ai][bj][m][1] * s;
                    u32x4 w; w.x = cvt_pk_bf16(v0[0], v0[1]); w.y = cvt_pk_bf16(v0[2], v0[3]); w.z = cvt_pk_bf16(v1[0], v1[1]); w.w = cvt_pk_bf16(v1[2], v1[3]);
                    *(u32x4*)(O + (size_t)row * ldc + col0 + bj * HALF) = w;
                    if (bj == 1 && dtl) {
                        f32x4 d0; d0[0] = softplus_f(v0[0] + dtb[0]); d0[1] = softplus_f(v0[1] + dtb[1]); d0[2] = softplus_f(v0[2] + dtb[2]); d0[3] = softplus_f(v0[3] + dtb[3]);
                        f32x4 d1; d1[0] = softplus_f(v1[0] + dtb[4]); d1[1] = softplus_f(v1[1] + dtb[5]); d1[2] = 0.f; d1[3] = 0.f;
                        *(f32x4*)(dtf + (size_t)row * 8) = d0; *(f32x4*)(dtf + (size_t)row * 8 + 4) = d1;
                    }
                }
            }
    }
};
__device__ __forceinline__ void group_rstd(const float* yssq, int row, float& r_ssd, float& r_sb, float& r_mem) {
    const f32x4 a = *(const f32x4*)(yssq + (size_t)row * 16), b = *(const f32x4*)(yssq + (size_t)row * 16 + 4), c = *(const f32x4*)(yssq + (size_t)row * 16 + 8), d = *(const f32x4*)(yssq + (size_t)row * 16 + 12);
    const float s0 = (a[0] + a[1]) + (a[2] + a[3]) + (b[0] + b[1]), s1 = (b[2] + b[3]) + (c[0] + c[1]) + (c[2] + c[3]), s2 = (d[0] + d[1]) + (d[2] + d[3]);
    r_ssd = rsqrtf(s0 * (1.f / 384.f) + EPS); r_sb = rsqrtf(s1 * (1.f / 384.f) + EPS); r_mem = rsqrtf(s2 * (1.f / 256.f) + EPS);
}
struct EpiOut {
    static constexpr bool PERM = false, AFTER_DRAIN = false, KHOOK = true;
    bf16_t* xb; float* xssq; const PG8_LAS float* gtab;
    __device__ __forceinline__ void khook(f32x4 (&acc)[2][2][4][2], const Unit& u, int t, int wr, int fr) const {
        if (t != 6 && t != 12) return;
#pragma unroll
        for (int ai = 0; ai < 2; ++ai)
#pragma unroll
            for (int m = 0; m < 4; ++m) {
                const float f = gtab[(t == 6 ? 0 : 256) + ai * HALF + wr * 64 + m * 16 + fr];
#pragma unroll
                for (int bj = 0; bj < 2; ++bj)
#pragma unroll
                    for (int n = 0; n < 2; ++n) acc[ai][bj][m][n] = acc[ai][bj][m][n] * f;
            }
    }
    __device__ __forceinline__ void operator()(const f32x4 (&acc)[2][2][4][2], const Unit& u, int wr, int wc, int fr, int fq) const {
        const int col0 = u.pn * BM + wc * 32 + 4 * fq;
#pragma unroll
        for (int ai = 0; ai < 2; ++ai)
#pragma unroll
            for (int m = 0; m < 4; ++m) {
                const int row = u.pm * BM + ai * HALF + wr * 64 + m * 16 + fr; const float r2 = gtab[512 + ai * HALF + wr * 64 + m * 16 + fr];
                float q = 0.f;
#pragma unroll
                for (int bj = 0; bj < 2; ++bj)
#pragma unroll
                    for (int n = 0; n < 2; ++n) {
                        const size_t off = (size_t)row * D + col0 + bj * HALF + n * 16;
                        typedef unsigned u32x2v __attribute__((ext_vector_type(2)));
                        const u32x2v bw = *(const u32x2v*)(xb + off);
                        const f32x4 x1 = (f32x4){__uint_as_float(bw.x << 16), __uint_as_float(bw.x & 0xffff0000u), __uint_as_float(bw.y << 16), __uint_as_float(bw.y & 0xffff0000u)} + acc[ai][bj][m][n] * r2;
                        u32x2v w; w.x = cvt_pk_bf16(x1[0], x1[1]); w.y = cvt_pk_bf16(x1[2], x1[3]); *(u32x2v*)(xb + off) = w;
                        q += (x1[0] * x1[0] + x1[1] * x1[1]) + (x1[2] * x1[2] + x1[3] * x1[3]);
                    }
                q = swap16_add(q, q); q = swap32_add(q, q);
                if (fq == 0) xssq[(size_t)row * 16 + u.pn * 4 + wc] = q;
            }
    }
};
struct EpiScores {
    static constexpr bool PERM = false, AFTER_DRAIN = false, KHOOK = false;
    float* O; const float* xssq;
    __device__ __forceinline__ void operator()(const f32x4 (&acc)[2][2][4][2], const Unit& u, int wr, int wc, int fr, int fq) const {
        const int col0 = u.pn * BM + wc * 32 + 4 * fq;
#pragma unroll
        for (int ai = 0; ai < 2; ++ai)
#pragma unroll
            for (int m = 0; m < 4; ++m) {
                const int row = u.pm * BM + ai * HALF + wr * 64 + m * 16 + fr;
                const f32x4 a = *(const f32x4*)(xssq + (size_t)row * 16), b = *(const f32x4*)(xssq + (size_t)row * 16 + 4), c = *(const f32x4*)(xssq + (size_t)row * 16 + 8), d = *(const f32x4*)(xssq + (size_t)row * 16 + 12);
                const float ss = ((a[0] + a[1]) + (a[2] + a[3])) + ((b[0] + b[1]) + (b[2] + b[3])) + ((c[0] + c[1]) + (c[2] + c[3])) + ((d[0] + d[1]) + (d[2] + d[3]));
                const float r = rsqrtf(ss * (1.f / 1024.f) + EPS);
#pragma unroll
                for (int bj = 0; bj < 2; ++bj)
#pragma unroll
                    for (int n = 0; n < 2; ++n) *(f32x4*)(O + (size_t)row * 2048 + col0 + bj * HALF + n * 16) = acc[ai][bj][m][n] * r;
            }
    }
};
}

struct Args { const float* in[22]; float* out; unsigned char* ws; int ph_lo, ph_hi, li, pad; };
enum { I_X = 0, I_MEM, I_NORM1G, I_WIN, I_CONVW, I_CONVB, I_DTBIAS, I_ALOG, I_DSKIP, I_SSDG, I_SBG, I_MEMNG, I_WMEMKV, I_MQG, I_MKG, I_MEMOG, I_WOUT, I_NORM2G, I_WQ, I_KEYS, I_PU, I_PV };

__device__ __forceinline__ int opq(int i) { asm volatile("" : "+s"(i)); return i; }
#define AIN(i) (a.in[opq(i)])
__device__ __forceinline__ void transpose_item(const float* W, int ldw, int src_c0, int nvalid, const float* g, bf16* WT, int K, int dst_r0, int k0, LAS float* scr, int lane) {
    const int c = lane & 31;
#pragma unroll 8
    for (int i = 0; i < 32; ++i) {
        const int kk = 2 * i + (lane >> 5);
        float v = (c < nvalid) ? W[(size_t)(k0 + kk) * ldw + src_c0 + c] : 0.f;
        if (g) v *= g[k0 + kk];
        scr[kk * 33 + c] = v;
    }
    LDS_WAIT(); asm volatile("" ::: "memory");
    const int c8 = lane & 7;
#pragma unroll
    for (int j = 0; j < 4; ++j) {
        const int n = (lane >> 3) + 8 * j; const LAS float* s = scr + (8 * c8) * 33 + n;
        v4u o; o.x = pkbf(s[0 * 33], s[1 * 33]); o.y = pkbf(s[2 * 33], s[3 * 33]); o.z = pkbf(s[4 * 33], s[5 * 33]); o.w = pkbf(s[6 * 33], s[7 * 33]);
        *(GAS v4u*)(WT + (size_t)(dst_r0 + n) * K + k0 + 8 * c8) = o;
    }
    LDS_WAIT(); asm volatile("" ::: "memory");
}
__device__ __forceinline__ void row_to_bf16(const float* xrow, bf16* orow, float* rs, bool partials, int lane) {
    const GAS f32x4* xr = (const GAS f32x4*)xrow + lane;
    f32x4 v[4]; float s = 0.f;
#pragma unroll
    for (int j = 0; j < 4; ++j) { v[j] = xr[64 * j]; s += (v[j].x * v[j].x + v[j].y * v[j].y) + (v[j].z * v[j].z + v[j].w * v[j].w); }
    s = wave_sum(s);
    GAS unsigned long long* o8 = (GAS unsigned long long*)orow + lane;
#pragma unroll
    for (int j = 0; j < 4; ++j) o8[64 * j] = (unsigned long long)pkbf(v[j].x, v[j].y) | ((unsigned long long)pkbf(v[j].z, v[j].w) << 32);
    if (partials) { if (lane < 8) rs[lane] = lane == 0 ? s : 0.f; }
    else if (lane == 0) *rs = rsqrtf(s * (1.f / 1024.f) + EPS);
}
__device__ __forceinline__ void ph_prologue(const Args& a, unsigned char* ws, LAS unsigned char* lds, int gw, int NGW, int wave, int lane) {
    LAS float* scr = (LAS float*)(lds + wave * 16384);
    constexpr int I_IN = 80 * 16, I_MEMW = 16 * 16, I_OUT = 32 * 16, I_SC = 32 * 16 + 128, PER_L = I_IN + I_MEMW + I_OUT + I_SC;
    constexpr int NW_ITEMS = NL * PER_L, NITEMS = NW_ITEMS;
    for (int it = gw; it < NITEMS; it += NGW) {
        if (it < NW_ITEMS) {
            const int l = it / PER_L; int r = it % PER_L;
            if (r < I_IN) {
                const int j = r / 16, kb = r % 16;
                const int src = (j < 32) ? 32 * j : (j < 76 ? 32 * j + 6 : 1024), nv = (j < 76) ? 32 : (j == 76 ? 6 : 0);
                transpose_item(AIN(I_WIN) + (size_t)l * D * DIN, DIN, src, nv, AIN(I_NORM1G) + l * D, (bf16*)(ws + WS_WIN) + (size_t)l * NPROJ * D, D, 32 * j, 64 * kb, scr, lane);
                continue;
            }
            r -= I_IN;
            if (r < I_MEMW) {
                const int j = r / 16, kb = r % 16;
                transpose_item(AIN(I_WMEMKV) + (size_t)l * D * 512, 512, 32 * j, 32, AIN(I_MEMNG) + l * D, (bf16*)(ws + WS_WMEM) + (size_t)l * 512 * D, D, 32 * j, 64 * kb, scr, lane);
                continue;
            }
            r -= I_MEMW;
            if (r < I_OUT) {
                const int j = r / 16, kb = r % 16;
                const float* g = (kb < 6) ? AIN(I_SSDG) + l * 384 : (kb < 12 ? AIN(I_SBG) + l * 384 - 384 : AIN(I_MEMOG) + l * 256 - 768);
                transpose_item(AIN(I_WOUT) + (size_t)l * D * D, D, 32 * j, 32, g, (bf16*)(ws + WS_WOUT) + (size_t)l * D * D, D, 32 * j, 64 * kb, scr, lane);
                continue;
            }
            r -= I_OUT;
            if (r < 32 * 16) { const int j = r / 16, kb = r % 16;
                transpose_item(AIN(I_WQ) + (size_t)l * D * D, D, 32 * j, 32, AIN(I_NORM2G) + l * D, (bf16*)(ws + WS_WSC) + (size_t)l * D * D, D, 32 * j, 64 * kb, scr, lane); }
            else { r -= 32 * 16;
                const GAS f32x4* kr = (const GAS f32x4*)(AIN(I_KEYS) + (size_t)l * 16 * 128 * 64 + (size_t)r * 1024) + lane; GAS unsigned long long* o8 = (GAS unsigned long long*)((bf16*)(ws + WS_KB) + (size_t)l * 16 * 128 * 64 + (size_t)r * 1024) + lane;
#pragma unroll
                for (int j = 0; j < 4; ++j) { const f32x4 v = kr[64 * j]; o8[64 * j] = (unsigned long long)pkbf(v.x, v.y) | ((unsigned long long)pkbf(v.z, v.w) << 32); } }
            continue;
        }
        (void)0;
    }
    for (int r0 = gw; r0 < T + MROWS; r0 += 4 * NGW) {
        f32x4 v[4][4];
#pragma unroll
        for (int q = 0; q < 4; ++q) { const int r = r0 + q * NGW; const float* src = r < T ? AIN(I_X) + (size_t)r * D : AIN(I_MEM) + (size_t)(r - T) * D;
#pragma unroll
            for (int j = 0; j < 4; ++j) v[q][j] = (r < T + MROWS) ? *((const GAS f32x4*)src + 64 * j + lane) : (f32x4){0.f, 0.f, 0.f, 0.f}; }
#pragma unroll
        for (int q = 0; q < 4; ++q) { const int r = r0 + q * NGW; if (r >= T + MROWS) continue;
            float ss = 0.f;
#pragma unroll
            for (int j = 0; j < 4; ++j) ss += (v[q][j].x * v[q][j].x + v[q][j].y * v[q][j].y) + (v[q][j].z * v[q][j].z + v[q][j].w * v[q][j].w);
            ss = wave_sum(ss);
            GAS unsigned long long* o8 = (GAS unsigned long long*)(r < T ? (bf16*)(ws + WS_XB) + (size_t)r * D : (bf16*)(ws + WS_MEMB) + (size_t)(r - T) * D) + lane;
#pragma unroll
            for (int j = 0; j < 4; ++j) o8[64 * j] = (unsigned long long)pkbf(v[q][j].x, v[q][j].y) | ((unsigned long long)pkbf(v[q][j].z, v[q][j].w) << 32);
            if (r < T) { if (lane < 8) ((float*)(ws + WS_RS1P))[(size_t)r * 8 + lane] = lane == 0 ? ss : 0.f; }
            else if (lane == 0) ((float*)(ws + WS_RSM))[r - T] = rsqrtf(ss * (1.f / 1024.f) + EPS);
        }
    }
}


__device__ __forceinline__ void convert_tables(const Args& a, unsigned char* ws, int l, int widx, int nw, int lane) {
    for (int r0 = widx; r0 < 2 * 16384; r0 += 4 * nw) {
        f32x4 v[4][4];
#pragma unroll
        for (int q = 0; q < 4; ++q) {
            const int r = r0 + q * nw; const int tb = r >> 14, e = (r & 16383) + l * 16384;
            const float* src = (tb == 0 ? AIN(I_PU) : AIN(I_PV)) + (size_t)e * D;
#pragma unroll
            for (int j = 0; j < 4; ++j) v[q][j] = (r < 2 * 16384) ? *((const GAS f32x4*)src + 64 * j + lane) : (f32x4){0.f, 0.f, 0.f, 0.f};
        }
#pragma unroll
        for (int q = 0; q < 4; ++q) {
            const int r = r0 + q * nw; const int tb = r >> 14, e = (r & 16383) + l * 16384;
            if (r >= 2 * 16384) continue;
            unsigned* dst = (unsigned*)(ws + (tb == 0 ? WS_UT : WS_VT) + (size_t)l * 16384 * D + (size_t)(e & 16383) * 128) + (lane & 31);
            const float* g = AIN(I_NORM2G) + l * D;
            float am = 0.f;
#pragma unroll
            for (int j = 0; j < 4; ++j) { if (tb == 0) v[q][j] = v[q][j] * *((const GAS f32x4*)g + 64 * j + lane);
                am = fmaxf(fmaxf(am, fmaxf(fabsf(v[q][j].x), fabsf(v[q][j].y))), fmaxf(fabsf(v[q][j].z), fabsf(v[q][j].w))); }
            am = wave_max(am);
            const float sc = am > 0.f ? 256.f / am : 1.f;
#pragma unroll
            for (int j = 0; j < 4; ++j) { int pk = 0; pk = __builtin_amdgcn_cvt_pk_fp8_f32(v[q][j].x * sc, v[q][j].y * sc, pk, false); pk = __builtin_amdgcn_cvt_pk_fp8_f32(v[q][j].z * sc, v[q][j].w * sc, pk, true); dst[(size_t)(2 * j + (lane >> 5)) * (16384 * 128 / 4)] = (unsigned)pk; }
            if (lane == 0) ((float*)(ws + (tb == 0 ? WS_USC : WS_VSC)))[e] = am > 0.f ? am * (1.f / 256.f) : 1.f;
        }
    }
}

typedef __attribute__((ext_vector_type(8))) __bf16 bf8_t;
typedef __attribute__((ext_vector_type(8))) float f32x8;
typedef __attribute__((ext_vector_type(8))) short s16x8;
typedef __attribute__((ext_vector_type(4))) short s16x4;
typedef __attribute__((ext_vector_type(16))) float f32x16;
typedef unsigned u32x2 __attribute__((ext_vector_type(2)));
#define MFMA32(a, b, c) __builtin_amdgcn_mfma_f32_32x32x16_bf16((a), (b), (c), 0, 0, 0)
__device__ __forceinline__ int crow(int i, int h) { return (i & 3) + 8 * (i >> 2) + 4 * h; }
__device__ __forceinline__ s16x8 cvt8(const f32x8 x) { return __builtin_bit_cast(s16x8, __builtin_convertvector(x, bf8_t)); }
__device__ __forceinline__ s16x8 pack_acc(const f32x16& x, int s) { f32x8 v;
#pragma unroll
    for (int j = 0; j < 8; ++j) v[j] = x[8 * s + j];
    return cvt8(v); }
__device__ __forceinline__ s16x8 cat4(const s16x4 lo, const s16x4 hi) { return __builtin_shufflevector(lo, hi, 0, 1, 2, 3, 4, 5, 6, 7); }
__device__ __forceinline__ f32x16 zero16() { f32x16 z;
#pragma unroll
    for (int i = 0; i < 16; ++i) z[i] = 0.f;
    return z; }
constexpr int L_BM = 0, L_CM = 18432, L_BMT = 36864, L_XDT = 54272, L_ACS = 106496, L_DT = 108032, L_TOT = 109568;

__device__ __forceinline__ void ssd_chunk_unit(const Args& a, unsigned char* ws, LAS unsigned char* lds, int l_, int unit, int tid, int wave, int lane) {
    const int g = unit & 1, c = (unit >> 1) & 31, b = unit >> 6, t0 = b * S + c * 128;
    const bf16* proj = (const bf16*)(ws + WS_PROJ); const float* dtf = (const float*)(ws + WS_DTF);
    LAS float* acs = (LAS float*)(lds + L_ACS); LAS float* dts = (LAS float*)(lds + L_DT); LAS float* tot = (LAS float*)(lds + L_TOT);
    float cs = 0.f, dtv = 0.f;
    if (wave < 6) {
        const int hh = wave >> 1, l = (wave & 1) * 64 + lane;
        dtv = dtf[(size_t)(t0 + l) * 8 + 3 * g + hh];
        cs = dtv * -expf(AIN(I_ALOG)[l_ * 6 + 3 * g + hh]);
#pragma unroll
        for (int o = 1; o < 64; o <<= 1) { const float t = bperm_f(cs, lane - o); if (lane >= o) cs += t; }
        if (lane == 63) tot[wave] = cs;
    }
    __syncthreads();
    if (wave < 6) {
        const int hh = wave >> 1, l = (wave & 1) * 64 + lane;
        if (wave & 1) cs += tot[wave - 1];
        acs[hh * 128 + l] = cs; dts[hh * 128 + l] = dtv;
        ((float*)(ws + WS_ACSG))[(size_t)(t0 + l) * 8 + 3 * g + hh] = cs;
    }
    __syncthreads();
    const float* cw = AIN(I_CONVW) + l_ * 4 * CONV_CH; const float* cb = AIN(I_CONVB) + l_ * CONV_CH;
#pragma unroll 2
    for (int it = 0; it < 10; ++it) {
        const int idx = tid + 512 * it, l = idx / 40, ck = idx % 40;
        int cc, kind, hh = 0, e0;
        if (ck < 24) { hh = ck >> 3; e0 = (ck & 7) * 8; cc = (3 * g + hh) * 64 + e0; kind = 0; }
        else if (ck < 32) { e0 = (ck - 24) * 8; cc = 384 + g * 64 + e0; kind = 1; }
        else { e0 = (ck - 32) * 8; cc = 512 + g * 64 + e0; kind = 2; }
        float acc[8];
        { const f32x4 b0 = *(const f32x4*)(cb + cc), b1 = *(const f32x4*)(cb + cc + 4); acc[0] = b0.x; acc[1] = b0.y; acc[2] = b0.z; acc[3] = b0.w; acc[4] = b1.x; acc[5] = b1.y; acc[6] = b1.z; acc[7] = b1.w; }
#pragma unroll
        for (int k = 0; k < 4; ++k) {
            const int sl = c * 128 + l - 3 + k;
            if (sl >= 0) {
                const v4u xv = *(const GAS v4u*)(proj + (size_t)(t0 + l - 3 + k) * NPROJ + PC_XBC + cc);
                const f32x4 w0 = *(const f32x4*)(cw + k * CONV_CH + cc), w1 = *(const f32x4*)(cw + k * CONV_CH + cc + 4);
                acc[0] += w0.x * __uint_as_float(xv.x << 16); acc[1] += w0.y * __uint_as_float(xv.x & 0xffff0000u);
                acc[2] += w0.z * __uint_as_float(xv.y << 16); acc[3] += w0.w * __uint_as_float(xv.y & 0xffff0000u);
                acc[4] += w1.x * __uint_as_float(xv.z << 16); acc[5] += w1.y * __uint_as_float(xv.z & 0xffff0000u);
                acc[6] += w1.z * __uint_as_float(xv.w << 16); acc[7] += w1.w * __uint_as_float(xv.w & 0xffff0000u);
            }
        }
#pragma unroll
        for (int e = 0; e < 8; ++e) acc[e] = silu_f(acc[e]);
        v4u pk; pk.x = pkbf(acc[0], acc[1]); pk.y = pkbf(acc[2], acc[3]); pk.z = pkbf(acc[4], acc[5]); pk.w = pkbf(acc[6], acc[7]);
        if (kind == 0) {
            *(GAS v4u*)((bf16*)(ws + WS_XCONV) + (size_t)(t0 + l) * 384 + (3 * g + hh) * 64 + e0) = pk;
            const float d = dts[hh * 128 + l];
            LAS bf16* xd = (LAS bf16*)(lds + L_XDT) + (hh * 64 + e0) * 136 + l;
#pragma unroll
            for (int e = 0; e < 8; e += 2) { const unsigned w = pkbf(acc[e] * d, acc[e + 1] * d); xd[e * 136] = (bf16)(w & 0xffffu); xd[(e + 1) * 136] = (bf16)(w >> 16); }
        } else if (kind == 1) {
            *(LAS v4u*)(lds + L_BM + (l * 72 + e0) * 2) = pk;
            LAS bf16* bt = (LAS bf16*)(lds + L_BMT) + e0 * 136 + l;
            bt[0 * 136] = (bf16)(pk.x & 0xffffu); bt[1 * 136] = (bf16)(pk.x >> 16); bt[2 * 136] = (bf16)(pk.y & 0xffffu); bt[3 * 136] = (bf16)(pk.y >> 16);
            bt[4 * 136] = (bf16)(pk.z & 0xffffu); bt[5 * 136] = (bf16)(pk.z >> 16); bt[6 * 136] = (bf16)(pk.w & 0xffffu); bt[7 * 136] = (bf16)(pk.w >> 16);
        } else {
            *(LAS v4u*)(lds + L_CM + (l * 72 + e0) * 2) = pk;
            *(GAS v4u*)((bf16*)(ws + WS_CMG) + (size_t)(t0 + l) * 128 + g * 64 + e0) = pk;
        }
    }
    __syncthreads();
    const int r = lane & 31, h = lane >> 5, lb = wave & 3, pt = wave >> 2;
    {
        s16x8 cf[4];
#pragma unroll
        for (int ks = 0; ks < 4; ++ks) cf[ks] = *(const LAS s16x8*)(lds + L_CM + ((lb * 32 + r) * 72 + ks * 16 + 8 * h) * 2);
        f32x16 gt[4];
#pragma unroll
        for (int sb = 0; sb < 4; ++sb) {
            gt[sb] = zero16();
            if (sb <= lb) {
#pragma unroll
                for (int ks = 0; ks < 4; ++ks) gt[sb] = MFMA32(*(const LAS s16x8*)(lds + L_BM + ((sb * 32 + r) * 72 + ks * 16 + 8 * h) * 2), cf[ks], gt[sb]);
            }
        }
#pragma unroll
        for (int hh = 0; hh < 3; ++hh) {
            const float al = acs[hh * 128 + lb * 32 + r];
            f32x16 yacc = zero16();
#pragma unroll
            for (int sb = 0; sb < 4; ++sb) {
                if (sb <= lb) {
                    f32x16 m;
#pragma unroll
                    for (int i = 0; i < 16; ++i) {
                        const int sl = crow(i, h);
                        const float v = gt[sb][i] * __expf(al - acs[hh * 128 + sb * 32 + sl]);
                        m[i] = (sb < lb || sl <= r) ? v : 0.f;
                    }
#pragma unroll
                    for (int ks = 0; ks < 2; ++ks) {
                        const LAS unsigned char* xp = lds + L_XDT + ((hh * 64 + pt * 32 + r) * 136 + sb * 32 + 16 * ks + 4 * h) * 2;
                        yacc = MFMA32(cat4(*(const LAS s16x4*)xp, *(const LAS s16x4*)(xp + 16)), pack_acc(m, ks), yacc);
                    }
                }
            }
            float* yp = (float*)(ws + WS_YPART) + (size_t)(t0 + lb * 32 + r) * 384 + (3 * g + hh) * 64 + pt * 32 + 4 * h;
#pragma unroll
            for (int i4 = 0; i4 < 4; ++i4) *(f32x4*)(yp + 8 * i4) = (f32x4){yacc[4 * i4], yacc[4 * i4 + 1], yacc[4 * i4 + 2], yacc[4 * i4 + 3]};
        }
    }
    for (int tl = wave; tl < 12; tl += 8) {
        const int hh = tl >> 2, nt = (tl >> 1) & 1, pt2 = tl & 1;
        const float alast = acs[hh * 128 + 127];
        f32x16 acc = zero16();
#pragma unroll
        for (int ks = 0; ks < 8; ++ks) {
            const s16x8 af = *(const LAS s16x8*)(lds + L_BMT + ((nt * 32 + r) * 136 + ks * 16 + 8 * h) * 2);
            const v4u xr = *(const LAS v4u*)(lds + L_XDT + ((hh * 64 + pt2 * 32 + r) * 136 + ks * 16 + 8 * h) * 2);
            const LAS float* ap = acs + hh * 128 + ks * 16 + 8 * h;
            f32x8 xf;
            xf[0] = __uint_as_float(xr.x << 16) * __expf(alast - ap[0]); xf[1] = __uint_as_float(xr.x & 0xffff0000u) * __expf(alast - ap[1]);
            xf[2] = __uint_as_float(xr.y << 16) * __expf(alast - ap[2]); xf[3] = __uint_as_float(xr.y & 0xffff0000u) * __expf(alast - ap[3]);
            xf[4] = __uint_as_float(xr.z << 16) * __expf(alast - ap[4]); xf[5] = __uint_as_float(xr.z & 0xffff0000u) * __expf(alast - ap[5]);
            xf[6] = __uint_as_float(xr.w << 16) * __expf(alast - ap[6]); xf[7] = __uint_as_float(xr.w & 0xffff0000u) * __expf(alast - ap[7]);
            acc = MFMA32(af, cvt8(xf), acc);
        }
        float* hp = (float*)(ws + WS_HS) + ((size_t)((b * 32 + c) * 6 + 3 * g + hh) * 64 + pt2 * 32 + r) * 64 + nt * 32 + 4 * h;
#pragma unroll
        for (int i4 = 0; i4 < 4; ++i4) *(f32x4*)(hp + 8 * i4) = (f32x4){acc[4 * i4], acc[4 * i4 + 1], acc[4 * i4 + 2], acc[4 * i4 + 3]};
    }
    if (tid < 3) ((float*)(ws + WS_CD))[(b * 32 + c) * 6 + 3 * g + tid] = __expf(acs[tid * 128 + 127]);
    __syncthreads();
}
__device__ __forceinline__ void ph_ssd_scan(unsigned char* ws, int bx, int G, int tid) {
    float* hs = (float*)(ws + WS_HS); const float* cd = (const float*)(ws + WS_CD);
    for (int e = bx * 512 + tid; e < 24 * 4096; e += G * 512) {
        const int bh = e >> 12, el = e & 4095, b = bh / 6, hh = bh % 6;
        float run = 0.f;
#pragma unroll 4
        for (int c = 0; c < 32; ++c) {
            const int idx = (b * 32 + c) * 6 + hh;
            const float v = hs[(size_t)idx * 4096 + el], d = cd[idx];
            hs[(size_t)idx * 4096 + el] = run; run = run * d + v;
        }
    }
}
__device__ __forceinline__ void ssd_finish_unit(const Args& a, unsigned char* ws, LAS unsigned char* lds, int l_, int unit, int tid, int wave, int lane) {
    const int g = unit & 1, c = (unit >> 1) & 31, b = unit >> 6, t0 = b * S + c * 128;
    const int r = lane & 31, h = lane >> 5;
    const bf16* proj = (const bf16*)(ws + WS_PROJ);
    LAS float* sq = (LAS float*)lds;
    for (int item = wave; item < 24; item += NWAVES) {
        const int pt = item & 1, hh = (item >> 1) % 3, lb = item / 6, hd = 3 * g + hh;
        const int t = t0 + lb * 32 + r;
        const bf16* cmg = (const bf16*)(ws + WS_CMG) + (size_t)t * 128 + g * 64;
        const float* hin = (const float*)(ws + WS_HS) + (size_t)((b * 32 + c) * 6 + hd) * 4096;
        s16x8 cf[4]; f32x4 h0[4], h1[4];
#pragma unroll
        for (int ks = 0; ks < 4; ++ks) { cf[ks] = *(const GAS s16x8*)(cmg + ks * 16 + 8 * h); const float* hp = hin + (pt * 32 + r) * 64 + ks * 16 + 8 * h; h0[ks] = *(const GAS f32x4*)hp; h1[ks] = *(const GAS f32x4*)(hp + 4); }
        const float ea = __expf(((const float*)(ws + WS_ACSG))[(size_t)t * 8 + hd]), dsk = AIN(I_DSKIP)[l_ * 6 + hd];
        f32x4 yp[4]; u32x2 xc[4], zz[4];
#pragma unroll
        for (int i4 = 0; i4 < 4; ++i4) {
            const int col = hd * 64 + pt * 32 + 8 * i4 + 4 * h;
            yp[i4] = *(const GAS f32x4*)((const float*)(ws + WS_YPART) + (size_t)t * 384 + col);
            xc[i4] = *(const GAS u32x2*)((const bf16*)(ws + WS_XCONV) + (size_t)t * 384 + col);
            zz[i4] = *(const GAS u32x2*)(proj + (size_t)t * NPROJ + PC_Z + col);
        }
        f32x16 acc = zero16();
#pragma unroll
        for (int ks = 0; ks < 4; ++ks) acc = MFMA32(cvt8((f32x8){h0[ks].x, h0[ks].y, h0[ks].z, h0[ks].w, h1[ks].x, h1[ks].y, h1[ks].z, h1[ks].w}), cf[ks], acc);
        float ssq = 0.f;
#pragma unroll
        for (int i4 = 0; i4 < 4; ++i4) {
            const int col = hd * 64 + pt * 32 + 8 * i4 + 4 * h;
            const float y0 = (yp[i4].x + acc[4 * i4 + 0] * ea + dsk * __uint_as_float(xc[i4].x << 16)) * silu_f(__uint_as_float(zz[i4].x << 16));
            const float y1 = (yp[i4].y + acc[4 * i4 + 1] * ea + dsk * __uint_as_float(xc[i4].x & 0xffff0000u)) * silu_f(__uint_as_float(zz[i4].x & 0xffff0000u));
            const float y2 = (yp[i4].z + acc[4 * i4 + 2] * ea + dsk * __uint_as_float(xc[i4].y << 16)) * silu_f(__uint_as_float(zz[i4].y << 16));
            const float y3 = (yp[i4].w + acc[4 * i4 + 3] * ea + dsk * __uint_as_float(xc[i4].y & 0xffff0000u)) * silu_f(__uint_as_float(zz[i4].y & 0xffff0000u));
            ssq += (y0 * y0 + y1 * y1) + (y2 * y2 + y3 * y3);
            u32x2 w; w.x = pkbf(y0, y1); w.y = pkbf(y2, y3);
            *(GAS u32x2*)((bf16*)(ws + WS_YCAT) + (size_t)t * D + col) = w;
        }
        ssq = swap32_add(ssq, ssq);
        if (h == 0) sq[((lb * 32 + r) * 3 + hh) * 2 + pt] = ssq;
    }
    __syncthreads();
    if (tid < 384) { const int tk = tid & 127, hh = tid >> 7; ((float*)(ws + WS_YSSQ))[(size_t)(t0 + tk) * 16 + 3 * g + hh] = sq[(tk * 3 + hh) * 2] + sq[(tk * 3 + hh) * 2 + 1]; }
    __syncthreads();
}

#define LOG2E 1.4426950408889634f
__device__ __forceinline__ s16x8 trv_frag(const LAS unsigned char* vimg, int key0, int ks, int dt, int lane) {
    const int h = lane >> 5, i16 = lane & 15, blk = (lane >> 4) & 1;
    const LAS unsigned char* p = vimg + (key0 + 16 * ks + 4 * h + (i16 >> 2)) * 144 + (dt * 32 + 16 * blk) * 2 + 8 * (i16 & 3);
    const s16x4 lo = __builtin_amdgcn_ds_read_tr16_b64_v4i16((LAS s16x4*)p), hi = __builtin_amdgcn_ds_read_tr16_b64_v4i16((LAS s16x4*)(p + 8 * 144));
    return cat4(lo, hi);
}
__device__ __forceinline__ void mem_unit(const Args& a, unsigned char* ws, LAS unsigned char* lds, int l_, int b, int hd, int qb, int tid, int wave, int lane) {
    const bf16* proj = (const bf16*)(ws + WS_PROJ); const bf16* memkv = (const bf16*)(ws + WS_MEMKV);
    const float* qg = AIN(I_MQG) + l_ * 64; const float* kg = AIN(I_MKG) + l_ * 64;
    LAS unsigned char* kimg = lds; LAS unsigned char* vimg = lds + 36864;
#pragma unroll
    for (int it = 0; it < 4; ++it) {
        const int idx = tid + 512 * it, m = idx >> 3, ch = idx & 7;
        const v4u kv = *(const GAS v4u*)(memkv + (size_t)(b * NMEM + m) * 512 + hd * 64 + ch * 8);
        const v4u vv = *(const GAS v4u*)(memkv + (size_t)(b * NMEM + m) * 512 + 256 + hd * 64 + ch * 8);
        float kf[8] = {__uint_as_float(kv.x << 16), __uint_as_float(kv.x & 0xffff0000u), __uint_as_float(kv.y << 16), __uint_as_float(kv.y & 0xffff0000u),
                       __uint_as_float(kv.z << 16), __uint_as_float(kv.z & 0xffff0000u), __uint_as_float(kv.w << 16), __uint_as_float(kv.w & 0xffff0000u)};
        float ss = 0.f;
#pragma unroll
        for (int e = 0; e < 8; ++e) ss += kf[e] * kf[e];
        ss = sum8(ss);
        const float rk = rsqrtf(ss * (1.f / 64.f) + EPS);
        const f32x4 g0 = *(const f32x4*)(kg + ch * 8), g1 = *(const f32x4*)(kg + ch * 8 + 4);
        v4u pk; pk.x = pkbf(kf[0] * rk * g0.x, kf[1] * rk * g0.y); pk.y = pkbf(kf[2] * rk * g0.z, kf[3] * rk * g0.w); pk.z = pkbf(kf[4] * rk * g1.x, kf[5] * rk * g1.y); pk.w = pkbf(kf[6] * rk * g1.z, kf[7] * rk * g1.w);
        *(LAS v4u*)(kimg + (m * 72 + ch * 8) * 2) = pk;
        *(LAS v4u*)(vimg + (m * 72 + ch * 8) * 2) = vv;
    }
    __syncthreads();
    const int r = lane & 31, h = lane >> 5;
    const int t = b * S + qb * 256 + wave * 32 + r;
    s16x8 qf[4];
    {
        f32x8 qv[4]; float ss = 0.f;
#pragma unroll
        for (int ks = 0; ks < 4; ++ks) {
            const v4u q = *(const GAS v4u*)(proj + (size_t)t * NPROJ + PC_QMEM + hd * 64 + ks * 16 + 8 * h);
            qv[ks] = (f32x8){__uint_as_float(q.x << 16), __uint_as_float(q.x & 0xffff0000u), __uint_as_float(q.y << 16), __uint_as_float(q.y & 0xffff0000u),
                             __uint_as_float(q.z << 16), __uint_as_float(q.z & 0xffff0000u), __uint_as_float(q.w << 16), __uint_as_float(q.w & 0xffff0000u)};
#pragma unroll
            for (int e = 0; e < 8; ++e) ss += qv[ks][e] * qv[ks][e];
        }
        ss = swap32_add(ss, ss);
        const float rq = rsqrtf(ss * (1.f / 64.f) + EPS) * (0.125f * LOG2E);
#pragma unroll
        for (int ks = 0; ks < 4; ++ks) {
            const f32x4 g0 = *(const f32x4*)(qg + ks * 16 + 8 * h), g1 = *(const f32x4*)(qg + ks * 16 + 8 * h + 4);
            qf[ks] = cvt8(qv[ks] * rq * (f32x8){g0.x, g0.y, g0.z, g0.w, g1.x, g1.y, g1.z, g1.w});
        }
    }
    f32x16 st[8];
    float mx = -INFINITY;
#pragma unroll
    for (int kt = 0; kt < 8; ++kt) {
        st[kt] = zero16();
#pragma unroll
        for (int ks = 0; ks < 4; ++ks) st[kt] = MFMA32(*(const LAS s16x8*)(kimg + ((kt * 32 + r) * 72 + ks * 16 + 8 * h) * 2), qf[ks], st[kt]);
#pragma unroll
        for (int i = 0; i < 16; ++i) mx = fmaxf(mx, st[kt][i]);
    }
    mx = swap32_max(mx);
    float lsum = 0.f;
    f32x16 o0 = zero16(), o1 = zero16();
#pragma unroll
    for (int kt = 0; kt < 8; ++kt) {
#pragma unroll
        for (int i = 0; i < 16; ++i) { st[kt][i] = __builtin_amdgcn_exp2f(st[kt][i] - mx); lsum += st[kt][i]; }
#pragma unroll
        for (int ks = 0; ks < 2; ++ks) {
            const s16x8 pf = pack_acc(st[kt], ks);
            o0 = MFMA32(trv_frag(vimg, kt * 32, ks, 0, lane), pf, o0);
            o1 = MFMA32(trv_frag(vimg, kt * 32, ks, 1, lane), pf, o1);
        }
    }
    lsum = swap32_add(lsum, lsum);
    const float il = 1.f / lsum; float ssq = 0.f;
    bf16* yc = (bf16*)(ws + WS_YCAT) + (size_t)t * D + 768 + hd * 64 + 4 * h;
#pragma unroll
    for (int i4 = 0; i4 < 4; ++i4) {
        const float a0 = o0[4 * i4] * il, a1 = o0[4 * i4 + 1] * il, a2 = o0[4 * i4 + 2] * il, a3 = o0[4 * i4 + 3] * il;
        const float b0 = o1[4 * i4] * il, b1 = o1[4 * i4 + 1] * il, b2 = o1[4 * i4 + 2] * il, b3 = o1[4 * i4 + 3] * il;
        ssq += (a0 * a0 + a1 * a1) + (a2 * a2 + a3 * a3) + (b0 * b0 + b1 * b1) + (b2 * b2 + b3 * b3);
        u32x2 w; w.x = pkbf(a0, a1); w.y = pkbf(a2, a3); *(GAS u32x2*)(yc + 8 * i4) = w;
        w.x = pkbf(b0, b1); w.y = pkbf(b2, b3); *(GAS u32x2*)(yc + 32 + 8 * i4) = w;
    }
    ssq = swap32_add(ssq, ssq);
    if (h == 0) ((float*)(ws + WS_YSSQ))[(size_t)t * 16 + 12 + hd] = ssq;
    __syncthreads();
}
__device__ __forceinline__ void sb_unit(unsigned char* ws, LAS unsigned char* lds, int b, int hd, int qb, int tid, int wave, int lane) {
    const bf16* proj = (const bf16*)(ws + WS_PROJ);
    const int r = lane & 31, h = lane >> 5;
    const int q0w = qb * 256 + wave * 32, t = b * S + q0w + r;
    s16x8 qf[4];
#pragma unroll
    for (int ks = 0; ks < 4; ++ks) {
        const v4u q = *(const GAS v4u*)(proj + (size_t)t * NPROJ + PC_QSB + hd * 64 + ks * 16 + 8 * h);
        const f32x8 qv = (f32x8){__uint_as_float(q.x << 16), __uint_as_float(q.x & 0xffff0000u), __uint_as_float(q.y << 16), __uint_as_float(q.y & 0xffff0000u),
                                 __uint_as_float(q.z << 16), __uint_as_float(q.z & 0xffff0000u), __uint_as_float(q.w << 16), __uint_as_float(q.w & 0xffff0000u)};
        qf[ks] = cvt8(qv * (0.125f * LOG2E));
    }
    const int srow = tid >> 3, sch = tid & 7;
    const bf16* kbase = proj + (size_t)(b * S) * NPROJ + PC_KSB + hd * 64 + sch * 8;
    const int ktop = qb * 4 + 3;
    v4u kr = *(const GAS v4u*)(kbase + (size_t)(ktop * 64 + srow) * NPROJ), vr = *(const GAS v4u*)(kbase + (size_t)(ktop * 64 + srow) * NPROJ + (PC_VSB - PC_KSB));
    *(LAS v4u*)(lds + (srow * 72 + sch * 8) * 2) = kr; *(LAS v4u*)(lds + 9216 + (srow * 72 + sch * 8) * 2) = vr;
    __syncthreads();
    f32x16 o0 = zero16(), o1 = zero16();
    float R = 0.f;
    volatile LAS unsigned* live = (volatile LAS unsigned*)(lds + 36864);
    bool mylive = true;
    for (int kt = ktop; kt >= 0; --kt) {
        LAS unsigned char* kimg = lds + ((ktop - kt) & 1) * 18432; LAS unsigned char* vimg = kimg + 9216;
        if (kt > 0) { kr = *(const GAS v4u*)(kbase + (size_t)((kt - 1) * 64 + srow) * NPROJ); vr = *(const GAS v4u*)(kbase + (size_t)((kt - 1) * 64 + srow) * NPROJ + (PC_VSB - PC_KSB)); }
#pragma unroll
        for (int sub = 1; sub >= 0; --sub) {
            const int kb = kt * 64 + sub * 32;
            if (kb <= q0w && mylive) {
                const bool diag = (kb == q0w);
                f32x16 z = zero16();
#pragma unroll
                for (int ks = 0; ks < 4; ++ks) z = MFMA32(*(const LAS s16x8*)(kimg + ((sub * 32 + r) * 72 + ks * 16 + 8 * h) * 2), qf[ks], z);
                float lk[16];
#pragma unroll
                for (int i = 0; i < 16; ++i) {
                    const float sp = fmaxf(z[i], 0.f) + __builtin_amdgcn_logf(1.f + __builtin_amdgcn_exp2f(-fabsf(z[i])));
                    const bool ok = !diag || (crow(i, h) < r);
                    lk[i] = ok ? -sp : 0.f;
                    z[i] = ok ? z[i] : -INFINITY;
                }
                float g[4], pg[4];
#pragma unroll
                for (int j = 0; j < 4; ++j) { g[j] = (lk[4 * j] + lk[4 * j + 1]) + (lk[4 * j + 2] + lk[4 * j + 3]); pg[j] = partner32(g[j], h != 0); }
                float ab[4];
                ab[3] = R + (h == 0 ? pg[3] : 0.f);
#pragma unroll
                for (int j = 2; j >= 0; --j) ab[j] = ab[j + 1] + g[j + 1] + (h == 0 ? pg[j] : pg[j + 1]);
#pragma unroll
                for (int j = 0; j < 4; ++j) {
                    const float s3 = ab[j], s2 = s3 + lk[4 * j + 3], s1 = s2 + lk[4 * j + 2], s0 = s1 + lk[4 * j + 1];
                    z[4 * j + 3] = __builtin_amdgcn_exp2f(z[4 * j + 3] + lk[4 * j + 3] + s3);
                    z[4 * j + 2] = __builtin_amdgcn_exp2f(z[4 * j + 2] + lk[4 * j + 2] + s2);
                    z[4 * j + 1] = __builtin_amdgcn_exp2f(z[4 * j + 1] + lk[4 * j + 1] + s1);
                    z[4 * j + 0] = __builtin_amdgcn_exp2f(z[4 * j + 0] + lk[4 * j + 0] + s0);
                }
                R = ab[0] + g[0] + (h == 0 ? 0.f : pg[0]);
#pragma unroll
                for (int ks = 0; ks < 2; ++ks) {
                    const s16x8 pf = pack_acc(z, ks);
                    o0 = MFMA32(trv_frag(vimg, sub * 32, ks, 0, lane), pf, o0);
                    o1 = MFMA32(trv_frag(vimg, sub * 32, ks, 1, lane), pf, o1);
                }
            }
        }
        if (kt > 0) { LAS unsigned char* nimg = lds + ((ktop - kt + 1) & 1) * 18432; *(LAS v4u*)(nimg + (srow * 72 + sch * 8) * 2) = kr; *(LAS v4u*)(nimg + 9216 + (srow * 72 + sch * 8) * 2) = vr; }
        mylive = mylive && (__builtin_amdgcn_ballot_w64(R >= -150.f) != 0ull);
        if (lane == 0) live[((ktop - kt) & 1) * 8 + wave] = mylive ? 1u : 0u;
        __syncthreads();
        { unsigned any = 0u;
#pragma unroll
          for (int w = 0; w < 8; ++w) any |= live[((ktop - kt) & 1) * 8 + w];
          if (any == 0u) break; }
    }
    float ssq = 0.f;
    bf16* yc = (bf16*)(ws + WS_YCAT) + (size_t)t * D + 384 + hd * 64 + 4 * h;
#pragma unroll
    for (int i4 = 0; i4 < 4; ++i4) {
        const float a0 = o0[4 * i4], a1 = o0[4 * i4 + 1], a2 = o0[4 * i4 + 2], a3 = o0[4 * i4 + 3];
        const float b0 = o1[4 * i4], b1 = o1[4 * i4 + 1], b2 = o1[4 * i4 + 2], b3 = o1[4 * i4 + 3];
        ssq += (a0 * a0 + a1 * a1) + (a2 * a2 + a3 * a3) + (b0 * b0 + b1 * b1) + (b2 * b2 + b3 * b3);
        u32x2 w; w.x = pkbf(a0, a1); w.y = pkbf(a2, a3); *(GAS u32x2*)(yc + 8 * i4) = w;
        w.x = pkbf(b0, b1); w.y = pkbf(b2, b3); *(GAS u32x2*)(yc + 32 + 8 * i4) = w;
    }
    ssq = swap32_add(ssq, ssq);
    if (h == 0) ((float*)(ws + WS_YSSQ))[(size_t)t * 16 + 6 + hd] = ssq;
}
constexpr int CW_Q = 8192;
__device__ __forceinline__ void ph_mix(const Args& a, unsigned char* ws, LAS unsigned char* lds, int l, int tid, int wave, int lane) {
    unsigned* head = (unsigned*)(ws + WS_CTL) + CW_Q + 64 * l;
    volatile LAS unsigned* slot = (volatile LAS unsigned*)(lds + MISC_OFF);
    for (int it = 0;; ++it) {
        if (tid == 0) slot[it & 1] = __hip_atomic_fetch_add(head, 1u, __ATOMIC_RELAXED, __HIP_MEMORY_SCOPE_AGENT);
        __syncthreads();
        const int n = (int)slot[it & 1];
        if (n >= 896) break;
        asm volatile("" : "+s"(ws), "+v"(tid));
        lane = tid & 63; wave = __builtin_amdgcn_readfirstlane(tid >> 6);
        if (n < 256) ssd_chunk_unit(a, ws, lds, l, n, tid, wave, lane);
        else if (n < 640) { const int m = n - 256; const int qb = 15 - m / 24, bh = m % 24; sb_unit(ws, lds, bh / 6, bh % 6, qb, tid, wave, lane); }
        else { const int m = n - 640; mem_unit(a, ws, lds, l, m >> 6, (m >> 4) & 3, m & 15, tid, wave, lane); }
    }
}

__device__ __forceinline__ unsigned f2o(float f) { const unsigned b = __float_as_uint(f); return b ^ ((unsigned)((int)b >> 31) | 0x80000000u); }
__device__ __forceinline__ float o2f(unsigned k) { return __uint_as_float(k ^ ((k & 0x80000000u) ? 0x80000000u : 0xffffffffu)); }
#define TK_CE(a, b) do { const unsigned _mx = (a) > (b) ? (a) : (b), _mn = (a) > (b) ? (b) : (a); (a) = _mx; (b) = _mn; } while (0)
template <int N, int BASE> __device__ __forceinline__ void tk_sort16(unsigned (&k)[N]) {
#pragma unroll
    for (int sz = 2; sz <= 16; sz <<= 1)
#pragma unroll
        for (int j = sz >> 1; j > 0; j >>= 1)
#pragma unroll
            for (int i = 0; i < 16; ++i) { const int l = i ^ j; if (l > i) { if ((i & sz) == 0) TK_CE(k[BASE + i], k[BASE + l]); else TK_CE(k[BASE + l], k[BASE + i]); } }
}
template <int NA, int A, int NB_, int B> __device__ __forceinline__ void tk_merge16(unsigned (&ka)[NA], const unsigned (&kb)[NB_]) {
#pragma unroll
    for (int i = 0; i < 16; ++i) ka[A + i] = ka[A + i] > kb[B + 15 - i] ? ka[A + i] : kb[B + 15 - i];
#pragma unroll
    for (int j = 8; j > 0; j >>= 1)
#pragma unroll
        for (int i = 0; i < 16; ++i) { const int l = i ^ j; if (l > i) TK_CE(ka[A + i], ka[A + l]); }
}
__device__ __forceinline__ unsigned partner32_u(unsigned a, bool hi) { const auto r = __builtin_amdgcn_permlane32_swap(a, a, false, false); return hi ? r[0] : r[1]; }
__device__ __forceinline__ void ph_topk(unsigned char* ws, LAS unsigned char* lds, int l, int pm, int pn, int wave, int lane) {
    const bf16* qb = (const bf16*)(ws + WS_YCAT); const bf16* kb = (const bf16*)(ws + WS_KB) + (size_t)l * 16 * 128 * 64;
    unsigned short* eidx = (unsigned short*)(ws + WS_EIDX); float* gate = (float*)(ws + WS_GATE);
    LAS float* tr = (LAS float*)(lds + wave * WSCR);
    const int r = lane & 31, h = lane >> 5;
    for (int item = wave; item < 16; item += NWAVES) {
        const int hd = 2 * pn + (item & 1), t = pm * 256 + (item >> 1) * 32 + r;
        unsigned top[2][16];
#pragma unroll
        for (int c = 0; c < 2; ++c) {
            const int hc = 2 * hd + c;
            s16x8 qf[4];
#pragma unroll
            for (int ks = 0; ks < 4; ++ks) qf[ks] = *(const GAS s16x8*)(qb + (size_t)t * D + hc * 64 + ks * 16 + 8 * h);
            unsigned k[64];
#pragma unroll
            for (int nt = 0; nt < 4; ++nt) {
                f32x16 acc = zero16();
#pragma unroll
                for (int ks = 0; ks < 4; ++ks) acc = MFMA32(*(const GAS s16x8*)(kb + (size_t)(hc * 128 + nt * 32 + r) * 64 + ks * 16 + 8 * h), qf[ks], acc);
#pragma unroll
                for (int i = 0; i < 16; ++i) k[16 * nt + i] = (f2o(acc[i]) & ~127u) | (unsigned)((127 - 32 * nt - 8 * (i >> 2) - (i & 3)) - 4 * h);
            }
            tk_sort16<64, 0>(k); tk_sort16<64, 16>(k); tk_sort16<64, 32>(k); tk_sort16<64, 48>(k);
            tk_merge16<64, 0, 64, 16>(k, k); tk_merge16<64, 32, 64, 48>(k, k); tk_merge16<64, 0, 64, 32>(k, k);
            unsigned pk[16];
#pragma unroll
            for (int i = 0; i < 16; ++i) { top[c][i] = k[i]; pk[i] = partner32_u(k[i], h != 0); }
            tk_merge16<16, 0, 16, 0>(top[c], pk);
        }
        const int b = 0; (void)b;
        float av[16], bv[16];
#pragma unroll
        for (int i = 0; i < 16; ++i) { av[i] = o2f(top[0][i] & ~127u); bv[i] = o2f(top[1][i] & ~127u); }
        LAS int* li = (LAS int*)tr + lane * 32;
#pragma unroll
        for (int i = 0; i < 16; ++i) { li[i] = 127 - (int)(top[0][i] & 127u); li[16 + i] = 127 - (int)(top[1][i] & 127u); }
        unsigned key[64];
        key[0] = (f2o(av[0] + bv[0]) & ~255u) | 255u;
        key[1] = (f2o(av[0] + bv[1]) & ~255u) | 254u;
        key[2] = (f2o(av[0] + bv[2]) & ~255u) | 253u;
        key[3] = (f2o(av[0] + bv[3]) & ~255u) | 252u;
        key[4] = (f2o(av[0] + bv[4]) & ~255u) | 251u;
        key[5] = (f2o(av[0] + bv[5]) & ~255u) | 250u;
        key[6] = (f2o(av[0] + bv[6]) & ~255u) | 249u;
        key[7] = (f2o(av[0] + bv[7]) & ~255u) | 248u;
        key[8] = (f2o(av[0] + bv[8]) & ~255u) | 247u;
        key[9] = (f2o(av[0] + bv[9]) & ~255u) | 246u;
        key[10] = (f2o(av[0] + bv[10]) & ~255u) | 245u;
        key[11] = (f2o(av[0] + bv[11]) & ~255u) | 244u;
        key[12] = (f2o(av[0] + bv[12]) & ~255u) | 243u;
        key[13] = (f2o(av[0] + bv[13]) & ~255u) | 242u;
        key[14] = (f2o(av[0] + bv[14]) & ~255u) | 241u;
        key[15] = (f2o(av[0] + bv[15]) & ~255u) | 240u;
        key[16] = (f2o(av[1] + bv[0]) & ~255u) | 239u;
        key[17] = (f2o(av[1] + bv[1]) & ~255u) | 238u;
        key[18] = (f2o(av[1] + bv[2]) & ~255u) | 237u;
        key[19] = (f2o(av[1] + bv[3]) & ~255u) | 236u;
        key[20] = (f2o(av[1] + bv[4]) & ~255u) | 235u;
        key[21] = (f2o(av[1] + bv[5]) & ~255u) | 234u;
        key[22] = (f2o(av[1] + bv[6]) & ~255u) | 233u;
        key[23] = (f2o(av[1] + bv[7]) & ~255u) | 232u;
        key[24] = (f2o(av[2] + bv[0]) & ~255u) | 223u;
        key[25] = (f2o(av[2] + bv[1]) & ~255u) | 222u;
        key[26] = (f2o(av[2] + bv[2]) & ~255u) | 221u;
        key[27] = (f2o(av[2] + bv[3]) & ~255u) | 220u;
        key[28] = (f2o(av[2] + bv[4]) & ~255u) | 219u;
        key[29] = (f2o(av[3] + bv[0]) & ~255u) | 207u;
        key[30] = (f2o(av[3] + bv[1]) & ~255u) | 206u;
        key[31] = (f2o(av[3] + bv[2]) & ~255u) | 205u;
        key[32] = (f2o(av[3] + bv[3]) & ~255u) | 204u;
        key[33] = (f2o(av[4] + bv[0]) & ~255u) | 191u;
        key[34] = (f2o(av[4] + bv[1]) & ~255u) | 190u;
        key[35] = (f2o(av[4] + bv[2]) & ~255u) | 189u;
        key[36] = (f2o(av[5] + bv[0]) & ~255u) | 175u;
        key[37] = (f2o(av[5] + bv[1]) & ~255u) | 174u;
        key[38] = (f2o(av[6] + bv[0]) & ~255u) | 159u;
        key[39] = (f2o(av[6] + bv[1]) & ~255u) | 158u;
        key[40] = (f2o(av[7] + bv[0]) & ~255u) | 143u;
        key[41] = (f2o(av[7] + bv[1]) & ~255u) | 142u;
        key[42] = (f2o(av[8] + bv[0]) & ~255u) | 127u;
        key[43] = (f2o(av[9] + bv[0]) & ~255u) | 111u;
        key[44] = (f2o(av[10] + bv[0]) & ~255u) | 95u;
        key[45] = (f2o(av[11] + bv[0]) & ~255u) | 79u;
        key[46] = (f2o(av[12] + bv[0]) & ~255u) | 63u;
        key[47] = (f2o(av[13] + bv[0]) & ~255u) | 47u;
        key[48] = (f2o(av[14] + bv[0]) & ~255u) | 31u;
        key[49] = (f2o(av[15] + bv[0]) & ~255u) | 15u;
#pragma unroll
        for (int i = 50; i < 64; ++i) key[i] = 0u;
        tk_sort16<64, 0>(key); tk_sort16<64, 16>(key); tk_sort16<64, 32>(key); tk_sort16<64, 48>(key);
        tk_merge16<64, 0, 64, 16>(key, key); tk_merge16<64, 32, 64, 48>(key, key); tk_merge16<64, 0, 64, 32>(key, key);
        asm volatile("s_waitcnt lgkmcnt(0)" ::: "memory");
        const float s0 = o2f(key[0] & ~255u);
        float ev[16]; int ei[16]; float den = 0.f;
#pragma unroll
        for (int w = 0; w < 16; ++w) {
            const unsigned ij = 255u - (key[w] & 255u);
            ev[w] = __expf(o2f(key[w] & ~255u) - s0); den += ev[w];
            ei[w] = li[ij >> 4] * 128 + li[16 + (ij & 15)];
        }
        const float inv = 1.f / den;
        const size_t ob = ((size_t)t * 8 + hd) * 16;
        if (h == 0) {
#pragma unroll
            for (int q = 0; q < 4; ++q) *(GAS f32x4*)(gate + ob + 4 * q) = (f32x4){ev[4 * q] * inv, ev[4 * q + 1] * inv, ev[4 * q + 2] * inv, ev[4 * q + 3] * inv};
#pragma unroll
            for (int q = 0; q < 2; ++q) { v4u pk; pk.x = (unsigned)ei[8 * q] | ((unsigned)ei[8 * q + 1] << 16); pk.y = (unsigned)ei[8 * q + 2] | ((unsigned)ei[8 * q + 3] << 16); pk.z = (unsigned)ei[8 * q + 4] | ((unsigned)ei[8 * q + 5] << 16); pk.w = (unsigned)ei[8 * q + 6] | ((unsigned)ei[8 * q + 7] << 16);
                *(GAS v4u*)(eidx + ob + 8 * q) = pk; }
        }
        asm volatile("s_waitcnt lgkmcnt(0)" ::: "memory");
    }
}

__device__ __forceinline__ float gelu_erf(float v) { return 0.5f * v * (1.f + erff(v * 0.70710678118654752f)); }
typedef __attribute__((ext_vector_type(2))) float f32x2v;
constexpr int CW_Q2 = 12288;
__device__ __forceinline__ void cvt16(const v4u r, float (&f)[16]) {
    const unsigned w[4] = {r.x, r.y, r.z, r.w};
#pragma unroll
    for (int i = 0; i < 4; ++i) { const f32x2v lo = __builtin_amdgcn_cvt_pk_f32_fp8((int)w[i], false), hi = __builtin_amdgcn_cvt_pk_f32_fp8((int)w[i], true); f[4 * i] = lo.x; f[4 * i + 1] = lo.y; f[4 * i + 2] = hi.x; f[4 * i + 3] = hi.y; }
}
constexpr int PCH = 256, PTW = PCH / 8;
typedef __attribute__((ext_vector_type(4))) int i32x4;
struct PIdx { v4u e[2]; };
struct PTok { v4u r[16]; v4u w[2]; v4u xa, xc; };
__device__ __forceinline__ void peer_idx(PIdx& I, const GAS unsigned short* eidx, int t, int lane) {
    const GAS v4u* ep = (const GAS v4u*)(eidx + (size_t)t * 128 + 16 * (lane >> 3));
    I.e[0] = ep[0]; I.e[1] = ep[1];
}
template <int PHASE> __device__ __forceinline__ void peer_rows(PTok& K, const PIdx& I, const GAS unsigned char* tab, const GAS bf16* wgt, const GAS bf16* xb, int t, int s, int lane) {
    const int g = lane >> 3, j = lane & 7;
    const unsigned ew[8] = {I.e[0].x, I.e[0].y, I.e[0].z, I.e[0].w, I.e[1].x, I.e[1].y, I.e[1].z, I.e[1].w};
#pragma unroll
    for (int i = 0; i < 16; ++i) { const unsigned e = (i & 1) ? (ew[i >> 1] >> 16) : (ew[i >> 1] & 0xffffu); K.r[i] = *(const GAS v4u*)(tab + (size_t)e * 128 + 16 * j); }
    if (PHASE == 0) { const GAS unsigned char* xrow = (const GAS unsigned char*)(xb + (size_t)t * D + s * 128 + 16 * j); K.xa = *(const GAS v4u*)xrow; K.xc = *(const GAS v4u*)(xrow + 16); }
    else { const GAS v4u* wp = (const GAS v4u*)(wgt + (size_t)t * 128 + 16 * g); K.w[0] = wp[0]; K.w[1] = wp[1]; }
}
__device__ __forceinline__ void cvt16p(const v4u r, f32x2v (&f)[8]) {
    const unsigned w[4] = {r.x, r.y, r.z, r.w};
#pragma unroll
    for (int i = 0; i < 4; ++i) { f[2 * i] = __builtin_amdgcn_cvt_pk_f32_fp8((int)w[i], false); f[2 * i + 1] = __builtin_amdgcn_cvt_pk_f32_fp8((int)w[i], true); }
}
__device__ __forceinline__ void peer_u_compute(const PTok& K, LAS float* lpart, int lane) {
    const int g = lane >> 3, j = lane & 7;
    f32x2v xv[8];
    { const unsigned xw[8] = {K.xa.x, K.xa.y, K.xa.z, K.xa.w, K.xc.x, K.xc.y, K.xc.z, K.xc.w};
#pragma unroll
      for (int i = 0; i < 8; ++i) xv[i] = (f32x2v){__uint_as_float(xw[i] << 16), __uint_as_float(xw[i] & 0xffff0000u)}; }
    float res_lo = 0.f, res_hi = 0.f;
#pragma unroll
    for (int i = 0; i < 16; ++i) {
        f32x2v f[8]; cvt16p(K.r[i], f);
        f32x2v a0 = xv[0] * f[0], a1 = xv[1] * f[1];
#pragma unroll
        for (int k = 2; k < 8; k += 2) { a0 = a0 + xv[k] * f[k]; a1 = a1 + xv[k + 1] * f[k + 1]; }
        const f32x2v a = a0 + a1;
        const float d = sum8(a.x + a.y);
        if (i < 8) res_lo = (j == i) ? d : res_lo; else res_hi = (j == i - 8) ? d : res_hi;
    }
    lpart[16 * g + j] = res_lo; lpart[16 * g + 8 + j] = res_hi;
}
__device__ __forceinline__ void peer_v_compute(const PTok& K, LAS float* lout, int lane) {
    const int g = lane >> 3, j = lane & 7;
    f32x2v acc[8];
#pragma unroll
    for (int k = 0; k < 8; ++k) acc[k] = (f32x2v){0.f, 0.f};
#pragma unroll
    for (int i = 0; i < 16; ++i) {
        f32x2v f[8]; cvt16p(K.r[i], f);
        const unsigned wq = (i < 8 ? K.w[0] : K.w[1])[(i >> 1) & 3]; const float wi = __uint_as_float((i & 1) ? (wq & 0xffff0000u) : (wq << 16)); const f32x2v w2 = {wi, wi};
#pragma unroll
        for (int k = 0; k < 8; ++k) acc[k] = acc[k] + w2 * f[k];
    }
    float o[16];
#pragma unroll
    for (int k = 0; k < 8; ++k) {
        float a = acc[k].x, b = acc[k].y;
        a += dpp_f<0x128>(a); b += dpp_f<0x128>(b); a = swap16_add(a, a); b = swap16_add(b, b); o[2 * k] = swap32_add(a, a); o[2 * k + 1] = swap32_add(b, b);
    }
    if (g == 0) {
#pragma unroll
        for (int q = 0; q < 4; ++q) *(LAS f32x4*)(lout + 16 * j + 4 * q) = (f32x4){o[4 * q], o[4 * q + 1], o[4 * q + 2], o[4 * q + 3]};
    }
}
template <int PHASE> __device__ __forceinline__ void ph_peer_sliced(unsigned char* ws, LAS unsigned char* lds, float* xout, int l, int tid, int wave, int lane) {
    unsigned* heads = (unsigned*)(ws + WS_CTL) + CW_Q2 + (l * 2 + PHASE) * 8 * 64;
    volatile LAS unsigned* slot = (volatile LAS unsigned*)(lds + MISC_OFF);
    const GAS unsigned short* eidx = (const GAS unsigned short*)(ws + WS_EIDX); const GAS bf16* wgt = (const GAS bf16*)(ws + WS_WV); GAS bf16* xb = (GAS bf16*)(ws + WS_XB);
    const int myx = (int)(xb_xcc_id() & 7u);
    if (tid == 0) slot[2] = 0xffu;
    int it = 0;
    unsigned avail = 0xffu;
    for (int k = 0; k < 8; ++k) {
        if (k == 1) {
            if (tid < 8) { const unsigned hv = __hip_atomic_load(heads + 64 * ((myx + tid) & 7), __ATOMIC_RELAXED, __HIP_MEMORY_SCOPE_AGENT); if (hv >= (unsigned)(T / PCH)) __hip_atomic_fetch_and((LAS unsigned*)(lds + MISC_OFF) + 2, ~(1u << tid), __ATOMIC_RELAXED, __HIP_MEMORY_SCOPE_WORKGROUP); }
            __syncthreads(); avail = slot[2]; __syncthreads();
        }
        if (!((avail >> k) & 1u)) continue;
        const int s = (myx + k) & 7;
        const GAS unsigned char* tab = (const GAS unsigned char*)(ws + (PHASE == 0 ? WS_UT : WS_VT) + (size_t)l * 16384 * D + (size_t)s * 16384 * 128);
        GAS float* part = (GAS float*)(ws + WS_PART) + (size_t)s * T * 128;
        for (;; ++it) {
            if (tid == 0) slot[it & 1] = __hip_atomic_fetch_add(heads + 64 * s, 1u, __ATOMIC_RELAXED, __HIP_MEMORY_SCOPE_AGENT);
            __syncthreads();
            const int c = (int)slot[it & 1];
            if (c >= T / PCH) { ++it; break; }
            const int t0 = c * PCH + wave * PTW;
            LAS float* stg = (LAS float*)(lds + wave * WSCR);
            PIdx iB, iC; PTok A, B;
            peer_idx(iB, eidx, t0, lane);
            peer_rows<PHASE>(A, iB, tab, wgt, xb, t0, s, lane);
            peer_idx(iB, eidx, t0 + 1, lane);
#pragma unroll 2
            for (int i = 0; i < PTW; ++i) {
                peer_idx(iC, eidx, t0 + (i + 2 < PTW ? i + 2 : PTW - 1), lane);
                peer_rows<PHASE>(B, iB, tab, wgt, xb, t0 + (i + 1 < PTW ? i + 1 : PTW - 1), s, lane);
                if (PHASE == 0) peer_u_compute(A, stg + i * 128, lane); else peer_v_compute(A, stg + i * 128, lane);
                A = B; iB = iC;
            }
            asm volatile("s_waitcnt lgkmcnt(0)" ::: "memory");
            if (PHASE == 0) {
#pragma unroll
                for (int q = 0; q < PTW * 128 / 256; ++q) *(GAS f32x4*)(part + (size_t)t0 * 128 + q * 256 + lane * 4) = *(const LAS f32x4*)(stg + q * 256 + lane * 4);
            } else {
                GAS float* xo = (GAS float*)xout; GAS float* rs1p = (GAS float*)(ws + WS_RS1P); GAS bf16* xbo = xb;
                constexpr int FB = 8;
#pragma unroll 1
                for (int q0 = 0; q0 < PTW / 2; q0 += FB) {
                    u32x2 bw[FB];
#pragma unroll
                    for (int q = 0; q < FB; ++q) { const int tk = 2 * (q0 + q) + (lane >> 5), cq = lane & 31; bw[q] = *(const GAS u32x2*)(xb + (size_t)(t0 + tk) * D + s * 128 + 4 * cq); }
#pragma unroll
                    for (int q = 0; q < FB; ++q) {
                        const int tk = 2 * (q0 + q) + (lane >> 5), cq = lane & 31, t = t0 + tk;
                        const f32x4 av = *(const LAS f32x4*)(stg + tk * 128 + 4 * cq);
                        const f32x4 xv = (f32x4){__uint_as_float(bw[q].x << 16), __uint_as_float(bw[q].x & 0xffff0000u), __uint_as_float(bw[q].y << 16), __uint_as_float(bw[q].y & 0xffff0000u)} + av;
                        if (l == NL - 1) *(GAS f32x4*)(xo + (size_t)t * D + s * 128 + 4 * cq) = xv;
                        else { u32x2 w; w.x = pkbf(xv.x, xv.y); w.y = pkbf(xv.z, xv.w); *(GAS u32x2*)(xbo + (size_t)t * D + s * 128 + 4 * cq) = w; }
                        float s2 = (xv.x * xv.x + xv.y * xv.y) + (xv.z * xv.z + xv.w * xv.w);
                        s2 = sum16(s2); s2 = swap16_add(s2, s2);
                        if (cq == 0) rs1p[(size_t)t * 8 + s] = s2;
                    }
                }
            }
            asm volatile("s_waitcnt lgkmcnt(0)" ::: "memory");
        }
    }
}
__device__ __forceinline__ void ph_peer_w(unsigned char* ws, int l, int gw, int NGW, int lane) {
    const GAS unsigned short* __restrict__ eidx = (const GAS unsigned short*)(ws + WS_EIDX); const GAS float* __restrict__ gate = (const GAS float*)(ws + WS_GATE); const GAS float* __restrict__ part = (const GAS float*)(ws + WS_PART);
    GAS bf16* __restrict__ wv = (GAS bf16*)(ws + WS_WV);
    const GAS float* __restrict__ usc = (const GAS float*)(ws + WS_USC) + l * 16384; const GAS float* __restrict__ vsc = (const GAS float*)(ws + WS_VSC) + l * 16384; const GAS float* __restrict__ xssq = (const GAS float*)(ws + WS_XSSQ);
    for (int t0 = gw; t0 < T; t0 += 4 * NGW) {
        float a[4][2], g[4][2], xs[4]; int e[4][2];
#pragma unroll
        for (int u = 0; u < 4; ++u) {
            const int t = t0 + u * NGW; xs[u] = xssq[(size_t)t * 16 + (lane & 15)];
#pragma unroll
            for (int hh = 0; hh < 2; ++hh) {
                const size_t q = (size_t)t * 128 + 64 * hh + lane;
                e[u][hh] = (int)eidx[q]; g[u][hh] = gate[q];
                float acc = 0.f;
#pragma unroll
                for (int s = 0; s < 8; ++s) acc += part[(size_t)s * T * 128 + q];
                a[u][hh] = acc;
            }
        }
#pragma unroll
        for (int u = 0; u < 4; ++u) {
            const int t = t0 + u * NGW;
            const float r2 = rsqrtf(sum16(xs[u]) * (1.f / 1024.f) + EPS);
#pragma unroll
            for (int hh = 0; hh < 2; ++hh) wv[(size_t)t * 128 + 64 * hh + lane] = (bf16)(pkbf(g[u][hh] * gelu_erf(a[u][hh] * (r2 * usc[e[u][hh]])) * vsc[e[u][hh]], 0.f) & 0xffffu);
        }
    }
}

constexpr int NPH_L = 9, NPHASES = 1 + NL * NPH_L;
__global__ void __launch_bounds__(NWAVES * 64, 2) mega(Args a) {
    extern __shared__ __attribute__((aligned(16))) unsigned char lds_raw[];
    {
        LAS unsigned char* lds0 = (LAS unsigned char*)lds_raw;
        for (int u = threadIdx.x; u < (LDS_BYTES - LDSCTL_OFF) / 4; u += NWAVES * 64) ((LAS unsigned*)(lds0 + LDSCTL_OFF))[u] = 0u;
        __syncthreads();
    }
    int wave0 = __builtin_amdgcn_readfirstlane((int)threadIdx.x >> 6); asm volatile("" : "+s"(wave0));
    int ph_lo = a.ph_lo, ph_hi = a.ph_hi; asm volatile("" : "+s"(ph_lo), "+s"(ph_hi));
    const bool multi = (ph_hi - ph_lo) > 1;
    XcdBarrier bar; bar.bar = (unsigned*)(a.ws + WS_CTL) + CW_BAR + a.li * XCD_BAR_WORDS; bar.x = 0; bar.st = nullptr;
    if (multi) bar = xcd_barrier_post((unsigned*)(a.ws + WS_CTL) + CW_BAR + a.li * XCD_BAR_WORDS, (volatile LAS unsigned*)((LAS unsigned char*)lds_raw + MISC_OFF) + 8);

    for (int ph = ph_lo; ph < ph_hi; ++ph) {
        unsigned char* ws = a.ws; asm volatile("" : "+s"(ws));
        int G = (int)gridDim.x; asm volatile("" : "+s"(G));
        int bx = (int)blockIdx.x; asm volatile("" : "+s"(bx));
        int tid; asm volatile("v_mbcnt_lo_u32_b32 %0, -1, 0\n\tv_mbcnt_hi_u32_b32 %0, -1, %0" : "=v"(tid)); tid |= wave0 << 6;
        LAS unsigned char* lds = (LAS unsigned char*)lds_raw;
        const int lane = tid & 63, wave = __builtin_amdgcn_readfirstlane(tid >> 6);
        const int vcu = (G % 8 == 0) ? (bx % 8) * (G / 8) + bx / 8 : bx;
        const int gw = vcu * NWAVES + wave, NGW = G * NWAVES;
        if (ph == 0) {
            ph_prologue(a, ws, lds, gw, NGW, wave, lane);
        } else {
            const int l = (ph - 1) / NPH_L, j = (ph - 1) % NPH_L;
            if (j == 0) {
              {
                { pg8::Gemm g{(const pg8::bf16_t*)(ws + WS_XB), (const pg8::bf16_t*)(ws + WS_WIN) + (size_t)l * NPROJ * D, T, NPROJ, D};
                  pg8::StaticOrder So; So.init(T, NPROJ, G, bx);
                  pg8::EpiInProj E{(pg8::bf16_t*)(ws + WS_PROJ), NPROJ, (const float*)(ws + WS_RS1P), (float*)(ws + WS_DTF), AIN(I_DTBIAS) + l * 6, 8};
                  pg8::gemm_phase<pg8::EpiInProj, pg8::StaticOrder, true, true>(lds, g, So, E, tid); }
                { const int nfull = ((T / 256) * (NPROJ / 256)) % G;
                    if (nfull == 0) convert_tables(a, ws, l, gw, NGW, lane); else if (bx >= nfull + 8) convert_tables(a, ws, l, (bx - nfull - 8) * NWAVES + wave, (G - nfull - 8) * NWAVES, lane); }
                { pg8::Gemm g{(const pg8::bf16_t*)(ws + WS_MEMB), (const pg8::bf16_t*)(ws + WS_WMEM) + (size_t)l * 512 * D, MROWS, 512, D};
                  pg8::StaticOrder So; So.init(MROWS, 512, G, (bx + G - (((T / 256) * (NPROJ / 256)) % G)) % G);
                  pg8::EpiInProj E{(pg8::bf16_t*)(ws + WS_MEMKV), 512, (const float*)(ws + WS_RSM), nullptr, nullptr, 0};
                  pg8::gemm_phase<pg8::EpiInProj, pg8::StaticOrder, true, true>(lds, g, So, E, tid); }
              }
            } else if (j == 1) {
                ph_mix(a, ws, lds, l, tid, wave, lane);
            } else if (j == 2) {
                ph_ssd_scan(ws, bx, G, tid);
            } else if (j == 3) {
                for (int u = vcu; u < 256; u += G) ssd_finish_unit(a, ws, lds, l, u, tid, wave, lane);
            } else if (j == 4) {
                pg8::Gemm g{(const pg8::bf16_t*)(ws + WS_YCAT), (const pg8::bf16_t*)(ws + WS_WOUT) + (size_t)l * D * D, T, D, D};
                pg8::StaticOrder So; So.init(T, D, G, bx);
                LAS float* gtab = (LAS float*)(lds + GTAB_OFF);
                { pg8::Unit u0; if (So.next(0, u0) && tid < 256) { float r0, r1, r2; pg8::group_rstd((const float*)(ws + WS_YSSQ), u0.pm * 256 + tid, r0, r1, r2); gtab[tid] = r0 / r1; gtab[256 + tid] = r1 / r2; gtab[512 + tid] = r2; } }
                __syncthreads();
                pg8::EpiOut E{(pg8::bf16_t*)(ws + WS_XB), (float*)(ws + WS_XSSQ), gtab};
                pg8::gemm_phase<pg8::EpiOut, pg8::StaticOrder, true, true>(lds, g, So, E, tid);
            } else if (j == 5) {
                pg8::Gemm g{(const pg8::bf16_t*)(ws + WS_XB), (const pg8::bf16_t*)(ws + WS_WSC) + (size_t)l * D * D, T, D, D};
                pg8::StaticOrder So; So.init(T, D, G, bx);
                pg8::EpiInProj E{(pg8::bf16_t*)(ws + WS_YCAT), D, (const float*)(ws + WS_XSSQ), nullptr, nullptr, 16};
                pg8::gemm_phase<pg8::EpiInProj, pg8::StaticOrder, true, true>(lds, g, So, E, tid);
                asm volatile("s_waitcnt vmcnt(0)" ::: "memory"); __syncthreads();
                if (tid == 0) __builtin_amdgcn_fence(__ATOMIC_ACQUIRE, "agent");
                asm volatile("s_waitcnt vmcnt(0)" ::: "memory"); __syncthreads();
                { pg8::Unit u0; if (So.next(0, u0)) ph_topk(ws, lds, l, u0.pm, u0.pn, wave, lane); }
            } else if (j == 6) {
                ph_peer_sliced<0>(ws, lds, a.out, l, tid, wave, lane);
            } else if (j == 7) {
                ph_peer_w(ws, l, gw, NGW, lane);
            } else if (j == 8) {
                ph_peer_sliced<1>(ws, lds, a.out, l, tid, wave, lane);
            }
        }
        if (ph + 1 < ph_hi) { XcdBarrier b2 = bar; { unsigned* p = b2.bar; unsigned x = b2.x; asm volatile("" : "+s"(p), "+s"(x)); b2.bar = p; b2.x = x; } xcd_barrier(b2, tid);
        }
    }
}

#ifndef MK_ONE_LAUNCH
#define MK_ONE_LAUNCH 1
#endif
extern "C" void kernel_launch(void* const* d_in, const int* in_sizes, int n_in, void* d_out, int out_size, void* d_ws, size_t ws_size, hipStream_t stream) {
    static int grid = 0;
    if (grid == 0) {
        if (n_in != 22 || out_size != T * D || ws_size < WS_END) { fprintf(stderr, "kernel_launch: unexpected problem (n_in %d out %d ws %zu)\n", n_in, out_size, ws_size); grid = -1; return; }
        int dev = 0, cus = 0, per_cu = 0;
        if (hipGetDevice(&dev) != hipSuccess || hipDeviceGetAttribute(&cus, hipDeviceAttributeMultiprocessorCount, dev) != hipSuccess) { grid = -1; return; }
        if (hipFuncSetAttribute((const void*)mega, hipFuncAttributeMaxDynamicSharedMemorySize, LDS_BYTES) != hipSuccess) { fprintf(stderr, "kernel_launch: hipFuncSetAttribute failed\n"); grid = -1; return; }
        if (hipOccupancyMaxActiveBlocksPerMultiprocessor(&per_cu, (const void*)mega, NWAVES * 64, LDS_BYTES) != hipSuccess || per_cu < 1) { fprintf(stderr, "kernel_launch: occupancy query says %d\n", per_cu); (void)hipGetLastError(); per_cu = 1; }
        if (cus != 256) { fprintf(stderr, "kernel_launch: built for a 256-CU device (one 256x256 tile per workgroup in the output-projection / query phases); this device reports %d CUs\n", cus); grid = -1; return; }
        grid = cus;
    }
    if (grid < 0) return;
    (void)hipMemsetAsync((char*)d_ws + WS_CTL, 0, CTL_ZERO_BYTES, stream);
    Args a{};
    for (int i = 0; i < 22; ++i) a.in[i] = (const float*)d_in[i];
    a.out = (float*)d_out; a.ws = (unsigned char*)d_ws;
#if MK_ONE_LAUNCH
    a.ph_lo = 0; a.ph_hi = NPHASES; a.li = 0;
    hipLaunchKernelGGL(mega, dim3(grid), dim3(NWAVES * 64), LDS_BYTES, stream, a);
#else
    for (int ph = 0; ph < NPHASES; ++ph) { a.ph_lo = ph; a.ph_hi = ph + 1; a.li = 0; hipLaunchKernelGGL(mega, dim3(grid), dim3(NWAVES * 64), LDS_BYTES, stream, a); }
#endif
}
```

```cpp
#include <hip/hip_runtime.h>
#include <cstdio>
#include <cstdint>
#include <cmath>
namespace pg8 {
#define PG8_LAS __attribute__((address_space(3)))
typedef unsigned short bf16_t;
typedef short bf16x8 __attribute__((ext_vector_type(8)));
typedef float f32x4 __attribute__((ext_vector_type(4)));
typedef unsigned u32x4 __attribute__((ext_vector_type(4)));
constexpr int BM = 256, BK = 64, HALF = 128, HTB = HALF * BK * 2  , STAGE_BYTES = 8 * HTB, NXCD = 8, WGM = 8;

__host__ __device__ __forceinline__ int lds_byte(int r, int c) { const int st = (r >> 4) * 2 + (c >> 5), rr = r & 15, cc = c & 31, ob = rr * 64 + cc * 2; return st * 1024 + (ob ^ (((ob >> 9) & 1) << 5)); }
__host__ __device__ __forceinline__ void stage_rc(int b, int& R, int& C) { const int st = b / 1024, sb = b % 1024, swz = sb ^ (((sb >> 9) & 1) << 5); R = (st >> 1) * 16 + swz / 64; C = (st & 1) * 32 + (swz % 64) / 2; }
__host__ __device__ __forceinline__ int perm32(int rho) { const int n = rho >> 4, i = rho & 15; return 8 * (i >> 2) + 4 * n + (i & 3); }

struct Unit { int pm, pn; };
struct Gemm { const bf16_t* A; const bf16_t* Bt; int M, N, K; };

struct StaticOrder {
    int nM, nN, nwg, G, c;
    __host__ __device__ void init(int M, int N, int G_, int c_) { nM = M / BM; nN = N / BM; nwg = nM * nN; G = G_; c = c_; }
    __host__ __device__ bool next(int i, Unit& u) const {
        const long L = (long)i * G + c; if (L >= nwg) return false;
        int wgid = (int)L; { const int q = nwg / NXCD, r = nwg % NXCD, xcd = wgid % NXCD, off = wgid / NXCD; wgid = (xcd < r ? xcd * (q + 1) : r * (q + 1) + (xcd - r) * q) + off; }
        const int nig = WGM * nN, gid = wgid / nig, fm = gid * WGM, gsz = (nM - fm) < WGM ? (nM - fm) : WGM;
        u.pm = fm + ((wgid % nig) % gsz); u.pn = (wgid % nig) / gsz; return true;
    }
    __device__ __forceinline__ void a_ready(const Unit&) const {}
    __device__ __forceinline__ void done(const Unit&) const {}
};

typedef __attribute__((ext_vector_type(2))) __bf16 bf16x2_cv; typedef __attribute__((ext_vector_type(2))) float f32x2_cv;
__device__ __forceinline__ unsigned cvt_pk_bf16(float lo, float hi) { const f32x2_cv v = {lo, hi}; return __builtin_bit_cast(unsigned, __builtin_convertvector(v, bf16x2_cv)); }
template <class Epi, class Sched, bool ALIGN_EPI = false, bool SP2 = false>
__device__ __forceinline__ void gemm_phase(PG8_LAS unsigned char* lds, const Gemm g, const Sched& S, const Epi& E, const int tid_in) {
    int tid_ = tid_in; asm volatile("" : "+v"(tid_));
    const int tid = tid_, wid = __builtin_amdgcn_readfirstlane(tid >> 6), lane = tid & 63, wr = wid >> 2, wc = wid & 3, fr = lane & 15, fq = lane >> 4;
    const int K = g.K, nt = K / BK;
    unsigned voffA[2], voffB[2];
#pragma unroll
    for (int i = 0; i < 2; ++i) { int R, C; stage_rc(tid * 16 + i * 8192, R, C); const int Rb = Epi::PERM ? ((R & ~31) + perm32(R & 31)) : R;
        voffA[i] = (unsigned)(R * K + C) * 2u; voffB[i] = (unsigned)(Rb * K + C) * 2u; }
    const size_t kstep = (size_t)(BK * 2);
    const size_t hstep = (size_t)HALF * K * 2;
    const size_t tstep = 2 * hstep;
    const unsigned ldsw = (unsigned)wid * 1024u;
    const int aoff = lds_byte(wr * 64 + fr, fq * 8), boff = lds_byte(wc * 32 + fr, fq * 8);
#define PG8_SA(b, h) (((b) * 2 + (h)) * HTB)
#define PG8_SB(b, h) ((4 + (b) * 2 + (h)) * HTB)
#define PG8_STAGE(bufoff, gbase, voff) do { _Pragma("unroll") for (int _i = 0; _i < 2; ++_i) \
        __builtin_amdgcn_global_load_lds((const unsigned*)((const char*)(gbase) + (voff)[_i]), (PG8_LAS unsigned*)(lds + (bufoff) + ldsw + _i * 8192), 16, 0, 0); } while (0)
#define PG8_LDA(dst, b, h) do { _Pragma("unroll") for (int m = 0; m < 4; ++m) _Pragma("unroll") for (int k = 0; k < 2; ++k) dst[m][k] = *(const PG8_LAS bf16x8*)(lds + PG8_SA(b, h) + aoff + m * 2048 + k * 1024); } while (0)
#define PG8_LDB(dst, b, h) do { _Pragma("unroll") for (int n = 0; n < 2; ++n) _Pragma("unroll") for (int k = 0; k < 2; ++k) dst[n][k] = *(const PG8_LAS bf16x8*)(lds + PG8_SB(b, h) + boff + n * 2048 + k * 1024); } while (0)
#define PG8_MMA(ai, bj, At, Bt) do { __builtin_amdgcn_s_setprio(1); _Pragma("unroll") for (int m = 0; m < 4; ++m) _Pragma("unroll") for (int n = 0; n < 2; ++n) _Pragma("unroll") for (int k = 0; k < 2; ++k) \
        acc[ai][bj][m][n] = __builtin_amdgcn_mfma_f32_16x16x32_bf16(Bt[n][k], At[m][k], acc[ai][bj][m][n], 0, 0, 0); __builtin_amdgcn_s_setprio(0); } while (0)
#define PG8_WAIT_V(n) asm volatile("s_waitcnt vmcnt(" #n ")" ::: "memory")
#define PG8_WAIT_L(n) asm volatile("s_waitcnt lgkmcnt(" #n ")" ::: "memory")
#define PG8_BAR __builtin_amdgcn_s_barrier()
#define PG8_SCHED __builtin_amdgcn_sched_barrier(0)
    Unit cur, nxt; int ui = 0;
    if (!S.next(0, cur)) return;
    f32x4 acc[2][2][4][2];
#pragma unroll
    for (int a = 0; a < 2; ++a)
#pragma unroll
        for (int b = 0; b < 2; ++b)
#pragma unroll
            for (int m = 0; m < 4; ++m)
#pragma unroll
                for (int n = 0; n < 2; ++n) acc[a][b][m][n] = (f32x4){0.f, 0.f, 0.f, 0.f};
    bf16x8 At[4][2], B0[2][2], B1[2][2];
    const char* cA = (const char*)g.A + (size_t)cur.pm * tstep; const char* cB = (const char*)g.Bt + (size_t)cur.pn * tstep;
    S.a_ready(cur);
    if constexpr (SP2) {
        PG8_STAGE(PG8_SB(0, 0), cB, voffB); PG8_STAGE(PG8_SB(0, 1), cB + hstep, voffB); PG8_STAGE(PG8_SA(0, 0), cA, voffA); PG8_STAGE(PG8_SA(0, 1), cA + hstep, voffA);
        if (wr == 1) PG8_BAR;
        PG8_WAIT_V(2); PG8_BAR;
        PG8_STAGE(PG8_SB(1, 0), cB + kstep, voffB); PG8_STAGE(PG8_SA(1, 0), cA + kstep, voffA); PG8_STAGE(PG8_SB(1, 1), cB + hstep + kstep, voffB);
        PG8_WAIT_V(6); PG8_BAR;
    } else {
        PG8_STAGE(PG8_SB(0, 0), cB, voffB); PG8_STAGE(PG8_SA(0, 0), cA, voffA); PG8_STAGE(PG8_SB(0, 1), cB + hstep, voffB); PG8_STAGE(PG8_SA(0, 1), cA + hstep, voffA);
        if (wr == 1) PG8_BAR;
        PG8_WAIT_V(4); PG8_BAR;
        PG8_STAGE(PG8_SB(1, 0), cB + kstep, voffB); PG8_STAGE(PG8_SA(1, 0), cA + kstep, voffA); PG8_STAGE(PG8_SB(1, 1), cB + hstep + kstep, voffB);
        PG8_WAIT_V(6); PG8_BAR;
    }
    for (;;) {
        const bool has_next = S.next(ui + 1, nxt);
        const char* nA = has_next ? (const char*)g.A + (size_t)nxt.pm * tstep : cA; const char* nB = has_next ? (const char*)g.Bt + (size_t)nxt.pn * tstep : cB;
        for (int t = 0; t < nt; t += 2) {
            const bool last = (t == nt - 2);
            const char* a1 = cA + (size_t)(t + 1) * kstep;
            const char* a2 = last ? nA : cA + (size_t)(t + 2) * kstep; const char* b2 = last ? nB : cB + (size_t)(t + 2) * kstep;
            const char* a3 = a2 + kstep; const char* b3 = b2 + kstep;
            if (last && has_next) S.a_ready(nxt);
            if constexpr (Epi::KHOOK) E.khook(acc, cur, t, wr, fr);
            if constexpr (SP2) {
            PG8_LDB(B0, 0, 0); PG8_LDB(B1, 0, 1); PG8_SCHED; PG8_LDA(At, 0, 0); PG8_STAGE(PG8_SA(1, 1), a1 + hstep, voffA);
            PG8_WAIT_V(8); PG8_WAIT_L(0); PG8_BAR; PG8_MMA(0, 0, At, B0); PG8_MMA(0, 1, At, B1); PG8_BAR; PG8_SCHED;
            PG8_LDA(At, 0, 1); PG8_STAGE(PG8_SB(0, 0), b2, voffB); PG8_STAGE(PG8_SB(0, 1), b2 + hstep, voffB); PG8_STAGE(PG8_SA(0, 0), a2, voffA);
            PG8_WAIT_V(8); PG8_WAIT_L(0); PG8_BAR; PG8_MMA(1, 0, At, B0); PG8_MMA(1, 1, At, B1); PG8_BAR; PG8_SCHED;
            PG8_LDB(B0, 1, 0); PG8_LDB(B1, 1, 1); PG8_SCHED; PG8_LDA(At, 1, 0); PG8_STAGE(PG8_SA(0, 1), a2 + hstep, voffA);
            PG8_WAIT_V(8); PG8_WAIT_L(0); PG8_BAR; PG8_MMA(0, 0, At, B0); PG8_MMA(0, 1, At, B1); PG8_BAR; PG8_SCHED;
            PG8_LDA(At, 1, 1); PG8_STAGE(PG8_SB(1, 0), b3, voffB); PG8_STAGE(PG8_SB(1, 1), b3 + hstep, voffB); PG8_STAGE(PG8_SA(1, 0), a3, voffA);
            PG8_WAIT_V(8); PG8_WAIT_L(0); PG8_BAR; PG8_MMA(1, 0, At, B0); PG8_MMA(1, 1, At, B1); PG8_BAR; PG8_SCHED;
            } else {
            PG8_LDB(B0, 0, 0); PG8_SCHED; PG8_LDA(At, 0, 0); PG8_STAGE(PG8_SA(1, 1), a1 + hstep, voffA);
            PG8_WAIT_L(8); PG8_BAR; PG8_WAIT_L(0); PG8_MMA(0, 0, At, B0); PG8_BAR; PG8_SCHED;
            PG8_LDB(B1, 0, 1); PG8_STAGE(PG8_SB(0, 0), b2, voffB);
            PG8_BAR; PG8_WAIT_L(0); PG8_MMA(0, 1, At, B1); PG8_BAR;
            PG8_LDA(At, 0, 1); PG8_STAGE(PG8_SA(0, 0), a2, voffA);
            PG8_BAR; PG8_WAIT_L(0); PG8_MMA(1, 0, At, B0); PG8_BAR; PG8_SCHED;
            PG8_STAGE(PG8_SB(0, 1), b2 + hstep, voffB);
            PG8_WAIT_V(6); PG8_BAR; PG8_MMA(1, 1, At, B1); PG8_BAR;
            PG8_LDB(B0, 1, 0); PG8_SCHED; PG8_LDA(At, 1, 0); PG8_STAGE(PG8_SA(0, 1), a2 + hstep, voffA);
            PG8_WAIT_L(8); PG8_BAR; PG8_WAIT_L(0); PG8_MMA(0, 0, At, B0); PG8_BAR; PG8_SCHED;
            PG8_LDB(B1, 1, 1); PG8_STAGE(PG8_SB(1, 0), b3, voffB);
            PG8_BAR; PG8_WAIT_L(0); PG8_MMA(0, 1, At, B1); PG8_BAR;
            PG8_LDA(At, 1, 1); PG8_STAGE(PG8_SA(1, 0), a3, voffA);
            PG8_BAR; PG8_WAIT_L(0); PG8_MMA(1, 0, At, B0); PG8_BAR; PG8_SCHED;
            PG8_STAGE(PG8_SB(1, 1), b3 + hstep, voffB);
            PG8_WAIT_V(6); PG8_BAR; PG8_MMA(1, 1, At, B1); PG8_BAR;
            }
        }
        if constexpr (ALIGN_EPI) { if (wr == 0) PG8_BAR; }
        if constexpr (!Epi::AFTER_DRAIN) { E(acc, cur, wr, wc, fr, fq); S.done(cur); }
        if (!has_next) break;
#pragma unroll
        for (int a = 0; a < 2; ++a)
#pragma unroll
            for (int b = 0; b < 2; ++b)
#pragma unroll
                for (int m = 0; m < 4; ++m)
#pragma unroll
                    for (int n = 0; n < 2; ++n) acc[a][b][m][n] = (f32x4){0.f, 0.f, 0.f, 0.f};
        cur = nxt; cA = nA; cB = nB; ++ui;
        if constexpr (ALIGN_EPI) { if (wr == 1) PG8_BAR; }
    }
    PG8_WAIT_V(0);
    if constexpr (!ALIGN_EPI) { if (wr == 0) PG8_BAR; }
    PG8_BAR;
    if constexpr (Epi::AFTER_DRAIN) { E.fused(acc, cur, wr, wc, fr, fq, lds, wid, lane); S.done(cur); }
#undef PG8_SA
#undef PG8_SB
#undef PG8_STAGE
#undef PG8_LDA
#undef PG8_LDB
#undef PG8_MMA
#undef PG8_WAIT_V
#undef PG8_WAIT_L
#undef PG8_BAR
#undef PG8_SCHED
}
}
#define GAS __attribute__((address_space(1)))
#define LAS __attribute__((address_space(3)))
typedef unsigned short bf16;
typedef unsigned v4u __attribute__((ext_vector_type(4)));
typedef float f32x4 __attribute__((ext_vector_type(4)));
typedef short bf16x8 __attribute__((ext_vector_type(8)));
typedef GAS unsigned gu32;
typedef GAS unsigned long long gu64;
#define RLX_AGENT __ATOMIC_RELAXED, __HIP_MEMORY_SCOPE_AGENT
#define LDS_WAIT() asm volatile("s_waitcnt lgkmcnt(0)" ::: "memory")
#define VM_WAIT() asm volatile("s_waitcnt vmcnt(0)" ::: "memory")
__device__ __forceinline__ unsigned long long rt() { return __builtin_amdgcn_s_memrealtime(); }
__device__ __forceinline__ unsigned f2bf(float f) { unsigned u = __builtin_bit_cast(unsigned, f); return (u + 0x7fffu + ((u >> 16) & 1u)) >> 16; }
__device__ __forceinline__ unsigned pk2(float lo, float hi) { return f2bf(lo) | (f2bf(hi) << 16); }

#define XB_TMO      128
#define XB_XCNT(j)  (256  + 64 * (j))
#define XB_XSUB(j)  (1280 + 64 * (j))
#define XB_XGEN(j)  (2304 + 64 * (j))
#define XB_TOP      3328
#define XB_TOPGEN   3392
#define XCD_BAR_WORDS 3456
#define XB_SPIN_CAP (1u << 18)

__device__ __forceinline__ unsigned xb_ld(unsigned* p)              { return __hip_atomic_load(p, __ATOMIC_RELAXED, __HIP_MEMORY_SCOPE_AGENT); }
__device__ __forceinline__ unsigned xb_add(unsigned* p, unsigned v) { return __hip_atomic_fetch_add(p, v, __ATOMIC_RELAXED, __HIP_MEMORY_SCOPE_AGENT); }
__device__ __forceinline__ unsigned xb_xcc_id() { return (unsigned)__builtin_amdgcn_s_getreg((3 << 11) | 20) & 0xFu; }
#define XB_SPIN(cond, bar) do { unsigned _sp = 0; while (cond) { __builtin_amdgcn_s_sleep(1); \
    if ((++_sp & 255u) == 0u) { if (xb_ld(&(bar)[XB_TMO])) break; if (_sp > XB_SPIN_CAP) { atomicAdd(&(bar)[XB_TMO], 1u); break; } } } } while (0)

struct XcdBarrier {
    unsigned* bar; unsigned x;
    volatile LAS unsigned* st;
};

__device__ __forceinline__ XcdBarrier xcd_barrier_post(unsigned* bar, volatile LAS unsigned* st) {
    XcdBarrier b; b.bar = bar; b.x = xb_xcc_id(); b.st = st;
    if (threadIdx.x == 0) (void)xb_add(&bar[XB_XCNT(b.x)], 1u);
    return b;
}
__device__ __forceinline__ void xcd_barrier_complete(unsigned* bar, unsigned x, unsigned& nloc, unsigned& nx) {
    const unsigned G = gridDim.x * gridDim.y * gridDim.z;
    unsigned sum, cnt, mine, sp = 0u;
    for (;;) {
        sum = 0u; cnt = 0u; mine = 0u;
#pragma unroll
        for (unsigned j = 0; j < 16; ++j) { const unsigned c = xb_ld(&bar[XB_XCNT(j)]); sum += c; cnt += (c > 0u) ? 1u : 0u; mine = (j == x) ? c : mine; }
        if (sum == G) break;
        __builtin_amdgcn_s_sleep(1);
        if ((++sp & 255u) == 0u) { if (xb_ld(&bar[XB_TMO])) break; if (sp > XB_SPIN_CAP) { atomicAdd(&bar[XB_TMO], 1u); break; } }
    }
    nloc = mine > 0u ? mine : 1u; nx = cnt > 0u ? cnt : 1u;
}

__device__ __forceinline__ void xcd_barrier(const XcdBarrier& b, const int tid) {
    asm volatile("s_waitcnt vmcnt(0)" ::: "memory");
    __syncthreads();
    if (tid == 0) {
        unsigned* bar = b.bar;
        __builtin_amdgcn_s_waitcnt(0);
        unsigned nloc = b.st[0], nx = b.st[1];
        if (nloc == 0u) { xcd_barrier_complete(bar, b.x, nloc, nx); b.st[0] = nloc; b.st[1] = nx; }
        const unsigned old = xb_add(&bar[XB_XSUB(b.x)], 1u);
        const unsigned gen = old / nloc;
        if (old + 1u == (gen + 1u) * nloc) {
            __builtin_amdgcn_fence(__ATOMIC_RELEASE, "agent");
            asm volatile("s_waitcnt vmcnt(0)" ::: "memory");
            const unsigned og = xb_add(&bar[XB_TOP], 1u);
            const unsigned tg = og / nx;
            if (og + 1u == (tg + 1u) * nx) xb_add(&bar[XB_TOPGEN], 1u);
            else XB_SPIN(xb_ld(&bar[XB_TOPGEN]) == tg, bar);
            __builtin_amdgcn_fence(__ATOMIC_ACQUIRE, "agent");
            xb_add(&bar[XB_XGEN(b.x)], 1u);
            asm volatile("s_waitcnt vmcnt(0)" ::: "memory");
        } else {
            XB_SPIN(xb_ld(&bar[XB_XGEN(b.x)]) == gen, bar);
            __builtin_amdgcn_fence(__ATOMIC_ACQUIRE, "agent");
            asm volatile("s_waitcnt vmcnt(0)" ::: "memory");
        }
    }
    __syncthreads();
}

constexpr int NWAVES = 8;
constexpr int D = 1024, NB = 4, S = 4096, T = NB * S, NL = 2, NMEM = 256, MROWS = NB * NMEM;
constexpr int DIN = 2438, NPROJ = 2560;
constexpr int PC_Z = 0, PC_XBC = 384, PC_QSB = 1024, PC_KSB = 1408, PC_VSB = 1792, PC_QMEM = 2176, PC_DT = 2432;
constexpr int CONV_CH = 640;
constexpr float EPS = 1e-6f;

constexpr int RING_BYTES = 131072;
constexpr int WSCR = 17408;
constexpr int LDSCTL_OFF = 8 * WSCR, MISC_OFF = LDSCTL_OFF + 320;
constexpr int LDS_BYTES = 147456;
constexpr int GTAB_OFF = LDSCTL_OFF + 1024;

constexpr size_t MiB = 1u << 20;
constexpr size_t WS_CTL = 0, CTL_ZERO_BYTES = 64 * 1024;
constexpr size_t WS_WIN = 2 * MiB;
constexpr size_t WS_WMEM = 12 * MiB;
constexpr size_t WS_WOUT = 14 * MiB;
constexpr size_t WS_WSC = 18 * MiB;
constexpr size_t WS_KB = 22 * MiB;
constexpr size_t WS_MEMB = 26 * MiB;
constexpr size_t WS_RSM = 28 * MiB;
constexpr size_t WS_RS1 = WS_RSM + 64 * 1024;
constexpr size_t WS_DTF = WS_RS1 + 64 * 1024;
constexpr size_t WS_XSSQ = 29 * MiB;
constexpr size_t WS_YSSQ = 30 * MiB;
constexpr size_t WS_MEMKV = 31 * MiB;
constexpr size_t WS_RS1P = 32 * MiB;
constexpr size_t WS_PART = 178 * MiB;
constexpr size_t WS_XB = 34 * MiB;
constexpr size_t WS_YCAT = 66 * MiB;
constexpr size_t WS_PROJ = 98 * MiB;
constexpr size_t WS_SCORES = 178 * MiB;
constexpr size_t WS_YPART = WS_SCORES;
constexpr size_t WS_XCONV = WS_SCORES + 24 * MiB;
constexpr size_t WS_CMG = WS_SCORES + 36 * MiB;
constexpr size_t WS_ACSG = WS_SCORES + 40 * MiB;
constexpr size_t WS_HS = WS_SCORES + 41 * MiB;
constexpr size_t WS_CD = WS_SCORES + 53 * MiB;
constexpr size_t WS_EIDX = 306 * MiB;
constexpr size_t WS_GATE = 314 * MiB;
constexpr size_t WS_WV = 322 * MiB;
constexpr size_t WS_STOP = 330 * MiB;
constexpr size_t WS_ITOP = 338 * MiB;
constexpr size_t WS_UT = 354 * MiB;
constexpr size_t WS_USC = 386 * MiB;
constexpr size_t WS_VT = 418 * MiB;
constexpr size_t WS_VSC = 450 * MiB;
constexpr size_t WS_END = 482 * MiB;
constexpr int CW_BAR = 4096;

__device__ __forceinline__ float bf2f(bf16 v) { return __uint_as_float((unsigned)v << 16); }
__device__ __forceinline__ unsigned pkbf(float lo, float hi) { return pg8::cvt_pk_bf16(lo, hi); }
template <int CTRL> __device__ __forceinline__ float dpp_f(float v) { return __uint_as_float((unsigned)__builtin_amdgcn_update_dpp(0, (int)__float_as_uint(v), CTRL, 0xf, 0xf, true)); }
__device__ __forceinline__ float swap32_add(float a, float b) {
    const auto r = __builtin_amdgcn_permlane32_swap(__float_as_uint(a), __float_as_uint(b), false, false); return __uint_as_float(r[0]) + __uint_as_float(r[1]); }
__device__ __forceinline__ float swap16_add(float a, float b) {
    const auto r = __builtin_amdgcn_permlane16_swap(__float_as_uint(a), __float_as_uint(b), false, false); return __uint_as_float(r[0]) + __uint_as_float(r[1]); }
__device__ __forceinline__ float swap32_max(float a) { const auto r = __builtin_amdgcn_permlane32_swap(__float_as_uint(a), __float_as_uint(a), false, false); return fmaxf(__uint_as_float(r[0]), __uint_as_float(r[1])); }
__device__ __forceinline__ float swap16_max(float a) { const auto r = __builtin_amdgcn_permlane16_swap(__float_as_uint(a), __float_as_uint(a), false, false); return fmaxf(__uint_as_float(r[0]), __uint_as_float(r[1])); }
__device__ __forceinline__ float partner32(float a, bool hi) { const auto r = __builtin_amdgcn_permlane32_swap(__float_as_uint(a), __float_as_uint(a), false, false); return __uint_as_float(hi ? r[0] : r[1]); }
__device__ __forceinline__ float sum8(float v) { v += dpp_f<0xB1>(v); v += dpp_f<0x4E>(v); v += dpp_f<0x141>(v); return v; }
__device__ __forceinline__ float sum16(float v) { v = sum8(v); v += dpp_f<0x140>(v); return v; }
__device__ __forceinline__ float wave_sum(float v) { v = sum16(v); v = swap16_add(v, v); return swap32_add(v, v); }
__device__ __forceinline__ float wave_max(float v) { v = fmaxf(v, dpp_f<0xB1>(v)); v = fmaxf(v, dpp_f<0x4E>(v)); v = fmaxf(v, dpp_f<0x141>(v)); v = fmaxf(v, dpp_f<0x140>(v)); v = swap16_max(v); return swap32_max(v); }
__device__ __forceinline__ float bperm_f(float v, int src_lane) { return __uint_as_float((unsigned)__builtin_amdgcn_ds_bpermute(src_lane << 2, (int)__float_as_uint(v))); }
__device__ __forceinline__ int bperm_i(int v, int src_lane) { return __builtin_amdgcn_ds_bpermute(src_lane << 2, v); }
__device__ __forceinline__ float softplus_f(float x) { return fmaxf(x, 0.f) + log1pf(expf(-fabsf(x))); }
__device__ __forceinline__ float silu_f(float x) { return x * __builtin_amdgcn_rcpf(1.f + __builtin_amdgcn_exp2f(-1.4426950408889634f * x)); }

namespace pg8 {
struct EpiInProj {
    static constexpr bool PERM = true, AFTER_DRAIN = false, KHOOK = false;
    bf16_t* O; int ldc; const float* rs; float* dtf; const float* dtb; int npart;
    __device__ __forceinline__ void operator()(const f32x4 (&acc)[2][2][4][2], const Unit& u, int wr, int wc, int fr, int fq) const {
        const int row0 = u.pm * BM + wr * 64 + fr, col0 = u.pn * BM + wc * 32 + 8 * fq;
        const bool dtl = dtf && (u.pn * BM == PC_DT - 128) && wc == 0 && fq == 0;
#pragma unroll
        for (int ai = 0; ai < 2; ++ai)
#pragma unroll
            for (int m = 0; m < 4; ++m) {
                const int row = row0 + ai * HALF + m * 16; float s;
                if (npart == 8) { const f32x4 p0 = *(const f32x4*)(rs + (size_t)row * 8), p1 = *(const f32x4*)(rs + (size_t)row * 8 + 4); s = rsqrtf((((p0[0] + p0[1]) + (p0[2] + p0[3])) + ((p1[0] + p1[1]) + (p1[2] + p1[3]))) * (1.f / 1024.f) + EPS); }
                else if (npart == 16) { const f32x4 p0 = *(const f32x4*)(rs + (size_t)row * 16), p1 = *(const f32x4*)(rs + (size_t)row * 16 + 4), p2 = *(const f32x4*)(rs + (size_t)row * 16 + 8), p3 = *(const f32x4*)(rs + (size_t)row * 16 + 12);
                    s = rsqrtf(((((p0[0] + p0[1]) + (p0[2] + p0[3])) + ((p1[0] + p1[1]) + (p1[2] + p1[3]))) + (((p2[0] + p2[1]) + (p2[2] + p2[3])) + ((p3[0] + p3[1]) + (p3[2] + p3[3])))) * (1.f / 1024.f) + EPS); }
                else s = rs[row];
#pragma unroll
                for (int bj = 0; bj < 2; ++bj) {
                    const f32x4 v0 = acc[ai][bj][m][0] * s, v1 = acc[ai][bj][m][1] * s;
                    u32x4 w; w.x = cvt_pk_bf16(v0[0], v0[1]); w.y = cvt_pk_bf16(v0[2], v0[3]); w.z = cvt_pk_bf16(v1[0], v1[1]); w.w = cvt_pk_bf16(v1[2], v1[3]);
                    *(u32x4*)(O + (size_t)row * ldc + col0 + bj * HALF) = w;
                    if (bj == 1 && dtl) {
                        f32x4 d0; d0[0] = softplus_f(v0[0] + dtb[0]); d0[1] = softplus_f(v0[1] + dtb[1]); d0[2] = softplus_f(v0[2] + dtb[2]); d0[3] = softplus_f(v0[3] + dtb[3]);
                        f32x4 d1; d1[0] = softplus_f(v1[0] + dtb[4]); d1[1] = softplus_f(v1[1] + dtb[5]); d1[2] = 0.f; d1[3] = 0.f;
                        *(f32x4*)(dtf + (size_t)row * 8) = d0; *(f32x4*)(dtf + (size_t)row * 8 + 4) = d1;
                    }
                }
            }
    }
};
__device__ __forceinline__ void group_rstd(const float* yssq, int row, float& r_ssd, float& r_sb, float& r_mem) {
    const f32x4 a = *(const f32x4*)(yssq + (size_t)row * 16), b = *(const f32x4*)(yssq + (size_t)row * 16 + 4), c = *(const f32x4*)(yssq + (size_t)row * 16 + 8), d = *(const f32x4*)(yssq + (size_t)row * 16 + 12);
    const float s0 = (a[0] + a[1]) + (a[2] + a[3]) + (b[0] + b[1]), s1 = (b[2] + b[3]) + (c[0] + c[1]) + (c[2] + c[3]), s2 = (d[0] + d[1]) + (d[2] + d[3]);
    r_ssd = rsqrtf(s0 * (1.f / 384.f) + EPS); r_sb = rsqrtf(s1 * (1.f / 384.f) + EPS); r_mem = rsqrtf(s2 * (1.f / 256.f) + EPS);
}
struct EpiOut {
    static constexpr bool PERM = false, AFTER_DRAIN = false, KHOOK = true;
    bf16_t* xb; float* xssq; const PG8_LAS float* gtab;
    __device__ __forceinline__ void khook(f32x4 (&acc)[2][2][4][2], const Unit& u, int t, int wr, int fr) const {
        if (t != 6 && t != 12) return;
#pragma unroll
        for (int ai = 0; ai < 2; ++ai)
#pragma unroll
            for (int m = 0; m < 4; ++m) {
                const float f = gtab[(t == 6 ? 0 : 256) + ai * HALF + wr * 64 + m * 16 + fr];
#pragma unroll
                for (int bj = 0; bj < 2; ++bj)
#pragma unroll
                    for (int n = 0; n < 2; ++n) acc[ai][bj][m][n] = acc[ai][bj][m][n] * f;
            }
    }
    __device__ __forceinline__ void operator()(const f32x4 (&acc)[2][2][4][2], const Unit& u, int wr, int wc, int fr, int fq) const {
        const int col0 = u.pn * BM + wc * 32 + 4 * fq;
#pragma unroll
        for (int ai = 0; ai < 2; ++ai)
#pragma unroll
            for (int m = 0; m < 4; ++m) {
                const int row = u.pm * BM + ai * HALF + wr * 64 + m * 16 + fr; const float r2 = gtab[512 + ai * HALF + wr * 64 + m * 16 + fr];
                float q = 0.f;
#pragma unroll
                for (int bj = 0; bj < 2; ++bj)
#pragma unroll
                    for (int n = 0; n < 2; ++n) {
                        const size_t off = (size_t)row * D + col0 + bj * HALF + n * 16;
                        typedef unsigned u32x2v __attribute__((ext_vector_type(2)));
                        const u32x2v bw = *(const u32x2v*)(xb + off);
                        const f32x4 x1 = (f32x4){__uint_as_float(bw.x << 16), __uint_as_float(bw.x & 0xffff0000u), __uint_as_float(bw.y << 16), __uint_as_float(bw.y & 0xffff0000u)} + acc[ai][bj][m][n] * r2;
                        u32x2v w; w.x = cvt_pk_bf16(x1[0], x1[1]); w.y = cvt_pk_bf16(x1[2], x1[3]); *(u32x2v*)(xb + off) = w;
                        q += (x1[0] * x1[0] + x1[1] * x1[1]) + (x1[2] * x1[2] + x1[3] * x1[3]);
                    }
                q = swap16_add(q, q); q = swap32_add(q, q);
                if (fq == 0) xssq[(size_t)row * 16 + u.pn * 4 + wc] = q;
            }
    }
};
struct EpiScores {
    static constexpr bool PERM = false, AFTER_DRAIN = false, KHOOK = false;
    float* O; const float* xssq;
    __device__ __forceinline__ void operator()(const f32x4 (&acc)[2][2][4][2], const Unit& u, int wr, int wc, int fr, int fq) const {
        const int col0 = u.pn * BM + wc * 32 + 4 * fq;
#pragma unroll
        for (int ai = 0; ai < 2; ++ai)
#pragma unroll
            for (int m = 0; m < 4; ++m) {
                const int row = u.pm * BM + ai * HALF + wr * 64 + m * 16 + fr;
                const f32x4 a = *(const f32x4*)(xssq + (size_t)row * 16), b = *(const f32x4*)(xssq + (size_t)row * 16 + 4), c = *(const f32x4*)(xssq + (size_t)row * 16 + 8), d = *(const f32x4*)(xssq + (size_t)row * 16 + 12);
                const float ss = ((a[0] + a[1]) + (a[2] + a[3])) + ((b[0] + b[1]) + (b[2] + b[3])) + ((c[0] + c[1]) + (c[2] + c[3])) + ((d[0] + d[1]) + (d[2] + d[3]));
                const float r = rsqrtf(ss * (1.f / 1024.f) + EPS);
#pragma unroll
                for (int bj = 0; bj < 2; ++bj)
#pragma unroll
                    for (int n = 0; n < 2; ++n) *(f32x4*)(O + (size_t)row * 2048 + col0 + bj * HALF + n * 16) = acc[ai][bj][m][n] * r;
            }
    }
};
}

struct Args { const float* in[22]; float* out; unsigned char* ws; int ph_lo, ph_hi, li, pad; };
enum { I_X = 0, I_MEM, I_NORM1G, I_WIN, I_CONVW, I_CONVB, I_DTBIAS, I_ALOG, I_DSKIP, I_SSDG, I_SBG, I_MEMNG, I_WMEMKV, I_MQG, I_MKG, I_MEMOG, I_WOUT, I_NORM2G, I_WQ, I_KEYS, I_PU, I_PV };

__device__ __forceinline__ int opq(int i) { asm volatile("" : "+s"(i)); return i; }
#define AIN(i) (a.in[opq(i)])
__device__ __forceinline__ void transpose_item(const float* W, int ldw, int src_c0, int nvalid, const float* g, bf16* WT, int K, int dst_r0, int k0, LAS float* scr, int lane) {
    const int c = lane & 31;
#pragma unroll 8
    for (int i = 0; i < 32; ++i) {
        const int kk = 2 * i + (lane >> 5);
        float v = (c < nvalid) ? W[(size_t)(k0 + kk) * ldw + src_c0 + c] : 0.f;
        if (g) v *= g[k0 + kk];
        scr[kk * 33 + c] = v;
    }
    LDS_WAIT(); asm volatile("" ::: "memory");
    const int c8 = lane & 7;
#pragma unroll
    for (int j = 0; j < 4; ++j) {
        const int n = (lane >> 3) + 8 * j; const LAS float* s = scr + (8 * c8) * 33 + n;
        v4u o; o.x = pkbf(s[0 * 33], s[1 * 33]); o.y = pkbf(s[2 * 33], s[3 * 33]); o.z = pkbf(s[4 * 33], s[5 * 33]); o.w = pkbf(s[6 * 33], s[7 * 33]);
        *(GAS v4u*)(WT + (size_t)(dst_r0 + n) * K + k0 + 8 * c8) = o;
    }
    LDS_WAIT(); asm volatile("" ::: "memory");
}
__device__ __forceinline__ void row_to_bf16(const float* xrow, bf16* orow, float* rs, bool partials, int lane) {
    const GAS f32x4* xr = (const GAS f32x4*)xrow + lane;
    f32x4 v[4]; float s = 0.f;
#pragma unroll
    for (int j = 0; j < 4; ++j) { v[j] = xr[64 * j]; s += (v[j].x * v[j].x + v[j].y * v[j].y) + (v[j].z * v[j].z + v[j].w * v[j].w); }
    s = wave_sum(s);
    GAS unsigned long long* o8 = (GAS unsigned long long*)orow + lane;
#pragma unroll
    for (int j = 0; j < 4; ++j) o8[64 * j] = (unsigned long long)pkbf(v[j].x, v[j].y) | ((unsigned long long)pkbf(v[j].z, v[j].w) << 32);
    if (partials) { if (lane < 8) rs[lane] = lane == 0 ? s : 0.f; }
    else if (lane == 0) *rs = rsqrtf(s * (1.f / 1024.f) + EPS);
}
__device__ __forceinline__ void ph_prologue(const Args& a, unsigned char* ws, LAS unsigned char* lds, int gw, int NGW, int wave, int lane) {
    LAS float* scr = (LAS float*)(lds + wave * 16384);
    constexpr int I_IN = 80 * 16, I_MEMW = 16 * 16, I_OUT = 32 * 16, I_SC = 32 * 16 + 128, PER_L = I_IN + I_MEMW + I_OUT + I_SC;
    constexpr int NW_ITEMS = NL * PER_L, NITEMS = NW_ITEMS;
    for (int it = gw; it < NITEMS; it += NGW) {
        if (it < NW_ITEMS) {
            const int l = it / PER_L; int r = it % PER_L;
            if (r < I_IN) {
                const int j = r / 16, kb = r % 16;
                const int src = (j < 32) ? 32 * j : (j < 76 ? 32 * j + 6 : 1024), nv = (j < 76) ? 32 : (j == 76 ? 6 : 0);
                transpose_item(AIN(I_WIN) + (size_t)l * D * DIN, DIN, src, nv, AIN(I_NORM1G) + l * D, (bf16*)(ws + WS_WIN) + (size_t)l * NPROJ * D, D, 32 * j, 64 * kb, scr, lane);
                continue;
            }
            r -= I_IN;
            if (r < I_MEMW) {
                const int j = r / 16, kb = r % 16;
                transpose_item(AIN(I_WMEMKV) + (size_t)l * D * 512, 512, 32 * j, 32, AIN(I_MEMNG) + l * D, (bf16*)(ws + WS_WMEM) + (size_t)l * 512 * D, D, 32 * j, 64 * kb, scr, lane);
                continue;
            }
            r -= I_MEMW;
            if (r < I_OUT) {
                const int j = r / 16, kb = r % 16;
                const float* g = (kb < 6) ? AIN(I_SSDG) + l * 384 : (kb < 12 ? AIN(I_SBG) + l * 384 - 384 : AIN(I_MEMOG) + l * 256 - 768);
                transpose_item(AIN(I_WOUT) + (size_t)l * D * D, D, 32 * j, 32, g, (bf16*)(ws + WS_WOUT) + (size_t)l * D * D, D, 32 * j, 64 * kb, scr, lane);
                continue;
            }
            r -= I_OUT;
            if (r < 32 * 16) { const int j = r / 16, kb = r % 16;
                transpose_item(AIN(I_WQ) + (size_t)l * D * D, D, 32 * j, 32, AIN(I_NORM2G) + l * D, (bf16*)(ws + WS_WSC) + (size_t)l * D * D, D, 32 * j, 64 * kb, scr, lane); }
            else { r -= 32 * 16;
                const GAS f32x4* kr = (const GAS f32x4*)(AIN(I_KEYS) + (size_t)l * 16 * 128 * 64 + (size_t)r * 1024) + lane; GAS unsigned long long* o8 = (GAS unsigned long long*)((bf16*)(ws + WS_KB) + (size_t)l * 16 * 128 * 64 + (size_t)r * 1024) + lane;
#pragma unroll
                for (int j = 0; j < 4; ++j) { const f32x4 v = kr[64 * j]; o8[64 * j] = (unsigned long long)pkbf(v.x, v.y) | ((unsigned long long)pkbf(v.z, v.w) << 32); } }
            continue;
        }
        (void)0;
    }
    for (int r0 = gw; r0 < T + MROWS; r0 += 4 * NGW) {
        f32x4 v[4][4];
#pragma unroll
        for (int q = 0; q < 4; ++q) { const int r = r0 + q * NGW; const float* src = r < T ? AIN(I_X) + (size_t)r * D : AIN(I_MEM) + (size_t)(r - T) * D;
#pragma unroll
            for (int j = 0; j < 4; ++j) v[q][j] = (r < T + MROWS) ? *((const GAS f32x4*)src + 64 * j + lane) : (f32x4){0.f, 0.f, 0.f, 0.f}; }
#pragma unroll
        for (int q = 0; q < 4; ++q) { const int r = r0 + q * NGW; if (r >= T + MROWS) continue;
            float ss = 0.f;
#pragma unroll
            for (int j = 0; j < 4; ++j) ss += (v[q][j].x * v[q][j].x + v[q][j].y * v[q][j].y) + (v[q][j].z * v[q][j].z + v[q][j].w * v[q][j].w);
            ss = wave_sum(ss);
            GAS unsigned long long* o8 = (GAS unsigned long long*)(r < T ? (bf16*)(ws + WS_XB) + (size_t)r * D : (bf16*)(ws + WS_MEMB) + (size_t)(r - T) * D) + lane;
#pragma unroll
            for (int j = 0; j < 4; ++j) o8[64 * j] = (unsigned long long)pkbf(v[q][j].x, v[q][j].y) | ((unsigned long long)pkbf(v[q][j].z, v[q][j].w) << 32);
            if (r < T) { if (lane < 8) ((float*)(ws + WS_RS1P))[(size_t)r * 8 + lane] = lane == 0 ? ss : 0.f; }
            else if (lane == 0) ((float*)(ws + WS_RSM))[r - T] = rsqrtf(ss * (1.f / 1024.f) + EPS);
        }
    }
}


__device__ __forceinline__ void convert_tables(const Args& a, unsigned char* ws, int l, int widx, int nw, int lane) {
    for (int r0 = widx; r0 < 2 * 16384; r0 += 4 * nw) {
        f32x4 v[4][4];
#pragma unroll
        for (int q = 0; q < 4; ++q) {
            const int r = r0 + q * nw; const int tb = r >> 14, e = (r & 16383) + l * 16384;
            const float* src = (tb == 0 ? AIN(I_PU) : AIN(I_PV)) + (size_t)e * D;
#pragma unroll
            for (int j = 0; j < 4; ++j) v[q][j] = (r < 2 * 16384) ? *((const GAS f32x4*)src + 64 * j + lane) : (f32x4){0.f, 0.f, 0.f, 0.f};
        }
#pragma unroll
        for (int q = 0; q < 4; ++q) {
            const int r = r0 + q * nw; const int tb = r >> 14, e = (r & 16383) + l * 16384;
            if (r >= 2 * 16384) continue;
            unsigned* dst = (unsigned*)(ws + (tb == 0 ? WS_UT : WS_VT) + (size_t)l * 16384 * D + (size_t)(e & 16383) * 128) + (lane & 31);
            const float* g = AIN(I_NORM2G) + l * D;
            float am = 0.f;
#pragma unroll
            for (int j = 0; j < 4; ++j) { if (tb == 0) v[q][j] = v[q][j] * *((const GAS f32x4*)g + 64 * j + lane);
                am = fmaxf(fmaxf(am, fmaxf(fabsf(v[q][j].x), fabsf(v[q][j].y))), fmaxf(fabsf(v[q][j].z), fabsf(v[q][j].w))); }
            am = wave_max(am);
            const float sc = am > 0.f ? 256.f / am : 1.f;
#pragma unroll
            for (int j = 0; j < 4; ++j) { int pk = 0; pk = __builtin_amdgcn_cvt_pk_fp8_f32(v[q][j].x * sc, v[q][j].y * sc, pk, false); pk = __builtin_amdgcn_cvt_pk_fp8_f32(v[q][j].z * sc, v[q][j].w * sc, pk, true); dst[(size_t)(2 * j + (lane >> 5)) * (16384 * 128 / 4)] = (unsigned)pk; }
            if (lane == 0) ((float*)(ws + (tb == 0 ? WS_USC : WS_VSC)))[e] = am > 0.f ? am * (1.f / 256.f) : 1.f;
        }
    }
}

typedef __attribute__((ext_vector_type(8))) __bf16 bf8_t;
typedef __attribute__((ext_vector_type(8))) float f32x8;
typedef __attribute__((ext_vector_type(8))) short s16x8;
typedef __attribute__((ext_vector_type(4))) short s16x4;
typedef __attribute__((ext_vector_type(16))) float f32x16;
typedef unsigned u32x2 __attribute__((ext_vector_type(2)));
#define MFMA32(a, b, c) __builtin_amdgcn_mfma_f32_32x32x16_bf16((a), (b), (c), 0, 0, 0)
__device__ __forceinline__ int crow(int i, int h) { return (i & 3) + 8 * (i >> 2) + 4 * h; }
__device__ __forceinline__ s16x8 cvt8(const f32x8 x) { return __builtin_bit_cast(s16x8, __builtin_convertvector(x, bf8_t)); }
__device__ __forceinline__ s16x8 pack_acc(const f32x16& x, int s) { f32x8 v;
#pragma unroll
    for (int j = 0; j < 8; ++j) v[j] = x[8 * s + j];
    return cvt8(v); }
__device__ __forceinline__ s16x8 cat4(const s16x4 lo, const s16x4 hi) { return __builtin_shufflevector(lo, hi, 0, 1, 2, 3, 4, 5, 6, 7); }
__device__ __forceinline__ f32x16 zero16() { f32x16 z;
#pragma unroll
    for (int i = 0; i < 16; ++i) z[i] = 0.f;
    return z; }
constexpr int L_BM = 0, L_CM = 18432, L_BMT = 36864, L_XDT = 54272, L_ACS = 106496, L_DT = 108032, L_TOT = 109568;

__device__ __forceinline__ void ssd_chunk_unit(const Args& a, unsigned char* ws, LAS unsigned char* lds, int l_, int unit, int tid, int wave, int lane) {
    const int g = unit & 1, c = (unit >> 1) & 31, b = unit >> 6, t0 = b * S + c * 128;
    const bf16* proj = (const bf16*)(ws + WS_PROJ); const float* dtf = (const float*)(ws + WS_DTF);
    LAS float* acs = (LAS float*)(lds + L_ACS); LAS float* dts = (LAS float*)(lds + L_DT); LAS float* tot = (LAS float*)(lds + L_TOT);
    float cs = 0.f, dtv = 0.f;
    if (wave < 6) {
        const int hh = wave >> 1, l = (wave & 1) * 64 + lane;
        dtv = dtf[(size_t)(t0 + l) * 8 + 3 * g + hh];
        cs = dtv * -expf(AIN(I_ALOG)[l_ * 6 + 3 * g + hh]);
#pragma unroll
        for (int o = 1; o < 64; o <<= 1) { const float t = bperm_f(cs, lane - o); if (lane >= o) cs += t; }
        if (lane == 63) tot[wave] = cs;
    }
    __syncthreads();
    if (wave < 6) {
        const int hh = wave >> 1, l = (wave & 1) * 64 + lane;
        if (wave & 1) cs += tot[wave - 1];
        acs[hh * 128 + l] = cs; dts[hh * 128 + l] = dtv;
        ((float*)(ws + WS_ACSG))[(size_t)(t0 + l) * 8 + 3 * g + hh] = cs;
    }
    __syncthreads();
    const float* cw = AIN(I_CONVW) + l_ * 4 * CONV_CH; const float* cb = AIN(I_CONVB) + l_ * CONV_CH;
#pragma unroll 2
    for (int it = 0; it < 10; ++it) {
        const int idx = tid + 512 * it, l = idx / 40, ck = idx % 40;
        int cc, kind, hh = 0, e0;
        if (ck < 24) { hh = ck >> 3; e0 = (ck & 7) * 8; cc = (3 * g + hh) * 64 + e0; kind = 0; }
        else if (ck < 32) { e0 = (ck - 24) * 8; cc = 384 + g * 64 + e0; kind = 1; }
        else { e0 = (ck - 32) * 8; cc = 512 + g * 64 + e0; kind = 2; }
        float acc[8];
        { const f32x4 b0 = *(const f32x4*)(cb + cc), b1 = *(const f32x4*)(cb + cc + 4); acc[0] = b0.x; acc[1] = b0.y; acc[2] = b0.z; acc[3] = b0.w; acc[4] = b1.x; acc[5] = b1.y; acc[6] = b1.z; acc[7] = b1.w; }
#pragma unroll
        for (int k = 0; k < 4; ++k) {
            const int sl = c * 128 + l - 3 + k;
            if (sl >= 0) {
                const v4u xv = *(const GAS v4u*)(proj + (size_t)(t0 + l - 3 + k) * NPROJ + PC_XBC + cc);
                const f32x4 w0 = *(const f32x4*)(cw + k * CONV_CH + cc), w1 = *(const f32x4*)(cw + k * CONV_CH + cc + 4);
                acc[0] += w0.x * __uint_as_float(xv.x << 16); acc[1] += w0.y * __uint_as_float(xv.x & 0xffff0000u);
                acc[2] += w0.z * __uint_as_float(xv.y << 16); acc[3] += w0.w * __uint_as_float(xv.y & 0xffff0000u);
                acc[4] += w1.x * __uint_as_float(xv.z << 16); acc[5] += w1.y * __uint_as_float(xv.z & 0xffff0000u);
                acc[6] += w1.z * __uint_as_float(xv.w << 16); acc[7] += w1.w * __uint_as_float(xv.w & 0xffff0000u);
            }
        }
#pragma unroll
        for (int e = 0; e < 8; ++e) acc[e] = silu_f(acc[e]);
        v4u pk; pk.x = pkbf(acc[0], acc[1]); pk.y = pkbf(acc[2], acc[3]); pk.z = pkbf(acc[4], acc[5]); pk.w = pkbf(acc[6], acc[7]);
        if (kind == 0) {
            *(GAS v4u*)((bf16*)(ws + WS_XCONV) + (size_t)(t0 + l) * 384 + (3 * g + hh) * 64 + e0) = pk;
            const float d = dts[hh * 128 + l];
            LAS bf16* xd = (LAS bf16*)(lds + L_XDT) + (hh * 64 + e0) * 136 + l;
#pragma unroll
            for (int e = 0; e < 8; e += 2) { const unsigned w = pkbf(acc[e] * d, acc[e + 1] * d); xd[e * 136] = (bf16)(w & 0xffffu); xd[(e + 1) * 136] = (bf16)(w >> 16); }
        } else if (kind == 1) {
            *(LAS v4u*)(lds + L_BM + (l * 72 + e0) * 2) = pk;
            LAS bf16* bt = (LAS bf16*)(lds + L_BMT) + e0 * 136 + l;
            bt[0 * 136] = (bf16)(pk.x & 0xffffu); bt[1 * 136] = (bf16)(pk.x >> 16); bt[2 * 136] = (bf16)(pk.y & 0xffffu); bt[3 * 136] = (bf16)(pk.y >> 16);
            bt[4 * 136] = (bf16)(pk.z & 0xffffu); bt[5 * 136] = (bf16)(pk.z >> 16); bt[6 * 136] = (bf16)(pk.w & 0xffffu); bt[7 * 136] = (bf16)(pk.w >> 16);
        } else {
            *(LAS v4u*)(lds + L_CM + (l * 72 + e0) * 2) = pk;
            *(GAS v4u*)((bf16*)(ws + WS_CMG) + (size_t)(t0 + l) * 128 + g * 64 + e0) = pk;
        }
    }
    __syncthreads();
    const int r = lane & 31, h = lane >> 5, lb = wave & 3, pt = wave >> 2;
    {
        s16x8 cf[4];
#pragma unroll
        for (int ks = 0; ks < 4; ++ks) cf[ks] = *(const LAS s16x8*)(lds + L_CM + ((lb * 32 + r) * 72 + ks * 16 + 8 * h) * 2);
        f32x16 gt[4];
#pragma unroll
        for (int sb = 0; sb < 4; ++sb) {
            gt[sb] = zero16();
            if (sb <= lb) {
#pragma unroll
                for (int ks = 0; ks < 4; ++ks) gt[sb] = MFMA32(*(const LAS s16x8*)(lds + L_BM + ((sb * 32 + r) * 72 + ks * 16 + 8 * h) * 2), cf[ks], gt[sb]);
            }
        }
#pragma unroll
        for (int hh = 0; hh < 3; ++hh) {
            const float al = acs[hh * 128 + lb * 32 + r];
            f32x16 yacc = zero16();
#pragma unroll
            for (int sb = 0; sb < 4; ++sb) {
                if (sb <= lb) {
                    f32x16 m;
#pragma unroll
                    for (int i = 0; i < 16; ++i) {
                        const int sl = crow(i, h);
                        const float v = gt[sb][i] * __expf(al - acs[hh * 128 + sb * 32 + sl]);
                        m[i] = (sb < lb || sl <= r) ? v : 0.f;
                    }
#pragma unroll
                    for (int ks = 0; ks < 2; ++ks) {
                        const LAS unsigned char* xp = lds + L_XDT + ((hh * 64 + pt * 32 + r) * 136 + sb * 32 + 16 * ks + 4 * h) * 2;
                        yacc = MFMA32(cat4(*(const LAS s16x4*)xp, *(const LAS s16x4*)(xp + 16)), pack_acc(m, ks), yacc);
                    }
                }
            }
            bf16* yp = (bf16*)(ws + WS_YPART) + (size_t)(t0 + lb * 32 + r) * 384 + (3 * g + hh) * 64 + pt * 32 + 4 * h;
#pragma unroll
            for (int i4 = 0; i4 < 4; ++i4) { u32x2 w; w.x = pkbf(yacc[4 * i4], yacc[4 * i4 + 1]); w.y = pkbf(yacc[4 * i4 + 2], yacc[4 * i4 + 3]); *(GAS u32x2*)(yp + 8 * i4) = w; }
        }
    }
    for (int tl = wave; tl < 12; tl += 8) {
        const int hh = tl >> 2, nt = (tl >> 1) & 1, pt2 = tl & 1;
        const float alast = acs[hh * 128 + 127];
        f32x16 acc = zero16();
#pragma unroll
        for (int ks = 0; ks < 8; ++ks) {
            const s16x8 af = *(const LAS s16x8*)(lds + L_BMT + ((nt * 32 + r) * 136 + ks * 16 + 8 * h) * 2);
            const v4u xr = *(const LAS v4u*)(lds + L_XDT + ((hh * 64 + pt2 * 32 + r) * 136 + ks * 16 + 8 * h) * 2);
            const LAS float* ap = acs + hh * 128 + ks * 16 + 8 * h;
            f32x8 xf;
            xf[0] = __uint_as_float(xr.x << 16) * __expf(alast - ap[0]); xf[1] = __uint_as_float(xr.x & 0xffff0000u) * __expf(alast - ap[1]);
            xf[2] = __uint_as_float(xr.y << 16) * __expf(alast - ap[2]); xf[3] = __uint_as_float(xr.y & 0xffff0000u) * __expf(alast - ap[3]);
            xf[4] = __uint_as_float(xr.z << 16) * __expf(alast - ap[4]); xf[5] = __uint_as_float(xr.z & 0xffff0000u) * __expf(alast - ap[5]);
            xf[6] = __uint_as_float(xr.w << 16) * __expf(alast - ap[6]); xf[7] = __uint_as_float(xr.w & 0xffff0000u) * __expf(alast - ap[7]);
            acc = MFMA32(af, cvt8(xf), acc);
        }
        float* hp = (float*)(ws + WS_HS) + ((size_t)((b * 32 + c) * 6 + 3 * g + hh) * 64 + pt2 * 32 + r) * 64 + nt * 32 + 4 * h;
#pragma unroll
        for (int i4 = 0; i4 < 4; ++i4) *(f32x4*)(hp + 8 * i4) = (f32x4){acc[4 * i4], acc[4 * i4 + 1], acc[4 * i4 + 2], acc[4 * i4 + 3]};
    }
    if (tid < 3) ((float*)(ws + WS_CD))[(b * 32 + c) * 6 + 3 * g + tid] = __expf(acs[tid * 128 + 127]);
    __syncthreads();
}
__device__ __forceinline__ void ph_ssd_scan(unsigned char* ws, int bx, int G, int tid) {
    float* hs = (float*)(ws + WS_HS); const float* cd = (const float*)(ws + WS_CD);
    for (int e = bx * 512 + tid; e < 24 * 4096; e += G * 512) {
        const int bh = e >> 12, el = e & 4095, b = bh / 6, hh = bh % 6;
        float run = 0.f;
#pragma unroll 4
        for (int c = 0; c < 32; ++c) {
            const int idx = (b * 32 + c) * 6 + hh;
            const float v = hs[(size_t)idx * 4096 + el], d = cd[idx];
            hs[(size_t)idx * 4096 + el] = run; run = run * d + v;
        }
    }
}
__device__ __forceinline__ void ssd_finish_unit(const Args& a, unsigned char* ws, LAS unsigned char* lds, int l_, int unit, int tid, int wave, int lane) {
    const int g = unit & 1, c = (unit >> 1) & 31, b = unit >> 6, t0 = b * S + c * 128;
    const int r = lane & 31, h = lane >> 5;
    const bf16* proj = (const bf16*)(ws + WS_PROJ);
    LAS float* sq = (LAS float*)lds;
    for (int item = wave; item < 24; item += NWAVES) {
        const int pt = item & 1, hh = (item >> 1) % 3, lb = item / 6, hd = 3 * g + hh;
        const int t = t0 + lb * 32 + r;
        const bf16* cmg = (const bf16*)(ws + WS_CMG) + (size_t)t * 128 + g * 64;
        const float* hin = (const float*)(ws + WS_HS) + (size_t)((b * 32 + c) * 6 + hd) * 4096;
        s16x8 cf[4]; f32x4 h0[4], h1[4];
#pragma unroll
        for (int ks = 0; ks < 4; ++ks) { cf[ks] = *(const GAS s16x8*)(cmg + ks * 16 + 8 * h); const float* hp = hin + (pt * 32 + r) * 64 + ks * 16 + 8 * h; h0[ks] = *(const GAS f32x4*)hp; h1[ks] = *(const GAS f32x4*)(hp + 4); }
        const float ea = __expf(((const float*)(ws + WS_ACSG))[(size_t)t * 8 + hd]), dsk = AIN(I_DSKIP)[l_ * 6 + hd];
        u32x2 yp[4], xc[4], zz[4];
#pragma unroll
        for (int i4 = 0; i4 < 4; ++i4) {
            const int col = hd * 64 + pt * 32 + 8 * i4 + 4 * h;
            yp[i4] = *(const GAS u32x2*)((const bf16*)(ws + WS_YPART) + (size_t)t * 384 + col);
            xc[i4] = *(const GAS u32x2*)((const bf16*)(ws + WS_XCONV) + (size_t)t * 384 + col);
            zz[i4] = *(const GAS u32x2*)(proj + (size_t)t * NPROJ + PC_Z + col);
        }
        f32x16 acc = zero16();
#pragma unroll
        for (int ks = 0; ks < 4; ++ks) acc = MFMA32(cvt8((f32x8){h0[ks].x, h0[ks].y, h0[ks].z, h0[ks].w, h1[ks].x, h1[ks].y, h1[ks].z, h1[ks].w}), cf[ks], acc);
        float ssq = 0.f;
#pragma unroll
        for (int i4 = 0; i4 < 4; ++i4) {
            const int col = hd * 64 + pt * 32 + 8 * i4 + 4 * h;
            const float y0 = (__uint_as_float(yp[i4].x << 16) + acc[4 * i4 + 0] * ea + dsk * __uint_as_float(xc[i4].x << 16)) * silu_f(__uint_as_float(zz[i4].x << 16));
            const float y1 = (__uint_as_float(yp[i4].x & 0xffff0000u) + acc[4 * i4 + 1] * ea + dsk * __uint_as_float(xc[i4].x & 0xffff0000u)) * silu_f(__uint_as_float(zz[i4].x & 0xffff0000u));
            const float y2 = (__uint_as_float(yp[i4].y << 16) + acc[4 * i4 + 2] * ea + dsk * __uint_as_float(xc[i4].y << 16)) * silu_f(__uint_as_float(zz[i4].y << 16));
            const float y3 = (__uint_as_float(yp[i4].y & 0xffff0000u) + acc[4 * i4 + 3] * ea + dsk * __uint_as_float(xc[i4].y & 0xffff0000u)) * silu_f(__uint_as_float(zz[i4].y & 0xffff0000u));
            ssq += (y0 * y0 + y1 * y1) + (y2 * y2 + y3 * y3);
            u32x2 w; w.x = pkbf(y0, y1); w.y = pkbf(y2, y3);
            *(GAS u32x2*)((bf16*)(ws + WS_YCAT) + (size_t)t * D + col) = w;
        }
        ssq = swap32_add(ssq, ssq);
        if (h == 0) sq[((lb * 32 + r) * 3 + hh) * 2 + pt] = ssq;
    }
    __syncthreads();
    if (tid < 384) { const int tk = tid & 127, hh = tid >> 7; ((float*)(ws + WS_YSSQ))[(size_t)(t0 + tk) * 16 + 3 * g + hh] = sq[(tk * 3 + hh) * 2] + sq[(tk * 3 + hh) * 2 + 1]; }
    __syncthreads();
}

#define LOG2E 1.4426950408889634f
__device__ __forceinline__ s16x8 trv_frag(const LAS unsigned char* vimg, int key0, int ks, int dt, int lane) {
    const int h = lane >> 5, i16 = lane & 15, blk = (lane >> 4) & 1;
    const LAS unsigned char* p = vimg + (key0 + 16 * ks + 4 * h + (i16 >> 2)) * 144 + (dt * 32 + 16 * blk) * 2 + 8 * (i16 & 3);
    const s16x4 lo = __builtin_amdgcn_ds_read_tr16_b64_v4i16((LAS s16x4*)p), hi = __builtin_amdgcn_ds_read_tr16_b64_v4i16((LAS s16x4*)(p + 8 * 144));
    return cat4(lo, hi);
}
__device__ __forceinline__ void mem_unit(const Args& a, unsigned char* ws, LAS unsigned char* lds, int l_, int b, int hd, int qb, int tid, int wave, int lane) {
    const bf16* proj = (const bf16*)(ws + WS_PROJ); const bf16* memkv = (const bf16*)(ws + WS_MEMKV);
    const float* qg = AIN(I_MQG) + l_ * 64; const float* kg = AIN(I_MKG) + l_ * 64;
    LAS unsigned char* kimg = lds; LAS unsigned char* vimg = lds + 36864;
#pragma unroll
    for (int it = 0; it < 4; ++it) {
        const int idx = tid + 512 * it, m = idx >> 3, ch = idx & 7;
        const v4u kv = *(const GAS v4u*)(memkv + (size_t)(b * NMEM + m) * 512 + hd * 64 + ch * 8);
        const v4u vv = *(const GAS v4u*)(memkv + (size_t)(b * NMEM + m) * 512 + 256 + hd * 64 + ch * 8);
        float kf[8] = {__uint_as_float(kv.x << 16), __uint_as_float(kv.x & 0xffff0000u), __uint_as_float(kv.y << 16), __uint_as_float(kv.y & 0xffff0000u),
                       __uint_as_float(kv.z << 16), __uint_as_float(kv.z & 0xffff0000u), __uint_as_float(kv.w << 16), __uint_as_float(kv.w & 0xffff0000u)};
        float ss = 0.f;
#pragma unroll
        for (int e = 0; e < 8; ++e) ss += kf[e] * kf[e];
        ss = sum8(ss);
        const float rk = rsqrtf(ss * (1.f / 64.f) + EPS);
        const f32x4 g0 = *(const f32x4*)(kg + ch * 8), g1 = *(const f32x4*)(kg + ch * 8 + 4);
        v4u pk; pk.x = pkbf(kf[0] * rk * g0.x, kf[1] * rk * g0.y); pk.y = pkbf(kf[2] * rk * g0.z, kf[3] * rk * g0.w); pk.z = pkbf(kf[4] * rk * g1.x, kf[5] * rk * g1.y); pk.w = pkbf(kf[6] * rk * g1.z, kf[7] * rk * g1.w);
        *(LAS v4u*)(kimg + (m * 72 + ch * 8) * 2) = pk;
        *(LAS v4u*)(vimg + (m * 72 + ch * 8) * 2) = vv;
    }
    __syncthreads();
    const int r = lane & 31, h = lane >> 5;
    const int t = b * S + qb * 256 + wave * 32 + r;
    s16x8 qf[4];
    {
        f32x8 qv[4]; float ss = 0.f;
#pragma unroll
        for (int ks = 0; ks < 4; ++ks) {
            const v4u q = *(const GAS v4u*)(proj + (size_t)t * NPROJ + PC_QMEM + hd * 64 + ks * 16 + 8 * h);
            qv[ks] = (f32x8){__uint_as_float(q.x << 16), __uint_as_float(q.x & 0xffff0000u), __uint_as_float(q.y << 16), __uint_as_float(q.y & 0xffff0000u),
                             __uint_as_float(q.z << 16), __uint_as_float(q.z & 0xffff0000u), __uint_as_float(q.w << 16), __uint_as_float(q.w & 0xffff0000u)};
#pragma unroll
            for (int e = 0; e < 8; ++e) ss += qv[ks][e] * qv[ks][e];
        }
        ss = swap32_add(ss, ss);
        const float rq = rsqrtf(ss * (1.f / 64.f) + EPS) * (0.125f * LOG2E);
#pragma unroll
        for (int ks = 0; ks < 4; ++ks) {
            const f32x4 g0 = *(const f32x4*)(qg + ks * 16 + 8 * h), g1 = *(const f32x4*)(qg + ks * 16 + 8 * h + 4);
            qf[ks] = cvt8(qv[ks] * rq * (f32x8){g0.x, g0.y, g0.z, g0.w, g1.x, g1.y, g1.z, g1.w});
        }
    }
    f32x16 st[8];
    float mx = -INFINITY;
#pragma unroll
    for (int kt = 0; kt < 8; ++kt) {
        st[kt] = zero16();
#pragma unroll
        for (int ks = 0; ks < 4; ++ks) st[kt] = MFMA32(*(const LAS s16x8*)(kimg + ((kt * 32 + r) * 72 + ks * 16 + 8 * h) * 2), qf[ks], st[kt]);
#pragma unroll
        for (int i = 0; i < 16; ++i) mx = fmaxf(mx, st[kt][i]);
    }
    mx = swap32_max(mx);
    float lsum = 0.f;
    f32x16 o0 = zero16(), o1 = zero16();
#pragma unroll
    for (int kt = 0; kt < 8; ++kt) {
#pragma unroll
        for (int i = 0; i < 16; ++i) { st[kt][i] = __builtin_amdgcn_exp2f(st[kt][i] - mx); lsum += st[kt][i]; }
#pragma unroll
        for (int ks = 0; ks < 2; ++ks) {
            const s16x8 pf = pack_acc(st[kt], ks);
            o0 = MFMA32(trv_frag(vimg, kt * 32, ks, 0, lane), pf, o0);
            o1 = MFMA32(trv_frag(vimg, kt * 32, ks, 1, lane), pf, o1);
        }
    }
    lsum = swap32_add(lsum, lsum);
    const float il = 1.f / lsum; float ssq = 0.f;
    bf16* yc = (bf16*)(ws + WS_YCAT) + (size_t)t * D + 768 + hd * 64 + 4 * h;
#pragma unroll
    for (int i4 = 0; i4 < 4; ++i4) {
        const float a0 = o0[4 * i4] * il, a1 = o0[4 * i4 + 1] * il, a2 = o0[4 * i4 + 2] * il, a3 = o0[4 * i4 + 3] * il;
        const float b0 = o1[4 * i4] * il, b1 = o1[4 * i4 + 1] * il, b2 = o1[4 * i4 + 2] * il, b3 = o1[4 * i4 + 3] * il;
        ssq += (a0 * a0 + a1 * a1) + (a2 * a2 + a3 * a3) + (b0 * b0 + b1 * b1) + (b2 * b2 + b3 * b3);
        u32x2 w; w.x = pkbf(a0, a1); w.y = pkbf(a2, a3); *(GAS u32x2*)(yc + 8 * i4) = w;
        w.x = pkbf(b0, b1); w.y = pkbf(b2, b3); *(GAS u32x2*)(yc + 32 + 8 * i4) = w;
    }
    ssq = swap32_add(ssq, ssq);
    if (h == 0) ((float*)(ws + WS_YSSQ))[(size_t)t * 16 + 12 + hd] = ssq;
    __syncthreads();
}
__device__ __forceinline__ void sb_unit(unsigned char* ws, LAS unsigned char* lds, int b, int hd, int qb, int tid, int wave, int lane) {
    const bf16* proj = (const bf16*)(ws + WS_PROJ);
    const int r = lane & 31, h = lane >> 5;
    const int q0w = qb * 256 + wave * 32, t = b * S + q0w + r;
    s16x8 qf[4];
#pragma unroll
    for (int ks = 0; ks < 4; ++ks) {
        const v4u q = *(const GAS v4u*)(proj + (size_t)t * NPROJ + PC_QSB + hd * 64 + ks * 16 + 8 * h);
        const f32x8 qv = (f32x8){__uint_as_float(q.x << 16), __uint_as_float(q.x & 0xffff0000u), __uint_as_float(q.y << 16), __uint_as_float(q.y & 0xffff0000u),
                                 __uint_as_float(q.z << 16), __uint_as_float(q.z & 0xffff0000u), __uint_as_float(q.w << 16), __uint_as_float(q.w & 0xffff0000u)};
        qf[ks] = cvt8(qv * (0.125f * LOG2E));
    }
    const int srow = tid >> 3, sch = tid & 7;
    const bf16* kbase = proj + (size_t)(b * S) * NPROJ + PC_KSB + hd * 64 + sch * 8;
    const int ktop = qb * 4 + 3;
    v4u kr = *(const GAS v4u*)(kbase + (size_t)(ktop * 64 + srow) * NPROJ), vr = *(const GAS v4u*)(kbase + (size_t)(ktop * 64 + srow) * NPROJ + (PC_VSB - PC_KSB));
    *(LAS v4u*)(lds + (srow * 72 + sch * 8) * 2) = kr; *(LAS v4u*)(lds + 9216 + (srow * 72 + sch * 8) * 2) = vr;
    __syncthreads();
    f32x16 o0 = zero16(), o1 = zero16();
    float R = 0.f;
    volatile LAS unsigned* live = (volatile LAS unsigned*)(lds + 36864);
    bool mylive = true;
    for (int kt = ktop; kt >= 0; --kt) {
        LAS unsigned char* kimg = lds + ((ktop - kt) & 1) * 18432; LAS unsigned char* vimg = kimg + 9216;
        if (kt > 0) { kr = *(const GAS v4u*)(kbase + (size_t)((kt - 1) * 64 + srow) * NPROJ); vr = *(const GAS v4u*)(kbase + (size_t)((kt - 1) * 64 + srow) * NPROJ + (PC_VSB - PC_KSB)); }
#pragma unroll
        for (int sub = 1; sub >= 0; --sub) {
            const int kb = kt * 64 + sub * 32;
            if (kb <= q0w && mylive) {
                const bool diag = (kb == q0w);
                f32x16 z = zero16();
#pragma unroll
                for (int ks = 0; ks < 4; ++ks) z = MFMA32(*(const LAS s16x8*)(kimg + ((sub * 32 + r) * 72 + ks * 16 + 8 * h) * 2), qf[ks], z);
                float lk[16];
#pragma unroll
                for (int i = 0; i < 16; ++i) {
                    const float sp = fmaxf(z[i], 0.f) + __builtin_amdgcn_logf(1.f + __builtin_amdgcn_exp2f(-fabsf(z[i])));
                    const bool ok = !diag || (crow(i, h) < r);
                    lk[i] = ok ? -sp : 0.f;
                    z[i] = ok ? z[i] : -INFINITY;
                }
                float g[4], pg[4];
#pragma unroll
                for (int j = 0; j < 4; ++j) { g[j] = (lk[4 * j] + lk[4 * j + 1]) + (lk[4 * j + 2] + lk[4 * j + 3]); pg[j] = partner32(g[j], h != 0); }
                float ab[4];
                ab[3] = R + (h == 0 ? pg[3] : 0.f);
#pragma unroll
                for (int j = 2; j >= 0; --j) ab[j] = ab[j + 1] + g[j + 1] + (h == 0 ? pg[j] : pg[j + 1]);
#pragma unroll
                for (int j = 0; j < 4; ++j) {
                    const float s3 = ab[j], s2 = s3 + lk[4 * j + 3], s1 = s2 + lk[4 * j + 2], s0 = s1 + lk[4 * j + 1];
                    z[4 * j + 3] = __builtin_amdgcn_exp2f(z[4 * j + 3] + lk[4 * j + 3] + s3);
                    z[4 * j + 2] = __builtin_amdgcn_exp2f(z[4 * j + 2] + lk[4 * j + 2] + s2);
                    z[4 * j + 1] = __builtin_amdgcn_exp2f(z[4 * j + 1] + lk[4 * j + 1] + s1);
                    z[4 * j + 0] = __builtin_amdgcn_exp2f(z[4 * j + 0] + lk[4 * j + 0] + s0);
                }
                R = ab[0] + g[0] + (h == 0 ? 0.f : pg[0]);
#pragma unroll
                for (int ks = 0; ks < 2; ++ks) {
                    const s16x8 pf = pack_acc(z, ks);
                    o0 = MFMA32(trv_frag(vimg, sub * 32, ks, 0, lane), pf, o0);
                    o1 = MFMA32(trv_frag(vimg, sub * 32, ks, 1, lane), pf, o1);
                }
            }
        }
        if (kt > 0) { LAS unsigned char* nimg = lds + ((ktop - kt + 1) & 1) * 18432; *(LAS v4u*)(nimg + (srow * 72 + sch * 8) * 2) = kr; *(LAS v4u*)(nimg + 9216 + (srow * 72 + sch * 8) * 2) = vr; }
        mylive = mylive && (__builtin_amdgcn_ballot_w64(R >= -150.f) != 0ull);
        if (lane == 0) live[((ktop - kt) & 1) * 8 + wave] = mylive ? 1u : 0u;
        __syncthreads();
        { unsigned any = 0u;
#pragma unroll
          for (int w = 0; w < 8; ++w) any |= live[((ktop - kt) & 1) * 8 + w];
          if (any == 0u) break; }
    }
    float ssq = 0.f;
    bf16* yc = (bf16*)(ws + WS_YCAT) + (size_t)t * D + 384 + hd * 64 + 4 * h;
#pragma unroll
    for (int i4 = 0; i4 < 4; ++i4) {
        const float a0 = o0[4 * i4], a1 = o0[4 * i4 + 1], a2 = o0[4 * i4 + 2], a3 = o0[4 * i4 + 3];
        const float b0 = o1[4 * i4], b1 = o1[4 * i4 + 1], b2 = o1[4 * i4 + 2], b3 = o1[4 * i4 + 3];
        ssq += (a0 * a0 + a1 * a1) + (a2 * a2 + a3 * a3) + (b0 * b0 + b1 * b1) + (b2 * b2 + b3 * b3);
        u32x2 w; w.x = pkbf(a0, a1); w.y = pkbf(a2, a3); *(GAS u32x2*)(yc + 8 * i4) = w;
        w.x = pkbf(b0, b1); w.y = pkbf(b2, b3); *(GAS u32x2*)(yc + 32 + 8 * i4) = w;
    }
    ssq = swap32_add(ssq, ssq);
    if (h == 0) ((float*)(ws + WS_YSSQ))[(size_t)t * 16 + 6 + hd] = ssq;
}
constexpr int CW_Q = 8192;
__device__ __forceinline__ void ph_mix(const Args& a, unsigned char* ws, LAS unsigned char* lds, int l, int tid, int wave, int lane) {
    unsigned* head = (unsigned*)(ws + WS_CTL) + CW_Q + 64 * l;
    volatile LAS unsigned* slot = (volatile LAS unsigned*)(lds + MISC_OFF);
    for (int it = 0;; ++it) {
        if (tid == 0) slot[it & 1] = __hip_atomic_fetch_add(head, 1u, __ATOMIC_RELAXED, __HIP_MEMORY_SCOPE_AGENT);
        __syncthreads();
        const int n = (int)slot[it & 1];
        if (n >= 896) break;
        asm volatile("" : "+s"(ws), "+v"(tid));
        lane = tid & 63; wave = __builtin_amdgcn_readfirstlane(tid >> 6);
        if (n < 256) ssd_chunk_unit(a, ws, lds, l, n, tid, wave, lane);
        else if (n < 640) { const int m = n - 256; const int qb = 15 - m / 24, bh = m % 24; sb_unit(ws, lds, bh / 6, bh % 6, qb, tid, wave, lane); }
        else { const int m = n - 640; mem_unit(a, ws, lds, l, m >> 6, (m >> 4) & 3, m & 15, tid, wave, lane); }
    }
}

__device__ __forceinline__ unsigned f2o(float f) { const unsigned b = __float_as_uint(f); return b ^ ((unsigned)((int)b >> 31) | 0x80000000u); }
__device__ __forceinline__ float o2f(unsigned k) { return __uint_as_float(k ^ ((k & 0x80000000u) ? 0x80000000u : 0xffffffffu)); }
#define TK_CE(a, b) do { const unsigned _mx = (a) > (b) ? (a) : (b), _mn = (a) > (b) ? (b) : (a); (a) = _mx; (b) = _mn; } while (0)
template <int N, int BASE> __device__ __forceinline__ void tk_sort16(unsigned (&k)[N]) {
#pragma unroll
    for (int sz = 2; sz <= 16; sz <<= 1)
#pragma unroll
        for (int j = sz >> 1; j > 0; j >>= 1)
#pragma unroll
            for (int i = 0; i < 16; ++i) { const int l = i ^ j; if (l > i) { if ((i & sz) == 0) TK_CE(k[BASE + i], k[BASE + l]); else TK_CE(k[BASE + l], k[BASE + i]); } }
}
template <int NA, int A, int NB_, int B> __device__ __forceinline__ void tk_merge16(unsigned (&ka)[NA], const unsigned (&kb)[NB_]) {
#pragma unroll
    for (int i = 0; i < 16; ++i) ka[A + i] = ka[A + i] > kb[B + 15 - i] ? ka[A + i] : kb[B + 15 - i];
#pragma unroll
    for (int j = 8; j > 0; j >>= 1)
#pragma unroll
        for (int i = 0; i < 16; ++i) { const int l = i ^ j; if (l > i) TK_CE(ka[A + i], ka[A + l]); }
}
__device__ __forceinline__ unsigned partner32_u(unsigned a, bool hi) { const auto r = __builtin_amdgcn_permlane32_swap(a, a, false, false); return hi ? r[0] : r[1]; }
__device__ __forceinline__ void ph_topk(unsigned char* ws, LAS unsigned char* lds, int l, int pm, int pn, int wave, int lane) {
    const bf16* qb = (const bf16*)(ws + WS_YCAT); const bf16* kb = (const bf16*)(ws + WS_KB) + (size_t)l * 16 * 128 * 64;
    unsigned short* eidx = (unsigned short*)(ws + WS_EIDX); float* gate = (float*)(ws + WS_GATE);
    LAS float* tr = (LAS float*)(lds + wave * WSCR);
    const int r = lane & 31, h = lane >> 5;
    for (int item = wave; item < 16; item += NWAVES) {
        const int hd = 2 * pn + (item & 1), t = pm * 256 + (item >> 1) * 32 + r;
        unsigned top[2][16];
#pragma unroll
        for (int c = 0; c < 2; ++c) {
            const int hc = 2 * hd + c;
            s16x8 qf[4];
#pragma unroll
            for (int ks = 0; ks < 4; ++ks) qf[ks] = *(const GAS s16x8*)(qb + (size_t)t * D + hc * 64 + ks * 16 + 8 * h);
            unsigned k[64];
#pragma unroll
            for (int nt = 0; nt < 4; ++nt) {
                f32x16 acc = zero16();
#pragma unroll
                for (int ks = 0; ks < 4; ++ks) acc = MFMA32(*(const GAS s16x8*)(kb + (size_t)(hc * 128 + nt * 32 + r) * 64 + ks * 16 + 8 * h), qf[ks], acc);
#pragma unroll
                for (int i = 0; i < 16; ++i) k[16 * nt + i] = (f2o(acc[i]) & ~127u) | (unsigned)((127 - 32 * nt - 8 * (i >> 2) - (i & 3)) - 4 * h);
            }
            tk_sort16<64, 0>(k); tk_sort16<64, 16>(k); tk_sort16<64, 32>(k); tk_sort16<64, 48>(k);
            tk_merge16<64, 0, 64, 16>(k, k); tk_merge16<64, 32, 64, 48>(k, k); tk_merge16<64, 0, 64, 32>(k, k);
            unsigned pk[16];
#pragma unroll
            for (int i = 0; i < 16; ++i) { top[c][i] = k[i]; pk[i] = partner32_u(k[i], h != 0); }
            tk_merge16<16, 0, 16, 0>(top[c], pk);
        }
        const int b = 0; (void)b;
        float av[16], bv[16];
#pragma unroll
        for (int i = 0; i < 16; ++i) { av[i] = o2f(top[0][i] & ~127u); bv[i] = o2f(top[1][i] & ~127u); }
        LAS int* li = (LAS int*)tr + lane * 32;
#pragma unroll
        for (int i = 0; i < 16; ++i) { li[i] = 127 - (int)(top[0][i] & 127u); li[16 + i] = 127 - (int)(top[1][i] & 127u); }
        unsigned key[64];
        key[0] = (f2o(av[0] + bv[0]) & ~255u) | 255u;
        key[1] = (f2o(av[0] + bv[1]) & ~255u) | 254u;
        key[2] = (f2o(av[0] + bv[2]) & ~255u) | 253u;
        key[3] = (f2o(av[0] + bv[3]) & ~255u) | 252u;
        key[4] = (f2o(av[0] + bv[4]) & ~255u) | 251u;
        key[5] = (f2o(av[0] + bv[5]) & ~255u) | 250u;
        key[6] = (f2o(av[0] + bv[6]) & ~255u) | 249u;
        key[7] = (f2o(av[0] + bv[7]) & ~255u) | 248u;
        key[8] = (f2o(av[0] + bv[8]) & ~255u) | 247u;
        key[9] = (f2o(av[0] + bv[9]) & ~255u) | 246u;
        key[10] = (f2o(av[0] + bv[10]) & ~255u) | 245u;
        key[11] = (f2o(av[0] + bv[11]) & ~255u) | 244u;
        key[12] = (f2o(av[0] + bv[12]) & ~255u) | 243u;
        key[13] = (f2o(av[0] + bv[13]) & ~255u) | 242u;
        key[14] = (f2o(av[0] + bv[14]) & ~255u) | 241u;
        key[15] = (f2o(av[0] + bv[15]) & ~255u) | 240u;
        key[16] = (f2o(av[1] + bv[0]) & ~255u) | 239u;
        key[17] = (f2o(av[1] + bv[1]) & ~255u) | 238u;
        key[18] = (f2o(av[1] + bv[2]) & ~255u) | 237u;
        key[19] = (f2o(av[1] + bv[3]) & ~255u) | 236u;
        key[20] = (f2o(av[1] + bv[4]) & ~255u) | 235u;
        key[21] = (f2o(av[1] + bv[5]) & ~255u) | 234u;
        key[22] = (f2o(av[1] + bv[6]) & ~255u) | 233u;
        key[23] = (f2o(av[1] + bv[7]) & ~255u) | 232u;
        key[24] = (f2o(av[2] + bv[0]) & ~255u) | 223u;
        key[25] = (f2o(av[2] + bv[1]) & ~255u) | 222u;
        key[26] = (f2o(av[2] + bv[2]) & ~255u) | 221u;
        key[27] = (f2o(av[2] + bv[3]) & ~255u) | 220u;
        key[28] = (f2o(av[2] + bv[4]) & ~255u) | 219u;
        key[29] = (f2o(av[3] + bv[0]) & ~255u) | 207u;
        key[30] = (f2o(av[3] + bv[1]) & ~255u) | 206u;
        key[31] = (f2o(av[3] + bv[2]) & ~255u) | 205u;
        key[32] = (f2o(av[3] + bv[3]) & ~255u) | 204u;
        key[33] = (f2o(av[4] + bv[0]) & ~255u) | 191u;
        key[34] = (f2o(av[4] + bv[1]) & ~255u) | 190u;
        key[35] = (f2o(av[4] + bv[2]) & ~255u) | 189u;
        key[36] = (f2o(av[5] + bv[0]) & ~255u) | 175u;
        key[37] = (f2o(av[5] + bv[1]) & ~255u) | 174u;
        key[38] = (f2o(av[6] + bv[0]) & ~255u) | 159u;
        key[39] = (f2o(av[6] + bv[1]) & ~255u) | 158u;
        key[40] = (f2o(av[7] + bv[0]) & ~255u) | 143u;
        key[41] = (f2o(av[7] + bv[1]) & ~255u) | 142u;
        key[42] = (f2o(av[8] + bv[0]) & ~255u) | 127u;
        key[43] = (f2o(av[9] + bv[0]) & ~255u) | 111u;
        key[44] = (f2o(av[10] + bv[0]) & ~255u) | 95u;
        key[45] = (f2o(av[11] + bv[0]) & ~255u) | 79u;
        key[46] = (f2o(av[12] + bv[0]) & ~255u) | 63u;
        key[47] = (f2o(av[13] + bv[0]) & ~255u) | 47u;
        key[48] = (f2o(av[14] + bv[0]) & ~255u) | 31u;
        key[49] = (f2o(av[15] + bv[0]) & ~255u) | 15u;
#pragma unroll
        for (int i = 50; i < 64; ++i) key[i] = 0u;
        tk_sort16<64, 0>(key); tk_sort16<64, 16>(key); tk_sort16<64, 32>(key); tk_sort16<64, 48>(key);
        tk_merge16<64, 0, 64, 16>(key, key); tk_merge16<64, 32, 64, 48>(key, key); tk_merge16<64, 0, 64, 32>(key, key);
        asm volatile("s_waitcnt lgkmcnt(0)" ::: "memory");
        const float s0 = o2f(key[0] & ~255u);
        float ev[16]; int ei[16]; float den = 0.f;
#pragma unroll
        for (int w = 0; w < 16; ++w) {
            const unsigned ij = 255u - (key[w] & 255u);
            ev[w] = __expf(o2f(key[w] & ~255u) - s0); den += ev[w];
            ei[w] = li[ij >> 4] * 128 + li[16 + (ij & 15)];
        }
        const float inv = 1.f / den;
        const size_t ob = ((size_t)t * 8 + hd) * 16;
        if (h == 0) {
#pragma unroll
            for (int q = 0; q < 4; ++q) *(GAS f32x4*)(gate + ob + 4 * q) = (f32x4){ev[4 * q] * inv, ev[4 * q + 1] * inv, ev[4 * q + 2] * inv, ev[4 * q + 3] * inv};
#pragma unroll
            for (int q = 0; q < 2; ++q) { v4u pk; pk.x = (unsigned)ei[8 * q] | ((unsigned)ei[8 * q + 1] << 16); pk.y = (unsigned)ei[8 * q + 2] | ((unsigned)ei[8 * q + 3] << 16); pk.z = (unsigned)ei[8 * q + 4] | ((unsigned)ei[8 * q + 5] << 16); pk.w = (unsigned)ei[8 * q + 6] | ((unsigned)ei[8 * q + 7] << 16);
                *(GAS v4u*)(eidx + ob + 8 * q) = pk; }
        }
        asm volatile("s_waitcnt lgkmcnt(0)" ::: "memory");
    }
}

__device__ __forceinline__ float gelu_erf(float v) { return 0.5f * v * (1.f + erff(v * 0.70710678118654752f)); }
typedef __attribute__((ext_vector_type(2))) float f32x2v;
constexpr int CW_Q2 = 12288;
__device__ __forceinline__ void cvt16(const v4u r, float (&f)[16]) {
    const unsigned w[4] = {r.x, r.y, r.z, r.w};
#pragma unroll
    for (int i = 0; i < 4; ++i) { const f32x2v lo = __builtin_amdgcn_cvt_pk_f32_fp8((int)w[i], false), hi = __builtin_amdgcn_cvt_pk_f32_fp8((int)w[i], true); f[4 * i] = lo.x; f[4 * i + 1] = lo.y; f[4 * i + 2] = hi.x; f[4 * i + 3] = hi.y; }
}
constexpr int PCH = 256, PTW = PCH / 8;
typedef __attribute__((ext_vector_type(4))) int i32x4;
struct PIdx { v4u e[2]; };
struct PTok { v4u r[16]; v4u w[2]; v4u xa, xc; };
__device__ __forceinline__ void peer_idx(PIdx& I, const GAS unsigned short* eidx, int t, int lane) {
    const GAS v4u* ep = (const GAS v4u*)(eidx + (size_t)t * 128 + 16 * (lane >> 3));
    I.e[0] = ep[0]; I.e[1] = ep[1];
}
template <int PHASE> __device__ __forceinline__ void peer_rows(PTok& K, const PIdx& I, const GAS unsigned char* tab, const GAS bf16* wgt, const GAS bf16* xb, int t, int s, int lane) {
    const int g = lane >> 3, j = lane & 7;
    const unsigned ew[8] = {I.e[0].x, I.e[0].y, I.e[0].z, I.e[0].w, I.e[1].x, I.e[1].y, I.e[1].z, I.e[1].w};
#pragma unroll
    for (int i = 0; i < 16; ++i) { const unsigned e = (i & 1) ? (ew[i >> 1] >> 16) : (ew[i >> 1] & 0xffffu); K.r[i] = *(const GAS v4u*)(tab + (size_t)e * 128 + 16 * j); }
    if (PHASE == 0) { const GAS unsigned char* xrow = (const GAS unsigned char*)(xb + (size_t)t * D + s * 128 + 16 * j); K.xa = *(const GAS v4u*)xrow; K.xc = *(const GAS v4u*)(xrow + 16); }
    else { const GAS v4u* wp = (const GAS v4u*)(wgt + (size_t)t * 128 + 16 * g); K.w[0] = wp[0]; K.w[1] = wp[1]; }
}
__device__ __forceinline__ void cvt16p(const v4u r, f32x2v (&f)[8]) {
    const unsigned w[4] = {r.x, r.y, r.z, r.w};
#pragma unroll
    for (int i = 0; i < 4; ++i) { f[2 * i] = __builtin_amdgcn_cvt_pk_f32_fp8((int)w[i], false); f[2 * i + 1] = __builtin_amdgcn_cvt_pk_f32_fp8((int)w[i], true); }
}
__device__ __forceinline__ void peer_u_compute(const PTok& K, LAS float* lpart, int lane) {
    const int g = lane >> 3, j = lane & 7;
    f32x2v xv[8];
    { const unsigned xw[8] = {K.xa.x, K.xa.y, K.xa.z, K.xa.w, K.xc.x, K.xc.y, K.xc.z, K.xc.w};
#pragma unroll
      for (int i = 0; i < 8; ++i) xv[i] = (f32x2v){__uint_as_float(xw[i] << 16), __uint_as_float(xw[i] & 0xffff0000u)}; }
    float res_lo = 0.f, res_hi = 0.f;
#pragma unroll
    for (int i = 0; i < 16; ++i) {
        f32x2v f[8]; cvt16p(K.r[i], f);
        f32x2v a0 = xv[0] * f[0], a1 = xv[1] * f[1];
#pragma unroll
        for (int k = 2; k < 8; k += 2) { a0 = a0 + xv[k] * f[k]; a1 = a1 + xv[k + 1] * f[k + 1]; }
        const f32x2v a = a0 + a1;
        const float d = sum8(a.x + a.y);
        if (i < 8) res_lo = (j == i) ? d : res_lo; else res_hi = (j == i - 8) ? d : res_hi;
    }
    lpart[16 * g + j] = res_lo; lpart[16 * g + 8 + j] = res_hi;
}
__device__ __forceinline__ void peer_v_compute(const PTok& K, LAS float* lout, int lane) {
    const int g = lane >> 3, j = lane & 7;
    f32x2v acc[8];
#pragma unroll
    for (int k = 0; k < 8; ++k) acc[k] = (f32x2v){0.f, 0.f};
#pragma unroll
    for (int i = 0; i < 16; ++i) {
        f32x2v f[8]; cvt16p(K.r[i], f);
        const unsigned wq = (i < 8 ? K.w[0] : K.w[1])[(i >> 1) & 3]; const float wi = __uint_as_float((i & 1) ? (wq & 0xffff0000u) : (wq << 16)); const f32x2v w2 = {wi, wi};
#pragma unroll
        for (int k = 0; k < 8; ++k) acc[k] = acc[k] + w2 * f[k];
    }
    float o[16];
#pragma unroll
    for (int k = 0; k < 8; ++k) {
        float a = acc[k].x, b = acc[k].y;
        a += dpp_f<0x128>(a); b += dpp_f<0x128>(b); a = swap16_add(a, a); b = swap16_add(b, b); o[2 * k] = swap32_add(a, a); o[2 * k + 1] = swap32_add(b, b);
    }
    if (g == 0) {
#pragma unroll
        for (int q = 0; q < 4; ++q) *(LAS f32x4*)(lout + 16 * j + 4 * q) = (f32x4){o[4 * q], o[4 * q + 1], o[4 * q + 2], o[4 * q + 3]};
    }
}
template <int PHASE> __device__ __forceinline__ void ph_peer_sliced(unsigned char* ws, LAS unsigned char* lds, float* xout, int l, int tid, int wave, int lane) {
    unsigned* heads = (unsigned*)(ws + WS_CTL) + CW_Q2 + (l * 2 + PHASE) * 8 * 64;
    volatile LAS unsigned* slot = (volatile LAS unsigned*)(lds + MISC_OFF);
    const GAS unsigned short* eidx = (const GAS unsigned short*)(ws + WS_EIDX); const GAS bf16* wgt = (const GAS bf16*)(ws + WS_WV); GAS bf16* xb = (GAS bf16*)(ws + WS_XB);
    const int myx = (int)(xb_xcc_id() & 7u);
    if (tid == 0) slot[2] = 0xffu;
    int it = 0;
    unsigned avail = 0xffu;
    for (int k = 0; k < 8; ++k) {
        if (k == 1) {
            if (tid < 8) { const unsigned hv = __hip_atomic_load(heads + 64 * ((myx + tid) & 7), __ATOMIC_RELAXED, __HIP_MEMORY_SCOPE_AGENT); if (hv >= (unsigned)(T / PCH)) __hip_atomic_fetch_and((LAS unsigned*)(lds + MISC_OFF) + 2, ~(1u << tid), __ATOMIC_RELAXED, __HIP_MEMORY_SCOPE_WORKGROUP); }
            __syncthreads(); avail = slot[2]; __syncthreads();
        }
        if (!((avail >> k) & 1u)) continue;
        const int s = (myx + k) & 7;
        const GAS unsigned char* tab = (const GAS unsigned char*)(ws + (PHASE == 0 ? WS_UT : WS_VT) + (size_t)l * 16384 * D + (size_t)s * 16384 * 128);
        GAS bf16* part = (GAS bf16*)(ws + WS_PART) + (size_t)s * T * 128;
        for (;; ++it) {
            if (tid == 0) slot[it & 1] = __hip_atomic_fetch_add(heads + 64 * s, 1u, __ATOMIC_RELAXED, __HIP_MEMORY_SCOPE_AGENT);
            __syncthreads();
            const int c = (int)slot[it & 1];
            if (c >= T / PCH) { ++it; break; }
            const int t0 = c * PCH + wave * PTW;
            LAS float* stg = (LAS float*)(lds + wave * WSCR);
            PIdx iB, iC; PTok A, B;
            peer_idx(iB, eidx, t0, lane);
            peer_rows<PHASE>(A, iB, tab, wgt, xb, t0, s, lane);
            peer_idx(iB, eidx, t0 + 1, lane);
#pragma unroll 2
            for (int i = 0; i < PTW; ++i) {
                peer_idx(iC, eidx, t0 + (i + 2 < PTW ? i + 2 : PTW - 1), lane);
                peer_rows<PHASE>(B, iB, tab, wgt, xb, t0 + (i + 1 < PTW ? i + 1 : PTW - 1), s, lane);
                if (PHASE == 0) peer_u_compute(A, stg + i * 128, lane); else peer_v_compute(A, stg + i * 128, lane);
                A = B; iB = iC;
            }
            asm volatile("s_waitcnt lgkmcnt(0)" ::: "memory");
            if (PHASE == 0) {
#pragma unroll
                for (int q = 0; q < PTW * 128 / 512; ++q) { const f32x4 p0 = *(const LAS f32x4*)(stg + q * 512 + lane * 8), p1 = *(const LAS f32x4*)(stg + q * 512 + lane * 8 + 4);
                    v4u w; w.x = pkbf(p0.x, p0.y); w.y = pkbf(p0.z, p0.w); w.z = pkbf(p1.x, p1.y); w.w = pkbf(p1.z, p1.w); *(GAS v4u*)(part + (size_t)t0 * 128 + q * 512 + lane * 8) = w; }
            } else {
                GAS float* xo = (GAS float*)xout; GAS float* rs1p = (GAS float*)(ws + WS_RS1P); GAS bf16* xbo = xb;
                constexpr int FB = 8;
#pragma unroll 1
                for (int q0 = 0; q0 < PTW / 2; q0 += FB) {
                    u32x2 bw[FB];
#pragma unroll
                    for (int q = 0; q < FB; ++q) { const int tk = 2 * (q0 + q) + (lane >> 5), cq = lane & 31; bw[q] = *(const GAS u32x2*)(xb + (size_t)(t0 + tk) * D + s * 128 + 4 * cq); }
#pragma unroll
                    for (int q = 0; q < FB; ++q) {
                        const int tk = 2 * (q0 + q) + (lane >> 5), cq = lane & 31, t = t0 + tk;
                        const f32x4 av = *(const LAS f32x4*)(stg + tk * 128 + 4 * cq);
                        const f32x4 xv = (f32x4){__uint_as_float(bw[q].x << 16), __uint_as_float(bw[q].x & 0xffff0000u), __uint_as_float(bw[q].y << 16), __uint_as_float(bw[q].y & 0xffff0000u)} + av;
                        if (l == NL - 1) *(GAS f32x4*)(xo + (size_t)t * D + s * 128 + 4 * cq) = xv;
                        else { u32x2 w; w.x = pkbf(xv.x, xv.y); w.y = pkbf(xv.z, xv.w); *(GAS u32x2*)(xbo + (size_t)t * D + s * 128 + 4 * cq) = w; }
                        float s2 = (xv.x * xv.x + xv.y * xv.y) + (xv.z * xv.z + xv.w * xv.w);
                        s2 = sum16(s2); s2 = swap16_add(s2, s2);
                        if (cq == 0) rs1p[(size_t)t * 8 + s] = s2;
                    }
                }
            }
            asm volatile("s_waitcnt lgkmcnt(0)" ::: "memory");
        }
    }
}
__device__ __forceinline__ void ph_peer_w(unsigned char* ws, int l, int gw, int NGW, int lane) {
    const GAS unsigned short* __restrict__ eidx = (const GAS unsigned short*)(ws + WS_EIDX); const GAS float* __restrict__ gate = (const GAS float*)(ws + WS_GATE); const GAS bf16* __restrict__ part = (const GAS bf16*)(ws + WS_PART);
    GAS bf16* __restrict__ wv = (GAS bf16*)(ws + WS_WV);
    const GAS float* __restrict__ usc = (const GAS float*)(ws + WS_USC) + l * 16384; const GAS float* __restrict__ vsc = (const GAS float*)(ws + WS_VSC) + l * 16384; const GAS float* __restrict__ xssq = (const GAS float*)(ws + WS_XSSQ);
    for (int t0 = gw; t0 < T; t0 += 4 * NGW) {
        float a[4][2], g[4][2], xs[4]; int e[4][2];
#pragma unroll
        for (int u = 0; u < 4; ++u) {
            const int t = t0 + u * NGW; xs[u] = xssq[(size_t)t * 16 + (lane & 15)];
#pragma unroll
            for (int hh = 0; hh < 2; ++hh) {
                const size_t q = (size_t)t * 128 + 64 * hh + lane;
                e[u][hh] = (int)eidx[q]; g[u][hh] = gate[q];
                float acc = 0.f;
#pragma unroll
                for (int s = 0; s < 8; ++s) acc += bf2f(part[(size_t)s * T * 128 + q]);
                a[u][hh] = acc;
            }
        }
#pragma unroll
        for (int u = 0; u < 4; ++u) {
            const int t = t0 + u * NGW;
            const float r2 = rsqrtf(sum16(xs[u]) * (1.f / 1024.f) + EPS);
#pragma unroll
            for (int hh = 0; hh < 2; ++hh) wv[(size_t)t * 128 + 64 * hh + lane] = (bf16)(pkbf(g[u][hh] * gelu_erf(a[u][hh] * (r2 * usc[e[u][hh]])) * vsc[e[u][hh]], 0.f) & 0xffffu);
        }
    }
}

constexpr int NPH_L = 9, NPHASES = 1 + NL * NPH_L;
__global__ void __launch_bounds__(NWAVES * 64, 2) mega(Args a) {
    extern __shared__ __attribute__((aligned(16))) unsigned char lds_raw[];
    {
        LAS unsigned char* lds0 = (LAS unsigned char*)lds_raw;
        for (int u = threadIdx.x; u < (LDS_BYTES - LDSCTL_OFF) / 4; u += NWAVES * 64) ((LAS unsigned*)(lds0 + LDSCTL_OFF))[u] = 0u;
        __syncthreads();
    }
    int wave0 = __builtin_amdgcn_readfirstlane((int)threadIdx.x >> 6); asm volatile("" : "+s"(wave0));
    int ph_lo = a.ph_lo, ph_hi = a.ph_hi; asm volatile("" : "+s"(ph_lo), "+s"(ph_hi));
    const bool multi = (ph_hi - ph_lo) > 1;
    XcdBarrier bar; bar.bar = (unsigned*)(a.ws + WS_CTL) + CW_BAR + a.li * XCD_BAR_WORDS; bar.x = 0; bar.st = nullptr;
    if (multi) bar = xcd_barrier_post((unsigned*)(a.ws + WS_CTL) + CW_BAR + a.li * XCD_BAR_WORDS, (volatile LAS unsigned*)((LAS unsigned char*)lds_raw + MISC_OFF) + 8);

    for (int ph = ph_lo; ph < ph_hi; ++ph) {
        unsigned char* ws = a.ws; asm volatile("" : "+s"(ws));
        int G = (int)gridDim.x; asm volatile("" : "+s"(G));
        int bx = (int)blockIdx.x; asm volatile("" : "+s"(bx));
        int tid; asm volatile("v_mbcnt_lo_u32_b32 %0, -1, 0\n\tv_mbcnt_hi_u32_b32 %0, -1, %0" : "=v"(tid)); tid |= wave0 << 6;
        LAS unsigned char* lds = (LAS unsigned char*)lds_raw;
        const int lane = tid & 63, wave = __builtin_amdgcn_readfirstlane(tid >> 6);
        const int vcu = (G % 8 == 0) ? (bx % 8) * (G / 8) + bx / 8 : bx;
        const int gw = vcu * NWAVES + wave, NGW = G * NWAVES;
        if (ph == 0) {
            ph_prologue(a, ws, lds, gw, NGW, wave, lane);
        } else {
            const int l = (ph - 1) / NPH_L, j = (ph - 1) % NPH_L;
            if (j == 0) {
              {
                { pg8::Gemm g{(const pg8::bf16_t*)(ws + WS_XB), (const pg8::bf16_t*)(ws + WS_WIN) + (size_t)l * NPROJ * D, T, NPROJ, D};
                  pg8::StaticOrder So; So.init(T, NPROJ, G, bx);
                  pg8::EpiInProj E{(pg8::bf16_t*)(ws + WS_PROJ), NPROJ, (const float*)(ws + WS_RS1P), (float*)(ws + WS_DTF), AIN(I_DTBIAS) + l * 6, 8};
                  pg8::gemm_phase<pg8::EpiInProj, pg8::StaticOrder, true, true>(lds, g, So, E, tid); }
                { const int nfull = ((T / 256) * (NPROJ / 256)) % G;
                    if (nfull == 0) convert_tables(a, ws, l, gw, NGW, lane); else if (bx >= nfull + 8) convert_tables(a, ws, l, (bx - nfull - 8) * NWAVES + wave, (G - nfull - 8) * NWAVES, lane); }
                { pg8::Gemm g{(const pg8::bf16_t*)(ws + WS_MEMB), (const pg8::bf16_t*)(ws + WS_WMEM) + (size_t)l * 512 * D, MROWS, 512, D};
                  pg8::StaticOrder So; So.init(MROWS, 512, G, (bx + G - (((T / 256) * (NPROJ / 256)) % G)) % G);
                  pg8::EpiInProj E{(pg8::bf16_t*)(ws + WS_MEMKV), 512, (const float*)(ws + WS_RSM), nullptr, nullptr, 0};
                  pg8::gemm_phase<pg8::EpiInProj, pg8::StaticOrder, true, true>(lds, g, So, E, tid); }
              }
            } else if (j == 1) {
                ph_mix(a, ws, lds, l, tid, wave, lane);
            } else if (j == 2) {
                ph_ssd_scan(ws, bx, G, tid);
            } else if (j == 3) {
                for (int u = vcu; u < 256; u += G) ssd_finish_unit(a, ws, lds, l, u, tid, wave, lane);
            } else if (j == 4) {
                pg8::Gemm g{(const pg8::bf16_t*)(ws + WS_YCAT), (const pg8::bf16_t*)(ws + WS_WOUT) + (size_t)l * D * D, T, D, D};
                pg8::StaticOrder So; So.init(T, D, G, bx);
                LAS float* gtab = (LAS float*)(lds + GTAB_OFF);
                { pg8::Unit u0; if (So.next(0, u0) && tid < 256) { float r0, r1, r2; pg8::group_rstd((const float*)(ws + WS_YSSQ), u0.pm * 256 + tid, r0, r1, r2); gtab[tid] = r0 / r1; gtab[256 + tid] = r1 / r2; gtab[512 + tid] = r2; } }
                __syncthreads();
                pg8::EpiOut E{(pg8::bf16_t*)(ws + WS_XB), (float*)(ws + WS_XSSQ), gtab};
                pg8::gemm_phase<pg8::EpiOut, pg8::StaticOrder, true, true>(lds, g, So, E, tid);
            } else if (j == 5) {
                pg8::Gemm g{(const pg8::bf16_t*)(ws + WS_XB), (const pg8::bf16_t*)(ws + WS_WSC) + (size_t)l * D * D, T, D, D};
                pg8::StaticOrder So; So.init(T, D, G, bx);
                pg8::EpiInProj E{(pg8::bf16_t*)(ws + WS_YCAT), D, (const float*)(ws + WS_XSSQ), nullptr, nullptr, 16};
                pg8::gemm_phase<pg8::EpiInProj, pg8::StaticOrder, true, true>(lds, g, So, E, tid);
                asm volatile("s_waitcnt vmcnt(0)" ::: "memory"); __syncthreads();
                if (tid == 0) __builtin_amdgcn_fence(__ATOMIC_ACQUIRE, "agent");
                asm volatile("s_waitcnt vmcnt(0)" ::: "memory"); __syncthreads();
                { pg8::Unit u0; if (So.next(0, u0)) ph_topk(ws, lds, l, u0.pm, u0.pn, wave, lane); }
            } else if (j == 6) {
                ph_peer_sliced<0>(ws, lds, a.out, l, tid, wave, lane);
            } else if (j == 7) {
                ph_peer_w(ws, l, gw, NGW, lane);
            } else if (j == 8) {
                ph_peer_sliced<1>(ws, lds, a.out, l, tid, wave, lane);
            }
        }
        if (ph + 1 < ph_hi) { XcdBarrier b2 = bar; { unsigned* p = b2.bar; unsigned x = b2.x; asm volatile("" : "+s"(p), "+s"(x)); b2.bar = p; b2.x = x; } xcd_barrier(b2, tid);
        }
    }
}

#ifndef MK_ONE_LAUNCH
#define MK_ONE_LAUNCH 1
#endif
extern "C" void kernel_launch(void* const* d_in, const int* in_sizes, int n_in, void* d_out, int out_size, void* d_ws, size_t ws_size, hipStream_t stream) {
    static int grid = 0;
    if (grid == 0) {
        if (n_in != 22 || out_size != T * D || ws_size < WS_END) { fprintf(stderr, "kernel_launch: unexpected problem (n_in %d out %d ws %zu)\n", n_in, out_size, ws_size); grid = -1; return; }
        int dev = 0, cus = 0, per_cu = 0;
        if (hipGetDevice(&dev) != hipSuccess || hipDeviceGetAttribute(&cus, hipDeviceAttributeMultiprocessorCount, dev) != hipSuccess) { grid = -1; return; }
        if (hipFuncSetAttribute((const void*)mega, hipFuncAttributeMaxDynamicSharedMemorySize, LDS_BYTES) != hipSuccess) { fprintf(stderr, "kernel_launch: hipFuncSetAttribute failed\n"); grid = -1; return; }
        if (hipOccupancyMaxActiveBlocksPerMultiprocessor(&per_cu, (const void*)mega, NWAVES * 64, LDS_BYTES) != hipSuccess || per_cu < 1) { fprintf(stderr, "kernel_launch: occupancy query says %d\n", per_cu); (void)hipGetLastError(); per_cu = 1; }
        if (cus != 256) { fprintf(stderr, "kernel_launch: built for a 256-CU device (one 256x256 tile per workgroup in the output-projection / query phases); this device reports %d CUs\n", cus); grid = -1; return; }
        grid = cus;
    }
    if (grid < 0) return;
    (void)hipMemsetAsync((char*)d_ws + WS_CTL, 0, CTL_ZERO_BYTES, stream);
    Args a{};
    for (int i = 0; i < 22; ++i) a.in[i] = (const float*)d_in[i];
    a.out = (float*)d_out; a.ws = (unsigned char*)d_ws;
#if MK_ONE_LAUNCH
    a.ph_lo = 0; a.ph_hi = NPHASES; a.li = 0;
    hipLaunchKernelGGL(mega, dim3(grid), dim3(NWAVES * 64), LDS_BYTES, stream, a);
#else
    for (int ph = 0; ph < NPHASES; ++ph) { a.ph_lo = ph; a.ph_hi = ph + 1; a.li = 0; hipLaunchKernelGGL(mega, dim3(grid), dim3(NWAVES * 64), LDS_BYTES, stream, a); }
#endif
}
```
